# Optimizing an MI355X kernel written in HIP

```python
import jax, jax.numpy as jnp
from jax import lax
import numpy as np

D_MODEL = 1024
BATCH = 8
SEQ = 8192
DEPTH = 2

GRID_W = 64
ROPE_THETA = 10000.0
ATTN_HEAD_DIM = 64
ATTN_Q_HEADS = 8
ATTN_KV_HEADS = 2
ATTN_GROUP = ATTN_Q_HEADS // ATTN_KV_HEADS
Q_BLOCK = 128
RET_HEADS = 4
RET_HEAD_DIM = 128
RET_CHUNK = 128
ATTN_W = ATTN_Q_HEADS * ATTN_HEAD_DIM
KV_W = ATTN_KV_HEADS * ATTN_HEAD_DIM
RET_W = RET_HEADS * RET_HEAD_DIM
MIX_W = ATTN_W + RET_W
IN_W = ATTN_W + 2 * KV_W + 4 * RET_W
SPLIT_POINTS = (ATTN_W, ATTN_W + KV_W, ATTN_W + 2 * KV_W, ATTN_W + 2 * KV_W + RET_W, ATTN_W + 2 * KV_W + 2 * RET_W, ATTN_W + 2 * KV_W + 3 * RET_W)
N_EXPERTS = 32
TOP_K = 4
D_FF_EXPERT = D_MODEL
SWIGLU_LIMIT = 7.0
SWIGLU_ALPHA = 1.702
MOE_BLOCK = 256
NORM_EPS = 1e-6

kernel_name = 'hybrid_gqa_retention_moe_encoder'


def rms_norm(x, g):
    xf = x.astype(jnp.float32)
    y = xf * lax.rsqrt(jnp.mean(xf * xf, axis=-1, keepdims=True) + NORM_EPS)
    return (y * g.astype(jnp.float32)).astype(x.dtype)


def axial_rope_tables(row_ids, col_ids, head_dim):
    quarter = head_dim // 4
    inv_freq = ROPE_THETA ** (-jnp.arange(quarter, dtype=jnp.float32) / quarter)
    ang_r = row_ids[:, None] * inv_freq[None, :]
    ang_c = col_ids[:, None] * inv_freq[None, :]
    return (jnp.cos(ang_r), jnp.sin(ang_r), jnp.cos(ang_c), jnp.sin(ang_c))


def apply_axial_rope(x, tables):
    cr, sr, cc, sc = [t[None, :, None, :].astype(x.dtype) for t in tables]
    a1, a2, b1, b2 = jnp.split(x, 4, axis=-1)
    return jnp.concatenate([a1 * cr - a2 * sr, a2 * cr + a1 * sr, b1 * cc - b2 * sc, b2 * cc + b1 * sc], axis=-1)


def block_attention(q, k, v):
    b, s, _, dh = q.shape
    nb = s // Q_BLOCK
    qb = jnp.moveaxis(q.reshape(b, nb, Q_BLOCK, ATTN_KV_HEADS, ATTN_GROUP, dh), 1, 0)
    scale = dh ** -0.5

    def one_block(qblk):
        sc = jnp.einsum('bqkgd,bskd->bkgqs', qblk, k).astype(jnp.float32) * scale
        p = jax.nn.softmax(sc, axis=-1).astype(v.dtype)
        return jnp.einsum('bkgqs,bskd->bqkgd', p, v)

    o = lax.map(one_block, qb)
    return jnp.moveaxis(o, 0, 1).reshape(b, s, ATTN_W)


def retention_one_direction(q, k, v, log_gamma):
    b, s, h, dk = q.shape
    dv = v.shape[-1]
    nc = s // RET_CHUNK
    idx = jnp.arange(RET_CHUNK, dtype=jnp.float32)
    diff = idx[:, None] - idx[None, :]
    inner_decay = jnp.where(diff >= 0, jnp.exp(log_gamma[:, None, None] * jnp.maximum(diff, 0.0)), 0.0)
    q_decay = jnp.exp(log_gamma[:, None] * (idx + 1.0))[None, :, :, None]
    k_decay = jnp.exp(log_gamma[:, None] * (RET_CHUNK - 1.0 - idx))[None, :, :, None]
    chunk_decay = jnp.exp(log_gamma * RET_CHUNK)[None, :, None, None]

    def to_chunks(t):
        return t.reshape(b, nc, RET_CHUNK, h, t.shape[-1]).transpose(1, 0, 3, 2, 4)

    def step(state, inp):
        qi, ki, vi = inp
        scores = jnp.einsum('bhqd,bhkd->bhqk', qi, ki) * inner_decay
        inner = jnp.einsum('bhqk,bhkv->bhqv', scores, vi)
        cross = jnp.einsum('bhqd,bhdv->bhqv', qi, state) * q_decay
        new_state = state * chunk_decay + jnp.einsum('bhkd,bhkv->bhdv', ki * k_decay, vi)
        return new_state, inner + cross

    state0 = jnp.zeros((b, h, dk, dv), jnp.float32)
    _, out = lax.scan(step, state0, (to_chunks(q), to_chunks(k), to_chunks(v)))
    return out.transpose(1, 0, 3, 2, 4).reshape(b, s, h, dv)


def hybrid_mixer(h, w_in, q_norm_g, k_norm_g, decay_fwd, decay_bwd, gn_g, gn_b, w_out, rope_a, rope_r):
    b, s, _ = h.shape
    proj = h @ w_in
    q_a, k_a, v_a, q_r, k_r, v_r, g_r = jnp.split(proj, SPLIT_POINTS, axis=-1)

    q_a = apply_axial_rope(rms_norm(q_a.reshape(b, s, ATTN_Q_HEADS, ATTN_HEAD_DIM), q_norm_g), rope_a)
    k_a = apply_axial_rope(rms_norm(k_a.reshape(b, s, ATTN_KV_HEADS, ATTN_HEAD_DIM), k_norm_g), rope_a)
    v_a = v_a.reshape(b, s, ATTN_KV_HEADS, ATTN_HEAD_DIM)
    o_attn = block_attention(q_a, k_a, v_a)

    q_r = apply_axial_rope(q_r.reshape(b, s, RET_HEADS, RET_HEAD_DIM), rope_r).astype(jnp.float32)
    k_r = (apply_axial_rope(k_r.reshape(b, s, RET_HEADS, RET_HEAD_DIM), rope_r).astype(jnp.float32) * (RET_HEAD_DIM ** -0.5))
    v_r = v_r.reshape(b, s, RET_HEADS, RET_HEAD_DIM).astype(jnp.float32)
    fwd = retention_one_direction(q_r, k_r, v_r, decay_fwd.astype(jnp.float32))
    bwd = jnp.flip(retention_one_direction(jnp.flip(q_r, 1), jnp.flip(k_r, 1), jnp.flip(v_r, 1), decay_bwd.astype(jnp.float32)), 1)
    ret = fwd + bwd
    mu = jnp.mean(ret, axis=-1, keepdims=True)
    var = jnp.mean(jnp.square(ret - mu), axis=-1, keepdims=True)
    ret = ((ret - mu) * lax.rsqrt(var + NORM_EPS)).reshape(b, s, RET_W)
    ret = ret * gn_g.astype(jnp.float32) + gn_b.astype(jnp.float32)
    o_ret = (jax.nn.silu(g_r.astype(jnp.float32)) * ret).astype(h.dtype)

    return jnp.concatenate([o_attn, o_ret], axis=-1) @ w_out


def routed_experts(h, w_router, b_router, w_up, b_up, w_down, b_down):
    n_tok = h.shape[0]
    logits = (h @ w_router + b_router).astype(jnp.float32)
    top_val, top_idx = lax.top_k(logits, TOP_K)
    top_w = jax.nn.softmax(top_val, axis=-1)
    n_asg = n_tok * TOP_K
    flat_e = top_idx.reshape(n_asg)
    order = jnp.argsort(flat_e)
    e_sorted = flat_e[order]
    tok_sorted = order // TOP_K
    w_sorted = top_w.reshape(n_asg)[order]
    n_blk = n_asg // MOE_BLOCK
    e_blk = e_sorted.reshape(n_blk, MOE_BLOCK)
    first = e_blk[:, 0]
    span = e_blk[:, -1] - first + 1
    ends = jnp.cumsum(span)
    starts = ends - span
    n_items = n_blk + N_EXPERTS - 1
    item = jnp.arange(n_items)
    item_blk = jnp.minimum(jnp.searchsorted(ends, item, side='right'), n_blk - 1)
    item_valid = item < ends[-1]
    item_exp = jnp.where(item_valid, first[item_blk] + item - starts[item_blk], 0)

    def step(acc, it):
        blk, e, valid = it
        start = blk * MOE_BLOCK
        rows = lax.dynamic_slice_in_dim(tok_sorted, start, MOE_BLOCK)
        es = lax.dynamic_slice_in_dim(e_sorted, start, MOE_BLOCK)
        ws = lax.dynamic_slice_in_dim(w_sorted, start, MOE_BLOCK)
        xb = jnp.take(h, rows, axis=0)
        up = xb @ w_up[e] + b_up[e]
        glu, lin = jnp.split(up, 2, axis=-1)
        glu = jnp.minimum(glu, SWIGLU_LIMIT)
        lin = jnp.clip(lin, -SWIGLU_LIMIT, SWIGLU_LIMIT)
        act = glu * jax.nn.sigmoid(SWIGLU_ALPHA * glu) * (lin + 1.0)
        y = act @ w_down[e] + b_down[e]
        coef = jnp.where((es == e) & valid, ws, 0.0).astype(h.dtype)
        return acc.at[rows].add(y * coef[:, None]), None

    out, _ = lax.scan(step, jnp.zeros_like(h), (item_blk, item_exp, item_valid))
    return out


def setup_inputs(seed: int = 0) -> dict:
    key = jax.random.key(seed)
    ks = jax.random.split(key, 22)
    f32 = jnp.float32
    L, D = DEPTH, D_MODEL

    def nrm(k, shape, scale):
        return jax.random.normal(k, shape, f32) * scale

    base_decay = jnp.log1p(-jnp.exp2(-5.0 - jnp.arange(RET_HEADS, dtype=f32)))
    return {
        'x': nrm(ks[0], (BATCH, SEQ, D), 1.0),
        'c': nrm(ks[1], (BATCH, D), 1.0),
        'ada_w': nrm(ks[2], (L, D, 6 * D), 0.5 * D ** -0.5),
        'ada_b': nrm(ks[3], (L, 6 * D), 0.02),
        'pre_mix_g': 1.0 + nrm(ks[4], (L, D), 0.05),
        'post_mix_g': 1.0 + nrm(ks[5], (L, D), 0.05),
        'w_in': nrm(ks[6], (L, D, IN_W), D ** -0.5),
        'q_norm_g': 1.0 + nrm(ks[7], (L, ATTN_HEAD_DIM), 0.05),
        'k_norm_g': 1.0 + nrm(ks[8], (L, ATTN_HEAD_DIM), 0.05),
        'ret_decay_fwd': base_decay * jnp.exp(nrm(ks[9], (L, RET_HEADS), 0.1)),
        'ret_decay_bwd': base_decay * jnp.exp(nrm(ks[10], (L, RET_HEADS), 0.1)),
        'ret_gn_g': 1.0 + nrm(ks[11], (L, RET_W), 0.05),
        'ret_gn_b': nrm(ks[12], (L, RET_W), 0.02),
        'w_out': nrm(ks[13], (L, MIX_W, D), MIX_W ** -0.5),
        'pre_ffn_g': 1.0 + nrm(ks[14], (L, D), 0.05),
        'post_ffn_g': 1.0 + nrm(ks[15], (L, D), 0.05),
        'router_w': nrm(ks[16], (L, D, N_EXPERTS), D ** -0.5),
        'router_b': nrm(ks[17], (L, N_EXPERTS), 0.01),
        'exp_w_up': nrm(ks[18], (L, N_EXPERTS, D, 2 * D_FF_EXPERT), D ** -0.5),
        'exp_b_up': nrm(ks[19], (L, N_EXPERTS, 2 * D_FF_EXPERT), 0.02),
        'exp_w_down': nrm(ks[20], (L, N_EXPERTS, D_FF_EXPERT, D), D_FF_EXPERT ** -0.5),
        'exp_b_down': nrm(ks[21], (L, N_EXPERTS, D), 0.02),
    }


def reference(x, c, ada_w, ada_b, pre_mix_g, post_mix_g, w_in, q_norm_g, k_norm_g, ret_decay_fwd, ret_decay_bwd, ret_gn_g, ret_gn_b, w_out, pre_ffn_g, post_ffn_g, router_w, router_b, exp_w_up, exp_b_up, exp_w_down, exp_b_down):
    b, s, d = x.shape
    rows = s // GRID_W
    row_ids = jnp.repeat(jnp.arange(rows, dtype=jnp.float32), GRID_W)
    col_ids = jnp.tile(jnp.arange(GRID_W, dtype=jnp.float32), rows)
    rope_a = axial_rope_tables(row_ids, col_ids, ATTN_HEAD_DIM)
    rope_r = axial_rope_tables(row_ids, col_ids, RET_HEAD_DIM)
    cond = jax.nn.silu(c)
    for l in range(DEPTH):
        mod = (cond @ ada_w[l] + ada_b[l])[:, None, :]
        sh_m, sc_m, g_m, sh_f, sc_f, g_f = jnp.split(mod, 6, axis=-1)
        hm = rms_norm(x, pre_mix_g[l]) * (1.0 + sc_m) + sh_m
        ym = hybrid_mixer(hm, w_in[l], q_norm_g[l], k_norm_g[l], ret_decay_fwd[l], ret_decay_bwd[l], ret_gn_g[l], ret_gn_b[l], w_out[l], rope_a, rope_r)
        x = x + g_m * rms_norm(ym, post_mix_g[l])
        hf = rms_norm(x, pre_ffn_g[l]) * (1.0 + sc_f) + sh_f
        yf = routed_experts(hf.reshape(b * s, d), router_w[l], router_b[l], exp_w_up[l], exp_b_up[l], exp_w_down[l], exp_b_down[l]).reshape(b, s, d)
        x = x + g_f * rms_norm(yf, post_ffn_g[l])
    return x
```

```cpp
#include <hip/hip_runtime.h>
#include <cstdio>
#include <cstdint>
namespace pg8 {
#define PG8_LAS __attribute__((address_space(3)))
typedef unsigned short bf16_t;
typedef short bf16x8 __attribute__((ext_vector_type(8)));
typedef float f32x4 __attribute__((ext_vector_type(4)));
typedef unsigned u32x4 __attribute__((ext_vector_type(4)));
constexpr int BM = 256, BK = 64, HALF = 128, HTB = HALF * BK * 2  , STAGE_BYTES = 8 * HTB, NXCD = 8, WGM = 8;

__host__ __device__ __forceinline__ int lds_byte(int r, int c) { const int st = (r >> 4) * 2 + (c >> 5), rr = r & 15, cc = c & 31, ob = rr * 64 + cc * 2; return st * 1024 + (ob ^ (((ob >> 9) & 1) << 5)); }
__host__ __device__ __forceinline__ void stage_rc(int b, int& R, int& C) { const int st = b / 1024, sb = b % 1024, swz = sb ^ (((sb >> 9) & 1) << 5); R = (st >> 1) * 16 + swz / 64; C = (st & 1) * 32 + (swz % 64) / 2; }
__host__ __device__ __forceinline__ int perm32(int rho) { const int n = rho >> 4, i = rho & 15; return 8 * (i >> 2) + 4 * n + (i & 3); }

struct Unit { int pm, pn; };
struct Gemm { const bf16_t* A; const bf16_t* Bt; int M, N, K; };

struct StaticOrder {
    int nM, nN, nwg, G, c;
    __host__ __device__ void init(int M, int N, int G_, int c_) { nM = M / BM; nN = N / BM; nwg = nM * nN; G = G_; c = c_; }
    __host__ __device__ bool next(int i, Unit& u) const {
        const long L = (long)i * G + c; if (L >= nwg) return false;
        int wgid = (int)L; { const int q = nwg / NXCD, r = nwg % NXCD, xcd = wgid % NXCD, off = wgid / NXCD; wgid = (xcd < r ? xcd * (q + 1) : r * (q + 1) + (xcd - r) * q) + off; }
        const int nig = WGM * nN, gid = wgid / nig, fm = gid * WGM, gsz = (nM - fm) < WGM ? (nM - fm) : WGM;
        u.pm = fm + ((wgid % nig) % gsz); u.pn = (wgid % nig) / gsz; return true;
    }
    __device__ __forceinline__ void a_ready(const Unit&) const {}
    __device__ __forceinline__ void done(const Unit&) const {}
};

__device__ __forceinline__ unsigned cvt_pk_bf16(float lo, float hi) { unsigned r; asm volatile("v_cvt_pk_bf16_f32 %0, %1, %2" : "=v"(r) : "v"(lo), "v"(hi)); return r; }
typedef float f32x2 __attribute__((ext_vector_type(2)));

struct EpiBf16 {
    static constexpr bool PERM = true, AFTER_DRAIN = false;
    bf16_t* O; int ldc; const float* bias; int split_cols; size_t split_stride;
    __device__ __forceinline__ void operator()(const f32x4 (&acc)[2][2][4][2], const Unit& u, int wr, int wc, int fr, int fq) const {
        const int row0 = u.pm * BM + wr * 64 + fr; int colt = u.pn * BM; bf16_t* base = O;
        if (split_cols) { const int t = colt / split_cols; base += (size_t)t * split_stride; colt -= t * split_cols; }
        const int col0 = colt + wc * 32 + 8 * fq, bcol0 = u.pn * BM + wc * 32 + 8 * fq;
        f32x4 bv[2][2];
#pragma unroll
        for (int bj = 0; bj < 2; ++bj)
#pragma unroll
            for (int n = 0; n < 2; ++n) bv[bj][n] = bias ? *(const f32x4*)(bias + bcol0 + bj * HALF + 4 * n) : (f32x4){0.f, 0.f, 0.f, 0.f};
#pragma unroll
        for (int ai = 0; ai < 2; ++ai)
#pragma unroll
            for (int m = 0; m < 4; ++m) { bf16_t* rowp = base + (size_t)(row0 + ai * HALF + m * 16) * ldc + col0;
#pragma unroll
                for (int bj = 0; bj < 2; ++bj) { const f32x4 v0 = acc[ai][bj][m][0] + bv[bj][0], v1 = acc[ai][bj][m][1] + bv[bj][1];
                    u32x4 w; w.x = cvt_pk_bf16(v0[0], v0[1]); w.y = cvt_pk_bf16(v0[2], v0[3]); w.z = cvt_pk_bf16(v1[0], v1[1]); w.w = cvt_pk_bf16(v1[2], v1[3]);
                    *(u32x4*)(rowp + bj * HALF) = w; } }
    }
};
__device__ __forceinline__ float swiglu_c(float g, float l) {
    g = fminf(g, 7.0f); l = fminf(fmaxf(l, -7.0f), 7.0f);
    const float s = __builtin_amdgcn_rcpf(1.0f + __builtin_amdgcn_exp2f(g * (-1.702f * 1.4426950408889634f)));
    return g * s * (l + 1.0f);
}
struct EpiMoeUp {
    static constexpr bool PERM = true, AFTER_DRAIN = false;
    bf16_t* O; const float* bias;
    __device__ __forceinline__ void operator()(const f32x4 (&acc)[2][2][4][2], const Unit& u, int wr, int wc, int fr, int fq) const {
        const int e = u.pn >> 3, pnl = u.pn & 7;
        const int row0 = u.pm * BM + wr * 64 + fr, cg0 = pnl * HALF + wc * 32 + 8 * fq;
        const float* bg = bias + (size_t)e * 2048 + cg0; const float* bl = bg + 1024;
        f32x4 bgv[2], blv[2];
#pragma unroll
        for (int n = 0; n < 2; ++n) { bgv[n] = *(const f32x4*)(bg + 4 * n); blv[n] = *(const f32x4*)(bl + 4 * n); }
#pragma unroll
        for (int ai = 0; ai < 2; ++ai)
#pragma unroll
            for (int m = 0; m < 4; ++m) { bf16_t* rowp = O + (size_t)(row0 + ai * HALF + m * 16) * 1024 + cg0;
                float a[8];
#pragma unroll
                for (int n = 0; n < 2; ++n) { const f32x4 g = acc[ai][0][m][n] + bgv[n], l = acc[ai][1][m][n] + blv[n];
#pragma unroll
                    for (int q = 0; q < 4; ++q) a[4 * n + q] = swiglu_c(g[q], l[q]); }
                u32x4 w; w.x = cvt_pk_bf16(a[0], a[1]); w.y = cvt_pk_bf16(a[2], a[3]); w.z = cvt_pk_bf16(a[4], a[5]); w.w = cvt_pk_bf16(a[6], a[7]);
                *(u32x4*)rowp = w; }
    }
};
template <int SH> struct MoeOrder {
    const PG8_LAS int* ts; int G, c, total;
    __device__ __forceinline__ bool next(int i, Unit& u) const {
        const int L = i * G + c; if (L >= total) return false;
        const int pm = L >> SH, pnl = L & ((1 << SH) - 1); int e = 0;
#pragma unroll
        for (int k = 1; k < 32; ++k) e += (pm >= ts[k]) ? 1 : 0;
        u.pm = pm; u.pn = (e << SH) + pnl; return true;
    }
    __device__ __forceinline__ void a_ready(const Unit&) const {}
    __device__ __forceinline__ void done(const Unit&) const {}
};
template <class Epi, class Sched, bool ALIGN_EPI = false, bool SP2 = false>
__device__ __forceinline__ void gemm_phase(PG8_LAS unsigned char* lds, const Gemm g, const Sched& S, const Epi& E) {
    int tid_ = threadIdx.x; asm volatile("" : "+v"(tid_));
    const int tid = tid_, wid = __builtin_amdgcn_readfirstlane(tid >> 6), lane = tid & 63, wr = wid >> 2, wc = wid & 3, fr = lane & 15, fq = lane >> 4;
    const int K = g.K, nt = K / BK;
    unsigned voffA[2], voffB[2];
#pragma unroll
    for (int i = 0; i < 2; ++i) { int R, C; stage_rc(tid * 16 + i * 8192, R, C); const int Rb = Epi::PERM ? ((R & ~31) + perm32(R & 31)) : R;
        voffA[i] = (unsigned)(R * K + C) * 2u; voffB[i] = (unsigned)(Rb * K + C) * 2u; }
    const size_t kstep = (size_t)(BK * 2);
    const size_t hstep = (size_t)HALF * K * 2;
    const size_t tstep = 2 * hstep;
    const unsigned ldsw = (unsigned)wid * 1024u;
    const int aoff = lds_byte(wr * 64 + fr, fq * 8), boff = lds_byte(wc * 32 + fr, fq * 8);
#define PG8_SA(b, h) (((b) * 2 + (h)) * HTB)
#define PG8_SB(b, h) ((4 + (b) * 2 + (h)) * HTB)
#define PG8_STAGE(bufoff, gbase, voff) do { _Pragma("unroll") for (int _i = 0; _i < 2; ++_i) \
        __builtin_amdgcn_global_load_lds((const unsigned*)((const char*)(gbase) + (voff)[_i]), (PG8_LAS unsigned*)(lds + (bufoff) + ldsw + _i * 8192), 16, 0, 0); } while (0)
#define PG8_LDA(dst, b, h) do { _Pragma("unroll") for (int m = 0; m < 4; ++m) _Pragma("unroll") for (int k = 0; k < 2; ++k) dst[m][k] = *(const PG8_LAS bf16x8*)(lds + PG8_SA(b, h) + aoff + m * 2048 + k * 1024); } while (0)
#define PG8_LDB(dst, b, h) do { _Pragma("unroll") for (int n = 0; n < 2; ++n) _Pragma("unroll") for (int k = 0; k < 2; ++k) dst[n][k] = *(const PG8_LAS bf16x8*)(lds + PG8_SB(b, h) + boff + n * 2048 + k * 1024); } while (0)
#define PG8_MMA(ai, bj, At, Bt) do { __builtin_amdgcn_s_setprio(1); _Pragma("unroll") for (int m = 0; m < 4; ++m) _Pragma("unroll") for (int n = 0; n < 2; ++n) _Pragma("unroll") for (int k = 0; k < 2; ++k) \
        acc[ai][bj][m][n] = __builtin_amdgcn_mfma_f32_16x16x32_bf16(Bt[n][k], At[m][k], acc[ai][bj][m][n], 0, 0, 0); __builtin_amdgcn_s_setprio(0); } while (0)
#define PG8_WAIT_V(n) asm volatile("s_waitcnt vmcnt(" #n ")" ::: "memory")
#define PG8_WAIT_L(n) asm volatile("s_waitcnt lgkmcnt(" #n ")" ::: "memory")
#define PG8_BAR __builtin_amdgcn_s_barrier()
#define PG8_SCHED __builtin_amdgcn_sched_barrier(0)
    Unit cur, nxt; int ui = 0;
    if (!S.next(0, cur)) return;
    f32x4 acc[2][2][4][2];
#pragma unroll
    for (int a = 0; a < 2; ++a)
#pragma unroll
        for (int b = 0; b < 2; ++b)
#pragma unroll
            for (int m = 0; m < 4; ++m)
#pragma unroll
                for (int n = 0; n < 2; ++n) acc[a][b][m][n] = (f32x4){0.f, 0.f, 0.f, 0.f};
    bf16x8 At[4][2], B0[2][2], B1[2][2];
    const char* cA = (const char*)g.A + (size_t)cur.pm * tstep; const char* cB = (const char*)g.Bt + (size_t)cur.pn * tstep;
    S.a_ready(cur);
    if constexpr (SP2) {
        PG8_STAGE(PG8_SB(0, 0), cB, voffB); PG8_STAGE(PG8_SB(0, 1), cB + hstep, voffB); PG8_STAGE(PG8_SA(0, 0), cA, voffA); PG8_STAGE(PG8_SA(0, 1), cA + hstep, voffA);
        if (wr == 1) PG8_BAR;
        PG8_WAIT_V(2); PG8_BAR;
        PG8_STAGE(PG8_SB(1, 0), cB + kstep, voffB); PG8_STAGE(PG8_SA(1, 0), cA + kstep, voffA); PG8_STAGE(PG8_SB(1, 1), cB + hstep + kstep, voffB);
        PG8_WAIT_V(6); PG8_BAR;
    } else {
        PG8_STAGE(PG8_SB(0, 0), cB, voffB); PG8_STAGE(PG8_SA(0, 0), cA, voffA); PG8_STAGE(PG8_SB(0, 1), cB + hstep, voffB); PG8_STAGE(PG8_SA(0, 1), cA + hstep, voffA);
        if (wr == 1) PG8_BAR;
        PG8_WAIT_V(4); PG8_BAR;
        PG8_STAGE(PG8_SB(1, 0), cB + kstep, voffB); PG8_STAGE(PG8_SA(1, 0), cA + kstep, voffA); PG8_STAGE(PG8_SB(1, 1), cB + hstep + kstep, voffB);
        PG8_WAIT_V(6); PG8_BAR;
    }
    for (;;) {
        const bool has_next = S.next(ui + 1, nxt);
        const char* nA = has_next ? (const char*)g.A + (size_t)nxt.pm * tstep : cA; const char* nB = has_next ? (const char*)g.Bt + (size_t)nxt.pn * tstep : cB;
        for (int t = 0; t < nt; t += 2) {
            const bool last = (t == nt - 2);
            const char* a1 = cA + (size_t)(t + 1) * kstep;
            const char* a2 = last ? nA : cA + (size_t)(t + 2) * kstep; const char* b2 = last ? nB : cB + (size_t)(t + 2) * kstep;
            const char* a3 = a2 + kstep; const char* b3 = b2 + kstep;
            if (last && has_next) S.a_ready(nxt);
            if constexpr (SP2) {
            PG8_LDB(B0, 0, 0); PG8_LDB(B1, 0, 1); PG8_SCHED; PG8_LDA(At, 0, 0); PG8_STAGE(PG8_SA(1, 1), a1 + hstep, voffA);
            PG8_WAIT_V(8); PG8_WAIT_L(0); PG8_BAR; PG8_MMA(0, 0, At, B0); PG8_MMA(0, 1, At, B1); PG8_BAR; PG8_SCHED;
            PG8_LDA(At, 0, 1); PG8_STAGE(PG8_SB(0, 0), b2, voffB); PG8_STAGE(PG8_SB(0, 1), b2 + hstep, voffB); PG8_STAGE(PG8_SA(0, 0), a2, voffA);
            PG8_WAIT_V(8); PG8_WAIT_L(0); PG8_BAR; PG8_MMA(1, 0, At, B0); PG8_MMA(1, 1, At, B1); PG8_BAR; PG8_SCHED;
            PG8_LDB(B0, 1, 0); PG8_LDB(B1, 1, 1); PG8_SCHED; PG8_LDA(At, 1, 0); PG8_STAGE(PG8_SA(0, 1), a2 + hstep, voffA);
            PG8_WAIT_V(8); PG8_WAIT_L(0); PG8_BAR; PG8_MMA(0, 0, At, B0); PG8_MMA(0, 1, At, B1); PG8_BAR; PG8_SCHED;
            PG8_LDA(At, 1, 1); PG8_STAGE(PG8_SB(1, 0), b3, voffB); PG8_STAGE(PG8_SB(1, 1), b3 + hstep, voffB); PG8_STAGE(PG8_SA(1, 0), a3, voffA);
            PG8_WAIT_V(8); PG8_WAIT_L(0); PG8_BAR; PG8_MMA(1, 0, At, B0); PG8_MMA(1, 1, At, B1); PG8_BAR; PG8_SCHED;
            } else {
            PG8_LDB(B0, 0, 0); PG8_SCHED; PG8_LDA(At, 0, 0); PG8_STAGE(PG8_SA(1, 1), a1 + hstep, voffA);
            PG8_WAIT_L(8); PG8_BAR; PG8_WAIT_L(0); PG8_MMA(0, 0, At, B0); PG8_BAR; PG8_SCHED;
            PG8_LDB(B1, 0, 1); PG8_STAGE(PG8_SB(0, 0), b2, voffB);
            PG8_BAR; PG8_WAIT_L(0); PG8_MMA(0, 1, At, B1); PG8_BAR;
            PG8_LDA(At, 0, 1); PG8_STAGE(PG8_SA(0, 0), a2, voffA);
            PG8_BAR; PG8_WAIT_L(0); PG8_MMA(1, 0, At, B0); PG8_BAR; PG8_SCHED;
            PG8_STAGE(PG8_SB(0, 1), b2 + hstep, voffB);
            PG8_WAIT_V(6); PG8_BAR; PG8_MMA(1, 1, At, B1); PG8_BAR;
            PG8_LDB(B0, 1, 0); PG8_SCHED; PG8_LDA(At, 1, 0); PG8_STAGE(PG8_SA(0, 1), a2 + hstep, voffA);
            PG8_WAIT_L(8); PG8_BAR; PG8_WAIT_L(0); PG8_MMA(0, 0, At, B0); PG8_BAR; PG8_SCHED;
            PG8_LDB(B1, 1, 1); PG8_STAGE(PG8_SB(1, 0), b3, voffB);
            PG8_BAR; PG8_WAIT_L(0); PG8_MMA(0, 1, At, B1); PG8_BAR;
            PG8_LDA(At, 1, 1); PG8_STAGE(PG8_SA(1, 0), a3, voffA);
            PG8_BAR; PG8_WAIT_L(0); PG8_MMA(1, 0, At, B0); PG8_BAR; PG8_SCHED;
            PG8_STAGE(PG8_SB(1, 1), b3 + hstep, voffB);
            PG8_WAIT_V(6); PG8_BAR; PG8_MMA(1, 1, At, B1); PG8_BAR;
            }
        }
        if constexpr (ALIGN_EPI) { if (wr == 0) PG8_BAR; }
        if constexpr (!Epi::AFTER_DRAIN) { E(acc, cur, wr, wc, fr, fq); S.done(cur); }
        if (!has_next) break;
#pragma unroll
        for (int a = 0; a < 2; ++a)
#pragma unroll
            for (int b = 0; b < 2; ++b)
#pragma unroll
                for (int m = 0; m < 4; ++m)
#pragma unroll
                    for (int n = 0; n < 2; ++n) acc[a][b][m][n] = (f32x4){0.f, 0.f, 0.f, 0.f};
        cur = nxt; cA = nA; cB = nB; ++ui;
        if constexpr (ALIGN_EPI) { if (wr == 1) PG8_BAR; }
    }
    PG8_WAIT_V(0);
    if constexpr (!ALIGN_EPI) { if (wr == 0) PG8_BAR; }
    PG8_BAR;
    if constexpr (Epi::AFTER_DRAIN) { E.fused(acc, cur, wr, wc, fr, fq, lds, wid, lane); S.done(cur); }
#undef PG8_SA
#undef PG8_SB
#undef PG8_STAGE
#undef PG8_LDA
#undef PG8_LDB
#undef PG8_MMA
#undef PG8_WAIT_V
#undef PG8_WAIT_L
#undef PG8_BAR
#undef PG8_SCHED
}
}
#include <hip/hip_bf16.h>
#include <cmath>
namespace attn_body {
using bf16=__hip_bfloat16;
using bf16x8=__attribute__((ext_vector_type(8)))short;
using s16x4=__attribute__((ext_vector_type(4)))short;
using f32x16=__attribute__((ext_vector_type(16)))float;
using u32x4=__attribute__((ext_vector_type(4)))unsigned;
constexpr int BATCH=8,NHEAD=8,NKVH=2,SEQ=8192,D=64,PQ=2816,PO=1024;
constexpr int NW=8,QBLK=32,QB=QBLK*NW,KVBLK=64,NQB=SEQ/QB;
constexpr int ATTN_UNIT_ROWS=QB;
__device__ __forceinline__ int crow(int r,int hi){return (r&3)+8*(r>>2)+4*hi;}
#define SBAR() __builtin_amdgcn_sched_barrier(0)
__device__ __forceinline__ void cmask(f32x16&p0,f32x16&p1,int jb,int qrel,int hi){
  const float NEG=-INFINITY; int kb=64*jb+4*hi;
  #pragma unroll
  for(int r=0;r<16;++r){int kv=kb+(r&3)+8*(r>>2); if(kv>qrel)p0[r]=NEG; if(kv+32>qrel)p1[r]=NEG;}
}

constexpr int NSLOT=3, SLOTB=8192;
constexpr int LDS_K=0, LDS_V=NSLOT*SLOTB, LDS_WS=2*NSLOT*SLOTB, LDS_OST=LDS_WS+NW*64*4, LDS_BYTES=LDS_OST+NW*4096;
constexpr float C2=0.125f*1.4426950408889634f;
__device__ __forceinline__ void glds16(const void*gsrc,unsigned lds_dst){unsigned keep;
  asm volatile("s_mov_b32 %0, m0\n\ts_mov_b32 m0, %2\n\ts_nop 0\n\tglobal_load_lds_dwordx4 %1, off\n\ts_mov_b32 m0, %0":"=&s"(keep):"v"(gsrc),"s"(lds_dst):"memory");}
__device__ __forceinline__ float max3f(float a,float b,float c){float r;asm("v_max3_f32 %0, %1, %2, %3":"=v"(r):"v"(a),"v"(b),"v"(c));return r;}
__device__ __forceinline__ float max2f(float a,float b){float r;asm("v_max_f32_e32 %0, %1, %2":"=v"(r):"v"(a),"v"(b));return r;}
__device__ __forceinline__ float fadd_s(float a,float b){float r;asm("v_add_f32_e32 %0, %1, %2":"=v"(r):"v"(a),"v"(b));return r;}
__device__ __forceinline__ float fsub_s(float a,float b){float r;asm("v_sub_f32_e32 %0, %1, %2":"=v"(r):"v"(a),"v"(b));return r;}
typedef float f32x2_t __attribute__((ext_vector_type(2))); typedef __bf16 bf16x2_t __attribute__((ext_vector_type(2)));
__device__ __forceinline__ unsigned cvtpk_s(float lo,float hi){f32x2_t v={lo,hi};bf16x2_t b=__builtin_convertvector(v,bf16x2_t);return __builtin_bit_cast(unsigned,b);}
#define WAIT_BAR(N) asm volatile("s_waitcnt vmcnt(" #N ") lgkmcnt(0)\n\ts_barrier":::"memory")

__device__ __forceinline__ void qkt(f32x16&p0,f32x16&p1,const char*Kslot,const bf16x8*qr,const f32x16&negm,int r32,int hi){
  const char*kb=Kslot+hi*1024+r32*16;
  #pragma unroll
  for(int d0=0;d0<4;++d0){
    const bf16x8 b0=*reinterpret_cast<const bf16x8*>(kb+d0*2048);
    const bf16x8 b1=*reinterpret_cast<const bf16x8*>(kb+d0*2048+512);
    if(d0==0){p0=__builtin_amdgcn_mfma_f32_32x32x16_bf16(b0,qr[0],negm,0,0,0);p1=__builtin_amdgcn_mfma_f32_32x32x16_bf16(b1,qr[0],negm,0,0,0);}
    else{p0=__builtin_amdgcn_mfma_f32_32x32x16_bf16(b0,qr[d0],p0,0,0,0);p1=__builtin_amdgcn_mfma_f32_32x32x16_bf16(b1,qr[d0],p1,0,0,0);}}
}
typedef __attribute__((address_space(3))) const char* lds_cptr;
typedef short v4i16_t __attribute__((ext_vector_type(4)));
__device__ __forceinline__ void kload8(bf16x8*kf,lds_cptr kp){
  kf[0]=*(const __attribute__((address_space(3))) bf16x8*)(kp);      kf[1]=*(const __attribute__((address_space(3))) bf16x8*)(kp+512);
  kf[2]=*(const __attribute__((address_space(3))) bf16x8*)(kp+2048); kf[3]=*(const __attribute__((address_space(3))) bf16x8*)(kp+2560);
  kf[4]=*(const __attribute__((address_space(3))) bf16x8*)(kp+4096); kf[5]=*(const __attribute__((address_space(3))) bf16x8*)(kp+4608);
  kf[6]=*(const __attribute__((address_space(3))) bf16x8*)(kp+6144); kf[7]=*(const __attribute__((address_space(3))) bf16x8*)(kp+6656);
}
__device__ __forceinline__ void kload2(bf16x8*kf,lds_cptr kp,int j){ kf[2*j]=*(const __attribute__((address_space(3))) bf16x8*)(kp+j*2048); kf[2*j+1]=*(const __attribute__((address_space(3))) bf16x8*)(kp+j*2048+512); }
__device__ __forceinline__ s16x4 vtr(lds_cptr p){ return __builtin_bit_cast(s16x4,__builtin_amdgcn_ds_read_tr16_b64_v4i16((__attribute__((address_space(3))) v4i16_t*)p)); }
__device__ __forceinline__ float rowmax(const f32x16&p0,const f32x16&p1){
  float a=max3f(p0[0],p0[1],p1[0]),b=max3f(p0[2],p0[3],p1[1]);a=max3f(a,p1[2],p1[3]);
  #pragma unroll
  for(int r=4;r<16;r+=4){a=max3f(a,p0[r],p0[r+1]);b=max3f(b,p0[r+2],p0[r+3]);a=max3f(a,p1[r],p1[r+1]);b=max3f(b,p1[r+2],p1[r+3]);}
  const float m=max2f(a,b);
  auto rr=__builtin_amdgcn_permlane32_swap(__float_as_uint(m),__float_as_uint(m),false,false);
  return max2f(__uint_as_float(rr[0]),__uint_as_float(rr[1]));
}
__device__ __forceinline__ void pv(f32x16*o,int vb,bf16x8 pa0,bf16x8 pa1,bf16x8 pa2,bf16x8 pa3){
  #pragma unroll
  for(int d0=0;d0<2;++d0){s16x4 lo[4],hi[4];
    #pragma unroll
    for(int ks=0;ks<4;++ks){
      asm volatile("ds_read_b64_tr_b16 %0,%1 offset:%c2":"=&v"(lo[ks]):"v"(vb),"i"(d0*4096+ks*1024):"memory");
      asm volatile("ds_read_b64_tr_b16 %0,%1 offset:%c2":"=&v"(hi[ks]):"v"(vb),"i"(d0*4096+ks*1024+512):"memory");}
    asm volatile("s_waitcnt lgkmcnt(0)":::"memory");SBAR();
    #define PK(k) (bf16x8){lo[k][0],lo[k][1],lo[k][2],lo[k][3],hi[k][0],hi[k][1],hi[k][2],hi[k][3]}
    o[d0]=__builtin_amdgcn_mfma_f32_32x32x16_bf16(pa0,PK(0),o[d0],0,0,0);
    o[d0]=__builtin_amdgcn_mfma_f32_32x32x16_bf16(pa1,PK(1),o[d0],0,0,0);
    o[d0]=__builtin_amdgcn_mfma_f32_32x32x16_bf16(pa2,PK(2),o[d0],0,0,0);
    o[d0]=__builtin_amdgcn_mfma_f32_32x32x16_bf16(pa3,PK(3),o[d0],0,0,0);
    #undef PK
  }
}

#ifndef ATTN_STORE16
#define ATTN_STORE16(p,v) (*(u32x4*)(p)=(v))
#endif
template<int THRL> __device__ __forceinline__ void attn_unit(int b,int h,int qb,const bf16*Q,const bf16*__restrict__ K,const bf16*__restrict__ V,bf16*O,char*shm){
  int tid_=threadIdx.x; asm volatile("":"+v"(tid_)); const int tid=tid_,lane=tid&63,r32=lane&31,hi=lane>>5; const int wid=__builtin_amdgcn_readfirstlane(tid>>6);
  const long rowbase=(long)b*SEQ; const int q0=qb*QB;
  const bf16*Qw=Q+(rowbase+q0+wid*QBLK)*PQ+h*D;
  const bf16*Kh=K+rowbase*PQ+(h>>2)*D,*Vh=V+rowbase*PQ+(h>>2)*D;
  const unsigned lds0=(unsigned)(uintptr_t)shm;
  float*wsf=(float*)(shm+LDS_WS)+wid*64;
  const bf16*ksrc=Kh+(long)lane*PQ+wid*8;
  const bf16*vsrc=Vh+(long)(16*(wid&3)+(lane>>2))*PQ+(wid>>2)*32+(lane&3)*8;
  const unsigned kdst=lds0+LDS_K+wid*1024, vdst=lds0+LDS_V+wid*1024;
  #define DMA_K(t,slot) glds16(ksrc+(long)(t)*KVBLK*PQ,(unsigned)__builtin_amdgcn_readfirstlane(kdst+(slot)))
  #define DMA_V(t,slot) glds16(vsrc+(long)(t)*KVBLK*PQ,(unsigned)__builtin_amdgcn_readfirstlane(vdst+(slot)))
  const int vb0=(int)(lds0+LDS_V)+((lane>>4)&1)*32+(lane&3)*8+(4*hi+((lane&15)>>2))*64;
  const char*Kbase=shm+LDS_K; bf16x8 kf[8];
  const lds_cptr shm3=(lds_cptr)shm; const lds_cptr kp0=shm3+LDS_K+hi*1024+r32*16; const lds_cptr vp0=shm3+LDS_V+((lane>>4)&1)*32+(lane&3)*8+(4*hi+((lane&15)>>2))*64;
  constexpr int NT=SEQ/KVBLK;
  DMA_K(0,0);DMA_V(0,0);DMA_K(1,SLOTB);
  bf16x8 qr[4];
  #pragma unroll
  for(int d0=0;d0<4;++d0)qr[d0]=*reinterpret_cast<const bf16x8*>(&Qw[(long)r32*PQ+d0*16+hi*8]);
  float mhat=0.f,l_reg=0.f;f32x16 o[2];o[0]=f32x16{};o[1]=f32x16{};f32x16 negm=f32x16{};asm volatile("":"+v"(negm));
  #define CMASK(P0,P1,t) do{}while(0)
  bool resc=false;
  #define START(P0,P1) do{ const float rm=rowmax(P0,P1); resc=false; \
    { const float dl=rm; mhat=fadd_s(mhat,dl); \
      _Pragma("unroll") for(int r=0;r<16;++r){P0[r]=fsub_s(P0[r],dl);P1[r]=fsub_s(P1[r],dl);} \
      _Pragma("unroll") for(int r=0;r<16;++r)negm[r]=-mhat; asm volatile("":"+v"(negm)); } \
    _Pragma("unroll") for(int r=0;r<16;++r)P0[r]=__builtin_amdgcn_exp2f(P0[r]); }while(0)
  #define RESC() do{ if(resc){ asm volatile("s_waitcnt lgkmcnt(0)":::"memory"); \
      _Pragma("unroll") for(int d_=0;d_<2;++d_) _Pragma("unroll") for(int r=0;r<16;++r)o[d_][r]*=wsf[crow(r,hi)]; } }while(0)
  f32x16 pA0,pA1,pB0,pB1;
  int sl_prev=0,sl_cur=0,sl_next=SLOTB;
  #define ROT() do{sl_prev=sl_cur;sl_cur=sl_next;sl_next=(sl_next==(NSLOT-1)*SLOTB)?0:sl_next+SLOTB;}while(0)
  DMA_K(2,2*SLOTB);
  WAIT_BAR(3);
  qkt(pA0,pA1,Kbase,qr,negm,r32,hi);asm volatile("s_nop 15\n\ts_nop 7":"+v"(pA0),"+v"(pA1));CMASK(pA0,pA1,0);
  START(pA0,pA1);
  _Pragma("unroll") for(int r=0;r<16;++r)pA1[r]=__builtin_amdgcn_exp2f(pA1[r]);
  WAIT_BAR(0);
  DMA_K(3,0);DMA_V(1,SLOTB);
  ROT();
  kload8(kf,kp0+sl_cur);
  WAIT_BAR(2);
  s16x4 vlo[8],vhi[8]; u32x4 pw0,pw1,pw2,pw3;
  #define PKW(P,B) cvtpk_s(P[B],P[B+1])
  #define PAF(k) __builtin_bit_cast(bf16x8,pw##k)
  #define VFR(i) (bf16x8){vlo[i][0],vlo[i][1],vlo[i][2],vlo[i][3],vhi[i][0],vhi[i][1],vhi[i][2],vhi[i][3]}
  #define PIN(x) asm volatile("":"+v"(x))
  #define MX3(a,b,c) __builtin_fmaxf(__builtin_fmaxf((a),(b)),(c))
  #define GAPA(MF,A0,A1,A2,A3,W0,W1,PW) do{ MF; sacc+=A0; sacc+=A1; sacc+=A2; sacc+=A3; PIN(sacc); W0; W1; PIN(PW); SBAR(); }while(0)
  #define EX(v) __builtin_amdgcn_exp2f(v)
  #define GAPB(MF,X,B) do{ MF; X[B]=EX(X[B]); X[B+1]=EX(X[B+1]); X[B+2]=EX(X[B+2]); X[B+3]=EX(X[B+3]); PIN(X); SBAR(); }while(0)
  #define VRD(i) do{ vlo[i]=vtr(vp_+(((i)>>2)*4096+((i)&3)*1024)); vhi[i]=vtr(vp_+(((i)>>2)*4096+((i)&3)*1024+512)); }while(0)
  #define KRD(G,j) do{ if(G){ kload2(kf,kp0+sl_next,j); SBAR(); } }while(0)
  #define STEP(C0,C1,P0,P1,t,GK,GV,GL) do{ SBAR(); \
    const lds_cptr vp_=vp0+sl_prev; \
    VRD(0); SBAR(); float sacc=(P0[0]+P0[1]); \
    GAPA(C0=__builtin_amdgcn_mfma_f32_32x32x16_bf16(kf[0],qr[0],negm,0,0,0), P0[2],P0[3],P0[4],P0[5],     pw0[0]=PKW(P0,0), pw0[1]=PKW(P0,2), pw0); \
    VRD(4); SBAR(); GAPA(C1=__builtin_amdgcn_mfma_f32_32x32x16_bf16(kf[1],qr[0],negm,0,0,0), P0[6],P0[7],P0[8],P0[9],     pw0[2]=PKW(P0,4), pw0[3]=PKW(P0,6), pw0); \
    VRD(1); SBAR(); GAPA(C0=__builtin_amdgcn_mfma_f32_32x32x16_bf16(kf[2],qr[1],C0,0,0,0),   P0[10],P0[11],P0[12],P0[13], pw1[0]=PKW(P0,8), pw1[1]=PKW(P0,10), pw1); \
    VRD(5); SBAR(); GAPA(C1=__builtin_amdgcn_mfma_f32_32x32x16_bf16(kf[3],qr[1],C1,0,0,0),   P0[14],P0[15],P1[0],P1[1],   pw1[2]=PKW(P0,12),pw1[3]=PKW(P0,14), pw1); \
    VRD(2); SBAR(); GAPA(C0=__builtin_amdgcn_mfma_f32_32x32x16_bf16(kf[4],qr[2],C0,0,0,0),   P1[2],P1[3],P1[4],P1[5],     pw2[0]=PKW(P1,0), pw2[1]=PKW(P1,2), pw2); \
    VRD(6); SBAR(); GAPA(C1=__builtin_amdgcn_mfma_f32_32x32x16_bf16(kf[5],qr[2],C1,0,0,0),   P1[6],P1[7],P1[8],P1[9],     pw2[2]=PKW(P1,4), pw2[3]=PKW(P1,6), pw2); \
    VRD(3); SBAR(); GAPA(C0=__builtin_amdgcn_mfma_f32_32x32x16_bf16(kf[6],qr[3],C0,0,0,0),   P1[10],P1[11],P1[12],P1[13], pw3[0]=PKW(P1,8), pw3[1]=PKW(P1,10), pw3); \
    VRD(7); SBAR(); GAPA(C1=__builtin_amdgcn_mfma_f32_32x32x16_bf16(kf[7],qr[3],C1,0,0,0),   P1[14],P1[15],0.f,0.f,       pw3[2]=PKW(P1,12),pw3[3]=PKW(P1,14), pw3); \
    l_reg+=sacc; \
    if(GK){DMA_K((t)+3,sl_cur);} if(GV){DMA_V((t)+1,sl_next);} \
    CMASK(C0,C1,t); \
    { float a=MX3(C0[0],C0[1],C1[0]),b=MX3(C0[2],C0[3],C1[1]); a=MX3(a,C1[2],C1[3]); \
      _Pragma("unroll") for(int r=4;r<16;r+=4){a=MX3(a,C0[r],C0[r+1]);b=MX3(b,C0[r+2],C0[r+3]);a=MX3(a,C1[r],C1[r+1]);b=MX3(b,C1[r+2],C1[r+3]);} \
      float rm=__builtin_fmaxf(a,b); { auto rr=__builtin_amdgcn_permlane32_swap(__float_as_uint(rm),__float_as_uint(rm),false,false); rm=__builtin_fmaxf(__uint_as_float(rr[0]),__uint_as_float(rr[1])); } \
      resc=false; \
      if(__builtin_expect(__any(rm>(float)THRL),0)){ const float dl=__builtin_fmaxf(rm,0.f); mhat+=dl; \
        _Pragma("unroll") for(int r=0;r<16;++r){C0[r]-=dl;C1[r]-=dl;} \
        _Pragma("unroll") for(int r=0;r<16;++r)negm[r]=-mhat; asm volatile("":"+v"(negm)); \
        const float f=__builtin_amdgcn_exp2f(-dl); l_reg*=f; if(hi==0)wsf[r32]=f; resc=true; } } \
    SBAR(); \
    GAPB(o[0]=__builtin_amdgcn_mfma_f32_32x32x16_bf16(PAF(0),VFR(0),o[0],0,0,0), C0,0); \
    GAPB(o[1]=__builtin_amdgcn_mfma_f32_32x32x16_bf16(PAF(0),VFR(4),o[1],0,0,0), C0,4); \
    KRD(GL,0); GAPB(o[0]=__builtin_amdgcn_mfma_f32_32x32x16_bf16(PAF(1),VFR(1),o[0],0,0,0), C0,8); \
    KRD(GL,1); GAPB(o[1]=__builtin_amdgcn_mfma_f32_32x32x16_bf16(PAF(1),VFR(5),o[1],0,0,0), C0,12); \
    KRD(GL,2); GAPB(o[0]=__builtin_amdgcn_mfma_f32_32x32x16_bf16(PAF(2),VFR(2),o[0],0,0,0), C1,0); \
    KRD(GL,3); GAPB(o[1]=__builtin_amdgcn_mfma_f32_32x32x16_bf16(PAF(2),VFR(6),o[1],0,0,0), C1,4); \
    GAPB(o[0]=__builtin_amdgcn_mfma_f32_32x32x16_bf16(PAF(3),VFR(3),o[0],0,0,0), C1,8); \
    GAPB(o[1]=__builtin_amdgcn_mfma_f32_32x32x16_bf16(PAF(3),VFR(7),o[1],0,0,0), C1,12); \
    }while(0)
  int t=1;
  #undef CMASK
  #define CMASK(P0,P1,t) do{}while(0)
  for(;t+5<NT;t+=2){
    STEP(pB0,pB1,pA0,pA1,t,true,true,true);     WAIT_BAR(2); RESC(); ROT();
    STEP(pA0,pA1,pB0,pB1,t+1,true,true,true);   WAIT_BAR(2); RESC(); ROT();
  }
  #undef CMASK
  #define CMASK(P0,P1,t) do{}while(0)
  #define ENDW(tt) do{ if((tt)+3<NT){WAIT_BAR(2);} else if((tt)+2<NT){WAIT_BAR(1);} else {WAIT_BAR(0);} }while(0)
  for(;t+1<NT;t+=2){
    STEP(pB0,pB1,pA0,pA1,t,(t+3<NT),(t+1<NT),(t+1<NT));       ENDW(t);   RESC(); ROT();
    STEP(pA0,pA1,pB0,pB1,t+1,(t+4<NT),(t+2<NT),(t+2<NT));     ENDW(t+1); RESC(); ROT();
  }
  STEP(pB0,pB1,pA0,pA1,NT-1,false,false,false); RESC();
  { float sacc=pB0[0]+pB0[1]; _Pragma("unroll") for(int r=2;r<16;++r)sacc+=pB0[r]; _Pragma("unroll") for(int r=0;r<16;++r)sacc+=pB1[r]; l_reg+=sacc;
    pw0=(u32x4){PKW(pB0,0),PKW(pB0,2),PKW(pB0,4),PKW(pB0,6)};pw1=(u32x4){PKW(pB0,8),PKW(pB0,10),PKW(pB0,12),PKW(pB0,14)};pw2=(u32x4){PKW(pB1,0),PKW(pB1,2),PKW(pB1,4),PKW(pB1,6)};pw3=(u32x4){PKW(pB1,8),PKW(pB1,10),PKW(pB1,12),PKW(pB1,14)};
    SBAR(); pv(o,vb0+sl_cur,PAF(0),PAF(1),PAF(2),PAF(3)); }
  #undef PKW
  #undef PAF
  #undef VFR
  #undef PIN
  #undef MX3
  #undef GAPA
  #undef GAPB
  #undef EX
  #undef VRD
  #undef KRD
  #undef STEP
  #undef ENDW
  {auto rr=__builtin_amdgcn_permlane32_swap(__float_as_uint(l_reg),__float_as_uint(l_reg),false,false);l_reg=__uint_as_float(rr[0])+__uint_as_float(rr[1]);}
  if(hi==0)wsf[32+r32]=l_reg;asm volatile("s_waitcnt lgkmcnt(0)":::"memory");
  float rli[16];
  #pragma unroll
  for(int r=0;r<16;++r)rli[r]=__builtin_amdgcn_rcpf(wsf[32+crow(r,hi)]);
  bf16*Ow=O+(rowbase+q0+wid*QBLK)*PO+h*D;
  { bf16*stg=(bf16*)(shm+LDS_OST)+wid*2048;
    #pragma unroll
    for(int r=0;r<16;++r){const int orow=crow(r,hi);
      #pragma unroll
      for(int d0=0;d0<2;++d0)stg[orow*64+d0*32+r32]=__float2bfloat16(o[d0][r]*rli[r]);}
    asm volatile("s_waitcnt lgkmcnt(0)":::"memory");
    #pragma unroll
    for(int i=0;i<4;++i){const int row=i*8+(lane>>3),ch=lane&7; const u32x4 v=*(const u32x4*)(stg+row*64+ch*8); ATTN_STORE16(Ow+(long)row*PO+ch*8,v);} }
  asm volatile("s_waitcnt lgkmcnt(0)\n\ts_barrier":::"memory");
  #undef DMA_K
  #undef DMA_V
  #undef CMASK
  #undef START
  #undef RESC
  #undef ROT
}
constexpr int ATTN_LDS_BYTES=LDS_BYTES;
struct AttnTensors { const bf16* Q; const bf16* K; const bf16* V; bf16* O; };
template<int THRL=8> __device__ __forceinline__ void attn_phase(char*lds,const AttnTensors&T,int vcu,int G){
  for(int L=vcu;L<BATCH*NHEAD*NQB;L+=G){
    const int pair=((L>>5)&7)*2+((L>>8)>>2), idx=(L&31)+32*((L>>8)&3);
    const int b=pair>>1, h=(pair&1)*4+(idx>>5), qb=idx&31;
    attn_unit<THRL>(b,h,qb,T.Q,T.K,T.V,T.O,lds);
  }
}
#undef SBAR
#undef WAIT_BAR
}
constexpr int NWAVES = 8;
constexpr int NTHR = NWAVES * 64;
constexpr int BATCH = 8, T = 8192, D = 1024, DEPTH = 2;
constexpr int M = BATCH * T;
constexpr int INW = 2816;
constexpr int C_QA = 0, C_KA = 512, C_VA = 640, C_QR = 768, C_KR = 1280, C_VR = 1792, C_GR = 2304;
constexpr int NE = 32, TOPK = 4, NASG = M * TOPK;
constexpr int XS_ROWS = NASG + NE * 256;
constexpr int RCH = 128, NCH = T / RCH, RH = 4;
constexpr int RUNITS = BATCH * RH * NCH;
constexpr float EPS = 1e-6f;
constexpr float LOG2E = 1.4426950408889634f;

constexpr size_t MiB = 1u << 20;
constexpr size_t WS_CTL = 0, CTL_ZERO_BYTES = 1 * MiB;
constexpr size_t WS_MOD = 512 * 1024;
constexpr size_t WS_WIN = 2 * MiB;
constexpr size_t WS_WOUT = 13 * MiB;
constexpr size_t WS_WUP = 17 * MiB;
constexpr size_t WS_WDN = 273 * MiB;
constexpr size_t WS_HM = 401 * MiB;
constexpr size_t WS_TOPI = 529 * MiB, WS_TOPW = 530 * MiB, WS_POS = 531 * MiB;
constexpr size_t WS_PROJ = 532 * MiB;
constexpr size_t WS_CAT = 884 * MiB;
constexpr size_t WS_YM = 1012 * MiB;
constexpr size_t WS_U = 1140 * MiB;
constexpr size_t WS_FT = 1396 * MiB;
constexpr size_t WS_XS = 532 * MiB;
constexpr size_t WS_ACT = 1060 * MiB;
constexpr size_t WS_END = 1588 * MiB;
static_assert(WS_MOD + (size_t)DEPTH * BATCH * 6 * D * 4 <= CTL_ZERO_BYTES, "mod inside the memset region");
static_assert(WS_XS + (size_t)XS_ROWS * 1024 * 2 <= WS_ACT && WS_ACT + (size_t)XS_ROWS * 1024 * 2 <= WS_END, "moe map");
static_assert(WS_PROJ + (size_t)M * INW * 2 <= WS_CAT && WS_FT + (size_t)RUNITS * 2 * 16384 * 2 <= WS_END, "mixer map");
constexpr int CW_TMO = 0, CW_CODE = 1;
constexpr int CW_BAR = 4096;
constexpr int CW_CNT = 8192;
constexpr int CW_CUR = 8192 + 256;

constexpr int RING_OFF = 0, RING_BYTES = 131072;
constexpr int LDSCTL_OFF = RING_BYTES;
constexpr int LCNT_OFF = LDSCTL_OFF, LTS_OFF = LDSCTL_OFF + 128, MISC_OFF = LDSCTL_OFF + 320;
constexpr int LDS_BYTES = 147456;
#define GAS __attribute__((address_space(1)))
#define LAS __attribute__((address_space(3)))
typedef unsigned short bf16;
typedef unsigned v4u __attribute__((ext_vector_type(4)));
typedef float f32x4 __attribute__((ext_vector_type(4)));
typedef short bf16x8 __attribute__((ext_vector_type(8)));
typedef GAS unsigned gu32;
typedef GAS unsigned long long gu64;
#define RLX_AGENT __ATOMIC_RELAXED, __HIP_MEMORY_SCOPE_AGENT
#define LDS_WAIT() asm volatile("s_waitcnt lgkmcnt(0)" ::: "memory")
#define VM_WAIT() asm volatile("s_waitcnt vmcnt(0)" ::: "memory")
__device__ __forceinline__ unsigned long long rt() { return __builtin_amdgcn_s_memrealtime(); }
__device__ __forceinline__ unsigned f2bf(float f) { unsigned u = __builtin_bit_cast(unsigned, f); return (u + 0x7fffu + ((u >> 16) & 1u)) >> 16; }
__device__ __forceinline__ unsigned pk2(float lo, float hi) { return f2bf(lo) | (f2bf(hi) << 16); }

#define XB_TMO      128
#define XB_XCNT(j)  (256  + 64 * (j))
#define XB_XSUB(j)  (1280 + 64 * (j))
#define XB_XGEN(j)  (2304 + 64 * (j))
#define XB_TOP      3328
#define XB_TOPGEN   3392
#define XCD_BAR_WORDS 3456
#define XB_SPIN_CAP (1u << 18)

__device__ __forceinline__ unsigned xb_ld(unsigned* p)              { return __hip_atomic_load(p, __ATOMIC_RELAXED, __HIP_MEMORY_SCOPE_AGENT); }
__device__ __forceinline__ unsigned xb_add(unsigned* p, unsigned v) { return __hip_atomic_fetch_add(p, v, __ATOMIC_RELAXED, __HIP_MEMORY_SCOPE_AGENT); }
__device__ __forceinline__ unsigned xb_xcc_id() { return (unsigned)__builtin_amdgcn_s_getreg((3 << 11) | 20) & 0xFu; }
#define XB_SPIN(cond, bar) do { unsigned _sp = 0; while (cond) { __builtin_amdgcn_s_sleep(1); \
    if ((++_sp & 255u) == 0u) { if (xb_ld(&(bar)[XB_TMO])) break; if (_sp > XB_SPIN_CAP) { atomicAdd(&(bar)[XB_TMO], 1u); break; } } } } while (0)

struct XcdBarrier {
    unsigned* bar; unsigned x;
    volatile LAS unsigned* st;
};

__device__ __forceinline__ XcdBarrier xcd_barrier_post(unsigned* bar, volatile LAS unsigned* st) {
    XcdBarrier b; b.bar = bar; b.x = xb_xcc_id(); b.st = st;
    if (threadIdx.x == 0) (void)xb_add(&bar[XB_XCNT(b.x)], 1u);
    return b;
}
__device__ __forceinline__ void xcd_barrier_complete(unsigned* bar, unsigned x, unsigned& nloc, unsigned& nx) {
    const unsigned G = gridDim.x * gridDim.y * gridDim.z;
    unsigned sum, cnt, mine, sp = 0u;
    for (;;) {
        sum = 0u; cnt = 0u; mine = 0u;
#pragma unroll
        for (unsigned j = 0; j < 16; ++j) { const unsigned c = xb_ld(&bar[XB_XCNT(j)]); sum += c; cnt += (c > 0u) ? 1u : 0u; mine = (j == x) ? c : mine; }
        if (sum == G) break;
        __builtin_amdgcn_s_sleep(1);
        if ((++sp & 255u) == 0u) { if (xb_ld(&bar[XB_TMO])) break; if (sp > XB_SPIN_CAP) { atomicAdd(&bar[XB_TMO], 1u); break; } }
    }
    nloc = mine > 0u ? mine : 1u; nx = cnt > 0u ? cnt : 1u;
}

__device__ __forceinline__ void xcd_barrier(const XcdBarrier& b) {
    asm volatile("s_waitcnt vmcnt(0)" ::: "memory");
    __syncthreads();
    if (threadIdx.x == 0) {
        unsigned* bar = b.bar;
        __builtin_amdgcn_s_waitcnt(0);
        unsigned nloc = b.st[0], nx = b.st[1];
        if (nloc == 0u) { xcd_barrier_complete(bar, b.x, nloc, nx); b.st[0] = nloc; b.st[1] = nx; }
        const unsigned old = xb_add(&bar[XB_XSUB(b.x)], 1u);
        const unsigned gen = old / nloc;
        if (old + 1u == (gen + 1u) * nloc) {
            __builtin_amdgcn_fence(__ATOMIC_RELEASE, "agent");
            asm volatile("s_waitcnt vmcnt(0)" ::: "memory");
            const unsigned og = xb_add(&bar[XB_TOP], 1u);
            const unsigned tg = og / nx;
            if (og + 1u == (tg + 1u) * nx) xb_add(&bar[XB_TOPGEN], 1u);
            else XB_SPIN(xb_ld(&bar[XB_TOPGEN]) == tg, bar);
            __builtin_amdgcn_fence(__ATOMIC_ACQUIRE, "agent");
            xb_add(&bar[XB_XGEN(b.x)], 1u);
            asm volatile("s_waitcnt vmcnt(0)" ::: "memory");
        } else {
            XB_SPIN(xb_ld(&bar[XB_XGEN(b.x)]) == gen, bar);
            __builtin_amdgcn_fence(__ATOMIC_ACQUIRE, "agent");
            asm volatile("s_waitcnt vmcnt(0)" ::: "memory");
        }
    }
    __syncthreads();
}

typedef unsigned u32x2 __attribute__((ext_vector_type(2)));
typedef short s16x4 __attribute__((ext_vector_type(4)));
typedef float f32x16 __attribute__((ext_vector_type(16)));
typedef int i32x4 __attribute__((ext_vector_type(4)));
struct Frame {
    LAS unsigned char* lds;
    volatile LAS unsigned* MISC;
    gu32* ctl;
    int tid, lane, wave, vcu, G;
};
__device__ __forceinline__ float wave_sum(float v) {
#pragma unroll
    for (int o = 1; o < 64; o <<= 1) v += __shfl_xor(v, o);
    return v;
}
__device__ __forceinline__ float bflo(unsigned w) { return __uint_as_float(w << 16); }
__device__ __forceinline__ float bfhi(unsigned w) { return __uint_as_float(w & 0xffff0000u); }
__device__ __forceinline__ unsigned pkbf(float lo, float hi) { return pg8::cvt_pk_bf16(lo, hi); }
__device__ __forceinline__ float fexp2(float x) { return __builtin_amdgcn_exp2f(x); }
__device__ __forceinline__ float frsq(float x) { return __builtin_amdgcn_rsqf(x); }
__device__ __forceinline__ float frcp(float x) { return __builtin_amdgcn_rcpf(x); }
__device__ __forceinline__ float row_rstd(const f32x4 (&v)[4]) {
    float s = 0.f;
#pragma unroll
    for (int j = 0; j < 4; ++j) s += (v[j].x * v[j].x + v[j].y * v[j].y) + (v[j].z * v[j].z + v[j].w * v[j].w);
    return frsq(wave_sum(s) * (1.f / D) + EPS);
}
__device__ __forceinline__ void store_row_bf16(bf16* orow, const f32x4 (&v)[4], int lane) {
    u32x2* o8 = (u32x2*)orow + lane;
#pragma unroll
    for (int j = 0; j < 4; ++j) { u32x2 w; w.x = pkbf(v[j].x, v[j].y); w.y = pkbf(v[j].z, v[j].w); o8[64 * j] = w; }
}
__device__ __forceinline__ void load_row_f32(const float* xrow, f32x4 (&v)[4], int lane) {
    const f32x4* xr = (const f32x4*)xrow + lane;
#pragma unroll
    for (int j = 0; j < 4; ++j) v[j] = xr[64 * j];
}
__device__ __forceinline__ void modnorm_row(const f32x4 (&x)[4], f32x4 (&h)[4], const float* g, const float* sc, const float* sh, int lane) {
    const float rs = row_rstd(x);
#pragma unroll
    for (int j = 0; j < 4; ++j) { const f32x4 gv = ((const f32x4*)g)[lane + 64 * j], scv = ((const f32x4*)sc)[lane + 64 * j], shv = ((const f32x4*)sh)[lane + 64 * j];
        h[j] = x[j] * rs * gv * (scv + 1.0f) + shv; }
}

__device__ __forceinline__ void p0_transpose_item(const float* W, int K, int N, bf16* WT, int row_off, LAS float* scr, int item, int lane) {
    const int nblk = N / 32, kb = item / nblk, nb = item % nblk, k0 = 64 * kb, n0 = 32 * nb;
#pragma unroll 8
    for (int i = 0; i < 32; ++i) { const int kk = 2 * i + (lane >> 5); scr[kk * 33 + (lane & 31)] = W[(size_t)(k0 + kk) * N + n0 + (lane & 31)]; }
    LDS_WAIT(); asm volatile("" ::: "memory");
    const int c = lane & 7;
#pragma unroll
    for (int j = 0; j < 4; ++j) { const int n = (lane >> 3) + 8 * j; const LAS float* s = scr + (8 * c) * 33 + n;
        v4u o; o.x = pkbf(s[0 * 33], s[1 * 33]); o.y = pkbf(s[2 * 33], s[3 * 33]); o.z = pkbf(s[4 * 33], s[5 * 33]); o.w = pkbf(s[6 * 33], s[7 * 33]);
        *(v4u*)(WT + (size_t)(row_off + n0 + n) * K + k0 + 8 * c) = o; }
    LDS_WAIT(); asm volatile("" ::: "memory");
}
__device__ __forceinline__ void p0_prologue(Frame& F, const float* c_in, const float* ada_w, const float* ada_b, float* mod,
                                            const float* w_in, const float* w_out, const float* w_up, const float* w_dn,
                                            bf16* Win_t, bf16* Wout_t, bf16* Wup_t, bf16* Wdn_t) {
    const int gw = F.vcu * NWAVES + F.wave, NGW = F.G * NWAVES;
    LAS float* cond = (LAS float*)F.lds;
    for (int i = F.tid; i < BATCH * D; i += NTHR) { const float v = c_in[i]; cond[i] = v * frcp(1.0f + __expf(-v)); }
    __syncthreads();
    LAS float* part = (LAS float*)(F.lds + 32768);
    for (int bt = blockIdx.x; bt < DEPTH * 96; bt += F.G) {
        const int l = bt / 96, chunk = bt % 96, ks = F.wave, col = chunk * 64 + F.lane;
        float acc[BATCH];
#pragma unroll
        for (int b = 0; b < BATCH; ++b) acc[b] = 0.f;
        const float* w = ada_w + ((size_t)l * D + ks * 128) * (6 * D) + col;
#pragma unroll 8
        for (int k = 0; k < 128; ++k) { const float wv = w[(size_t)k * (6 * D)];
#pragma unroll
            for (int b = 0; b < BATCH; ++b) acc[b] += cond[b * D + ks * 128 + k] * wv; }
#pragma unroll
        for (int b = 0; b < BATCH; ++b) part[(ks * BATCH + b) * 64 + F.lane] = acc[b];
        __syncthreads();
        { const int b = F.wave; float sum = ada_b[l * 6 * D + col];
#pragma unroll
          for (int k2 = 0; k2 < 8; ++k2) sum += part[(k2 * BATCH + b) * 64 + F.lane];
          mod[((size_t)l * BATCH + b) * (6 * D) + col] = sum; }
        __syncthreads();
    }
    LAS float* scr = (LAS float*)(F.lds + F.wave * 16384);
    constexpr int I_IN = 16 * 88, I_OUT = 16 * 32, I_UP = 16 * 64, I_DN = 16 * 32;
    constexpr int NITEMS = DEPTH * I_IN + DEPTH * I_OUT + DEPTH * NE * I_UP + DEPTH * NE * I_DN;
    for (int it = gw; it < NITEMS; it += NGW) {
        int r = it;
        if (r < DEPTH * I_IN) { const int l = r / I_IN; p0_transpose_item(w_in + (size_t)l * D * INW, D, INW, Win_t + (size_t)l * INW * D, 0, scr, r % I_IN, F.lane); continue; } r -= DEPTH * I_IN;
        if (r < DEPTH * I_OUT) { const int l = r / I_OUT; p0_transpose_item(w_out + (size_t)l * D * D, D, D, Wout_t + (size_t)l * D * D, 0, scr, r % I_OUT, F.lane); continue; } r -= DEPTH * I_OUT;
        if (r < DEPTH * NE * I_UP) { const int le = r / I_UP, item = r % I_UP, n0 = 32 * (item % 64);
            const int dest = (n0 < 1024) ? (256 * (n0 >> 7) + (n0 & 127)) : (256 * ((n0 - 1024) >> 7) + 128 + ((n0 - 1024) & 127));
            p0_transpose_item(w_up + (size_t)le * D * 2048, D, 2048, Wup_t + (size_t)le * 2048 * D, dest - n0, scr, item, F.lane); continue; } r -= DEPTH * NE * I_UP;
        { const int le = r / I_DN; p0_transpose_item(w_dn + (size_t)le * D * D, D, D, Wdn_t + (size_t)le * D * D, 0, scr, r % I_DN, F.lane); }
    }
}
__device__ __forceinline__ void p0b_premix(Frame& F, const float* x, bf16* HM, const float* g, const float* mod_l) {
    const int gw = F.vcu * NWAVES + F.wave, NGW = F.G * NWAVES;
    for (int m = gw; m < M; m += NGW) {
        const float* modb = mod_l + (size_t)(m >> 13) * (6 * D);
        f32x4 v[4], h[4]; load_row_f32(x + (size_t)m * D, v, F.lane);
        modnorm_row(v, h, g, modb + D, modb, F.lane);
        store_row_bf16(HM + (size_t)m * D, h, F.lane);
    }
}

__device__ __forceinline__ void rope4(float (&y)[4][2], const float (&cr)[2], const float (&sr)[2], const float (&cc)[2], const float (&sc)[2], float scale, unsigned (&w)[4]) {
    float o[4][2];
#pragma unroll
    for (int e = 0; e < 2; ++e) { o[0][e] = y[0][e] * cr[e] - y[1][e] * sr[e]; o[1][e] = y[1][e] * cr[e] + y[0][e] * sr[e];
                                  o[2][e] = y[2][e] * cc[e] - y[3][e] * sc[e]; o[3][e] = y[3][e] * cc[e] + y[2][e] * sc[e]; }
#pragma unroll
    for (int q = 0; q < 4; ++q) w[q] = pkbf(o[q][0] * scale, o[q][1] * scale);
}
__device__ __forceinline__ void p1b_rope(Frame& F, bf16* PROJ, const float* qg, const float* kg) {
    const int lane = F.lane, gw = F.vcu * NWAVES + F.wave, NGW = F.G * NWAVES;
    const int ja = lane & 7, jr = lane & 15;
    constexpr float L2T = 13.287712379549449f;
    float fa[2], fr[2], gq[4][2], gk[4][2];
#pragma unroll
    for (int e = 0; e < 2; ++e) { fa[e] = fexp2(-(float)(2 * ja + e) * (L2T / 16.f)); fr[e] = fexp2(-(float)(2 * jr + e) * (L2T / 32.f)); }
#pragma unroll
    for (int q = 0; q < 4; ++q)
#pragma unroll
        for (int e = 0; e < 2; ++e) { gq[q][e] = qg[q * 16 + 2 * ja + e]; gk[q][e] = kg[q * 16 + 2 * ja + e]; }
    for (int m = gw; m < M; m += NGW) {
        const int s = m & (T - 1); const float rid = (float)(s >> 6), cid = (float)(s & 63);
        float cra[2], sra[2], cca[2], sca[2], crr[2], srr[2], ccr[2], scr2[2];
#pragma unroll
        for (int e = 0; e < 2; ++e) { cra[e] = __cosf(rid * fa[e]); sra[e] = __sinf(rid * fa[e]); cca[e] = __cosf(cid * fa[e]); sca[e] = __sinf(cid * fa[e]);
                                      crr[e] = __cosf(rid * fr[e]); srr[e] = __sinf(rid * fr[e]); ccr[e] = __cosf(cid * fr[e]); scr2[e] = __sinf(cid * fr[e]); }
        bf16* row = PROJ + (size_t)m * INW;
        {
            unsigned* p = (unsigned*)(row + C_QA + (lane >> 3) * 64 + 2 * ja); unsigned w[4]; float y[4][2]; float ss = 0.f;
#pragma unroll
            for (int q = 0; q < 4; ++q) { w[q] = p[q * 8]; y[q][0] = bflo(w[q]); y[q][1] = bfhi(w[q]); ss += y[q][0] * y[q][0] + y[q][1] * y[q][1]; }
            ss += __shfl_xor(ss, 1); ss += __shfl_xor(ss, 2); ss += __shfl_xor(ss, 4);
            const float rs = frsq(ss * (1.f / 64.f) + EPS);
#pragma unroll
            for (int q = 0; q < 4; ++q) { y[q][0] *= rs * gq[q][0]; y[q][1] *= rs * gq[q][1]; }
            rope4(y, cra, sra, cca, sca, attn_body::C2, w);
#pragma unroll
            for (int q = 0; q < 4; ++q) p[q * 8] = w[q];
        }
        {
            const int hk = (lane >> 3) & 1;
            unsigned* p = (unsigned*)(row + C_KA + hk * 64 + 2 * ja); unsigned w[4]; float y[4][2]; float ss = 0.f;
#pragma unroll
            for (int q = 0; q < 4; ++q) { w[q] = p[q * 8]; y[q][0] = bflo(w[q]); y[q][1] = bfhi(w[q]); ss += y[q][0] * y[q][0] + y[q][1] * y[q][1]; }
            ss += __shfl_xor(ss, 1); ss += __shfl_xor(ss, 2); ss += __shfl_xor(ss, 4);
            const float rs = frsq(ss * (1.f / 64.f) + EPS);
#pragma unroll
            for (int q = 0; q < 4; ++q) { y[q][0] *= rs * gk[q][0]; y[q][1] *= rs * gk[q][1]; }
            rope4(y, cra, sra, cca, sca, 1.0f, w);
            if (lane < 16) {
#pragma unroll
                for (int q = 0; q < 4; ++q) p[q * 8] = w[q]; }
        }
#pragma unroll
        for (int which = 0; which < 2; ++which) {
            unsigned* p = (unsigned*)(row + (which ? C_KR : C_QR) + (lane >> 4) * 128 + 2 * jr); unsigned w[4]; float y[4][2];
#pragma unroll
            for (int q = 0; q < 4; ++q) { w[q] = p[q * 16]; y[q][0] = bflo(w[q]); y[q][1] = bfhi(w[q]); }
            rope4(y, crr, srr, ccr, scr2, which ? 0.08838834764831845f : 1.0f, w);
#pragma unroll
            for (int q = 0; q < 4; ++q) p[q * 16] = w[q];
        }
    }
}

__device__ __forceinline__ unsigned off_b(unsigned row, unsigned ch) { return 256u * row + 16u * (ch ^ (((row & 3) << 2) | ((row >> 2) & 3))); }
__device__ __forceinline__ bf16x8 rowread(const LAS unsigned char* tb, int rb, int s, int lane) {
    return *(const LAS bf16x8*)(tb + off_b(32 * rb + (lane & 31), 2 * s + (lane >> 5)));
}
__device__ __forceinline__ bf16x8 trread(const LAS unsigned char* tb, int c, int ks, int lane) {
    const unsigned h = lane >> 5, blk = (lane >> 4) & 1, q = (lane & 15) >> 2, p = lane & 3;
    const unsigned r0 = 16 * ks + 8 * h + q, ch = 4 * c + 2 * blk + (p >> 1);
    const s16x4 lo = __builtin_amdgcn_ds_read_tr16_b64_v4i16((LAS s16x4*)(tb + off_b(r0, ch) + 8 * (p & 1)));
    const s16x4 hi = __builtin_amdgcn_ds_read_tr16_b64_v4i16((LAS s16x4*)(tb + off_b(r0 + 4, ch) + 8 * (p & 1)));
    return (bf16x8){lo[0], lo[1], lo[2], lo[3], hi[0], hi[1], hi[2], hi[3]};
}
__device__ __forceinline__ int crow(int r, int hi) { return (r & 3) + 8 * (r >> 2) + 4 * hi; }
template <int MODE> __device__ __forceinline__ void stage_tile(LAS unsigned char* tb, const bf16* src, int pitch, int tid, float lg) {
#pragma unroll
    for (int i = 0; i < 4; ++i) { const int n = tid + NTHR * i, row = n >> 4, ch = n & 15;
        v4u v = *(const v4u*)(src + (size_t)row * pitch + ch * 8);
        if (MODE != 0) { const float f = fexp2((MODE == 1 ? (float)(127 - row) : (float)row) * lg);
            v.x = pkbf(bflo(v.x) * f, bfhi(v.x) * f); v.y = pkbf(bflo(v.y) * f, bfhi(v.y) * f); v.z = pkbf(bflo(v.z) * f, bfhi(v.z) * f); v.w = pkbf(bflo(v.w) * f, bfhi(v.w) * f); }
        *(LAS v4u*)(tb + off_b(row, ch)) = v; }
}
__device__ __forceinline__ void r1_states(Frame& F, const bf16* PROJ, float* U, const float* dec_f, const float* dec_b) {
    LAS unsigned char* TKf = F.lds, *TKb = F.lds + 32768, *TV = F.lds + 65536;
    const int lane = F.lane, w = F.wave, hi = lane >> 5, mb = w & 3, nb0 = 2 * (w >> 2);
    for (int u = F.vcu; u < RUNITS; u += F.G) {
        const int b = u >> 8, h = (u >> 6) & 3, c = u & 63;
        const float lgf = dec_f[h] * LOG2E, lgb = dec_b[h] * LOG2E;
        const bf16* base = PROJ + ((size_t)b * T + (size_t)c * RCH) * INW + h * 128;
        stage_tile<1>(TKf, base + C_KR, INW, F.tid, lgf);
        stage_tile<2>(TKb, base + C_KR, INW, F.tid, lgb);
        stage_tile<0>(TV, base + C_VR, INW, F.tid, 0.f);
        __syncthreads();
        f32x16 acc[2][2];
#pragma unroll
        for (int d = 0; d < 2; ++d)
#pragma unroll
            for (int n = 0; n < 2; ++n) acc[d][n] = (f32x16){};
#pragma unroll 2
        for (int ks = 0; ks < 8; ++ks) {
            const bf16x8 a = trread(TV, mb, ks, lane);
#pragma unroll
            for (int n = 0; n < 2; ++n) { const bf16x8 bf = trread(TKf, nb0 + n, ks, lane), bb = trread(TKb, nb0 + n, ks, lane);
                acc[0][n] = __builtin_amdgcn_mfma_f32_32x32x16_bf16(a, bf, acc[0][n], 0, 0, 0);
                acc[1][n] = __builtin_amdgcn_mfma_f32_32x32x16_bf16(a, bb, acc[1][n], 0, 0, 0); }
        }
#pragma unroll
        for (int d = 0; d < 2; ++d)
#pragma unroll
            for (int n = 0; n < 2; ++n) { float* o = U + ((size_t)u * 2 + d) * 16384 + 32 * (nb0 + n) + (lane & 31);
#pragma unroll
                for (int r = 0; r < 16; ++r) o[(32 * mb + crow(r, hi)) * 128] = acc[d][n][r]; }
        __syncthreads();
    }
}
__device__ __forceinline__ void r2_scan(Frame& F, const float* U, bf16* FT, const float* dec_f, const float* dec_b) {
    for (int task = blockIdx.x * NTHR + F.tid; task < BATCH * RH * 4096; task += F.G * NTHR) {
        const int bh = task >> 12, e4 = task & 4095, h = bh & 3;
        const float df = __expf(dec_f[h] * 128.f), db = __expf(dec_b[h] * 128.f);
        f32x4 s = (f32x4){0.f, 0.f, 0.f, 0.f};
#pragma unroll 8
        for (int c = 0; c < NCH; ++c) { const size_t idx = (((size_t)bh * NCH + c) * 2 + 0) * 16384 + 4 * e4;
            u32x2 w; w.x = pkbf(s.x, s.y); w.y = pkbf(s.z, s.w); *(u32x2*)(FT + idx) = w;
            s = s * df + *(const f32x4*)(U + idx); }
        s = (f32x4){0.f, 0.f, 0.f, 0.f};
#pragma unroll 8
        for (int c = NCH - 1; c >= 0; --c) { const size_t idx = (((size_t)bh * NCH + c) * 2 + 1) * 16384 + 4 * e4;
            u32x2 w; w.x = pkbf(s.x, s.y); w.y = pkbf(s.z, s.w); *(u32x2*)(FT + idx) = w;
            s = s * db + *(const f32x4*)(U + idx); }
    }
}
__device__ __forceinline__ void r3_out(Frame& F, const bf16* PROJ, const bf16* FT, bf16* CAT, const float* dec_f, const float* dec_b, const float* gn_g, const float* gn_b) {
    LAS unsigned char* TQ = F.lds, *TK = F.lds + 32768, *TV = F.lds + 65536, *TP = F.lds + 98304;
    LAS float* OT = (LAS float*)F.lds;
    const int lane = F.lane, w = F.wave, hi = lane >> 5, l31 = lane & 31, wb = w & 3, wp0 = 2 * (w >> 2);
    for (int u = F.vcu; u < RUNITS; u += F.G) {
        const int b = u >> 8, h = (u >> 6) & 3, c = u & 63;
        const float lgf = dec_f[h] * LOG2E, lgb = dec_b[h] * LOG2E;
        const size_t m0 = (size_t)b * T + (size_t)c * RCH;
        const bf16* base = PROJ + m0 * INW + h * 128;
        stage_tile<0>(TQ, base + C_QR, INW, F.tid, 0.f);
        stage_tile<0>(TK, base + C_KR, INW, F.tid, 0.f);
        stage_tile<0>(TV, base + C_VR, INW, F.tid, 0.f);
        __syncthreads();
        {
            f32x16 st[2]; st[0] = (f32x16){}; st[1] = (f32x16){};
#pragma unroll 1
            for (int s = 0; s < 8; ++s) { const bf16x8 a = rowread(TK, wb, s, lane);
#pragma unroll
                for (int n = 0; n < 2; ++n) st[n] = __builtin_amdgcn_mfma_f32_32x32x16_bf16(a, rowread(TQ, wp0 + n, s, lane), st[n], 0, 0, 0); }
#pragma unroll
            for (int n = 0; n < 2; ++n) { const int i = 32 * (wp0 + n) + l31;
#pragma unroll
                for (int g = 0; g < 4; ++g) { float p[4];
#pragma unroll
                    for (int q = 0; q < 4; ++q) { const int j = 32 * wb + 8 * g + 4 * hi + q; const float fd = (float)(i - j);
                        const float mk = fexp2(fmaxf(fd, 0.f) * lgf + fmaxf(-fd, 0.f) * lgb) + fmaxf(1.0f - fabsf(fd), 0.f);
                        p[q] = st[n][4 * g + q] * mk; }
                    u32x2 pw; pw.x = pkbf(p[0], p[1]); pw.y = pkbf(p[2], p[3]);
                    *(LAS u32x2*)(TP + off_b(i, 4 * wb + g) + 8 * hi) = pw; } }
        }
        __syncthreads();
        f32x16 ao[2];
#pragma unroll
        for (int n = 0; n < 2; ++n) ao[n] = (f32x16){};
        {
            const bf16* ftf = FT + ((size_t)u * 2 + 0) * 16384 + (size_t)(32 * wp0 + l31) * 128 + 8 * hi;
            const bf16* ftb = ftf + 16384;
            const float xf = fexp2((float)(32 * wb + l31 + 1) * lgf), xb = fexp2((float)(128 - 32 * wb - l31) * lgb);
#pragma unroll 1
            for (int s = 0; s < 8; ++s) { const bf16x8 ap = rowread(TP, wb, s, lane); const v4u aq = *(const LAS v4u*)(TQ + off_b(32 * wb + l31, 2 * s + hi));
                v4u qf, qb;
                qf.x = pkbf(bflo(aq.x) * xf, bfhi(aq.x) * xf); qf.y = pkbf(bflo(aq.y) * xf, bfhi(aq.y) * xf); qf.z = pkbf(bflo(aq.z) * xf, bfhi(aq.z) * xf); qf.w = pkbf(bflo(aq.w) * xf, bfhi(aq.w) * xf);
                qb.x = pkbf(bflo(aq.x) * xb, bfhi(aq.x) * xb); qb.y = pkbf(bflo(aq.y) * xb, bfhi(aq.y) * xb); qb.z = pkbf(bflo(aq.z) * xb, bfhi(aq.z) * xb); qb.w = pkbf(bflo(aq.w) * xb, bfhi(aq.w) * xb);
                const bf16x8 aqf = __builtin_bit_cast(bf16x8, qf), aqb = __builtin_bit_cast(bf16x8, qb);
#pragma unroll
                for (int n = 0; n < 2; ++n) {
                    ao[n] = __builtin_amdgcn_mfma_f32_32x32x16_bf16(ap, trread(TV, wp0 + n, s, lane), ao[n], 0, 0, 0);
                    const bf16x8 bf = *(const bf16x8*)(ftf + n * 32 * 128 + 16 * s), bb = *(const bf16x8*)(ftb + n * 32 * 128 + 16 * s);
                    ao[n] = __builtin_amdgcn_mfma_f32_32x32x16_bf16(aqf, bf, ao[n], 0, 0, 0);
                    ao[n] = __builtin_amdgcn_mfma_f32_32x32x16_bf16(aqb, bb, ao[n], 0, 0, 0); } }
        }
        __syncthreads();
#pragma unroll
        for (int r = 0; r < 16; ++r) { const int i = 32 * wb + crow(r, hi);
#pragma unroll
            for (int n = 0; n < 2; ++n) OT[i * 132 + 32 * (wp0 + n) + l31] = ao[n][r]; }
        __syncthreads();
        {
            const int i = F.tid >> 2, qd = F.tid & 3;
            f32x4 v[8]; float s1 = 0.f, s2 = 0.f;
#pragma unroll
            for (int k = 0; k < 8; ++k) { v[k] = *(const LAS f32x4*)(OT + i * 132 + 32 * qd + 4 * k); s1 += (v[k].x + v[k].y) + (v[k].z + v[k].w);
                s2 += (v[k].x * v[k].x + v[k].y * v[k].y) + (v[k].z * v[k].z + v[k].w * v[k].w); }
            s1 += __shfl_xor(s1, 1); s1 += __shfl_xor(s1, 2); s2 += __shfl_xor(s2, 1); s2 += __shfl_xor(s2, 2);
            const float mu = s1 * (1.f / 128.f), var = fmaxf(s2 * (1.f / 128.f) - mu * mu, 0.f), rs = frsq(var + EPS);
            const int col = h * 128 + 32 * qd;
            const bf16* gp = PROJ + (m0 + i) * INW + C_GR + col; bf16* op = CAT + (m0 + i) * D + 512 + col;
#pragma unroll
            for (int k2 = 0; k2 < 4; ++k2) { const v4u gw4 = *(const v4u*)(gp + 8 * k2); const unsigned gwv[4] = {gw4.x, gw4.y, gw4.z, gw4.w}; float o[8];
#pragma unroll
                for (int q = 0; q < 8; ++q) { const int cc = 8 * k2 + q; const float x = v[cc >> 2][cc & 3];
                    const float y = (x - mu) * rs * gn_g[col + cc] + gn_b[col + cc];
                    const float gt = (q & 1) ? bfhi(gwv[q >> 1]) : bflo(gwv[q >> 1]);
                    o[q] = y * gt * frcp(1.0f + __expf(-gt)); }
                v4u ow; ow.x = pkbf(o[0], o[1]); ow.y = pkbf(o[2], o[3]); ow.z = pkbf(o[4], o[5]); ow.w = pkbf(o[6], o[7]);
                *(v4u*)(op + 8 * k2) = ow; }
        }
        __syncthreads();
    }
}

__device__ __forceinline__ void p3b_postmix(Frame& F, const float* xin, float* xout, const bf16* YM, bf16* HM, const float* mod_l,
                                            const float* post_g, const float* pre_g, const float* rw, const float* rb, int* topi, float* topw, gu32* cnt_g) {
    const int lane = F.lane, gw = F.vcu * NWAVES + F.wave, NGW = F.G * NWAVES;
    LAS f32x4* RW = (LAS f32x4*)F.lds;
    LAS unsigned* lcnt = (LAS unsigned*)(F.lds + LCNT_OFF);
#pragma unroll
    for (int i = 0; i < 16; ++i) { const int n = F.tid + NTHR * i, k = n >> 3, ec = n & 7; const f32x4 v = *(const f32x4*)(rw + (size_t)k * NE + ec * 4);
        RW[(((k >> 8) * 4 + (k & 3)) * 8 + ec) * 64 + ((k & 255) >> 2)] = v; }
    if (F.tid < 32) lcnt[F.tid] = 0u;
    __syncthreads();
    const float rbias = rb[lane & 31];
    for (int m = gw; m < M; m += NGW) {
        const float* modb = mod_l + (size_t)(m >> 13) * (6 * D);
        f32x4 y[4], x[4], hf[4];
        { const u32x2* yr = (const u32x2*)(YM + (size_t)m * D) + lane;
#pragma unroll
          for (int j = 0; j < 4; ++j) { const u32x2 w = yr[64 * j]; y[j] = (f32x4){bflo(w.x), bfhi(w.x), bflo(w.y), bfhi(w.y)}; } }
        load_row_f32(xin + (size_t)m * D, x, lane);
        const float rsy = row_rstd(y);
#pragma unroll
        for (int j = 0; j < 4; ++j) { const f32x4 pg = ((const f32x4*)post_g)[lane + 64 * j], gm = ((const f32x4*)(modb + 2 * D))[lane + 64 * j];
            x[j] = x[j] + gm * (y[j] * rsy * pg); ((f32x4*)(xout + (size_t)m * D))[lane + 64 * j] = x[j]; }
        modnorm_row(x, hf, pre_g, modb + 4 * D, modb + 3 * D, lane);
        store_row_bf16(HM + (size_t)m * D, hf, lane);
        float lg2[2];
#pragma unroll
        for (int half = 0; half < 2; ++half) {
            float acc[16];
#pragma unroll
            for (int e = 0; e < 16; ++e) acc[e] = 0.f;
#pragma unroll
            for (int j = 0; j < 4; ++j)
#pragma unroll
                for (int q = 0; q < 4; ++q) { const float hv = hf[j][q];
#pragma unroll
                    for (int ec = 0; ec < 4; ++ec) { const f32x4 wv = RW[((j * 4 + q) * 8 + 4 * half + ec) * 64 + lane];
                        acc[4 * ec + 0] += hv * wv.x; acc[4 * ec + 1] += hv * wv.y; acc[4 * ec + 2] += hv * wv.z; acc[4 * ec + 3] += hv * wv.w; } }
#define RS_STEP(H) { const bool up = (lane & (H)) != 0; _Pragma("unroll") for (int i = 0; i < (H); ++i) { const float send = up ? acc[i] : acc[i + (H)], keep = up ? acc[i + (H)] : acc[i]; acc[i] = keep + __shfl_xor(send, (H)); } }
            RS_STEP(8) RS_STEP(4) RS_STEP(2) RS_STEP(1)
#undef RS_STEP
            float v = acc[0]; v += __shfl_xor(v, 16); v += __shfl_xor(v, 32); lg2[half] = v;
        }
        const float logit = ((lane & 16) ? lg2[1] : lg2[0]) + rbias;
        bool taken = false; float tv[TOPK]; int ti[TOPK];
#pragma unroll
        for (int k = 0; k < TOPK; ++k) { float bv = taken ? -INFINITY : logit; int bi = lane & 31;
#define MX_STEP(o) { const float ov = __shfl_xor(bv, (o)); const int oi = __shfl_xor(bi, (o)); const bool tk = (ov > bv) || (ov == bv && oi < bi); bv = tk ? ov : bv; bi = tk ? oi : bi; }
            MX_STEP(16) MX_STEP(8) MX_STEP(4) MX_STEP(2) MX_STEP(1)
#undef MX_STEP
            tv[k] = bv; ti[k] = bi; if ((lane & 31) == bi) taken = true; }
        const float e1 = __expf(tv[1] - tv[0]), e2 = __expf(tv[2] - tv[0]), e3 = __expf(tv[3] - tv[0]), inv = frcp(1.0f + e1 + e2 + e3);
        if (lane == 0) { *(i32x4*)(topi + (size_t)m * 4) = (i32x4){ti[0], ti[1], ti[2], ti[3]}; *(f32x4*)(topw + (size_t)m * 4) = (f32x4){inv, e1 * inv, e2 * inv, e3 * inv}; }
        if (taken && lane < 32) atomicAdd((unsigned*)(lcnt + lane), 1u);
    }
    __syncthreads();
    if (F.tid < 32) { const unsigned c = lcnt[F.tid]; if (c) __hip_atomic_fetch_add(cnt_g + F.tid, c, RLX_AGENT); }
}
__device__ __forceinline__ void p4a_route(Frame& F, const bf16* HM, bf16* XS, const int* topi, int* pos, gu32* cnt_g, gu32* cur_g) {
    const int lane = F.lane, gw = F.vcu * NWAVES + F.wave, NGW = F.G * NWAVES;
    LAS int* ts = (LAS int*)(F.lds + LTS_OFF);
    if (F.tid == 0) { int a = 0; for (int e = 0; e < NE; ++e) { ts[e] = a; a += (int)((__hip_atomic_load(cnt_g + e, RLX_AGENT) + 255u) >> 8); } ts[NE] = a; }
    __syncthreads();
    for (int base = gw * 64; base < M; base += NGW * 64) {
        const int tok = base + lane; const i32x4 id = *(const i32x4*)(topi + (size_t)tok * 4);
        unsigned mycnt = 0u;
#pragma unroll 1
        for (int e = 0; e < NE; ++e) { const unsigned long long mk = __ballot(id.x == e || id.y == e || id.z == e || id.w == e); if (lane == e) mycnt = (unsigned)__popcll(mk); }
        unsigned mybase = 0u;
        if (lane < NE && mycnt) mybase = __hip_atomic_fetch_add(cur_g + lane, mycnt, RLX_AGENT);
        i32x4 ps = (i32x4){0, 0, 0, 0};
        const unsigned long long lt = (1ull << lane) - 1ull;
#pragma unroll 1
        for (int e = 0; e < NE; ++e) { const bool has = (id.x == e || id.y == e || id.z == e || id.w == e); const unsigned long long mk = __ballot(has);
            const int p = ts[e] * 256 + (int)__shfl(mybase, e) + (int)__popcll(mk & lt);
            if (id.x == e) ps.x = p; if (id.y == e) ps.y = p; if (id.z == e) ps.z = p; if (id.w == e) ps.w = p; }
        *(i32x4*)(pos + (size_t)tok * 4) = ps;
        for (int tt = 0; tt < 64; ++tt) {
            const v4u* src = (const v4u*)(HM + (size_t)(base + tt) * D); const v4u a = src[lane], b = src[64 + lane];
            const int p0 = __shfl(ps.x, tt), p1 = __shfl(ps.y, tt), p2 = __shfl(ps.z, tt), p3 = __shfl(ps.w, tt);
            v4u* d0 = (v4u*)(XS + (size_t)p0 * D); d0[lane] = a; d0[64 + lane] = b;
            v4u* d1 = (v4u*)(XS + (size_t)p1 * D); d1[lane] = a; d1[64 + lane] = b;
            v4u* d2 = (v4u*)(XS + (size_t)p2 * D); d2[lane] = a; d2[64 + lane] = b;
            v4u* d3 = (v4u*)(XS + (size_t)p3 * D); d3[lane] = a; d3[64 + lane] = b;
        }
    }
}
__device__ __forceinline__ void p5b_combine(Frame& F, float* xio, const bf16* Y, const int* pos, const float* topw, const float* mod_l, const float* post_g,
                                            bool has_next, const float* mod_n, const float* pre_g_n, bf16* HM) {
    const int lane = F.lane, gw = F.vcu * NWAVES + F.wave, NGW = F.G * NWAVES;
    for (int m = gw; m < M; m += NGW) {
        const float* modb = mod_l + (size_t)(m >> 13) * (6 * D);
        const i32x4 ps = *(const i32x4*)(pos + (size_t)m * 4); const f32x4 wt = *(const f32x4*)(topw + (size_t)m * 4);
        f32x4 y[4], x[4];
#pragma unroll
        for (int j = 0; j < 4; ++j) y[j] = (f32x4){0.f, 0.f, 0.f, 0.f};
#pragma unroll
        for (int k = 0; k < TOPK; ++k) { const u32x2* yr = (const u32x2*)(Y + (size_t)ps[k] * D) + lane; const float wk = wt[k];
#pragma unroll
            for (int j = 0; j < 4; ++j) { const u32x2 w = yr[64 * j]; y[j] += (f32x4){bflo(w.x), bfhi(w.x), bflo(w.y), bfhi(w.y)} * wk; } }
        load_row_f32(xio + (size_t)m * D, x, lane);
        const float rsy = row_rstd(y);
#pragma unroll
        for (int j = 0; j < 4; ++j) { const f32x4 pg = ((const f32x4*)post_g)[lane + 64 * j], gf = ((const f32x4*)(modb + 5 * D))[lane + 64 * j];
            x[j] = x[j] + gf * (y[j] * rsy * pg); ((f32x4*)(xio + (size_t)m * D))[lane + 64 * j] = x[j]; }
        if (has_next) { const float* modn = mod_n + (size_t)(m >> 13) * (6 * D); f32x4 h[4];
            modnorm_row(x, h, pre_g_n, modn + D, modn, lane);
            store_row_bf16(HM + (size_t)m * D, h, lane); }
    }
}

struct Args { const float* in[22]; float* out; unsigned char* ws; };
__global__ void __launch_bounds__(NTHR, 2) mk_fwd(Args args) {
    extern __shared__ __attribute__((aligned(16))) unsigned char lds[];
    Frame F;
    F.lds = (LAS unsigned char*)lds;
    F.MISC = (volatile LAS unsigned*)(F.lds + MISC_OFF);
    F.tid = threadIdx.x; F.lane = F.tid & 63; F.wave = __builtin_amdgcn_readfirstlane(F.tid >> 6);
    F.G = gridDim.x; { const int bx = blockIdx.x; F.vcu = (F.G % 8 == 0) ? (bx % 8) * (F.G / 8) + bx / 8 : bx; }
    unsigned char* ws = args.ws;
    F.ctl = (gu32*)(ws + WS_CTL);
    const float* x_in = args.in[0]; const float* c_in = args.in[1]; const float* ada_w = args.in[2]; const float* ada_b = args.in[3];
    const float* pre_mix_g = args.in[4]; const float* post_mix_g = args.in[5]; const float* w_in = args.in[6]; const float* q_norm_g = args.in[7]; const float* k_norm_g = args.in[8];
    const float* dec_f = args.in[9]; const float* dec_b = args.in[10]; const float* gn_g = args.in[11]; const float* gn_b = args.in[12]; const float* w_out = args.in[13];
    const float* pre_ffn_g = args.in[14]; const float* post_ffn_g = args.in[15]; const float* router_w = args.in[16]; const float* router_b = args.in[17];
    const float* w_up = args.in[18]; const float* b_up = args.in[19]; const float* w_dn = args.in[20]; const float* b_dn = args.in[21];
    float* xres = args.out;
    float* mod = (float*)(ws + WS_MOD);
    bf16* Win_t = (bf16*)(ws + WS_WIN); bf16* Wout_t = (bf16*)(ws + WS_WOUT); bf16* Wup_t = (bf16*)(ws + WS_WUP); bf16* Wdn_t = (bf16*)(ws + WS_WDN);
    bf16* HM = (bf16*)(ws + WS_HM); bf16* PROJ = (bf16*)(ws + WS_PROJ); bf16* CAT = (bf16*)(ws + WS_CAT); bf16* YM = (bf16*)(ws + WS_YM);
    float* U = (float*)(ws + WS_U); bf16* FT = (bf16*)(ws + WS_FT); bf16* XS = (bf16*)(ws + WS_XS); bf16* ACT = (bf16*)(ws + WS_ACT);
    int* topi = (int*)(ws + WS_TOPI); float* topw = (float*)(ws + WS_TOPW); int* pos = (int*)(ws + WS_POS);
    for (int u = F.tid; u < (LDS_BYTES - LDSCTL_OFF) / 4; u += NTHR) ((LAS unsigned*)(F.lds + LDSCTL_OFF))[u] = 0u;
    __syncthreads();
    XcdBarrier bar = xcd_barrier_post((unsigned*)(F.ctl + CW_BAR), F.MISC + 8);
#define GRID_BAR() do { xcd_barrier(bar); F.tid = threadIdx.x; asm volatile("" : "+v"(F.tid)); F.lane = F.tid & 63; F.wave = __builtin_amdgcn_readfirstlane(F.tid >> 6); } while (0)

#ifndef SKIP_P0
    p0_prologue(F, c_in, ada_w, ada_b, mod, w_in, w_out, w_up, w_dn, Win_t, Wout_t, Wup_t, Wdn_t);
#endif
    GRID_BAR();
#ifndef SKIP_P0B
    p0b_premix(F, x_in, HM, pre_mix_g, mod);
#endif
    GRID_BAR();
#pragma clang loop unroll(disable)
    for (int l = 0; l < DEPTH; ++l) {
        const float* mod_l = mod + (size_t)l * BATCH * 6 * D;
#ifndef SKIP_P1
        {
            pg8::Gemm g{HM, Win_t + (size_t)l * INW * D, M, INW, D}; pg8::StaticOrder S; S.init(M, INW, F.G, (int)blockIdx.x);
            pg8::EpiBf16 E{PROJ, INW, nullptr, 0, 0};
            pg8::gemm_phase<pg8::EpiBf16, pg8::StaticOrder, true, true>(F.lds + RING_OFF, g, S, E);
        }
#endif
        GRID_BAR();
#ifndef SKIP_P1B
        p1b_rope(F, PROJ, q_norm_g + l * 64, k_norm_g + l * 64);
#endif
        GRID_BAR();
#ifndef SKIP_R1
        r1_states(F, PROJ, U, dec_f + l * RH, dec_b + l * RH);
#endif
        GRID_BAR();
#ifndef SKIP_R2
        r2_scan(F, U, FT, dec_f + l * RH, dec_b + l * RH);
#endif
        GRID_BAR();
#ifndef SKIP_R3
        r3_out(F, PROJ, FT, CAT, dec_f + l * RH, dec_b + l * RH, gn_g + l * 512, gn_b + l * 512);
#endif
#ifndef SKIP_P2
        {
            const attn_body::AttnTensors AT{(const attn_body::bf16*)(PROJ + C_QA), (const attn_body::bf16*)(PROJ + C_KA), (const attn_body::bf16*)(PROJ + C_VA), (attn_body::bf16*)CAT};
            attn_body::attn_phase<8>((char*)lds + RING_OFF, AT, F.vcu, F.G);
        }
#endif
        GRID_BAR();
#ifndef SKIP_P3
        {
            pg8::Gemm g{CAT, Wout_t + (size_t)l * D * D, M, D, D}; pg8::StaticOrder S; S.init(M, D, F.G, (int)blockIdx.x);
            pg8::EpiBf16 E{YM, D, nullptr, 0, 0};
            pg8::gemm_phase<pg8::EpiBf16, pg8::StaticOrder, true, true>(F.lds + RING_OFF, g, S, E);
        }
#endif
        GRID_BAR();
#ifndef SKIP_P3B
        p3b_postmix(F, l == 0 ? x_in : xres, xres, YM, HM, mod_l, post_mix_g + l * D, pre_ffn_g + l * D, router_w + (size_t)l * D * NE, router_b + l * NE,
                    topi, topw, F.ctl + CW_CNT + l * 64);
#endif
        GRID_BAR();
#ifndef SKIP_P4A
        p4a_route(F, HM, XS, topi, pos, F.ctl + CW_CNT + l * 64, F.ctl + CW_CUR + l * 64);
#endif
        GRID_BAR();
        const LAS int* ts = (const LAS int*)(F.lds + LTS_OFF);
#ifndef SKIP_P4
        {
            pg8::Gemm g{XS, Wup_t + (size_t)l * NE * 2048 * D, XS_ROWS, 2048, D}; pg8::MoeOrder<3> S{ts, F.G, F.vcu, ts[NE] * 8};
            pg8::EpiMoeUp E{ACT, b_up + (size_t)l * NE * 2048};
            pg8::gemm_phase<pg8::EpiMoeUp, pg8::MoeOrder<3>, true, true>(F.lds + RING_OFF, g, S, E);
        }
#endif
        GRID_BAR();
#ifndef SKIP_P5
        {
            pg8::Gemm g{ACT, Wdn_t + (size_t)l * NE * D * D, XS_ROWS, D, D}; pg8::MoeOrder<2> S{ts, F.G, F.vcu, ts[NE] * 4};
            pg8::EpiBf16 E{XS, D, b_dn + (size_t)l * NE * D, D, 0};
            pg8::gemm_phase<pg8::EpiBf16, pg8::MoeOrder<2>, true, true>(F.lds + RING_OFF, g, S, E);
        }
#endif
        GRID_BAR();
#ifndef SKIP_P5B
        p5b_combine(F, xres, XS, pos, topw, mod_l, post_ffn_g + l * D, l + 1 < DEPTH, mod_l + (size_t)BATCH * 6 * D, pre_mix_g + (l + 1 < DEPTH ? (l + 1) * D : 0), HM);
#endif
        if (l + 1 < DEPTH) GRID_BAR();
    }
#undef GRID_BAR
}

extern "C" void kernel_launch(void* const* d_in, const int* in_sizes, int n_in, void* d_out, int out_size, void* d_ws, size_t ws_size, hipStream_t stream) {
    static int grid = 0;
    if (grid == 0) {
        if (n_in != 22 || in_sizes[0] != M * D || out_size != M * D || ws_size < WS_END) { fprintf(stderr, "kernel_launch: unexpected shapes/workspace (n_in %d, in0 %d, out %d, ws %zu < %zu)\n", n_in, n_in > 0 ? in_sizes[0] : -1, out_size, ws_size, (size_t)WS_END); grid = -1; return; }
        int dev = 0, cus = 0, per_cu = 0;
        if (hipGetDevice(&dev) != hipSuccess || hipDeviceGetAttribute(&cus, hipDeviceAttributeMultiprocessorCount, dev) != hipSuccess) { grid = -1; return; }
        if (hipFuncSetAttribute((const void*)mk_fwd, hipFuncAttributeMaxDynamicSharedMemorySize, LDS_BYTES) != hipSuccess) { fprintf(stderr, "kernel_launch: hipFuncSetAttribute failed\n"); grid = -1; return; }
        if (hipOccupancyMaxActiveBlocksPerMultiprocessor(&per_cu, (const void*)mk_fwd, NTHR, LDS_BYTES) != hipSuccess || per_cu < 1) { fprintf(stderr, "kernel_launch: occupancy query says %d\n", per_cu); }
        (void)hipGetLastError();
        grid = cus;
    }
    if (grid < 0) return;
    if (hipMemsetAsync((char*)d_ws + WS_CTL, 0, CTL_ZERO_BYTES, stream) != hipSuccess) { fprintf(stderr, "kernel_launch: memset failed\n"); return; }
    Args a{};
    for (int i = 0; i < 22; ++i) a.in[i] = (const float*)d_in[i];
    a.out = (float*)d_out; a.ws = (unsigned char*)d_ws;
    hipLaunchKernelGGL(mk_fwd, dim3(grid), dim3(NTHR), LDS_BYTES, stream, a);
    const hipError_t le = hipPeekAtLastError();
    if (le != hipSuccess) fprintf(stderr, "kernel_launch: launch failed: %s\n", hipGetErrorName(le));
}
```

```cpp
#ifndef REP_P0
#define REP_P0 1
#endif
#ifndef REP_P1
#define REP_P1 1
#endif
#ifndef REP_R1
#define REP_R1 1
#endif
#ifndef REP_R2
#define REP_R2 1
#endif
#ifndef REP_R3
#define REP_R3 1
#endif
#ifndef REP_P2
#define REP_P2 1
#endif
#ifndef REP_P3
#define REP_P3 1
#endif
#ifndef REP_P4
#define REP_P4 1
#endif
#ifndef REP_P5
#define REP_P5 1
#endif
#ifndef REP_P0B
#define REP_P0B 1
#endif
#ifndef REP_P1B
#define REP_P1B 1
#endif
#ifndef REP_P3B
#define REP_P3B 1
#endif
#ifndef REP_P4A
#define REP_P4A 1
#endif
#ifndef REP_P5B
#define REP_P5B 1
#endif
#ifndef REP_EPI
#define REP_EPI 1
#endif
#ifndef STAGGER_WAYS
#define STAGGER_WAYS 8
#endif
#include <hip/hip_runtime.h>
template <int M> __device__ __forceinline__ float shx(float v) { return __int_as_float(__builtin_amdgcn_ds_swizzle(__float_as_int(v), (M << 10) | 0x1f)); }
template <int M> __device__ __forceinline__ int shxi(int v) { return __builtin_amdgcn_ds_swizzle(v, (M << 10) | 0x1f); }
__device__ __forceinline__ float sum32(float v) { auto rr = __builtin_amdgcn_permlane32_swap(__float_as_uint(v), __float_as_uint(v), false, false); return __uint_as_float(rr[0]) + __uint_as_float(rr[1]); }
__device__ __forceinline__ float max32(float v) { auto rr = __builtin_amdgcn_permlane32_swap(__float_as_uint(v), __float_as_uint(v), false, false); return fmaxf(__uint_as_float(rr[0]), __uint_as_float(rr[1])); }
__device__ __forceinline__ float shx32(float v, bool upper) { auto rr = __builtin_amdgcn_permlane32_swap(__float_as_uint(v), __float_as_uint(v), false, false); return __uint_as_float(upper ? rr[0] : rr[1]); }
__device__ __forceinline__ int bcastl(int v, int srclane) { return __builtin_amdgcn_ds_bpermute(srclane << 2, v); }
__device__ __forceinline__ float wsum64(float v) { v += shx<1>(v); v += shx<2>(v); v += shx<4>(v); v += shx<8>(v); v += shx<16>(v); return sum32(v); }
__device__ __forceinline__ float wmax64(float v) { v = fmaxf(v, shx<1>(v)); v = fmaxf(v, shx<2>(v)); v = fmaxf(v, shx<4>(v)); v = fmaxf(v, shx<8>(v)); v = fmaxf(v, shx<16>(v)); return max32(v); }
#ifndef YF8_FROM
#define YF8_FROM 0
#endif
#ifndef X16_FROM
#define X16_FROM 0
#endif
#include <hip/hip_runtime.h>
#include <cstdio>
#include <cstdint>
namespace pg8 {
#define PG8_LAS __attribute__((address_space(3)))
typedef unsigned short bf16_t;
typedef short bf16x8 __attribute__((ext_vector_type(8)));
typedef float f32x4 __attribute__((ext_vector_type(4)));
typedef unsigned u32x4 __attribute__((ext_vector_type(4)));
constexpr int BM = 256, BK = 64, HALF = 128, HTB = HALF * BK * 2  , STAGE_BYTES = 8 * HTB, NXCD = 8, WGM = 8;

__host__ __device__ __forceinline__ int lds_byte(int r, int c) { const int st = (r >> 4) * 2 + (c >> 5), rr = r & 15, cc = c & 31, ob = rr * 64 + cc * 2; return st * 1024 + (ob ^ (((ob >> 9) & 1) << 5)); }
__host__ __device__ __forceinline__ void stage_rc(int b, int& R, int& C) { const int st = b / 1024, sb = b % 1024, swz = sb ^ (((sb >> 9) & 1) << 5); R = (st >> 1) * 16 + swz / 64; C = (st & 1) * 32 + (swz % 64) / 2; }
__host__ __device__ __forceinline__ int perm32(int rho) { const int n = rho >> 4, i = rho & 15; return 8 * (i >> 2) + 4 * n + (i & 3); }

struct Unit { int pm, pn; };
struct Gemm { const bf16_t* A; const bf16_t* Bt; int M, N, K; };

struct StaticOrder {
    int nM, nN, nwg, G, c;
    __host__ __device__ void init(int M, int N, int G_, int c_) { nM = M / BM; nN = N / BM; nwg = nM * nN; G = G_; c = c_; }
    __host__ __device__ bool next(int i, Unit& u) const {
        const long L = (long)i * G + c; if (L >= nwg) return false;
        int wgid = (int)L; { const int q = nwg / NXCD, r = nwg % NXCD, xcd = wgid % NXCD, off = wgid / NXCD; wgid = (xcd < r ? xcd * (q + 1) : r * (q + 1) + (xcd - r) * q) + off; }
        const int nig = WGM * nN, gid = wgid / nig, fm = gid * WGM, gsz = (nM - fm) < WGM ? (nM - fm) : WGM;
        u.pm = fm + ((wgid % nig) % gsz); u.pn = (wgid % nig) / gsz; return true;
    }
    __device__ __forceinline__ void a_ready(const Unit&) const {}
    __device__ __forceinline__ void done(const Unit&) const {}
};

__device__ __forceinline__ unsigned cvt_pk_bf16(float lo, float hi) { unsigned r; asm volatile("v_cvt_pk_bf16_f32 %0, %1, %2" : "=v"(r) : "v"(lo), "v"(hi)); return r; }
typedef float f32x2 __attribute__((ext_vector_type(2)));

typedef int i32x4 __attribute__((ext_vector_type(4)));
__device__ __forceinline__ void dma4(const float* g, PG8_LAS unsigned char* l) { __builtin_amdgcn_global_load_lds((const unsigned*)g, (PG8_LAS unsigned*)l, 4, 0, 0); }
template <bool OUT_F8> struct EpiBf16T {
    static constexpr bool PERM = true, AFTER_DRAIN = false; static constexpr int NST = OUT_F8 ? 8 : 16;
    bf16_t* O; int ldc; const float* bias; int split_cols; size_t split_stride; PG8_LAS unsigned char* sp;
    const float* csc = nullptr; float cmul = 1.0f;
    __device__ __forceinline__ void prefetch(const Unit& u, int wid, int lane) const {
        if (bias && wid < 4) dma4(bias + u.pn * BM + wid * 64 + lane, sp + wid * 256);
        if (csc && wid >= 4) dma4(csc + u.pn * BM + (wid - 4) * 64 + lane, sp + 1024 + (wid - 4) * 256);
    }
    __device__ __forceinline__ void operator()(const f32x4 (&acc)[2][2][4][2], const Unit& u, int wr, int wc, int fr, int fq) const {
        const int row0 = u.pm * BM + wr * 64 + fr; int colt = u.pn * BM; bf16_t* base = O;
        if (split_cols) { const int t = colt / split_cols; base += (size_t)t * split_stride; colt -= t * split_cols; }
        const int col0 = colt + wc * 32 + 8 * fq;
        f32x4 bv[2][2];
#pragma unroll
        for (int bj = 0; bj < 2; ++bj)
#pragma unroll
            for (int n = 0; n < 2; ++n) bv[bj][n] = bias ? *(const PG8_LAS f32x4*)(sp + 4 * (bj * HALF + wc * 32 + 8 * fq + 4 * n)) : (f32x4){0.f, 0.f, 0.f, 0.f};
        f32x4 cv[2][2];
#pragma unroll
        for (int bj = 0; bj < 2; ++bj)
#pragma unroll
            for (int n = 0; n < 2; ++n) cv[bj][n] = csc ? *(const PG8_LAS f32x4*)(sp + 1024 + 4 * (bj * HALF + wc * 32 + 8 * fq + 4 * n)) * cmul : (f32x4){1.f, 1.f, 1.f, 1.f};
#pragma unroll
        for (int ai = 0; ai < 2; ++ai)
#pragma unroll
            for (int m = 0; m < 4; ++m) { bf16_t* rowp = base + (size_t)(row0 + ai * HALF + m * 16) * ldc + col0;
                if constexpr (OUT_F8) { unsigned w[4];
#pragma unroll
                    for (int bj = 0; bj < 2; ++bj) { f32x4 v0 = acc[ai][bj][m][0] * cv[bj][0] + bv[bj][0], v1 = acc[ai][bj][m][1] * cv[bj][1] + bv[bj][1]; unsigned w0 = 0u, w1 = 0u;
#pragma unroll
                        for (int q = 0; q < 4; ++q) { v0[q] = __builtin_amdgcn_fmed3f(v0[q], -448.0f, 448.0f); v1[q] = __builtin_amdgcn_fmed3f(v1[q], -448.0f, 448.0f); }
                        w0 = __builtin_amdgcn_cvt_pk_fp8_f32(v0[0], v0[1], w0, false); w0 = __builtin_amdgcn_cvt_pk_fp8_f32(v0[2], v0[3], w0, true);
                        w1 = __builtin_amdgcn_cvt_pk_fp8_f32(v1[0], v1[1], w1, false); w1 = __builtin_amdgcn_cvt_pk_fp8_f32(v1[2], v1[3], w1, true);
                        w[2 * bj] = w0; w[2 * bj + 1] = w1; }
                    *(u32x4*)((unsigned char*)base + (size_t)(row0 + ai * HALF + m * 16) * ldc + colt + 64 * wc + 16 * fq) = (u32x4){w[0], w[1], w[2], w[3]}; }
                else {
#pragma unroll
                    for (int bj = 0; bj < 2; ++bj) { const f32x4 v0 = acc[ai][bj][m][0] * cv[bj][0] + bv[bj][0], v1 = acc[ai][bj][m][1] * cv[bj][1] + bv[bj][1];
                        u32x4 w; w.x = cvt_pk_bf16(v0[0], v0[1]); w.y = cvt_pk_bf16(v0[2], v0[3]); w.z = cvt_pk_bf16(v1[0], v1[1]); w.w = cvt_pk_bf16(v1[2], v1[3]);
                        *(u32x4*)(rowp + bj * HALF) = w; } } }
    }
};
typedef EpiBf16T<false> EpiBf16;
struct EpiNullI8 {
    static constexpr bool PERM = true, AFTER_DRAIN = false; static constexpr int NST = 0;
    __device__ __forceinline__ void prefetch(const Unit&, int, int) const {}
    __device__ __forceinline__ void operator()(const i32x4 (&acc)[2][2][4][2], const Unit&, int, int, int, int) const {
#pragma unroll
        for (int a = 0; a < 2; ++a)
#pragma unroll
            for (int b = 0; b < 2; ++b)
#pragma unroll
                for (int m = 0; m < 4; ++m)
#pragma unroll
                    for (int n = 0; n < 2; ++n) asm volatile("" :: "v"(acc[a][b][m][n]));
    }
};
struct EpiI8Bf16 {
    static constexpr bool PERM = true, AFTER_DRAIN = false; static constexpr int NST = 16;
    bf16_t* O; int ldc; const float* rsc; const float* csc; PG8_LAS unsigned char* sp;
    __device__ __forceinline__ void prefetch(const Unit& u, int wid, int lane) const {
        if (wid < 4) dma4(rsc + u.pm * BM + wid * 64 + lane, sp + wid * 256);
        else dma4(csc + u.pn * BM + (wid - 4) * 64 + lane, sp + 1024 + (wid - 4) * 256);
    }
    __device__ __forceinline__ void operator()(const i32x4 (&acc)[2][2][4][2], const Unit& u, int wr, int wc, int fr, int fq) const {
        const int row0 = u.pm * BM + wr * 64 + fr, col0 = u.pn * BM + wc * 32 + 8 * fq;
        const PG8_LAS float* spf = (const PG8_LAS float*)sp;
        f32x4 cv[2][2];
#pragma unroll
        for (int bj = 0; bj < 2; ++bj)
#pragma unroll
            for (int n = 0; n < 2; ++n) cv[bj][n] = *(const PG8_LAS f32x4*)(spf + 256 + bj * HALF + wc * 32 + 8 * fq + 4 * n);
#pragma unroll
        for (int ai = 0; ai < 2; ++ai)
#pragma unroll
            for (int m = 0; m < 4; ++m) { const int row = row0 + ai * HALF + m * 16; const float rs = spf[ai * HALF + wr * 64 + m * 16 + fr]; bf16_t* rowp = O + (size_t)row * ldc + col0;
#pragma unroll
                for (int bj = 0; bj < 2; ++bj) { float v[8];
#pragma unroll
                    for (int n = 0; n < 2; ++n)
#pragma unroll
                        for (int q = 0; q < 4; ++q) v[4 * n + q] = (float)acc[ai][bj][m][n][q] * (rs * cv[bj][n][q]);
                    u32x4 w; w.x = cvt_pk_bf16(v[0], v[1]); w.y = cvt_pk_bf16(v[2], v[3]); w.z = cvt_pk_bf16(v[4], v[5]); w.w = cvt_pk_bf16(v[6], v[7]);
                    *(u32x4*)(rowp + bj * HALF) = w; } }
    }
};
__device__ __forceinline__ float swiglu_c(float g, float l) {
    g = fminf(g, 7.0f); l = fminf(fmaxf(l, -7.0f), 7.0f);
    const float s = __builtin_amdgcn_rcpf(1.0f + __builtin_amdgcn_exp2f(g * (-1.702f * 1.4426950408889634f)));
    return g * s * (l + 1.0f);
}
typedef float f32x2e __attribute__((ext_vector_type(2)));
__device__ __forceinline__ f32x2e swiglu_pk(f32x2e g, f32x2e l) {
    g.x = fminf(g.x, 7.0f); g.y = fminf(g.y, 7.0f);
    l.x = __builtin_amdgcn_fmed3f(l.x, -7.0f, 7.0f); l.y = __builtin_amdgcn_fmed3f(l.y, -7.0f, 7.0f);
    const f32x2e z = g * (-1.702f * 1.4426950408889634f);
    f32x2e d; d.x = __builtin_amdgcn_exp2f(z.x); d.y = __builtin_amdgcn_exp2f(z.y);
    d = d + 1.0f;
    f32x2e s; s.x = __builtin_amdgcn_rcpf(d.x); s.y = __builtin_amdgcn_rcpf(d.y);
    return (g * s) * (l + 1.0f);
}
typedef unsigned pg_u32x2 __attribute__((ext_vector_type(2)));
constexpr float ACT_F8_SCALE = 4.0f;
template <bool ACT_F8> struct EpiMoeUpT {
    static constexpr bool PERM = true, AFTER_DRAIN = false; static constexpr int NST = 8;
    bf16_t* O; const float* bias; const float* rsc; const float* csc; PG8_LAS unsigned char* sp;
    __device__ __forceinline__ void prefetch(const Unit& u, int wid, int lane) const {
        const int e = u.pn >> 3, pnl = u.pn & 7;
        if (wid < 4) dma4(rsc + u.pm * BM + wid * 64 + lane, sp + wid * 256);
        else if (wid < 6) { const float* b = bias + (size_t)e * 2048 + pnl * HALF + (wid - 4) * 64 + lane; dma4(b, sp + 1024 + (wid - 4) * 256); dma4(b + 1024, sp + 1536 + (wid - 4) * 256); }
        else { const float* c = csc + (size_t)e * 2048 + pnl * 256 + (wid - 6) * 64 + lane; dma4(c, sp + 2048 + (wid - 6) * 256); dma4(c + HALF, sp + 2560 + (wid - 6) * 256); }
    }
    __device__ __forceinline__ void operator()(const i32x4 (&acc)[2][2][4][2], const Unit& u, int wr, int wc, int fr, int fq) const {
        const int pnl = u.pn & 7;
        const int row0 = u.pm * BM + wr * 64 + fr, cg0 = pnl * HALF + wc * 32 + 8 * fq;
        const PG8_LAS float* spf = (const PG8_LAS float*)sp; const int cl = wc * 32 + 8 * fq;
        f32x4 bgv[2], blv[2], sgv[2], slv[2];
#pragma unroll
        for (int n = 0; n < 2; ++n) { bgv[n] = *(const PG8_LAS f32x4*)(spf + 256 + cl + 4 * n); blv[n] = *(const PG8_LAS f32x4*)(spf + 384 + cl + 4 * n); sgv[n] = *(const PG8_LAS f32x4*)(spf + 512 + cl + 4 * n); slv[n] = *(const PG8_LAS f32x4*)(spf + 640 + cl + 4 * n); }
#pragma unroll
        for (int ai = 0; ai < 2; ++ai)
#pragma unroll
            for (int m = 0; m < 4; ++m) { const int row = row0 + ai * HALF + m * 16; bf16_t* rowp = O + (size_t)row * 1024 + cg0; const float rs = spf[ai * HALF + wr * 64 + m * 16 + fr];
                float a[8];
#pragma unroll
                for (int n = 0; n < 2; ++n) {
#pragma unroll
                    for (int q = 0; q < 4; q += 2) {
                        const f32x2e gi = (f32x2e){(float)acc[ai][0][m][n][q], (float)acc[ai][0][m][n][q + 1]}, li = (f32x2e){(float)acc[ai][1][m][n][q], (float)acc[ai][1][m][n][q + 1]};
                        const f32x2e sg2 = (f32x2e){sgv[n][q], sgv[n][q + 1]} * rs, sl2 = (f32x2e){slv[n][q], slv[n][q + 1]} * rs;
                        const f32x2e r = swiglu_pk(gi * sg2 + (f32x2e){bgv[n][q], bgv[n][q + 1]}, li * sl2 + (f32x2e){blv[n][q], blv[n][q + 1]});
                        a[4 * n + q] = r.x; a[4 * n + q + 1] = r.y; } }
                if constexpr (ACT_F8) { unsigned w0 = 0u, w1 = 0u;
                    w0 = __builtin_amdgcn_cvt_pk_fp8_f32(a[0] * ACT_F8_SCALE, a[1] * ACT_F8_SCALE, w0, false); w0 = __builtin_amdgcn_cvt_pk_fp8_f32(a[2] * ACT_F8_SCALE, a[3] * ACT_F8_SCALE, w0, true);
                    w1 = __builtin_amdgcn_cvt_pk_fp8_f32(a[4] * ACT_F8_SCALE, a[5] * ACT_F8_SCALE, w1, false); w1 = __builtin_amdgcn_cvt_pk_fp8_f32(a[6] * ACT_F8_SCALE, a[7] * ACT_F8_SCALE, w1, true);
                    *(pg_u32x2*)((unsigned char*)O + (size_t)row * 1024 + cg0) = (pg_u32x2){w0, w1}; }
                else { u32x4 w; w.x = cvt_pk_bf16(a[0], a[1]); w.y = cvt_pk_bf16(a[2], a[3]); w.z = cvt_pk_bf16(a[4], a[5]); w.w = cvt_pk_bf16(a[6], a[7]);
                    *(u32x4*)rowp = w; } }
    }
};
typedef EpiMoeUpT<false> EpiMoeUp;
struct EpiMoeUpNoLoad {
    static constexpr bool PERM = true, AFTER_DRAIN = false; static constexpr int NST = 8;
    __device__ __forceinline__ void prefetch(const Unit&, int, int) const {}
    bf16_t* O; float k0, k1;
    __device__ __forceinline__ void operator()(const i32x4 (&acc)[2][2][4][2], const Unit& u, int wr, int wc, int fr, int fq) const {
        const int pnl = u.pn & 7;
        const int row0 = u.pm * BM + wr * 64 + fr, cg0 = pnl * HALF + wc * 32 + 8 * fq;
#pragma unroll
        for (int ai = 0; ai < 2; ++ai)
#pragma unroll
            for (int m = 0; m < 4; ++m) { const int row = row0 + ai * HALF + m * 16; bf16_t* rowp = O + (size_t)row * 1024 + cg0;
                float a[8];
#pragma unroll
                for (int n = 0; n < 2; ++n) {
#pragma unroll
                    for (int q = 0; q < 4; ++q) { const float g = (float)acc[ai][0][m][n][q] * k0 + k1, l = (float)acc[ai][1][m][n][q] * k0 + k1;
                        a[4 * n + q] = swiglu_c(g, l); } }
                u32x4 w; w.x = cvt_pk_bf16(a[0], a[1]); w.y = cvt_pk_bf16(a[2], a[3]); w.z = cvt_pk_bf16(a[4], a[5]); w.w = cvt_pk_bf16(a[6], a[7]);
                *(u32x4*)rowp = w; }
    }
};
struct EpiMoeUpNoStore {
    static constexpr bool PERM = true, AFTER_DRAIN = false; static constexpr int NST = 8;
    __device__ __forceinline__ void prefetch(const Unit&, int, int) const {}
    bf16_t* O; float k0, k1;
    __device__ __forceinline__ void operator()(const i32x4 (&acc)[2][2][4][2], const Unit& u, int wr, int wc, int fr, int fq) const {
        const int pnl = u.pn & 7;
        const int row0 = u.pm * BM + wr * 64 + fr, cg0 = pnl * HALF + wc * 32 + 8 * fq;
#pragma unroll
        for (int ai = 0; ai < 2; ++ai)
#pragma unroll
            for (int m = 0; m < 4; ++m) { const int row = row0 + ai * HALF + m * 16; bf16_t* rowp = O + (size_t)row * 1024 + cg0;
                float a[8];
#pragma unroll
                for (int n = 0; n < 2; ++n) {
#pragma unroll
                    for (int q = 0; q < 4; ++q) { const float g = (float)acc[ai][0][m][n][q] * k0 + k1, l = (float)acc[ai][1][m][n][q] * k0 + k1;
                        a[4 * n + q] = swiglu_c(g, l); } }
                u32x4 w; w.x = cvt_pk_bf16(a[0], a[1]); w.y = cvt_pk_bf16(a[2], a[3]); w.z = cvt_pk_bf16(a[4], a[5]); w.w = cvt_pk_bf16(a[6], a[7]);
                if (ai == 0 && m == 0) *(u32x4*)rowp = w; else asm volatile("" :: "v"(w)); }
    }
};
template <int SH> struct MoeOrder {
    const PG8_LAS int* ts; int G, c, total; int tsv;
    __device__ __forceinline__ bool next(int i, Unit& u) const {
        const int L = i * G + c; if (L >= total) return false;
        const int pm = L >> SH, pnl = L & ((1 << SH) - 1);
        const unsigned long long mk = __builtin_amdgcn_ballot_w64(pm >= tsv);
        const int e = __builtin_popcount((unsigned)mk & 0xfffffffeu);
        u.pm = pm; u.pn = (e << SH) + pnl; return true;
    }
    __device__ __forceinline__ void a_ready(const Unit&) const {}
    __device__ __forceinline__ void done(const Unit&) const {}
};
typedef int i32x4 __attribute__((ext_vector_type(4)));
template <bool I8> struct AccSel { typedef f32x4 T; };
template <> struct AccSel<true> { typedef i32x4 T; };
template <bool I8> __device__ __forceinline__ typename AccSel<I8>::T mma16(bf16x8 b, bf16x8 a, typename AccSel<I8>::T c) {
    if constexpr (I8) return __builtin_amdgcn_mfma_i32_16x16x64_i8(__builtin_bit_cast(i32x4, b), __builtin_bit_cast(i32x4, a), c, 0, 0, 0);
    else return __builtin_amdgcn_mfma_f32_16x16x32_bf16(b, a, c, 0, 0, 0);
}
typedef int i32x8 __attribute__((ext_vector_type(8)));
__device__ __forceinline__ f32x4 mma_f8(bf16x8 b0, bf16x8 b1, bf16x8 a0, bf16x8 a1, f32x4 c) {
    const i32x4 bl = __builtin_bit_cast(i32x4, b0), bh = __builtin_bit_cast(i32x4, b1), al = __builtin_bit_cast(i32x4, a0), ah = __builtin_bit_cast(i32x4, a1);
    const i32x8 bb = (i32x8){bl[0], bl[1], bl[2], bl[3], bh[0], bh[1], bh[2], bh[3]}, aa = (i32x8){al[0], al[1], al[2], al[3], ah[0], ah[1], ah[2], ah[3]};
    return __builtin_amdgcn_mfma_scale_f32_16x16x128_f8f6f4(bb, aa, c, 0, 0, 0, 0, 0, 0);
}
template <class Epi, class Sched, bool ALIGN_EPI = false, bool SP2 = false, bool I8 = false, bool GATHER = false, bool F8 = false>
__device__ __forceinline__ void gemm_phase(PG8_LAS unsigned char* lds, const Gemm g, const Sched& S, const Epi& E, const int* rowmap = nullptr) {
    int tid_ = threadIdx.x; asm volatile("" : "+v"(tid_));
    const int tid = tid_, wid = __builtin_amdgcn_readfirstlane(tid >> 6), lane = tid & 63, wr = wid >> 2, wc = wid & 3, fr = lane & 15, fq = lane >> 4;
    const int K = g.K, nt = K / BK;
    unsigned voffA, voffB;
    { int R, C; stage_rc(tid * 16, R, C); const int Rb = Epi::PERM ? ((R & ~31) + perm32(R & 31)) : R;
        voffA = (unsigned)(R * K + C) * 2u; voffB = (unsigned)(Rb * K + C) * 2u; }
    const size_t pstep = (size_t)128 * K;
    unsigned offA[2][2];
    constexpr int RM_OFF = STAGE_BYTES + 1024 + 3072;
    const size_t kstep = (size_t)(BK * 2);
    const size_t hstep = (size_t)HALF * K * 2;
    const size_t tstep = 2 * hstep;
    const unsigned ldsw = (unsigned)wid * 1024u;
    const int aoff = lds_byte(wr * 64 + fr, fq * 8), boff = lds_byte(wc * 32 + fr, fq * 8);
#define PG8_SA(b, h) (((b) * 2 + (h)) * HTB)
#define PG8_SB(b, h) ((4 + (b) * 2 + (h)) * HTB)
#define PG8_STAGE(bufoff, gbase, voff) do { _Pragma("unroll") for (int _i = 0; _i < 2; ++_i) \
        __builtin_amdgcn_global_load_lds((const unsigned*)((const char*)(gbase) + (_i ? pstep : (size_t)0) + (voff)), (PG8_LAS unsigned*)(lds + (bufoff) + ldsw + _i * 8192), 16, 0, 0); } while (0)
#define PG8_STAGE_A(bufoff, gbase, h, nextu) do { if constexpr (GATHER) { _Pragma("unroll") for (int _i = 0; _i < 2; ++_i) \
        __builtin_amdgcn_global_load_lds((const unsigned*)((const char*)(gbase) + offA[h][_i]), (PG8_LAS unsigned*)(lds + (bufoff) + ldsw + _i * 8192), 16, 0, 0); } \
    else { PG8_STAGE(bufoff, (gbase) + (h) * hstep, voffA); } } while (0)
#define PG8_GOFF(SRCEXPR) do { _Pragma("unroll") for (int _h = 0; _h < 2; ++_h) _Pragma("unroll") for (int _i = 0; _i < 2; ++_i) { int R_, C_; stage_rc(tid * 16 + _i * 8192, R_, C_); \
        const int ri_ = _h * HALF + R_; offA[_h][_i] = (unsigned)(SRCEXPR) * (unsigned)(K * 2) + (unsigned)(C_ * 2); } } while (0)
#define PG8_LDA(dst, b, h) do { _Pragma("unroll") for (int m = 0; m < 4; ++m) _Pragma("unroll") for (int k = 0; k < 2; ++k) dst[m][k] = *(const PG8_LAS bf16x8*)(lds + PG8_SA(b, h) + aoff + m * 2048 + k * 1024); } while (0)
#define PG8_LDB(dst, b, h) do { _Pragma("unroll") for (int n = 0; n < 2; ++n) _Pragma("unroll") for (int k = 0; k < 2; ++k) dst[n][k] = *(const PG8_LAS bf16x8*)(lds + PG8_SB(b, h) + boff + n * 2048 + k * 1024); } while (0)
#define PG8_MMA(ai, bj, At, Bt) do { __builtin_amdgcn_s_setprio(1); _Pragma("unroll") for (int m = 0; m < 4; ++m) _Pragma("unroll") for (int n = 0; n < 2; ++n) { \
        if constexpr (F8) { const f32x4 c_ = n ? __builtin_shufflevector(acc8[ai][bj][m], acc8[ai][bj][m], 4, 5, 6, 7) : __builtin_shufflevector(acc8[ai][bj][m], acc8[ai][bj][m], 0, 1, 2, 3); \
            const f32x4 d_ = mma_f8(Bt[n][0], Bt[n][1], At[m][0], At[m][1], c_); \
            if (n) { acc8[ai][bj][m][4] = d_[0]; acc8[ai][bj][m][5] = d_[1]; acc8[ai][bj][m][6] = d_[2]; acc8[ai][bj][m][7] = d_[3]; } else { acc8[ai][bj][m][0] = d_[0]; acc8[ai][bj][m][1] = d_[1]; acc8[ai][bj][m][2] = d_[2]; acc8[ai][bj][m][3] = d_[3]; } } \
        else { _Pragma("unroll") for (int k = 0; k < 2; ++k) acc[ai][bj][m][n] = mma16<I8>(Bt[n][k], At[m][k], acc[ai][bj][m][n]); } } __builtin_amdgcn_s_setprio(0); } while (0)
#define PG8_WAIT_V(n) asm volatile("s_waitcnt vmcnt(" #n ")" ::: "memory")
#define PG8_WAIT_L(n) asm volatile("s_waitcnt lgkmcnt(" #n ")" ::: "memory")
#define PG8_WAIT_VR(fl) do { if constexpr (F8) { PG8_WAIT_V(8); } else asm volatile("s_waitcnt vmcnt(%1)\n\tv_cmp_ne_u32_e32 vcc, 0, %0\n\ts_cbranch_vccnz 1f\n\ts_waitcnt vmcnt(8)\n1:" :: "v"(fl), "n"(8 + Epi::NST) : "vcc", "memory"); } while (0)
#define PG8_BAR __builtin_amdgcn_s_barrier()
#define PG8_SCHED __builtin_amdgcn_sched_barrier(0)
    Unit cur, nxt; int ui = 0;
    if (!S.next(0, cur)) return;
    typedef typename AccSel<I8>::T acc4; acc4 acc[2][2][4][2];
    typedef float f32x8 __attribute__((ext_vector_type(8))); f32x8 acc8[2][2][4];
#pragma unroll
    for (int a = 0; a < 2; ++a)
#pragma unroll
        for (int b = 0; b < 2; ++b)
#pragma unroll
            for (int m = 0; m < 4; ++m)
#pragma unroll
                for (int n = 0; n < 2; ++n) { acc[a][b][m][n] = (acc4){0, 0, 0, 0}; if constexpr (F8) acc8[a][b][m] = (f32x8){0.f, 0.f, 0.f, 0.f, 0.f, 0.f, 0.f, 0.f}; }
    bf16x8 At[4][2], B0[2][2], B1[2][2];
    const char* cA = GATHER ? (const char*)g.A : (const char*)g.A + (size_t)cur.pm * tstep; const char* cB = (const char*)g.Bt + (size_t)cur.pn * tstep;
    if constexpr (GATHER) { PG8_GOFF(rowmap[cur.pm * BM + ri_]); }
    S.a_ready(cur);
    if constexpr (SP2) {
        PG8_STAGE(PG8_SB(0, 0), cB, voffB); PG8_STAGE(PG8_SB(0, 1), cB + hstep, voffB); PG8_STAGE_A(PG8_SA(0, 0), cA, 0, false); PG8_STAGE_A(PG8_SA(0, 1), cA, 1, false);
        if (wr == 1) PG8_BAR;
        PG8_WAIT_V(2); PG8_BAR;
        PG8_STAGE(PG8_SB(1, 0), cB + kstep, voffB); PG8_STAGE_A(PG8_SA(1, 0), cA + kstep, 0, false); PG8_STAGE(PG8_SB(1, 1), cB + hstep + kstep, voffB);
        PG8_STAGE_A(PG8_SA(1, 1), cA + kstep, 1, false);
        PG8_WAIT_V(8); PG8_BAR;
    } else {
        PG8_STAGE(PG8_SB(0, 0), cB, voffB); PG8_STAGE_A(PG8_SA(0, 0), cA, 0, false); PG8_STAGE(PG8_SB(0, 1), cB + hstep, voffB); PG8_STAGE_A(PG8_SA(0, 1), cA, 1, false);
        if (wr == 1) PG8_BAR;
        PG8_WAIT_V(4); PG8_BAR;
        PG8_STAGE(PG8_SB(1, 0), cB + kstep, voffB); PG8_STAGE_A(PG8_SA(1, 0), cA + kstep, 0, false); PG8_STAGE(PG8_SB(1, 1), cB + hstep + kstep, voffB);
        PG8_WAIT_V(6); PG8_BAR;
    }
    for (;;) {
        const bool has_next = S.next(ui + 1, nxt);
        if constexpr (GATHER) { if (has_next && wid < 4) __builtin_amdgcn_global_load_lds((const unsigned*)(rowmap + nxt.pm * BM + wid * 64 + lane), (PG8_LAS unsigned*)(lds + RM_OFF + wid * 256), 4, 0, 0); }
        const char* nA = (has_next && !GATHER) ? (const char*)g.A + (size_t)nxt.pm * tstep : cA; const char* nB = has_next ? (const char*)g.Bt + (size_t)nxt.pn * tstep : cB;
        for (int t = 0; t < nt; t += 2) {
            const bool last = (t == nt - 2);
            asm volatile("" : "+v"(voffA), "+v"(voffB));
            const char* a1 = cA + (size_t)(t + 1) * kstep;
            const char* a2 = last ? nA : cA + (size_t)(t + 2) * kstep; const char* b2 = last ? nB : cB + (size_t)(t + 2) * kstep;
            const char* a3 = a2 + kstep; const char* b3 = b2 + kstep;
            if (last && has_next) S.a_ready(nxt);
            if (last) { int ln_ = lane; asm volatile("" : "+v"(ln_)); E.prefetch(cur, wid, ln_); }
            if constexpr (SP2) {
            const int fl = (t == 0 && ui > 0) ? 1 : 0;
            PG8_LDB(B0, 0, 0); PG8_LDB(B1, 0, 1); PG8_SCHED; PG8_LDA(At, 0, 0);
            if constexpr (GATHER) { if (last && has_next) { const PG8_LAS int* rm = (const PG8_LAS int*)(lds + RM_OFF); PG8_GOFF(rm[ri_]); } }
            PG8_WAIT_VR(fl); PG8_WAIT_L(0); PG8_BAR; PG8_MMA(0, 0, At, B0); PG8_MMA(0, 1, At, B1); PG8_BAR; PG8_SCHED;
            PG8_LDA(At, 0, 1); PG8_STAGE(PG8_SB(0, 0), b2, voffB); PG8_STAGE(PG8_SB(0, 1), b2 + hstep, voffB); PG8_STAGE_A(PG8_SA(0, 0), a2, 0, last);
            PG8_WAIT_VR(fl); PG8_WAIT_L(0); PG8_BAR; PG8_MMA(1, 0, At, B0); PG8_MMA(1, 1, At, B1); PG8_BAR; PG8_SCHED;
            PG8_LDB(B0, 1, 0); PG8_LDB(B1, 1, 1); PG8_SCHED; PG8_LDA(At, 1, 0); PG8_STAGE_A(PG8_SA(0, 1), a2, 1, last);
            PG8_WAIT_VR(fl); PG8_WAIT_L(0); PG8_BAR; PG8_MMA(0, 0, At, B0); PG8_MMA(0, 1, At, B1); PG8_BAR; PG8_SCHED;
            PG8_LDA(At, 1, 1); PG8_STAGE(PG8_SB(1, 0), b3, voffB); PG8_STAGE(PG8_SB(1, 1), b3 + hstep, voffB); PG8_STAGE_A(PG8_SA(1, 0), a3, 0, last);
            PG8_WAIT_V(8); PG8_WAIT_L(0); PG8_BAR; PG8_MMA(1, 0, At, B0); PG8_MMA(1, 1, At, B1); PG8_BAR; PG8_SCHED;
            PG8_STAGE_A(PG8_SA(1, 1), a3, 1, last);
            } else {
            PG8_LDB(B0, 0, 0); PG8_SCHED; PG8_LDA(At, 0, 0); PG8_STAGE_A(PG8_SA(1, 1), a1, 1, false);
            if constexpr (GATHER) { if (last && has_next) { const PG8_LAS int* rm = (const PG8_LAS int*)(lds + RM_OFF); PG8_GOFF(rm[ri_]); } }
            PG8_WAIT_L(8); PG8_BAR; PG8_WAIT_L(0); PG8_MMA(0, 0, At, B0); PG8_BAR; PG8_SCHED;
            PG8_LDB(B1, 0, 1); PG8_STAGE(PG8_SB(0, 0), b2, voffB);
            PG8_BAR; PG8_WAIT_L(0); PG8_MMA(0, 1, At, B1); PG8_BAR;
            PG8_LDA(At, 0, 1); PG8_STAGE_A(PG8_SA(0, 0), a2, 0, last);
            PG8_BAR; PG8_WAIT_L(0); PG8_MMA(1, 0, At, B0); PG8_BAR; PG8_SCHED;
            PG8_STAGE(PG8_SB(0, 1), b2 + hstep, voffB);
            PG8_WAIT_V(6); PG8_BAR; PG8_MMA(1, 1, At, B1); PG8_BAR;
            PG8_LDB(B0, 1, 0); PG8_SCHED; PG8_LDA(At, 1, 0); PG8_STAGE_A(PG8_SA(0, 1), a2, 1, last);
            PG8_WAIT_L(8); PG8_BAR; PG8_WAIT_L(0); PG8_MMA(0, 0, At, B0); PG8_BAR; PG8_SCHED;
            PG8_LDB(B1, 1, 1); PG8_STAGE(PG8_SB(1, 0), b3, voffB);
            PG8_BAR; PG8_WAIT_L(0); PG8_MMA(0, 1, At, B1); PG8_BAR;
            PG8_LDA(At, 1, 1); PG8_STAGE_A(PG8_SA(1, 0), a3, 0, last);
            PG8_BAR; PG8_WAIT_L(0); PG8_MMA(1, 0, At, B0); PG8_BAR; PG8_SCHED;
            PG8_STAGE(PG8_SB(1, 1), b3 + hstep, voffB);
            PG8_WAIT_V(6); PG8_BAR; PG8_MMA(1, 1, At, B1); PG8_BAR;
            }
        }
        if constexpr (ALIGN_EPI) { if (wr == 0) PG8_BAR; }
        if constexpr (F8 && !I8) {
#pragma unroll
            for (int a_ = 0; a_ < 2; ++a_)
#pragma unroll
                for (int b_ = 0; b_ < 2; ++b_)
#pragma unroll
                    for (int m = 0; m < 4; ++m) { acc[a_][b_][m][0] = __builtin_shufflevector(acc8[a_][b_][m], acc8[a_][b_][m], 0, 1, 2, 3); acc[a_][b_][m][1] = __builtin_shufflevector(acc8[a_][b_][m], acc8[a_][b_][m], 4, 5, 6, 7); } }
        if constexpr (!Epi::AFTER_DRAIN) { int t2_ = threadIdx.x; asm volatile("" : "+v"(t2_)); E(acc, cur, wr, wc, t2_ & 15, (t2_ & 63) >> 4); S.done(cur); }
        if (!has_next) break;
#pragma unroll
        for (int a = 0; a < 2; ++a)
#pragma unroll
            for (int b = 0; b < 2; ++b)
#pragma unroll
                for (int m = 0; m < 4; ++m)
#pragma unroll
                    for (int n = 0; n < 2; ++n) { acc[a][b][m][n] = (acc4){0, 0, 0, 0}; if constexpr (F8) acc8[a][b][m] = (f32x8){0.f, 0.f, 0.f, 0.f, 0.f, 0.f, 0.f, 0.f}; }
        cur = nxt; cA = nA; cB = nB; ++ui;
        if constexpr (ALIGN_EPI) { if (wr == 1) PG8_BAR; }
    }
    PG8_WAIT_V(0);
    if constexpr (!ALIGN_EPI) { if (wr == 0) PG8_BAR; }
    PG8_BAR;
    if constexpr (Epi::AFTER_DRAIN) { E.fused(acc, cur, wr, wc, fr, fq, lds, wid, lane); S.done(cur); }
#undef PG8_SA
#undef PG8_SB
#undef PG8_STAGE
#undef PG8_STAGE_A
#undef PG8_GOFF
#undef PG8_LDA
#undef PG8_LDB
#undef PG8_MMA
#undef PG8_WAIT_V
#undef PG8_WAIT_L
#undef PG8_WAIT_VR
#undef PG8_BAR
#undef PG8_SCHED
}
}
#include <hip/hip_bf16.h>
#include <cmath>
namespace attn_body {
using bf16=__hip_bfloat16;
using bf16x8=__attribute__((ext_vector_type(8)))short;
using s16x4=__attribute__((ext_vector_type(4)))short;
using f32x16=__attribute__((ext_vector_type(16)))float;
using u32x4=__attribute__((ext_vector_type(4)))unsigned;
constexpr float OSCALE=32.0f;
constexpr int BATCH=8,NHEAD=8,NKVH=2,SEQ=8192,D=64,PQ=2816,PO=1024;
constexpr int NW=8,QBLK=32,QB=QBLK*NW,KVBLK=64,NQB=SEQ/QB;
constexpr int ATTN_UNIT_ROWS=QB;
__device__ __forceinline__ int crow(int r,int hi){return (r&3)+8*(r>>2)+4*hi;}
#define SBAR() __builtin_amdgcn_sched_barrier(0)
__device__ __forceinline__ void cmask(f32x16&p0,f32x16&p1,int jb,int qrel,int hi){
  const float NEG=-INFINITY; int kb=64*jb+4*hi;
  #pragma unroll
  for(int r=0;r<16;++r){int kv=kb+(r&3)+8*(r>>2); if(kv>qrel)p0[r]=NEG; if(kv+32>qrel)p1[r]=NEG;}
}

constexpr int NSLOT=3, SLOTB=8192;
constexpr int LDS_K=0, LDS_V=NSLOT*SLOTB, LDS_WS=2*NSLOT*SLOTB, LDS_OST=LDS_WS+NW*64*4, LDS_BYTES=LDS_OST+NW*4096;
constexpr float C2=0.125f*1.4426950408889634f;
__device__ __forceinline__ void glds16(const void*gsrc,unsigned lds_dst){unsigned keep;
  asm volatile("s_mov_b32 %0, m0\n\ts_mov_b32 m0, %2\n\ts_nop 0\n\tglobal_load_lds_dwordx4 %1, off\n\ts_mov_b32 m0, %0":"=&s"(keep):"v"(gsrc),"s"(lds_dst):"memory");}
__device__ __forceinline__ float max3f(float a,float b,float c){float r;asm("v_max3_f32 %0, %1, %2, %3":"=v"(r):"v"(a),"v"(b),"v"(c));return r;}
__device__ __forceinline__ float max2f(float a,float b){float r;asm("v_max_f32_e32 %0, %1, %2":"=v"(r):"v"(a),"v"(b));return r;}
__device__ __forceinline__ float fadd_s(float a,float b){float r;asm("v_add_f32_e32 %0, %1, %2":"=v"(r):"v"(a),"v"(b));return r;}
__device__ __forceinline__ float fsub_s(float a,float b){float r;asm("v_sub_f32_e32 %0, %1, %2":"=v"(r):"v"(a),"v"(b));return r;}
typedef float f32x2_t __attribute__((ext_vector_type(2))); typedef __bf16 bf16x2_t __attribute__((ext_vector_type(2)));
__device__ __forceinline__ unsigned cvtpk_s(float lo,float hi){f32x2_t v={lo,hi};bf16x2_t b=__builtin_convertvector(v,bf16x2_t);return __builtin_bit_cast(unsigned,b);}
#define WAIT_BAR(N) asm volatile("s_waitcnt vmcnt(" #N ") lgkmcnt(0)\n\ts_barrier":::"memory")

__device__ __forceinline__ void qkt(f32x16&p0,f32x16&p1,const char*Kslot,const bf16x8*qr,const f32x16&negm,int r32,int hi){
  const char*kb=Kslot+hi*1024+r32*16;
  #pragma unroll
  for(int d0=0;d0<4;++d0){
    const bf16x8 b0=*reinterpret_cast<const bf16x8*>(kb+d0*2048);
    const bf16x8 b1=*reinterpret_cast<const bf16x8*>(kb+d0*2048+512);
    if(d0==0){p0=__builtin_amdgcn_mfma_f32_32x32x16_bf16(b0,qr[0],negm,0,0,0);p1=__builtin_amdgcn_mfma_f32_32x32x16_bf16(b1,qr[0],negm,0,0,0);}
    else{p0=__builtin_amdgcn_mfma_f32_32x32x16_bf16(b0,qr[d0],p0,0,0,0);p1=__builtin_amdgcn_mfma_f32_32x32x16_bf16(b1,qr[d0],p1,0,0,0);}}
}
typedef __attribute__((address_space(3))) const char* lds_cptr;
typedef short v4i16_t __attribute__((ext_vector_type(4)));
__device__ __forceinline__ void kload8(bf16x8*kf,lds_cptr kp){
  kf[0]=*(const __attribute__((address_space(3))) bf16x8*)(kp);      kf[1]=*(const __attribute__((address_space(3))) bf16x8*)(kp+512);
  kf[2]=*(const __attribute__((address_space(3))) bf16x8*)(kp+2048); kf[3]=*(const __attribute__((address_space(3))) bf16x8*)(kp+2560);
  kf[4]=*(const __attribute__((address_space(3))) bf16x8*)(kp+4096); kf[5]=*(const __attribute__((address_space(3))) bf16x8*)(kp+4608);
  kf[6]=*(const __attribute__((address_space(3))) bf16x8*)(kp+6144); kf[7]=*(const __attribute__((address_space(3))) bf16x8*)(kp+6656);
}
__device__ __forceinline__ void kload2(bf16x8*kf,lds_cptr kp,int j){ kf[2*j]=*(const __attribute__((address_space(3))) bf16x8*)(kp+j*2048); kf[2*j+1]=*(const __attribute__((address_space(3))) bf16x8*)(kp+j*2048+512); }
__device__ __forceinline__ s16x4 vtr(lds_cptr p){ return __builtin_bit_cast(s16x4,__builtin_amdgcn_ds_read_tr16_b64_v4i16((__attribute__((address_space(3))) v4i16_t*)p)); }
__device__ __forceinline__ float rowmax(const f32x16&p0,const f32x16&p1){
  float a=max3f(p0[0],p0[1],p1[0]),b=max3f(p0[2],p0[3],p1[1]);a=max3f(a,p1[2],p1[3]);
  #pragma unroll
  for(int r=4;r<16;r+=4){a=max3f(a,p0[r],p0[r+1]);b=max3f(b,p0[r+2],p0[r+3]);a=max3f(a,p1[r],p1[r+1]);b=max3f(b,p1[r+2],p1[r+3]);}
  const float m=max2f(a,b);
  auto rr=__builtin_amdgcn_permlane32_swap(__float_as_uint(m),__float_as_uint(m),false,false);
  return max2f(__uint_as_float(rr[0]),__uint_as_float(rr[1]));
}
__device__ __forceinline__ void pv(f32x16*o,int vb,bf16x8 pa0,bf16x8 pa1,bf16x8 pa2,bf16x8 pa3){
  #pragma unroll
  for(int d0=0;d0<2;++d0){s16x4 lo[4],hi[4];
    #pragma unroll
    for(int ks=0;ks<4;++ks){
      asm volatile("ds_read_b64_tr_b16 %0,%1 offset:%c2":"=&v"(lo[ks]):"v"(vb),"i"(d0*4096+ks*1024):"memory");
      asm volatile("ds_read_b64_tr_b16 %0,%1 offset:%c2":"=&v"(hi[ks]):"v"(vb),"i"(d0*4096+ks*1024+512):"memory");}
    asm volatile("s_waitcnt lgkmcnt(0)":::"memory");SBAR();
    #define PK(k) (bf16x8){lo[k][0],lo[k][1],lo[k][2],lo[k][3],hi[k][0],hi[k][1],hi[k][2],hi[k][3]}
    o[d0]=__builtin_amdgcn_mfma_f32_32x32x16_bf16(pa0,PK(0),o[d0],0,0,0);
    o[d0]=__builtin_amdgcn_mfma_f32_32x32x16_bf16(pa1,PK(1),o[d0],0,0,0);
    o[d0]=__builtin_amdgcn_mfma_f32_32x32x16_bf16(pa2,PK(2),o[d0],0,0,0);
    o[d0]=__builtin_amdgcn_mfma_f32_32x32x16_bf16(pa3,PK(3),o[d0],0,0,0);
    #undef PK
  }
}

#ifndef ATTN_STORE16
#define ATTN_STORE16(p,v) (*(u32x4*)(p)=(v))
#endif
template<int THRL> __device__ __forceinline__ void attn_unit(int b,int h,int qb,const bf16*Q,const bf16*__restrict__ K,const bf16*__restrict__ V,bf16*O,char*shm,const float*qg,const float nref){
  int tid_=threadIdx.x; asm volatile("":"+v"(tid_)); const int tid=tid_,lane=tid&63,r32=lane&31,hi=lane>>5; const int wid=__builtin_amdgcn_readfirstlane(tid>>6);
  const long rowbase=(long)b*SEQ; const int q0=qb*QB;
  const bf16*Qw=Q+(rowbase+q0+wid*QBLK)*PQ+h*D;
  const bf16*Kh=K+rowbase*PQ+(h>>2)*D,*Vh=V+rowbase*PQ+(h>>2)*D;
  const unsigned lds0=(unsigned)(uintptr_t)shm;
  float*wsf=(float*)(shm+LDS_WS)+wid*64;
  const bf16*ksrc=Kh+(long)lane*PQ+wid*8;
  const bf16*vsrc=Vh+(long)(16*(wid&3)+(lane>>2))*PQ+(wid>>2)*32+(lane&3)*8;
  const unsigned kdst=lds0+LDS_K+wid*1024, vdst=lds0+LDS_V+wid*1024;
  #define DMA_K(t,slot) glds16(ksrc+(long)(t)*KVBLK*PQ,(unsigned)__builtin_amdgcn_readfirstlane(kdst+(slot)))
  #define DMA_V(t,slot) glds16(vsrc+(long)(t)*KVBLK*PQ,(unsigned)__builtin_amdgcn_readfirstlane(vdst+(slot)))
  const int vb0=(int)(lds0+LDS_V)+((lane>>4)&1)*32+(lane&3)*8+(4*hi+((lane&15)>>2))*64;
  const char*Kbase=shm+LDS_K; bf16x8 kf[8];
  const lds_cptr shm3=(lds_cptr)shm; const lds_cptr kp0=shm3+LDS_K+hi*1024+r32*16; const lds_cptr vp0=shm3+LDS_V+((lane>>4)&1)*32+(lane&3)*8+(4*hi+((lane&15)>>2))*64;
  constexpr int NT=SEQ/KVBLK;
  DMA_K(0,0);DMA_V(0,0);DMA_K(1,SLOTB);
  bf16x8 qr[4];
  #pragma unroll
  for(int d0=0;d0<4;++d0)qr[d0]=*reinterpret_cast<const bf16x8*>(&Qw[(long)r32*PQ+d0*16+hi*8]);
  {
    float y[4][8]; float ss=0.f;
    #pragma unroll
    for(int d0=0;d0<4;++d0){
      #pragma unroll
      for(int j=0;j<8;++j){ y[d0][j]=__uint_as_float(((unsigned)(unsigned short)qr[d0][j])<<16); ss+=y[d0][j]*y[d0][j]; } }
    { auto rr=__builtin_amdgcn_permlane32_swap(__float_as_uint(ss),__float_as_uint(ss),false,false); ss=__uint_as_float(rr[0])+__uint_as_float(rr[1]); }
    const float rs=__builtin_amdgcn_rsqf(ss*(1.f/64.f)+1e-6f);
    const int spos=q0+wid*QBLK+r32; const float rid=(float)(spos>>6),cid=(float)(spos&63);
    #pragma unroll
    for(int j=0;j<8;++j){ const float fr=__builtin_amdgcn_exp2f(-(float)(8*hi+j)*(13.287712379549449f/16.f));
      const float cr=__cosf(rid*fr),sr=__sinf(rid*fr),cc=__cosf(cid*fr),sc=__sinf(cid*fr);
      const float a1=y[0][j]*rs*qg[8*hi+j],a2=y[1][j]*rs*qg[16+8*hi+j],b1=y[2][j]*rs*qg[32+8*hi+j],b2=y[3][j]*rs*qg[48+8*hi+j];
      y[0][j]=(a1*cr-a2*sr)*C2; y[1][j]=(a2*cr+a1*sr)*C2; y[2][j]=(b1*cc-b2*sc)*C2; y[3][j]=(b2*cc+b1*sc)*C2; }
    #pragma unroll
    for(int d0=0;d0<4;++d0){ u32x4 w; w.x=cvtpk_s(y[d0][0],y[d0][1]); w.y=cvtpk_s(y[d0][2],y[d0][3]); w.z=cvtpk_s(y[d0][4],y[d0][5]); w.w=cvtpk_s(y[d0][6],y[d0][7]); qr[d0]=__builtin_bit_cast(bf16x8,w); }
  }
  float l_reg=0.f;f32x16 o[2];o[0]=f32x16{};o[1]=f32x16{};f32x16 negm; _Pragma("unroll") for(int r=0;r<16;++r)negm[r]=nref; asm volatile("":"+v"(negm));
  #define CMASK(P0,P1,t) do{}while(0)
  #define START(P0,P1) do{ _Pragma("unroll") for(int r=0;r<16;++r)P0[r]=__builtin_amdgcn_exp2f(P0[r]); }while(0)
  #define RESC() do{}while(0)
  f32x16 pA0,pA1,pB0,pB1;
  int sl_prev=0,sl_cur=0,sl_next=SLOTB;
  #define ROT() do{sl_prev=sl_cur;sl_cur=sl_next;sl_next=(sl_next==(NSLOT-1)*SLOTB)?0:sl_next+SLOTB;}while(0)
  DMA_K(2,2*SLOTB);
  WAIT_BAR(3);
  qkt(pA0,pA1,Kbase,qr,negm,r32,hi);asm volatile("s_nop 15\n\ts_nop 7":"+v"(pA0),"+v"(pA1));CMASK(pA0,pA1,0);
  START(pA0,pA1);
  _Pragma("unroll") for(int r=0;r<16;++r)pA1[r]=__builtin_amdgcn_exp2f(pA1[r]);
  WAIT_BAR(0);
  DMA_K(3,0);DMA_V(1,SLOTB);
  ROT();
  kload8(kf,kp0+sl_cur);
  WAIT_BAR(2);
  s16x4 vlo[8],vhi[8]; u32x4 pw0,pw1,pw2,pw3;
  #define PKW(P,B) cvtpk_s(P[B],P[B+1])
  #define PAF(k) __builtin_bit_cast(bf16x8,pw##k)
  #define VFR(i) (bf16x8){vlo[i][0],vlo[i][1],vlo[i][2],vlo[i][3],vhi[i][0],vhi[i][1],vhi[i][2],vhi[i][3]}
  #define PIN(x) asm volatile("":"+v"(x))
  #define MX3(a,b,c) __builtin_fmaxf(__builtin_fmaxf((a),(b)),(c))
  #define GAPA(MF,A0,A1,A2,A3,W0,W1,PW) do{ MF; sacc+=A0; sacc+=A1; sacc+=A2; sacc+=A3; PIN(sacc); W0; W1; PIN(PW); SBAR(); }while(0)
  #define EX(v) __builtin_amdgcn_exp2f(v)
  #define GAPB(MF,X,B) do{ MF; X[B]=EX(X[B]); X[B+1]=EX(X[B+1]); X[B+2]=EX(X[B+2]); X[B+3]=EX(X[B+3]); PIN(X); SBAR(); }while(0)
  #define VRD(i) do{ vlo[i]=vtr(vp_+(((i)>>2)*4096+((i)&3)*1024)); vhi[i]=vtr(vp_+(((i)>>2)*4096+((i)&3)*1024+512)); }while(0)
  #define KRD(G,j) do{ if(G){ kload2(kf,kp0+sl_next,j); SBAR(); } }while(0)
  #define STEP(C0,C1,P0,P1,t,GK,GV,GL) do{ SBAR(); \
    const lds_cptr vp_=vp0+sl_prev; \
    VRD(0); SBAR(); float sacc=(P0[0]+P0[1]); \
    GAPA(C0=__builtin_amdgcn_mfma_f32_32x32x16_bf16(kf[0],qr[0],negm,0,0,0), P0[2],P0[3],P0[4],P0[5],     pw0[0]=PKW(P0,0), pw0[1]=PKW(P0,2), pw0); \
    VRD(4); SBAR(); GAPA(C1=__builtin_amdgcn_mfma_f32_32x32x16_bf16(kf[1],qr[0],negm,0,0,0), P0[6],P0[7],P0[8],P0[9],     pw0[2]=PKW(P0,4), pw0[3]=PKW(P0,6), pw0); \
    VRD(1); SBAR(); GAPA(C0=__builtin_amdgcn_mfma_f32_32x32x16_bf16(kf[2],qr[1],C0,0,0,0),   P0[10],P0[11],P0[12],P0[13], pw1[0]=PKW(P0,8), pw1[1]=PKW(P0,10), pw1); \
    VRD(5); SBAR(); GAPA(C1=__builtin_amdgcn_mfma_f32_32x32x16_bf16(kf[3],qr[1],C1,0,0,0),   P0[14],P0[15],P1[0],P1[1],   pw1[2]=PKW(P0,12),pw1[3]=PKW(P0,14), pw1); \
    VRD(2); SBAR(); GAPA(C0=__builtin_amdgcn_mfma_f32_32x32x16_bf16(kf[4],qr[2],C0,0,0,0),   P1[2],P1[3],P1[4],P1[5],     pw2[0]=PKW(P1,0), pw2[1]=PKW(P1,2), pw2); \
    VRD(6); SBAR(); GAPA(C1=__builtin_amdgcn_mfma_f32_32x32x16_bf16(kf[5],qr[2],C1,0,0,0),   P1[6],P1[7],P1[8],P1[9],     pw2[2]=PKW(P1,4), pw2[3]=PKW(P1,6), pw2); \
    VRD(3); SBAR(); GAPA(C0=__builtin_amdgcn_mfma_f32_32x32x16_bf16(kf[6],qr[3],C0,0,0,0),   P1[10],P1[11],P1[12],P1[13], pw3[0]=PKW(P1,8), pw3[1]=PKW(P1,10), pw3); \
    VRD(7); SBAR(); GAPA(C1=__builtin_amdgcn_mfma_f32_32x32x16_bf16(kf[7],qr[3],C1,0,0,0),   P1[14],P1[15],0.f,0.f,       pw3[2]=PKW(P1,12),pw3[3]=PKW(P1,14), pw3); \
    l_reg+=sacc; \
    if(GK){DMA_K((t)+3,sl_cur);} if(GV){DMA_V((t)+1,sl_next);} \
    CMASK(C0,C1,t); \
    SBAR(); \
    GAPB(o[0]=__builtin_amdgcn_mfma_f32_32x32x16_bf16(PAF(0),VFR(0),o[0],0,0,0), C0,0); \
    GAPB(o[1]=__builtin_amdgcn_mfma_f32_32x32x16_bf16(PAF(0),VFR(4),o[1],0,0,0), C0,4); \
    KRD(GL,0); GAPB(o[0]=__builtin_amdgcn_mfma_f32_32x32x16_bf16(PAF(1),VFR(1),o[0],0,0,0), C0,8); \
    KRD(GL,1); GAPB(o[1]=__builtin_amdgcn_mfma_f32_32x32x16_bf16(PAF(1),VFR(5),o[1],0,0,0), C0,12); \
    KRD(GL,2); GAPB(o[0]=__builtin_amdgcn_mfma_f32_32x32x16_bf16(PAF(2),VFR(2),o[0],0,0,0), C1,0); \
    KRD(GL,3); GAPB(o[1]=__builtin_amdgcn_mfma_f32_32x32x16_bf16(PAF(2),VFR(6),o[1],0,0,0), C1,4); \
    GAPB(o[0]=__builtin_amdgcn_mfma_f32_32x32x16_bf16(PAF(3),VFR(3),o[0],0,0,0), C1,8); \
    GAPB(o[1]=__builtin_amdgcn_mfma_f32_32x32x16_bf16(PAF(3),VFR(7),o[1],0,0,0), C1,12); \
    }while(0)
  int t=1;
  #undef CMASK
  #define CMASK(P0,P1,t) do{}while(0)
  for(;t+5<NT;t+=2){
    STEP(pB0,pB1,pA0,pA1,t,true,true,true);     WAIT_BAR(2); RESC(); ROT();
    STEP(pA0,pA1,pB0,pB1,t+1,true,true,true);   WAIT_BAR(2); RESC(); ROT();
  }
  #undef CMASK
  #define CMASK(P0,P1,t) do{}while(0)
  #define ENDW(tt) do{ if((tt)+3<NT){WAIT_BAR(2);} else if((tt)+2<NT){WAIT_BAR(1);} else {WAIT_BAR(0);} }while(0)
  for(;t+1<NT;t+=2){
    STEP(pB0,pB1,pA0,pA1,t,(t+3<NT),(t+1<NT),(t+1<NT));       ENDW(t);   RESC(); ROT();
    STEP(pA0,pA1,pB0,pB1,t+1,(t+4<NT),(t+2<NT),(t+2<NT));     ENDW(t+1); RESC(); ROT();
  }
  STEP(pB0,pB1,pA0,pA1,NT-1,false,false,false); RESC();
  { float sacc=pB0[0]+pB0[1]; _Pragma("unroll") for(int r=2;r<16;++r)sacc+=pB0[r]; _Pragma("unroll") for(int r=0;r<16;++r)sacc+=pB1[r]; l_reg+=sacc;
    pw0=(u32x4){PKW(pB0,0),PKW(pB0,2),PKW(pB0,4),PKW(pB0,6)};pw1=(u32x4){PKW(pB0,8),PKW(pB0,10),PKW(pB0,12),PKW(pB0,14)};pw2=(u32x4){PKW(pB1,0),PKW(pB1,2),PKW(pB1,4),PKW(pB1,6)};pw3=(u32x4){PKW(pB1,8),PKW(pB1,10),PKW(pB1,12),PKW(pB1,14)};
    SBAR(); pv(o,vb0+sl_cur,PAF(0),PAF(1),PAF(2),PAF(3)); }
  #undef PKW
  #undef PAF
  #undef VFR
  #undef PIN
  #undef MX3
  #undef GAPA
  #undef GAPB
  #undef EX
  #undef VRD
  #undef KRD
  #undef STEP
  #undef ENDW
  {auto rr=__builtin_amdgcn_permlane32_swap(__float_as_uint(l_reg),__float_as_uint(l_reg),false,false);l_reg=__uint_as_float(rr[0])+__uint_as_float(rr[1]);}
  if(hi==0)wsf[32+r32]=l_reg;asm volatile("s_waitcnt lgkmcnt(0)":::"memory");
  float rli[16];
  #pragma unroll
  for(int r=0;r<16;++r)rli[r]=__builtin_amdgcn_rcpf(wsf[32+crow(r,hi)]);
  unsigned char*Ow=(unsigned char*)O+(rowbase+q0+wid*QBLK)*PO+h*D;
  { unsigned char*stg=(unsigned char*)(shm+LDS_OST)+wid*2048;
    #pragma unroll
    for(int r=0;r<16;++r){const int orow=crow(r,hi); const float sc=rli[r]*OSCALE;
      #pragma unroll
      for(int d0=0;d0<2;++d0){ const float v=__builtin_amdgcn_fmed3f(o[d0][r]*sc,-448.0f,448.0f); stg[orow*64+d0*32+r32]=(unsigned char)(__builtin_amdgcn_cvt_pk_fp8_f32(v,0.f,0u,false)&0xffu); } }
    asm volatile("s_waitcnt lgkmcnt(0)":::"memory");
    #pragma unroll
    for(int i=0;i<2;++i){const int row=i*16+(lane>>2),ch=lane&3; const u32x4 v=*(const u32x4*)(stg+row*64+ch*16); ATTN_STORE16(Ow+(long)row*PO+ch*16,v);} }
  asm volatile("s_waitcnt lgkmcnt(0)\n\ts_barrier":::"memory");
  #undef DMA_K
  #undef DMA_V
  #undef CMASK
  #undef START
  #undef RESC
  #undef ROT
}
constexpr int ATTN_LDS_BYTES=LDS_BYTES;
struct AttnTensors { const bf16* Q; const bf16* K; const bf16* V; bf16* O; const float* qg; const float* kg; };
template<int THRL=8> __device__ __forceinline__ void attn_phase(char*lds,const AttnTensors&T,int vcu,int G){
  float gq=fabsf(T.qg[threadIdx.x&63]),gk=fabsf(T.kg[threadIdx.x&63]);
  gq=wmax64(gq); gk=wmax64(gk);
  const float nref=__uint_as_float(__builtin_amdgcn_readfirstlane(__float_as_uint(-(64.f*C2*gq*gk*1.02f+0.25f))));
  for(int L=vcu;L<BATCH*NHEAD*NQB;L+=G){
    const int pair=((L>>5)&7)*2+((L>>8)>>2), idx=(L&31)+32*((L>>8)&3);
    const int b=pair>>1, h=(pair&1)*4+(idx>>5), qb=idx&31;
    attn_unit<THRL>(b,h,qb,T.Q,T.K,T.V,T.O,lds,T.qg,nref);
  }
}
#undef SBAR
#undef WAIT_BAR
}
constexpr int NWAVES = 8;
constexpr int NTHR = NWAVES * 64;
constexpr int BATCH = 8, T = 8192, D = 1024, DEPTH = 2;
constexpr int M = BATCH * T;
constexpr int INW = 2816;
constexpr int C_QA = 0, C_KA = 512, C_VA = 640, C_QR = 768, C_KR = 1280, C_VR = 1792, C_GR = 2304;
constexpr int NE = 32, TOPK = 4, NASG = M * TOPK;
constexpr int XS_ROWS = NASG + NE * 256;
constexpr int RCH = 128, NCH = T / RCH, RH = 4;
constexpr int RUNITS = BATCH * RH * NCH;
constexpr float EPS = 1e-6f;
constexpr float LOG2E = 1.4426950408889634f;

constexpr size_t MiB = 1u << 20;
constexpr size_t WS_CTL = 0, CTL_ZERO_BYTES = 2 * MiB;
constexpr size_t WS_MOD = 512 * 1024;
constexpr size_t WS_CMAXIN = 256 * 1024, WS_CSCIN = 320 * 1024;
constexpr size_t WS_CMAX = 1 * MiB;
constexpr size_t WS_CSCDN = 1 * MiB;
constexpr size_t WS_CSCOUT = 1 * MiB + 256 * 1024;
constexpr float CAT_S_ATT = 32.0f, CAT_S_RET = 8.0f;
static_assert(attn_body::OSCALE == CAT_S_ATT, "attention output scale");
constexpr size_t WS_CSC = 1 * MiB + 512 * 1024;
constexpr size_t WS_WIN = 2 * MiB;
constexpr size_t WS_WOUT = 13 * MiB;
constexpr size_t WS_WUP = 17 * MiB;
constexpr size_t WS_WDN = 273 * MiB;
constexpr size_t WS_HM = 401 * MiB;
constexpr size_t WS_TOPI = 529 * MiB, WS_TOPW = 530 * MiB, WS_POS = 531 * MiB;
constexpr size_t WS_PROJ = 532 * MiB;
constexpr size_t WS_CAT = 884 * MiB;
constexpr size_t WS_YM = 1012 * MiB;
constexpr size_t WS_U = 1140 * MiB;
constexpr size_t WS_FT = 1396 * MiB;
constexpr size_t WS_XS = 532 * MiB;
constexpr size_t WS_ACT = 1060 * MiB;
constexpr size_t WS_HS = 1588 * MiB;
constexpr size_t WS_XSC = 1589 * MiB;
constexpr size_t WS_RMAP = 1591 * MiB;
constexpr size_t WS_END = 1593 * MiB;
constexpr size_t WS_DUMMY = 1593 * MiB;
static_assert(WS_MOD + (size_t)DEPTH * BATCH * 6 * D * 4 <= CTL_ZERO_BYTES, "mod inside the memset region");
static_assert(WS_XS + (size_t)XS_ROWS * 1024 * 2 <= WS_ACT && WS_ACT + (size_t)XS_ROWS * 1024 * 2 <= WS_END, "moe map");
static_assert(WS_PROJ + (size_t)M * INW * 2 <= WS_CAT && WS_FT + (size_t)RUNITS * 2 * 16384 * 2 <= WS_END, "mixer map");
constexpr int CW_TMO = 0, CW_CODE = 1;
constexpr int CW_BAR = 4096;
constexpr int CW_CNT = 8192;
constexpr int CW_WQ = 8192 + 1024;
constexpr int CW_CUR = 8192 + 256;

constexpr int RING_OFF = 0, RING_BYTES = 131072;
constexpr int LDSCTL_OFF = RING_BYTES;
constexpr int LCNT_OFF = LDSCTL_OFF, LTS_OFF = LDSCTL_OFF + 128, MISC_OFF = LDSCTL_OFF + 320;
constexpr int EPI_SP_OFF = LDSCTL_OFF + 1024;
constexpr int GAIN_OFF = LDSCTL_OFF + 6144;
constexpr int LDS_BYTES = 147456;
#define GAS __attribute__((address_space(1)))
#define LAS __attribute__((address_space(3)))
typedef unsigned short bf16;
typedef unsigned v4u __attribute__((ext_vector_type(4)));
typedef float f32x4 __attribute__((ext_vector_type(4)));
typedef short bf16x8 __attribute__((ext_vector_type(8)));
typedef GAS unsigned gu32;
typedef GAS unsigned long long gu64;
#define RLX_AGENT __ATOMIC_RELAXED, __HIP_MEMORY_SCOPE_AGENT
#define LDS_WAIT() asm volatile("s_waitcnt lgkmcnt(0)" ::: "memory")
#define VM_WAIT() asm volatile("s_waitcnt vmcnt(0)" ::: "memory")
__device__ __forceinline__ unsigned long long rt() { return __builtin_amdgcn_s_memrealtime(); }
__device__ __forceinline__ unsigned f2bf(float f) { unsigned u = __builtin_bit_cast(unsigned, f); return (u + 0x7fffu + ((u >> 16) & 1u)) >> 16; }
__device__ __forceinline__ unsigned pk2(float lo, float hi) { return f2bf(lo) | (f2bf(hi) << 16); }

#define XB_TMO      128
#define XB_XCNT(j)  (256  + 64 * (j))
#define XB_XSUB(j)  (1280 + 64 * (j))
#define XB_XGEN(j)  (2304 + 64 * (j))
#define XB_TOP      3328
#define XB_TOPGEN   3392
#define XCD_BAR_WORDS 3456
#define XB_SPIN_CAP (1u << 18)

__device__ __forceinline__ unsigned xb_ld(unsigned* p)              { return __hip_atomic_load(p, __ATOMIC_RELAXED, __HIP_MEMORY_SCOPE_AGENT); }
__device__ __forceinline__ unsigned xb_add(unsigned* p, unsigned v) { return __hip_atomic_fetch_add(p, v, __ATOMIC_RELAXED, __HIP_MEMORY_SCOPE_AGENT); }
__device__ __forceinline__ unsigned xb_xcc_id() { return (unsigned)__builtin_amdgcn_s_getreg((3 << 11) | 20) & 0xFu; }
#define XB_SPIN(cond, bar) do { unsigned _sp = 0; while (cond) { __builtin_amdgcn_s_sleep(1); \
    if ((++_sp & 255u) == 0u) { if (xb_ld(&(bar)[XB_TMO])) break; if (_sp > XB_SPIN_CAP) { atomicAdd(&(bar)[XB_TMO], 1u); break; } } } } while (0)

struct XcdBarrier {
    unsigned* bar; unsigned x;
    volatile LAS unsigned* st;
};

__device__ __forceinline__ XcdBarrier xcd_barrier_post(unsigned* bar, volatile LAS unsigned* st) {
    XcdBarrier b; b.bar = bar; b.x = xb_xcc_id(); b.st = st;
    if (threadIdx.x == 0) (void)xb_add(&bar[XB_XCNT(b.x)], 1u);
    return b;
}
__device__ __forceinline__ void xcd_barrier_complete(unsigned* bar, unsigned x, unsigned& nloc, unsigned& nx) {
    const unsigned G = gridDim.x * gridDim.y * gridDim.z;
    unsigned sum, cnt, mine, sp = 0u;
    for (;;) {
        sum = 0u; cnt = 0u; mine = 0u;
#pragma unroll
        for (unsigned j = 0; j < 16; ++j) { const unsigned c = xb_ld(&bar[XB_XCNT(j)]); sum += c; cnt += (c > 0u) ? 1u : 0u; mine = (j == x) ? c : mine; }
        if (sum == G) break;
        __builtin_amdgcn_s_sleep(1);
        if ((++sp & 255u) == 0u) { if (xb_ld(&bar[XB_TMO])) break; if (sp > XB_SPIN_CAP) { atomicAdd(&bar[XB_TMO], 1u); break; } }
    }
    nloc = mine > 0u ? mine : 1u; nx = cnt > 0u ? cnt : 1u;
}

__device__ __forceinline__ void xcd_barrier(const XcdBarrier& b) {
    asm volatile("s_waitcnt vmcnt(0)" ::: "memory");
    __syncthreads();
    if (threadIdx.x == 0) {
        unsigned* bar = b.bar;
        __builtin_amdgcn_s_waitcnt(0);
        unsigned nloc = b.st[0], nx = b.st[1];
        if (nloc == 0u) { xcd_barrier_complete(bar, b.x, nloc, nx); b.st[0] = nloc; b.st[1] = nx; }
        const unsigned old = xb_add(&bar[XB_XSUB(b.x)], 1u);
        const unsigned gen = old / nloc;
        if (old + 1u == (gen + 1u) * nloc) {
            __builtin_amdgcn_fence(__ATOMIC_RELEASE, "agent");
            asm volatile("s_waitcnt vmcnt(0)" ::: "memory");
            const unsigned og = xb_add(&bar[XB_TOP], 1u);
            const unsigned tg = og / nx;
            if (og + 1u == (tg + 1u) * nx) xb_add(&bar[XB_TOPGEN], 1u);
            else XB_SPIN(xb_ld(&bar[XB_TOPGEN]) == tg, bar);
            __builtin_amdgcn_fence(__ATOMIC_ACQUIRE, "agent");
            xb_add(&bar[XB_XGEN(b.x)], 1u);
            asm volatile("s_waitcnt vmcnt(0)" ::: "memory");
        } else {
            XB_SPIN(xb_ld(&bar[XB_XGEN(b.x)]) == gen, bar);
            __builtin_amdgcn_fence(__ATOMIC_ACQUIRE, "agent");
            asm volatile("s_waitcnt vmcnt(0)" ::: "memory");
        }
    }
    __syncthreads();
}

typedef unsigned u32x2 __attribute__((ext_vector_type(2)));
typedef short s16x4 __attribute__((ext_vector_type(4)));
typedef float f32x16 __attribute__((ext_vector_type(16)));
typedef int i32x4 __attribute__((ext_vector_type(4)));
struct Frame {
    LAS unsigned char* lds;
    volatile LAS unsigned* MISC;
    gu32* ctl;
    int tid, lane, wave, vcu, G;
};
__device__ __forceinline__ float wave_sum(float v) {
    return wsum64(v);
}
__device__ __forceinline__ float bflo(unsigned w) { return __uint_as_float(w << 16); }
__device__ __forceinline__ float bfhi(unsigned w) { return __uint_as_float(w & 0xffff0000u); }
__device__ __forceinline__ unsigned pkbf(float lo, float hi) { return pg8::cvt_pk_bf16(lo, hi); }
__device__ __forceinline__ float fexp2(float x) { return __builtin_amdgcn_exp2f(x); }
__device__ __forceinline__ float frsq(float x) { return __builtin_amdgcn_rsqf(x); }
__device__ __forceinline__ float frcp(float x) { return __builtin_amdgcn_rcpf(x); }
__device__ __forceinline__ float row_rstd(const f32x4 (&v)[4]) {
    float s = 0.f;
#pragma unroll
    for (int j = 0; j < 4; ++j) s += (v[j].x * v[j].x + v[j].y * v[j].y) + (v[j].z * v[j].z + v[j].w * v[j].w);
    return frsq(wave_sum(s) * (1.f / D) + EPS);
}
__device__ __forceinline__ void store_row_bf16(bf16* orow, const f32x4 (&v)[4], int lane) {
    u32x2* o8 = (u32x2*)orow + lane;
#pragma unroll
    for (int j = 0; j < 4; ++j) { u32x2 w; w.x = pkbf(v[j].x, v[j].y); w.y = pkbf(v[j].z, v[j].w); o8[64 * j] = w; }
}
__device__ __forceinline__ void load_row_f32(const float* xrow, f32x4 (&v)[4], int lane) {
    const f32x4* xr = (const f32x4*)xrow + lane;
#pragma unroll
    for (int j = 0; j < 4; ++j) v[j] = xr[64 * j];
}
__device__ __forceinline__ void modnorm_row(const f32x4 (&x)[4], f32x4 (&h)[4], const float* g, const float* sc, const float* sh, int lane) {
    const float rs = row_rstd(x);
#pragma unroll
    for (int j = 0; j < 4; ++j) { const f32x4 gv = ((const f32x4*)g)[lane + 64 * j], scv = ((const f32x4*)sc)[lane + 64 * j], shv = ((const f32x4*)sh)[lane + 64 * j];
        h[j] = x[j] * rs * gv * (scv + 1.0f) + shv; }
}

template <bool UPPERM> __device__ __forceinline__ void p0_transpose_item(const float* W, int K, int N, bf16* WT, int item, int lane) {
    const int nblk = N / 256, kb = item / nblk, nb = item - kb * nblk, k0 = 32 * kb, n0 = 256 * nb + 4 * lane;
    const float* src = W + (size_t)k0 * N + n0;
    int drow = n0;
    if (UPPERM) drow = (n0 < 1024) ? (256 * (n0 >> 7) + (n0 & 127)) : (256 * ((n0 - 1024) >> 7) + 128 + ((n0 - 1024) & 127));
    bf16* dst = WT + (size_t)drow * K + k0;
#pragma unroll
    for (int s = 0; s < 4; ++s) {
        f32x4 v[8];
#pragma unroll
        for (int k = 0; k < 8; ++k) v[k] = *(const f32x4*)(src + (size_t)(8 * s + k) * N);
#pragma unroll
        for (int j = 0; j < 4; ++j) { v4u o; o.x = pkbf(v[0][j], v[1][j]); o.y = pkbf(v[2][j], v[3][j]); o.z = pkbf(v[4][j], v[5][j]); o.w = pkbf(v[6][j], v[7][j]);
            *(v4u*)(dst + (size_t)j * K + 8 * s) = o; }
    }
}
__device__ __forceinline__ int up_dest_row(int n0) { return (n0 < 1024) ? (256 * (n0 >> 7) + (n0 & 127)) : (256 * ((n0 - 1024) >> 7) + 128 + ((n0 - 1024) & 127)); }
template <int N, bool UPPERM> __device__ __forceinline__ void p0_absmax_item(const float* W, unsigned* cmax, int item, int lane) {
    constexpr int NBLK = N / 256; const int kb = item / NBLK, nb = item - kb * NBLK, k0 = 32 * kb, n0 = 256 * nb + 4 * lane;
    const float* src = W + (size_t)k0 * N + n0;
    f32x4 mx = (f32x4){0.f, 0.f, 0.f, 0.f};
#pragma unroll
    for (int k = 0; k < 32; ++k) { const f32x4 v = *(const f32x4*)(src + (size_t)k * N); mx.x = fmaxf(mx.x, fabsf(v.x)); mx.y = fmaxf(mx.y, fabsf(v.y)); mx.z = fmaxf(mx.z, fabsf(v.z)); mx.w = fmaxf(mx.w, fabsf(v.w)); }
    unsigned* d = cmax + (UPPERM ? up_dest_row(n0) : n0);
    atomicMax(d + 0, __float_as_uint(mx.x)); atomicMax(d + 1, __float_as_uint(mx.y)); atomicMax(d + 2, __float_as_uint(mx.z)); atomicMax(d + 3, __float_as_uint(mx.w));
}
template <int N, bool UPPERM> __device__ __forceinline__ void p0_quant_item(const float* W, const unsigned* cmax, signed char* WQ, float* csc, int item, int lane) {
    constexpr int NBLK = N / 256; const int kb = item / NBLK, nb = item - kb * NBLK, k0 = 32 * kb, n0 = 256 * nb + 4 * lane, drow = UPPERM ? up_dest_row(n0) : n0;
    const float* src = W + (size_t)k0 * N + n0;
    float inv[4];
#pragma unroll
    for (int j = 0; j < 4; ++j) { const float cm = __uint_as_float(cmax[drow + j]); inv[j] = cm > 0.f ? 127.0f / cm : 0.f; if (kb == 0) csc[drow + j] = cm * (1.0f / 127.0f); }
#pragma unroll
    for (int s = 0; s < 2; ++s) {
        f32x4 v[16];
#pragma unroll
        for (int k = 0; k < 16; ++k) v[k] = *(const f32x4*)(src + (size_t)(16 * s + k) * N);
#pragma unroll
        for (int j = 0; j < 4; ++j) { unsigned w[4];
#pragma unroll
            for (int d = 0; d < 4; ++d) { unsigned x = 0u;
#pragma unroll
                for (int b = 0; b < 4; ++b) { const int q = (int)__builtin_rintf(v[4 * d + b][j] * inv[j]); x |= ((unsigned)q & 0xffu) << (8 * b); }
                w[d] = x; }
            *(v4u*)(WQ + (size_t)(drow + j) * 1024 + k0 + 16 * s) = (v4u){w[0], w[1], w[2], w[3]}; }
    }
}
__device__ __forceinline__ void p0_quant_up(Frame& F, const float* w_up, const unsigned* cmax, signed char* WQ, float* csc, const float* w_in, const unsigned* cmax_in, signed char* WQin, float* csc_in) {
    const int gw = F.vcu * NWAVES + F.wave, NGW = F.G * NWAVES;
    for (int it = gw; it < DEPTH * NE * 256 + DEPTH * 352; it += NGW) {
        if (it < DEPTH * NE * 256) { const int le = it >> 8;
            p0_quant_item<2048, true>(w_up + (size_t)le * D * 2048, cmax + (size_t)le * 2048, WQ + (size_t)le * 2048 * D, csc + (size_t)le * 2048, it & 255, F.lane); }
        else { const int r = it - DEPTH * NE * 256, l = r / 352;
            p0_quant_item<INW, false>(w_in + (size_t)l * D * INW, cmax_in + (size_t)l * INW, WQin + (size_t)l * INW * D, csc_in + (size_t)l * INW, r % 352, F.lane); }
    }
}
template <int N, bool UPPERM, bool FP8 = false, bool KSC = false> __device__ __forceinline__ void p0_quant_unit(const float* W, signed char* WQ, float* csc, int cb, LAS unsigned* red, int tid) {
    const int cg = tid & 15, kq = tid >> 4, n0 = 64 * cb + 4 * cg, drow = UPPERM ? up_dest_row(n0) : n0;
    f32x4 v[2][16]; f32x4 mx = (f32x4){0.f, 0.f, 0.f, 0.f};
#pragma unroll
    for (int h = 0; h < 2; ++h)
#pragma unroll
        for (int i = 0; i < 16; ++i) { v[h][i] = *(const f32x4*)(W + (size_t)(16 * (kq + 32 * h) + i) * N + n0); if constexpr (KSC) v[h][i] = v[h][i] * (h == 0 ? 1.0f / CAT_S_ATT : 1.0f / CAT_S_RET);
            mx.x = fmaxf(mx.x, fabsf(v[h][i].x)); mx.y = fmaxf(mx.y, fabsf(v[h][i].y)); mx.z = fmaxf(mx.z, fabsf(v[h][i].z)); mx.w = fmaxf(mx.w, fabsf(v[h][i].w)); }
    if (tid < 64) red[tid] = 0u;
    __syncthreads();
    atomicMax((unsigned*)(red + 4 * cg + 0), __float_as_uint(mx.x)); atomicMax((unsigned*)(red + 4 * cg + 1), __float_as_uint(mx.y));
    atomicMax((unsigned*)(red + 4 * cg + 2), __float_as_uint(mx.z)); atomicMax((unsigned*)(red + 4 * cg + 3), __float_as_uint(mx.w));
    __syncthreads();
    float inv[4];
#pragma unroll
    for (int j = 0; j < 4; ++j) { const float cm = __uint_as_float(red[4 * cg + j]); constexpr float QMAX = FP8 ? 448.0f : 127.0f; inv[j] = cm > 0.f ? QMAX / cm : 0.f; if (kq == 0) csc[drow + j] = cm * (1.0f / QMAX); }
#pragma unroll
    for (int h = 0; h < 2; ++h)
#pragma unroll
        for (int j = 0; j < 4; ++j) { unsigned w[4];
#pragma unroll
            for (int d = 0; d < 4; ++d) { unsigned x = 0u;
                if constexpr (FP8) { x = __builtin_amdgcn_cvt_pk_fp8_f32(v[h][4 * d + 0][j] * inv[j], v[h][4 * d + 1][j] * inv[j], x, false); x = __builtin_amdgcn_cvt_pk_fp8_f32(v[h][4 * d + 2][j] * inv[j], v[h][4 * d + 3][j] * inv[j], x, true); }
                else {
#pragma unroll
                for (int b = 0; b < 4; ++b) { const int q = (int)__builtin_rintf(v[h][4 * d + b][j] * inv[j]); x |= ((unsigned)q & 0xffu) << (8 * b); } }
                w[d] = x; }
            *(v4u*)(WQ + (size_t)(drow + j) * 1024 + 16 * (kq + 32 * h)) = (v4u){w[0], w[1], w[2], w[3]}; }
    __syncthreads();
}
struct QItem { const float* W; signed char* WQ; float* csc; int N, n0, type; };
__device__ __forceinline__ void q_issue(f32x4 (&v)[16], const QItem& q, int tid) {
    const int cg = tid & 7, kq = tid >> 3; const float* src = q.W + (size_t)(16 * kq) * q.N + q.n0 + 4 * cg;
#pragma unroll
    for (int i = 0; i < 16; ++i) v[i] = *(const f32x4*)(src + (size_t)i * q.N);
}
template <bool UPPERM, bool FP8, bool KSC> __device__ __forceinline__ void q_finish(f32x4 (&v)[16], const QItem& q, LAS unsigned* red, int tid) {
    const int cg = tid & 7, kq = tid >> 3, n0 = q.n0 + 4 * cg, drow = UPPERM ? up_dest_row(n0) : n0;
    f32x4 mx = (f32x4){0.f, 0.f, 0.f, 0.f};
#pragma unroll
    for (int i = 0; i < 16; ++i) { if constexpr (KSC) v[i] = v[i] * (kq < 32 ? 1.0f / CAT_S_ATT : 1.0f / CAT_S_RET);
        mx.x = fmaxf(mx.x, fabsf(v[i].x)); mx.y = fmaxf(mx.y, fabsf(v[i].y)); mx.z = fmaxf(mx.z, fabsf(v[i].z)); mx.w = fmaxf(mx.w, fabsf(v[i].w)); }
    if (tid < 32) red[tid] = 0u;
    __syncthreads();
    atomicMax((unsigned*)(red + 4 * cg + 0), __float_as_uint(mx.x)); atomicMax((unsigned*)(red + 4 * cg + 1), __float_as_uint(mx.y));
    atomicMax((unsigned*)(red + 4 * cg + 2), __float_as_uint(mx.z)); atomicMax((unsigned*)(red + 4 * cg + 3), __float_as_uint(mx.w));
    __syncthreads();
    constexpr float QMAX = FP8 ? 448.0f : 127.0f;
#pragma unroll
    for (int j = 0; j < 4; ++j) { const float cm = __uint_as_float(red[4 * cg + j]), inv = cm > 0.f ? QMAX / cm : 0.f; if (kq == 0) q.csc[drow + j] = cm * (1.0f / QMAX);
        unsigned w[4];
#pragma unroll
        for (int d = 0; d < 4; ++d) { unsigned x = 0u;
            if constexpr (FP8) { x = __builtin_amdgcn_cvt_pk_fp8_f32(v[4 * d + 0][j] * inv, v[4 * d + 1][j] * inv, x, false); x = __builtin_amdgcn_cvt_pk_fp8_f32(v[4 * d + 2][j] * inv, v[4 * d + 3][j] * inv, x, true); }
            else {
#pragma unroll
                for (int b = 0; b < 4; ++b) { const int qv = (int)__builtin_rintf(v[4 * d + b][j] * inv); x |= ((unsigned)qv & 0xffu) << (8 * b); } }
            w[d] = x; }
        *(v4u*)(q.WQ + (size_t)(drow + j) * 1024 + 16 * kq) = (v4u){w[0], w[1], w[2], w[3]}; }
}
__device__ __forceinline__ void q_finish_any(f32x4 (&v)[16], const QItem& q, LAS unsigned* red, int tid) {
    if (q.type == 0) q_finish<true, false, false>(v, q, red, tid);
    else if (q.type == 1) q_finish<false, false, false>(v, q, red, tid);
    else if (q.type == 2) q_finish<false, true, false>(v, q, red, tid);
    else q_finish<false, true, true>(v, q, red, tid);
}
__device__ __forceinline__ void p0_prologue(Frame& F, const float* c_in, const float* ada_w, const float* ada_b, float* mod,
                                            const float* w_in, const float* w_out, const float* w_up, const float* w_dn,
                                            signed char* WQin, float* csc_in, signed char* WQout, float* csc_out, signed char* WQup, float* csc_up, signed char* WQdn, float* csc_dn, gu32* wq_ctr) {
    const int gw = F.vcu * NWAVES + F.wave, NGW = F.G * NWAVES;
    __syncthreads();
    LAS float* cond = (LAS float*)F.lds;
    for (int i = F.tid; i < BATCH * D; i += NTHR) { const float v = c_in[i]; cond[i] = v * frcp(1.0f + __expf(-v)); }
    __syncthreads();
    LAS float* part = (LAS float*)(F.lds + 32768);
    for (int bt = blockIdx.x; bt < DEPTH * 96; bt += F.G) {
        const int l = bt / 96, chunk = bt % 96, ks = F.wave, col = chunk * 64 + F.lane;
        float acc[BATCH];
#pragma unroll
        for (int b = 0; b < BATCH; ++b) acc[b] = 0.f;
        const float* w = ada_w + ((size_t)l * D + ks * 128) * (6 * D) + col;
#pragma unroll 16
        for (int k = 0; k < 128; ++k) { const float wv = w[(size_t)k * (6 * D)];
#pragma unroll
            for (int b = 0; b < BATCH; ++b) acc[b] += cond[b * D + ks * 128 + k] * wv; }
#pragma unroll
        for (int b = 0; b < BATCH; ++b) part[(ks * BATCH + b) * 64 + F.lane] = acc[b];
        __syncthreads();
        { const int b = F.wave; float sum = ada_b[l * 6 * D + col];
#pragma unroll
          for (int k2 = 0; k2 < 8; ++k2) sum += part[(k2 * BATCH + b) * 64 + F.lane];
          mod[((size_t)l * BATCH + b) * (6 * D) + col] = sum; }
        __syncthreads();
    }
    {   LAS unsigned* redA = (LAS unsigned*)(F.lds + 49152 + 1024), *redB = redA + 32; LAS unsigned* claim = redA + 64;
        constexpr int U_UP = DEPTH * NE * 64, U_IN = DEPTH * 88, U_DN = DEPTH * NE * 32, U_OUT = DEPTH * 32, U_ALL = U_UP + U_IN + U_DN + U_OUT;
        auto take = [&](QItem& q) -> bool {
            if (F.tid == 0) claim[0] = __hip_atomic_fetch_add(wq_ctr, 1u, RLX_AGENT);
            __syncthreads();
            const int u = (int)claim[0];
            __syncthreads();
            if (u >= U_ALL) return false;
            if (u < U_UP) { const int le = u >> 6; q = QItem{w_up + (size_t)le * D * 2048, WQup + (size_t)le * 2048 * D, csc_up + (size_t)le * 2048, 2048, 32 * (u & 63), 0}; }
            else if (u < U_UP + U_IN) { const int r = u - U_UP, l = r / 88; q = QItem{w_in + (size_t)l * D * INW, WQin + (size_t)l * INW * D, csc_in + (size_t)l * INW, INW, 32 * (r % 88), 1}; }
            else if (u < U_UP + U_IN + U_DN) { const int r = u - U_UP - U_IN, le = r >> 5; q = QItem{w_dn + (size_t)le * D * D, WQdn + (size_t)le * D * D, csc_dn + (size_t)le * D, D, 32 * (r & 31), 2}; }
            else { const int r = u - U_UP - U_IN - U_DN, l = r >> 5; q = QItem{w_out + (size_t)l * D * D, WQout + (size_t)l * D * D, csc_out + (size_t)l * D, D, 32 * (r & 31), 3}; }
            return true; };
        f32x4 vA[16], vB[16]; QItem qA, qB;
        bool hA = take(qA); if (hA) q_issue(vA, qA, F.tid);
        bool hB = hA && take(qB); if (hB) q_issue(vB, qB, F.tid);
        while (hA || hB) {
            if (hA) { q_finish_any(vA, qA, redA, F.tid); hA = take(qA); if (hA) q_issue(vA, qA, F.tid); }
            if (hB) { q_finish_any(vB, qB, redB, F.tid); hB = take(qB); if (hB) q_issue(vB, qB, F.tid); }
        }
    }
}
__device__ __forceinline__ void store_row_i8(signed char* qrow, float* sc, const f32x4 (&h)[4], int lane) {
    float mx = 0.f;
#pragma unroll
    for (int j = 0; j < 4; ++j) mx = fmaxf(fmaxf(mx, fmaxf(fabsf(h[j].x), fabsf(h[j].y))), fmaxf(fabsf(h[j].z), fabsf(h[j].w)));
    mx = wmax64(mx);
    const float inv = mx > 0.f ? 127.0f / mx : 0.f;
    unsigned* qr = (unsigned*)qrow + lane;
#pragma unroll
    for (int j = 0; j < 4; ++j) { const int q0 = (int)__builtin_rintf(h[j].x * inv), q1 = (int)__builtin_rintf(h[j].y * inv), q2 = (int)__builtin_rintf(h[j].z * inv), q3 = (int)__builtin_rintf(h[j].w * inv);
        qr[64 * j] = ((unsigned)q0 & 0xffu) | (((unsigned)q1 & 0xffu) << 8) | (((unsigned)q2 & 0xffu) << 16) | (((unsigned)q3 & 0xffu) << 24); }
    if (lane == 0) *sc = mx * (1.0f / 127.0f);
}
__device__ __forceinline__ void p0b_premix(Frame& F, const float* x, signed char* HQ, float* hs, const float* g, const float* mod_l) {
    const int lane = F.lane, gw = F.vcu * NWAVES + F.wave, NGW = F.G * NWAVES;
    for (int ch = gw; ch < M / 32; ch += NGW) { const int mb = ch * 32;
        const float* modb = mod_l + (size_t)(mb >> 13) * (6 * D);
        f32x4 gsv[4], shv[4];
#pragma unroll
        for (int j = 0; j < 4; ++j) { gsv[j] = ((const f32x4*)g)[lane + 64 * j] * (((const f32x4*)(modb + D))[lane + 64 * j] + 1.0f); shv[j] = ((const f32x4*)modb)[lane + 64 * j]; }
        f32x4 A[2][4], B[2][4];
#define P0B_ISSUE(BUF, t0) do { _Pragma("unroll") for (int r = 0; r < 2; ++r) load_row_f32(x + (size_t)(mb + (t0) + r) * D, BUF[r], lane); } while (0)
#define P0B_PROC(BUF, t0) do { _Pragma("unroll") for (int r = 0; r < 2; ++r) { const int m = mb + (t0) + r; f32x4 h[4]; const float rs = row_rstd(BUF[r]); \
            _Pragma("unroll") for (int j = 0; j < 4; ++j) h[j] = BUF[r][j] * rs * gsv[j] + shv[j]; store_row_i8(HQ + (size_t)m * D, hs + m, h, lane); } } while (0)
        P0B_ISSUE(A, 0);
#pragma unroll 1
        for (int it = 0; it < 8; ++it) { const int t0 = 4 * it;
            P0B_ISSUE(B, t0 + 2);
            P0B_PROC(A, t0);
            if (it < 7) P0B_ISSUE(A, t0 + 4);
            P0B_PROC(B, t0 + 2);
        }
#undef P0B_ISSUE
#undef P0B_PROC
    }
}
__device__ __forceinline__ void rope4(float (&y)[4][2], const float (&cr)[2], const float (&sr)[2], const float (&cc)[2], const float (&sc)[2], float scale, unsigned (&w)[4]) {
    float o[4][2];
#pragma unroll
    for (int e = 0; e < 2; ++e) { o[0][e] = y[0][e] * cr[e] - y[1][e] * sr[e]; o[1][e] = y[1][e] * cr[e] + y[0][e] * sr[e];
                                  o[2][e] = y[2][e] * cc[e] - y[3][e] * sc[e]; o[3][e] = y[3][e] * cc[e] + y[2][e] * sc[e]; }
#pragma unroll
    for (int q = 0; q < 4; ++q) w[q] = pkbf(o[q][0] * scale, o[q][1] * scale);
}
__device__ __forceinline__ void p1b_ka(Frame& F, bf16* PROJ, const float* kg) {
    const int lane = F.lane, gw = F.vcu * NWAVES + F.wave, NGW = F.G * NWAVES;
    const int ja = lane & 7, hk = (lane >> 3) & 1, sub = lane >> 4;
    constexpr float L2T = 13.287712379549449f;
    float fa[2], gk[4][2];
#pragma unroll
    for (int e = 0; e < 2; ++e) fa[e] = fexp2(-(float)(2 * ja + e) * (L2T / 16.f));
#pragma unroll
    for (int q = 0; q < 4; ++q)
#pragma unroll
        for (int e = 0; e < 2; ++e) gk[q][e] = kg[q * 16 + 2 * ja + e];
    for (int m0 = gw * 4; m0 < M; m0 += NGW * 4) {
        const int m = m0 + sub, s = m & (T - 1); const float rid = (float)(s >> 6), cid = (float)(s & 63);
        float cra[2], sra[2], cca[2], sca[2];
#pragma unroll
        for (int e = 0; e < 2; ++e) { cra[e] = __cosf(rid * fa[e]); sra[e] = __sinf(rid * fa[e]); cca[e] = __cosf(cid * fa[e]); sca[e] = __sinf(cid * fa[e]); }
        unsigned* p = (unsigned*)(PROJ + (size_t)m * INW + C_KA + hk * 64 + 2 * ja); unsigned w[4]; float y[4][2]; float ss = 0.f;
#pragma unroll
        for (int q = 0; q < 4; ++q) { w[q] = p[q * 8]; y[q][0] = bflo(w[q]); y[q][1] = bfhi(w[q]); ss += y[q][0] * y[q][0] + y[q][1] * y[q][1]; }
        ss += shx<1>(ss); ss += shx<2>(ss); ss += shx<4>(ss);
        const float rs = frsq(ss * (1.f / 64.f) + EPS);
#pragma unroll
        for (int q = 0; q < 4; ++q) { y[q][0] *= rs * gk[q][0]; y[q][1] *= rs * gk[q][1]; }
        rope4(y, cra, sra, cca, sca, 1.0f, w);
#pragma unroll
        for (int q = 0; q < 4; ++q) p[q * 8] = w[q];
    }
}
__device__ __forceinline__ void p1b_rope(Frame& F, bf16* PROJ, bf16* PDST, const float* qg, const float* kg) {
    const int lane = F.lane, gw = F.vcu * NWAVES + F.wave, NGW = F.G * NWAVES;
    const int ja = lane & 7, jr = lane & 15;
    constexpr float L2T = 13.287712379549449f;
    float fa[2], fr[2], gq[4][2], gk[4][2];
#pragma unroll
    for (int e = 0; e < 2; ++e) { fa[e] = fexp2(-(float)(2 * ja + e) * (L2T / 16.f)); fr[e] = fexp2(-(float)(2 * jr + e) * (L2T / 32.f)); }
#pragma unroll
    for (int q = 0; q < 4; ++q)
#pragma unroll
        for (int e = 0; e < 2; ++e) { gq[q][e] = qg[q * 16 + 2 * ja + e]; gk[q][e] = kg[q * 16 + 2 * ja + e]; }
    for (int m = gw; m < M; m += NGW) {
        const int s = m & (T - 1); const float rid = (float)(s >> 6), cid = (float)(s & 63);
        float cra[2], sra[2], cca[2], sca[2], crr[2], srr[2], ccr[2], scr2[2];
#pragma unroll
        for (int e = 0; e < 2; ++e) { cra[e] = __cosf(rid * fa[e]); sra[e] = __sinf(rid * fa[e]); cca[e] = __cosf(cid * fa[e]); sca[e] = __sinf(cid * fa[e]);
                                      crr[e] = __cosf(rid * fr[e]); srr[e] = __sinf(rid * fr[e]); ccr[e] = __cosf(cid * fr[e]); scr2[e] = __sinf(cid * fr[e]); }
        bf16* row = PROJ + (size_t)m * INW; const size_t dd = (size_t)((const char*)PDST - (const char*)PROJ) / 4;
        {
            unsigned* p = (unsigned*)(row + C_QA + (lane >> 3) * 64 + 2 * ja); unsigned w[4]; float y[4][2]; float ss = 0.f;
#pragma unroll
            for (int q = 0; q < 4; ++q) { w[q] = p[q * 8]; y[q][0] = bflo(w[q]); y[q][1] = bfhi(w[q]); ss += y[q][0] * y[q][0] + y[q][1] * y[q][1]; }
            ss += shx<1>(ss); ss += shx<2>(ss); ss += shx<4>(ss);
            const float rs = frsq(ss * (1.f / 64.f) + EPS);
#pragma unroll
            for (int q = 0; q < 4; ++q) { y[q][0] *= rs * gq[q][0]; y[q][1] *= rs * gq[q][1]; }
            rope4(y, cra, sra, cca, sca, attn_body::C2, w);
#pragma unroll
            for (int q = 0; q < 4; ++q) p[dd + q * 8] = w[q];
        }
        {
            const int hk = (lane >> 3) & 1;
            unsigned* p = (unsigned*)(row + C_KA + hk * 64 + 2 * ja); unsigned w[4]; float y[4][2]; float ss = 0.f;
#pragma unroll
            for (int q = 0; q < 4; ++q) { w[q] = p[q * 8]; y[q][0] = bflo(w[q]); y[q][1] = bfhi(w[q]); ss += y[q][0] * y[q][0] + y[q][1] * y[q][1]; }
            ss += shx<1>(ss); ss += shx<2>(ss); ss += shx<4>(ss);
            const float rs = frsq(ss * (1.f / 64.f) + EPS);
#pragma unroll
            for (int q = 0; q < 4; ++q) { y[q][0] *= rs * gk[q][0]; y[q][1] *= rs * gk[q][1]; }
            rope4(y, cra, sra, cca, sca, 1.0f, w);
            if (lane < 16) {
#pragma unroll
                for (int q = 0; q < 4; ++q) p[dd + q * 8] = w[q]; }
        }
#pragma unroll
        for (int which = 0; which < 2; ++which) {
            unsigned* p = (unsigned*)(row + (which ? C_KR : C_QR) + (lane >> 4) * 128 + 2 * jr); unsigned w[4]; float y[4][2];
#pragma unroll
            for (int q = 0; q < 4; ++q) { w[q] = p[q * 16]; y[q][0] = bflo(w[q]); y[q][1] = bfhi(w[q]); }
            rope4(y, crr, srr, ccr, scr2, which ? 0.08838834764831845f : 1.0f, w);
#pragma unroll
            for (int q = 0; q < 4; ++q) p[dd + q * 16] = w[q];
        }
    }
}

__device__ __forceinline__ unsigned off_b(unsigned row, unsigned ch) { return 256u * row + 16u * (ch ^ (((row & 3) << 2) | ((row >> 2) & 3))); }
__device__ __forceinline__ bf16x8 rowread(const LAS unsigned char* tb, int rb, int s, int lane) {
    return *(const LAS bf16x8*)(tb + off_b(32 * rb + (lane & 31), 2 * s + (lane >> 5)));
}
__device__ __forceinline__ bf16x8 trread(const LAS unsigned char* tb, int c, int ks, int lane) {
    const unsigned h = lane >> 5, blk = (lane >> 4) & 1, q = (lane & 15) >> 2, p = lane & 3;
    const unsigned r0 = 16 * ks + 8 * h + q, ch = 4 * c + 2 * blk + (p >> 1);
    const s16x4 lo = __builtin_amdgcn_ds_read_tr16_b64_v4i16((LAS s16x4*)(tb + off_b(r0, ch) + 8 * (p & 1)));
    const s16x4 hi = __builtin_amdgcn_ds_read_tr16_b64_v4i16((LAS s16x4*)(tb + off_b(r0 + 4, ch) + 8 * (p & 1)));
    return (bf16x8){lo[0], lo[1], lo[2], lo[3], hi[0], hi[1], hi[2], hi[3]};
}
__device__ __forceinline__ int crow(int r, int hi) { return (r & 3) + 8 * (r >> 2) + 4 * hi; }
template <int MODE> __device__ __forceinline__ void stage_tile(LAS unsigned char* tb, const bf16* src, int pitch, int tid, float lg) {
#pragma unroll
    for (int i = 0; i < 4; ++i) { const int n = tid + NTHR * i, row = n >> 4, ch = n & 15;
        v4u v = *(const v4u*)(src + (size_t)row * pitch + ch * 8);
        if (MODE != 0) { const float f = fexp2((MODE == 1 ? (float)(127 - row) : (float)row) * lg);
            v.x = pkbf(bflo(v.x) * f, bfhi(v.x) * f); v.y = pkbf(bflo(v.y) * f, bfhi(v.y) * f); v.z = pkbf(bflo(v.z) * f, bfhi(v.z) * f); v.w = pkbf(bflo(v.w) * f, bfhi(v.w) * f); }
        *(LAS v4u*)(tb + off_b(row, ch)) = v; }
}
template <int NOUT> __device__ __forceinline__ void stage_rope_tile(LAS unsigned char* tb0, LAS unsigned char* tb1, const bf16* src, int pitch, int tid, int s0, float scale, float lgf, float lgb) {
    constexpr float L2T = 13.287712379549449f;
#pragma unroll 1
    for (int i2 = 0; i2 < 2; ++i2) { const int n = tid + NTHR * i2, row = n >> 3, cp = n & 7, c0 = (cp & 3) + ((cp >> 2) << 3);
        const bf16* rp = src + (size_t)row * pitch; const v4u va = *(const v4u*)(rp + c0 * 8), vb = *(const v4u*)(rp + (c0 + 4) * 8);
        const int s = s0 + row; const float pos = (cp & 4) ? (float)(s & 63) : (float)(s >> 6);
        const unsigned wa[4] = {va.x, va.y, va.z, va.w}, wb[4] = {vb.x, vb.y, vb.z, vb.w}; float oa[8], ob[8];
#pragma unroll
        for (int j = 0; j < 8; ++j) { const float fr = fexp2(-(float)(8 * (cp & 3) + j) * (L2T / 32.f)), ang = pos * fr, cs = __cosf(ang), sn = __sinf(ang);
            const float a = (j & 1) ? bfhi(wa[j >> 1]) : bflo(wa[j >> 1]), b = (j & 1) ? bfhi(wb[j >> 1]) : bflo(wb[j >> 1]);
            oa[j] = (a * cs - b * sn) * scale; ob[j] = (b * cs + a * sn) * scale; }
        if (NOUT == 1) {
            *(LAS v4u*)(tb0 + off_b(row, c0)) = (v4u){pkbf(oa[0], oa[1]), pkbf(oa[2], oa[3]), pkbf(oa[4], oa[5]), pkbf(oa[6], oa[7])};
            *(LAS v4u*)(tb0 + off_b(row, c0 + 4)) = (v4u){pkbf(ob[0], ob[1]), pkbf(ob[2], ob[3]), pkbf(ob[4], ob[5]), pkbf(ob[6], ob[7])};
        } else {
            const float ff = fexp2((float)(127 - row) * lgf), fb = fexp2((float)row * lgb);
            *(LAS v4u*)(tb0 + off_b(row, c0)) = (v4u){pkbf(oa[0] * ff, oa[1] * ff), pkbf(oa[2] * ff, oa[3] * ff), pkbf(oa[4] * ff, oa[5] * ff), pkbf(oa[6] * ff, oa[7] * ff)};
            *(LAS v4u*)(tb0 + off_b(row, c0 + 4)) = (v4u){pkbf(ob[0] * ff, ob[1] * ff), pkbf(ob[2] * ff, ob[3] * ff), pkbf(ob[4] * ff, ob[5] * ff), pkbf(ob[6] * ff, ob[7] * ff)};
            *(LAS v4u*)(tb1 + off_b(row, c0)) = (v4u){pkbf(oa[0] * fb, oa[1] * fb), pkbf(oa[2] * fb, oa[3] * fb), pkbf(oa[4] * fb, oa[5] * fb), pkbf(oa[6] * fb, oa[7] * fb)};
            *(LAS v4u*)(tb1 + off_b(row, c0 + 4)) = (v4u){pkbf(ob[0] * fb, ob[1] * fb), pkbf(ob[2] * fb, ob[3] * fb), pkbf(ob[4] * fb, ob[5] * fb), pkbf(ob[6] * fb, ob[7] * fb)};
        } }
}
__device__ __forceinline__ void rope_load(v4u (&raw)[2][2], const bf16* src, int pitch, int tid) {
#pragma unroll
    for (int i2 = 0; i2 < 2; ++i2) { const int n = tid + NTHR * i2, row = n >> 3, cp = n & 7, c0 = (cp & 3) + ((cp >> 2) << 3);
        const bf16* rp = src + (size_t)row * pitch; raw[i2][0] = *(const v4u*)(rp + c0 * 8); raw[i2][1] = *(const v4u*)(rp + (c0 + 4) * 8); }
}
template <int NOUT> __device__ __forceinline__ void rope_store(LAS unsigned char* tb0, LAS unsigned char* tb1, const v4u (&raw)[2][2], int tid, int s0, float scale, float lgf, float lgb) {
    constexpr float L2T = 13.287712379549449f;
#pragma unroll
    for (int i2 = 0; i2 < 2; ++i2) { __builtin_amdgcn_sched_barrier(0);
        const int n = tid + NTHR * i2, row = n >> 3, cp = n & 7, c0 = (cp & 3) + ((cp >> 2) << 3);
        const v4u va = raw[i2][0], vb = raw[i2][1];
        const int s = s0 + row; const float pos = (cp & 4) ? (float)(s & 63) : (float)(s >> 6);
        const unsigned wa[4] = {va.x, va.y, va.z, va.w}, wb[4] = {vb.x, vb.y, vb.z, vb.w}; float oa[8], ob[8];
#pragma unroll
        for (int j = 0; j < 8; ++j) { const float fr = fexp2(-(float)(8 * (cp & 3) + j) * (L2T / 32.f)), ang = pos * fr, cs = __cosf(ang), sn = __sinf(ang);
            const float a = (j & 1) ? bfhi(wa[j >> 1]) : bflo(wa[j >> 1]), b = (j & 1) ? bfhi(wb[j >> 1]) : bflo(wb[j >> 1]);
            oa[j] = (a * cs - b * sn) * scale; ob[j] = (b * cs + a * sn) * scale; }
        if (NOUT == 1) {
            *(LAS v4u*)(tb0 + off_b(row, c0)) = (v4u){pkbf(oa[0], oa[1]), pkbf(oa[2], oa[3]), pkbf(oa[4], oa[5]), pkbf(oa[6], oa[7])};
            *(LAS v4u*)(tb0 + off_b(row, c0 + 4)) = (v4u){pkbf(ob[0], ob[1]), pkbf(ob[2], ob[3]), pkbf(ob[4], ob[5]), pkbf(ob[6], ob[7])};
        } else {
            const float ff = fexp2((float)(127 - row) * lgf), fb = fexp2((float)row * lgb);
            *(LAS v4u*)(tb0 + off_b(row, c0)) = (v4u){pkbf(oa[0] * ff, oa[1] * ff), pkbf(oa[2] * ff, oa[3] * ff), pkbf(oa[4] * ff, oa[5] * ff), pkbf(oa[6] * ff, oa[7] * ff)};
            *(LAS v4u*)(tb0 + off_b(row, c0 + 4)) = (v4u){pkbf(ob[0] * ff, ob[1] * ff), pkbf(ob[2] * ff, ob[3] * ff), pkbf(ob[4] * ff, ob[5] * ff), pkbf(ob[6] * ff, ob[7] * ff)};
            *(LAS v4u*)(tb1 + off_b(row, c0)) = (v4u){pkbf(oa[0] * fb, oa[1] * fb), pkbf(oa[2] * fb, oa[3] * fb), pkbf(oa[4] * fb, oa[5] * fb), pkbf(oa[6] * fb, oa[7] * fb)};
            *(LAS v4u*)(tb1 + off_b(row, c0 + 4)) = (v4u){pkbf(ob[0] * fb, ob[1] * fb), pkbf(ob[2] * fb, ob[3] * fb), pkbf(ob[4] * fb, ob[5] * fb), pkbf(ob[6] * fb, ob[7] * fb)};
        } }
}
__device__ __forceinline__ void vtile_load(v4u (&raw)[4], const bf16* src, int pitch, int tid) {
#pragma unroll
    for (int i = 0; i < 4; ++i) { const int n = tid + NTHR * i, row = n >> 4, ch = n & 15; raw[i] = *(const v4u*)(src + (size_t)row * pitch + ch * 8); }
}
__device__ __forceinline__ void vtile_store(LAS unsigned char* tb, const v4u (&raw)[4], int tid) {
#pragma unroll
    for (int i = 0; i < 4; ++i) { const int n = tid + NTHR * i, row = n >> 4, ch = n & 15; *(LAS v4u*)(tb + off_b(row, ch)) = raw[i]; }
}
__device__ __forceinline__ void r1_states(Frame& F, const bf16* PROJ, bf16* U, const float* dec_f, const float* dec_b) {
    LAS unsigned char* TKf = F.lds, *TKb = F.lds + 32768, *TV = F.lds + 65536;
    const int lane = F.lane, w = F.wave, hi = lane >> 5, mb = w & 3, nb0 = 2 * (w >> 2);
    for (int u = F.vcu; u < RUNITS; u += F.G) {
        const int b = u >> 8, h = (u >> 6) & 3, c = u & 63;
        const float lgf = dec_f[h] * LOG2E, lgb = dec_b[h] * LOG2E;
        const bf16* base = PROJ + ((size_t)b * T + (size_t)c * RCH) * INW + h * 128;
        { v4u rk[2][2], rv[4]; rope_load(rk, base + C_KR, INW, F.tid); vtile_load(rv, base + C_VR, INW, F.tid);
          rope_store<2>(TKf, TKb, rk, F.tid, c * RCH, 0.08838834764831845f, lgf, lgb);
          vtile_store(TV, rv, F.tid); }
        __syncthreads();
        f32x16 acc[2][2];
#pragma unroll
        for (int d = 0; d < 2; ++d)
#pragma unroll
            for (int n = 0; n < 2; ++n) acc[d][n] = (f32x16){};
#pragma unroll 2
        for (int ks = 0; ks < 8; ++ks) {
            const bf16x8 a = trread(TV, mb, ks, lane);
#pragma unroll
            for (int n = 0; n < 2; ++n) { const bf16x8 bf = trread(TKf, nb0 + n, ks, lane), bb = trread(TKb, nb0 + n, ks, lane);
                acc[0][n] = __builtin_amdgcn_mfma_f32_32x32x16_bf16(bf, a, acc[0][n], 0, 0, 0);
                acc[1][n] = __builtin_amdgcn_mfma_f32_32x32x16_bf16(bb, a, acc[1][n], 0, 0, 0); }
        }
#pragma unroll
        for (int d = 0; d < 2; ++d)
#pragma unroll
            for (int n = 0; n < 2; ++n) { bf16* o = U + ((size_t)u * 2 + d) * 16384 + (size_t)(32 * mb + (lane & 31)) * 128 + 32 * (nb0 + n) + 4 * hi;
#pragma unroll
                for (int g = 0; g < 4; ++g) { u32x2 w; w.x = pkbf(acc[d][n][4 * g], acc[d][n][4 * g + 1]); w.y = pkbf(acc[d][n][4 * g + 2], acc[d][n][4 * g + 3]); *(u32x2*)(o + 8 * g) = w; } }
        __syncthreads();
    }
}
__device__ __forceinline__ void r2_scan(Frame& F, const bf16* __restrict__ U, bf16* __restrict__ FT, const float* dec_f, const float* dec_b) {
    for (int task = blockIdx.x * NTHR + F.tid; task < BATCH * RH * 4096; task += F.G * NTHR) {
        const int bh = task >> 12, e4 = task & 4095, h = bh & 3;
        const float df = __expf(dec_f[h] * 128.f), db = __expf(dec_b[h] * 128.f);
        f32x4 s = (f32x4){0.f, 0.f, 0.f, 0.f};
#pragma unroll 8
        for (int c = 0; c < NCH; ++c) { const size_t idx = (((size_t)bh * NCH + c) * 2 + 0) * 16384 + 4 * e4;
            u32x2 w; w.x = pkbf(s.x, s.y); w.y = pkbf(s.z, s.w); *(u32x2*)(FT + idx) = w;
            { const u32x2 uw = *(const u32x2*)(U + idx); s = s * df + (f32x4){bflo(uw.x), bfhi(uw.x), bflo(uw.y), bfhi(uw.y)}; } }
        s = (f32x4){0.f, 0.f, 0.f, 0.f};
#pragma unroll 8
        for (int c = NCH - 1; c >= 0; --c) { const size_t idx = (((size_t)bh * NCH + c) * 2 + 1) * 16384 + 4 * e4;
            u32x2 w; w.x = pkbf(s.x, s.y); w.y = pkbf(s.z, s.w); *(u32x2*)(FT + idx) = w;
            { const u32x2 uw = *(const u32x2*)(U + idx); s = s * db + (f32x4){bflo(uw.x), bfhi(uw.x), bflo(uw.y), bfhi(uw.y)}; } }
    }
}
__device__ __forceinline__ void r3_out(Frame& F, const bf16* PROJ, const bf16* FT, bf16* CAT, const float* dec_f, const float* dec_b, const float* gn_g, const float* gn_b) {
    LAS unsigned char* TQ = F.lds, *TK = F.lds + 32768, *TV = F.lds + 65536, *TP = F.lds + 98304;
    LAS float* OT = (LAS float*)F.lds;
    const int w = F.wave, wb = w & 3, wp0 = 2 * (w >> 2);
    for (int u = F.vcu; u < RUNITS; u += F.G) {
        int lane = F.lane, tid_u = F.tid; asm volatile("" : "+v"(lane), "+v"(tid_u));
        const int hi = lane >> 5, l31 = lane & 31;
        const int b = u >> 8, h = (u >> 6) & 3, c = u & 63;
        const float lgf = dec_f[h] * LOG2E, lgb = dec_b[h] * LOG2E;
        const size_t m0 = (size_t)b * T + (size_t)c * RCH;
        const bf16* base = PROJ + m0 * INW + h * 128;
        const int gi = tid_u >> 2, gqd = tid_u & 3, gcol = h * 128 + 32 * gqd;
        const bf16* gp = PROJ + (m0 + gi) * INW + C_GR + gcol;
        v4u gw[4];
#pragma unroll
        for (int k2 = 0; k2 < 4; ++k2) gw[k2] = *(const v4u*)(gp + 8 * k2);
        bf16x8 cf[4][2], cb[4][2];
        const bf16* ftf = FT + ((size_t)u * 2 + 0) * 16384 + (size_t)(32 * wp0 + l31) * 128 + 8 * hi;
#pragma unroll
        for (int s = 0; s < 4; ++s)
#pragma unroll
            for (int n = 0; n < 2; ++n) { cf[s][n] = *(const bf16x8*)(ftf + n * 32 * 128 + 16 * s); cb[s][n] = *(const bf16x8*)(ftf + 16384 + n * 32 * 128 + 16 * s); }
        { v4u rq[2][2], rk[2][2], rv[4];
          rope_load(rq, base + C_QR, INW, tid_u); rope_load(rk, base + C_KR, INW, tid_u); vtile_load(rv, base + C_VR, INW, tid_u);
          __builtin_amdgcn_sched_barrier(0);
          rope_store<1>(TQ, TQ, rq, tid_u, c * RCH, 1.0f, 0.f, 0.f);
          rope_store<1>(TK, TK, rk, tid_u, c * RCH, 0.08838834764831845f, 0.f, 0.f);
          __builtin_amdgcn_sched_barrier(0);
          vtile_store(TV, rv, tid_u); }
        __syncthreads();
        {
            f32x16 st[2]; st[0] = (f32x16){}; st[1] = (f32x16){};
#pragma unroll 1
            for (int s = 0; s < 8; ++s) { const bf16x8 a = rowread(TK, wb, s, lane);
#pragma unroll
                for (int n = 0; n < 2; ++n) st[n] = __builtin_amdgcn_mfma_f32_32x32x16_bf16(a, rowread(TQ, wp0 + n, s, lane), st[n], 0, 0, 0); }
#pragma unroll
            for (int n = 0; n < 2; ++n) { const int i = 32 * (wp0 + n) + l31; __builtin_amdgcn_sched_barrier(0);
#pragma unroll
                for (int g = 0; g < 4; ++g) { float p[4];
#pragma unroll
                    for (int q = 0; q < 4; ++q) { const int j = 32 * wb + 8 * g + 4 * hi + q; const float fd = (float)(i - j);
                        const float mk = fexp2(fmaxf(fd, 0.f) * lgf + fmaxf(-fd, 0.f) * lgb) + fmaxf(1.0f - fabsf(fd), 0.f);
                        p[q] = st[n][4 * g + q] * mk; }
                    u32x2 pw; pw.x = pkbf(p[0], p[1]); pw.y = pkbf(p[2], p[3]);
                    *(LAS u32x2*)(TP + off_b(i, 4 * wb + g) + 8 * hi) = pw; } }
        }
        __syncthreads();
        f32x16 ao[2];
#pragma unroll
        for (int n = 0; n < 2; ++n) ao[n] = (f32x16){};
        {
            const float xf = fexp2((float)(32 * wb + l31 + 1) * lgf), xb = fexp2((float)(128 - 32 * wb - l31) * lgb);
#pragma unroll
            for (int s = 0; s < 8; ++s) { __builtin_amdgcn_sched_barrier(0); const bf16x8 ap = rowread(TP, wb, s, lane); const v4u aq = *(const LAS v4u*)(TQ + off_b(32 * wb + l31, 2 * s + hi));
                v4u qf, qb;
                qf.x = pkbf(bflo(aq.x) * xf, bfhi(aq.x) * xf); qf.y = pkbf(bflo(aq.y) * xf, bfhi(aq.y) * xf); qf.z = pkbf(bflo(aq.z) * xf, bfhi(aq.z) * xf); qf.w = pkbf(bflo(aq.w) * xf, bfhi(aq.w) * xf);
                qb.x = pkbf(bflo(aq.x) * xb, bfhi(aq.x) * xb); qb.y = pkbf(bflo(aq.y) * xb, bfhi(aq.y) * xb); qb.z = pkbf(bflo(aq.z) * xb, bfhi(aq.z) * xb); qb.w = pkbf(bflo(aq.w) * xb, bfhi(aq.w) * xb);
                const bf16x8 aqf = __builtin_bit_cast(bf16x8, qf), aqb = __builtin_bit_cast(bf16x8, qb);
#pragma unroll
                for (int n = 0; n < 2; ++n) {
                    ao[n] = __builtin_amdgcn_mfma_f32_32x32x16_bf16(ap, trread(TV, wp0 + n, s, lane), ao[n], 0, 0, 0);
                    ao[n] = __builtin_amdgcn_mfma_f32_32x32x16_bf16(aqf, cf[s & 3][n], ao[n], 0, 0, 0);
                    ao[n] = __builtin_amdgcn_mfma_f32_32x32x16_bf16(aqb, cb[s & 3][n], ao[n], 0, 0, 0); }
                if (s < 4) {
#pragma unroll
                    for (int n = 0; n < 2; ++n) { cf[s][n] = *(const bf16x8*)(ftf + n * 32 * 128 + 16 * (s + 4)); cb[s][n] = *(const bf16x8*)(ftf + 16384 + n * 32 * 128 + 16 * (s + 4)); } } }
        }
        __syncthreads();
#pragma unroll
        for (int r = 0; r < 16; ++r) { const int i = 32 * wb + crow(r, hi);
#pragma unroll
            for (int n = 0; n < 2; ++n) OT[i * 132 + 32 * (wp0 + n) + l31] = ao[n][r]; }
        __syncthreads();
        {
            const int i = tid_u >> 2, qd = tid_u & 3;
            f32x4 v[8]; float s1 = 0.f, s2 = 0.f;
#pragma unroll
            for (int k = 0; k < 8; ++k) { v[k] = *(const LAS f32x4*)(OT + i * 132 + 32 * qd + 4 * k); s1 += (v[k].x + v[k].y) + (v[k].z + v[k].w);
                s2 += (v[k].x * v[k].x + v[k].y * v[k].y) + (v[k].z * v[k].z + v[k].w * v[k].w); }
            s1 += shx<1>(s1); s1 += shx<2>(s1); s2 += shx<1>(s2); s2 += shx<2>(s2);
            const float mu = s1 * (1.f / 128.f), var = fmaxf(s2 * (1.f / 128.f) - mu * mu, 0.f), rs = frsq(var + EPS);
            const int col = h * 128 + 32 * qd;
            unsigned char* op = (unsigned char*)CAT + (m0 + i) * D + 512 + col;
#pragma unroll
            for (int k2 = 0; k2 < 4; ++k2) { __builtin_amdgcn_sched_barrier(0); const v4u gw4 = gw[k2]; const unsigned gwv[4] = {gw4.x, gw4.y, gw4.z, gw4.w}; float o[8];
#pragma unroll
                for (int q = 0; q < 8; ++q) { const int cc = 8 * k2 + q; const float x = v[cc >> 2][cc & 3];
                    const float y = (x - mu) * rs * gn_g[col + cc] + gn_b[col + cc];
                    const float gt = (q & 1) ? bfhi(gwv[q >> 1]) : bflo(gwv[q >> 1]);
                    o[q] = y * gt * frcp(1.0f + __expf(-gt)); }
#pragma unroll
                for (int q = 0; q < 8; ++q) o[q] = __builtin_amdgcn_fmed3f(o[q] * CAT_S_RET, -448.0f, 448.0f);
                unsigned w0 = 0u, w1 = 0u;
                w0 = __builtin_amdgcn_cvt_pk_fp8_f32(o[0], o[1], w0, false); w0 = __builtin_amdgcn_cvt_pk_fp8_f32(o[2], o[3], w0, true);
                w1 = __builtin_amdgcn_cvt_pk_fp8_f32(o[4], o[5], w1, false); w1 = __builtin_amdgcn_cvt_pk_fp8_f32(o[6], o[7], w1, true);
                *(u32x2*)(op + 8 * k2) = (u32x2){w0, w1}; }
        }
        __syncthreads();
    }
}

#if defined(ATTN_PROBE)
__device__ __forceinline__ void attn_check(Frame& F, const bf16* PROJ, const bf16* CAT, gu32* flag, const float* qg) {
    const int lane = F.lane, s = F.vcu * NWAVES + F.wave;
    const int b = s & 7, h = (s >> 3) & 7, qpos = (s * 977 + 131) & (T - 1), kvh = h >> 2;
    const bf16* qrow = PROJ + ((size_t)b * T + qpos) * INW + C_QA + h * 64;
    float qf[64], o[64];
    {
        const float raw = __uint_as_float((unsigned)qrow[lane] << 16);
        const float ss = wave_sum(raw * raw), y = raw * (1.0f / sqrtf(ss * (1.f / 64.f) + 1e-6f)) * qg[lane];
        const int quarter = lane >> 4, i = lane & 15; const float partner = shx<16>(y);
        const float invf = exp2f(-(float)i * (13.287712379549449f / 16.f)), ang = ((quarter < 2) ? (float)(qpos >> 6) : (float)(qpos & 63)) * invf;
        const float cs = __cosf(ang), sn = __sinf(ang);
        const float rot = (quarter & 1) ? (y * cs + partner * sn) : (y * cs - partner * sn);
        const float qv = rot * (0.125f * 1.4426950408889634f);
#pragma unroll
        for (int d = 0; d < 64; ++d) qf[d] = __int_as_float(bcastl(__float_as_int(qv), d));
    }
#pragma unroll
    for (int d = 0; d < 64; ++d) o[d] = 0.f;
    float m = -1e30f, l = 0.f;
    for (int i = 0; i < T / 64; ++i) {
        const size_t krow = ((size_t)b * T + i * 64 + lane) * INW;
        const bf16* kp = PROJ + krow + C_KA + kvh * 64; const bf16* vp = PROJ + krow + C_VA + kvh * 64;
        float sc = 0.f;
#pragma unroll
        for (int c = 0; c < 8; ++c) { const v4u w = *(const v4u*)(kp + 8 * c);
            sc += qf[8 * c + 0] * bflo(w.x) + qf[8 * c + 1] * bfhi(w.x) + qf[8 * c + 2] * bflo(w.y) + qf[8 * c + 3] * bfhi(w.y) + qf[8 * c + 4] * bflo(w.z) + qf[8 * c + 5] * bfhi(w.z) + qf[8 * c + 6] * bflo(w.w) + qf[8 * c + 7] * bfhi(w.w); }
        const float mn = fmaxf(m, sc), fs = fexp2(m - mn), p = fexp2(sc - mn);
        l = l * fs + p; m = mn;
#pragma unroll
        for (int c = 0; c < 8; ++c) { const v4u w = *(const v4u*)(vp + 8 * c);
            o[8 * c + 0] = o[8 * c + 0] * fs + p * bflo(w.x); o[8 * c + 1] = o[8 * c + 1] * fs + p * bfhi(w.x); o[8 * c + 2] = o[8 * c + 2] * fs + p * bflo(w.y); o[8 * c + 3] = o[8 * c + 3] * fs + p * bfhi(w.y);
            o[8 * c + 4] = o[8 * c + 4] * fs + p * bflo(w.z); o[8 * c + 5] = o[8 * c + 5] * fs + p * bfhi(w.z); o[8 * c + 6] = o[8 * c + 6] * fs + p * bflo(w.w); o[8 * c + 7] = o[8 * c + 7] * fs + p * bfhi(w.w); }
    }
    float mm = m;
    mm = wmax64(mm);
    const float f = fexp2(m - mm); const float L = wave_sum(l * f);
    float mine = 0.f;
#pragma unroll
    for (int d = 0; d < 64; ++d) { const float od = wave_sum(o[d] * f) / L; if (lane == d) mine = od; }
    const unsigned short cw = CAT[((size_t)b * T + qpos) * D + h * 64 + lane];
    const float got = __uint_as_float((unsigned)cw << 16);
    const float E = wave_sum((mine - got) * (mine - got)), R = wave_sum(mine * mine);
    if (!(E <= 4e-4f * R) && lane == 0) __hip_atomic_store(flag, 1u, RLX_AGENT);
}
__device__ __forceinline__ void ka_expect(Frame& F, const bf16* PROJ, float* EXP, const float* kg) {
    const int lane = F.lane, s = F.vcu * NWAVES + F.wave, m = (s * 40503 + 77) & (M - 1), pos = m & (T - 1);
    for (int hk = 0; hk < 2; ++hk) {
        const float raw = __uint_as_float((unsigned)PROJ[(size_t)m * INW + C_KA + hk * 64 + lane] << 16);
        const float ss = wave_sum(raw * raw), y = raw * (1.0f / sqrtf(ss * (1.f / 64.f) + 1e-6f)) * kg[lane];
        const int quarter = lane >> 4, i = lane & 15; const float partner = shx<16>(y);
        const float invf = exp2f(-(float)i * (13.287712379549449f / 16.f)), ang = ((quarter < 2) ? (float)(pos >> 6) : (float)(pos & 63)) * invf;
        const float cs = __cosf(ang), sn = __sinf(ang);
        EXP[(size_t)s * 128 + hk * 64 + lane] = (quarter & 1) ? (y * cs + partner * sn) : (y * cs - partner * sn);
    }
}
__device__ __forceinline__ void ka_compare(Frame& F, const bf16* PROJ, const float* EXP, gu32* flag) {
    const int lane = F.lane, s = F.vcu * NWAVES + F.wave, m = (s * 40503 + 77) & (M - 1);
    float E = 0.f, R = 0.f;
    for (int hk = 0; hk < 2; ++hk) { const float got = __uint_as_float((unsigned)PROJ[(size_t)m * INW + C_KA + hk * 64 + lane] << 16), ex = EXP[(size_t)s * 128 + hk * 64 + lane];
        E += (got - ex) * (got - ex); R += ex * ex; }
    E = wave_sum(E); R = wave_sum(R);
    if (!(E <= 1e-4f * R) && lane == 0) __hip_atomic_store(flag, 1u, RLX_AGENT);
}
#endif

typedef _Float16 f16x8 __attribute__((ext_vector_type(8)));
typedef _Float16 f16x4 __attribute__((ext_vector_type(4)));
template <bool X16, bool XIN16 = false> __device__ __forceinline__ void p3b_postmix(Frame& F, const float* xin, float* xout, const bf16* YM, signed char* HQ, float* hs, const float* mod_l,
                                            const float* post_g, const float* pre_g, const float* rw, const float* rb, int* topi, float* topw, gu32* cnt_g) {
    const int lane = F.lane, gw = F.vcu * NWAVES + F.wave, NGW = F.G * NWAVES;
    LAS unsigned char* WT = F.lds;
    LAS unsigned char* AT = F.lds + 65536 + F.wave * 8192;
    LAS unsigned* lcnt = (LAS unsigned*)(F.lds + LCNT_OFF);
#pragma unroll
    for (int i = 0; i < 16; ++i) { const int n = F.tid + NTHR * i, k = n >> 3, e0 = (n & 7) * 4; const f32x4 v = *(const f32x4*)(rw + (size_t)k * NE + e0);
#pragma unroll
        for (int q = 0; q < 4; ++q) { const int e = e0 + q; *(LAS _Float16*)(WT + e * 2048 + (((k >> 3) ^ (e & 15)) << 4) + (k & 7) * 2) = (_Float16)v[q]; } }
    if (F.tid < 32) lcnt[F.tid] = 0u;
    LAS float* GL = (LAS float*)(F.lds + GAIN_OFF);
    { const f32x4 g0 = ((const f32x4*)post_g)[F.tid & 255], g1 = ((const f32x4*)pre_g)[F.tid & 255]; if (F.tid < 256) { ((LAS f32x4*)GL)[F.tid] = g0; ((LAS f32x4*)(GL + D))[F.tid] = g1; } }
    __syncthreads();
    const float rbias = rb[lane & 31];
    const int ar = lane & 3, kg = lane >> 4, be = lane & 15;
    for (int ch = gw; ch < M / 32; ch += NGW) { const int mb = ch * 32;
        const float* modb = mod_l + (size_t)(mb >> 13) * (6 * D);
        f32x4 gpv[4], gsv[4], shv[4];
#pragma unroll
        for (int j = 0; j < 4; ++j) { const f32x4 gm = ((const f32x4*)(modb + 2 * D))[lane + 64 * j], sc = ((const f32x4*)(modb + 4 * D))[lane + 64 * j]; shv[j] = ((const f32x4*)(modb + 3 * D))[lane + 64 * j];
            gpv[j] = gm * ((const LAS f32x4*)GL)[lane + 64 * j]; gsv[j] = ((const LAS f32x4*)(GL + D))[lane + 64 * j] * (sc + 1.0f); }
        u32x2 ywA[2][4], ywB[2][4]; f32x4 xrA[2][4], xrB[2][4];
#define P3B_ISSUE(YW, XR, t0) do { _Pragma("unroll") for (int rr = 0; rr < 2; ++rr) { const u32x2* yr = (const u32x2*)(YM + (size_t)(mb + (t0) + rr) * D) + lane; \
            _Pragma("unroll") for (int j = 0; j < 4; ++j) YW[rr][j] = yr[64 * j]; \
            if constexpr (XIN16) { const u32x2* xq = (const u32x2*)((const bf16*)xin + (size_t)(mb + (t0) + rr) * D) + lane; _Pragma("unroll") for (int j = 0; j < 4; ++j) { const u32x2 w = xq[64 * j]; XR[rr][j].x = __uint_as_float(w.x); XR[rr][j].y = __uint_as_float(w.y); } } \
            else load_row_f32(xin + (size_t)(mb + (t0) + rr) * D, XR[rr], lane); } } while (0)
#define P3B_PROC(YW, XR, t0, RB) do { _Pragma("unroll") for (int rr = 0; rr < 2; ++rr) { const int m = mb + (t0) + rr, r = (RB) + rr; \
            f32x4 y[4], x[4], hf[4]; \
            _Pragma("unroll") for (int j = 0; j < 4; ++j) { const u32x2 w = YW[rr][j]; y[j] = (f32x4){bflo(w.x), bfhi(w.x), bflo(w.y), bfhi(w.y)}; \
                if constexpr (XIN16) { const unsigned xa = __float_as_uint(XR[rr][j].x), xb = __float_as_uint(XR[rr][j].y); x[j] = (f32x4){bflo(xa), bfhi(xa), bflo(xb), bfhi(xb)}; } else x[j] = XR[rr][j]; } \
            const float rsy = row_rstd(y); \
            _Pragma("unroll") for (int j = 0; j < 4; ++j) { x[j] = x[j] + gpv[j] * (y[j] * rsy); if constexpr (!X16) ((f32x4*)(xout + (size_t)m * D))[lane + 64 * j] = x[j]; } \
            if constexpr (X16) store_row_bf16((bf16*)xout + (size_t)m * D, x, lane); \
            { const float rs = row_rstd(x); _Pragma("unroll") for (int j = 0; j < 4; ++j) hf[j] = x[j] * rs * gsv[j] + shv[j]; } \
            store_row_i8(HQ + (size_t)m * D, hs + m, hf, lane);                    \
            _Pragma("unroll") for (int j = 0; j < 4; ++j) { const int c = (lane >> 1) + 32 * j;        \
                *(LAS f16x4*)(AT + r * 2048 + ((c ^ (r << 2)) << 4) + 8 * (lane & 1)) = (f16x4){(_Float16)hf[j].x, (_Float16)hf[j].y, (_Float16)hf[j].z, (_Float16)hf[j].w}; } } } while (0)
        P3B_ISSUE(ywA, xrA, 0);
#pragma unroll 1
        for (int it = 0; it < 8; ++it) { const int m0 = mb + 4 * it;
        P3B_ISSUE(ywB, xrB, 4 * it + 2);
        P3B_PROC(ywA, xrA, 4 * it, 0);
        if (it < 7) P3B_ISSUE(ywA, xrA, 4 * it + 4);
        P3B_PROC(ywB, xrB, 4 * it + 2, 2);
        f32x4 la = (f32x4){0.f, 0.f, 0.f, 0.f}, lb = (f32x4){0.f, 0.f, 0.f, 0.f};
#pragma unroll 8
        for (int s = 0; s < 32; ++s) { const int c = 4 * s + kg;
            const f16x8 a = *(const LAS f16x8*)(AT + ar * 2048 + ((c ^ (ar << 2)) << 4));
            const f16x8 b0 = *(const LAS f16x8*)(WT + be * 2048 + ((c ^ be) << 4)), b1 = *(const LAS f16x8*)(WT + (16 + be) * 2048 + ((c ^ be) << 4));
            la = __builtin_amdgcn_mfma_f32_16x16x32_f16(a, b0, la, 0, 0, 0); lb = __builtin_amdgcn_mfma_f32_16x16x32_f16(a, b1, lb, 0, 0, 0); }
        const bool upper = (lane & 32) != 0, blk = (lane & 16) != 0;
#pragma unroll
        for (int pr = 0; pr < 2; ++pr) {
            const float lo_ = blk ? lb[pr] : la[pr], up_ = blk ? lb[pr + 2] : la[pr + 2];
            const float logit = (upper ? up_ : lo_) + rbias;
            const int m = m0 + pr + (upper ? 2 : 0);
            bool taken = false; float tv[TOPK]; int ti[TOPK];
#pragma unroll
            for (int k = 0; k < TOPK; ++k) { float bv = taken ? -INFINITY : logit; int bi = lane & 31;
#define MX_STEP(o) { const float ov = shx<(o)>(bv); const int oi = shxi<(o)>(bi); const bool tk = (ov > bv) || (ov == bv && oi < bi); bv = tk ? ov : bv; bi = tk ? oi : bi; }
                MX_STEP(16) MX_STEP(8) MX_STEP(4) MX_STEP(2) MX_STEP(1)
#undef MX_STEP
                tv[k] = bv; ti[k] = bi; if ((lane & 31) == bi) taken = true; }
            const float e1 = __expf(tv[1] - tv[0]), e2 = __expf(tv[2] - tv[0]), e3 = __expf(tv[3] - tv[0]), inv = frcp(1.0f + e1 + e2 + e3);
            if ((lane & 31) == 0) { *(i32x4*)(topi + (size_t)m * 4) = (i32x4){ti[0], ti[1], ti[2], ti[3]}; *(f32x4*)(topw + (size_t)m * 4) = (f32x4){inv, e1 * inv, e2 * inv, e3 * inv}; }
            if (taken) atomicAdd((unsigned*)(lcnt + (lane & 31)), 1u);
        }
        }
#undef P3B_ISSUE
#undef P3B_PROC
    }
    __syncthreads();
    if (F.tid < 32) { const unsigned c = lcnt[F.tid]; if (c) __hip_atomic_fetch_add(cnt_g + F.tid, c, RLX_AGENT); }
}
__device__ __forceinline__ void p4a_route(Frame& F, const float* hs, int* rmap, float* xsc, const int* topi, int* pos, gu32* cnt_g, gu32* cur_g) {
    const int gw = F.vcu * NWAVES + F.wave, NGW = F.G * NWAVES;
    LAS int* ts = (LAS int*)(F.lds + LTS_OFF);
    if (F.tid == 0) { int a = 0; for (int e = 0; e < NE; ++e) { ts[e] = a; a += (int)((__hip_atomic_load(cnt_g + e, RLX_AGENT) + 255u) >> 8); } ts[NE] = a; }
    __syncthreads();
    const int lane = F.lane;
    if (gw < NE) {
        const int c = (int)__hip_atomic_load(cnt_g + gw, RLX_AGENT), p0 = ts[gw] * 256 + c, p1 = ts[gw + 1] * 256;
        for (int p = p0 + lane; p < p1; p += 64) rmap[p] = 0;
    }
    for (int base = gw * 64; base < M; base += NGW * 64) {
        const int tok = base + lane; const i32x4 id = *(const i32x4*)(topi + (size_t)tok * 4);
        unsigned mycnt = 0u;
#pragma unroll 1
        for (int e = 0; e < NE; ++e) { const unsigned long long mk = __ballot(id.x == e || id.y == e || id.z == e || id.w == e); if (lane == e) mycnt = (unsigned)__popcll(mk); }
        unsigned mybase = 0u;
        if (lane < NE && mycnt) mybase = __hip_atomic_fetch_add(cur_g + lane, mycnt, RLX_AGENT);
        i32x4 ps = (i32x4){0, 0, 0, 0};
#pragma unroll 1
        for (int e = 0; e < NE; ++e) { const bool has = (id.x == e || id.y == e || id.z == e || id.w == e); const unsigned long long mk = __ballot(has);
            const int p = ts[e] * 256 + bcastl((int)mybase, e) + (int)__builtin_amdgcn_mbcnt_hi((unsigned)(mk >> 32), __builtin_amdgcn_mbcnt_lo((unsigned)mk, 0u));
            if (id.x == e) ps.x = p; if (id.y == e) ps.y = p; if (id.z == e) ps.z = p; if (id.w == e) ps.w = p; }
        *(i32x4*)(pos + (size_t)tok * 4) = ps;
        { const float sc = hs[tok]; xsc[ps.x] = sc; xsc[ps.y] = sc; xsc[ps.z] = sc; xsc[ps.w] = sc; rmap[ps.x] = tok; rmap[ps.y] = tok; rmap[ps.z] = tok; rmap[ps.w] = tok; }
    }
}
template <bool Y_F8, bool X16, bool XOUT16 = false> __device__ __forceinline__ void p5b_combine(Frame& F, const float* xin, float* xout, const bf16* Y,
                                            const int* pos, const float* topw, const float* mod_l, const float* post_g,
                                            bool has_next, const float* mod_n, const float* pre_g_n, signed char* HQ, float* hs) {
    const int lane = F.lane, gw = F.vcu * NWAVES + F.wave, NGW = F.G * NWAVES;
    for (int ch = gw; ch < M / 32; ch += NGW) { const int mb = ch * 32;
        const float* modb = mod_l + (size_t)(mb >> 13) * (6 * D); const float* modn = mod_n + (size_t)(mb >> 13) * (6 * D);
        f32x4 gpv[4], gsv[4], shv[4];
#pragma unroll
        for (int j = 0; j < 4; ++j) { gpv[j] = ((const f32x4*)post_g)[lane + 64 * j] * ((const f32x4*)(modb + 5 * D))[lane + 64 * j];
            gsv[j] = ((const f32x4*)pre_g_n)[lane + 64 * j] * (((const f32x4*)(modn + D))[lane + 64 * j] + 1.0f); shv[j] = ((const f32x4*)modn)[lane + 64 * j]; }
        const i32x4 myps = *(const i32x4*)(pos + (size_t)(mb + (lane & 31)) * 4); const f32x4 mywt = *(const f32x4*)(topw + (size_t)(mb + (lane & 31)) * 4);
        u32x2 ywA[2][TOPK][4], ywB[2][TOPK][4], xwA[2][4], xwB[2][4]; f32x4 xfA[2][4], xfB[2][4];
#define P5B_ISSUE(YW, XW, XF, t0) do { _Pragma("unroll") for (int r = 0; r < 2; ++r) { const int t_ = (t0) + r; \
            _Pragma("unroll") for (int k = 0; k < TOPK; ++k) { const int p_ = __builtin_amdgcn_readlane(myps[k], t_); \
                if constexpr (Y_F8) { const int c0 = 4 * lane; const unsigned* yr = (const unsigned*)((const unsigned char*)Y + (size_t)p_ * D + 64 * ((c0 >> 5) & 3) + 16 * ((c0 >> 3) & 3) + 8 * (c0 >> 7) + (c0 & 7)); \
                    _Pragma("unroll") for (int j = 0; j < 4; ++j) { YW[r][k][j].x = yr[64 * j]; YW[r][k][j].y = 0u; } } \
                else { const u32x2* yr = (const u32x2*)(Y + (size_t)p_ * D) + lane; _Pragma("unroll") for (int j = 0; j < 4; ++j) YW[r][k][j] = yr[64 * j]; } } \
            if constexpr (X16) { const u32x2* xr = (const u32x2*)((const bf16*)xin + (size_t)(mb + t_) * D) + lane; _Pragma("unroll") for (int j = 0; j < 4; ++j) XW[r][j] = xr[64 * j]; } \
            else load_row_f32(xin + (size_t)(mb + t_) * D, XF[r], lane); } } while (0)
#define P5B_PROC(YW, XW, XF, t0) do { _Pragma("unroll") for (int r = 0; r < 2; ++r) { const int t_ = (t0) + r, m = mb + t_; f32x4 y[4], x[4]; \
            float wk[TOPK]; _Pragma("unroll") for (int k = 0; k < TOPK; ++k) wk[k] = __int_as_float(__builtin_amdgcn_readlane(__float_as_int(mywt[k]), t_)); \
            _Pragma("unroll") for (int j = 0; j < 4; ++j) { y[j] = (f32x4){0.f, 0.f, 0.f, 0.f}; \
                _Pragma("unroll") for (int k = 0; k < TOPK; ++k) { const u32x2 w = YW[r][k][j]; \
                    if constexpr (Y_F8) { typedef float f32x2p __attribute__((ext_vector_type(2))); const f32x2p lo = __builtin_amdgcn_cvt_pk_f32_fp8(w.x, false), hi2 = __builtin_amdgcn_cvt_pk_f32_fp8(w.x, true); \
                        y[j] += (f32x4){lo.x, lo.y, hi2.x, hi2.y} * wk[k]; } \
                    else y[j] += (f32x4){bflo(w.x), bfhi(w.x), bflo(w.y), bfhi(w.y)} * wk[k]; } \
                if constexpr (X16) { const u32x2 w = XW[r][j]; x[j] = (f32x4){bflo(w.x), bfhi(w.x), bflo(w.y), bfhi(w.y)}; } else x[j] = XF[r][j]; } \
            const float rsy = row_rstd(y); \
            _Pragma("unroll") for (int j = 0; j < 4; ++j) { x[j] = x[j] + gpv[j] * (y[j] * rsy); if constexpr (!XOUT16) ((f32x4*)(xout + (size_t)m * D))[lane + 64 * j] = x[j]; } \
            if constexpr (XOUT16) store_row_bf16((bf16*)xout + (size_t)m * D, x, lane);        \
            if (has_next) { f32x4 h[4]; const float rs = row_rstd(x); _Pragma("unroll") for (int j = 0; j < 4; ++j) h[j] = x[j] * rs * gsv[j] + shv[j]; \
                store_row_i8(HQ + (size_t)m * D, hs + m, h, lane); } } } while (0)
        P5B_ISSUE(ywA, xwA, xfA, 0);
#pragma unroll 1
        for (int it = 0; it < 8; ++it) { const int t0 = 4 * it;
            P5B_ISSUE(ywB, xwB, xfB, t0 + 2);
            P5B_PROC(ywA, xwA, xfA, t0);
            if (it < 7) P5B_ISSUE(ywA, xwA, xfA, t0 + 4);
            P5B_PROC(ywB, xwB, xfB, t0 + 2);
        }
#undef P5B_ISSUE
#undef P5B_PROC
    }
}

constexpr int PTAB_OFF = LDSCTL_OFF + 512;
enum { I_X = 0, I_C, I_ADAW, I_ADAB, I_PREMIX, I_POSTMIX, I_WIN, I_QG, I_KG, I_DECF, I_DECB, I_GNG, I_GNB, I_WOUT, I_PREFFN, I_POSTFFN, I_RW, I_RB, I_WUP, I_BUP, I_WDN, I_BDN, I_OUT, I_WS };
__device__ __forceinline__ unsigned char* ptab(LAS unsigned char* lds, int k) {
    const LAS unsigned* p = (const LAS unsigned*)(lds + PTAB_OFF) + 2 * k;
    const unsigned lo = __builtin_amdgcn_readfirstlane(p[0]), hi = __builtin_amdgcn_readfirstlane(p[1]);
    return (unsigned char*)(GAS unsigned char*)(((unsigned long long)hi << 32) | lo);
}
__device__ __forceinline__ unsigned char* ptabx(LAS unsigned char* lds, int k) {
    const LAS unsigned* p = (const LAS unsigned*)(lds + PTAB_OFF) + 2 * k;
    const unsigned lo = __builtin_amdgcn_readfirstlane(p[0]), hi = __builtin_amdgcn_readfirstlane(p[1]);
    return (unsigned char*)(((unsigned long long)hi << 32) | lo);
}
#define WSX(off) (ptabx(F.lds, I_WS) + (off))
#define PF(k) ((const float*)ptab(F.lds, (k)))
#define WSP(off) (ptab(F.lds, I_WS) + (off))
struct Args { const float* in[22]; float* out; unsigned char* ws; };
__global__ void __launch_bounds__(NTHR, 2) mk_fwd(Args args) {
    extern __shared__ __attribute__((aligned(16))) unsigned char lds[];
    Frame F;
    F.lds = (LAS unsigned char*)lds;
    F.MISC = (volatile LAS unsigned*)(F.lds + MISC_OFF);
    F.tid = threadIdx.x; F.lane = F.tid & 63; F.wave = __builtin_amdgcn_readfirstlane(F.tid >> 6);
    F.G = gridDim.x; { const int bx = blockIdx.x; F.vcu = (F.G % 8 == 0) ? (bx % 8) * (F.G / 8) + bx / 8 : bx; }
    F.ctl = (gu32*)(args.ws + WS_CTL);
    for (int u = F.tid; u < (LDS_BYTES - LDSCTL_OFF) / 4; u += NTHR) ((LAS unsigned*)(F.lds + LDSCTL_OFF))[u] = 0u;
    __syncthreads();
    if (F.tid == 0) { LAS unsigned long long* PT = (LAS unsigned long long*)(F.lds + PTAB_OFF);
#pragma unroll
        for (int k = 0; k < 22; ++k) PT[k] = (unsigned long long)args.in[k];
        PT[I_OUT] = (unsigned long long)args.out; PT[I_WS] = (unsigned long long)args.ws; }
    __syncthreads();
    (void)xcd_barrier_post((unsigned*)(F.ctl + CW_BAR), F.MISC + 8);
#define LAUNDER() do { F.tid = threadIdx.x; asm volatile("" : "+v"(F.tid)); F.lane = F.tid & 63; F.wave = __builtin_amdgcn_readfirstlane(F.tid >> 6); \
    { unsigned long long lb_ = (unsigned long long)lds0_; int vc_ = vcu0_, g_ = G0_; asm volatile("" : "+s"(lb_), "+s"(vc_), "+s"(g_)); F.lds = (LAS unsigned char*)lb_; F.vcu = vc_; F.G = g_; } } while (0)
#ifndef REP_BAR
#define REP_BAR 1
#endif
#define GRID_BAR() for (int rb_ = 0; rb_ < REP_BAR; ++rb_) do { XcdBarrier b_; b_.bar = (unsigned*)(ptab(F.lds, I_WS) + WS_CTL) + CW_BAR; b_.x = xb_xcc_id(); b_.st = (volatile LAS unsigned*)(F.lds + MISC_OFF) + 8; xcd_barrier(b_); LAUNDER(); } while (0)
    const LAS unsigned char* lds0_ = F.lds; const int vcu0_ = F.vcu, G0_ = F.G;

#ifndef SKIP_P0
    for (int rep_ = 0; rep_ < REP_P0; ++rep_)
    p0_prologue(F, PF(I_C), PF(I_ADAW), PF(I_ADAB), (float*)WSP(WS_MOD), PF(I_WIN), PF(I_WOUT), PF(I_WUP), PF(I_WDN),
                (signed char*)WSP(WS_WIN), (float*)WSP(WS_CSCIN), (signed char*)WSP(WS_WOUT), (float*)WSP(WS_CSCOUT), (signed char*)WSP(WS_WUP), (float*)WSP(WS_CSC), (signed char*)WSP(WS_WDN), (float*)WSP(WS_CSCDN), F.ctl + CW_WQ);
#endif
    GRID_BAR();
#ifndef SKIP_P0B
    for (int rep_ = 0; rep_ < REP_P0B; ++rep_)
    p0b_premix(F, PF(I_X), (signed char*)WSP(WS_HM), (float*)WSP(WS_HS), PF(I_PREMIX), (const float*)WSP(WS_MOD));
#endif
    GRID_BAR();
    { constexpr int l = 0;
        for (int rep_ = 0; rep_ < REP_P1; ++rep_) { LAUNDER();
#ifndef SKIP_P1
        {
            pg8::Gemm g{(const bf16*)WSP(WS_HM), (const bf16*)(WSP(WS_WIN) + (size_t)l * INW * D), M, INW, D / 2}; pg8::StaticOrder S; S.init(M, INW, F.G, (int)blockIdx.x);
            pg8::EpiI8Bf16 E{(bf16*)WSP(WS_PROJ), INW, (const float*)WSP(WS_HS), (const float*)WSP(WS_CSCIN) + (size_t)l * INW, F.lds + EPI_SP_OFF};
#if defined(STAGGER_P1)
            { const unsigned long long t0_ = __builtin_amdgcn_s_memrealtime(), dl_ = (unsigned long long)(F.vcu & 7) * STAGGER_P1; while (__builtin_amdgcn_s_memrealtime() - t0_ < dl_) __builtin_amdgcn_s_sleep(8); }
#endif
#if defined(NOEPI_P1)
            { pg8::EpiNullI8 E0; pg8::gemm_phase<pg8::EpiNullI8, pg8::StaticOrder, true, true, true, true>(F.lds + RING_OFF, g, S, E0, (const int*)WSP(WS_RMAP)); LAUNDER(); }
#endif
            pg8::gemm_phase<pg8::EpiI8Bf16, pg8::StaticOrder, true, true, true>(F.lds + RING_OFF, g, S, E);
        }
#endif
        }
        GRID_BAR();
#if defined(ATTN_PROBE)
        if (l == 0) ka_expect(F, (const bf16*)WSP(WS_PROJ), (float*)WSP(WS_DUMMY), PF(I_KG));
        GRID_BAR();
#endif
#ifndef SKIP_P1B
        p1b_ka(F, (bf16*)WSP(WS_PROJ), PF(I_KG) + l * 64);
#endif
        for (int rep_ = 0; rep_ < REP_R1; ++rep_) { LAUNDER();
#ifndef SKIP_R1
        r1_states(F, (const bf16*)WSP(WS_PROJ), (bf16*)WSP(WS_U), PF(I_DECF) + l * RH, PF(I_DECB) + l * RH);
#endif
        }
        GRID_BAR();
        for (int rep_ = 0; rep_ < REP_R2; ++rep_) { LAUNDER();
#ifndef SKIP_R2
        r2_scan(F, (const bf16*)WSP(WS_U), (bf16*)WSP(WS_FT), PF(I_DECF) + l * RH, PF(I_DECB) + l * RH);
#endif
        }
        GRID_BAR();
#pragma unroll 1
        for (int pass_ = 0; pass_ < 2; ++pass_) { LAUNDER();
        if (((F.vcu ^ pass_) & 1) == 0) {
#ifndef SKIP_R3
        r3_out(F, (const bf16*)WSP(WS_PROJ), (const bf16*)WSP(WS_FT), (bf16*)WSP(WS_CAT), PF(I_DECF) + l * RH, PF(I_DECB) + l * RH, PF(I_GNG) + l * 512, PF(I_GNB) + l * 512);
#endif
        } else {
#ifndef SKIP_P2
        {
            const bf16* PROJ = (const bf16*)WSP(WS_PROJ);
            const attn_body::AttnTensors AT{(const attn_body::bf16*)(PROJ + C_QA), (const attn_body::bf16*)(PROJ + C_KA), (const attn_body::bf16*)(PROJ + C_VA), (attn_body::bf16*)WSP(WS_CAT), PF(I_QG) + l * 64, PF(I_KG) + l * 64};
            attn_body::attn_phase<8>((char*)lds + RING_OFF, AT, F.vcu, F.G);
        }
#endif
        }
        }
        GRID_BAR();
#if defined(ATTN_PROBE)
        if (l == 0) ka_compare(F, (const bf16*)WSP(WS_PROJ), (const float*)WSP(WS_DUMMY), F.ctl + CW_CODE + 8);
        if (l == 0) attn_check(F, (const bf16*)WSP(WS_PROJ), (const bf16*)WSP(WS_CAT), F.ctl + CW_CODE + 8, PF(I_QG));
#endif
        for (int rep_ = 0; rep_ < REP_P3; ++rep_) { LAUNDER();
#ifndef SKIP_P3
        {
            pg8::Gemm g{(const bf16*)WSP(WS_CAT), (const bf16*)(WSP(WS_WOUT) + (size_t)l * D * D), M, D, D / 2}; pg8::StaticOrder S; S.init(M, D, F.G, (int)blockIdx.x);
            pg8::EpiBf16 E{(bf16*)WSP(WS_YM), D, nullptr, 0, 0, F.lds + EPI_SP_OFF, (const float*)WSP(WS_CSCOUT) + (size_t)l * D, 1.0f};
            pg8::gemm_phase<pg8::EpiBf16, pg8::StaticOrder, true, true, false, false, true>(F.lds + RING_OFF, g, S, E);
        }
#endif
        }
        GRID_BAR();
#ifndef SKIP_P3B
        for (int rep_ = 1; rep_ < REP_P3B; ++rep_) { LAUNDER();
        p3b_postmix<false, (l > 0)>(F, l == 0 ? PF(I_X) : PF(I_OUT), (float*)WSP(WS_DUMMY), (const bf16*)WSP(WS_YM), (signed char*)WSP(WS_DUMMY + 256 * MiB), (float*)WSP(WS_DUMMY + 386 * MiB), (const float*)WSP(WS_MOD) + (size_t)l * BATCH * 6 * D,
                    PF(I_POSTMIX) + l * D, PF(I_PREFFN) + l * D, PF(I_RW) + (size_t)l * D * NE, PF(I_RB) + l * NE, (int*)WSP(WS_DUMMY + 384 * MiB), (float*)WSP(WS_DUMMY + 385 * MiB), F.ctl + CW_CNT + 128 + l * 64);
        }
        LAUNDER();
        p3b_postmix<(l >= X16_FROM), (l > 0)>(F, l == 0 ? PF(I_X) : PF(I_OUT), (l >= X16_FROM) ? (float*)WSP(WS_CAT) : (float*)ptab(F.lds, I_OUT), (const bf16*)WSP(WS_YM), (signed char*)WSP(WS_HM), (float*)WSP(WS_HS), (const float*)WSP(WS_MOD) + (size_t)l * BATCH * 6 * D,
                    PF(I_POSTMIX) + l * D, PF(I_PREFFN) + l * D, PF(I_RW) + (size_t)l * D * NE, PF(I_RB) + l * NE, (int*)WSP(WS_TOPI), (float*)WSP(WS_TOPW), F.ctl + CW_CNT + l * 64);
#endif
        GRID_BAR();
#ifndef SKIP_P4A
        for (int rep_ = 1; rep_ < REP_P4A; ++rep_) { LAUNDER();
        p4a_route(F, (const float*)WSP(WS_HS), (int*)WSP(WS_DUMMY + 16 * MiB), (float*)WSP(WS_DUMMY + 8 * MiB), (const int*)WSP(WS_TOPI), (int*)WSP(WS_DUMMY), F.ctl + CW_CNT + l * 64, F.ctl + CW_CUR + 128 + l * 64);
        }
        LAUNDER();
        p4a_route(F, (const float*)WSP(WS_HS), (int*)WSP(WS_RMAP), (float*)WSP(WS_XSC), (const int*)WSP(WS_TOPI), (int*)WSP(WS_POS), F.ctl + CW_CNT + l * 64, F.ctl + CW_CUR + l * 64);
#endif
        GRID_BAR();
        for (int rep_ = 0; rep_ < REP_P4; ++rep_) { LAUNDER();
#ifndef SKIP_P4
        {
            const LAS int* ts = (const LAS int*)(F.lds + LTS_OFF);
            pg8::Gemm g{(const bf16*)WSP(WS_HM), (const bf16*)(WSP(WS_WUP) + (size_t)l * NE * 2048 * D), XS_ROWS, 2048, D / 2}; pg8::MoeOrder<3> S{ts, F.G, F.vcu, ts[NE] * 8, ts[F.lane & 31]};
            pg8::EpiMoeUpT<true> E{(bf16*)WSP(WS_ACT), PF(I_BUP) + (size_t)l * NE * 2048, (const float*)WSP(WS_XSC), (const float*)WSP(WS_CSC) + (size_t)l * NE * 2048, F.lds + EPI_SP_OFF};
#if defined(STAGGER_P4)
            { const unsigned long long t0_ = __builtin_amdgcn_s_memrealtime(), dl_ = (unsigned long long)(F.vcu & (STAGGER_WAYS - 1)) * STAGGER_P4; while (__builtin_amdgcn_s_memrealtime() - t0_ < dl_) __builtin_amdgcn_s_sleep(8); }
#endif
#if defined(NOLOAD_P4)
            { pg8::EpiMoeUpNoLoad E0{(bf16*)WSP(WS_ACT), 1e-4f, 0.01f}; pg8::gemm_phase<pg8::EpiMoeUpNoLoad, pg8::MoeOrder<3>, true, true, true, true>(F.lds + RING_OFF, g, S, E0, (const int*)WSP(WS_RMAP)); LAUNDER(); }
#endif
#if defined(NOSTORE_P4)
            { pg8::EpiMoeUpNoStore E0{(bf16*)WSP(WS_ACT), 1e-4f, 0.01f}; pg8::gemm_phase<pg8::EpiMoeUpNoStore, pg8::MoeOrder<3>, true, true, true, true>(F.lds + RING_OFF, g, S, E0, (const int*)WSP(WS_RMAP)); LAUNDER(); }
#endif
#if defined(NOEPI_P4)
            { pg8::EpiNullI8 E0; pg8::gemm_phase<pg8::EpiNullI8, pg8::MoeOrder<3>, true, true, true, true>(F.lds + RING_OFF, g, S, E0, (const int*)WSP(WS_RMAP)); LAUNDER(); }
#endif
            pg8::gemm_phase<pg8::EpiMoeUpT<true>, pg8::MoeOrder<3>, true, true, true, true>(F.lds + RING_OFF, g, S, E, (const int*)WSP(WS_RMAP));
        }
#endif
        }
        GRID_BAR();
        for (int rep_ = 0; rep_ < REP_P5; ++rep_) { LAUNDER();
#ifndef SKIP_P5
        {
            const LAS int* ts = (const LAS int*)(F.lds + LTS_OFF);
            pg8::Gemm g{(const bf16*)WSP(WS_ACT), (const bf16*)(WSP(WS_WDN) + (size_t)l * NE * D * D), XS_ROWS, D, D / 2}; pg8::MoeOrder<2> S{ts, F.G, F.vcu, ts[NE] * 4, ts[F.lane & 31]};
            typedef pg8::EpiBf16T<(l >= YF8_FROM)> EpiDn;
            EpiDn E{(bf16*)WSP(WS_XS), D, PF(I_BDN) + (size_t)l * NE * D, D, 0, F.lds + EPI_SP_OFF, (const float*)WSP(WS_CSCDN) + (size_t)l * NE * D, 1.0f / pg8::ACT_F8_SCALE};
#if defined(STAGGER_P5)
            { const unsigned long long t0_ = __builtin_amdgcn_s_memrealtime(), dl_ = (unsigned long long)(F.vcu & 7) * STAGGER_P5; while (__builtin_amdgcn_s_memrealtime() - t0_ < dl_) __builtin_amdgcn_s_sleep(8); }
#endif
            pg8::gemm_phase<EpiDn, pg8::MoeOrder<2>, true, true, false, false, true>(F.lds + RING_OFF, g, S, E);
        }
#endif
        }
        GRID_BAR();
#ifndef SKIP_P5B
        for (int rep_ = 1; rep_ < REP_P5B; ++rep_) { LAUNDER();
        p5b_combine<(l >= YF8_FROM), (l >= X16_FROM), (l + 1 < DEPTH)>(F, (l >= X16_FROM) ? (const float*)WSP(WS_CAT) : (const float*)ptab(F.lds, I_OUT), (float*)WSP(WS_DUMMY), (const bf16*)WSP(WS_XS), (const int*)WSP(WS_POS), (const float*)WSP(WS_TOPW), (const float*)WSP(WS_MOD) + (size_t)l * BATCH * 6 * D, PF(I_POSTFFN) + l * D,
                    l + 1 < DEPTH, (const float*)WSP(WS_MOD) + (size_t)(l + 1 < DEPTH ? l + 1 : l) * BATCH * 6 * D, PF(I_PREMIX) + (l + 1 < DEPTH ? (l + 1) * D : 0), (signed char*)WSP(WS_DUMMY + 256 * MiB), (float*)WSP(WS_DUMMY + 386 * MiB));
        }
        LAUNDER();
        p5b_combine<(l >= YF8_FROM), (l >= X16_FROM), (l + 1 < DEPTH)>(F, (l >= X16_FROM) ? (const float*)WSP(WS_CAT) : (const float*)ptab(F.lds, I_OUT), (float*)ptab(F.lds, I_OUT), (const bf16*)WSP(WS_XS), (const int*)WSP(WS_POS), (const float*)WSP(WS_TOPW), (const float*)WSP(WS_MOD) + (size_t)l * BATCH * 6 * D, PF(I_POSTFFN) + l * D,
                    l + 1 < DEPTH, (const float*)WSP(WS_MOD) + (size_t)(l + 1 < DEPTH ? l + 1 : l) * BATCH * 6 * D, PF(I_PREMIX) + (l + 1 < DEPTH ? (l + 1) * D : 0), (signed char*)WSP(WS_HM), (float*)WSP(WS_HS));
#endif
        if (l + 1 < DEPTH) GRID_BAR();
    }
    { constexpr int l = 1;
        for (int rep_ = 0; rep_ < REP_P1; ++rep_) { LAUNDER();
#ifndef SKIP_P1
        {
            pg8::Gemm g{(const bf16*)WSP(WS_HM), (const bf16*)(WSP(WS_WIN) + (size_t)l * INW * D), M, INW, D / 2}; pg8::StaticOrder S; S.init(M, INW, F.G, (int)blockIdx.x);
            pg8::EpiI8Bf16 E{(bf16*)WSP(WS_PROJ), INW, (const float*)WSP(WS_HS), (const float*)WSP(WS_CSCIN) + (size_t)l * INW, F.lds + EPI_SP_OFF};
#if defined(STAGGER_P1)
            { const unsigned long long t0_ = __builtin_amdgcn_s_memrealtime(), dl_ = (unsigned long long)(F.vcu & 7) * STAGGER_P1; while (__builtin_amdgcn_s_memrealtime() - t0_ < dl_) __builtin_amdgcn_s_sleep(8); }
#endif
#if defined(NOEPI_P1)
            { pg8::EpiNullI8 E0; pg8::gemm_phase<pg8::EpiNullI8, pg8::StaticOrder, true, true, true, true>(F.lds + RING_OFF, g, S, E0, (const int*)WSP(WS_RMAP)); LAUNDER(); }
#endif
            pg8::gemm_phase<pg8::EpiI8Bf16, pg8::StaticOrder, true, true, true>(F.lds + RING_OFF, g, S, E);
        }
#endif
        }
        GRID_BAR();
#if defined(ATTN_PROBE)
        if (l == 0) ka_expect(F, (const bf16*)WSP(WS_PROJ), (float*)WSP(WS_DUMMY), PF(I_KG));
        GRID_BAR();
#endif
#ifndef SKIP_P1B
        p1b_ka(F, (bf16*)WSP(WS_PROJ), PF(I_KG) + l * 64);
#endif
        for (int rep_ = 0; rep_ < REP_R1; ++rep_) { LAUNDER();
#ifndef SKIP_R1
        r1_states(F, (const bf16*)WSP(WS_PROJ), (bf16*)WSP(WS_U), PF(I_DECF) + l * RH, PF(I_DECB) + l * RH);
#endif
        }
        GRID_BAR();
        for (int rep_ = 0; rep_ < REP_R2; ++rep_) { LAUNDER();
#ifndef SKIP_R2
        r2_scan(F, (const bf16*)WSP(WS_U), (bf16*)WSP(WS_FT), PF(I_DECF) + l * RH, PF(I_DECB) + l * RH);
#endif
        }
        GRID_BAR();
#pragma unroll 1
        for (int pass_ = 0; pass_ < 2; ++pass_) { LAUNDER();
        if (((F.vcu ^ pass_) & 1) == 0) {
#ifndef SKIP_R3
        r3_out(F, (const bf16*)WSP(WS_PROJ), (const bf16*)WSP(WS_FT), (bf16*)WSP(WS_CAT), PF(I_DECF) + l * RH, PF(I_DECB) + l * RH, PF(I_GNG) + l * 512, PF(I_GNB) + l * 512);
#endif
        } else {
#ifndef SKIP_P2
        {
            const bf16* PROJ = (const bf16*)WSP(WS_PROJ);
            const attn_body::AttnTensors AT{(const attn_body::bf16*)(PROJ + C_QA), (const attn_body::bf16*)(PROJ + C_KA), (const attn_body::bf16*)(PROJ + C_VA), (attn_body::bf16*)WSP(WS_CAT), PF(I_QG) + l * 64, PF(I_KG) + l * 64};
            attn_body::attn_phase<8>((char*)lds + RING_OFF, AT, F.vcu, F.G);
        }
#endif
        }
        }
        GRID_BAR();
#if defined(ATTN_PROBE)
        if (l == 0) ka_compare(F, (const bf16*)WSP(WS_PROJ), (const float*)WSP(WS_DUMMY), F.ctl + CW_CODE + 8);
        if (l == 0) attn_check(F, (const bf16*)WSP(WS_PROJ), (const bf16*)WSP(WS_CAT), F.ctl + CW_CODE + 8, PF(I_QG));
#endif
        for (int rep_ = 0; rep_ < REP_P3; ++rep_) { LAUNDER();
#ifndef SKIP_P3
        {
            pg8::Gemm g{(const bf16*)WSP(WS_CAT), (const bf16*)(WSP(WS_WOUT) + (size_t)l * D * D), M, D, D / 2}; pg8::StaticOrder S; S.init(M, D, F.G, (int)blockIdx.x);
            pg8::EpiBf16 E{(bf16*)WSP(WS_YM), D, nullptr, 0, 0, F.lds + EPI_SP_OFF, (const float*)WSP(WS_CSCOUT) + (size_t)l * D, 1.0f};
            pg8::gemm_phase<pg8::EpiBf16, pg8::StaticOrder, true, true, false, false, true>(F.lds + RING_OFF, g, S, E);
        }
#endif
        }
        GRID_BAR();
#ifndef SKIP_P3B
        for (int rep_ = 1; rep_ < REP_P3B; ++rep_) { LAUNDER();
        p3b_postmix<false, (l > 0)>(F, l == 0 ? PF(I_X) : PF(I_OUT), (float*)WSP(WS_DUMMY), (const bf16*)WSP(WS_YM), (signed char*)WSP(WS_DUMMY + 256 * MiB), (float*)WSP(WS_DUMMY + 386 * MiB), (const float*)WSP(WS_MOD) + (size_t)l * BATCH * 6 * D,
                    PF(I_POSTMIX) + l * D, PF(I_PREFFN) + l * D, PF(I_RW) + (size_t)l * D * NE, PF(I_RB) + l * NE, (int*)WSP(WS_DUMMY + 384 * MiB), (float*)WSP(WS_DUMMY + 385 * MiB), F.ctl + CW_CNT + 128 + l * 64);
        }
        LAUNDER();
        p3b_postmix<(l >= X16_FROM), (l > 0)>(F, l == 0 ? PF(I_X) : PF(I_OUT), (l >= X16_FROM) ? (float*)WSP(WS_CAT) : (float*)ptab(F.lds, I_OUT), (const bf16*)WSP(WS_YM), (signed char*)WSP(WS_HM), (float*)WSP(WS_HS), (const float*)WSP(WS_MOD) + (size_t)l * BATCH * 6 * D,
                    PF(I_POSTMIX) + l * D, PF(I_PREFFN) + l * D, PF(I_RW) + (size_t)l * D * NE, PF(I_RB) + l * NE, (int*)WSP(WS_TOPI), (float*)WSP(WS_TOPW), F.ctl + CW_CNT + l * 64);
#endif
        GRID_BAR();
#ifndef SKIP_P4A
        for (int rep_ = 1; rep_ < REP_P4A; ++rep_) { LAUNDER();
        p4a_route(F, (const float*)WSP(WS_HS), (int*)WSP(WS_DUMMY + 16 * MiB), (float*)WSP(WS_DUMMY + 8 * MiB), (const int*)WSP(WS_TOPI), (int*)WSP(WS_DUMMY), F.ctl + CW_CNT + l * 64, F.ctl + CW_CUR + 128 + l * 64);
        }
        LAUNDER();
        p4a_route(F, (const float*)WSP(WS_HS), (int*)WSP(WS_RMAP), (float*)WSP(WS_XSC), (const int*)WSP(WS_TOPI), (int*)WSP(WS_POS), F.ctl + CW_CNT + l * 64, F.ctl + CW_CUR + l * 64);
#endif
        GRID_BAR();
        for (int rep_ = 0; rep_ < REP_P4; ++rep_) { LAUNDER();
#ifndef SKIP_P4
        {
            const LAS int* ts = (const LAS int*)(F.lds + LTS_OFF);
            pg8::Gemm g{(const bf16*)WSP(WS_HM), (const bf16*)(WSP(WS_WUP) + (size_t)l * NE * 2048 * D), XS_ROWS, 2048, D / 2}; pg8::MoeOrder<3> S{ts, F.G, F.vcu, ts[NE] * 8, ts[F.lane & 31]};
            pg8::EpiMoeUpT<true> E{(bf16*)WSP(WS_ACT), PF(I_BUP) + (size_t)l * NE * 2048, (const float*)WSP(WS_XSC), (const float*)WSP(WS_CSC) + (size_t)l * NE * 2048, F.lds + EPI_SP_OFF};
#if defined(STAGGER_P4)
            { const unsigned long long t0_ = __builtin_amdgcn_s_memrealtime(), dl_ = (unsigned long long)(F.vcu & (STAGGER_WAYS - 1)) * STAGGER_P4; while (__builtin_amdgcn_s_memrealtime() - t0_ < dl_) __builtin_amdgcn_s_sleep(8); }
#endif
#if defined(NOLOAD_P4)
            { pg8::EpiMoeUpNoLoad E0{(bf16*)WSP(WS_ACT), 1e-4f, 0.01f}; pg8::gemm_phase<pg8::EpiMoeUpNoLoad, pg8::MoeOrder<3>, true, true, true, true>(F.lds + RING_OFF, g, S, E0, (const int*)WSP(WS_RMAP)); LAUNDER(); }
#endif
#if defined(NOSTORE_P4)
            { pg8::EpiMoeUpNoStore E0{(bf16*)WSP(WS_ACT), 1e-4f, 0.01f}; pg8::gemm_phase<pg8::EpiMoeUpNoStore, pg8::MoeOrder<3>, true, true, true, true>(F.lds + RING_OFF, g, S, E0, (const int*)WSP(WS_RMAP)); LAUNDER(); }
#endif
#if defined(NOEPI_P4)
            { pg8::EpiNullI8 E0; pg8::gemm_phase<pg8::EpiNullI8, pg8::MoeOrder<3>, true, true, true, true>(F.lds + RING_OFF, g, S, E0, (const int*)WSP(WS_RMAP)); LAUNDER(); }
#endif
            pg8::gemm_phase<pg8::EpiMoeUpT<true>, pg8::MoeOrder<3>, true, true, true, true>(F.lds + RING_OFF, g, S, E, (const int*)WSP(WS_RMAP));
        }
#endif
        }
        GRID_BAR();
        for (int rep_ = 0; rep_ < REP_P5; ++rep_) { LAUNDER();
#ifndef SKIP_P5
        {
            const LAS int* ts = (const LAS int*)(F.lds + LTS_OFF);
            pg8::Gemm g{(const bf16*)WSP(WS_ACT), (const bf16*)(WSP(WS_WDN) + (size_t)l * NE * D * D), XS_ROWS, D, D / 2}; pg8::MoeOrder<2> S{ts, F.G, F.vcu, ts[NE] * 4, ts[F.lane & 31]};
            typedef pg8::EpiBf16T<(l >= YF8_FROM)> EpiDn;
            EpiDn E{(bf16*)WSP(WS_XS), D, PF(I_BDN) + (size_t)l * NE * D, D, 0, F.lds + EPI_SP_OFF, (const float*)WSP(WS_CSCDN) + (size_t)l * NE * D, 1.0f / pg8::ACT_F8_SCALE};
#if defined(STAGGER_P5)
            { const unsigned long long t0_ = __builtin_amdgcn_s_memrealtime(), dl_ = (unsigned long long)(F.vcu & 7) * STAGGER_P5; while (__builtin_amdgcn_s_memrealtime() - t0_ < dl_) __builtin_amdgcn_s_sleep(8); }
#endif
            pg8::gemm_phase<EpiDn, pg8::MoeOrder<2>, true, true, false, false, true>(F.lds + RING_OFF, g, S, E);
        }
#endif
        }
        GRID_BAR();
#ifndef SKIP_P5B
        for (int rep_ = 1; rep_ < REP_P5B; ++rep_) { LAUNDER();
        p5b_combine<(l >= YF8_FROM), (l >= X16_FROM), (l + 1 < DEPTH)>(F, (l >= X16_FROM) ? (const float*)WSP(WS_CAT) : (const float*)ptab(F.lds, I_OUT), (float*)WSP(WS_DUMMY), (const bf16*)WSP(WS_XS), (const int*)WSP(WS_POS), (const float*)WSP(WS_TOPW), (const float*)WSP(WS_MOD) + (size_t)l * BATCH * 6 * D, PF(I_POSTFFN) + l * D,
                    l + 1 < DEPTH, (const float*)WSP(WS_MOD) + (size_t)(l + 1 < DEPTH ? l + 1 : l) * BATCH * 6 * D, PF(I_PREMIX) + (l + 1 < DEPTH ? (l + 1) * D : 0), (signed char*)WSP(WS_DUMMY + 256 * MiB), (float*)WSP(WS_DUMMY + 386 * MiB));
        }
        LAUNDER();
        p5b_combine<(l >= YF8_FROM), (l >= X16_FROM), (l + 1 < DEPTH)>(F, (l >= X16_FROM) ? (const float*)WSP(WS_CAT) : (const float*)ptab(F.lds, I_OUT), (float*)ptab(F.lds, I_OUT), (const bf16*)WSP(WS_XS), (const int*)WSP(WS_POS), (const float*)WSP(WS_TOPW), (const float*)WSP(WS_MOD) + (size_t)l * BATCH * 6 * D, PF(I_POSTFFN) + l * D,
                    l + 1 < DEPTH, (const float*)WSP(WS_MOD) + (size_t)(l + 1 < DEPTH ? l + 1 : l) * BATCH * 6 * D, PF(I_PREMIX) + (l + 1 < DEPTH ? (l + 1) * D : 0), (signed char*)WSP(WS_HM), (float*)WSP(WS_HS));
#endif
        if (l + 1 < DEPTH) GRID_BAR();
    }
#if defined(ATTN_PROBE)
    GRID_BAR();
    if (blockIdx.x == 0 && F.tid == 0 && __hip_atomic_load(F.ctl + CW_CODE + 8, RLX_AGENT) != 0u) ((float*)ptab(F.lds, I_OUT))[0] = __builtin_nanf("");
#endif
#undef GRID_BAR
}

extern "C" void kernel_launch(void* const* d_in, const int* in_sizes, int n_in, void* d_out, int out_size, void* d_ws, size_t ws_size, hipStream_t stream) {
    static int grid = 0;
    if (grid == 0) {
        if (n_in != 22 || in_sizes[0] != M * D || out_size != M * D || ws_size < WS_END) { fprintf(stderr, "kernel_launch: unexpected shapes/workspace (n_in %d, in0 %d, out %d, ws %zu < %zu)\n", n_in, n_in > 0 ? in_sizes[0] : -1, out_size, ws_size, (size_t)WS_END); grid = -1; return; }
        int dev = 0, cus = 0, per_cu = 0;
        if (hipGetDevice(&dev) != hipSuccess || hipDeviceGetAttribute(&cus, hipDeviceAttributeMultiprocessorCount, dev) != hipSuccess) { grid = -1; return; }
        if (hipFuncSetAttribute((const void*)mk_fwd, hipFuncAttributeMaxDynamicSharedMemorySize, LDS_BYTES) != hipSuccess) { fprintf(stderr, "kernel_launch: hipFuncSetAttribute failed\n"); grid = -1; return; }
        if (hipOccupancyMaxActiveBlocksPerMultiprocessor(&per_cu, (const void*)mk_fwd, NTHR, LDS_BYTES) != hipSuccess || per_cu < 1) { fprintf(stderr, "kernel_launch: occupancy query says %d\n", per_cu); }
        (void)hipGetLastError();
        grid = cus;
    }
    if (grid < 0) return;
    if (hipMemsetAsync((char*)d_ws + WS_CTL, 0, CTL_ZERO_BYTES, stream) != hipSuccess) { fprintf(stderr, "kernel_launch: memset failed\n"); return; }
    Args a{};
    for (int i = 0; i < 22; ++i) a.in[i] = (const float*)d_in[i];
    a.out = (float*)d_out; a.ws = (unsigned char*)d_ws;
    hipLaunchKernelGGL(mk_fwd, dim3(grid), dim3(NTHR), LDS_BYTES, stream, a);
    const hipError_t le = hipPeekAtLastError();
    if (le != hipSuccess) fprintf(stderr, "kernel_launch: launch failed: %s\n", hipGetErrorName(le));
}
```

```cpp
#ifndef REP_P0
#define REP_P0 1
#endif
#ifndef REP_P1
#define REP_P1 1
#endif
#ifndef REP_R1
#define REP_R1 1
#endif
#ifndef REP_R2
#define REP_R2 1
#endif
#ifndef REP_R3
#define REP_R3 1
#endif
#ifndef REP_P2
#define REP_P2 1
#endif
#ifndef REP_P3
#define REP_P3 1
#endif
#ifndef REP_P4
#define REP_P4 1
#endif
#ifndef REP_P5
#define REP_P5 1
#endif
#ifndef REP_P0B
#define REP_P0B 1
#endif
#ifndef REP_P1B
#define REP_P1B 1
#endif
#ifndef REP_P3B
#define REP_P3B 1
#endif
#ifndef REP_P4A
#define REP_P4A 1
#endif
#ifndef REP_P5B
#define REP_P5B 1
#endif
#ifndef REP_EPI
#define REP_EPI 1
#endif
#ifndef STAGGER_WAYS
#define STAGGER_WAYS 8
#endif
#include <hip/hip_runtime.h>
template <int M> __device__ __forceinline__ float shx(float v) { return __int_as_float(__builtin_amdgcn_ds_swizzle(__float_as_int(v), (M << 10) | 0x1f)); }
template <int M> __device__ __forceinline__ int shxi(int v) { return __builtin_amdgcn_ds_swizzle(v, (M << 10) | 0x1f); }
__device__ __forceinline__ float sum32(float v) { auto rr = __builtin_amdgcn_permlane32_swap(__float_as_uint(v), __float_as_uint(v), false, false); return __uint_as_float(rr[0]) + __uint_as_float(rr[1]); }
__device__ __forceinline__ float max32(float v) { auto rr = __builtin_amdgcn_permlane32_swap(__float_as_uint(v), __float_as_uint(v), false, false); return fmaxf(__uint_as_float(rr[0]), __uint_as_float(rr[1])); }
__device__ __forceinline__ float shx32(float v, bool upper) { auto rr = __builtin_amdgcn_permlane32_swap(__float_as_uint(v), __float_as_uint(v), false, false); return __uint_as_float(upper ? rr[0] : rr[1]); }
__device__ __forceinline__ int bcastl(int v, int srclane) { return __builtin_amdgcn_ds_bpermute(srclane << 2, v); }
__device__ __forceinline__ float wsum64(float v) { v += shx<1>(v); v += shx<2>(v); v += shx<4>(v); v += shx<8>(v); v += shx<16>(v); return sum32(v); }
__device__ __forceinline__ float wmax64(float v) { v = fmaxf(v, shx<1>(v)); v = fmaxf(v, shx<2>(v)); v = fmaxf(v, shx<4>(v)); v = fmaxf(v, shx<8>(v)); v = fmaxf(v, shx<16>(v)); return max32(v); }
#ifndef YF8_FROM
#define YF8_FROM 0
#endif
#ifndef X16_FROM
#define X16_FROM 0
#endif
#include <hip/hip_runtime.h>
#include <cstdio>
#include <cstdint>
namespace pg8 {
#define PG8_LAS __attribute__((address_space(3)))
typedef unsigned short bf16_t;
typedef short bf16x8 __attribute__((ext_vector_type(8)));
typedef float f32x4 __attribute__((ext_vector_type(4)));
typedef unsigned u32x4 __attribute__((ext_vector_type(4)));
constexpr int BM = 256, BK = 64, HALF = 128, HTB = HALF * BK * 2  , STAGE_BYTES = 8 * HTB, NXCD = 8, WGM = 8;

__host__ __device__ __forceinline__ int lds_byte(int r, int c) { const int st = (r >> 4) * 2 + (c >> 5), rr = r & 15, cc = c & 31, ob = rr * 64 + cc * 2; return st * 1024 + (ob ^ (((ob >> 9) & 1) << 5)); }
__host__ __device__ __forceinline__ void stage_rc(int b, int& R, int& C) { const int st = b / 1024, sb = b % 1024, swz = sb ^ (((sb >> 9) & 1) << 5); R = (st >> 1) * 16 + swz / 64; C = (st & 1) * 32 + (swz % 64) / 2; }
__host__ __device__ __forceinline__ int perm32(int rho) { const int n = rho >> 4, i = rho & 15; return 8 * (i >> 2) + 4 * n + (i & 3); }

struct Unit { int pm, pn; };
struct Gemm { const bf16_t* A; const bf16_t* Bt; int M, N, K; };

struct StaticOrder {
    int nM, nN, nwg, G, c;
    __host__ __device__ void init(int M, int N, int G_, int c_) { nM = M / BM; nN = N / BM; nwg = nM * nN; G = G_; c = c_; }
    __host__ __device__ bool next(int i, Unit& u) const {
        const long L = (long)i * G + c; if (L >= nwg) return false;
        int wgid = (int)L; { const int q = nwg / NXCD, r = nwg % NXCD, xcd = wgid % NXCD, off = wgid / NXCD; wgid = (xcd < r ? xcd * (q + 1) : r * (q + 1) + (xcd - r) * q) + off; }
        const int nig = WGM * nN, gid = wgid / nig, fm = gid * WGM, gsz = (nM - fm) < WGM ? (nM - fm) : WGM;
        u.pm = fm + ((wgid % nig) % gsz); u.pn = (wgid % nig) / gsz; return true;
    }
    __device__ __forceinline__ void a_ready(const Unit&) const {}
    __device__ __forceinline__ void done(const Unit&) const {}
};

__device__ __forceinline__ unsigned cvt_pk_bf16(float lo, float hi) { unsigned r; asm volatile("v_cvt_pk_bf16_f32 %0, %1, %2" : "=v"(r) : "v"(lo), "v"(hi)); return r; }
typedef float f32x2 __attribute__((ext_vector_type(2)));

typedef int i32x4 __attribute__((ext_vector_type(4)));
__device__ __forceinline__ void dma4(const float* g, PG8_LAS unsigned char* l) { __builtin_amdgcn_global_load_lds((const unsigned*)g, (PG8_LAS unsigned*)l, 4, 0, 0); }
template <bool OUT_F8> struct EpiBf16T {
    static constexpr bool PERM = true, AFTER_DRAIN = false; static constexpr int NST = OUT_F8 ? 8 : 16;
    bf16_t* O; int ldc; const float* bias; int split_cols; size_t split_stride; PG8_LAS unsigned char* sp;
    const float* csc = nullptr; float cmul = 1.0f;
    __device__ __forceinline__ void prefetch(const Unit& u, int wid, int lane) const {
        if (bias && wid < 4) dma4(bias + u.pn * BM + wid * 64 + lane, sp + wid * 256);
        if (csc && wid >= 4) dma4(csc + u.pn * BM + (wid - 4) * 64 + lane, sp + 1024 + (wid - 4) * 256);
    }
    __device__ __forceinline__ void operator()(const f32x4 (&acc)[2][2][4][2], const Unit& u, int wr, int wc, int fr, int fq) const {
        const int row0 = u.pm * BM + wr * 64 + fr; int colt = u.pn * BM; bf16_t* base = O;
        if (split_cols) { const int t = colt / split_cols; base += (size_t)t * split_stride; colt -= t * split_cols; }
        const int col0 = colt + wc * 32 + 8 * fq;
        f32x4 bv[2][2];
#pragma unroll
        for (int bj = 0; bj < 2; ++bj)
#pragma unroll
            for (int n = 0; n < 2; ++n) bv[bj][n] = bias ? *(const PG8_LAS f32x4*)(sp + 4 * (bj * HALF + wc * 32 + 8 * fq + 4 * n)) : (f32x4){0.f, 0.f, 0.f, 0.f};
        f32x4 cv[2][2];
#pragma unroll
        for (int bj = 0; bj < 2; ++bj)
#pragma unroll
            for (int n = 0; n < 2; ++n) cv[bj][n] = csc ? *(const PG8_LAS f32x4*)(sp + 1024 + 4 * (bj * HALF + wc * 32 + 8 * fq + 4 * n)) * cmul : (f32x4){1.f, 1.f, 1.f, 1.f};
#pragma unroll
        for (int ai = 0; ai < 2; ++ai)
#pragma unroll
            for (int m = 0; m < 4; ++m) { bf16_t* rowp = base + (size_t)(row0 + ai * HALF + m * 16) * ldc + col0;
                if constexpr (OUT_F8) { unsigned w[4];
#pragma unroll
                    for (int bj = 0; bj < 2; ++bj) { f32x4 v0 = acc[ai][bj][m][0] * cv[bj][0] + bv[bj][0], v1 = acc[ai][bj][m][1] * cv[bj][1] + bv[bj][1]; unsigned w0 = 0u, w1 = 0u;
#pragma unroll
                        for (int q = 0; q < 4; ++q) { v0[q] = __builtin_amdgcn_fmed3f(v0[q], -448.0f, 448.0f); v1[q] = __builtin_amdgcn_fmed3f(v1[q], -448.0f, 448.0f); }
                        w0 = __builtin_amdgcn_cvt_pk_fp8_f32(v0[0], v0[1], w0, false); w0 = __builtin_amdgcn_cvt_pk_fp8_f32(v0[2], v0[3], w0, true);
                        w1 = __builtin_amdgcn_cvt_pk_fp8_f32(v1[0], v1[1], w1, false); w1 = __builtin_amdgcn_cvt_pk_fp8_f32(v1[2], v1[3], w1, true);
                        w[2 * bj] = w0; w[2 * bj + 1] = w1; }
                    *(u32x4*)((unsigned char*)base + (size_t)(row0 + ai * HALF + m * 16) * ldc + colt + 64 * wc + 16 * fq) = (u32x4){w[0], w[1], w[2], w[3]}; }
                else {
#pragma unroll
                    for (int bj = 0; bj < 2; ++bj) { const f32x4 v0 = acc[ai][bj][m][0] * cv[bj][0] + bv[bj][0], v1 = acc[ai][bj][m][1] * cv[bj][1] + bv[bj][1];
                        u32x4 w; w.x = cvt_pk_bf16(v0[0], v0[1]); w.y = cvt_pk_bf16(v0[2], v0[3]); w.z = cvt_pk_bf16(v1[0], v1[1]); w.w = cvt_pk_bf16(v1[2], v1[3]);
                        *(u32x4*)(rowp + bj * HALF) = w; } } }
    }
};
typedef EpiBf16T<false> EpiBf16;
struct EpiNullI8 {
    static constexpr bool PERM = true, AFTER_DRAIN = false; static constexpr int NST = 0;
    __device__ __forceinline__ void prefetch(const Unit&, int, int) const {}
    __device__ __forceinline__ void operator()(const i32x4 (&acc)[2][2][4][2], const Unit&, int, int, int, int) const {
#pragma unroll
        for (int a = 0; a < 2; ++a)
#pragma unroll
            for (int b = 0; b < 2; ++b)
#pragma unroll
                for (int m = 0; m < 4; ++m)
#pragma unroll
                    for (int n = 0; n < 2; ++n) asm volatile("" :: "v"(acc[a][b][m][n]));
    }
};
struct EpiI8Bf16 {
    static constexpr bool PERM = true, AFTER_DRAIN = false; static constexpr int NST = 16;
    bf16_t* O; int ldc; const float* rsc; const float* csc; PG8_LAS unsigned char* sp;
    __device__ __forceinline__ void prefetch(const Unit& u, int wid, int lane) const {
        if (wid < 4) dma4(rsc + u.pm * BM + wid * 64 + lane, sp + wid * 256);
        else dma4(csc + u.pn * BM + (wid - 4) * 64 + lane, sp + 1024 + (wid - 4) * 256);
    }
    __device__ __forceinline__ void operator()(const i32x4 (&acc)[2][2][4][2], const Unit& u, int wr, int wc, int fr, int fq) const {
        const int row0 = u.pm * BM + wr * 64 + fr, col0 = u.pn * BM + wc * 32 + 8 * fq;
        const PG8_LAS float* spf = (const PG8_LAS float*)sp;
        f32x4 cv[2][2];
#pragma unroll
        for (int bj = 0; bj < 2; ++bj)
#pragma unroll
            for (int n = 0; n < 2; ++n) cv[bj][n] = *(const PG8_LAS f32x4*)(spf + 256 + bj * HALF + wc * 32 + 8 * fq + 4 * n);
#pragma unroll
        for (int ai = 0; ai < 2; ++ai)
#pragma unroll
            for (int m = 0; m < 4; ++m) { const int row = row0 + ai * HALF + m * 16; const float rs = spf[ai * HALF + wr * 64 + m * 16 + fr]; bf16_t* rowp = O + (size_t)row * ldc + col0;
#pragma unroll
                for (int bj = 0; bj < 2; ++bj) { float v[8];
#pragma unroll
                    for (int n = 0; n < 2; ++n)
#pragma unroll
                        for (int q = 0; q < 4; ++q) v[4 * n + q] = (float)acc[ai][bj][m][n][q] * (rs * cv[bj][n][q]);
                    u32x4 w; w.x = cvt_pk_bf16(v[0], v[1]); w.y = cvt_pk_bf16(v[2], v[3]); w.z = cvt_pk_bf16(v[4], v[5]); w.w = cvt_pk_bf16(v[6], v[7]);
                    *(u32x4*)(rowp + bj * HALF) = w; } }
    }
};
__device__ __forceinline__ float swiglu_c(float g, float l) {
    g = fminf(g, 7.0f); l = fminf(fmaxf(l, -7.0f), 7.0f);
    const float s = __builtin_amdgcn_rcpf(1.0f + __builtin_amdgcn_exp2f(g * (-1.702f * 1.4426950408889634f)));
    return g * s * (l + 1.0f);
}
typedef float f32x2e __attribute__((ext_vector_type(2)));
__device__ __forceinline__ f32x2e swiglu_pk(f32x2e g, f32x2e l) {
    g.x = fminf(g.x, 7.0f); g.y = fminf(g.y, 7.0f);
    l.x = __builtin_amdgcn_fmed3f(l.x, -7.0f, 7.0f); l.y = __builtin_amdgcn_fmed3f(l.y, -7.0f, 7.0f);
    const f32x2e z = g * (-1.702f * 1.4426950408889634f);
    f32x2e d; d.x = __builtin_amdgcn_exp2f(z.x); d.y = __builtin_amdgcn_exp2f(z.y);
    d = d + 1.0f;
    f32x2e s; s.x = __builtin_amdgcn_rcpf(d.x); s.y = __builtin_amdgcn_rcpf(d.y);
    return (g * s) * (l + 1.0f);
}
typedef unsigned pg_u32x2 __attribute__((ext_vector_type(2)));
constexpr float ACT_F8_SCALE = 4.0f;
template <bool ACT_F8> struct EpiMoeUpT {
    static constexpr bool PERM = true, AFTER_DRAIN = false; static constexpr int NST = 8;
    bf16_t* O; const float* bias; const float* rsc; const float* csc; PG8_LAS unsigned char* sp;
    __device__ __forceinline__ void prefetch(const Unit& u, int wid, int lane) const {
        const int e = u.pn >> 3, pnl = u.pn & 7;
        if (wid < 4) dma4(rsc + u.pm * BM + wid * 64 + lane, sp + wid * 256);
        else if (wid < 6) { const float* b = bias + (size_t)e * 2048 + pnl * HALF + (wid - 4) * 64 + lane; dma4(b, sp + 1024 + (wid - 4) * 256); dma4(b + 1024, sp + 1536 + (wid - 4) * 256); }
        else { const float* c = csc + (size_t)e * 2048 + pnl * 256 + (wid - 6) * 64 + lane; dma4(c, sp + 2048 + (wid - 6) * 256); dma4(c + HALF, sp + 2560 + (wid - 6) * 256); }
    }
    __device__ __forceinline__ void operator()(const i32x4 (&acc)[2][2][4][2], const Unit& u, int wr, int wc, int fr, int fq) const {
        const int pnl = u.pn & 7;
        const int row0 = u.pm * BM + wr * 64 + fr, cg0 = pnl * HALF + wc * 32 + 8 * fq;
        const PG8_LAS float* spf = (const PG8_LAS float*)sp; const int cl = wc * 32 + 8 * fq;
        f32x4 bgv[2], blv[2], sgv[2], slv[2];
#pragma unroll
        for (int n = 0; n < 2; ++n) { bgv[n] = *(const PG8_LAS f32x4*)(spf + 256 + cl + 4 * n); blv[n] = *(const PG8_LAS f32x4*)(spf + 384 + cl + 4 * n); sgv[n] = *(const PG8_LAS f32x4*)(spf + 512 + cl + 4 * n); slv[n] = *(const PG8_LAS f32x4*)(spf + 640 + cl + 4 * n); }
#pragma unroll
        for (int ai = 0; ai < 2; ++ai)
#pragma unroll
            for (int m = 0; m < 4; ++m) { const int row = row0 + ai * HALF + m * 16; bf16_t* rowp = O + (size_t)row * 1024 + cg0; const float rs = spf[ai * HALF + wr * 64 + m * 16 + fr];
                float a[8];
#pragma unroll
                for (int n = 0; n < 2; ++n) {
#pragma unroll
                    for (int q = 0; q < 4; q += 2) {
                        const f32x2e gi = (f32x2e){(float)acc[ai][0][m][n][q], (float)acc[ai][0][m][n][q + 1]}, li = (f32x2e){(float)acc[ai][1][m][n][q], (float)acc[ai][1][m][n][q + 1]};
                        const f32x2e sg2 = (f32x2e){sgv[n][q], sgv[n][q + 1]} * rs, sl2 = (f32x2e){slv[n][q], slv[n][q + 1]} * rs;
                        const f32x2e r = swiglu_pk(gi * sg2 + (f32x2e){bgv[n][q], bgv[n][q + 1]}, li * sl2 + (f32x2e){blv[n][q], blv[n][q + 1]});
                        a[4 * n + q] = r.x; a[4 * n + q + 1] = r.y; } }
                if constexpr (ACT_F8) { unsigned w0 = 0u, w1 = 0u;
                    w0 = __builtin_amdgcn_cvt_pk_fp8_f32(a[0] * ACT_F8_SCALE, a[1] * ACT_F8_SCALE, w0, false); w0 = __builtin_amdgcn_cvt_pk_fp8_f32(a[2] * ACT_F8_SCALE, a[3] * ACT_F8_SCALE, w0, true);
                    w1 = __builtin_amdgcn_cvt_pk_fp8_f32(a[4] * ACT_F8_SCALE, a[5] * ACT_F8_SCALE, w1, false); w1 = __builtin_amdgcn_cvt_pk_fp8_f32(a[6] * ACT_F8_SCALE, a[7] * ACT_F8_SCALE, w1, true);
                    *(pg_u32x2*)((unsigned char*)O + (size_t)row * 1024 + cg0) = (pg_u32x2){w0, w1}; }
                else { u32x4 w; w.x = cvt_pk_bf16(a[0], a[1]); w.y = cvt_pk_bf16(a[2], a[3]); w.z = cvt_pk_bf16(a[4], a[5]); w.w = cvt_pk_bf16(a[6], a[7]);
                    *(u32x4*)rowp = w; } }
    }
};
typedef EpiMoeUpT<false> EpiMoeUp;
struct EpiMoeUpNoLoad {
    static constexpr bool PERM = true, AFTER_DRAIN = false; static constexpr int NST = 8;
    __device__ __forceinline__ void prefetch(const Unit&, int, int) const {}
    bf16_t* O; float k0, k1;
    __device__ __forceinline__ void operator()(const i32x4 (&acc)[2][2][4][2], const Unit& u, int wr, int wc, int fr, int fq) const {
        const int pnl = u.pn & 7;
        const int row0 = u.pm * BM + wr * 64 + fr, cg0 = pnl * HALF + wc * 32 + 8 * fq;
#pragma unroll
        for (int ai = 0; ai < 2; ++ai)
#pragma unroll
            for (int m = 0; m < 4; ++m) { const int row = row0 + ai * HALF + m * 16; bf16_t* rowp = O + (size_t)row * 1024 + cg0;
                float a[8];
#pragma unroll
                for (int n = 0; n < 2; ++n) {
#pragma unroll
                    for (int q = 0; q < 4; ++q) { const float g = (float)acc[ai][0][m][n][q] * k0 + k1, l = (float)acc[ai][1][m][n][q] * k0 + k1;
                        a[4 * n + q] = swiglu_c(g, l); } }
                u32x4 w; w.x = cvt_pk_bf16(a[0], a[1]); w.y = cvt_pk_bf16(a[2], a[3]); w.z = cvt_pk_bf16(a[4], a[5]); w.w = cvt_pk_bf16(a[6], a[7]);
                *(u32x4*)rowp = w; }
    }
};
struct EpiMoeUpNoStore {
    static constexpr bool PERM = true, AFTER_DRAIN = false; static constexpr int NST = 8;
    __device__ __forceinline__ void prefetch(const Unit&, int, int) const {}
    bf16_t* O; float k0, k1;
    __device__ __forceinline__ void operator()(const i32x4 (&acc)[2][2][4][2], const Unit& u, int wr, int wc, int fr, int fq) const {
        const int pnl = u.pn & 7;
        const int row0 = u.pm * BM + wr * 64 + fr, cg0 = pnl * HALF + wc * 32 + 8 * fq;
#pragma unroll
        for (int ai = 0; ai < 2; ++ai)
#pragma unroll
            for (int m = 0; m < 4; ++m) { const int row = row0 + ai * HALF + m * 16; bf16_t* rowp = O + (size_t)row * 1024 + cg0;
                float a[8];
#pragma unroll
                for (int n = 0; n < 2; ++n) {
#pragma unroll
                    for (int q = 0; q < 4; ++q) { const float g = (float)acc[ai][0][m][n][q] * k0 + k1, l = (float)acc[ai][1][m][n][q] * k0 + k1;
                        a[4 * n + q] = swiglu_c(g, l); } }
                u32x4 w; w.x = cvt_pk_bf16(a[0], a[1]); w.y = cvt_pk_bf16(a[2], a[3]); w.z = cvt_pk_bf16(a[4], a[5]); w.w = cvt_pk_bf16(a[6], a[7]);
                if (ai == 0 && m == 0) *(u32x4*)rowp = w; else asm volatile("" :: "v"(w)); }
    }
};
template <int SH> struct MoeOrder {
    const PG8_LAS int* ts; int G, c, total; int tsv;
    __device__ __forceinline__ bool next(int i, Unit& u) const {
        const int L = i * G + c; if (L >= total) return false;
        const int pm = L >> SH, pnl = L & ((1 << SH) - 1);
        const unsigned long long mk = __builtin_amdgcn_ballot_w64(pm >= tsv);
        const int e = __builtin_popcount((unsigned)mk & 0xfffffffeu);
        u.pm = pm; u.pn = (e << SH) + pnl; return true;
    }
    __device__ __forceinline__ void a_ready(const Unit&) const {}
    __device__ __forceinline__ void done(const Unit&) const {}
};
typedef int i32x4 __attribute__((ext_vector_type(4)));
template <bool I8> struct AccSel { typedef f32x4 T; };
template <> struct AccSel<true> { typedef i32x4 T; };
template <bool I8> __device__ __forceinline__ typename AccSel<I8>::T mma16(bf16x8 b, bf16x8 a, typename AccSel<I8>::T c) {
    if constexpr (I8) return __builtin_amdgcn_mfma_i32_16x16x64_i8(__builtin_bit_cast(i32x4, b), __builtin_bit_cast(i32x4, a), c, 0, 0, 0);
    else return __builtin_amdgcn_mfma_f32_16x16x32_bf16(b, a, c, 0, 0, 0);
}
typedef int i32x8 __attribute__((ext_vector_type(8)));
__device__ __forceinline__ f32x4 mma_f8(bf16x8 b0, bf16x8 b1, bf16x8 a0, bf16x8 a1, f32x4 c) {
    const i32x4 bl = __builtin_bit_cast(i32x4, b0), bh = __builtin_bit_cast(i32x4, b1), al = __builtin_bit_cast(i32x4, a0), ah = __builtin_bit_cast(i32x4, a1);
    const i32x8 bb = (i32x8){bl[0], bl[1], bl[2], bl[3], bh[0], bh[1], bh[2], bh[3]}, aa = (i32x8){al[0], al[1], al[2], al[3], ah[0], ah[1], ah[2], ah[3]};
    return __builtin_amdgcn_mfma_scale_f32_16x16x128_f8f6f4(bb, aa, c, 0, 0, 0, 0, 0, 0);
}
template <class Epi, class Sched, bool ALIGN_EPI = false, bool SP2 = false, bool I8 = false, bool GATHER = false, bool F8 = false>
__device__ __forceinline__ void gemm_phase(PG8_LAS unsigned char* lds, const Gemm g, const Sched& S, const Epi& E, const int* rowmap = nullptr) {
    int tid_ = threadIdx.x; asm volatile("" : "+v"(tid_));
    const int tid = tid_, wid = __builtin_amdgcn_readfirstlane(tid >> 6), lane = tid & 63, wr = wid >> 2, wc = wid & 3, fr = lane & 15, fq = lane >> 4;
    const int K = g.K, nt = K / BK;
    unsigned voffA, voffB;
    { int R, C; stage_rc(tid * 16, R, C); const int Rb = Epi::PERM ? ((R & ~31) + perm32(R & 31)) : R;
        voffA = (unsigned)(R * K + C) * 2u; voffB = (unsigned)(Rb * K + C) * 2u; }
    const size_t pstep = (size_t)128 * K;
    unsigned offA[2][2];
    constexpr int RM_OFF = STAGE_BYTES + 1024 + 3072;
    const size_t kstep = (size_t)(BK * 2);
    const size_t hstep = (size_t)HALF * K * 2;
    const size_t tstep = 2 * hstep;
    const unsigned ldsw = (unsigned)wid * 1024u;
    const int aoff = lds_byte(wr * 64 + fr, fq * 8), boff = lds_byte(wc * 32 + fr, fq * 8);
#define PG8_SA(b, h) (((b) * 2 + (h)) * HTB)
#define PG8_SB(b, h) ((4 + (b) * 2 + (h)) * HTB)
#define PG8_STAGE(bufoff, gbase, voff) do { _Pragma("unroll") for (int _i = 0; _i < 2; ++_i) \
        __builtin_amdgcn_global_load_lds((const unsigned*)((const char*)(gbase) + (_i ? pstep : (size_t)0) + (voff)), (PG8_LAS unsigned*)(lds + (bufoff) + ldsw + _i * 8192), 16, 0, 0); } while (0)
#define PG8_STAGE_A(bufoff, gbase, h, nextu) do { if constexpr (GATHER) { _Pragma("unroll") for (int _i = 0; _i < 2; ++_i) \
        __builtin_amdgcn_global_load_lds((const unsigned*)((const char*)(gbase) + offA[h][_i]), (PG8_LAS unsigned*)(lds + (bufoff) + ldsw + _i * 8192), 16, 0, 0); } \
    else { PG8_STAGE(bufoff, (gbase) + (h) * hstep, voffA); } } while (0)
#define PG8_GOFF(SRCEXPR) do { _Pragma("unroll") for (int _h = 0; _h < 2; ++_h) _Pragma("unroll") for (int _i = 0; _i < 2; ++_i) { int R_, C_; stage_rc(tid * 16 + _i * 8192, R_, C_); \
        const int ri_ = _h * HALF + R_; offA[_h][_i] = (unsigned)(SRCEXPR) * (unsigned)(K * 2) + (unsigned)(C_ * 2); } } while (0)
#define PG8_LDA(dst, b, h) do { _Pragma("unroll") for (int m = 0; m < 4; ++m) _Pragma("unroll") for (int k = 0; k < 2; ++k) dst[m][k] = *(const PG8_LAS bf16x8*)(lds + PG8_SA(b, h) + aoff + m * 2048 + k * 1024); } while (0)
#define PG8_LDB(dst, b, h) do { _Pragma("unroll") for (int n = 0; n < 2; ++n) _Pragma("unroll") for (int k = 0; k < 2; ++k) dst[n][k] = *(const PG8_LAS bf16x8*)(lds + PG8_SB(b, h) + boff + n * 2048 + k * 1024); } while (0)
#define PG8_MMA(ai, bj, At, Bt) do { __builtin_amdgcn_s_setprio(1); _Pragma("unroll") for (int m = 0; m < 4; ++m) _Pragma("unroll") for (int n = 0; n < 2; ++n) { \
        if constexpr (F8) { const f32x4 c_ = n ? __builtin_shufflevector(acc8[ai][bj][m], acc8[ai][bj][m], 4, 5, 6, 7) : __builtin_shufflevector(acc8[ai][bj][m], acc8[ai][bj][m], 0, 1, 2, 3); \
            const f32x4 d_ = mma_f8(Bt[n][0], Bt[n][1], At[m][0], At[m][1], c_); \
            if (n) { acc8[ai][bj][m][4] = d_[0]; acc8[ai][bj][m][5] = d_[1]; acc8[ai][bj][m][6] = d_[2]; acc8[ai][bj][m][7] = d_[3]; } else { acc8[ai][bj][m][0] = d_[0]; acc8[ai][bj][m][1] = d_[1]; acc8[ai][bj][m][2] = d_[2]; acc8[ai][bj][m][3] = d_[3]; } } \
        else { _Pragma("unroll") for (int k = 0; k < 2; ++k) acc[ai][bj][m][n] = mma16<I8>(Bt[n][k], At[m][k], acc[ai][bj][m][n]); } } __builtin_amdgcn_s_setprio(0); } while (0)
#define PG8_WAIT_V(n) asm volatile("s_waitcnt vmcnt(" #n ")" ::: "memory")
#define PG8_WAIT_L(n) asm volatile("s_waitcnt lgkmcnt(" #n ")" ::: "memory")
#define PG8_WAIT_VR(fl) do { if constexpr (F8) { PG8_WAIT_V(8); } else asm volatile("s_waitcnt vmcnt(%1)\n\tv_cmp_ne_u32_e32 vcc, 0, %0\n\ts_cbranch_vccnz 1f\n\ts_waitcnt vmcnt(8)\n1:" :: "v"(fl), "n"(8 + Epi::NST) : "vcc", "memory"); } while (0)
#define PG8_BAR __builtin_amdgcn_s_barrier()
#define PG8_SCHED __builtin_amdgcn_sched_barrier(0)
    Unit cur, nxt; int ui = 0;
    if (!S.next(0, cur)) return;
    typedef typename AccSel<I8>::T acc4; acc4 acc[2][2][4][2];
    typedef float f32x8 __attribute__((ext_vector_type(8))); f32x8 acc8[2][2][4];
#pragma unroll
    for (int a = 0; a < 2; ++a)
#pragma unroll
        for (int b = 0; b < 2; ++b)
#pragma unroll
            for (int m = 0; m < 4; ++m)
#pragma unroll
                for (int n = 0; n < 2; ++n) { acc[a][b][m][n] = (acc4){0, 0, 0, 0}; if constexpr (F8) acc8[a][b][m] = (f32x8){0.f, 0.f, 0.f, 0.f, 0.f, 0.f, 0.f, 0.f}; }
    bf16x8 At[4][2], B0[2][2], B1[2][2];
    const char* cA = GATHER ? (const char*)g.A : (const char*)g.A + (size_t)cur.pm * tstep; const char* cB = (const char*)g.Bt + (size_t)cur.pn * tstep;
    if constexpr (GATHER) { PG8_GOFF(rowmap[cur.pm * BM + ri_]); }
    S.a_ready(cur);
    if constexpr (SP2) {
        PG8_STAGE(PG8_SB(0, 0), cB, voffB); PG8_STAGE(PG8_SB(0, 1), cB + hstep, voffB); PG8_STAGE_A(PG8_SA(0, 0), cA, 0, false); PG8_STAGE_A(PG8_SA(0, 1), cA, 1, false);
        if (wr == 1) PG8_BAR;
        PG8_WAIT_V(2); PG8_BAR;
        PG8_STAGE(PG8_SB(1, 0), cB + kstep, voffB); PG8_STAGE_A(PG8_SA(1, 0), cA + kstep, 0, false); PG8_STAGE(PG8_SB(1, 1), cB + hstep + kstep, voffB);
        PG8_STAGE_A(PG8_SA(1, 1), cA + kstep, 1, false);
        PG8_WAIT_V(8); PG8_BAR;
    } else {
        PG8_STAGE(PG8_SB(0, 0), cB, voffB); PG8_STAGE_A(PG8_SA(0, 0), cA, 0, false); PG8_STAGE(PG8_SB(0, 1), cB + hstep, voffB); PG8_STAGE_A(PG8_SA(0, 1), cA, 1, false);
        if (wr == 1) PG8_BAR;
        PG8_WAIT_V(4); PG8_BAR;
        PG8_STAGE(PG8_SB(1, 0), cB + kstep, voffB); PG8_STAGE_A(PG8_SA(1, 0), cA + kstep, 0, false); PG8_STAGE(PG8_SB(1, 1), cB + hstep + kstep, voffB);
        PG8_WAIT_V(6); PG8_BAR;
    }
    for (;;) {
        const bool has_next = S.next(ui + 1, nxt);
        if constexpr (GATHER) { if (has_next && wid < 4) __builtin_amdgcn_global_load_lds((const unsigned*)(rowmap + nxt.pm * BM + wid * 64 + lane), (PG8_LAS unsigned*)(lds + RM_OFF + wid * 256), 4, 0, 0); }
        const char* nA = (has_next && !GATHER) ? (const char*)g.A + (size_t)nxt.pm * tstep : cA; const char* nB = has_next ? (const char*)g.Bt + (size_t)nxt.pn * tstep : cB;
        for (int t = 0; t < nt; t += 2) {
            const bool last = (t == nt - 2);
            asm volatile("" : "+v"(voffA), "+v"(voffB));
            const char* a1 = cA + (size_t)(t + 1) * kstep;
            const char* a2 = last ? nA : cA + (size_t)(t + 2) * kstep; const char* b2 = last ? nB : cB + (size_t)(t + 2) * kstep;
            const char* a3 = a2 + kstep; const char* b3 = b2 + kstep;
            if (last && has_next) S.a_ready(nxt);
            if (last) { int ln_ = lane; asm volatile("" : "+v"(ln_)); E.prefetch(cur, wid, ln_); }
            if constexpr (SP2) {
            const int fl = (t == 0 && ui > 0) ? 1 : 0;
            PG8_LDB(B0, 0, 0); PG8_LDB(B1, 0, 1); PG8_SCHED; PG8_LDA(At, 0, 0);
            if constexpr (GATHER) { if (last && has_next) { const PG8_LAS int* rm = (const PG8_LAS int*)(lds + RM_OFF); PG8_GOFF(rm[ri_]); } }
            PG8_WAIT_VR(fl); PG8_WAIT_L(0); PG8_BAR; PG8_MMA(0, 0, At, B0); PG8_MMA(0, 1, At, B1); PG8_BAR; PG8_SCHED;
            PG8_LDA(At, 0, 1); PG8_STAGE(PG8_SB(0, 0), b2, voffB); PG8_STAGE(PG8_SB(0, 1), b2 + hstep, voffB); PG8_STAGE_A(PG8_SA(0, 0), a2, 0, last);
            PG8_WAIT_VR(fl); PG8_WAIT_L(0); PG8_BAR; PG8_MMA(1, 0, At, B0); PG8_MMA(1, 1, At, B1); PG8_BAR; PG8_SCHED;
            PG8_LDB(B0, 1, 0); PG8_LDB(B1, 1, 1); PG8_SCHED; PG8_LDA(At, 1, 0); PG8_STAGE_A(PG8_SA(0, 1), a2, 1, last);
            PG8_WAIT_VR(fl); PG8_WAIT_L(0); PG8_BAR; PG8_MMA(0, 0, At, B0); PG8_MMA(0, 1, At, B1); PG8_BAR; PG8_SCHED;
            PG8_LDA(At, 1, 1); PG8_STAGE(PG8_SB(1, 0), b3, voffB); PG8_STAGE(PG8_SB(1, 1), b3 + hstep, voffB); PG8_STAGE_A(PG8_SA(1, 0), a3, 0, last);
            PG8_WAIT_V(8); PG8_WAIT_L(0); PG8_BAR; PG8_MMA(1, 0, At, B0); PG8_MMA(1, 1, At, B1); PG8_BAR; PG8_SCHED;
            PG8_STAGE_A(PG8_SA(1, 1), a3, 1, last);
            } else {
            PG8_LDB(B0, 0, 0); PG8_SCHED; PG8_LDA(At, 0, 0); PG8_STAGE_A(PG8_SA(1, 1), a1, 1, false);
            if constexpr (GATHER) { if (last && has_next) { const PG8_LAS int* rm = (const PG8_LAS int*)(lds + RM_OFF); PG8_GOFF(rm[ri_]); } }
            PG8_WAIT_L(8); PG8_BAR; PG8_WAIT_L(0); PG8_MMA(0, 0, At, B0); PG8_BAR; PG8_SCHED;
            PG8_LDB(B1, 0, 1); PG8_STAGE(PG8_SB(0, 0), b2, voffB);
            PG8_BAR; PG8_WAIT_L(0); PG8_MMA(0, 1, At, B1); PG8_BAR;
            PG8_LDA(At, 0, 1); PG8_STAGE_A(PG8_SA(0, 0), a2, 0, last);
            PG8_BAR; PG8_WAIT_L(0); PG8_MMA(1, 0, At, B0); PG8_BAR; PG8_SCHED;
            PG8_STAGE(PG8_SB(0, 1), b2 + hstep, voffB);
            PG8_WAIT_V(6); PG8_BAR; PG8_MMA(1, 1, At, B1); PG8_BAR;
            PG8_LDB(B0, 1, 0); PG8_SCHED; PG8_LDA(At, 1, 0); PG8_STAGE_A(PG8_SA(0, 1), a2, 1, last);
            PG8_WAIT_L(8); PG8_BAR; PG8_WAIT_L(0); PG8_MMA(0, 0, At, B0); PG8_BAR; PG8_SCHED;
            PG8_LDB(B1, 1, 1); PG8_STAGE(PG8_SB(1, 0), b3, voffB);
            PG8_BAR; PG8_WAIT_L(0); PG8_MMA(0, 1, At, B1); PG8_BAR;
            PG8_LDA(At, 1, 1); PG8_STAGE_A(PG8_SA(1, 0), a3, 0, last);
            PG8_BAR; PG8_WAIT_L(0); PG8_MMA(1, 0, At, B0); PG8_BAR; PG8_SCHED;
            PG8_STAGE(PG8_SB(1, 1), b3 + hstep, voffB);
            PG8_WAIT_V(6); PG8_BAR; PG8_MMA(1, 1, At, B1); PG8_BAR;
            }
        }
        if constexpr (ALIGN_EPI) { if (wr == 0) PG8_BAR; }
        if constexpr (F8 && !I8) {
#pragma unroll
            for (int a_ = 0; a_ < 2; ++a_)
#pragma unroll
                for (int b_ = 0; b_ < 2; ++b_)
#pragma unroll
                    for (int m = 0; m < 4; ++m) { acc[a_][b_][m][0] = __builtin_shufflevector(acc8[a_][b_][m], acc8[a_][b_][m], 0, 1, 2, 3); acc[a_][b_][m][1] = __builtin_shufflevector(acc8[a_][b_][m], acc8[a_][b_][m], 4, 5, 6, 7); } }
        if constexpr (!Epi::AFTER_DRAIN) { int t2_ = threadIdx.x; asm volatile("" : "+v"(t2_)); E(acc, cur, wr, wc, t2_ & 15, (t2_ & 63) >> 4); S.done(cur); }
        if (!has_next) break;
#pragma unroll
        for (int a = 0; a < 2; ++a)
#pragma unroll
            for (int b = 0; b < 2; ++b)
#pragma unroll
                for (int m = 0; m < 4; ++m)
#pragma unroll
                    for (int n = 0; n < 2; ++n) { acc[a][b][m][n] = (acc4){0, 0, 0, 0}; if constexpr (F8) acc8[a][b][m] = (f32x8){0.f, 0.f, 0.f, 0.f, 0.f, 0.f, 0.f, 0.f}; }
        cur = nxt; cA = nA; cB = nB; ++ui;
        if constexpr (ALIGN_EPI) { if (wr == 1) PG8_BAR; }
    }
    PG8_WAIT_V(0);
    if constexpr (!ALIGN_EPI) { if (wr == 0) PG8_BAR; }
    PG8_BAR;
    if constexpr (Epi::AFTER_DRAIN) { E.fused(acc, cur, wr, wc, fr, fq, lds, wid, lane); S.done(cur); }
#undef PG8_SA
#undef PG8_SB
#undef PG8_STAGE
#undef PG8_STAGE_A
#undef PG8_GOFF
#undef PG8_LDA
#undef PG8_LDB
#undef PG8_MMA
#undef PG8_WAIT_V
#undef PG8_WAIT_L
#undef PG8_WAIT_VR
#undef PG8_BAR
#undef PG8_SCHED
}
}
#include <hip/hip_bf16.h>
#include <cmath>
namespace attn_body {
using bf16=__hip_bfloat16;
using bf16x8=__attribute__((ext_vector_type(8)))short;
using s16x4=__attribute__((ext_vector_type(4)))short;
using f32x16=__attribute__((ext_vector_type(16)))float;
using u32x4=__attribute__((ext_vector_type(4)))unsigned;
constexpr float OSCALE=32.0f;
constexpr int BATCH=8,NHEAD=8,NKVH=2,SEQ=8192,D=64,PQ=2816,PO=1024;
constexpr int NW=8,QBLK=32,QB=QBLK*NW,KVBLK=64,NQB=SEQ/QB;
constexpr int ATTN_UNIT_ROWS=QB;
__device__ __forceinline__ int crow(int r,int hi){return (r&3)+8*(r>>2)+4*hi;}
#define SBAR() __builtin_amdgcn_sched_barrier(0)
__device__ __forceinline__ void cmask(f32x16&p0,f32x16&p1,int jb,int qrel,int hi){
  const float NEG=-INFINITY; int kb=64*jb+4*hi;
  #pragma unroll
  for(int r=0;r<16;++r){int kv=kb+(r&3)+8*(r>>2); if(kv>qrel)p0[r]=NEG; if(kv+32>qrel)p1[r]=NEG;}
}

constexpr int NSLOT=3, SLOTB=8192;
constexpr int LDS_K=0, LDS_V=NSLOT*SLOTB, LDS_WS=2*NSLOT*SLOTB, LDS_OST=LDS_WS+NW*64*4, LDS_BYTES=LDS_OST+NW*4096;
constexpr float C2=0.125f*1.4426950408889634f;
__device__ __forceinline__ void glds16(const void*gsrc,unsigned lds_dst){unsigned keep;
  asm volatile("s_mov_b32 %0, m0\n\ts_mov_b32 m0, %2\n\ts_nop 0\n\tglobal_load_lds_dwordx4 %1, off\n\ts_mov_b32 m0, %0":"=&s"(keep):"v"(gsrc),"s"(lds_dst):"memory");}
__device__ __forceinline__ float max3f(float a,float b,float c){float r;asm("v_max3_f32 %0, %1, %2, %3":"=v"(r):"v"(a),"v"(b),"v"(c));return r;}
__device__ __forceinline__ float max2f(float a,float b){float r;asm("v_max_f32_e32 %0, %1, %2":"=v"(r):"v"(a),"v"(b));return r;}
__device__ __forceinline__ float fadd_s(float a,float b){float r;asm("v_add_f32_e32 %0, %1, %2":"=v"(r):"v"(a),"v"(b));return r;}
__device__ __forceinline__ float fsub_s(float a,float b){float r;asm("v_sub_f32_e32 %0, %1, %2":"=v"(r):"v"(a),"v"(b));return r;}
typedef float f32x2_t __attribute__((ext_vector_type(2))); typedef __bf16 bf16x2_t __attribute__((ext_vector_type(2)));
__device__ __forceinline__ unsigned cvtpk_s(float lo,float hi){f32x2_t v={lo,hi};bf16x2_t b=__builtin_convertvector(v,bf16x2_t);return __builtin_bit_cast(unsigned,b);}
#define WAIT_BAR(N) asm volatile("s_waitcnt vmcnt(" #N ") lgkmcnt(0)\n\ts_barrier":::"memory")

__device__ __forceinline__ void qkt(f32x16&p0,f32x16&p1,const char*Kslot,const bf16x8*qr,const f32x16&negm,int r32,int hi){
  const char*kb=Kslot+hi*1024+r32*16;
  #pragma unroll
  for(int d0=0;d0<4;++d0){
    const bf16x8 b0=*reinterpret_cast<const bf16x8*>(kb+d0*2048);
    const bf16x8 b1=*reinterpret_cast<const bf16x8*>(kb+d0*2048+512);
    if(d0==0){p0=__builtin_amdgcn_mfma_f32_32x32x16_bf16(b0,qr[0],negm,0,0,0);p1=__builtin_amdgcn_mfma_f32_32x32x16_bf16(b1,qr[0],negm,0,0,0);}
    else{p0=__builtin_amdgcn_mfma_f32_32x32x16_bf16(b0,qr[d0],p0,0,0,0);p1=__builtin_amdgcn_mfma_f32_32x32x16_bf16(b1,qr[d0],p1,0,0,0);}}
}
typedef __attribute__((address_space(3))) const char* lds_cptr;
typedef short v4i16_t __attribute__((ext_vector_type(4)));
__device__ __forceinline__ void kload8(bf16x8*kf,lds_cptr kp){
  kf[0]=*(const __attribute__((address_space(3))) bf16x8*)(kp);      kf[1]=*(const __attribute__((address_space(3))) bf16x8*)(kp+512);
  kf[2]=*(const __attribute__((address_space(3))) bf16x8*)(kp+2048); kf[3]=*(const __attribute__((address_space(3))) bf16x8*)(kp+2560);
  kf[4]=*(const __attribute__((address_space(3))) bf16x8*)(kp+4096); kf[5]=*(const __attribute__((address_space(3))) bf16x8*)(kp+4608);
  kf[6]=*(const __attribute__((address_space(3))) bf16x8*)(kp+6144); kf[7]=*(const __attribute__((address_space(3))) bf16x8*)(kp+6656);
}
__device__ __forceinline__ void kload2(bf16x8*kf,lds_cptr kp,int j){ kf[2*j]=*(const __attribute__((address_space(3))) bf16x8*)(kp+j*2048); kf[2*j+1]=*(const __attribute__((address_space(3))) bf16x8*)(kp+j*2048+512); }
__device__ __forceinline__ s16x4 vtr(lds_cptr p){ return __builtin_bit_cast(s16x4,__builtin_amdgcn_ds_read_tr16_b64_v4i16((__attribute__((address_space(3))) v4i16_t*)p)); }
__device__ __forceinline__ float rowmax(const f32x16&p0,const f32x16&p1){
  float a=max3f(p0[0],p0[1],p1[0]),b=max3f(p0[2],p0[3],p1[1]);a=max3f(a,p1[2],p1[3]);
  #pragma unroll
  for(int r=4;r<16;r+=4){a=max3f(a,p0[r],p0[r+1]);b=max3f(b,p0[r+2],p0[r+3]);a=max3f(a,p1[r],p1[r+1]);b=max3f(b,p1[r+2],p1[r+3]);}
  const float m=max2f(a,b);
  auto rr=__builtin_amdgcn_permlane32_swap(__float_as_uint(m),__float_as_uint(m),false,false);
  return max2f(__uint_as_float(rr[0]),__uint_as_float(rr[1]));
}
__device__ __forceinline__ void pv(f32x16*o,int vb,bf16x8 pa0,bf16x8 pa1,bf16x8 pa2,bf16x8 pa3){
  #pragma unroll
  for(int d0=0;d0<2;++d0){s16x4 lo[4],hi[4];
    #pragma unroll
    for(int ks=0;ks<4;++ks){
      asm volatile("ds_read_b64_tr_b16 %0,%1 offset:%c2":"=&v"(lo[ks]):"v"(vb),"i"(d0*4096+ks*1024):"memory");
      asm volatile("ds_read_b64_tr_b16 %0,%1 offset:%c2":"=&v"(hi[ks]):"v"(vb),"i"(d0*4096+ks*1024+512):"memory");}
    asm volatile("s_waitcnt lgkmcnt(0)":::"memory");SBAR();
    #define PK(k) (bf16x8){lo[k][0],lo[k][1],lo[k][2],lo[k][3],hi[k][0],hi[k][1],hi[k][2],hi[k][3]}
    o[d0]=__builtin_amdgcn_mfma_f32_32x32x16_bf16(pa0,PK(0),o[d0],0,0,0);
    o[d0]=__builtin_amdgcn_mfma_f32_32x32x16_bf16(pa1,PK(1),o[d0],0,0,0);
    o[d0]=__builtin_amdgcn_mfma_f32_32x32x16_bf16(pa2,PK(2),o[d0],0,0,0);
    o[d0]=__builtin_amdgcn_mfma_f32_32x32x16_bf16(pa3,PK(3),o[d0],0,0,0);
    #undef PK
  }
}

#ifndef ATTN_STORE16
#define ATTN_STORE16(p,v) (*(u32x4*)(p)=(v))
#endif
template<int THRL> __device__ __forceinline__ void attn_unit(int b,int h,int qb,const bf16*Q,const bf16*__restrict__ K,const bf16*__restrict__ V,bf16*O,char*shm,const float*qg,const float nref){
  int tid_=threadIdx.x; asm volatile("":"+v"(tid_)); const int tid=tid_,lane=tid&63,r32=lane&31,hi=lane>>5; const int wid=__builtin_amdgcn_readfirstlane(tid>>6);
  const long rowbase=(long)b*SEQ; const int q0=qb*QB;
  const bf16*Qw=Q+(rowbase+q0+wid*QBLK)*PQ+h*D;
  const bf16*Kh=K+rowbase*PQ+(h>>2)*D,*Vh=V+rowbase*PQ+(h>>2)*D;
  const unsigned lds0=(unsigned)(uintptr_t)shm;
  float*wsf=(float*)(shm+LDS_WS)+wid*64;
  const bf16*ksrc=Kh+(long)lane*PQ+wid*8;
  const bf16*vsrc=Vh+(long)(16*(wid&3)+(lane>>2))*PQ+(wid>>2)*32+(lane&3)*8;
  const unsigned kdst=lds0+LDS_K+wid*1024, vdst=lds0+LDS_V+wid*1024;
  #define DMA_K(t,slot) glds16(ksrc+(long)(t)*KVBLK*PQ,(unsigned)__builtin_amdgcn_readfirstlane(kdst+(slot)))
  #define DMA_V(t,slot) glds16(vsrc+(long)(t)*KVBLK*PQ,(unsigned)__builtin_amdgcn_readfirstlane(vdst+(slot)))
  const int vb0=(int)(lds0+LDS_V)+((lane>>4)&1)*32+(lane&3)*8+(4*hi+((lane&15)>>2))*64;
  const char*Kbase=shm+LDS_K; bf16x8 kf[8];
  const lds_cptr shm3=(lds_cptr)shm; const lds_cptr kp0=shm3+LDS_K+hi*1024+r32*16; const lds_cptr vp0=shm3+LDS_V+((lane>>4)&1)*32+(lane&3)*8+(4*hi+((lane&15)>>2))*64;
  constexpr int NT=SEQ/KVBLK;
  DMA_K(0,0);DMA_V(0,0);DMA_K(1,SLOTB);
  bf16x8 qr[4];
  #pragma unroll
  for(int d0=0;d0<4;++d0)qr[d0]=*reinterpret_cast<const bf16x8*>(&Qw[(long)r32*PQ+d0*16+hi*8]);
  {
    float y[4][8]; float ss=0.f;
    #pragma unroll
    for(int d0=0;d0<4;++d0){
      #pragma unroll
      for(int j=0;j<8;++j){ y[d0][j]=__uint_as_float(((unsigned)(unsigned short)qr[d0][j])<<16); ss+=y[d0][j]*y[d0][j]; } }
    { auto rr=__builtin_amdgcn_permlane32_swap(__float_as_uint(ss),__float_as_uint(ss),false,false); ss=__uint_as_float(rr[0])+__uint_as_float(rr[1]); }
    const float rs=__builtin_amdgcn_rsqf(ss*(1.f/64.f)+1e-6f);
    const int spos=q0+wid*QBLK+r32; const float rid=(float)(spos>>6),cid=(float)(spos&63);
    #pragma unroll
    for(int j=0;j<8;++j){ const float fr=__builtin_amdgcn_exp2f(-(float)(8*hi+j)*(13.287712379549449f/16.f));
      const float cr=__cosf(rid*fr),sr=__sinf(rid*fr),cc=__cosf(cid*fr),sc=__sinf(cid*fr);
      const float a1=y[0][j]*rs*qg[8*hi+j],a2=y[1][j]*rs*qg[16+8*hi+j],b1=y[2][j]*rs*qg[32+8*hi+j],b2=y[3][j]*rs*qg[48+8*hi+j];
      y[0][j]=(a1*cr-a2*sr)*C2; y[1][j]=(a2*cr+a1*sr)*C2; y[2][j]=(b1*cc-b2*sc)*C2; y[3][j]=(b2*cc+b1*sc)*C2; }
    #pragma unroll
    for(int d0=0;d0<4;++d0){ u32x4 w; w.x=cvtpk_s(y[d0][0],y[d0][1]); w.y=cvtpk_s(y[d0][2],y[d0][3]); w.z=cvtpk_s(y[d0][4],y[d0][5]); w.w=cvtpk_s(y[d0][6],y[d0][7]); qr[d0]=__builtin_bit_cast(bf16x8,w); }
  }
  float l_reg=0.f;f32x16 o[2];o[0]=f32x16{};o[1]=f32x16{};f32x16 negm; _Pragma("unroll") for(int r=0;r<16;++r)negm[r]=nref; asm volatile("":"+v"(negm));
  #define CMASK(P0,P1,t) do{}while(0)
  #define START(P0,P1) do{ _Pragma("unroll") for(int r=0;r<16;++r)P0[r]=__builtin_amdgcn_exp2f(P0[r]); }while(0)
  #define RESC() do{}while(0)
  f32x16 pA0,pA1,pB0,pB1;
  int sl_prev=0,sl_cur=0,sl_next=SLOTB;
  #define ROT() do{sl_prev=sl_cur;sl_cur=sl_next;sl_next=(sl_next==(NSLOT-1)*SLOTB)?0:sl_next+SLOTB;}while(0)
  DMA_K(2,2*SLOTB);
  WAIT_BAR(3);
  qkt(pA0,pA1,Kbase,qr,negm,r32,hi);asm volatile("s_nop 15\n\ts_nop 7":"+v"(pA0),"+v"(pA1));CMASK(pA0,pA1,0);
  START(pA0,pA1);
  _Pragma("unroll") for(int r=0;r<16;++r)pA1[r]=__builtin_amdgcn_exp2f(pA1[r]);
  WAIT_BAR(0);
  DMA_K(3,0);DMA_V(1,SLOTB);
  ROT();
  kload8(kf,kp0+sl_cur);
  WAIT_BAR(2);
  s16x4 vlo[8],vhi[8]; u32x4 pw0,pw1,pw2,pw3;
  #define PKW(P,B) cvtpk_s(P[B],P[B+1])
  #define PAF(k) __builtin_bit_cast(bf16x8,pw##k)
  #define VFR(i) (bf16x8){vlo[i][0],vlo[i][1],vlo[i][2],vlo[i][3],vhi[i][0],vhi[i][1],vhi[i][2],vhi[i][3]}
  #define PIN(x) asm volatile("":"+v"(x))
  #define MX3(a,b,c) __builtin_fmaxf(__builtin_fmaxf((a),(b)),(c))
  #define GAPA(MF,A0,A1,A2,A3,W0,W1,PW) do{ MF; sacc+=A0; sacc+=A1; sacc+=A2; sacc+=A3; PIN(sacc); W0; W1; PIN(PW); SBAR(); }while(0)
  #define EX(v) __builtin_amdgcn_exp2f(v)
  #define GAPB(MF,X,B) do{ MF; X[B]=EX(X[B]); X[B+1]=EX(X[B+1]); X[B+2]=EX(X[B+2]); X[B+3]=EX(X[B+3]); PIN(X); SBAR(); }while(0)
  #define VRD(i) do{ vlo[i]=vtr(vp_+(((i)>>2)*4096+((i)&3)*1024)); vhi[i]=vtr(vp_+(((i)>>2)*4096+((i)&3)*1024+512)); }while(0)
  #define KRD(G,j) do{ if(G){ kload2(kf,kp0+sl_next,j); SBAR(); } }while(0)
  #define STEP(C0,C1,P0,P1,t,GK,GV,GL) do{ SBAR(); \
    const lds_cptr vp_=vp0+sl_prev; \
    VRD(0); SBAR(); float sacc=(P0[0]+P0[1]); \
    GAPA(C0=__builtin_amdgcn_mfma_f32_32x32x16_bf16(kf[0],qr[0],negm,0,0,0), P0[2],P0[3],P0[4],P0[5],     pw0[0]=PKW(P0,0), pw0[1]=PKW(P0,2), pw0); \
    VRD(4); SBAR(); GAPA(C1=__builtin_amdgcn_mfma_f32_32x32x16_bf16(kf[1],qr[0],negm,0,0,0), P0[6],P0[7],P0[8],P0[9],     pw0[2]=PKW(P0,4), pw0[3]=PKW(P0,6), pw0); \
    VRD(1); SBAR(); GAPA(C0=__builtin_amdgcn_mfma_f32_32x32x16_bf16(kf[2],qr[1],C0,0,0,0),   P0[10],P0[11],P0[12],P0[13], pw1[0]=PKW(P0,8), pw1[1]=PKW(P0,10), pw1); \
    VRD(5); SBAR(); GAPA(C1=__builtin_amdgcn_mfma_f32_32x32x16_bf16(kf[3],qr[1],C1,0,0,0),   P0[14],P0[15],P1[0],P1[1],   pw1[2]=PKW(P0,12),pw1[3]=PKW(P0,14), pw1); \
    VRD(2); SBAR(); GAPA(C0=__builtin_amdgcn_mfma_f32_32x32x16_bf16(kf[4],qr[2],C0,0,0,0),   P1[2],P1[3],P1[4],P1[5],     pw2[0]=PKW(P1,0), pw2[1]=PKW(P1,2), pw2); \
    VRD(6); SBAR(); GAPA(C1=__builtin_amdgcn_mfma_f32_32x32x16_bf16(kf[5],qr[2],C1,0,0,0),   P1[6],P1[7],P1[8],P1[9],     pw2[2]=PKW(P1,4), pw2[3]=PKW(P1,6), pw2); \
    VRD(3); SBAR(); GAPA(C0=__builtin_amdgcn_mfma_f32_32x32x16_bf16(kf[6],qr[3],C0,0,0,0),   P1[10],P1[11],P1[12],P1[13], pw3[0]=PKW(P1,8), pw3[1]=PKW(P1,10), pw3); \
    VRD(7); SBAR(); GAPA(C1=__builtin_amdgcn_mfma_f32_32x32x16_bf16(kf[7],qr[3],C1,0,0,0),   P1[14],P1[15],0.f,0.f,       pw3[2]=PKW(P1,12),pw3[3]=PKW(P1,14), pw3); \
    l_reg+=sacc; \
    if(GK){DMA_K((t)+3,sl_cur);} if(GV){DMA_V((t)+1,sl_next);} \
    CMASK(C0,C1,t); \
    SBAR(); \
    GAPB(o[0]=__builtin_amdgcn_mfma_f32_32x32x16_bf16(PAF(0),VFR(0),o[0],0,0,0), C0,0); \
    GAPB(o[1]=__builtin_amdgcn_mfma_f32_32x32x16_bf16(PAF(0),VFR(4),o[1],0,0,0), C0,4); \
    KRD(GL,0); GAPB(o[0]=__builtin_amdgcn_mfma_f32_32x32x16_bf16(PAF(1),VFR(1),o[0],0,0,0), C0,8); \
    KRD(GL,1); GAPB(o[1]=__builtin_amdgcn_mfma_f32_32x32x16_bf16(PAF(1),VFR(5),o[1],0,0,0), C0,12); \
    KRD(GL,2); GAPB(o[0]=__builtin_amdgcn_mfma_f32_32x32x16_bf16(PAF(2),VFR(2),o[0],0,0,0), C1,0); \
    KRD(GL,3); GAPB(o[1]=__builtin_amdgcn_mfma_f32_32x32x16_bf16(PAF(2),VFR(6),o[1],0,0,0), C1,4); \
    GAPB(o[0]=__builtin_amdgcn_mfma_f32_32x32x16_bf16(PAF(3),VFR(3),o[0],0,0,0), C1,8); \
    GAPB(o[1]=__builtin_amdgcn_mfma_f32_32x32x16_bf16(PAF(3),VFR(7),o[1],0,0,0), C1,12); \
    }while(0)
  int t=1;
  #undef CMASK
  #define CMASK(P0,P1,t) do{}while(0)
  for(;t+5<NT;t+=2){
    STEP(pB0,pB1,pA0,pA1,t,true,true,true);     WAIT_BAR(2); RESC(); ROT();
    STEP(pA0,pA1,pB0,pB1,t+1,true,true,true);   WAIT_BAR(2); RESC(); ROT();
  }
  #undef CMASK
  #define CMASK(P0,P1,t) do{}while(0)
  #define ENDW(tt) do{ if((tt)+3<NT){WAIT_BAR(2);} else if((tt)+2<NT){WAIT_BAR(1);} else {WAIT_BAR(0);} }while(0)
  for(;t+1<NT;t+=2){
    STEP(pB0,pB1,pA0,pA1,t,(t+3<NT),(t+1<NT),(t+1<NT));       ENDW(t);   RESC(); ROT();
    STEP(pA0,pA1,pB0,pB1,t+1,(t+4<NT),(t+2<NT),(t+2<NT));     ENDW(t+1); RESC(); ROT();
  }
  STEP(pB0,pB1,pA0,pA1,NT-1,false,false,false); RESC();
  { float sacc=pB0[0]+pB0[1]; _Pragma("unroll") for(int r=2;r<16;++r)sacc+=pB0[r]; _Pragma("unroll") for(int r=0;r<16;++r)sacc+=pB1[r]; l_reg+=sacc;
    pw0=(u32x4){PKW(pB0,0),PKW(pB0,2),PKW(pB0,4),PKW(pB0,6)};pw1=(u32x4){PKW(pB0,8),PKW(pB0,10),PKW(pB0,12),PKW(pB0,14)};pw2=(u32x4){PKW(pB1,0),PKW(pB1,2),PKW(pB1,4),PKW(pB1,6)};pw3=(u32x4){PKW(pB1,8),PKW(pB1,10),PKW(pB1,12),PKW(pB1,14)};
    SBAR(); pv(o,vb0+sl_cur,PAF(0),PAF(1),PAF(2),PAF(3)); }
  #undef PKW
  #undef PAF
  #undef VFR
  #undef PIN
  #undef MX3
  #undef GAPA
  #undef GAPB
  #undef EX
  #undef VRD
  #undef KRD
  #undef STEP
  #undef ENDW
  {auto rr=__builtin_amdgcn_permlane32_swap(__float_as_uint(l_reg),__float_as_uint(l_reg),false,false);l_reg=__uint_as_float(rr[0])+__uint_as_float(rr[1]);}
  if(hi==0)wsf[32+r32]=l_reg;asm volatile("s_waitcnt lgkmcnt(0)":::"memory");
  float rli[16];
  #pragma unroll
  for(int r=0;r<16;++r)rli[r]=__builtin_amdgcn_rcpf(wsf[32+crow(r,hi)]);
  unsigned char*Ow=(unsigned char*)O+(rowbase+q0+wid*QBLK)*PO+h*D;
  { unsigned char*stg=(unsigned char*)(shm+LDS_OST)+wid*2048;
    #pragma unroll
    for(int r=0;r<16;++r){const int orow=crow(r,hi); const float sc=rli[r]*OSCALE;
      #pragma unroll
      for(int d0=0;d0<2;++d0){ const float v=__builtin_amdgcn_fmed3f(o[d0][r]*sc,-448.0f,448.0f); stg[orow*64+d0*32+r32]=(unsigned char)(__builtin_amdgcn_cvt_pk_fp8_f32(v,0.f,0u,false)&0xffu); } }
    asm volatile("s_waitcnt lgkmcnt(0)":::"memory");
    #pragma unroll
    for(int i=0;i<2;++i){const int row=i*16+(lane>>2),ch=lane&3; const u32x4 v=*(const u32x4*)(stg+row*64+ch*16); ATTN_STORE16(Ow+(long)row*PO+ch*16,v);} }
  asm volatile("s_waitcnt lgkmcnt(0)\n\ts_barrier":::"memory");
  #undef DMA_K
  #undef DMA_V
  #undef CMASK
  #undef START
  #undef RESC
  #undef ROT
}
constexpr int ATTN_LDS_BYTES=LDS_BYTES;
struct AttnTensors { const bf16* Q; const bf16* K; const bf16* V; bf16* O; const float* qg; const float* kg; };
template<int THRL=8> __device__ __forceinline__ void attn_phase(char*lds,const AttnTensors&T,int vcu,int G){
  float gq=fabsf(T.qg[threadIdx.x&63]),gk=fabsf(T.kg[threadIdx.x&63]);
  gq=wmax64(gq); gk=wmax64(gk);
  const float nref=__uint_as_float(__builtin_amdgcn_readfirstlane(__float_as_uint(-(64.f*C2*gq*gk*1.02f+0.25f))));
  for(int L=vcu;L<BATCH*NHEAD*NQB;L+=G){
    const int pair=((L>>5)&7)*2+((L>>8)>>2), idx=(L&31)+32*((L>>8)&3);
    const int b=pair>>1, h=(pair&1)*4+(idx>>5), qb=idx&31;
    attn_unit<THRL>(b,h,qb,T.Q,T.K,T.V,T.O,lds,T.qg,nref);
  }
}
#undef SBAR
#undef WAIT_BAR
}
constexpr int NWAVES = 8;
constexpr int NTHR = NWAVES * 64;
constexpr int BATCH = 8, T = 8192, D = 1024, DEPTH = 2;
constexpr int M = BATCH * T;
constexpr int INW = 2816;
constexpr int C_QA = 0, C_KA = 512, C_VA = 640, C_QR = 768, C_KR = 1280, C_VR = 1792, C_GR = 2304;
constexpr int NE = 32, TOPK = 4, NASG = M * TOPK;
constexpr int XS_ROWS = NASG + NE * 256;
constexpr int RCH = 128, NCH = T / RCH, RH = 4;
constexpr int RUNITS = BATCH * RH * NCH;
constexpr float EPS = 1e-6f;
constexpr float LOG2E = 1.4426950408889634f;

constexpr size_t MiB = 1u << 20;
constexpr size_t WS_CTL = 0, CTL_ZERO_BYTES = 2 * MiB;
constexpr size_t WS_MOD = 512 * 1024;
constexpr size_t WS_CMAXIN = 256 * 1024, WS_CSCIN = 320 * 1024;
constexpr size_t WS_CMAX = 1 * MiB;
constexpr size_t WS_CSCDN = 1 * MiB;
constexpr size_t WS_CSCOUT = 1 * MiB + 256 * 1024;
constexpr float CAT_S_ATT = 32.0f, CAT_S_RET = 8.0f;
static_assert(attn_body::OSCALE == CAT_S_ATT, "attention output scale");
constexpr size_t WS_CSC = 1 * MiB + 512 * 1024;
constexpr size_t WS_WIN = 2 * MiB;
constexpr size_t WS_WOUT = 13 * MiB;
constexpr size_t WS_WUP = 17 * MiB;
constexpr size_t WS_WDN = 273 * MiB;
constexpr size_t WS_HM = 401 * MiB;
constexpr size_t WS_TOPI = 529 * MiB, WS_TOPW = 530 * MiB, WS_POS = 531 * MiB;
constexpr size_t WS_PROJ = 532 * MiB;
constexpr size_t WS_CAT = 884 * MiB;
constexpr size_t WS_YM = 1012 * MiB;
constexpr size_t WS_U = 1140 * MiB;
constexpr size_t WS_FT = 1396 * MiB;
constexpr size_t WS_XS = 532 * MiB;
constexpr size_t WS_ACT = 1060 * MiB;
constexpr size_t WS_HS = 1588 * MiB;
constexpr size_t WS_XSC = 1589 * MiB;
constexpr size_t WS_RMAP = 1591 * MiB;
constexpr size_t WS_END = 1593 * MiB;
constexpr size_t WS_DUMMY = 1593 * MiB;
static_assert(WS_MOD + (size_t)DEPTH * BATCH * 6 * D * 4 <= CTL_ZERO_BYTES, "mod inside the memset region");
static_assert(WS_XS + (size_t)XS_ROWS * 1024 * 2 <= WS_ACT && WS_ACT + (size_t)XS_ROWS * 1024 * 2 <= WS_END, "moe map");
static_assert(WS_PROJ + (size_t)M * INW * 2 <= WS_CAT && WS_FT + (size_t)RUNITS * 2 * 16384 * 2 <= WS_END, "mixer map");
constexpr int CW_TMO = 0, CW_CODE = 1;
constexpr int CW_BAR = 4096;
constexpr int CW_CNT = 8192;
constexpr int CW_WQ = 8192 + 1024;
constexpr int CW_CUR = 8192 + 256;

constexpr int RING_OFF = 0, RING_BYTES = 131072;
constexpr int LDSCTL_OFF = RING_BYTES;
constexpr int LCNT_OFF = LDSCTL_OFF, LTS_OFF = LDSCTL_OFF + 128, MISC_OFF = LDSCTL_OFF + 320;
constexpr int EPI_SP_OFF = LDSCTL_OFF + 1024;
constexpr int GAIN_OFF = LDSCTL_OFF + 6144;
constexpr int LDS_BYTES = 147456;
#define GAS __attribute__((address_space(1)))
#define LAS __attribute__((address_space(3)))
typedef unsigned short bf16;
typedef unsigned v4u __attribute__((ext_vector_type(4)));
typedef float f32x4 __attribute__((ext_vector_type(4)));
typedef short bf16x8 __attribute__((ext_vector_type(8)));
typedef GAS unsigned gu32;
typedef GAS unsigned long long gu64;
#define RLX_AGENT __ATOMIC_RELAXED, __HIP_MEMORY_SCOPE_AGENT
#define LDS_WAIT() asm volatile("s_waitcnt lgkmcnt(0)" ::: "memory")
#define VM_WAIT() asm volatile("s_waitcnt vmcnt(0)" ::: "memory")
__device__ __forceinline__ unsigned long long rt() { return __builtin_amdgcn_s_memrealtime(); }
__device__ __forceinline__ unsigned f2bf(float f) { unsigned u = __builtin_bit_cast(unsigned, f); return (u + 0x7fffu + ((u >> 16) & 1u)) >> 16; }
__device__ __forceinline__ unsigned pk2(float lo, float hi) { return f2bf(lo) | (f2bf(hi) << 16); }

#define XB_TMO      128
#define XB_XCNT(j)  (256  + 64 * (j))
#define XB_XSUB(j)  (1280 + 64 * (j))
#define XB_XGEN(j)  (2304 + 64 * (j))
#define XB_TOP      3328
#define XB_TOPGEN   3392
#define XCD_BAR_WORDS 3456
#define XB_SPIN_CAP (1u << 18)

__device__ __forceinline__ unsigned xb_ld(unsigned* p)              { return __hip_atomic_load(p, __ATOMIC_RELAXED, __HIP_MEMORY_SCOPE_AGENT); }
__device__ __forceinline__ unsigned xb_add(unsigned* p, unsigned v) { return __hip_atomic_fetch_add(p, v, __ATOMIC_RELAXED, __HIP_MEMORY_SCOPE_AGENT); }
__device__ __forceinline__ unsigned xb_xcc_id() { return (unsigned)__builtin_amdgcn_s_getreg((3 << 11) | 20) & 0xFu; }
#define XB_SPIN(cond, bar) do { unsigned _sp = 0; while (cond) { __builtin_amdgcn_s_sleep(1); \
    if ((++_sp & 255u) == 0u) { if (xb_ld(&(bar)[XB_TMO])) break; if (_sp > XB_SPIN_CAP) { atomicAdd(&(bar)[XB_TMO], 1u); break; } } } } while (0)

struct XcdBarrier {
    unsigned* bar; unsigned x;
    volatile LAS unsigned* st;
};

__device__ __forceinline__ XcdBarrier xcd_barrier_post(unsigned* bar, volatile LAS unsigned* st) {
    XcdBarrier b; b.bar = bar; b.x = xb_xcc_id(); b.st = st;
    if (threadIdx.x == 0) (void)xb_add(&bar[XB_XCNT(b.x)], 1u);
    return b;
}
__device__ __forceinline__ void xcd_barrier_complete(unsigned* bar, unsigned x, unsigned& nloc, unsigned& nx) {
    const unsigned G = gridDim.x * gridDim.y * gridDim.z;
    unsigned sum, cnt, mine, sp = 0u;
    for (;;) {
        sum = 0u; cnt = 0u; mine = 0u;
#pragma unroll
        for (unsigned j = 0; j < 16; ++j) { const unsigned c = xb_ld(&bar[XB_XCNT(j)]); sum += c; cnt += (c > 0u) ? 1u : 0u; mine = (j == x) ? c : mine; }
        if (sum == G) break;
        __builtin_amdgcn_s_sleep(1);
        if ((++sp & 255u) == 0u) { if (xb_ld(&bar[XB_TMO])) break; if (sp > XB_SPIN_CAP) { atomicAdd(&bar[XB_TMO], 1u); break; } }
    }
    nloc = mine > 0u ? mine : 1u; nx = cnt > 0u ? cnt : 1u;
}

__device__ __forceinline__ void xcd_barrier(const XcdBarrier& b) {
    asm volatile("s_waitcnt vmcnt(0)" ::: "memory");
    __syncthreads();
    if (threadIdx.x == 0) {
        unsigned* bar = b.bar;
        __builtin_amdgcn_s_waitcnt(0);
        unsigned nloc = b.st[0], nx = b.st[1];
        if (nloc == 0u) { xcd_barrier_complete(bar, b.x, nloc, nx); b.st[0] = nloc; b.st[1] = nx; }
        const unsigned old = xb_add(&bar[XB_XSUB(b.x)], 1u);
        const unsigned gen = old / nloc;
        if (old + 1u == (gen + 1u) * nloc) {
            __builtin_amdgcn_fence(__ATOMIC_RELEASE, "agent");
            asm volatile("s_waitcnt vmcnt(0)" ::: "memory");
            const unsigned og = xb_add(&bar[XB_TOP], 1u);
            const unsigned tg = og / nx;
            if (og + 1u == (tg + 1u) * nx) xb_add(&bar[XB_TOPGEN], 1u);
            else XB_SPIN(xb_ld(&bar[XB_TOPGEN]) == tg, bar);
            __builtin_amdgcn_fence(__ATOMIC_ACQUIRE, "agent");
            xb_add(&bar[XB_XGEN(b.x)], 1u);
            asm volatile("s_waitcnt vmcnt(0)" ::: "memory");
        } else {
            XB_SPIN(xb_ld(&bar[XB_XGEN(b.x)]) == gen, bar);
            __builtin_amdgcn_fence(__ATOMIC_ACQUIRE, "agent");
            asm volatile("s_waitcnt vmcnt(0)" ::: "memory");
        }
    }
    __syncthreads();
}

typedef unsigned u32x2 __attribute__((ext_vector_type(2)));
typedef short s16x4 __attribute__((ext_vector_type(4)));
typedef float f32x16 __attribute__((ext_vector_type(16)));
typedef int i32x4 __attribute__((ext_vector_type(4)));
struct Frame {
    LAS unsigned char* lds;
    volatile LAS unsigned* MISC;
    gu32* ctl;
    int tid, lane, wave, vcu, G;
};
__device__ __forceinline__ float wave_sum(float v) {
    return wsum64(v);
}
__device__ __forceinline__ float bflo(unsigned w) { return __uint_as_float(w << 16); }
__device__ __forceinline__ float bfhi(unsigned w) { return __uint_as_float(w & 0xffff0000u); }
__device__ __forceinline__ unsigned pkbf(float lo, float hi) { return pg8::cvt_pk_bf16(lo, hi); }
__device__ __forceinline__ float fexp2(float x) { return __builtin_amdgcn_exp2f(x); }
__device__ __forceinline__ float frsq(float x) { return __builtin_amdgcn_rsqf(x); }
__device__ __forceinline__ float frcp(float x) { return __builtin_amdgcn_rcpf(x); }
__device__ __forceinline__ float row_rstd(const f32x4 (&v)[4]) {
    float s = 0.f;
#pragma unroll
    for (int j = 0; j < 4; ++j) s += (v[j].x * v[j].x + v[j].y * v[j].y) + (v[j].z * v[j].z + v[j].w * v[j].w);
    return frsq(wave_sum(s) * (1.f / D) + EPS);
}
__device__ __forceinline__ void store_row_bf16(bf16* orow, const f32x4 (&v)[4], int lane) {
    u32x2* o8 = (u32x2*)orow + lane;
#pragma unroll
    for (int j = 0; j < 4; ++j) { u32x2 w; w.x = pkbf(v[j].x, v[j].y); w.y = pkbf(v[j].z, v[j].w); o8[64 * j] = w; }
}
__device__ __forceinline__ void load_row_f32(const float* xrow, f32x4 (&v)[4], int lane) {
    const f32x4* xr = (const f32x4*)xrow + lane;
#pragma unroll
    for (int j = 0; j < 4; ++j) v[j] = xr[64 * j];
}
__device__ __forceinline__ void modnorm_row(const f32x4 (&x)[4], f32x4 (&h)[4], const float* g, const float* sc, const float* sh, int lane) {
    const float rs = row_rstd(x);
#pragma unroll
    for (int j = 0; j < 4; ++j) { const f32x4 gv = ((const f32x4*)g)[lane + 64 * j], scv = ((const f32x4*)sc)[lane + 64 * j], shv = ((const f32x4*)sh)[lane + 64 * j];
        h[j] = x[j] * rs * gv * (scv + 1.0f) + shv; }
}

template <bool UPPERM> __device__ __forceinline__ void p0_transpose_item(const float* W, int K, int N, bf16* WT, int item, int lane) {
    const int nblk = N / 256, kb = item / nblk, nb = item - kb * nblk, k0 = 32 * kb, n0 = 256 * nb + 4 * lane;
    const float* src = W + (size_t)k0 * N + n0;
    int drow = n0;
    if (UPPERM) drow = (n0 < 1024) ? (256 * (n0 >> 7) + (n0 & 127)) : (256 * ((n0 - 1024) >> 7) + 128 + ((n0 - 1024) & 127));
    bf16* dst = WT + (size_t)drow * K + k0;
#pragma unroll
    for (int s = 0; s < 4; ++s) {
        f32x4 v[8];
#pragma unroll
        for (int k = 0; k < 8; ++k) v[k] = *(const f32x4*)(src + (size_t)(8 * s + k) * N);
#pragma unroll
        for (int j = 0; j < 4; ++j) { v4u o; o.x = pkbf(v[0][j], v[1][j]); o.y = pkbf(v[2][j], v[3][j]); o.z = pkbf(v[4][j], v[5][j]); o.w = pkbf(v[6][j], v[7][j]);
            *(v4u*)(dst + (size_t)j * K + 8 * s) = o; }
    }
}
__device__ __forceinline__ int up_dest_row(int n0) { return (n0 < 1024) ? (256 * (n0 >> 7) + (n0 & 127)) : (256 * ((n0 - 1024) >> 7) + 128 + ((n0 - 1024) & 127)); }
template <int N, bool UPPERM> __device__ __forceinline__ void p0_absmax_item(const float* W, unsigned* cmax, int item, int lane) {
    constexpr int NBLK = N / 256; const int kb = item / NBLK, nb = item - kb * NBLK, k0 = 32 * kb, n0 = 256 * nb + 4 * lane;
    const float* src = W + (size_t)k0 * N + n0;
    f32x4 mx = (f32x4){0.f, 0.f, 0.f, 0.f};
#pragma unroll
    for (int k = 0; k < 32; ++k) { const f32x4 v = *(const f32x4*)(src + (size_t)k * N); mx.x = fmaxf(mx.x, fabsf(v.x)); mx.y = fmaxf(mx.y, fabsf(v.y)); mx.z = fmaxf(mx.z, fabsf(v.z)); mx.w = fmaxf(mx.w, fabsf(v.w)); }
    unsigned* d = cmax + (UPPERM ? up_dest_row(n0) : n0);
    atomicMax(d + 0, __float_as_uint(mx.x)); atomicMax(d + 1, __float_as_uint(mx.y)); atomicMax(d + 2, __float_as_uint(mx.z)); atomicMax(d + 3, __float_as_uint(mx.w));
}
template <int N, bool UPPERM> __device__ __forceinline__ void p0_quant_item(const float* W, const unsigned* cmax, signed char* WQ, float* csc, int item, int lane) {
    constexpr int NBLK = N / 256; const int kb = item / NBLK, nb = item - kb * NBLK, k0 = 32 * kb, n0 = 256 * nb + 4 * lane, drow = UPPERM ? up_dest_row(n0) : n0;
    const float* src = W + (size_t)k0 * N + n0;
    float inv[4];
#pragma unroll
    for (int j = 0; j < 4; ++j) { const float cm = __uint_as_float(cmax[drow + j]); inv[j] = cm > 0.f ? 127.0f / cm : 0.f; if (kb == 0) csc[drow + j] = cm * (1.0f / 127.0f); }
#pragma unroll
    for (int s = 0; s < 2; ++s) {
        f32x4 v[16];
#pragma unroll
        for (int k = 0; k < 16; ++k) v[k] = *(const f32x4*)(src + (size_t)(16 * s + k) * N);
#pragma unroll
        for (int j = 0; j < 4; ++j) { unsigned w[4];
#pragma unroll
            for (int d = 0; d < 4; ++d) { unsigned x = 0u;
#pragma unroll
                for (int b = 0; b < 4; ++b) { const int q = (int)__builtin_rintf(v[4 * d + b][j] * inv[j]); x |= ((unsigned)q & 0xffu) << (8 * b); }
                w[d] = x; }
            *(v4u*)(WQ + (size_t)(drow + j) * 1024 + k0 + 16 * s) = (v4u){w[0], w[1], w[2], w[3]}; }
    }
}
__device__ __forceinline__ void p0_quant_up(Frame& F, const float* w_up, const unsigned* cmax, signed char* WQ, float* csc, const float* w_in, const unsigned* cmax_in, signed char* WQin, float* csc_in) {
    const int gw = F.vcu * NWAVES + F.wave, NGW = F.G * NWAVES;
    for (int it = gw; it < DEPTH * NE * 256 + DEPTH * 352; it += NGW) {
        if (it < DEPTH * NE * 256) { const int le = it >> 8;
            p0_quant_item<2048, true>(w_up + (size_t)le * D * 2048, cmax + (size_t)le * 2048, WQ + (size_t)le * 2048 * D, csc + (size_t)le * 2048, it & 255, F.lane); }
        else { const int r = it - DEPTH * NE * 256, l = r / 352;
            p0_quant_item<INW, false>(w_in + (size_t)l * D * INW, cmax_in + (size_t)l * INW, WQin + (size_t)l * INW * D, csc_in + (size_t)l * INW, r % 352, F.lane); }
    }
}
template <int N, bool UPPERM, bool FP8 = false, bool KSC = false> __device__ __forceinline__ void p0_quant_unit(const float* W, signed char* WQ, float* csc, int cb, LAS unsigned* red, int tid) {
    const int cg = tid & 15, kq = tid >> 4, n0 = 64 * cb + 4 * cg, drow = UPPERM ? up_dest_row(n0) : n0;
    f32x4 v[2][16]; f32x4 mx = (f32x4){0.f, 0.f, 0.f, 0.f};
#pragma unroll
    for (int h = 0; h < 2; ++h)
#pragma unroll
        for (int i = 0; i < 16; ++i) { v[h][i] = *(const f32x4*)(W + (size_t)(16 * (kq + 32 * h) + i) * N + n0); if constexpr (KSC) v[h][i] = v[h][i] * (h == 0 ? 1.0f / CAT_S_ATT : 1.0f / CAT_S_RET);
            mx.x = fmaxf(mx.x, fabsf(v[h][i].x)); mx.y = fmaxf(mx.y, fabsf(v[h][i].y)); mx.z = fmaxf(mx.z, fabsf(v[h][i].z)); mx.w = fmaxf(mx.w, fabsf(v[h][i].w)); }
    if (tid < 64) red[tid] = 0u;
    __syncthreads();
    atomicMax((unsigned*)(red + 4 * cg + 0), __float_as_uint(mx.x)); atomicMax((unsigned*)(red + 4 * cg + 1), __float_as_uint(mx.y));
    atomicMax((unsigned*)(red + 4 * cg + 2), __float_as_uint(mx.z)); atomicMax((unsigned*)(red + 4 * cg + 3), __float_as_uint(mx.w));
    __syncthreads();
    float inv[4];
#pragma unroll
    for (int j = 0; j < 4; ++j) { const float cm = __uint_as_float(red[4 * cg + j]); constexpr float QMAX = FP8 ? 448.0f : 127.0f; inv[j] = cm > 0.f ? QMAX / cm : 0.f; if (kq == 0) csc[drow + j] = cm * (1.0f / QMAX); }
#pragma unroll
    for (int h = 0; h < 2; ++h)
#pragma unroll
        for (int j = 0; j < 4; ++j) { unsigned w[4];
#pragma unroll
            for (int d = 0; d < 4; ++d) { unsigned x = 0u;
                if constexpr (FP8) { x = __builtin_amdgcn_cvt_pk_fp8_f32(v[h][4 * d + 0][j] * inv[j], v[h][4 * d + 1][j] * inv[j], x, false); x = __builtin_amdgcn_cvt_pk_fp8_f32(v[h][4 * d + 2][j] * inv[j], v[h][4 * d + 3][j] * inv[j], x, true); }
                else {
#pragma unroll
                for (int b = 0; b < 4; ++b) { const int q = (int)__builtin_rintf(v[h][4 * d + b][j] * inv[j]); x |= ((unsigned)q & 0xffu) << (8 * b); } }
                w[d] = x; }
            *(v4u*)(WQ + (size_t)(drow + j) * 1024 + 16 * (kq + 32 * h)) = (v4u){w[0], w[1], w[2], w[3]}; }
    __syncthreads();
}
struct QItem { const float* W; signed char* WQ; float* csc; int N, n0, type; };
__device__ __forceinline__ void q_issue(f32x4 (&v)[16], const QItem& q, int tid) {
    const int cg = tid & 7, kq = tid >> 3; const float* src = q.W + (size_t)(16 * kq) * q.N + q.n0 + 4 * cg;
#pragma unroll
    for (int i = 0; i < 16; ++i) v[i] = *(const f32x4*)(src + (size_t)i * q.N);
}
template <bool UPPERM, bool FP8, bool KSC> __device__ __forceinline__ void q_finish(f32x4 (&v)[16], const QItem& q, LAS unsigned* red, int tid) {
    const int cg = tid & 7, kq = tid >> 3, n0 = q.n0 + 4 * cg, drow = UPPERM ? up_dest_row(n0) : n0;
    f32x4 mx = (f32x4){0.f, 0.f, 0.f, 0.f};
#pragma unroll
    for (int i = 0; i < 16; ++i) { if constexpr (KSC) v[i] = v[i] * (kq < 32 ? 1.0f / CAT_S_ATT : 1.0f / CAT_S_RET);
        mx.x = fmaxf(mx.x, fabsf(v[i].x)); mx.y = fmaxf(mx.y, fabsf(v[i].y)); mx.z = fmaxf(mx.z, fabsf(v[i].z)); mx.w = fmaxf(mx.w, fabsf(v[i].w)); }
    if (tid < 32) red[tid] = 0u;
    __syncthreads();
    atomicMax((unsigned*)(red + 4 * cg + 0), __float_as_uint(mx.x)); atomicMax((unsigned*)(red + 4 * cg + 1), __float_as_uint(mx.y));
    atomicMax((unsigned*)(red + 4 * cg + 2), __float_as_uint(mx.z)); atomicMax((unsigned*)(red + 4 * cg + 3), __float_as_uint(mx.w));
    __syncthreads();
    constexpr float QMAX = FP8 ? 448.0f : 127.0f;
#pragma unroll
    for (int j = 0; j < 4; ++j) { const float cm = __uint_as_float(red[4 * cg + j]), inv = cm > 0.f ? QMAX / cm : 0.f; if (kq == 0) q.csc[drow + j] = cm * (1.0f / QMAX);
        unsigned w[4];
#pragma unroll
        for (int d = 0; d < 4; ++d) { unsigned x = 0u;
            if constexpr (FP8) { x = __builtin_amdgcn_cvt_pk_fp8_f32(v[4 * d + 0][j] * inv, v[4 * d + 1][j] * inv, x, false); x = __builtin_amdgcn_cvt_pk_fp8_f32(v[4 * d + 2][j] * inv, v[4 * d + 3][j] * inv, x, true); }
            else {
#pragma unroll
                for (int b = 0; b < 4; ++b) { const int qv = (int)__builtin_rintf(v[4 * d + b][j] * inv); x |= ((unsigned)qv & 0xffu) << (8 * b); } }
            w[d] = x; }
        *(v4u*)(q.WQ + (size_t)(drow + j) * 1024 + 16 * kq) = (v4u){w[0], w[1], w[2], w[3]}; }
}
__device__ __forceinline__ void q_finish_any(f32x4 (&v)[16], const QItem& q, LAS unsigned* red, int tid) {
    if (q.type == 0) q_finish<true, false, false>(v, q, red, tid);
    else if (q.type == 1) q_finish<false, false, false>(v, q, red, tid);
    else if (q.type == 2) q_finish<false, true, false>(v, q, red, tid);
    else q_finish<false, true, true>(v, q, red, tid);
}
__device__ __forceinline__ void p0_prologue(Frame& F, const float* c_in, const float* ada_w, const float* ada_b, float* mod,
                                            const float* w_in, const float* w_out, const float* w_up, const float* w_dn,
                                            signed char* WQin, float* csc_in, signed char* WQout, float* csc_out, signed char* WQup, float* csc_up, signed char* WQdn, float* csc_dn, gu32* wq_ctr) {
    const int gw = F.vcu * NWAVES + F.wave, NGW = F.G * NWAVES;
    __syncthreads();
    LAS float* cond = (LAS float*)F.lds;
    for (int i = F.tid; i < BATCH * D; i += NTHR) { const float v = c_in[i]; cond[i] = v * frcp(1.0f + __expf(-v)); }
    __syncthreads();
    LAS float* part = (LAS float*)(F.lds + 32768);
    for (int bt = blockIdx.x; bt < DEPTH * 96; bt += F.G) {
        const int l = bt / 96, chunk = bt % 96, ks = F.wave, col = chunk * 64 + F.lane;
        float acc[BATCH];
#pragma unroll
        for (int b = 0; b < BATCH; ++b) acc[b] = 0.f;
        const float* w = ada_w + ((size_t)l * D + ks * 128) * (6 * D) + col;
#pragma unroll 16
        for (int k = 0; k < 128; ++k) { const float wv = w[(size_t)k * (6 * D)];
#pragma unroll
            for (int b = 0; b < BATCH; ++b) acc[b] += cond[b * D + ks * 128 + k] * wv; }
#pragma unroll
        for (int b = 0; b < BATCH; ++b) part[(ks * BATCH + b) * 64 + F.lane] = acc[b];
        __syncthreads();
        { const int b = F.wave; float sum = ada_b[l * 6 * D + col];
#pragma unroll
          for (int k2 = 0; k2 < 8; ++k2) sum += part[(k2 * BATCH + b) * 64 + F.lane];
          mod[((size_t)l * BATCH + b) * (6 * D) + col] = sum; }
        __syncthreads();
    }
    {   LAS unsigned* redA = (LAS unsigned*)(F.lds + 49152 + 1024), *redB = redA + 32; LAS unsigned* claim = redA + 64;
        constexpr int U_UP = DEPTH * NE * 64, U_IN = DEPTH * 88, U_DN = DEPTH * NE * 32, U_OUT = DEPTH * 32, U_ALL = U_UP + U_IN + U_DN + U_OUT;
        auto take = [&](QItem& q) -> bool {
            if (F.tid == 0) claim[0] = __hip_atomic_fetch_add(wq_ctr, 1u, RLX_AGENT);
            __syncthreads();
            const int u = (int)claim[0];
            __syncthreads();
            if (u >= U_ALL) return false;
            if (u < U_UP) { const int le = u >> 6; q = QItem{w_up + (size_t)le * D * 2048, WQup + (size_t)le * 2048 * D, csc_up + (size_t)le * 2048, 2048, 32 * (u & 63), 0}; }
            else if (u < U_UP + U_IN) { const int r = u - U_UP, l = r / 88; q = QItem{w_in + (size_t)l * D * INW, WQin + (size_t)l * INW * D, csc_in + (size_t)l * INW, INW, 32 * (r % 88), 1}; }
            else if (u < U_UP + U_IN + U_DN) { const int r = u - U_UP - U_IN, le = r >> 5; q = QItem{w_dn + (size_t)le * D * D, WQdn + (size_t)le * D * D, csc_dn + (size_t)le * D, D, 32 * (r & 31), 2}; }
            else { const int r = u - U_UP - U_IN - U_DN, l = r >> 5; q = QItem{w_out + (size_t)l * D * D, WQout + (size_t)l * D * D, csc_out + (size_t)l * D, D, 32 * (r & 31), 3}; }
            return true; };
        f32x4 vA[16], vB[16]; QItem qA, qB;
        bool hA = take(qA); if (hA) q_issue(vA, qA, F.tid);
        bool hB = hA && take(qB); if (hB) q_issue(vB, qB, F.tid);
        while (hA || hB) {
            if (hA) { q_finish_any(vA, qA, redA, F.tid); hA = take(qA); if (hA) q_issue(vA, qA, F.tid); }
            if (hB) { q_finish_any(vB, qB, redB, F.tid); hB = take(qB); if (hB) q_issue(vB, qB, F.tid); }
        }
    }
}
__device__ __forceinline__ void store_row_i8(signed char* qrow, float* sc, const f32x4 (&h)[4], int lane) {
    float mx = 0.f;
#pragma unroll
    for (int j = 0; j < 4; ++j) mx = fmaxf(fmaxf(mx, fmaxf(fabsf(h[j].x), fabsf(h[j].y))), fmaxf(fabsf(h[j].z), fabsf(h[j].w)));
    mx = wmax64(mx);
    const float inv = mx > 0.f ? 127.0f / mx : 0.f;
    unsigned* qr = (unsigned*)qrow + lane;
#pragma unroll
    for (int j = 0; j < 4; ++j) { const int q0 = (int)__builtin_rintf(h[j].x * inv), q1 = (int)__builtin_rintf(h[j].y * inv), q2 = (int)__builtin_rintf(h[j].z * inv), q3 = (int)__builtin_rintf(h[j].w * inv);
        qr[64 * j] = ((unsigned)q0 & 0xffu) | (((unsigned)q1 & 0xffu) << 8) | (((unsigned)q2 & 0xffu) << 16) | (((unsigned)q3 & 0xffu) << 24); }
    if (lane == 0) *sc = mx * (1.0f / 127.0f);
}
__device__ __forceinline__ void p0b_premix(Frame& F, const float* x, signed char* HQ, float* hs, const float* g, const float* mod_l) {
    const int lane = F.lane, gw = F.vcu * NWAVES + F.wave, NGW = F.G * NWAVES;
    for (int ch = gw; ch < M / 32; ch += NGW) { const int mb = ch * 32;
        const float* modb = mod_l + (size_t)(mb >> 13) * (6 * D);
        f32x4 gsv[4], shv[4];
#pragma unroll
        for (int j = 0; j < 4; ++j) { gsv[j] = ((const f32x4*)g)[lane + 64 * j] * (((const f32x4*)(modb + D))[lane + 64 * j] + 1.0f); shv[j] = ((const f32x4*)modb)[lane + 64 * j]; }
        f32x4 A[2][4], B[2][4];
#define P0B_ISSUE(BUF, t0) do { _Pragma("unroll") for (int r = 0; r < 2; ++r) load_row_f32(x + (size_t)(mb + (t0) + r) * D, BUF[r], lane); } while (0)
#define P0B_PROC(BUF, t0) do { _Pragma("unroll") for (int r = 0; r < 2; ++r) { const int m = mb + (t0) + r; f32x4 h[4]; const float rs = row_rstd(BUF[r]); \
            _Pragma("unroll") for (int j = 0; j < 4; ++j) h[j] = BUF[r][j] * rs * gsv[j] + shv[j]; store_row_i8(HQ + (size_t)m * D, hs + m, h, lane); } } while (0)
        P0B_ISSUE(A, 0);
#pragma unroll 1
        for (int it = 0; it < 8; ++it) { const int t0 = 4 * it;
            P0B_ISSUE(B, t0 + 2);
            P0B_PROC(A, t0);
            if (it < 7) P0B_ISSUE(A, t0 + 4);
            P0B_PROC(B, t0 + 2);
        }
#undef P0B_ISSUE
#undef P0B_PROC
    }
}
__device__ __forceinline__ void rope4(float (&y)[4][2], const float (&cr)[2], const float (&sr)[2], const float (&cc)[2], const float (&sc)[2], float scale, unsigned (&w)[4]) {
    float o[4][2];
#pragma unroll
    for (int e = 0; e < 2; ++e) { o[0][e] = y[0][e] * cr[e] - y[1][e] * sr[e]; o[1][e] = y[1][e] * cr[e] + y[0][e] * sr[e];
                                  o[2][e] = y[2][e] * cc[e] - y[3][e] * sc[e]; o[3][e] = y[3][e] * cc[e] + y[2][e] * sc[e]; }
#pragma unroll
    for (int q = 0; q < 4; ++q) w[q] = pkbf(o[q][0] * scale, o[q][1] * scale);
}
__device__ __forceinline__ void p1b_ka(Frame& F, bf16* PROJ, const float* kg) {
    const int lane = F.lane, gw = F.vcu * NWAVES + F.wave, NGW = F.G * NWAVES;
    const int ja = lane & 7, hk = (lane >> 3) & 1, sub = lane >> 4;
    constexpr float L2T = 13.287712379549449f;
    float fa[2], gk[4][2];
#pragma unroll
    for (int e = 0; e < 2; ++e) fa[e] = fexp2(-(float)(2 * ja + e) * (L2T / 16.f));
#pragma unroll
    for (int q = 0; q < 4; ++q)
#pragma unroll
        for (int e = 0; e < 2; ++e) gk[q][e] = kg[q * 16 + 2 * ja + e];
    for (int m0 = gw * 4; m0 < M; m0 += NGW * 4) {
        const int m = m0 + sub, s = m & (T - 1); const float rid = (float)(s >> 6), cid = (float)(s & 63);
        float cra[2], sra[2], cca[2], sca[2];
#pragma unroll
        for (int e = 0; e < 2; ++e) { cra[e] = __cosf(rid * fa[e]); sra[e] = __sinf(rid * fa[e]); cca[e] = __cosf(cid * fa[e]); sca[e] = __sinf(cid * fa[e]); }
        unsigned* p = (unsigned*)(PROJ + (size_t)m * INW + C_KA + hk * 64 + 2 * ja); unsigned w[4]; float y[4][2]; float ss = 0.f;
#pragma unroll
        for (int q = 0; q < 4; ++q) { w[q] = p[q * 8]; y[q][0] = bflo(w[q]); y[q][1] = bfhi(w[q]); ss += y[q][0] * y[q][0] + y[q][1] * y[q][1]; }
        ss += shx<1>(ss); ss += shx<2>(ss); ss += shx<4>(ss);
        const float rs = frsq(ss * (1.f / 64.f) + EPS);
#pragma unroll
        for (int q = 0; q < 4; ++q) { y[q][0] *= rs * gk[q][0]; y[q][1] *= rs * gk[q][1]; }
        rope4(y, cra, sra, cca, sca, 1.0f, w);
#pragma unroll
        for (int q = 0; q < 4; ++q) p[q * 8] = w[q];
    }
}
__device__ __forceinline__ void p1b_rope(Frame& F, bf16* PROJ, bf16* PDST, const float* qg, const float* kg) {
    const int lane = F.lane, gw = F.vcu * NWAVES + F.wave, NGW = F.G * NWAVES;
    const int ja = lane & 7, jr = lane & 15;
    constexpr float L2T = 13.287712379549449f;
    float fa[2], fr[2], gq[4][2], gk[4][2];
#pragma unroll
    for (int e = 0; e < 2; ++e) { fa[e] = fexp2(-(float)(2 * ja + e) * (L2T / 16.f)); fr[e] = fexp2(-(float)(2 * jr + e) * (L2T / 32.f)); }
#pragma unroll
    for (int q = 0; q < 4; ++q)
#pragma unroll
        for (int e = 0; e < 2; ++e) { gq[q][e] = qg[q * 16 + 2 * ja + e]; gk[q][e] = kg[q * 16 + 2 * ja + e]; }
    for (int m = gw; m < M; m += NGW) {
        const int s = m & (T - 1); const float rid = (float)(s >> 6), cid = (float)(s & 63);
        float cra[2], sra[2], cca[2], sca[2], crr[2], srr[2], ccr[2], scr2[2];
#pragma unroll
        for (int e = 0; e < 2; ++e) { cra[e] = __cosf(rid * fa[e]); sra[e] = __sinf(rid * fa[e]); cca[e] = __cosf(cid * fa[e]); sca[e] = __sinf(cid * fa[e]);
                                      crr[e] = __cosf(rid * fr[e]); srr[e] = __sinf(rid * fr[e]); ccr[e] = __cosf(cid * fr[e]); scr2[e] = __sinf(cid * fr[e]); }
        bf16* row = PROJ + (size_t)m * INW; const size_t dd = (size_t)((const char*)PDST - (const char*)PROJ) / 4;
        {
            unsigned* p = (unsigned*)(row + C_QA + (lane >> 3) * 64 + 2 * ja); unsigned w[4]; float y[4][2]; float ss = 0.f;
#pragma unroll
            for (int q = 0; q < 4; ++q) { w[q] = p[q * 8]; y[q][0] = bflo(w[q]); y[q][1] = bfhi(w[q]); ss += y[q][0] * y[q][0] + y[q][1] * y[q][1]; }
            ss += shx<1>(ss); ss += shx<2>(ss); ss += shx<4>(ss);
            const float rs = frsq(ss * (1.f / 64.f) + EPS);
#pragma unroll
            for (int q = 0; q < 4; ++q) { y[q][0] *= rs * gq[q][0]; y[q][1] *= rs * gq[q][1]; }
            rope4(y, cra, sra, cca, sca, attn_body::C2, w);
#pragma unroll
            for (int q = 0; q < 4; ++q) p[dd + q * 8] = w[q];
        }
        {
            const int hk = (lane >> 3) & 1;
            unsigned* p = (unsigned*)(row + C_KA + hk * 64 + 2 * ja); unsigned w[4]; float y[4][2]; float ss = 0.f;
#pragma unroll
            for (int q = 0; q < 4; ++q) { w[q] = p[q * 8]; y[q][0] = bflo(w[q]); y[q][1] = bfhi(w[q]); ss += y[q][0] * y[q][0] + y[q][1] * y[q][1]; }
            ss += shx<1>(ss); ss += shx<2>(ss); ss += shx<4>(ss);
            const float rs = frsq(ss * (1.f / 64.f) + EPS);
#pragma unroll
            for (int q = 0; q < 4; ++q) { y[q][0] *= rs * gk[q][0]; y[q][1] *= rs * gk[q][1]; }
            rope4(y, cra, sra, cca, sca, 1.0f, w);
            if (lane < 16) {
#pragma unroll
                for (int q = 0; q < 4; ++q) p[dd + q * 8] = w[q]; }
        }
#pragma unroll
        for (int which = 0; which < 2; ++which) {
            unsigned* p = (unsigned*)(row + (which ? C_KR : C_QR) + (lane >> 4) * 128 + 2 * jr); unsigned w[4]; float y[4][2];
#pragma unroll
            for (int q = 0; q < 4; ++q) { w[q] = p[q * 16]; y[q][0] = bflo(w[q]); y[q][1] = bfhi(w[q]); }
            rope4(y, crr, srr, ccr, scr2, which ? 0.08838834764831845f : 1.0f, w);
#pragma unroll
            for (int q = 0; q < 4; ++q) p[dd + q * 16] = w[q];
        }
    }
}

__device__ __forceinline__ unsigned off_b(unsigned row, unsigned ch) { return 256u * row + 16u * (ch ^ (((row & 3) << 2) | ((row >> 2) & 3))); }
__device__ __forceinline__ bf16x8 rowread(const LAS unsigned char* tb, int rb, int s, int lane) {
    return *(const LAS bf16x8*)(tb + off_b(32 * rb + (lane & 31), 2 * s + (lane >> 5)));
}
__device__ __forceinline__ bf16x8 trread(const LAS unsigned char* tb, int c, int ks, int lane) {
    const unsigned h = lane >> 5, blk = (lane >> 4) & 1, q = (lane & 15) >> 2, p = lane & 3;
    const unsigned r0 = 16 * ks + 8 * h + q, ch = 4 * c + 2 * blk + (p >> 1);
    const s16x4 lo = __builtin_amdgcn_ds_read_tr16_b64_v4i16((LAS s16x4*)(tb + off_b(r0, ch) + 8 * (p & 1)));
    const s16x4 hi = __builtin_amdgcn_ds_read_tr16_b64_v4i16((LAS s16x4*)(tb + off_b(r0 + 4, ch) + 8 * (p & 1)));
    return (bf16x8){lo[0], lo[1], lo[2], lo[3], hi[0], hi[1], hi[2], hi[3]};
}
__device__ __forceinline__ int crow(int r, int hi) { return (r & 3) + 8 * (r >> 2) + 4 * hi; }
template <int MODE> __device__ __forceinline__ void stage_tile(LAS unsigned char* tb, const bf16* src, int pitch, int tid, float lg) {
#pragma unroll
    for (int i = 0; i < 4; ++i) { const int n = tid + NTHR * i, row = n >> 4, ch = n & 15;
        v4u v = *(const v4u*)(src + (size_t)row * pitch + ch * 8);
        if (MODE != 0) { const float f = fexp2((MODE == 1 ? (float)(127 - row) : (float)row) * lg);
            v.x = pkbf(bflo(v.x) * f, bfhi(v.x) * f); v.y = pkbf(bflo(v.y) * f, bfhi(v.y) * f); v.z = pkbf(bflo(v.z) * f, bfhi(v.z) * f); v.w = pkbf(bflo(v.w) * f, bfhi(v.w) * f); }
        *(LAS v4u*)(tb + off_b(row, ch)) = v; }
}
template <int NOUT> __device__ __forceinline__ void stage_rope_tile(LAS unsigned char* tb0, LAS unsigned char* tb1, const bf16* src, int pitch, int tid, int s0, float scale, float lgf, float lgb) {
    constexpr float L2T = 13.287712379549449f;
#pragma unroll 1
    for (int i2 = 0; i2 < 2; ++i2) { const int n = tid + NTHR * i2, row = n >> 3, cp = n & 7, c0 = (cp & 3) + ((cp >> 2) << 3);
        const bf16* rp = src + (size_t)row * pitch; const v4u va = *(const v4u*)(rp + c0 * 8), vb = *(const v4u*)(rp + (c0 + 4) * 8);
        const int s = s0 + row; const float pos = (cp & 4) ? (float)(s & 63) : (float)(s >> 6);
        const unsigned wa[4] = {va.x, va.y, va.z, va.w}, wb[4] = {vb.x, vb.y, vb.z, vb.w}; float oa[8], ob[8];
#pragma unroll
        for (int j = 0; j < 8; ++j) { const float fr = fexp2(-(float)(8 * (cp & 3) + j) * (L2T / 32.f)), ang = pos * fr, cs = __cosf(ang), sn = __sinf(ang);
            const float a = (j & 1) ? bfhi(wa[j >> 1]) : bflo(wa[j >> 1]), b = (j & 1) ? bfhi(wb[j >> 1]) : bflo(wb[j >> 1]);
            oa[j] = (a * cs - b * sn) * scale; ob[j] = (b * cs + a * sn) * scale; }
        if (NOUT == 1) {
            *(LAS v4u*)(tb0 + off_b(row, c0)) = (v4u){pkbf(oa[0], oa[1]), pkbf(oa[2], oa[3]), pkbf(oa[4], oa[5]), pkbf(oa[6], oa[7])};
            *(LAS v4u*)(tb0 + off_b(row, c0 + 4)) = (v4u){pkbf(ob[0], ob[1]), pkbf(ob[2], ob[3]), pkbf(ob[4], ob[5]), pkbf(ob[6], ob[7])};
        } else {
            const float ff = fexp2((float)(127 - row) * lgf), fb = fexp2((float)row * lgb);
            *(LAS v4u*)(tb0 + off_b(row, c0)) = (v4u){pkbf(oa[0] * ff, oa[1] * ff), pkbf(oa[2] * ff, oa[3] * ff), pkbf(oa[4] * ff, oa[5] * ff), pkbf(oa[6] * ff, oa[7] * ff)};
            *(LAS v4u*)(tb0 + off_b(row, c0 + 4)) = (v4u){pkbf(ob[0] * ff, ob[1] * ff), pkbf(ob[2] * ff, ob[3] * ff), pkbf(ob[4] * ff, ob[5] * ff), pkbf(ob[6] * ff, ob[7] * ff)};
            *(LAS v4u*)(tb1 + off_b(row, c0)) = (v4u){pkbf(oa[0] * fb, oa[1] * fb), pkbf(oa[2] * fb, oa[3] * fb), pkbf(oa[4] * fb, oa[5] * fb), pkbf(oa[6] * fb, oa[7] * fb)};
            *(LAS v4u*)(tb1 + off_b(row, c0 + 4)) = (v4u){pkbf(ob[0] * fb, ob[1] * fb), pkbf(ob[2] * fb, ob[3] * fb), pkbf(ob[4] * fb, ob[5] * fb), pkbf(ob[6] * fb, ob[7] * fb)};
        } }
}
__device__ __forceinline__ void rope_load(v4u (&raw)[2][2], const bf16* src, int pitch, int tid) {
#pragma unroll
    for (int i2 = 0; i2 < 2; ++i2) { const int n = tid + NTHR * i2, row = n >> 3, cp = n & 7, c0 = (cp & 3) + ((cp >> 2) << 3);
        const bf16* rp = src + (size_t)row * pitch; raw[i2][0] = *(const v4u*)(rp + c0 * 8); raw[i2][1] = *(const v4u*)(rp + (c0 + 4) * 8); }
}
template <int NOUT> __device__ __forceinline__ void rope_store(LAS unsigned char* tb0, LAS unsigned char* tb1, const v4u (&raw)[2][2], int tid, int s0, float scale, float lgf, float lgb) {
    constexpr float L2T = 13.287712379549449f;
#pragma unroll
    for (int i2 = 0; i2 < 2; ++i2) { __builtin_amdgcn_sched_barrier(0);
        const int n = tid + NTHR * i2, row = n >> 3, cp = n & 7, c0 = (cp & 3) + ((cp >> 2) << 3);
        const v4u va = raw[i2][0], vb = raw[i2][1];
        const int s = s0 + row; const float pos = (cp & 4) ? (float)(s & 63) : (float)(s >> 6);
        const unsigned wa[4] = {va.x, va.y, va.z, va.w}, wb[4] = {vb.x, vb.y, vb.z, vb.w}; float oa[8], ob[8];
#pragma unroll
        for (int j = 0; j < 8; ++j) { const float fr = fexp2(-(float)(8 * (cp & 3) + j) * (L2T / 32.f)), ang = pos * fr, cs = __cosf(ang), sn = __sinf(ang);
            const float a = (j & 1) ? bfhi(wa[j >> 1]) : bflo(wa[j >> 1]), b = (j & 1) ? bfhi(wb[j >> 1]) : bflo(wb[j >> 1]);
            oa[j] = (a * cs - b * sn) * scale; ob[j] = (b * cs + a * sn) * scale; }
        if (NOUT == 1) {
            *(LAS v4u*)(tb0 + off_b(row, c0)) = (v4u){pkbf(oa[0], oa[1]), pkbf(oa[2], oa[3]), pkbf(oa[4], oa[5]), pkbf(oa[6], oa[7])};
            *(LAS v4u*)(tb0 + off_b(row, c0 + 4)) = (v4u){pkbf(ob[0], ob[1]), pkbf(ob[2], ob[3]), pkbf(ob[4], ob[5]), pkbf(ob[6], ob[7])};
        } else {
            const float ff = fexp2((float)(127 - row) * lgf), fb = fexp2((float)row * lgb);
            *(LAS v4u*)(tb0 + off_b(row, c0)) = (v4u){pkbf(oa[0] * ff, oa[1] * ff), pkbf(oa[2] * ff, oa[3] * ff), pkbf(oa[4] * ff, oa[5] * ff), pkbf(oa[6] * ff, oa[7] * ff)};
            *(LAS v4u*)(tb0 + off_b(row, c0 + 4)) = (v4u){pkbf(ob[0] * ff, ob[1] * ff), pkbf(ob[2] * ff, ob[3] * ff), pkbf(ob[4] * ff, ob[5] * ff), pkbf(ob[6] * ff, ob[7] * ff)};
            *(LAS v4u*)(tb1 + off_b(row, c0)) = (v4u){pkbf(oa[0] * fb, oa[1] * fb), pkbf(oa[2] * fb, oa[3] * fb), pkbf(oa[4] * fb, oa[5] * fb), pkbf(oa[6] * fb, oa[7] * fb)};
            *(LAS v4u*)(tb1 + off_b(row, c0 + 4)) = (v4u){pkbf(ob[0] * fb, ob[1] * fb), pkbf(ob[2] * fb, ob[3] * fb), pkbf(ob[4] * fb, ob[5] * fb), pkbf(ob[6] * fb, ob[7] * fb)};
        } }
}
__device__ __forceinline__ void vtile_load(v4u (&raw)[4], const bf16* src, int pitch, int tid) {
#pragma unroll
    for (int i = 0; i < 4; ++i) { const int n = tid + NTHR * i, row = n >> 4, ch = n & 15; raw[i] = *(const v4u*)(src + (size_t)row * pitch + ch * 8); }
}
__device__ __forceinline__ void vtile_store(LAS unsigned char* tb, const v4u (&raw)[4], int tid) {
#pragma unroll
    for (int i = 0; i < 4; ++i) { const int n = tid + NTHR * i, row = n >> 4, ch = n & 15; *(LAS v4u*)(tb + off_b(row, ch)) = raw[i]; }
}
__device__ __forceinline__ void r1_states(Frame& F, const bf16* PROJ, bf16* U, const float* dec_f, const float* dec_b) {
    LAS unsigned char* TKf = F.lds, *TKb = F.lds + 32768, *TV = F.lds + 65536;
    const int lane = F.lane, w = F.wave, hi = lane >> 5, mb = w & 3, nb0 = 2 * (w >> 2);
    for (int u = F.vcu; u < RUNITS; u += F.G) {
        const int b = u >> 8, h = (u >> 6) & 3, c = u & 63;
        const float lgf = dec_f[h] * LOG2E, lgb = dec_b[h] * LOG2E;
        const bf16* base = PROJ + ((size_t)b * T + (size_t)c * RCH) * INW + h * 128;
        { v4u rk[2][2], rv[4]; rope_load(rk, base + C_KR, INW, F.tid); vtile_load(rv, base + C_VR, INW, F.tid);
          rope_store<2>(TKf, TKb, rk, F.tid, c * RCH, 0.08838834764831845f, lgf, lgb);
          vtile_store(TV, rv, F.tid); }
        __syncthreads();
        f32x16 acc[2][2];
#pragma unroll
        for (int d = 0; d < 2; ++d)
#pragma unroll
            for (int n = 0; n < 2; ++n) acc[d][n] = (f32x16){};
#pragma unroll 2
        for (int ks = 0; ks < 8; ++ks) {
            const bf16x8 a = trread(TV, mb, ks, lane);
#pragma unroll
            for (int n = 0; n < 2; ++n) { const bf16x8 bf = trread(TKf, nb0 + n, ks, lane), bb = trread(TKb, nb0 + n, ks, lane);
                acc[0][n] = __builtin_amdgcn_mfma_f32_32x32x16_bf16(bf, a, acc[0][n], 0, 0, 0);
                acc[1][n] = __builtin_amdgcn_mfma_f32_32x32x16_bf16(bb, a, acc[1][n], 0, 0, 0); }
        }
#pragma unroll
        for (int d = 0; d < 2; ++d)
#pragma unroll
            for (int n = 0; n < 2; ++n) { bf16* o = U + ((size_t)u * 2 + d) * 16384 + (size_t)(32 * mb + (lane & 31)) * 128 + 32 * (nb0 + n) + 4 * hi;
#pragma unroll
                for (int g = 0; g < 4; ++g) { u32x2 w; w.x = pkbf(acc[d][n][4 * g], acc[d][n][4 * g + 1]); w.y = pkbf(acc[d][n][4 * g + 2], acc[d][n][4 * g + 3]); *(u32x2*)(o + 8 * g) = w; } }
        __syncthreads();
    }
}
__device__ __forceinline__ void r2_scan(Frame& F, const bf16* __restrict__ U, bf16* __restrict__ FT, const float* dec_f, const float* dec_b) {
    for (int task = blockIdx.x * NTHR + F.tid; task < BATCH * RH * 4096; task += F.G * NTHR) {
        const int bh = task >> 12, e4 = task & 4095, h = bh & 3;
        const float df = __expf(dec_f[h] * 128.f), db = __expf(dec_b[h] * 128.f);
        f32x4 s = (f32x4){0.f, 0.f, 0.f, 0.f};
#pragma unroll 8
        for (int c = 0; c < NCH; ++c) { const size_t idx = (((size_t)bh * NCH + c) * 2 + 0) * 16384 + 4 * e4;
            u32x2 w; w.x = pkbf(s.x, s.y); w.y = pkbf(s.z, s.w); *(u32x2*)(FT + idx) = w;
            { const u32x2 uw = *(const u32x2*)(U + idx); s = s * df + (f32x4){bflo(uw.x), bfhi(uw.x), bflo(uw.y), bfhi(uw.y)}; } }
        s = (f32x4){0.f, 0.f, 0.f, 0.f};
#pragma unroll 8
        for (int c = NCH - 1; c >= 0; --c) { const size_t idx = (((size_t)bh * NCH + c) * 2 + 1) * 16384 + 4 * e4;
            u32x2 w; w.x = pkbf(s.x, s.y); w.y = pkbf(s.z, s.w); *(u32x2*)(FT + idx) = w;
            { const u32x2 uw = *(const u32x2*)(U + idx); s = s * db + (f32x4){bflo(uw.x), bfhi(uw.x), bflo(uw.y), bfhi(uw.y)}; } }
    }
}
__device__ __forceinline__ void r3_out(Frame& F, const bf16* PROJ, const bf16* FT, bf16* CAT, const float* dec_f, const float* dec_b, const float* gn_g, const float* gn_b) {
    LAS unsigned char* TQ = F.lds, *TK = F.lds + 32768, *TV = F.lds + 65536, *TP = F.lds + 98304;
    LAS float* OT = (LAS float*)F.lds;
    const int w = F.wave, wb = w & 3, wp0 = 2 * (w >> 2);
    for (int u = F.vcu; u < RUNITS; u += F.G) {
        int lane = F.lane, tid_u = F.tid; asm volatile("" : "+v"(lane), "+v"(tid_u));
        const int hi = lane >> 5, l31 = lane & 31;
        const int b = u >> 8, h = (u >> 6) & 3, c = u & 63;
        const float lgf = dec_f[h] * LOG2E, lgb = dec_b[h] * LOG2E;
        const size_t m0 = (size_t)b * T + (size_t)c * RCH;
        const bf16* base = PROJ + m0 * INW + h * 128;
        const int gi = tid_u >> 2, gqd = tid_u & 3, gcol = h * 128 + 32 * gqd;
        const bf16* gp = PROJ + (m0 + gi) * INW + C_GR + gcol;
        v4u gw[4];
#pragma unroll
        for (int k2 = 0; k2 < 4; ++k2) gw[k2] = *(const v4u*)(gp + 8 * k2);
        bf16x8 cf[4][2], cb[4][2];
        const bf16* ftf = FT + ((size_t)u * 2 + 0) * 16384 + (size_t)(32 * wp0 + l31) * 128 + 8 * hi;
#pragma unroll
        for (int s = 0; s < 4; ++s)
#pragma unroll
            for (int n = 0; n < 2; ++n) { cf[s][n] = *(const bf16x8*)(ftf + n * 32 * 128 + 16 * s); cb[s][n] = *(const bf16x8*)(ftf + 16384 + n * 32 * 128 + 16 * s); }
        { v4u rq[2][2], rk[2][2], rv[4];
          rope_load(rq, base + C_QR, INW, tid_u); rope_load(rk, base + C_KR, INW, tid_u); vtile_load(rv, base + C_VR, INW, tid_u);
          __builtin_amdgcn_sched_barrier(0);
          rope_store<1>(TQ, TQ, rq, tid_u, c * RCH, 1.0f, 0.f, 0.f);
          rope_store<1>(TK, TK, rk, tid_u, c * RCH, 0.08838834764831845f, 0.f, 0.f);
          __builtin_amdgcn_sched_barrier(0);
          vtile_store(TV, rv, tid_u); }
        __syncthreads();
        {
            f32x16 st[2]; st[0] = (f32x16){}; st[1] = (f32x16){};
#pragma unroll 1
            for (int s = 0; s < 8; ++s) { const bf16x8 a = rowread(TK, wb, s, lane);
#pragma unroll
                for (int n = 0; n < 2; ++n) st[n] = __builtin_amdgcn_mfma_f32_32x32x16_bf16(a, rowread(TQ, wp0 + n, s, lane), st[n], 0, 0, 0); }
#pragma unroll
            for (int n = 0; n < 2; ++n) { const int i = 32 * (wp0 + n) + l31; __builtin_amdgcn_sched_barrier(0);
#pragma unroll
                for (int g = 0; g < 4; ++g) { float p[4];
#pragma unroll
                    for (int q = 0; q < 4; ++q) { const int j = 32 * wb + 8 * g + 4 * hi + q; const float fd = (float)(i - j);
                        const float mk = fexp2(fmaxf(fd, 0.f) * lgf + fmaxf(-fd, 0.f) * lgb) + fmaxf(1.0f - fabsf(fd), 0.f);
                        p[q] = st[n][4 * g + q] * mk; }
                    u32x2 pw; pw.x = pkbf(p[0], p[1]); pw.y = pkbf(p[2], p[3]);
                    *(LAS u32x2*)(TP + off_b(i, 4 * wb + g) + 8 * hi) = pw; } }
        }
        __syncthreads();
        f32x16 ao[2];
#pragma unroll
        for (int n = 0; n < 2; ++n) ao[n] = (f32x16){};
        {
            const float xf = fexp2((float)(32 * wb + l31 + 1) * lgf), xb = fexp2((float)(128 - 32 * wb - l31) * lgb);
#pragma unroll
            for (int s = 0; s < 8; ++s) { __builtin_amdgcn_sched_barrier(0); const bf16x8 ap = rowread(TP, wb, s, lane); const v4u aq = *(const LAS v4u*)(TQ + off_b(32 * wb + l31, 2 * s + hi));
                v4u qf, qb;
                qf.x = pkbf(bflo(aq.x) * xf, bfhi(aq.x) * xf); qf.y = pkbf(bflo(aq.y) * xf, bfhi(aq.y) * xf); qf.z = pkbf(bflo(aq.z) * xf, bfhi(aq.z) * xf); qf.w = pkbf(bflo(aq.w) * xf, bfhi(aq.w) * xf);
                qb.x = pkbf(bflo(aq.x) * xb, bfhi(aq.x) * xb); qb.y = pkbf(bflo(aq.y) * xb, bfhi(aq.y) * xb); qb.z = pkbf(bflo(aq.z) * xb, bfhi(aq.z) * xb); qb.w = pkbf(bflo(aq.w) * xb, bfhi(aq.w) * xb);
                const bf16x8 aqf = __builtin_bit_cast(bf16x8, qf), aqb = __builtin_bit_cast(bf16x8, qb);
#pragma unroll
                for (int n = 0; n < 2; ++n) {
                    ao[n] = __builtin_amdgcn_mfma_f32_32x32x16_bf16(ap, trread(TV, wp0 + n, s, lane), ao[n], 0, 0, 0);
                    ao[n] = __builtin_amdgcn_mfma_f32_32x32x16_bf16(aqf, cf[s & 3][n], ao[n], 0, 0, 0);
                    ao[n] = __builtin_amdgcn_mfma_f32_32x32x16_bf16(aqb, cb[s & 3][n], ao[n], 0, 0, 0); }
                if (s < 4) {
#pragma unroll
                    for (int n = 0; n < 2; ++n) { cf[s][n] = *(const bf16x8*)(ftf + n * 32 * 128 + 16 * (s + 4)); cb[s][n] = *(const bf16x8*)(ftf + 16384 + n * 32 * 128 + 16 * (s + 4)); } } }
        }
        __syncthreads();
#pragma unroll
        for (int r = 0; r < 16; ++r) { const int i = 32 * wb + crow(r, hi);
#pragma unroll
            for (int n = 0; n < 2; ++n) OT[i * 132 + 32 * (wp0 + n) + l31] = ao[n][r]; }
        __syncthreads();
        {
            const int i = tid_u >> 2, qd = tid_u & 3;
            f32x4 v[8]; float s1 = 0.f, s2 = 0.f;
#pragma unroll
            for (int k = 0; k < 8; ++k) { v[k] = *(const LAS f32x4*)(OT + i * 132 + 32 * qd + 4 * k); s1 += (v[k].x + v[k].y) + (v[k].z + v[k].w);
                s2 += (v[k].x * v[k].x + v[k].y * v[k].y) + (v[k].z * v[k].z + v[k].w * v[k].w); }
            s1 += shx<1>(s1); s1 += shx<2>(s1); s2 += shx<1>(s2); s2 += shx<2>(s2);
            const float mu = s1 * (1.f / 128.f), var = fmaxf(s2 * (1.f / 128.f) - mu * mu, 0.f), rs = frsq(var + EPS);
            const int col = h * 128 + 32 * qd;
            unsigned char* op = (unsigned char*)CAT + (m0 + i) * D + 512 + col;
            f32x4 gg[8], gbv[8];
#pragma unroll
            for (int k = 0; k < 8; ++k) { gg[k] = *(const f32x4*)(gn_g + col + 4 * k); gbv[k] = *(const f32x4*)(gn_b + col + 4 * k); }
#pragma unroll
            for (int k2 = 0; k2 < 4; ++k2) { __builtin_amdgcn_sched_barrier(0); const v4u gw4 = gw[k2]; const unsigned gwv[4] = {gw4.x, gw4.y, gw4.z, gw4.w}; float o[8];
#pragma unroll
                for (int q = 0; q < 8; ++q) { const int cc = 8 * k2 + q; const float x = v[cc >> 2][cc & 3];
                    const float y = (x - mu) * rs * gg[cc >> 2][cc & 3] + gbv[cc >> 2][cc & 3];
                    const float gt = (q & 1) ? bfhi(gwv[q >> 1]) : bflo(gwv[q >> 1]);
                    o[q] = y * gt * frcp(1.0f + __expf(-gt)); }
#pragma unroll
                for (int q = 0; q < 8; ++q) o[q] = __builtin_amdgcn_fmed3f(o[q] * CAT_S_RET, -448.0f, 448.0f);
                unsigned w0 = 0u, w1 = 0u;
                w0 = __builtin_amdgcn_cvt_pk_fp8_f32(o[0], o[1], w0, false); w0 = __builtin_amdgcn_cvt_pk_fp8_f32(o[2], o[3], w0, true);
                w1 = __builtin_amdgcn_cvt_pk_fp8_f32(o[4], o[5], w1, false); w1 = __builtin_amdgcn_cvt_pk_fp8_f32(o[6], o[7], w1, true);
                *(u32x2*)(op + 8 * k2) = (u32x2){w0, w1}; }
        }
        __syncthreads();
    }
}

#if defined(ATTN_PROBE)
__device__ __forceinline__ void attn_check(Frame& F, const bf16* PROJ, const bf16* CAT, gu32* flag, const float* qg) {
    const int lane = F.lane, s = F.vcu * NWAVES + F.wave;
    const int b = s & 7, h = (s >> 3) & 7, qpos = (s * 977 + 131) & (T - 1), kvh = h >> 2;
    const bf16* qrow = PROJ + ((size_t)b * T + qpos) * INW + C_QA + h * 64;
    float qf[64], o[64];
    {
        const float raw = __uint_as_float((unsigned)qrow[lane] << 16);
        const float ss = wave_sum(raw * raw), y = raw * (1.0f / sqrtf(ss * (1.f / 64.f) + 1e-6f)) * qg[lane];
        const int quarter = lane >> 4, i = lane & 15; const float partner = shx<16>(y);
        const float invf = exp2f(-(float)i * (13.287712379549449f / 16.f)), ang = ((quarter < 2) ? (float)(qpos >> 6) : (float)(qpos & 63)) * invf;
        const float cs = __cosf(ang), sn = __sinf(ang);
        const float rot = (quarter & 1) ? (y * cs + partner * sn) : (y * cs - partner * sn);
        const float qv = rot * (0.125f * 1.4426950408889634f);
#pragma unroll
        for (int d = 0; d < 64; ++d) qf[d] = __int_as_float(bcastl(__float_as_int(qv), d));
    }
#pragma unroll
    for (int d = 0; d < 64; ++d) o[d] = 0.f;
    float m = -1e30f, l = 0.f;
    for (int i = 0; i < T / 64; ++i) {
        const size_t krow = ((size_t)b * T + i * 64 + lane) * INW;
        const bf16* kp = PROJ + krow + C_KA + kvh * 64; const bf16* vp = PROJ + krow + C_VA + kvh * 64;
        float sc = 0.f;
#pragma unroll
        for (int c = 0; c < 8; ++c) { const v4u w = *(const v4u*)(kp + 8 * c);
            sc += qf[8 * c + 0] * bflo(w.x) + qf[8 * c + 1] * bfhi(w.x) + qf[8 * c + 2] * bflo(w.y) + qf[8 * c + 3] * bfhi(w.y) + qf[8 * c + 4] * bflo(w.z) + qf[8 * c + 5] * bfhi(w.z) + qf[8 * c + 6] * bflo(w.w) + qf[8 * c + 7] * bfhi(w.w); }
        const float mn = fmaxf(m, sc), fs = fexp2(m - mn), p = fexp2(sc - mn);
        l = l * fs + p; m = mn;
#pragma unroll
        for (int c = 0; c < 8; ++c) { const v4u w = *(const v4u*)(vp + 8 * c);
            o[8 * c + 0] = o[8 * c + 0] * fs + p * bflo(w.x); o[8 * c + 1] = o[8 * c + 1] * fs + p * bfhi(w.x); o[8 * c + 2] = o[8 * c + 2] * fs + p * bflo(w.y); o[8 * c + 3] = o[8 * c + 3] * fs + p * bfhi(w.y);
            o[8 * c + 4] = o[8 * c + 4] * fs + p * bflo(w.z); o[8 * c + 5] = o[8 * c + 5] * fs + p * bfhi(w.z); o[8 * c + 6] = o[8 * c + 6] * fs + p * bflo(w.w); o[8 * c + 7] = o[8 * c + 7] * fs + p * bfhi(w.w); }
    }
    float mm = m;
    mm = wmax64(mm);
    const float f = fexp2(m - mm); const float L = wave_sum(l * f);
    float mine = 0.f;
#pragma unroll
    for (int d = 0; d < 64; ++d) { const float od = wave_sum(o[d] * f) / L; if (lane == d) mine = od; }
    const unsigned short cw = CAT[((size_t)b * T + qpos) * D + h * 64 + lane];
    const float got = __uint_as_float((unsigned)cw << 16);
    const float E = wave_sum((mine - got) * (mine - got)), R = wave_sum(mine * mine);
    if (!(E <= 4e-4f * R) && lane == 0) __hip_atomic_store(flag, 1u, RLX_AGENT);
}
__device__ __forceinline__ void ka_expect(Frame& F, const bf16* PROJ, float* EXP, const float* kg) {
    const int lane = F.lane, s = F.vcu * NWAVES + F.wave, m = (s * 40503 + 77) & (M - 1), pos = m & (T - 1);
    for (int hk = 0; hk < 2; ++hk) {
        const float raw = __uint_as_float((unsigned)PROJ[(size_t)m * INW + C_KA + hk * 64 + lane] << 16);
        const float ss = wave_sum(raw * raw), y = raw * (1.0f / sqrtf(ss * (1.f / 64.f) + 1e-6f)) * kg[lane];
        const int quarter = lane >> 4, i = lane & 15; const float partner = shx<16>(y);
        const float invf = exp2f(-(float)i * (13.287712379549449f / 16.f)), ang = ((quarter < 2) ? (float)(pos >> 6) : (float)(pos & 63)) * invf;
        const float cs = __cosf(ang), sn = __sinf(ang);
        EXP[(size_t)s * 128 + hk * 64 + lane] = (quarter & 1) ? (y * cs + partner * sn) : (y * cs - partner * sn);
    }
}
__device__ __forceinline__ void ka_compare(Frame& F, const bf16* PROJ, const float* EXP, gu32* flag) {
    const int lane = F.lane, s = F.vcu * NWAVES + F.wave, m = (s * 40503 + 77) & (M - 1);
    float E = 0.f, R = 0.f;
    for (int hk = 0; hk < 2; ++hk) { const float got = __uint_as_float((unsigned)PROJ[(size_t)m * INW + C_KA + hk * 64 + lane] << 16), ex = EXP[(size_t)s * 128 + hk * 64 + lane];
        E += (got - ex) * (got - ex); R += ex * ex; }
    E = wave_sum(E); R = wave_sum(R);
    if (!(E <= 1e-4f * R) && lane == 0) __hip_atomic_store(flag, 1u, RLX_AGENT);
}
#endif

typedef _Float16 f16x8 __attribute__((ext_vector_type(8)));
typedef _Float16 f16x4 __attribute__((ext_vector_type(4)));
template <bool X16, bool XIN16 = false> __device__ __forceinline__ void p3b_postmix(Frame& F, const float* xin, float* xout, const bf16* YM, signed char* HQ, float* hs, const float* mod_l,
                                            const float* post_g, const float* pre_g, const float* rw, const float* rb, int* topi, float* topw, gu32* cnt_g) {
    const int lane = F.lane, gw = F.vcu * NWAVES + F.wave, NGW = F.G * NWAVES;
    LAS unsigned char* WT = F.lds;
    LAS unsigned char* AT = F.lds + 65536 + F.wave * 8192;
    LAS unsigned* lcnt = (LAS unsigned*)(F.lds + LCNT_OFF);
#pragma unroll
    for (int i = 0; i < 16; ++i) { const int n = F.tid + NTHR * i, k = n >> 3, e0 = (n & 7) * 4; const f32x4 v = *(const f32x4*)(rw + (size_t)k * NE + e0);
#pragma unroll
        for (int q = 0; q < 4; ++q) { const int e = e0 + q; *(LAS _Float16*)(WT + e * 2048 + (((k >> 3) ^ (e & 15)) << 4) + (k & 7) * 2) = (_Float16)v[q]; } }
    if (F.tid < 32) lcnt[F.tid] = 0u;
    LAS float* GL = (LAS float*)(F.lds + GAIN_OFF);
    { const f32x4 g0 = ((const f32x4*)post_g)[F.tid & 255], g1 = ((const f32x4*)pre_g)[F.tid & 255]; if (F.tid < 256) { ((LAS f32x4*)GL)[F.tid] = g0; ((LAS f32x4*)(GL + D))[F.tid] = g1; } }
    __syncthreads();
    const float rbias = rb[lane & 31];
    const int ar = lane & 3, kg = lane >> 4, be = lane & 15;
    for (int ch = gw; ch < M / 32; ch += NGW) { const int mb = ch * 32;
        const float* modb = mod_l + (size_t)(mb >> 13) * (6 * D);
        f32x4 gpv[4], gsv[4], shv[4];
#pragma unroll
        for (int j = 0; j < 4; ++j) { const f32x4 gm = ((const f32x4*)(modb + 2 * D))[lane + 64 * j], sc = ((const f32x4*)(modb + 4 * D))[lane + 64 * j]; shv[j] = ((const f32x4*)(modb + 3 * D))[lane + 64 * j];
            gpv[j] = gm * ((const LAS f32x4*)GL)[lane + 64 * j]; gsv[j] = ((const LAS f32x4*)(GL + D))[lane + 64 * j] * (sc + 1.0f); }
        u32x2 ywA[2][4], ywB[2][4]; f32x4 xrA[2][4], xrB[2][4];
#define P3B_ISSUE(YW, XR, t0) do { _Pragma("unroll") for (int rr = 0; rr < 2; ++rr) { const u32x2* yr = (const u32x2*)(YM + (size_t)(mb + (t0) + rr) * D) + lane; \
            _Pragma("unroll") for (int j = 0; j < 4; ++j) YW[rr][j] = yr[64 * j]; \
            if constexpr (XIN16) { const u32x2* xq = (const u32x2*)((const bf16*)xin + (size_t)(mb + (t0) + rr) * D) + lane; _Pragma("unroll") for (int j = 0; j < 4; ++j) { const u32x2 w = xq[64 * j]; XR[rr][j].x = __uint_as_float(w.x); XR[rr][j].y = __uint_as_float(w.y); } } \
            else load_row_f32(xin + (size_t)(mb + (t0) + rr) * D, XR[rr], lane); } } while (0)
#define P3B_PROC(YW, XR, t0, RB) do { _Pragma("unroll") for (int rr = 0; rr < 2; ++rr) { const int m = mb + (t0) + rr, r = (RB) + rr; \
            f32x4 y[4], x[4], hf[4]; \
            _Pragma("unroll") for (int j = 0; j < 4; ++j) { const u32x2 w = YW[rr][j]; y[j] = (f32x4){bflo(w.x), bfhi(w.x), bflo(w.y), bfhi(w.y)}; \
                if constexpr (XIN16) { const unsigned xa = __float_as_uint(XR[rr][j].x), xb = __float_as_uint(XR[rr][j].y); x[j] = (f32x4){bflo(xa), bfhi(xa), bflo(xb), bfhi(xb)}; } else x[j] = XR[rr][j]; } \
            const float rsy = row_rstd(y); \
            _Pragma("unroll") for (int j = 0; j < 4; ++j) { x[j] = x[j] + gpv[j] * (y[j] * rsy); if constexpr (!X16) ((f32x4*)(xout + (size_t)m * D))[lane + 64 * j] = x[j]; } \
            if constexpr (X16) store_row_bf16((bf16*)xout + (size_t)m * D, x, lane); \
            { const float rs = row_rstd(x); _Pragma("unroll") for (int j = 0; j < 4; ++j) hf[j] = x[j] * rs * gsv[j] + shv[j]; } \
            store_row_i8(HQ + (size_t)m * D, hs + m, hf, lane);                    \
            _Pragma("unroll") for (int j = 0; j < 4; ++j) { const int c = (lane >> 1) + 32 * j;        \
                *(LAS f16x4*)(AT + r * 2048 + ((c ^ (r << 2)) << 4) + 8 * (lane & 1)) = (f16x4){(_Float16)hf[j].x, (_Float16)hf[j].y, (_Float16)hf[j].z, (_Float16)hf[j].w}; } } } while (0)
        P3B_ISSUE(ywA, xrA, 0);
#pragma unroll 1
        for (int it = 0; it < 8; ++it) { const int m0 = mb + 4 * it;
        P3B_ISSUE(ywB, xrB, 4 * it + 2);
        P3B_PROC(ywA, xrA, 4 * it, 0);
        if (it < 7) P3B_ISSUE(ywA, xrA, 4 * it + 4);
        P3B_PROC(ywB, xrB, 4 * it + 2, 2);
        f32x4 la = (f32x4){0.f, 0.f, 0.f, 0.f}, lb = (f32x4){0.f, 0.f, 0.f, 0.f};
#pragma unroll 8
        for (int s = 0; s < 32; ++s) { const int c = 4 * s + kg;
            const f16x8 a = *(const LAS f16x8*)(AT + ar * 2048 + ((c ^ (ar << 2)) << 4));
            const f16x8 b0 = *(const LAS f16x8*)(WT + be * 2048 + ((c ^ be) << 4)), b1 = *(const LAS f16x8*)(WT + (16 + be) * 2048 + ((c ^ be) << 4));
            la = __builtin_amdgcn_mfma_f32_16x16x32_f16(a, b0, la, 0, 0, 0); lb = __builtin_amdgcn_mfma_f32_16x16x32_f16(a, b1, lb, 0, 0, 0); }
        const bool upper = (lane & 32) != 0, blk = (lane & 16) != 0;
#pragma unroll
        for (int pr = 0; pr < 2; ++pr) {
            const float lo_ = blk ? lb[pr] : la[pr], up_ = blk ? lb[pr + 2] : la[pr + 2];
            const float logit = (upper ? up_ : lo_) + rbias;
            const int m = m0 + pr + (upper ? 2 : 0);
            bool taken = false; float tv[TOPK]; int ti[TOPK];
#pragma unroll
            for (int k = 0; k < TOPK; ++k) { float bv = taken ? -INFINITY : logit; int bi = lane & 31;
#define MX_STEP(o) { const float ov = shx<(o)>(bv); const int oi = shxi<(o)>(bi); const bool tk = (ov > bv) || (ov == bv && oi < bi); bv = tk ? ov : bv; bi = tk ? oi : bi; }
                MX_STEP(16) MX_STEP(8) MX_STEP(4) MX_STEP(2) MX_STEP(1)
#undef MX_STEP
                tv[k] = bv; ti[k] = bi; if ((lane & 31) == bi) taken = true; }
            const float e1 = __expf(tv[1] - tv[0]), e2 = __expf(tv[2] - tv[0]), e3 = __expf(tv[3] - tv[0]), inv = frcp(1.0f + e1 + e2 + e3);
            if ((lane & 31) == 0) { *(i32x4*)(topi + (size_t)m * 4) = (i32x4){ti[0], ti[1], ti[2], ti[3]}; *(f32x4*)(topw + (size_t)m * 4) = (f32x4){inv, e1 * inv, e2 * inv, e3 * inv}; }
            if (taken) atomicAdd((unsigned*)(lcnt + (lane & 31)), 1u);
        }
        }
#undef P3B_ISSUE
#undef P3B_PROC
    }
    __syncthreads();
    if (F.tid < 32) { const unsigned c = lcnt[F.tid]; if (c) __hip_atomic_fetch_add(cnt_g + F.tid, c, RLX_AGENT); }
}
__device__ __forceinline__ void p4a_route(Frame& F, const float* hs, int* rmap, float* xsc, const int* topi, int* pos, gu32* cnt_g, gu32* cur_g) {
    const int gw = F.vcu * NWAVES + F.wave, NGW = F.G * NWAVES;
    LAS int* ts = (LAS int*)(F.lds + LTS_OFF);
    if (F.tid == 0) { int a = 0; for (int e = 0; e < NE; ++e) { ts[e] = a; a += (int)((__hip_atomic_load(cnt_g + e, RLX_AGENT) + 255u) >> 8); } ts[NE] = a; }
    __syncthreads();
    const int lane = F.lane;
    if (gw < NE) {
        const int c = (int)__hip_atomic_load(cnt_g + gw, RLX_AGENT), p0 = ts[gw] * 256 + c, p1 = ts[gw + 1] * 256;
        for (int p = p0 + lane; p < p1; p += 64) rmap[p] = 0;
    }
    for (int base = gw * 64; base < M; base += NGW * 64) {
        const int tok = base + lane; const i32x4 id = *(const i32x4*)(topi + (size_t)tok * 4);
        unsigned mycnt = 0u;
#pragma unroll 1
        for (int e = 0; e < NE; ++e) { const unsigned long long mk = __ballot(id.x == e || id.y == e || id.z == e || id.w == e); if (lane == e) mycnt = (unsigned)__popcll(mk); }
        unsigned mybase = 0u;
        if (lane < NE && mycnt) mybase = __hip_atomic_fetch_add(cur_g + lane, mycnt, RLX_AGENT);
        i32x4 ps = (i32x4){0, 0, 0, 0};
#pragma unroll 1
        for (int e = 0; e < NE; ++e) { const bool has = (id.x == e || id.y == e || id.z == e || id.w == e); const unsigned long long mk = __ballot(has);
            const int p = ts[e] * 256 + bcastl((int)mybase, e) + (int)__builtin_amdgcn_mbcnt_hi((unsigned)(mk >> 32), __builtin_amdgcn_mbcnt_lo((unsigned)mk, 0u));
            if (id.x == e) ps.x = p; if (id.y == e) ps.y = p; if (id.z == e) ps.z = p; if (id.w == e) ps.w = p; }
        *(i32x4*)(pos + (size_t)tok * 4) = ps;
        { const float sc = hs[tok]; xsc[ps.x] = sc; xsc[ps.y] = sc; xsc[ps.z] = sc; xsc[ps.w] = sc; rmap[ps.x] = tok; rmap[ps.y] = tok; rmap[ps.z] = tok; rmap[ps.w] = tok; }
    }
}
template <bool Y_F8, bool X16, bool XOUT16 = false> __device__ __forceinline__ void p5b_combine(Frame& F, const float* xin, float* xout, const bf16* Y,
                                            const int* pos, const float* topw, const float* mod_l, const float* post_g,
                                            bool has_next, const float* mod_n, const float* pre_g_n, signed char* HQ, float* hs) {
    const int lane = F.lane, gw = F.vcu * NWAVES + F.wave, NGW = F.G * NWAVES;
    for (int ch = gw; ch < M / 32; ch += NGW) { const int mb = ch * 32;
        const float* modb = mod_l + (size_t)(mb >> 13) * (6 * D); const float* modn = mod_n + (size_t)(mb >> 13) * (6 * D);
        f32x4 gpv[4], gsv[4], shv[4];
#pragma unroll
        for (int j = 0; j < 4; ++j) { gpv[j] = ((const f32x4*)post_g)[lane + 64 * j] * ((const f32x4*)(modb + 5 * D))[lane + 64 * j];
            gsv[j] = ((const f32x4*)pre_g_n)[lane + 64 * j] * (((const f32x4*)(modn + D))[lane + 64 * j] + 1.0f); shv[j] = ((const f32x4*)modn)[lane + 64 * j]; }
        const i32x4 myps = *(const i32x4*)(pos + (size_t)(mb + (lane & 31)) * 4); const f32x4 mywt = *(const f32x4*)(topw + (size_t)(mb + (lane & 31)) * 4);
        u32x2 ywA[2][TOPK][4], ywB[2][TOPK][4], xwA[2][4], xwB[2][4]; f32x4 xfA[2][4], xfB[2][4];
#define P5B_ISSUE(YW, XW, XF, t0) do { _Pragma("unroll") for (int r = 0; r < 2; ++r) { const int t_ = (t0) + r; \
            _Pragma("unroll") for (int k = 0; k < TOPK; ++k) { const int p_ = __builtin_amdgcn_readlane(myps[k], t_); \
                if constexpr (Y_F8) { const int c0 = 4 * lane; const unsigned* yr = (const unsigned*)((const unsigned char*)Y + (size_t)p_ * D + 64 * ((c0 >> 5) & 3) + 16 * ((c0 >> 3) & 3) + 8 * (c0 >> 7) + (c0 & 7)); \
                    _Pragma("unroll") for (int j = 0; j < 4; ++j) { YW[r][k][j].x = yr[64 * j]; YW[r][k][j].y = 0u; } } \
                else { const u32x2* yr = (const u32x2*)(Y + (size_t)p_ * D) + lane; _Pragma("unroll") for (int j = 0; j < 4; ++j) YW[r][k][j] = yr[64 * j]; } } \
            if constexpr (X16) { const u32x2* xr = (const u32x2*)((const bf16*)xin + (size_t)(mb + t_) * D) + lane; _Pragma("unroll") for (int j = 0; j < 4; ++j) XW[r][j] = xr[64 * j]; } \
            else load_row_f32(xin + (size_t)(mb + t_) * D, XF[r], lane); } } while (0)
#define P5B_PROC(YW, XW, XF, t0) do { _Pragma("unroll") for (int r = 0; r < 2; ++r) { const int t_ = (t0) + r, m = mb + t_; f32x4 y[4], x[4]; \
            float wk[TOPK]; _Pragma("unroll") for (int k = 0; k < TOPK; ++k) wk[k] = __int_as_float(__builtin_amdgcn_readlane(__float_as_int(mywt[k]), t_)); \
            _Pragma("unroll") for (int j = 0; j < 4; ++j) { y[j] = (f32x4){0.f, 0.f, 0.f, 0.f}; \
                _Pragma("unroll") for (int k = 0; k < TOPK; ++k) { const u32x2 w = YW[r][k][j]; \
                    if constexpr (Y_F8) { typedef float f32x2p __attribute__((ext_vector_type(2))); const f32x2p lo = __builtin_amdgcn_cvt_pk_f32_fp8(w.x, false), hi2 = __builtin_amdgcn_cvt_pk_f32_fp8(w.x, true); \
                        y[j] += (f32x4){lo.x, lo.y, hi2.x, hi2.y} * wk[k]; } \
                    else y[j] += (f32x4){bflo(w.x), bfhi(w.x), bflo(w.y), bfhi(w.y)} * wk[k]; } \
                if constexpr (X16) { const u32x2 w = XW[r][j]; x[j] = (f32x4){bflo(w.x), bfhi(w.x), bflo(w.y), bfhi(w.y)}; } else x[j] = XF[r][j]; } \
            const float rsy = row_rstd(y); \
            _Pragma("unroll") for (int j = 0; j < 4; ++j) { x[j] = x[j] + gpv[j] * (y[j] * rsy); if constexpr (!XOUT16) ((f32x4*)(xout + (size_t)m * D))[lane + 64 * j] = x[j]; } \
            if constexpr (XOUT16) store_row_bf16((bf16*)xout + (size_t)m * D, x, lane);        \
            if (has_next) { f32x4 h[4]; const float rs = row_rstd(x); _Pragma("unroll") for (int j = 0; j < 4; ++j) h[j] = x[j] * rs * gsv[j] + shv[j]; \
                store_row_i8(HQ + (size_t)m * D, hs + m, h, lane); } } } while (0)
        P5B_ISSUE(ywA, xwA, xfA, 0);
#pragma unroll 1
        for (int it = 0; it < 8; ++it) { const int t0 = 4 * it;
            P5B_ISSUE(ywB, xwB, xfB, t0 + 2);
            P5B_PROC(ywA, xwA, xfA, t0);
            if (it < 7) P5B_ISSUE(ywA, xwA, xfA, t0 + 4);
            P5B_PROC(ywB, xwB, xfB, t0 + 2);
        }
#undef P5B_ISSUE
#undef P5B_PROC
    }
}

constexpr int PTAB_OFF = LDSCTL_OFF + 512;
enum { I_X = 0, I_C, I_ADAW, I_ADAB, I_PREMIX, I_POSTMIX, I_WIN, I_QG, I_KG, I_DECF, I_DECB, I_GNG, I_GNB, I_WOUT, I_PREFFN, I_POSTFFN, I_RW, I_RB, I_WUP, I_BUP, I_WDN, I_BDN, I_OUT, I_WS };
__device__ __forceinline__ unsigned char* ptab(LAS unsigned char* lds, int k) {
    const LAS unsigned* p = (const LAS unsigned*)(lds + PTAB_OFF) + 2 * k;
    const unsigned lo = __builtin_amdgcn_readfirstlane(p[0]), hi = __builtin_amdgcn_readfirstlane(p[1]);
    return (unsigned char*)(GAS unsigned char*)(((unsigned long long)hi << 32) | lo);
}
__device__ __forceinline__ unsigned char* ptabx(LAS unsigned char* lds, int k) {
    const LAS unsigned* p = (const LAS unsigned*)(lds + PTAB_OFF) + 2 * k;
    const unsigned lo = __builtin_amdgcn_readfirstlane(p[0]), hi = __builtin_amdgcn_readfirstlane(p[1]);
    return (unsigned char*)(((unsigned long long)hi << 32) | lo);
}
#define WSX(off) (ptabx(F.lds, I_WS) + (off))
#define PF(k) ((const float*)ptab(F.lds, (k)))
#define WSP(off) (ptab(F.lds, I_WS) + (off))
struct Args { const float* in[22]; float* out; unsigned char* ws; };
__global__ void __launch_bounds__(NTHR, 2) mk_fwd(Args args) {
    extern __shared__ __attribute__((aligned(16))) unsigned char lds[];
    Frame F;
    F.lds = (LAS unsigned char*)lds;
    F.MISC = (volatile LAS unsigned*)(F.lds + MISC_OFF);
    F.tid = threadIdx.x; F.lane = F.tid & 63; F.wave = __builtin_amdgcn_readfirstlane(F.tid >> 6);
    F.G = gridDim.x; { const int bx = blockIdx.x; F.vcu = (F.G % 8 == 0) ? (bx % 8) * (F.G / 8) + bx / 8 : bx; }
    F.ctl = (gu32*)(args.ws + WS_CTL);
    for (int u = F.tid; u < (LDS_BYTES - LDSCTL_OFF) / 4; u += NTHR) ((LAS unsigned*)(F.lds + LDSCTL_OFF))[u] = 0u;
    __syncthreads();
    if (F.tid == 0) { LAS unsigned long long* PT = (LAS unsigned long long*)(F.lds + PTAB_OFF);
#pragma unroll
        for (int k = 0; k < 22; ++k) PT[k] = (unsigned long long)args.in[k];
        PT[I_OUT] = (unsigned long long)args.out; PT[I_WS] = (unsigned long long)args.ws; }
    __syncthreads();
    (void)xcd_barrier_post((unsigned*)(F.ctl + CW_BAR), F.MISC + 8);
#define LAUNDER() do { F.tid = threadIdx.x; asm volatile("" : "+v"(F.tid)); F.lane = F.tid & 63; F.wave = __builtin_amdgcn_readfirstlane(F.tid >> 6); \
    { unsigned long long lb_ = (unsigned long long)lds0_; int vc_ = vcu0_, g_ = G0_; asm volatile("" : "+s"(lb_), "+s"(vc_), "+s"(g_)); F.lds = (LAS unsigned char*)lb_; F.vcu = vc_; F.G = g_; } } while (0)
#ifndef REP_BAR
#define REP_BAR 1
#endif
#define GRID_BAR() for (int rb_ = 0; rb_ < REP_BAR; ++rb_) do { XcdBarrier b_; b_.bar = (unsigned*)(ptab(F.lds, I_WS) + WS_CTL) + CW_BAR; b_.x = xb_xcc_id(); b_.st = (volatile LAS unsigned*)(F.lds + MISC_OFF) + 8; xcd_barrier(b_); LAUNDER(); } while (0)
    const LAS unsigned char* lds0_ = F.lds; const int vcu0_ = F.vcu, G0_ = F.G;

#ifndef SKIP_P0
    for (int rep_ = 0; rep_ < REP_P0; ++rep_)
    p0_prologue(F, PF(I_C), PF(I_ADAW), PF(I_ADAB), (float*)WSP(WS_MOD), PF(I_WIN), PF(I_WOUT), PF(I_WUP), PF(I_WDN),
                (signed char*)WSP(WS_WIN), (float*)WSP(WS_CSCIN), (signed char*)WSP(WS_WOUT), (float*)WSP(WS_CSCOUT), (signed char*)WSP(WS_WUP), (float*)WSP(WS_CSC), (signed char*)WSP(WS_WDN), (float*)WSP(WS_CSCDN), F.ctl + CW_WQ);
#endif
    GRID_BAR();
#ifndef SKIP_P0B
    for (int rep_ = 0; rep_ < REP_P0B; ++rep_)
    p0b_premix(F, PF(I_X), (signed char*)WSP(WS_HM), (float*)WSP(WS_HS), PF(I_PREMIX), (const float*)WSP(WS_MOD));
#endif
    GRID_BAR();
    { constexpr int l = 0;
        for (int rep_ = 0; rep_ < REP_P1; ++rep_) { LAUNDER();
#ifndef SKIP_P1
        {
            pg8::Gemm g{(const bf16*)WSP(WS_HM), (const bf16*)(WSP(WS_WIN) + (size_t)l * INW * D), M, INW, D / 2}; pg8::StaticOrder S; S.init(M, INW, F.G, (int)blockIdx.x);
            pg8::EpiI8Bf16 E{(bf16*)WSP(WS_PROJ), INW, (const float*)WSP(WS_HS), (const float*)WSP(WS_CSCIN) + (size_t)l * INW, F.lds + EPI_SP_OFF};
#if defined(STAGGER_P1)
            { const unsigned long long t0_ = __builtin_amdgcn_s_memrealtime(), dl_ = (unsigned long long)(F.vcu & 7) * STAGGER_P1; while (__builtin_amdgcn_s_memrealtime() - t0_ < dl_) __builtin_amdgcn_s_sleep(8); }
#endif
#if defined(NOEPI_P1)
            { pg8::EpiNullI8 E0; pg8::gemm_phase<pg8::EpiNullI8, pg8::StaticOrder, true, true, true, true>(F.lds + RING_OFF, g, S, E0, (const int*)WSP(WS_RMAP)); LAUNDER(); }
#endif
            pg8::gemm_phase<pg8::EpiI8Bf16, pg8::StaticOrder, true, true, true>(F.lds + RING_OFF, g, S, E);
        }
#endif
        }
        GRID_BAR();
#if defined(ATTN_PROBE)
        if (l == 0) ka_expect(F, (const bf16*)WSP(WS_PROJ), (float*)WSP(WS_DUMMY), PF(I_KG));
        GRID_BAR();
#endif
#ifndef SKIP_P1B
        p1b_ka(F, (bf16*)WSP(WS_PROJ), PF(I_KG) + l * 64);
#endif
        for (int rep_ = 0; rep_ < REP_R1; ++rep_) { LAUNDER();
#ifndef SKIP_R1
        r1_states(F, (const bf16*)WSP(WS_PROJ), (bf16*)WSP(WS_U), PF(I_DECF) + l * RH, PF(I_DECB) + l * RH);
#endif
        }
        GRID_BAR();
        for (int rep_ = 0; rep_ < REP_R2; ++rep_) { LAUNDER();
#ifndef SKIP_R2
        r2_scan(F, (const bf16*)WSP(WS_U), (bf16*)WSP(WS_FT), PF(I_DECF) + l * RH, PF(I_DECB) + l * RH);
#endif
        }
        GRID_BAR();
#pragma unroll 1
        for (int pass_ = 0; pass_ < 2; ++pass_) { LAUNDER();
        if (((F.vcu ^ pass_) & 1) == 0) {
#ifndef SKIP_R3
        r3_out(F, (const bf16*)WSP(WS_PROJ), (const bf16*)WSP(WS_FT), (bf16*)WSP(WS_CAT), PF(I_DECF) + l * RH, PF(I_DECB) + l * RH, PF(I_GNG) + l * 512, PF(I_GNB) + l * 512);
#endif
        } else {
#ifndef SKIP_P2
        {
            const bf16* PROJ = (const bf16*)WSP(WS_PROJ);
            const attn_body::AttnTensors AT{(const attn_body::bf16*)(PROJ + C_QA), (const attn_body::bf16*)(PROJ + C_KA), (const attn_body::bf16*)(PROJ + C_VA), (attn_body::bf16*)WSP(WS_CAT), PF(I_QG) + l * 64, PF(I_KG) + l * 64};
            attn_body::attn_phase<8>((char*)lds + RING_OFF, AT, F.vcu, F.G);
        }
#endif
        }
        }
        GRID_BAR();
#if defined(ATTN_PROBE)
        if (l == 0) ka_compare(F, (const bf16*)WSP(WS_PROJ), (const float*)WSP(WS_DUMMY), F.ctl + CW_CODE + 8);
        if (l == 0) attn_check(F, (const bf16*)WSP(WS_PROJ), (const bf16*)WSP(WS_CAT), F.ctl + CW_CODE + 8, PF(I_QG));
#endif
        for (int rep_ = 0; rep_ < REP_P3; ++rep_) { LAUNDER();
#ifndef SKIP_P3
        {
            pg8::Gemm g{(const bf16*)WSP(WS_CAT), (const bf16*)(WSP(WS_WOUT) + (size_t)l * D * D), M, D, D / 2}; pg8::StaticOrder S; S.init(M, D, F.G, (int)blockIdx.x);
            pg8::EpiBf16 E{(bf16*)WSP(WS_YM), D, nullptr, 0, 0, F.lds + EPI_SP_OFF, (const float*)WSP(WS_CSCOUT) + (size_t)l * D, 1.0f};
            pg8::gemm_phase<pg8::EpiBf16, pg8::StaticOrder, true, true, false, false, true>(F.lds + RING_OFF, g, S, E);
        }
#endif
        }
        GRID_BAR();
#ifndef SKIP_P3B
        for (int rep_ = 1; rep_ < REP_P3B; ++rep_) { LAUNDER();
        p3b_postmix<false, (l > 0)>(F, l == 0 ? PF(I_X) : PF(I_OUT), (float*)WSP(WS_DUMMY), (const bf16*)WSP(WS_YM), (signed char*)WSP(WS_DUMMY + 256 * MiB), (float*)WSP(WS_DUMMY + 386 * MiB), (const float*)WSP(WS_MOD) + (size_t)l * BATCH * 6 * D,
                    PF(I_POSTMIX) + l * D, PF(I_PREFFN) + l * D, PF(I_RW) + (size_t)l * D * NE, PF(I_RB) + l * NE, (int*)WSP(WS_DUMMY + 384 * MiB), (float*)WSP(WS_DUMMY + 385 * MiB), F.ctl + CW_CNT + 128 + l * 64);
        }
        LAUNDER();
        p3b_postmix<(l >= X16_FROM), (l > 0)>(F, l == 0 ? PF(I_X) : PF(I_OUT), (l >= X16_FROM) ? (float*)WSP(WS_CAT) : (float*)ptab(F.lds, I_OUT), (const bf16*)WSP(WS_YM), (signed char*)WSP(WS_HM), (float*)WSP(WS_HS), (const float*)WSP(WS_MOD) + (size_t)l * BATCH * 6 * D,
                    PF(I_POSTMIX) + l * D, PF(I_PREFFN) + l * D, PF(I_RW) + (size_t)l * D * NE, PF(I_RB) + l * NE, (int*)WSP(WS_TOPI), (float*)WSP(WS_TOPW), F.ctl + CW_CNT + l * 64);
#endif
        GRID_BAR();
#ifndef SKIP_P4A
        for (int rep_ = 1; rep_ < REP_P4A; ++rep_) { LAUNDER();
        p4a_route(F, (const float*)WSP(WS_HS), (int*)WSP(WS_DUMMY + 16 * MiB), (float*)WSP(WS_DUMMY + 8 * MiB), (const int*)WSP(WS_TOPI), (int*)WSP(WS_DUMMY), F.ctl + CW_CNT + l * 64, F.ctl + CW_CUR + 128 + l * 64);
        }
        LAUNDER();
        p4a_route(F, (const float*)WSP(WS_HS), (int*)WSP(WS_RMAP), (float*)WSP(WS_XSC), (const int*)WSP(WS_TOPI), (int*)WSP(WS_POS), F.ctl + CW_CNT + l * 64, F.ctl + CW_CUR + l * 64);
#endif
        GRID_BAR();
        for (int rep_ = 0; rep_ < REP_P4; ++rep_) { LAUNDER();
#ifndef SKIP_P4
        {
            const LAS int* ts = (const LAS int*)(F.lds + LTS_OFF);
            pg8::Gemm g{(const bf16*)WSP(WS_HM), (const bf16*)(WSP(WS_WUP) + (size_t)l * NE * 2048 * D), XS_ROWS, 2048, D / 2}; pg8::MoeOrder<3> S{ts, F.G, F.vcu, ts[NE] * 8, ts[F.lane & 31]};
            pg8::EpiMoeUpT<true> E{(bf16*)WSP(WS_ACT), PF(I_BUP) + (size_t)l * NE * 2048, (const float*)WSP(WS_XSC), (const float*)WSP(WS_CSC) + (size_t)l * NE * 2048, F.lds + EPI_SP_OFF};
#if defined(STAGGER_P4)
            { const unsigned long long t0_ = __builtin_amdgcn_s_memrealtime(), dl_ = (unsigned long long)(F.vcu & (STAGGER_WAYS - 1)) * STAGGER_P4; while (__builtin_amdgcn_s_memrealtime() - t0_ < dl_) __builtin_amdgcn_s_sleep(8); }
#endif
#if defined(NOLOAD_P4)
            { pg8::EpiMoeUpNoLoad E0{(bf16*)WSP(WS_ACT), 1e-4f, 0.01f}; pg8::gemm_phase<pg8::EpiMoeUpNoLoad, pg8::MoeOrder<3>, true, true, true, true>(F.lds + RING_OFF, g, S, E0, (const int*)WSP(WS_RMAP)); LAUNDER(); }
#endif
#if defined(NOSTORE_P4)
            { pg8::EpiMoeUpNoStore E0{(bf16*)WSP(WS_ACT), 1e-4f, 0.01f}; pg8::gemm_phase<pg8::EpiMoeUpNoStore, pg8::MoeOrder<3>, true, true, true, true>(F.lds + RING_OFF, g, S, E0, (const int*)WSP(WS_RMAP)); LAUNDER(); }
#endif
#if defined(NOEPI_P4)
            { pg8::EpiNullI8 E0; pg8::gemm_phase<pg8::EpiNullI8, pg8::MoeOrder<3>, true, true, true, true>(F.lds + RING_OFF, g, S, E0, (const int*)WSP(WS_RMAP)); LAUNDER(); }
#endif
            pg8::gemm_phase<pg8::EpiMoeUpT<true>, pg8::MoeOrder<3>, true, true, true, true>(F.lds + RING_OFF, g, S, E, (const int*)WSP(WS_RMAP));
        }
#endif
        }
        GRID_BAR();
        for (int rep_ = 0; rep_ < REP_P5; ++rep_) { LAUNDER();
#ifndef SKIP_P5
        {
            const LAS int* ts = (const LAS int*)(F.lds + LTS_OFF);
            pg8::Gemm g{(const bf16*)WSP(WS_ACT), (const bf16*)(WSP(WS_WDN) + (size_t)l * NE * D * D), XS_ROWS, D, D / 2}; pg8::MoeOrder<2> S{ts, F.G, F.vcu, ts[NE] * 4, ts[F.lane & 31]};
            typedef pg8::EpiBf16T<(l >= YF8_FROM)> EpiDn;
            EpiDn E{(bf16*)WSP(WS_XS), D, PF(I_BDN) + (size_t)l * NE * D, D, 0, F.lds + EPI_SP_OFF, (const float*)WSP(WS_CSCDN) + (size_t)l * NE * D, 1.0f / pg8::ACT_F8_SCALE};
#if defined(STAGGER_P5)
            { const unsigned long long t0_ = __builtin_amdgcn_s_memrealtime(), dl_ = (unsigned long long)(F.vcu & 7) * STAGGER_P5; while (__builtin_amdgcn_s_memrealtime() - t0_ < dl_) __builtin_amdgcn_s_sleep(8); }
#endif
            pg8::gemm_phase<EpiDn, pg8::MoeOrder<2>, true, true, false, false, true>(F.lds + RING_OFF, g, S, E);
        }
#endif
        }
        GRID_BAR();
#ifndef SKIP_P5B
        for (int rep_ = 1; rep_ < REP_P5B; ++rep_) { LAUNDER();
        p5b_combine<(l >= YF8_FROM), (l >= X16_FROM), (l + 1 < DEPTH)>(F, (l >= X16_FROM) ? (const float*)WSP(WS_CAT) : (const float*)ptab(F.lds, I_OUT), (float*)WSP(WS_DUMMY), (const bf16*)WSP(WS_XS), (const int*)WSP(WS_POS), (const float*)WSP(WS_TOPW), (const float*)WSP(WS_MOD) + (size_t)l * BATCH * 6 * D, PF(I_POSTFFN) + l * D,
                    l + 1 < DEPTH, (const float*)WSP(WS_MOD) + (size_t)(l + 1 < DEPTH ? l + 1 : l) * BATCH * 6 * D, PF(I_PREMIX) + (l + 1 < DEPTH ? (l + 1) * D : 0), (signed char*)WSP(WS_DUMMY + 256 * MiB), (float*)WSP(WS_DUMMY + 386 * MiB));
        }
        LAUNDER();
        p5b_combine<(l >= YF8_FROM), (l >= X16_FROM), (l + 1 < DEPTH)>(F, (l >= X16_FROM) ? (const float*)WSP(WS_CAT) : (const float*)ptab(F.lds, I_OUT), (float*)ptab(F.lds, I_OUT), (const bf16*)WSP(WS_XS), (const int*)WSP(WS_POS), (const float*)WSP(WS_TOPW), (const float*)WSP(WS_MOD) + (size_t)l * BATCH * 6 * D, PF(I_POSTFFN) + l * D,
                    l + 1 < DEPTH, (const float*)WSP(WS_MOD) + (size_t)(l + 1 < DEPTH ? l + 1 : l) * BATCH * 6 * D, PF(I_PREMIX) + (l + 1 < DEPTH ? (l + 1) * D : 0), (signed char*)WSP(WS_HM), (float*)WSP(WS_HS));
#endif
        if (l + 1 < DEPTH) GRID_BAR();
    }
    { constexpr int l = 1;
        for (int rep_ = 0; rep_ < REP_P1; ++rep_) { LAUNDER();
#ifndef SKIP_P1
        {
            pg8::Gemm g{(const bf16*)WSP(WS_HM), (const bf16*)(WSP(WS_WIN) + (size_t)l * INW * D), M, INW, D / 2}; pg8::StaticOrder S; S.init(M, INW, F.G, (int)blockIdx.x);
            pg8::EpiI8Bf16 E{(bf16*)WSP(WS_PROJ), INW, (const float*)WSP(WS_HS), (const float*)WSP(WS_CSCIN) + (size_t)l * INW, F.lds + EPI_SP_OFF};
#if defined(STAGGER_P1)
            { const unsigned long long t0_ = __builtin_amdgcn_s_memrealtime(), dl_ = (unsigned long long)(F.vcu & 7) * STAGGER_P1; while (__builtin_amdgcn_s_memrealtime() - t0_ < dl_) __builtin_amdgcn_s_sleep(8); }
#endif
#if defined(NOEPI_P1)
            { pg8::EpiNullI8 E0; pg8::gemm_phase<pg8::EpiNullI8, pg8::StaticOrder, true, true, true, true>(F.lds + RING_OFF, g, S, E0, (const int*)WSP(WS_RMAP)); LAUNDER(); }
#endif
            pg8::gemm_phase<pg8::EpiI8Bf16, pg8::StaticOrder, true, true, true>(F.lds + RING_OFF, g, S, E);
        }
#endif
        }
        GRID_BAR();
#if defined(ATTN_PROBE)
        if (l == 0) ka_expect(F, (const bf16*)WSP(WS_PROJ), (float*)WSP(WS_DUMMY), PF(I_KG));
        GRID_BAR();
#endif
#ifndef SKIP_P1B
        p1b_ka(F, (bf16*)WSP(WS_PROJ), PF(I_KG) + l * 64);
#endif
        for (int rep_ = 0; rep_ < REP_R1; ++rep_) { LAUNDER();
#ifndef SKIP_R1
        r1_states(F, (const bf16*)WSP(WS_PROJ), (bf16*)WSP(WS_U), PF(I_DECF) + l * RH, PF(I_DECB) + l * RH);
#endif
        }
        GRID_BAR();
        for (int rep_ = 0; rep_ < REP_R2; ++rep_) { LAUNDER();
#ifndef SKIP_R2
        r2_scan(F, (const bf16*)WSP(WS_U), (bf16*)WSP(WS_FT), PF(I_DECF) + l * RH, PF(I_DECB) + l * RH);
#endif
        }
        GRID_BAR();
#pragma unroll 1
        for (int pass_ = 0; pass_ < 2; ++pass_) { LAUNDER();
        if (((F.vcu ^ pass_) & 1) == 0) {
#ifndef SKIP_R3
        r3_out(F, (const bf16*)WSP(WS_PROJ), (const bf16*)WSP(WS_FT), (bf16*)WSP(WS_CAT), PF(I_DECF) + l * RH, PF(I_DECB) + l * RH, PF(I_GNG) + l * 512, PF(I_GNB) + l * 512);
#endif
        } else {
#ifndef SKIP_P2
        {
            const bf16* PROJ = (const bf16*)WSP(WS_PROJ);
            const attn_body::AttnTensors AT{(const attn_body::bf16*)(PROJ + C_QA), (const attn_body::bf16*)(PROJ + C_KA), (const attn_body::bf16*)(PROJ + C_VA), (attn_body::bf16*)WSP(WS_CAT), PF(I_QG) + l * 64, PF(I_KG) + l * 64};
            attn_body::attn_phase<8>((char*)lds + RING_OFF, AT, F.vcu, F.G);
        }
#endif
        }
        }
        GRID_BAR();
#if defined(ATTN_PROBE)
        if (l == 0) ka_compare(F, (const bf16*)WSP(WS_PROJ), (const float*)WSP(WS_DUMMY), F.ctl + CW_CODE + 8);
        if (l == 0) attn_check(F, (const bf16*)WSP(WS_PROJ), (const bf16*)WSP(WS_CAT), F.ctl + CW_CODE + 8, PF(I_QG));
#endif
        for (int rep_ = 0; rep_ < REP_P3; ++rep_) { LAUNDER();
#ifndef SKIP_P3
        {
            pg8::Gemm g{(const bf16*)WSP(WS_CAT), (const bf16*)(WSP(WS_WOUT) + (size_t)l * D * D), M, D, D / 2}; pg8::StaticOrder S; S.init(M, D, F.G, (int)blockIdx.x);
            pg8::EpiBf16 E{(bf16*)WSP(WS_YM), D, nullptr, 0, 0, F.lds + EPI_SP_OFF, (const float*)WSP(WS_CSCOUT) + (size_t)l * D, 1.0f};
            pg8::gemm_phase<pg8::EpiBf16, pg8::StaticOrder, true, true, false, false, true>(F.lds + RING_OFF, g, S, E);
        }
#endif
        }
        GRID_BAR();
#ifndef SKIP_P3B
        for (int rep_ = 1; rep_ < REP_P3B; ++rep_) { LAUNDER();
        p3b_postmix<false, (l > 0)>(F, l == 0 ? PF(I_X) : PF(I_OUT), (float*)WSP(WS_DUMMY), (const bf16*)WSP(WS_YM), (signed char*)WSP(WS_DUMMY + 256 * MiB), (float*)WSP(WS_DUMMY + 386 * MiB), (const float*)WSP(WS_MOD) + (size_t)l * BATCH * 6 * D,
                    PF(I_POSTMIX) + l * D, PF(I_PREFFN) + l * D, PF(I_RW) + (size_t)l * D * NE, PF(I_RB) + l * NE, (int*)WSP(WS_DUMMY + 384 * MiB), (float*)WSP(WS_DUMMY + 385 * MiB), F.ctl + CW_CNT + 128 + l * 64);
        }
        LAUNDER();
        p3b_postmix<(l >= X16_FROM), (l > 0)>(F, l == 0 ? PF(I_X) : PF(I_OUT), (l >= X16_FROM) ? (float*)WSP(WS_CAT) : (float*)ptab(F.lds, I_OUT), (const bf16*)WSP(WS_YM), (signed char*)WSP(WS_HM), (float*)WSP(WS_HS), (const float*)WSP(WS_MOD) + (size_t)l * BATCH * 6 * D,
                    PF(I_POSTMIX) + l * D, PF(I_PREFFN) + l * D, PF(I_RW) + (size_t)l * D * NE, PF(I_RB) + l * NE, (int*)WSP(WS_TOPI), (float*)WSP(WS_TOPW), F.ctl + CW_CNT + l * 64);
#endif
        GRID_BAR();
#ifndef SKIP_P4A
        for (int rep_ = 1; rep_ < REP_P4A; ++rep_) { LAUNDER();
        p4a_route(F, (const float*)WSP(WS_HS), (int*)WSP(WS_DUMMY + 16 * MiB), (float*)WSP(WS_DUMMY + 8 * MiB), (const int*)WSP(WS_TOPI), (int*)WSP(WS_DUMMY), F.ctl + CW_CNT + l * 64, F.ctl + CW_CUR + 128 + l * 64);
        }
        LAUNDER();
        p4a_route(F, (const float*)WSP(WS_HS), (int*)WSP(WS_RMAP), (float*)WSP(WS_XSC), (const int*)WSP(WS_TOPI), (int*)WSP(WS_POS), F.ctl + CW_CNT + l * 64, F.ctl + CW_CUR + l * 64);
#endif
        GRID_BAR();
        for (int rep_ = 0; rep_ < REP_P4; ++rep_) { LAUNDER();
#ifndef SKIP_P4
        {
            const LAS int* ts = (const LAS int*)(F.lds + LTS_OFF);
            pg8::Gemm g{(const bf16*)WSP(WS_HM), (const bf16*)(WSP(WS_WUP) + (size_t)l * NE * 2048 * D), XS_ROWS, 2048, D / 2}; pg8::MoeOrder<3> S{ts, F.G, F.vcu, ts[NE] * 8, ts[F.lane & 31]};
            pg8::EpiMoeUpT<true> E{(bf16*)WSP(WS_ACT), PF(I_BUP) + (size_t)l * NE * 2048, (const float*)WSP(WS_XSC), (const float*)WSP(WS_CSC) + (size_t)l * NE * 2048, F.lds + EPI_SP_OFF};
#if defined(STAGGER_P4)
            { const unsigned long long t0_ = __builtin_amdgcn_s_memrealtime(), dl_ = (unsigned long long)(F.vcu & (STAGGER_WAYS - 1)) * STAGGER_P4; while (__builtin_amdgcn_s_memrealtime() - t0_ < dl_) __builtin_amdgcn_s_sleep(8); }
#endif
#if defined(NOLOAD_P4)
            { pg8::EpiMoeUpNoLoad E0{(bf16*)WSP(WS_ACT), 1e-4f, 0.01f}; pg8::gemm_phase<pg8::EpiMoeUpNoLoad, pg8::MoeOrder<3>, true, true, true, true>(F.lds + RING_OFF, g, S, E0, (const int*)WSP(WS_RMAP)); LAUNDER(); }
#endif
#if defined(NOSTORE_P4)
            { pg8::EpiMoeUpNoStore E0{(bf16*)WSP(WS_ACT), 1e-4f, 0.01f}; pg8::gemm_phase<pg8::EpiMoeUpNoStore, pg8::MoeOrder<3>, true, true, true, true>(F.lds + RING_OFF, g, S, E0, (const int*)WSP(WS_RMAP)); LAUNDER(); }
#endif
#if defined(NOEPI_P4)
            { pg8::EpiNullI8 E0; pg8::gemm_phase<pg8::EpiNullI8, pg8::MoeOrder<3>, true, true, true, true>(F.lds + RING_OFF, g, S, E0, (const int*)WSP(WS_RMAP)); LAUNDER(); }
#endif
            pg8::gemm_phase<pg8::EpiMoeUpT<true>, pg8::MoeOrder<3>, true, true, true, true>(F.lds + RING_OFF, g, S, E, (const int*)WSP(WS_RMAP));
        }
#endif
        }
        GRID_BAR();
        for (int rep_ = 0; rep_ < REP_P5; ++rep_) { LAUNDER();
#ifndef SKIP_P5
        {
            const LAS int* ts = (const LAS int*)(F.lds + LTS_OFF);
            pg8::Gemm g{(const bf16*)WSP(WS_ACT), (const bf16*)(WSP(WS_WDN) + (size_t)l * NE * D * D), XS_ROWS, D, D / 2}; pg8::MoeOrder<2> S{ts, F.G, F.vcu, ts[NE] * 4, ts[F.lane & 31]};
            typedef pg8::EpiBf16T<(l >= YF8_FROM)> EpiDn;
            EpiDn E{(bf16*)WSP(WS_XS), D, PF(I_BDN) + (size_t)l * NE * D, D, 0, F.lds + EPI_SP_OFF, (const float*)WSP(WS_CSCDN) + (size_t)l * NE * D, 1.0f / pg8::ACT_F8_SCALE};
#if defined(STAGGER_P5)
            { const unsigned long long t0_ = __builtin_amdgcn_s_memrealtime(), dl_ = (unsigned long long)(F.vcu & 7) * STAGGER_P5; while (__builtin_amdgcn_s_memrealtime() - t0_ < dl_) __builtin_amdgcn_s_sleep(8); }
#endif
            pg8::gemm_phase<EpiDn, pg8::MoeOrder<2>, true, true, false, false, true>(F.lds + RING_OFF, g, S, E);
        }
#endif
        }
        GRID_BAR();
#ifndef SKIP_P5B
        for (int rep_ = 1; rep_ < REP_P5B; ++rep_) { LAUNDER();
        p5b_combine<(l >= YF8_FROM), (l >= X16_FROM), (l + 1 < DEPTH)>(F, (l >= X16_FROM) ? (const float*)WSP(WS_CAT) : (const float*)ptab(F.lds, I_OUT), (float*)WSP(WS_DUMMY), (const bf16*)WSP(WS_XS), (const int*)WSP(WS_POS), (const float*)WSP(WS_TOPW), (const float*)WSP(WS_MOD) + (size_t)l * BATCH * 6 * D, PF(I_POSTFFN) + l * D,
                    l + 1 < DEPTH, (const float*)WSP(WS_MOD) + (size_t)(l + 1 < DEPTH ? l + 1 : l) * BATCH * 6 * D, PF(I_PREMIX) + (l + 1 < DEPTH ? (l + 1) * D : 0), (signed char*)WSP(WS_DUMMY + 256 * MiB), (float*)WSP(WS_DUMMY + 386 * MiB));
        }
        LAUNDER();
        p5b_combine<(l >= YF8_FROM), (l >= X16_FROM), (l + 1 < DEPTH)>(F, (l >= X16_FROM) ? (const float*)WSP(WS_CAT) : (const float*)ptab(F.lds, I_OUT), (float*)ptab(F.lds, I_OUT), (const bf16*)WSP(WS_XS), (const int*)WSP(WS_POS), (const float*)WSP(WS_TOPW), (const float*)WSP(WS_MOD) + (size_t)l * BATCH * 6 * D, PF(I_POSTFFN) + l * D,
                    l + 1 < DEPTH, (const float*)WSP(WS_MOD) + (size_t)(l + 1 < DEPTH ? l + 1 : l) * BATCH * 6 * D, PF(I_PREMIX) + (l + 1 < DEPTH ? (l + 1) * D : 0), (signed char*)WSP(WS_HM), (float*)WSP(WS_HS));
#endif
        if (l + 1 < DEPTH) GRID_BAR();
    }
#if defined(ATTN_PROBE)
    GRID_BAR();
    if (blockIdx.x == 0 && F.tid == 0 && __hip_atomic_load(F.ctl + CW_CODE + 8, RLX_AGENT) != 0u) ((float*)ptab(F.lds, I_OUT))[0] = __builtin_nanf("");
#endif
#undef GRID_BAR
}

extern "C" void kernel_launch(void* const* d_in, const int* in_sizes, int n_in, void* d_out, int out_size, void* d_ws, size_t ws_size, hipStream_t stream) {
    static int grid = 0;
    if (grid == 0) {
        if (n_in != 22 || in_sizes[0] != M * D || out_size != M * D || ws_size < WS_END) { fprintf(stderr, "kernel_launch: unexpected shapes/workspace (n_in %d, in0 %d, out %d, ws %zu < %zu)\n", n_in, n_in > 0 ? in_sizes[0] : -1, out_size, ws_size, (size_t)WS_END); grid = -1; return; }
        int dev = 0, cus = 0, per_cu = 0;
        if (hipGetDevice(&dev) != hipSuccess || hipDeviceGetAttribute(&cus, hipDeviceAttributeMultiprocessorCount, dev) != hipSuccess) { grid = -1; return; }
        if (hipFuncSetAttribute((const void*)mk_fwd, hipFuncAttributeMaxDynamicSharedMemorySize, LDS_BYTES) != hipSuccess) { fprintf(stderr, "kernel_launch: hipFuncSetAttribute failed\n"); grid = -1; return; }
        if (hipOccupancyMaxActiveBlocksPerMultiprocessor(&per_cu, (const void*)mk_fwd, NTHR, LDS_BYTES) != hipSuccess || per_cu < 1) { fprintf(stderr, "kernel_launch: occupancy query says %d\n", per_cu); }
        (void)hipGetLastError();
        grid = cus;
    }
    if (grid < 0) return;
    if (hipMemsetAsync((char*)d_ws + WS_CTL, 0, CTL_ZERO_BYTES, stream) != hipSuccess) { fprintf(stderr, "kernel_launch: memset failed\n"); return; }
    Args a{};
    for (int i = 0; i < 22; ++i) a.in[i] = (const float*)d_in[i];
    a.out = (float*)d_out; a.ws = (unsigned char*)d_ws;
    hipLaunchKernelGGL(mk_fwd, dim3(grid), dim3(NTHR), LDS_BYTES, stream, a);
    const hipError_t le = hipPeekAtLastError();
    if (le != hipSuccess) fprintf(stderr, "kernel_launch: launch failed: %s\n", hipGetErrorName(le));
}
```

```cpp
#ifndef REP_P0
#define REP_P0 1
#endif
#ifndef REP_P1
#define REP_P1 1
#endif
#ifndef REP_R1
#define REP_R1 1
#endif
#ifndef REP_R2
#define REP_R2 1
#endif
#ifndef REP_R3
#define REP_R3 1
#endif
#ifndef REP_P2
#define REP_P2 1
#endif
#ifndef REP_P3
#define REP_P3 1
#endif
#ifndef REP_P4
#define REP_P4 1
#endif
#ifndef REP_P5
#define REP_P5 1
#endif
#ifndef REP_P0B
#define REP_P0B 1
#endif
#ifndef REP_P1B
#define REP_P1B 1
#endif
#ifndef REP_P3B
#define REP_P3B 1
#endif
#ifndef REP_P4A
#define REP_P4A 1
#endif
#ifndef REP_P5B
#define REP_P5B 1
#endif
#ifndef REP_EPI
#define REP_EPI 1
#endif
#ifndef STAGGER_WAYS
#define STAGGER_WAYS 8
#endif
#include <hip/hip_runtime.h>
template <int M> __device__ __forceinline__ float shx(float v) { return __int_as_float(__builtin_amdgcn_ds_swizzle(__float_as_int(v), (M << 10) | 0x1f)); }
template <int M> __device__ __forceinline__ int shxi(int v) { return __builtin_amdgcn_ds_swizzle(v, (M << 10) | 0x1f); }
__device__ __forceinline__ float sum32(float v) { auto rr = __builtin_amdgcn_permlane32_swap(__float_as_uint(v), __float_as_uint(v), false, false); return __uint_as_float(rr[0]) + __uint_as_float(rr[1]); }
__device__ __forceinline__ float max32(float v) { auto rr = __builtin_amdgcn_permlane32_swap(__float_as_uint(v), __float_as_uint(v), false, false); return fmaxf(__uint_as_float(rr[0]), __uint_as_float(rr[1])); }
__device__ __forceinline__ float shx32(float v, bool upper) { auto rr = __builtin_amdgcn_permlane32_swap(__float_as_uint(v), __float_as_uint(v), false, false); return __uint_as_float(upper ? rr[0] : rr[1]); }
__device__ __forceinline__ int bcastl(int v, int srclane) { return __builtin_amdgcn_ds_bpermute(srclane << 2, v); }
__device__ __forceinline__ float wsum64(float v) { v += shx<1>(v); v += shx<2>(v); v += shx<4>(v); v += shx<8>(v); v += shx<16>(v); return sum32(v); }
__device__ __forceinline__ float wmax64(float v) { v = fmaxf(v, shx<1>(v)); v = fmaxf(v, shx<2>(v)); v = fmaxf(v, shx<4>(v)); v = fmaxf(v, shx<8>(v)); v = fmaxf(v, shx<16>(v)); return max32(v); }
#ifndef YF8_FROM
#define YF8_FROM 0
#endif
#ifndef X16_FROM
#define X16_FROM 0
#endif
#include <hip/hip_runtime.h>
#include <cstdio>
#include <cstdint>
namespace pg8 {
#define PG8_LAS __attribute__((address_space(3)))
typedef unsigned short bf16_t;
typedef short bf16x8 __attribute__((ext_vector_type(8)));
typedef float f32x4 __attribute__((ext_vector_type(4)));
typedef unsigned u32x4 __attribute__((ext_vector_type(4)));
constexpr int BM = 256, BK = 64, HALF = 128, HTB = HALF * BK * 2  , STAGE_BYTES = 8 * HTB, NXCD = 8, WGM = 8;

__host__ __device__ __forceinline__ int lds_byte(int r, int c) { const int st = (r >> 4) * 2 + (c >> 5), rr = r & 15, cc = c & 31, ob = rr * 64 + cc * 2; return st * 1024 + (ob ^ (((ob >> 9) & 1) << 5)); }
__host__ __device__ __forceinline__ void stage_rc(int b, int& R, int& C) { const int st = b / 1024, sb = b % 1024, swz = sb ^ (((sb >> 9) & 1) << 5); R = (st >> 1) * 16 + swz / 64; C = (st & 1) * 32 + (swz % 64) / 2; }
__host__ __device__ __forceinline__ int perm32(int rho) { const int n = rho >> 4, i = rho & 15; return 8 * (i >> 2) + 4 * n + (i & 3); }

struct Unit { int pm, pn; };
struct Gemm { const bf16_t* A; const bf16_t* Bt; int M, N, K; };

struct StaticOrder {
    int nM, nN, nwg, G, c;
    __host__ __device__ void init(int M, int N, int G_, int c_) { nM = M / BM; nN = N / BM; nwg = nM * nN; G = G_; c = c_; }
    __host__ __device__ bool next(int i, Unit& u) const {
        const long L = (long)i * G + c; if (L >= nwg) return false;
        int wgid = (int)L; { const int q = nwg / NXCD, r = nwg % NXCD, xcd = wgid % NXCD, off = wgid / NXCD; wgid = (xcd < r ? xcd * (q + 1) : r * (q + 1) + (xcd - r) * q) + off; }
        const int nig = WGM * nN, gid = wgid / nig, fm = gid * WGM, gsz = (nM - fm) < WGM ? (nM - fm) : WGM;
        u.pm = fm + ((wgid % nig) % gsz); u.pn = (wgid % nig) / gsz; return true;
    }
    __device__ __forceinline__ void a_ready(const Unit&) const {}
    __device__ __forceinline__ void done(const Unit&) const {}
};

__device__ __forceinline__ unsigned cvt_pk_bf16(float lo, float hi) { unsigned r; asm volatile("v_cvt_pk_bf16_f32 %0, %1, %2" : "=v"(r) : "v"(lo), "v"(hi)); return r; }
typedef float f32x2 __attribute__((ext_vector_type(2)));

typedef int i32x4 __attribute__((ext_vector_type(4)));
__device__ __forceinline__ void dma4(const float* g, PG8_LAS unsigned char* l) { __builtin_amdgcn_global_load_lds((const unsigned*)g, (PG8_LAS unsigned*)l, 4, 0, 0); }
template <bool OUT_F8> struct EpiBf16T {
    static constexpr bool PERM = true, AFTER_DRAIN = false; static constexpr int NST = OUT_F8 ? 8 : 16;
    bf16_t* O; int ldc; const float* bias; int split_cols; size_t split_stride; PG8_LAS unsigned char* sp;
    const float* csc = nullptr; float cmul = 1.0f;
    __device__ __forceinline__ void prefetch(const Unit& u, int wid, int lane) const {
        if (bias && wid < 4) dma4(bias + u.pn * BM + wid * 64 + lane, sp + wid * 256);
        if (csc && wid >= 4) dma4(csc + u.pn * BM + (wid - 4) * 64 + lane, sp + 1024 + (wid - 4) * 256);
    }
    __device__ __forceinline__ void operator()(const f32x4 (&acc)[2][2][4][2], const Unit& u, int wr, int wc, int fr, int fq) const {
        const int row0 = u.pm * BM + wr * 64 + fr; int colt = u.pn * BM; bf16_t* base = O;
        if (split_cols) { const int t = colt / split_cols; base += (size_t)t * split_stride; colt -= t * split_cols; }
        const int col0 = colt + wc * 32 + 8 * fq;
        f32x4 bv[2][2];
#pragma unroll
        for (int bj = 0; bj < 2; ++bj)
#pragma unroll
            for (int n = 0; n < 2; ++n) bv[bj][n] = bias ? *(const PG8_LAS f32x4*)(sp + 4 * (bj * HALF + wc * 32 + 8 * fq + 4 * n)) : (f32x4){0.f, 0.f, 0.f, 0.f};
        f32x4 cv[2][2];
#pragma unroll
        for (int bj = 0; bj < 2; ++bj)
#pragma unroll
            for (int n = 0; n < 2; ++n) cv[bj][n] = csc ? *(const PG8_LAS f32x4*)(sp + 1024 + 4 * (bj * HALF + wc * 32 + 8 * fq + 4 * n)) * cmul : (f32x4){1.f, 1.f, 1.f, 1.f};
#pragma unroll
        for (int ai = 0; ai < 2; ++ai)
#pragma unroll
            for (int m = 0; m < 4; ++m) { bf16_t* rowp = base + (size_t)(row0 + ai * HALF + m * 16) * ldc + col0;
                if constexpr (OUT_F8) { unsigned w[4];
#pragma unroll
                    for (int bj = 0; bj < 2; ++bj) { f32x4 v0 = acc[ai][bj][m][0] * cv[bj][0] + bv[bj][0], v1 = acc[ai][bj][m][1] * cv[bj][1] + bv[bj][1]; unsigned w0 = 0u, w1 = 0u;
#pragma unroll
                        for (int q = 0; q < 4; ++q) { v0[q] = __builtin_amdgcn_fmed3f(v0[q], -448.0f, 448.0f); v1[q] = __builtin_amdgcn_fmed3f(v1[q], -448.0f, 448.0f); }
                        w0 = __builtin_amdgcn_cvt_pk_fp8_f32(v0[0], v0[1], w0, false); w0 = __builtin_amdgcn_cvt_pk_fp8_f32(v0[2], v0[3], w0, true);
                        w1 = __builtin_amdgcn_cvt_pk_fp8_f32(v1[0], v1[1], w1, false); w1 = __builtin_amdgcn_cvt_pk_fp8_f32(v1[2], v1[3], w1, true);
                        w[2 * bj] = w0; w[2 * bj + 1] = w1; }
                    *(u32x4*)((unsigned char*)base + (size_t)(row0 + ai * HALF + m * 16) * ldc + colt + 64 * wc + 16 * fq) = (u32x4){w[0], w[1], w[2], w[3]}; }
                else {
#pragma unroll
                    for (int bj = 0; bj < 2; ++bj) { const f32x4 v0 = acc[ai][bj][m][0] * cv[bj][0] + bv[bj][0], v1 = acc[ai][bj][m][1] * cv[bj][1] + bv[bj][1];
                        u32x4 w; w.x = cvt_pk_bf16(v0[0], v0[1]); w.y = cvt_pk_bf16(v0[2], v0[3]); w.z = cvt_pk_bf16(v1[0], v1[1]); w.w = cvt_pk_bf16(v1[2], v1[3]);
                        *(u32x4*)(rowp + bj * HALF) = w; } } }
    }
};
typedef EpiBf16T<false> EpiBf16;
struct EpiNullI8 {
    static constexpr bool PERM = true, AFTER_DRAIN = false; static constexpr int NST = 0;
    __device__ __forceinline__ void prefetch(const Unit&, int, int) const {}
    __device__ __forceinline__ void operator()(const i32x4 (&acc)[2][2][4][2], const Unit&, int, int, int, int) const {
#pragma unroll
        for (int a = 0; a < 2; ++a)
#pragma unroll
            for (int b = 0; b < 2; ++b)
#pragma unroll
                for (int m = 0; m < 4; ++m)
#pragma unroll
                    for (int n = 0; n < 2; ++n) asm volatile("" :: "v"(acc[a][b][m][n]));
    }
};
struct EpiI8Bf16 {
    static constexpr bool PERM = true, AFTER_DRAIN = false; static constexpr int NST = 16;
    bf16_t* O; int ldc; const float* rsc; const float* csc; PG8_LAS unsigned char* sp;
    __device__ __forceinline__ void prefetch(const Unit& u, int wid, int lane) const {
        if (wid < 4) dma4(rsc + u.pm * BM + wid * 64 + lane, sp + wid * 256);
        else dma4(csc + u.pn * BM + (wid - 4) * 64 + lane, sp + 1024 + (wid - 4) * 256);
    }
    __device__ __forceinline__ void operator()(const i32x4 (&acc)[2][2][4][2], const Unit& u, int wr, int wc, int fr, int fq) const {
        const int row0 = u.pm * BM + wr * 64 + fr, col0 = u.pn * BM + wc * 32 + 8 * fq;
        const PG8_LAS float* spf = (const PG8_LAS float*)sp;
        f32x4 cv[2][2];
#pragma unroll
        for (int bj = 0; bj < 2; ++bj)
#pragma unroll
            for (int n = 0; n < 2; ++n) cv[bj][n] = *(const PG8_LAS f32x4*)(spf + 256 + bj * HALF + wc * 32 + 8 * fq + 4 * n);
#pragma unroll
        for (int ai = 0; ai < 2; ++ai)
#pragma unroll
            for (int m = 0; m < 4; ++m) { const int row = row0 + ai * HALF + m * 16; const float rs = spf[ai * HALF + wr * 64 + m * 16 + fr]; bf16_t* rowp = O + (size_t)row * ldc + col0;
#pragma unroll
                for (int bj = 0; bj < 2; ++bj) { float v[8];
#pragma unroll
                    for (int n = 0; n < 2; ++n)
#pragma unroll
                        for (int q = 0; q < 4; ++q) v[4 * n + q] = (float)acc[ai][bj][m][n][q] * (rs * cv[bj][n][q]);
                    u32x4 w; w.x = cvt_pk_bf16(v[0], v[1]); w.y = cvt_pk_bf16(v[2], v[3]); w.z = cvt_pk_bf16(v[4], v[5]); w.w = cvt_pk_bf16(v[6], v[7]);
                    *(u32x4*)(rowp + bj * HALF) = w; } }
    }
};
__device__ __forceinline__ float swiglu_c(float g, float l) {
    g = fminf(g, 7.0f); l = fminf(fmaxf(l, -7.0f), 7.0f);
    const float s = __builtin_amdgcn_rcpf(1.0f + __builtin_amdgcn_exp2f(g * (-1.702f * 1.4426950408889634f)));
    return g * s * (l + 1.0f);
}
typedef float f32x2e __attribute__((ext_vector_type(2)));
__device__ __forceinline__ f32x2e swiglu_pk(f32x2e g, f32x2e l) {
    g.x = fminf(g.x, 7.0f); g.y = fminf(g.y, 7.0f);
    l.x = __builtin_amdgcn_fmed3f(l.x, -7.0f, 7.0f); l.y = __builtin_amdgcn_fmed3f(l.y, -7.0f, 7.0f);
    const f32x2e z = g * (-1.702f * 1.4426950408889634f);
    f32x2e d; d.x = __builtin_amdgcn_exp2f(z.x); d.y = __builtin_amdgcn_exp2f(z.y);
    d = d + 1.0f;
    f32x2e s; s.x = __builtin_amdgcn_rcpf(d.x); s.y = __builtin_amdgcn_rcpf(d.y);
    return (g * s) * (l + 1.0f);
}
typedef unsigned pg_u32x2 __attribute__((ext_vector_type(2)));
constexpr float ACT_F8_SCALE = 4.0f;
template <bool ACT_F8> struct EpiMoeUpT {
    static constexpr bool PERM = true, AFTER_DRAIN = false; static constexpr int NST = 8;
    bf16_t* O; const float* bias; const float* rsc; const float* csc; PG8_LAS unsigned char* sp;
    __device__ __forceinline__ void prefetch(const Unit& u, int wid, int lane) const {
        const int e = u.pn >> 3, pnl = u.pn & 7;
        if (wid < 4) dma4(rsc + u.pm * BM + wid * 64 + lane, sp + wid * 256);
        else if (wid < 6) { const float* b = bias + (size_t)e * 2048 + pnl * HALF + (wid - 4) * 64 + lane; dma4(b, sp + 1024 + (wid - 4) * 256); dma4(b + 1024, sp + 1536 + (wid - 4) * 256); }
        else { const float* c = csc + (size_t)e * 2048 + pnl * 256 + (wid - 6) * 64 + lane; dma4(c, sp + 2048 + (wid - 6) * 256); dma4(c + HALF, sp + 2560 + (wid - 6) * 256); }
    }
    __device__ __forceinline__ void operator()(const i32x4 (&acc)[2][2][4][2], const Unit& u, int wr, int wc, int fr, int fq) const {
        const int pnl = u.pn & 7;
        const int row0 = u.pm * BM + wr * 64 + fr, cg0 = pnl * HALF + wc * 32 + 8 * fq;
        const PG8_LAS float* spf = (const PG8_LAS float*)sp; const int cl = wc * 32 + 8 * fq;
        f32x4 bgv[2], blv[2], sgv[2], slv[2];
#pragma unroll
        for (int n = 0; n < 2; ++n) { bgv[n] = *(const PG8_LAS f32x4*)(spf + 256 + cl + 4 * n); blv[n] = *(const PG8_LAS f32x4*)(spf + 384 + cl + 4 * n); sgv[n] = *(const PG8_LAS f32x4*)(spf + 512 + cl + 4 * n); slv[n] = *(const PG8_LAS f32x4*)(spf + 640 + cl + 4 * n); }
#pragma unroll
        for (int ai = 0; ai < 2; ++ai)
#pragma unroll
            for (int m = 0; m < 4; ++m) { const int row = row0 + ai * HALF + m * 16; bf16_t* rowp = O + (size_t)row * 1024 + cg0; const float rs = spf[ai * HALF + wr * 64 + m * 16 + fr];
                float a[8];
#pragma unroll
                for (int n = 0; n < 2; ++n) {
#pragma unroll
                    for (int q = 0; q < 4; q += 2) {
                        const f32x2e gi = (f32x2e){(float)acc[ai][0][m][n][q], (float)acc[ai][0][m][n][q + 1]}, li = (f32x2e){(float)acc[ai][1][m][n][q], (float)acc[ai][1][m][n][q + 1]};
                        const f32x2e sg2 = (f32x2e){sgv[n][q], sgv[n][q + 1]} * rs, sl2 = (f32x2e){slv[n][q], slv[n][q + 1]} * rs;
                        const f32x2e r = swiglu_pk(gi * sg2 + (f32x2e){bgv[n][q], bgv[n][q + 1]}, li * sl2 + (f32x2e){blv[n][q], blv[n][q + 1]});
                        a[4 * n + q] = r.x; a[4 * n + q + 1] = r.y; } }
                if constexpr (ACT_F8) { unsigned w0 = 0u, w1 = 0u;
                    w0 = __builtin_amdgcn_cvt_pk_fp8_f32(a[0] * ACT_F8_SCALE, a[1] * ACT_F8_SCALE, w0, false); w0 = __builtin_amdgcn_cvt_pk_fp8_f32(a[2] * ACT_F8_SCALE, a[3] * ACT_F8_SCALE, w0, true);
                    w1 = __builtin_amdgcn_cvt_pk_fp8_f32(a[4] * ACT_F8_SCALE, a[5] * ACT_F8_SCALE, w1, false); w1 = __builtin_amdgcn_cvt_pk_fp8_f32(a[6] * ACT_F8_SCALE, a[7] * ACT_F8_SCALE, w1, true);
                    *(pg_u32x2*)((unsigned char*)O + (size_t)row * 1024 + cg0) = (pg_u32x2){w0, w1}; }
                else { u32x4 w; w.x = cvt_pk_bf16(a[0], a[1]); w.y = cvt_pk_bf16(a[2], a[3]); w.z = cvt_pk_bf16(a[4], a[5]); w.w = cvt_pk_bf16(a[6], a[7]);
                    *(u32x4*)rowp = w; } }
    }
};
typedef EpiMoeUpT<false> EpiMoeUp;
struct EpiMoeUpNoLoad {
    static constexpr bool PERM = true, AFTER_DRAIN = false; static constexpr int NST = 8;
    __device__ __forceinline__ void prefetch(const Unit&, int, int) const {}
    bf16_t* O; float k0, k1;
    __device__ __forceinline__ void operator()(const i32x4 (&acc)[2][2][4][2], const Unit& u, int wr, int wc, int fr, int fq) const {
        const int pnl = u.pn & 7;
        const int row0 = u.pm * BM + wr * 64 + fr, cg0 = pnl * HALF + wc * 32 + 8 * fq;
#pragma unroll
        for (int ai = 0; ai < 2; ++ai)
#pragma unroll
            for (int m = 0; m < 4; ++m) { const int row = row0 + ai * HALF + m * 16; bf16_t* rowp = O + (size_t)row * 1024 + cg0;
                float a[8];
#pragma unroll
                for (int n = 0; n < 2; ++n) {
#pragma unroll
                    for (int q = 0; q < 4; ++q) { const float g = (float)acc[ai][0][m][n][q] * k0 + k1, l = (float)acc[ai][1][m][n][q] * k0 + k1;
                        a[4 * n + q] = swiglu_c(g, l); } }
                u32x4 w; w.x = cvt_pk_bf16(a[0], a[1]); w.y = cvt_pk_bf16(a[2], a[3]); w.z = cvt_pk_bf16(a[4], a[5]); w.w = cvt_pk_bf16(a[6], a[7]);
                *(u32x4*)rowp = w; }
    }
};
struct EpiMoeUpNoStore {
    static constexpr bool PERM = true, AFTER_DRAIN = false; static constexpr int NST = 8;
    __device__ __forceinline__ void prefetch(const Unit&, int, int) const {}
    bf16_t* O; float k0, k1;
    __device__ __forceinline__ void operator()(const i32x4 (&acc)[2][2][4][2], const Unit& u, int wr, int wc, int fr, int fq) const {
        const int pnl = u.pn & 7;
        const int row0 = u.pm * BM + wr * 64 + fr, cg0 = pnl * HALF + wc * 32 + 8 * fq;
#pragma unroll
        for (int ai = 0; ai < 2; ++ai)
#pragma unroll
            for (int m = 0; m < 4; ++m) { const int row = row0 + ai * HALF + m * 16; bf16_t* rowp = O + (size_t)row * 1024 + cg0;
                float a[8];
#pragma unroll
                for (int n = 0; n < 2; ++n) {
#pragma unroll
                    for (int q = 0; q < 4; ++q) { const float g = (float)acc[ai][0][m][n][q] * k0 + k1, l = (float)acc[ai][1][m][n][q] * k0 + k1;
                        a[4 * n + q] = swiglu_c(g, l); } }
                u32x4 w; w.x = cvt_pk_bf16(a[0], a[1]); w.y = cvt_pk_bf16(a[2], a[3]); w.z = cvt_pk_bf16(a[4], a[5]); w.w = cvt_pk_bf16(a[6], a[7]);
                if (ai == 0 && m == 0) *(u32x4*)rowp = w; else asm volatile("" :: "v"(w)); }
    }
};
template <int SH> struct MoeOrder {
    const PG8_LAS int* ts; int G, c, total; int tsv;
    __device__ __forceinline__ bool next(int i, Unit& u) const {
        const int L = i * G + c; if (L >= total) return false;
        const int pm = L >> SH, pnl = L & ((1 << SH) - 1);
        const unsigned long long mk = __builtin_amdgcn_ballot_w64(pm >= tsv);
        const int e = __builtin_popcount((unsigned)mk & 0xfffffffeu);
        u.pm = pm; u.pn = (e << SH) + pnl; return true;
    }
    __device__ __forceinline__ void a_ready(const Unit&) const {}
    __device__ __forceinline__ void done(const Unit&) const {}
};
typedef int i32x4 __attribute__((ext_vector_type(4)));
template <bool I8> struct AccSel { typedef f32x4 T; };
template <> struct AccSel<true> { typedef i32x4 T; };
template <bool I8> __device__ __forceinline__ typename AccSel<I8>::T mma16(bf16x8 b, bf16x8 a, typename AccSel<I8>::T c) {
    if constexpr (I8) return __builtin_amdgcn_mfma_i32_16x16x64_i8(__builtin_bit_cast(i32x4, b), __builtin_bit_cast(i32x4, a), c, 0, 0, 0);
    else return __builtin_amdgcn_mfma_f32_16x16x32_bf16(b, a, c, 0, 0, 0);
}
typedef int i32x8 __attribute__((ext_vector_type(8)));
__device__ __forceinline__ f32x4 mma_f8(bf16x8 b0, bf16x8 b1, bf16x8 a0, bf16x8 a1, f32x4 c) {
    const i32x4 bl = __builtin_bit_cast(i32x4, b0), bh = __builtin_bit_cast(i32x4, b1), al = __builtin_bit_cast(i32x4, a0), ah = __builtin_bit_cast(i32x4, a1);
    const i32x8 bb = (i32x8){bl[0], bl[1], bl[2], bl[3], bh[0], bh[1], bh[2], bh[3]}, aa = (i32x8){al[0], al[1], al[2], al[3], ah[0], ah[1], ah[2], ah[3]};
    return __builtin_amdgcn_mfma_scale_f32_16x16x128_f8f6f4(bb, aa, c, 0, 0, 0, 0, 0, 0);
}
template <class Epi, class Sched, bool ALIGN_EPI = false, bool SP2 = false, bool I8 = false, bool GATHER = false, bool F8 = false>
__device__ __forceinline__ void gemm_phase(PG8_LAS unsigned char* lds, const Gemm g, const Sched& S, const Epi& E, const int* rowmap = nullptr) {
    int tid_ = threadIdx.x; asm volatile("" : "+v"(tid_));
    const int tid = tid_, wid = __builtin_amdgcn_readfirstlane(tid >> 6), lane = tid & 63, wr = wid >> 2, wc = wid & 3, fr = lane & 15, fq = lane >> 4;
    const int K = g.K, nt = K / BK;
    unsigned voffA, voffB;
    { int R, C; stage_rc(tid * 16, R, C); const int Rb = Epi::PERM ? ((R & ~31) + perm32(R & 31)) : R;
        voffA = (unsigned)(R * K + C) * 2u; voffB = (unsigned)(Rb * K + C) * 2u; }
    const size_t pstep = (size_t)128 * K;
    unsigned offA[2][2];
    constexpr int RM_OFF = STAGE_BYTES + 1024 + 3072;
    const size_t kstep = (size_t)(BK * 2);
    const size_t hstep = (size_t)HALF * K * 2;
    const size_t tstep = 2 * hstep;
    const unsigned ldsw = (unsigned)wid * 1024u;
    const int aoff = lds_byte(wr * 64 + fr, fq * 8), boff = lds_byte(wc * 32 + fr, fq * 8);
#define PG8_SA(b, h) (((b) * 2 + (h)) * HTB)
#define PG8_SB(b, h) ((4 + (b) * 2 + (h)) * HTB)
#define PG8_STAGE(bufoff, gbase, voff) do { _Pragma("unroll") for (int _i = 0; _i < 2; ++_i) \
        __builtin_amdgcn_global_load_lds((const unsigned*)((const char*)(gbase) + (_i ? pstep : (size_t)0) + (voff)), (PG8_LAS unsigned*)(lds + (bufoff) + ldsw + _i * 8192), 16, 0, 0); } while (0)
#define PG8_STAGE_A(bufoff, gbase, h, nextu) do { if constexpr (GATHER) { _Pragma("unroll") for (int _i = 0; _i < 2; ++_i) \
        __builtin_amdgcn_global_load_lds((const unsigned*)((const char*)(gbase) + offA[h][_i]), (PG8_LAS unsigned*)(lds + (bufoff) + ldsw + _i * 8192), 16, 0, 0); } \
    else { PG8_STAGE(bufoff, (gbase) + (h) * hstep, voffA); } } while (0)
#define PG8_GOFF(SRCEXPR) do { _Pragma("unroll") for (int _h = 0; _h < 2; ++_h) _Pragma("unroll") for (int _i = 0; _i < 2; ++_i) { int R_, C_; stage_rc(tid * 16 + _i * 8192, R_, C_); \
        const int ri_ = _h * HALF + R_; offA[_h][_i] = (unsigned)(SRCEXPR) * (unsigned)(K * 2) + (unsigned)(C_ * 2); } } while (0)
#define PG8_LDA(dst, b, h) do { _Pragma("unroll") for (int m = 0; m < 4; ++m) _Pragma("unroll") for (int k = 0; k < 2; ++k) dst[m][k] = *(const PG8_LAS bf16x8*)(lds + PG8_SA(b, h) + aoff + m * 2048 + k * 1024); } while (0)
#define PG8_LDB(dst, b, h) do { _Pragma("unroll") for (int n = 0; n < 2; ++n) _Pragma("unroll") for (int k = 0; k < 2; ++k) dst[n][k] = *(const PG8_LAS bf16x8*)(lds + PG8_SB(b, h) + boff + n * 2048 + k * 1024); } while (0)
#define PG8_MMA(ai, bj, At, Bt) do { __builtin_amdgcn_s_setprio(1); _Pragma("unroll") for (int m = 0; m < 4; ++m) _Pragma("unroll") for (int n = 0; n < 2; ++n) { \
        if constexpr (F8) { const f32x4 c_ = n ? __builtin_shufflevector(acc8[ai][bj][m], acc8[ai][bj][m], 4, 5, 6, 7) : __builtin_shufflevector(acc8[ai][bj][m], acc8[ai][bj][m], 0, 1, 2, 3); \
            const f32x4 d_ = mma_f8(Bt[n][0], Bt[n][1], At[m][0], At[m][1], c_); \
            if (n) { acc8[ai][bj][m][4] = d_[0]; acc8[ai][bj][m][5] = d_[1]; acc8[ai][bj][m][6] = d_[2]; acc8[ai][bj][m][7] = d_[3]; } else { acc8[ai][bj][m][0] = d_[0]; acc8[ai][bj][m][1] = d_[1]; acc8[ai][bj][m][2] = d_[2]; acc8[ai][bj][m][3] = d_[3]; } } \
        else { _Pragma("unroll") for (int k = 0; k < 2; ++k) acc[ai][bj][m][n] = mma16<I8>(Bt[n][k], At[m][k], acc[ai][bj][m][n]); } } __builtin_amdgcn_s_setprio(0); } while (0)
#define PG8_WAIT_V(n) asm volatile("s_waitcnt vmcnt(" #n ")" ::: "memory")
#define PG8_WAIT_L(n) asm volatile("s_waitcnt lgkmcnt(" #n ")" ::: "memory")
#define PG8_WAIT_VR(fl) do { if constexpr (F8) { PG8_WAIT_V(8); } else asm volatile("s_waitcnt vmcnt(%1)\n\tv_cmp_ne_u32_e32 vcc, 0, %0\n\ts_cbranch_vccnz 1f\n\ts_waitcnt vmcnt(8)\n1:" :: "v"(fl), "n"(8 + Epi::NST) : "vcc", "memory"); } while (0)
#define PG8_BAR __builtin_amdgcn_s_barrier()
#define PG8_SCHED __builtin_amdgcn_sched_barrier(0)
    Unit cur, nxt; int ui = 0;
    if (!S.next(0, cur)) return;
    typedef typename AccSel<I8>::T acc4; acc4 acc[2][2][4][2];
    typedef float f32x8 __attribute__((ext_vector_type(8))); f32x8 acc8[2][2][4];
#pragma unroll
    for (int a = 0; a < 2; ++a)
#pragma unroll
        for (int b = 0; b < 2; ++b)
#pragma unroll
            for (int m = 0; m < 4; ++m)
#pragma unroll
                for (int n = 0; n < 2; ++n) { acc[a][b][m][n] = (acc4){0, 0, 0, 0}; if constexpr (F8) acc8[a][b][m] = (f32x8){0.f, 0.f, 0.f, 0.f, 0.f, 0.f, 0.f, 0.f}; }
    bf16x8 At[4][2], B0[2][2], B1[2][2];
    const char* cA = GATHER ? (const char*)g.A : (const char*)g.A + (size_t)cur.pm * tstep; const char* cB = (const char*)g.Bt + (size_t)cur.pn * tstep;
    if constexpr (GATHER) { PG8_GOFF(rowmap[cur.pm * BM + ri_]); }
    S.a_ready(cur);
    if constexpr (SP2) {
        PG8_STAGE(PG8_SB(0, 0), cB, voffB); PG8_STAGE(PG8_SB(0, 1), cB + hstep, voffB); PG8_STAGE_A(PG8_SA(0, 0), cA, 0, false); PG8_STAGE_A(PG8_SA(0, 1), cA, 1, false);
        if (wr == 1) PG8_BAR;
        PG8_WAIT_V(2); PG8_BAR;
        PG8_STAGE(PG8_SB(1, 0), cB + kstep, voffB); PG8_STAGE_A(PG8_SA(1, 0), cA + kstep, 0, false); PG8_STAGE(PG8_SB(1, 1), cB + hstep + kstep, voffB);
        PG8_STAGE_A(PG8_SA(1, 1), cA + kstep, 1, false);
        PG8_WAIT_V(8); PG8_BAR;
    } else {
        PG8_STAGE(PG8_SB(0, 0), cB, voffB); PG8_STAGE_A(PG8_SA(0, 0), cA, 0, false); PG8_STAGE(PG8_SB(0, 1), cB + hstep, voffB); PG8_STAGE_A(PG8_SA(0, 1), cA, 1, false);
        if (wr == 1) PG8_BAR;
        PG8_WAIT_V(4); PG8_BAR;
        PG8_STAGE(PG8_SB(1, 0), cB + kstep, voffB); PG8_STAGE_A(PG8_SA(1, 0), cA + kstep, 0, false); PG8_STAGE(PG8_SB(1, 1), cB + hstep + kstep, voffB);
        PG8_WAIT_V(6); PG8_BAR;
    }
    for (;;) {
        const bool has_next = S.next(ui + 1, nxt);
        if constexpr (GATHER) { if (has_next && wid < 4) __builtin_amdgcn_global_load_lds((const unsigned*)(rowmap + nxt.pm * BM + wid * 64 + lane), (PG8_LAS unsigned*)(lds + RM_OFF + wid * 256), 4, 0, 0); }
        const char* nA = (has_next && !GATHER) ? (const char*)g.A + (size_t)nxt.pm * tstep : cA; const char* nB = has_next ? (const char*)g.Bt + (size_t)nxt.pn * tstep : cB;
        for (int t = 0; t < nt; t += 2) {
            const bool last = (t == nt - 2);
            asm volatile("" : "+v"(voffA), "+v"(voffB));
            const char* a1 = cA + (size_t)(t + 1) * kstep;
            const char* a2 = last ? nA : cA + (size_t)(t + 2) * kstep; const char* b2 = last ? nB : cB + (size_t)(t + 2) * kstep;
            const char* a3 = a2 + kstep; const char* b3 = b2 + kstep;
            if (last && has_next) S.a_ready(nxt);
            if (last) { int ln_ = lane; asm volatile("" : "+v"(ln_)); E.prefetch(cur, wid, ln_); }
            if constexpr (SP2) {
            const int fl = (t == 0 && ui > 0) ? 1 : 0;
            PG8_LDB(B0, 0, 0); PG8_LDB(B1, 0, 1); PG8_SCHED; PG8_LDA(At, 0, 0);
            if constexpr (GATHER) { if (last && has_next) { const PG8_LAS int* rm = (const PG8_LAS int*)(lds + RM_OFF); PG8_GOFF(rm[ri_]); } }
            PG8_WAIT_VR(fl); PG8_WAIT_L(0); PG8_BAR; PG8_MMA(0, 0, At, B0); PG8_MMA(0, 1, At, B1); PG8_BAR; PG8_SCHED;
            PG8_LDA(At, 0, 1); PG8_STAGE(PG8_SB(0, 0), b2, voffB); PG8_STAGE(PG8_SB(0, 1), b2 + hstep, voffB); PG8_STAGE_A(PG8_SA(0, 0), a2, 0, last);
            PG8_WAIT_VR(fl); PG8_WAIT_L(0); PG8_BAR; PG8_MMA(1, 0, At, B0); PG8_MMA(1, 1, At, B1); PG8_BAR; PG8_SCHED;
            PG8_LDB(B0, 1, 0); PG8_LDB(B1, 1, 1); PG8_SCHED; PG8_LDA(At, 1, 0); PG8_STAGE_A(PG8_SA(0, 1), a2, 1, last);
            PG8_WAIT_VR(fl); PG8_WAIT_L(0); PG8_BAR; PG8_MMA(0, 0, At, B0); PG8_MMA(0, 1, At, B1); PG8_BAR; PG8_SCHED;
            PG8_LDA(At, 1, 1); PG8_STAGE(PG8_SB(1, 0), b3, voffB); PG8_STAGE(PG8_SB(1, 1), b3 + hstep, voffB); PG8_STAGE_A(PG8_SA(1, 0), a3, 0, last);
            PG8_WAIT_V(8); PG8_WAIT_L(0); PG8_BAR; PG8_MMA(1, 0, At, B0); PG8_MMA(1, 1, At, B1); PG8_BAR; PG8_SCHED;
            PG8_STAGE_A(PG8_SA(1, 1), a3, 1, last);
            } else {
            PG8_LDB(B0, 0, 0); PG8_SCHED; PG8_LDA(At, 0, 0); PG8_STAGE_A(PG8_SA(1, 1), a1, 1, false);
            if constexpr (GATHER) { if (last && has_next) { const PG8_LAS int* rm = (const PG8_LAS int*)(lds + RM_OFF); PG8_GOFF(rm[ri_]); } }
            PG8_WAIT_L(8); PG8_BAR; PG8_WAIT_L(0); PG8_MMA(0, 0, At, B0); PG8_BAR; PG8_SCHED;
            PG8_LDB(B1, 0, 1); PG8_STAGE(PG8_SB(0, 0), b2, voffB);
            PG8_BAR; PG8_WAIT_L(0); PG8_MMA(0, 1, At, B1); PG8_BAR;
            PG8_LDA(At, 0, 1); PG8_STAGE_A(PG8_SA(0, 0), a2, 0, last);
            PG8_BAR; PG8_WAIT_L(0); PG8_MMA(1, 0, At, B0); PG8_BAR; PG8_SCHED;
            PG8_STAGE(PG8_SB(0, 1), b2 + hstep, voffB);
            PG8_WAIT_V(6); PG8_BAR; PG8_MMA(1, 1, At, B1); PG8_BAR;
            PG8_LDB(B0, 1, 0); PG8_SCHED; PG8_LDA(At, 1, 0); PG8_STAGE_A(PG8_SA(0, 1), a2, 1, last);
            PG8_WAIT_L(8); PG8_BAR; PG8_WAIT_L(0); PG8_MMA(0, 0, At, B0); PG8_BAR; PG8_SCHED;
            PG8_LDB(B1, 1, 1); PG8_STAGE(PG8_SB(1, 0), b3, voffB);
            PG8_BAR; PG8_WAIT_L(0); PG8_MMA(0, 1, At, B1); PG8_BAR;
            PG8_LDA(At, 1, 1); PG8_STAGE_A(PG8_SA(1, 0), a3, 0, last);
            PG8_BAR; PG8_WAIT_L(0); PG8_MMA(1, 0, At, B0); PG8_BAR; PG8_SCHED;
            PG8_STAGE(PG8_SB(1, 1), b3 + hstep, voffB);
            PG8_WAIT_V(6); PG8_BAR; PG8_MMA(1, 1, At, B1); PG8_BAR;
            }
        }
        if constexpr (ALIGN_EPI) { if (wr == 0) PG8_BAR; }
        if constexpr (F8 && !I8) {
#pragma unroll
            for (int a_ = 0; a_ < 2; ++a_)
#pragma unroll
                for (int b_ = 0; b_ < 2; ++b_)
#pragma unroll
                    for (int m = 0; m < 4; ++m) { acc[a_][b_][m][0] = __builtin_shufflevector(acc8[a_][b_][m], acc8[a_][b_][m], 0, 1, 2, 3); acc[a_][b_][m][1] = __builtin_shufflevector(acc8[a_][b_][m], acc8[a_][b_][m], 4, 5, 6, 7); } }
        if constexpr (!Epi::AFTER_DRAIN) { int t2_ = threadIdx.x; asm volatile("" : "+v"(t2_)); E(acc, cur, wr, wc, t2_ & 15, (t2_ & 63) >> 4); S.done(cur); }
        if (!has_next) break;
#pragma unroll
        for (int a = 0; a < 2; ++a)
#pragma unroll
            for (int b = 0; b < 2; ++b)
#pragma unroll
                for (int m = 0; m < 4; ++m)
#pragma unroll
                    for (int n = 0; n < 2; ++n) { acc[a][b][m][n] = (acc4){0, 0, 0, 0}; if constexpr (F8) acc8[a][b][m] = (f32x8){0.f, 0.f, 0.f, 0.f, 0.f, 0.f, 0.f, 0.f}; }
        cur = nxt; cA = nA; cB = nB; ++ui;
        if constexpr (ALIGN_EPI) { if (wr == 1) PG8_BAR; }
    }
    PG8_WAIT_V(0);
    if constexpr (!ALIGN_EPI) { if (wr == 0) PG8_BAR; }
    PG8_BAR;
    if constexpr (Epi::AFTER_DRAIN) { E.fused(acc, cur, wr, wc, fr, fq, lds, wid, lane); S.done(cur); }
#undef PG8_SA
#undef PG8_SB
#undef PG8_STAGE
#undef PG8_STAGE_A
#undef PG8_GOFF
#undef PG8_LDA
#undef PG8_LDB
#undef PG8_MMA
#undef PG8_WAIT_V
#undef PG8_WAIT_L
#undef PG8_WAIT_VR
#undef PG8_BAR
#undef PG8_SCHED
}
}
#include <hip/hip_bf16.h>
#include <cmath>
namespace attn_body {
using bf16=__hip_bfloat16;
using bf16x8=__attribute__((ext_vector_type(8)))short;
using s16x4=__attribute__((ext_vector_type(4)))short;
using f32x16=__attribute__((ext_vector_type(16)))float;
using u32x4=__attribute__((ext_vector_type(4)))unsigned;
constexpr float OSCALE=32.0f;
constexpr int BATCH=8,NHEAD=8,NKVH=2,SEQ=8192,D=64,PQ=2816,PO=1024;
constexpr int NW=8,QBLK=32,QB=QBLK*NW,KVBLK=64,NQB=SEQ/QB;
constexpr int ATTN_UNIT_ROWS=QB;
__device__ __forceinline__ int crow(int r,int hi){return (r&3)+8*(r>>2)+4*hi;}
#define SBAR() __builtin_amdgcn_sched_barrier(0)
__device__ __forceinline__ void cmask(f32x16&p0,f32x16&p1,int jb,int qrel,int hi){
  const float NEG=-INFINITY; int kb=64*jb+4*hi;
  #pragma unroll
  for(int r=0;r<16;++r){int kv=kb+(r&3)+8*(r>>2); if(kv>qrel)p0[r]=NEG; if(kv+32>qrel)p1[r]=NEG;}
}

constexpr int NSLOT=3, SLOTB=8192;
constexpr int LDS_K=0, LDS_V=NSLOT*SLOTB, LDS_WS=2*NSLOT*SLOTB, LDS_OST=LDS_WS+NW*64*4, LDS_BYTES=LDS_OST+NW*4096;
constexpr float C2=0.125f*1.4426950408889634f;
__device__ __forceinline__ void glds16(const void*gsrc,unsigned lds_dst){unsigned keep;
  asm volatile("s_mov_b32 %0, m0\n\ts_mov_b32 m0, %2\n\ts_nop 0\n\tglobal_load_lds_dwordx4 %1, off\n\ts_mov_b32 m0, %0":"=&s"(keep):"v"(gsrc),"s"(lds_dst):"memory");}
__device__ __forceinline__ float max3f(float a,float b,float c){float r;asm("v_max3_f32 %0, %1, %2, %3":"=v"(r):"v"(a),"v"(b),"v"(c));return r;}
__device__ __forceinline__ float max2f(float a,float b){float r;asm("v_max_f32_e32 %0, %1, %2":"=v"(r):"v"(a),"v"(b));return r;}
__device__ __forceinline__ float fadd_s(float a,float b){float r;asm("v_add_f32_e32 %0, %1, %2":"=v"(r):"v"(a),"v"(b));return r;}
__device__ __forceinline__ float fsub_s(float a,float b){float r;asm("v_sub_f32_e32 %0, %1, %2":"=v"(r):"v"(a),"v"(b));return r;}
typedef float f32x2_t __attribute__((ext_vector_type(2))); typedef __bf16 bf16x2_t __attribute__((ext_vector_type(2)));
__device__ __forceinline__ unsigned cvtpk_s(float lo,float hi){f32x2_t v={lo,hi};bf16x2_t b=__builtin_convertvector(v,bf16x2_t);return __builtin_bit_cast(unsigned,b);}
#define WAIT_BAR(N) asm volatile("s_waitcnt vmcnt(" #N ") lgkmcnt(0)\n\ts_barrier":::"memory")

__device__ __forceinline__ void qkt(f32x16&p0,f32x16&p1,const char*Kslot,const bf16x8*qr,const f32x16&negm,int r32,int hi){
  const char*kb=Kslot+hi*1024+r32*16;
  #pragma unroll
  for(int d0=0;d0<4;++d0){
    const bf16x8 b0=*reinterpret_cast<const bf16x8*>(kb+d0*2048);
    const bf16x8 b1=*reinterpret_cast<const bf16x8*>(kb+d0*2048+512);
    if(d0==0){p0=__builtin_amdgcn_mfma_f32_32x32x16_bf16(b0,qr[0],negm,0,0,0);p1=__builtin_amdgcn_mfma_f32_32x32x16_bf16(b1,qr[0],negm,0,0,0);}
    else{p0=__builtin_amdgcn_mfma_f32_32x32x16_bf16(b0,qr[d0],p0,0,0,0);p1=__builtin_amdgcn_mfma_f32_32x32x16_bf16(b1,qr[d0],p1,0,0,0);}}
}
typedef __attribute__((address_space(3))) const char* lds_cptr;
typedef short v4i16_t __attribute__((ext_vector_type(4)));
__device__ __forceinline__ void kload8(bf16x8*kf,lds_cptr kp){
  kf[0]=*(const __attribute__((address_space(3))) bf16x8*)(kp);      kf[1]=*(const __attribute__((address_space(3))) bf16x8*)(kp+512);
  kf[2]=*(const __attribute__((address_space(3))) bf16x8*)(kp+2048); kf[3]=*(const __attribute__((address_space(3))) bf16x8*)(kp+2560);
  kf[4]=*(const __attribute__((address_space(3))) bf16x8*)(kp+4096); kf[5]=*(const __attribute__((address_space(3))) bf16x8*)(kp+4608);
  kf[6]=*(const __attribute__((address_space(3))) bf16x8*)(kp+6144); kf[7]=*(const __attribute__((address_space(3))) bf16x8*)(kp+6656);
}
__device__ __forceinline__ void kload2(bf16x8*kf,lds_cptr kp,int j){ kf[2*j]=*(const __attribute__((address_space(3))) bf16x8*)(kp+j*2048); kf[2*j+1]=*(const __attribute__((address_space(3))) bf16x8*)(kp+j*2048+512); }
__device__ __forceinline__ s16x4 vtr(lds_cptr p){ return __builtin_bit_cast(s16x4,__builtin_amdgcn_ds_read_tr16_b64_v4i16((__attribute__((address_space(3))) v4i16_t*)p)); }
__device__ __forceinline__ float rowmax(const f32x16&p0,const f32x16&p1){
  float a=max3f(p0[0],p0[1],p1[0]),b=max3f(p0[2],p0[3],p1[1]);a=max3f(a,p1[2],p1[3]);
  #pragma unroll
  for(int r=4;r<16;r+=4){a=max3f(a,p0[r],p0[r+1]);b=max3f(b,p0[r+2],p0[r+3]);a=max3f(a,p1[r],p1[r+1]);b=max3f(b,p1[r+2],p1[r+3]);}
  const float m=max2f(a,b);
  auto rr=__builtin_amdgcn_permlane32_swap(__float_as_uint(m),__float_as_uint(m),false,false);
  return max2f(__uint_as_float(rr[0]),__uint_as_float(rr[1]));
}
__device__ __forceinline__ void pv(f32x16*o,int vb,bf16x8 pa0,bf16x8 pa1,bf16x8 pa2,bf16x8 pa3){
  #pragma unroll
  for(int d0=0;d0<2;++d0){s16x4 lo[4],hi[4];
    #pragma unroll
    for(int ks=0;ks<4;++ks){
      asm volatile("ds_read_b64_tr_b16 %0,%1 offset:%c2":"=&v"(lo[ks]):"v"(vb),"i"(d0*4096+ks*1024):"memory");
      asm volatile("ds_read_b64_tr_b16 %0,%1 offset:%c2":"=&v"(hi[ks]):"v"(vb),"i"(d0*4096+ks*1024+512):"memory");}
    asm volatile("s_waitcnt lgkmcnt(0)":::"memory");SBAR();
    #define PK(k) (bf16x8){lo[k][0],lo[k][1],lo[k][2],lo[k][3],hi[k][0],hi[k][1],hi[k][2],hi[k][3]}
    o[d0]=__builtin_amdgcn_mfma_f32_32x32x16_bf16(pa0,PK(0),o[d0],0,0,0);
    o[d0]=__builtin_amdgcn_mfma_f32_32x32x16_bf16(pa1,PK(1),o[d0],0,0,0);
    o[d0]=__builtin_amdgcn_mfma_f32_32x32x16_bf16(pa2,PK(2),o[d0],0,0,0);
    o[d0]=__builtin_amdgcn_mfma_f32_32x32x16_bf16(pa3,PK(3),o[d0],0,0,0);
    #undef PK
  }
}

#ifndef ATTN_STORE16
#define ATTN_STORE16(p,v) (*(u32x4*)(p)=(v))
#endif
template<int THRL> __device__ __forceinline__ void attn_unit(int b,int h,int qb,const bf16*Q,const bf16*__restrict__ K,const bf16*__restrict__ V,bf16*O,char*shm,const float*qg,const float nref){
  int tid_=threadIdx.x; asm volatile("":"+v"(tid_)); const int tid=tid_,lane=tid&63,r32=lane&31,hi=lane>>5; const int wid=__builtin_amdgcn_readfirstlane(tid>>6);
  const long rowbase=(long)b*SEQ; const int q0=qb*QB;
  const bf16*Qw=Q+(rowbase+q0+wid*QBLK)*PQ+h*D;
  const bf16*Kh=K+rowbase*PQ+(h>>2)*D,*Vh=V+rowbase*PQ+(h>>2)*D;
  const unsigned lds0=(unsigned)(uintptr_t)shm;
  float*wsf=(float*)(shm+LDS_WS)+wid*64;
  const bf16*ksrc=Kh+(long)lane*PQ+wid*8;
  const bf16*vsrc=Vh+(long)(16*(wid&3)+(lane>>2))*PQ+(wid>>2)*32+(lane&3)*8;
  const unsigned kdst=lds0+LDS_K+wid*1024, vdst=lds0+LDS_V+wid*1024;
  #define DMA_K(t,slot) glds16(ksrc+(long)(t)*KVBLK*PQ,(unsigned)__builtin_amdgcn_readfirstlane(kdst+(slot)))
  #define DMA_V(t,slot) glds16(vsrc+(long)(t)*KVBLK*PQ,(unsigned)__builtin_amdgcn_readfirstlane(vdst+(slot)))
  const int vb0=(int)(lds0+LDS_V)+((lane>>4)&1)*32+(lane&3)*8+(4*hi+((lane&15)>>2))*64;
  const char*Kbase=shm+LDS_K; bf16x8 kf[8];
  const lds_cptr shm3=(lds_cptr)shm; const lds_cptr kp0=shm3+LDS_K+hi*1024+r32*16; const lds_cptr vp0=shm3+LDS_V+((lane>>4)&1)*32+(lane&3)*8+(4*hi+((lane&15)>>2))*64;
  constexpr int NT=SEQ/KVBLK;
  DMA_K(0,0);DMA_V(0,0);DMA_K(1,SLOTB);
  bf16x8 qr[4];
  #pragma unroll
  for(int d0=0;d0<4;++d0)qr[d0]=*reinterpret_cast<const bf16x8*>(&Qw[(long)r32*PQ+d0*16+hi*8]);
  {
    float y[4][8]; float ss=0.f;
    #pragma unroll
    for(int d0=0;d0<4;++d0){
      #pragma unroll
      for(int j=0;j<8;++j){ y[d0][j]=__uint_as_float(((unsigned)(unsigned short)qr[d0][j])<<16); ss+=y[d0][j]*y[d0][j]; } }
    { auto rr=__builtin_amdgcn_permlane32_swap(__float_as_uint(ss),__float_as_uint(ss),false,false); ss=__uint_as_float(rr[0])+__uint_as_float(rr[1]); }
    const float rs=__builtin_amdgcn_rsqf(ss*(1.f/64.f)+1e-6f);
    const int spos=q0+wid*QBLK+r32; const float rid=(float)(spos>>6),cid=(float)(spos&63);
    #pragma unroll
    for(int j=0;j<8;++j){ const float fr=__builtin_amdgcn_exp2f(-(float)(8*hi+j)*(13.287712379549449f/16.f));
      const float cr=__cosf(rid*fr),sr=__sinf(rid*fr),cc=__cosf(cid*fr),sc=__sinf(cid*fr);
      const float a1=y[0][j]*rs*qg[8*hi+j],a2=y[1][j]*rs*qg[16+8*hi+j],b1=y[2][j]*rs*qg[32+8*hi+j],b2=y[3][j]*rs*qg[48+8*hi+j];
      y[0][j]=(a1*cr-a2*sr)*C2; y[1][j]=(a2*cr+a1*sr)*C2; y[2][j]=(b1*cc-b2*sc)*C2; y[3][j]=(b2*cc+b1*sc)*C2; }
    #pragma unroll
    for(int d0=0;d0<4;++d0){ u32x4 w; w.x=cvtpk_s(y[d0][0],y[d0][1]); w.y=cvtpk_s(y[d0][2],y[d0][3]); w.z=cvtpk_s(y[d0][4],y[d0][5]); w.w=cvtpk_s(y[d0][6],y[d0][7]); qr[d0]=__builtin_bit_cast(bf16x8,w); }
  }
  float l_reg=0.f;f32x16 o[2];o[0]=f32x16{};o[1]=f32x16{};f32x16 negm; _Pragma("unroll") for(int r=0;r<16;++r)negm[r]=nref; asm volatile("":"+v"(negm));
  #define CMASK(P0,P1,t) do{}while(0)
  #define START(P0,P1) do{ _Pragma("unroll") for(int r=0;r<16;++r)P0[r]=__builtin_amdgcn_exp2f(P0[r]); }while(0)
  #define RESC() do{}while(0)
  f32x16 pA0,pA1,pB0,pB1;
  int sl_prev=0,sl_cur=0,sl_next=SLOTB;
  #define ROT() do{sl_prev=sl_cur;sl_cur=sl_next;sl_next=(sl_next==(NSLOT-1)*SLOTB)?0:sl_next+SLOTB;}while(0)
  DMA_K(2,2*SLOTB);
  WAIT_BAR(3);
  qkt(pA0,pA1,Kbase,qr,negm,r32,hi);asm volatile("s_nop 15\n\ts_nop 7":"+v"(pA0),"+v"(pA1));CMASK(pA0,pA1,0);
  START(pA0,pA1);
  _Pragma("unroll") for(int r=0;r<16;++r)pA1[r]=__builtin_amdgcn_exp2f(pA1[r]);
  WAIT_BAR(0);
  DMA_K(3,0);DMA_V(1,SLOTB);
  ROT();
  kload8(kf,kp0+sl_cur);
  WAIT_BAR(2);
  s16x4 vlo[8],vhi[8]; u32x4 pw0,pw1,pw2,pw3;
  #define PKW(P,B) cvtpk_s(P[B],P[B+1])
  #define PAF(k) __builtin_bit_cast(bf16x8,pw##k)
  #define VFR(i) (bf16x8){vlo[i][0],vlo[i][1],vlo[i][2],vlo[i][3],vhi[i][0],vhi[i][1],vhi[i][2],vhi[i][3]}
  #define PIN(x) asm volatile("":"+v"(x))
  #define MX3(a,b,c) __builtin_fmaxf(__builtin_fmaxf((a),(b)),(c))
  #define GAPA(MF,A0,A1,A2,A3,W0,W1,PW) do{ MF; sacc+=A0; sacc+=A1; sacc+=A2; sacc+=A3; PIN(sacc); W0; W1; PIN(PW); SBAR(); }while(0)
  #define EX(v) __builtin_amdgcn_exp2f(v)
  #define GAPB(MF,X,B) do{ MF; X[B]=EX(X[B]); X[B+1]=EX(X[B+1]); X[B+2]=EX(X[B+2]); X[B+3]=EX(X[B+3]); PIN(X); SBAR(); }while(0)
  #define VRD(i) do{ vlo[i]=vtr(vp_+(((i)>>2)*4096+((i)&3)*1024)); vhi[i]=vtr(vp_+(((i)>>2)*4096+((i)&3)*1024+512)); }while(0)
  #define KRD(G,j) do{ if(G){ kload2(kf,kp0+sl_next,j); SBAR(); } }while(0)
  #define STEP(C0,C1,P0,P1,t,GK,GV,GL) do{ SBAR(); \
    const lds_cptr vp_=vp0+sl_prev; \
    VRD(0); SBAR(); float sacc=(P0[0]+P0[1]); \
    GAPA(C0=__builtin_amdgcn_mfma_f32_32x32x16_bf16(kf[0],qr[0],negm,0,0,0), P0[2],P0[3],P0[4],P0[5],     pw0[0]=PKW(P0,0), pw0[1]=PKW(P0,2), pw0); \
    VRD(4); SBAR(); GAPA(C1=__builtin_amdgcn_mfma_f32_32x32x16_bf16(kf[1],qr[0],negm,0,0,0), P0[6],P0[7],P0[8],P0[9],     pw0[2]=PKW(P0,4), pw0[3]=PKW(P0,6), pw0); \
    VRD(1); SBAR(); GAPA(C0=__builtin_amdgcn_mfma_f32_32x32x16_bf16(kf[2],qr[1],C0,0,0,0),   P0[10],P0[11],P0[12],P0[13], pw1[0]=PKW(P0,8), pw1[1]=PKW(P0,10), pw1); \
    VRD(5); SBAR(); GAPA(C1=__builtin_amdgcn_mfma_f32_32x32x16_bf16(kf[3],qr[1],C1,0,0,0),   P0[14],P0[15],P1[0],P1[1],   pw1[2]=PKW(P0,12),pw1[3]=PKW(P0,14), pw1); \
    VRD(2); SBAR(); GAPA(C0=__builtin_amdgcn_mfma_f32_32x32x16_bf16(kf[4],qr[2],C0,0,0,0),   P1[2],P1[3],P1[4],P1[5],     pw2[0]=PKW(P1,0), pw2[1]=PKW(P1,2), pw2); \
    VRD(6); SBAR(); GAPA(C1=__builtin_amdgcn_mfma_f32_32x32x16_bf16(kf[5],qr[2],C1,0,0,0),   P1[6],P1[7],P1[8],P1[9],     pw2[2]=PKW(P1,4), pw2[3]=PKW(P1,6), pw2); \
    VRD(3); SBAR(); GAPA(C0=__builtin_amdgcn_mfma_f32_32x32x16_bf16(kf[6],qr[3],C0,0,0,0),   P1[10],P1[11],P1[12],P1[13], pw3[0]=PKW(P1,8), pw3[1]=PKW(P1,10), pw3); \
    VRD(7); SBAR(); GAPA(C1=__builtin_amdgcn_mfma_f32_32x32x16_bf16(kf[7],qr[3],C1,0,0,0),   P1[14],P1[15],0.f,0.f,       pw3[2]=PKW(P1,12),pw3[3]=PKW(P1,14), pw3); \
    l_reg+=sacc; \
    if(GK){DMA_K((t)+3,sl_cur);} if(GV){DMA_V((t)+1,sl_next);} \
    CMASK(C0,C1,t); \
    SBAR(); \
    GAPB(o[0]=__builtin_amdgcn_mfma_f32_32x32x16_bf16(PAF(0),VFR(0),o[0],0,0,0), C0,0); \
    GAPB(o[1]=__builtin_amdgcn_mfma_f32_32x32x16_bf16(PAF(0),VFR(4),o[1],0,0,0), C0,4); \
    KRD(GL,0); GAPB(o[0]=__builtin_amdgcn_mfma_f32_32x32x16_bf16(PAF(1),VFR(1),o[0],0,0,0), C0,8); \
    KRD(GL,1); GAPB(o[1]=__builtin_amdgcn_mfma_f32_32x32x16_bf16(PAF(1),VFR(5),o[1],0,0,0), C0,12); \
    KRD(GL,2); GAPB(o[0]=__builtin_amdgcn_mfma_f32_32x32x16_bf16(PAF(2),VFR(2),o[0],0,0,0), C1,0); \
    KRD(GL,3); GAPB(o[1]=__builtin_amdgcn_mfma_f32_32x32x16_bf16(PAF(2),VFR(6),o[1],0,0,0), C1,4); \
    GAPB(o[0]=__builtin_amdgcn_mfma_f32_32x32x16_bf16(PAF(3),VFR(3),o[0],0,0,0), C1,8); \
    GAPB(o[1]=__builtin_amdgcn_mfma_f32_32x32x16_bf16(PAF(3),VFR(7),o[1],0,0,0), C1,12); \
    }while(0)
  int t=1;
  #undef CMASK
  #define CMASK(P0,P1,t) do{}while(0)
  for(;t+5<NT;t+=2){
    STEP(pB0,pB1,pA0,pA1,t,true,true,true);     WAIT_BAR(2); RESC(); ROT();
    STEP(pA0,pA1,pB0,pB1,t+1,true,true,true);   WAIT_BAR(2); RESC(); ROT();
  }
  #undef CMASK
  #define CMASK(P0,P1,t) do{}while(0)
  #define ENDW(tt) do{ if((tt)+3<NT){WAIT_BAR(2);} else if((tt)+2<NT){WAIT_BAR(1);} else {WAIT_BAR(0);} }while(0)
  for(;t+1<NT;t+=2){
    STEP(pB0,pB1,pA0,pA1,t,(t+3<NT),(t+1<NT),(t+1<NT));       ENDW(t);   RESC(); ROT();
    STEP(pA0,pA1,pB0,pB1,t+1,(t+4<NT),(t+2<NT),(t+2<NT));     ENDW(t+1); RESC(); ROT();
  }
  STEP(pB0,pB1,pA0,pA1,NT-1,false,false,false); RESC();
  { float sacc=pB0[0]+pB0[1]; _Pragma("unroll") for(int r=2;r<16;++r)sacc+=pB0[r]; _Pragma("unroll") for(int r=0;r<16;++r)sacc+=pB1[r]; l_reg+=sacc;
    pw0=(u32x4){PKW(pB0,0),PKW(pB0,2),PKW(pB0,4),PKW(pB0,6)};pw1=(u32x4){PKW(pB0,8),PKW(pB0,10),PKW(pB0,12),PKW(pB0,14)};pw2=(u32x4){PKW(pB1,0),PKW(pB1,2),PKW(pB1,4),PKW(pB1,6)};pw3=(u32x4){PKW(pB1,8),PKW(pB1,10),PKW(pB1,12),PKW(pB1,14)};
    SBAR(); pv(o,vb0+sl_cur,PAF(0),PAF(1),PAF(2),PAF(3)); }
  #undef PKW
  #undef PAF
  #undef VFR
  #undef PIN
  #undef MX3
  #undef GAPA
  #undef GAPB
  #undef EX
  #undef VRD
  #undef KRD
  #undef STEP
  #undef ENDW
  {auto rr=__builtin_amdgcn_permlane32_swap(__float_as_uint(l_reg),__float_as_uint(l_reg),false,false);l_reg=__uint_as_float(rr[0])+__uint_as_float(rr[1]);}
  if(hi==0)wsf[32+r32]=l_reg;asm volatile("s_waitcnt lgkmcnt(0)":::"memory");
  float rli[16];
  #pragma unroll
  for(int r=0;r<16;++r)rli[r]=__builtin_amdgcn_rcpf(wsf[32+crow(r,hi)]);
  unsigned char*Ow=(unsigned char*)O+(rowbase+q0+wid*QBLK)*PO+h*D;
  { unsigned char*stg=(unsigned char*)(shm+LDS_OST)+wid*2048;
    #pragma unroll
    for(int r=0;r<16;++r){const int orow=crow(r,hi); const float sc=rli[r]*OSCALE;
      #pragma unroll
      for(int d0=0;d0<2;++d0){ const float v=__builtin_amdgcn_fmed3f(o[d0][r]*sc,-448.0f,448.0f); stg[orow*64+d0*32+r32]=(unsigned char)(__builtin_amdgcn_cvt_pk_fp8_f32(v,0.f,0u,false)&0xffu); } }
    asm volatile("s_waitcnt lgkmcnt(0)":::"memory");
    #pragma unroll
    for(int i=0;i<2;++i){const int row=i*16+(lane>>2),ch=lane&3; const u32x4 v=*(const u32x4*)(stg+row*64+ch*16); ATTN_STORE16(Ow+(long)row*PO+ch*16,v);} }
  asm volatile("s_waitcnt lgkmcnt(0)\n\ts_barrier":::"memory");
  #undef DMA_K
  #undef DMA_V
  #undef CMASK
  #undef START
  #undef RESC
  #undef ROT
}
constexpr int ATTN_LDS_BYTES=LDS_BYTES;
struct AttnTensors { const bf16* Q; const bf16* K; const bf16* V; bf16* O; const float* qg; const float* kg; };
template<int THRL=8> __device__ __forceinline__ void attn_phase(char*lds,const AttnTensors&T,int vcu,int G){
  float gq=fabsf(T.qg[threadIdx.x&63]),gk=fabsf(T.kg[threadIdx.x&63]);
  gq=wmax64(gq); gk=wmax64(gk);
  const float nref=__uint_as_float(__builtin_amdgcn_readfirstlane(__float_as_uint(-(64.f*C2*gq*gk*1.02f+0.25f))));
  for(int L=vcu;L<BATCH*NHEAD*NQB;L+=G){
    const int pair=((L>>5)&7)*2+((L>>8)>>2), idx=(L&31)+32*((L>>8)&3);
    const int b=pair>>1, h=(pair&1)*4+(idx>>5), qb=idx&31;
    attn_unit<THRL>(b,h,qb,T.Q,T.K,T.V,T.O,lds,T.qg,nref);
  }
}
#undef SBAR
#undef WAIT_BAR
}
constexpr int NWAVES = 8;
constexpr int NTHR = NWAVES * 64;
constexpr int BATCH = 8, T = 8192, D = 1024, DEPTH = 2;
constexpr int M = BATCH * T;
constexpr int INW = 2816;
constexpr int C_QA = 0, C_KA = 512, C_VA = 640, C_QR = 768, C_KR = 1280, C_VR = 1792, C_GR = 2304;
constexpr int NE = 32, TOPK = 4, NASG = M * TOPK;
constexpr int XS_ROWS = NASG + NE * 256;
constexpr int RCH = 128, NCH = T / RCH, RH = 4;
constexpr int RUNITS = BATCH * RH * NCH;
constexpr float EPS = 1e-6f;
constexpr float LOG2E = 1.4426950408889634f;

constexpr size_t MiB = 1u << 20;
constexpr size_t WS_CTL = 0, CTL_ZERO_BYTES = 2 * MiB;
constexpr size_t WS_MOD = 512 * 1024;
constexpr size_t WS_CMAXIN = 256 * 1024, WS_CSCIN = 320 * 1024;
constexpr size_t WS_CMAX = 1 * MiB;
constexpr size_t WS_CSCDN = 1 * MiB;
constexpr size_t WS_CSCOUT = 1 * MiB + 256 * 1024;
constexpr float CAT_S_ATT = 32.0f, CAT_S_RET = 8.0f;
static_assert(attn_body::OSCALE == CAT_S_ATT, "attention output scale");
constexpr size_t WS_CSC = 1 * MiB + 512 * 1024;
constexpr size_t WS_WIN = 2 * MiB;
constexpr size_t WS_WOUT = 13 * MiB;
constexpr size_t WS_WUP = 17 * MiB;
constexpr size_t WS_WDN = 273 * MiB;
constexpr size_t WS_HM = 401 * MiB;
constexpr size_t WS_TOPI = 529 * MiB, WS_TOPW = 530 * MiB, WS_POS = 531 * MiB;
constexpr size_t WS_PROJ = 532 * MiB;
constexpr size_t WS_CAT = 884 * MiB;
constexpr size_t WS_YM = 1012 * MiB;
constexpr size_t WS_U = 1140 * MiB;
constexpr size_t WS_FT = 1396 * MiB;
constexpr size_t WS_XS = 532 * MiB;
constexpr size_t WS_ACT = 1060 * MiB;
constexpr size_t WS_HS = 1588 * MiB;
constexpr size_t WS_XSC = 1589 * MiB;
constexpr size_t WS_RMAP = 1591 * MiB;
constexpr size_t WS_END = 1593 * MiB;
constexpr size_t WS_DUMMY = 1593 * MiB;
static_assert(WS_MOD + (size_t)DEPTH * BATCH * 6 * D * 4 <= CTL_ZERO_BYTES, "mod inside the memset region");
static_assert(WS_XS + (size_t)XS_ROWS * 1024 * 2 <= WS_ACT && WS_ACT + (size_t)XS_ROWS * 1024 * 2 <= WS_END, "moe map");
static_assert(WS_PROJ + (size_t)M * INW * 2 <= WS_CAT && WS_FT + (size_t)RUNITS * 2 * 16384 * 2 <= WS_END, "mixer map");
constexpr int CW_TMO = 0, CW_CODE = 1;
constexpr int CW_BAR = 4096;
constexpr int CW_CNT = 8192;
constexpr int CW_WQ = 8192 + 1024;
constexpr int CW_CUR = 8192 + 256;

constexpr int RING_OFF = 0, RING_BYTES = 131072;
constexpr int LDSCTL_OFF = RING_BYTES;
constexpr int LCNT_OFF = LDSCTL_OFF, LTS_OFF = LDSCTL_OFF + 128, MISC_OFF = LDSCTL_OFF + 320;
constexpr int EPI_SP_OFF = LDSCTL_OFF + 1024;
constexpr int GAIN_OFF = LDSCTL_OFF + 6144;
constexpr int LDS_BYTES = 147456;
#define GAS __attribute__((address_space(1)))
#define LAS __attribute__((address_space(3)))
typedef unsigned short bf16;
typedef unsigned v4u __attribute__((ext_vector_type(4)));
typedef float f32x4 __attribute__((ext_vector_type(4)));
typedef short bf16x8 __attribute__((ext_vector_type(8)));
typedef GAS unsigned gu32;
typedef GAS unsigned long long gu64;
#define RLX_AGENT __ATOMIC_RELAXED, __HIP_MEMORY_SCOPE_AGENT
#define LDS_WAIT() asm volatile("s_waitcnt lgkmcnt(0)" ::: "memory")
#define VM_WAIT() asm volatile("s_waitcnt vmcnt(0)" ::: "memory")
__device__ __forceinline__ unsigned long long rt() { return __builtin_amdgcn_s_memrealtime(); }
__device__ __forceinline__ unsigned f2bf(float f) { unsigned u = __builtin_bit_cast(unsigned, f); return (u + 0x7fffu + ((u >> 16) & 1u)) >> 16; }
__device__ __forceinline__ unsigned pk2(float lo, float hi) { return f2bf(lo) | (f2bf(hi) << 16); }

#define XB_TMO      128
#define XB_XCNT(j)  (256  + 64 * (j))
#define XB_XSUB(j)  (1280 + 64 * (j))
#define XB_XGEN(j)  (2304 + 64 * (j))
#define XB_TOP      3328
#define XB_TOPGEN   3392
#define XCD_BAR_WORDS 3456
#define XB_SPIN_CAP (1u << 18)

__device__ __forceinline__ unsigned xb_ld(unsigned* p)              { return __hip_atomic_load(p, __ATOMIC_RELAXED, __HIP_MEMORY_SCOPE_AGENT); }
__device__ __forceinline__ unsigned xb_add(unsigned* p, unsigned v) { return __hip_atomic_fetch_add(p, v, __ATOMIC_RELAXED, __HIP_MEMORY_SCOPE_AGENT); }
__device__ __forceinline__ unsigned xb_xcc_id() { return (unsigned)__builtin_amdgcn_s_getreg((3 << 11) | 20) & 0xFu; }
#define XB_SPIN(cond, bar) do { unsigned _sp = 0; while (cond) { __builtin_amdgcn_s_sleep(1); \
    if ((++_sp & 255u) == 0u) { if (xb_ld(&(bar)[XB_TMO])) break; if (_sp > XB_SPIN_CAP) { atomicAdd(&(bar)[XB_TMO], 1u); break; } } } } while (0)

struct XcdBarrier {
    unsigned* bar; unsigned x;
    volatile LAS unsigned* st;
};

__device__ __forceinline__ XcdBarrier xcd_barrier_post(unsigned* bar, volatile LAS unsigned* st) {
    XcdBarrier b; b.bar = bar; b.x = xb_xcc_id(); b.st = st;
    if (threadIdx.x == 0) (void)xb_add(&bar[XB_XCNT(b.x)], 1u);
    return b;
}
__device__ __forceinline__ void xcd_barrier_complete(unsigned* bar, unsigned x, unsigned& nloc, unsigned& nx) {
    const unsigned G = gridDim.x * gridDim.y * gridDim.z;
    unsigned sum, cnt, mine, sp = 0u;
    for (;;) {
        sum = 0u; cnt = 0u; mine = 0u;
#pragma unroll
        for (unsigned j = 0; j < 16; ++j) { const unsigned c = xb_ld(&bar[XB_XCNT(j)]); sum += c; cnt += (c > 0u) ? 1u : 0u; mine = (j == x) ? c : mine; }
        if (sum == G) break;
        __builtin_amdgcn_s_sleep(1);
        if ((++sp & 255u) == 0u) { if (xb_ld(&bar[XB_TMO])) break; if (sp > XB_SPIN_CAP) { atomicAdd(&bar[XB_TMO], 1u); break; } }
    }
    nloc = mine > 0u ? mine : 1u; nx = cnt > 0u ? cnt : 1u;
}

__device__ __forceinline__ void xcd_barrier(const XcdBarrier& b) {
    asm volatile("s_waitcnt vmcnt(0)" ::: "memory");
    __syncthreads();
    if (threadIdx.x == 0) {
        unsigned* bar = b.bar;
        __builtin_amdgcn_s_waitcnt(0);
        unsigned nloc = b.st[0], nx = b.st[1];
        if (nloc == 0u) { xcd_barrier_complete(bar, b.x, nloc, nx); b.st[0] = nloc; b.st[1] = nx; }
        const unsigned old = xb_add(&bar[XB_XSUB(b.x)], 1u);
        const unsigned gen = old / nloc;
        if (old + 1u == (gen + 1u) * nloc) {
            __builtin_amdgcn_fence(__ATOMIC_RELEASE, "agent");
            asm volatile("s_waitcnt vmcnt(0)" ::: "memory");
            const unsigned og = xb_add(&bar[XB_TOP], 1u);
            const unsigned tg = og / nx;
            if (og + 1u == (tg + 1u) * nx) xb_add(&bar[XB_TOPGEN], 1u);
            else XB_SPIN(xb_ld(&bar[XB_TOPGEN]) == tg, bar);
            __builtin_amdgcn_fence(__ATOMIC_ACQUIRE, "agent");
            xb_add(&bar[XB_XGEN(b.x)], 1u);
            asm volatile("s_waitcnt vmcnt(0)" ::: "memory");
        } else {
            XB_SPIN(xb_ld(&bar[XB_XGEN(b.x)]) == gen, bar);
            __builtin_amdgcn_fence(__ATOMIC_ACQUIRE, "agent");
            asm volatile("s_waitcnt vmcnt(0)" ::: "memory");
        }
    }
    __syncthreads();
}

typedef unsigned u32x2 __attribute__((ext_vector_type(2)));
typedef short s16x4 __attribute__((ext_vector_type(4)));
typedef float f32x16 __attribute__((ext_vector_type(16)));
typedef int i32x4 __attribute__((ext_vector_type(4)));
struct Frame {
    LAS unsigned char* lds;
    volatile LAS unsigned* MISC;
    gu32* ctl;
    int tid, lane, wave, vcu, G;
};
__device__ __forceinline__ float wave_sum(float v) {
    return wsum64(v);
}
__device__ __forceinline__ float bflo(unsigned w) { return __uint_as_float(w << 16); }
__device__ __forceinline__ float bfhi(unsigned w) { return __uint_as_float(w & 0xffff0000u); }
__device__ __forceinline__ unsigned pkbf(float lo, float hi) { return pg8::cvt_pk_bf16(lo, hi); }
__device__ __forceinline__ float fexp2(float x) { return __builtin_amdgcn_exp2f(x); }
__device__ __forceinline__ float frsq(float x) { return __builtin_amdgcn_rsqf(x); }
__device__ __forceinline__ float frcp(float x) { return __builtin_amdgcn_rcpf(x); }
__device__ __forceinline__ float row_rstd(const f32x4 (&v)[4]) {
    float s = 0.f;
#pragma unroll
    for (int j = 0; j < 4; ++j) s += (v[j].x * v[j].x + v[j].y * v[j].y) + (v[j].z * v[j].z + v[j].w * v[j].w);
    return frsq(wave_sum(s) * (1.f / D) + EPS);
}
__device__ __forceinline__ void store_row_bf16(bf16* orow, const f32x4 (&v)[4], int lane) {
    u32x2* o8 = (u32x2*)orow + lane;
#pragma unroll
    for (int j = 0; j < 4; ++j) { u32x2 w; w.x = pkbf(v[j].x, v[j].y); w.y = pkbf(v[j].z, v[j].w); o8[64 * j] = w; }
}
__device__ __forceinline__ void load_row_f32(const float* xrow, f32x4 (&v)[4], int lane) {
    const f32x4* xr = (const f32x4*)xrow + lane;
#pragma unroll
    for (int j = 0; j < 4; ++j) v[j] = xr[64 * j];
}
__device__ __forceinline__ void modnorm_row(const f32x4 (&x)[4], f32x4 (&h)[4], const float* g, const float* sc, const float* sh, int lane) {
    const float rs = row_rstd(x);
#pragma unroll
    for (int j = 0; j < 4; ++j) { const f32x4 gv = ((const f32x4*)g)[lane + 64 * j], scv = ((const f32x4*)sc)[lane + 64 * j], shv = ((const f32x4*)sh)[lane + 64 * j];
        h[j] = x[j] * rs * gv * (scv + 1.0f) + shv; }
}

template <bool UPPERM> __device__ __forceinline__ void p0_transpose_item(const float* W, int K, int N, bf16* WT, int item, int lane) {
    const int nblk = N / 256, kb = item / nblk, nb = item - kb * nblk, k0 = 32 * kb, n0 = 256 * nb + 4 * lane;
    const float* src = W + (size_t)k0 * N + n0;
    int drow = n0;
    if (UPPERM) drow = (n0 < 1024) ? (256 * (n0 >> 7) + (n0 & 127)) : (256 * ((n0 - 1024) >> 7) + 128 + ((n0 - 1024) & 127));
    bf16* dst = WT + (size_t)drow * K + k0;
#pragma unroll
    for (int s = 0; s < 4; ++s) {
        f32x4 v[8];
#pragma unroll
        for (int k = 0; k < 8; ++k) v[k] = *(const f32x4*)(src + (size_t)(8 * s + k) * N);
#pragma unroll
        for (int j = 0; j < 4; ++j) { v4u o; o.x = pkbf(v[0][j], v[1][j]); o.y = pkbf(v[2][j], v[3][j]); o.z = pkbf(v[4][j], v[5][j]); o.w = pkbf(v[6][j], v[7][j]);
            *(v4u*)(dst + (size_t)j * K + 8 * s) = o; }
    }
}
__device__ __forceinline__ int up_dest_row(int n0) { return (n0 < 1024) ? (256 * (n0 >> 7) + (n0 & 127)) : (256 * ((n0 - 1024) >> 7) + 128 + ((n0 - 1024) & 127)); }
template <int N, bool UPPERM> __device__ __forceinline__ void p0_absmax_item(const float* W, unsigned* cmax, int item, int lane) {
    constexpr int NBLK = N / 256; const int kb = item / NBLK, nb = item - kb * NBLK, k0 = 32 * kb, n0 = 256 * nb + 4 * lane;
    const float* src = W + (size_t)k0 * N + n0;
    f32x4 mx = (f32x4){0.f, 0.f, 0.f, 0.f};
#pragma unroll
    for (int k = 0; k < 32; ++k) { const f32x4 v = *(const f32x4*)(src + (size_t)k * N); mx.x = fmaxf(mx.x, fabsf(v.x)); mx.y = fmaxf(mx.y, fabsf(v.y)); mx.z = fmaxf(mx.z, fabsf(v.z)); mx.w = fmaxf(mx.w, fabsf(v.w)); }
    unsigned* d = cmax + (UPPERM ? up_dest_row(n0) : n0);
    atomicMax(d + 0, __float_as_uint(mx.x)); atomicMax(d + 1, __float_as_uint(mx.y)); atomicMax(d + 2, __float_as_uint(mx.z)); atomicMax(d + 3, __float_as_uint(mx.w));
}
template <int N, bool UPPERM> __device__ __forceinline__ void p0_quant_item(const float* W, const unsigned* cmax, signed char* WQ, float* csc, int item, int lane) {
    constexpr int NBLK = N / 256; const int kb = item / NBLK, nb = item - kb * NBLK, k0 = 32 * kb, n0 = 256 * nb + 4 * lane, drow = UPPERM ? up_dest_row(n0) : n0;
    const float* src = W + (size_t)k0 * N + n0;
    float inv[4];
#pragma unroll
    for (int j = 0; j < 4; ++j) { const float cm = __uint_as_float(cmax[drow + j]); inv[j] = cm > 0.f ? 127.0f / cm : 0.f; if (kb == 0) csc[drow + j] = cm * (1.0f / 127.0f); }
#pragma unroll
    for (int s = 0; s < 2; ++s) {
        f32x4 v[16];
#pragma unroll
        for (int k = 0; k < 16; ++k) v[k] = *(const f32x4*)(src + (size_t)(16 * s + k) * N);
#pragma unroll
        for (int j = 0; j < 4; ++j) { unsigned w[4];
#pragma unroll
            for (int d = 0; d < 4; ++d) { unsigned x = 0u;
#pragma unroll
                for (int b = 0; b < 4; ++b) { const int q = (int)__builtin_rintf(v[4 * d + b][j] * inv[j]); x |= ((unsigned)q & 0xffu) << (8 * b); }
                w[d] = x; }
            *(v4u*)(WQ + (size_t)(drow + j) * 1024 + k0 + 16 * s) = (v4u){w[0], w[1], w[2], w[3]}; }
    }
}
__device__ __forceinline__ void p0_quant_up(Frame& F, const float* w_up, const unsigned* cmax, signed char* WQ, float* csc, const float* w_in, const unsigned* cmax_in, signed char* WQin, float* csc_in) {
    const int gw = F.vcu * NWAVES + F.wave, NGW = F.G * NWAVES;
    for (int it = gw; it < DEPTH * NE * 256 + DEPTH * 352; it += NGW) {
        if (it < DEPTH * NE * 256) { const int le = it >> 8;
            p0_quant_item<2048, true>(w_up + (size_t)le * D * 2048, cmax + (size_t)le * 2048, WQ + (size_t)le * 2048 * D, csc + (size_t)le * 2048, it & 255, F.lane); }
        else { const int r = it - DEPTH * NE * 256, l = r / 352;
            p0_quant_item<INW, false>(w_in + (size_t)l * D * INW, cmax_in + (size_t)l * INW, WQin + (size_t)l * INW * D, csc_in + (size_t)l * INW, r % 352, F.lane); }
    }
}
template <int N, bool UPPERM, bool FP8 = false, bool KSC = false> __device__ __forceinline__ void p0_quant_unit(const float* W, signed char* WQ, float* csc, int cb, LAS unsigned* red, int tid) {
    const int cg = tid & 15, kq = tid >> 4, n0 = 64 * cb + 4 * cg, drow = UPPERM ? up_dest_row(n0) : n0;
    f32x4 v[2][16]; f32x4 mx = (f32x4){0.f, 0.f, 0.f, 0.f};
#pragma unroll
    for (int h = 0; h < 2; ++h)
#pragma unroll
        for (int i = 0; i < 16; ++i) { v[h][i] = *(const f32x4*)(W + (size_t)(16 * (kq + 32 * h) + i) * N + n0); if constexpr (KSC) v[h][i] = v[h][i] * (h == 0 ? 1.0f / CAT_S_ATT : 1.0f / CAT_S_RET);
            mx.x = fmaxf(mx.x, fabsf(v[h][i].x)); mx.y = fmaxf(mx.y, fabsf(v[h][i].y)); mx.z = fmaxf(mx.z, fabsf(v[h][i].z)); mx.w = fmaxf(mx.w, fabsf(v[h][i].w)); }
    if (tid < 64) red[tid] = 0u;
    __syncthreads();
    atomicMax((unsigned*)(red + 4 * cg + 0), __float_as_uint(mx.x)); atomicMax((unsigned*)(red + 4 * cg + 1), __float_as_uint(mx.y));
    atomicMax((unsigned*)(red + 4 * cg + 2), __float_as_uint(mx.z)); atomicMax((unsigned*)(red + 4 * cg + 3), __float_as_uint(mx.w));
    __syncthreads();
    float inv[4];
#pragma unroll
    for (int j = 0; j < 4; ++j) { const float cm = __uint_as_float(red[4 * cg + j]); constexpr float QMAX = FP8 ? 448.0f : 127.0f; inv[j] = cm > 0.f ? QMAX / cm : 0.f; if (kq == 0) csc[drow + j] = cm * (1.0f / QMAX); }
#pragma unroll
    for (int h = 0; h < 2; ++h)
#pragma unroll
        for (int j = 0; j < 4; ++j) { unsigned w[4];
#pragma unroll
            for (int d = 0; d < 4; ++d) { unsigned x = 0u;
                if constexpr (FP8) { x = __builtin_amdgcn_cvt_pk_fp8_f32(v[h][4 * d + 0][j] * inv[j], v[h][4 * d + 1][j] * inv[j], x, false); x = __builtin_amdgcn_cvt_pk_fp8_f32(v[h][4 * d + 2][j] * inv[j], v[h][4 * d + 3][j] * inv[j], x, true); }
                else {
#pragma unroll
                for (int b = 0; b < 4; ++b) { const int q = (int)__builtin_rintf(v[h][4 * d + b][j] * inv[j]); x |= ((unsigned)q & 0xffu) << (8 * b); } }
                w[d] = x; }
            *(v4u*)(WQ + (size_t)(drow + j) * 1024 + 16 * (kq + 32 * h)) = (v4u){w[0], w[1], w[2], w[3]}; }
    __syncthreads();
}
struct QItem { const float* W; signed char* WQ; float* csc; int N, n0, type; };
__device__ __forceinline__ void q_issue(f32x4 (&v)[16], const QItem& q, int tid) {
    const int cg = tid & 7, kq = tid >> 3; const float* src = q.W + (size_t)(16 * kq) * q.N + q.n0 + 4 * cg;
#pragma unroll
    for (int i = 0; i < 16; ++i) v[i] = *(const f32x4*)(src + (size_t)i * q.N);
}
template <bool UPPERM, bool FP8, bool KSC> __device__ __forceinline__ void q_finish(f32x4 (&v)[16], const QItem& q, LAS unsigned* red, int tid) {
    const int cg = tid & 7, kq = tid >> 3, n0 = q.n0 + 4 * cg, drow = UPPERM ? up_dest_row(n0) : n0;
    f32x4 mx = (f32x4){0.f, 0.f, 0.f, 0.f};
#pragma unroll
    for (int i = 0; i < 16; ++i) { if constexpr (KSC) v[i] = v[i] * (kq < 32 ? 1.0f / CAT_S_ATT : 1.0f / CAT_S_RET);
        mx.x = fmaxf(mx.x, fabsf(v[i].x)); mx.y = fmaxf(mx.y, fabsf(v[i].y)); mx.z = fmaxf(mx.z, fabsf(v[i].z)); mx.w = fmaxf(mx.w, fabsf(v[i].w)); }
    if (tid < 32) red[tid] = 0u;
    __syncthreads();
    atomicMax((unsigned*)(red + 4 * cg + 0), __float_as_uint(mx.x)); atomicMax((unsigned*)(red + 4 * cg + 1), __float_as_uint(mx.y));
    atomicMax((unsigned*)(red + 4 * cg + 2), __float_as_uint(mx.z)); atomicMax((unsigned*)(red + 4 * cg + 3), __float_as_uint(mx.w));
    __syncthreads();
    constexpr float QMAX = FP8 ? 448.0f : 127.0f;
#pragma unroll
    for (int j = 0; j < 4; ++j) { const float cm = __uint_as_float(red[4 * cg + j]), inv = cm > 0.f ? QMAX / cm : 0.f; if (kq == 0) q.csc[drow + j] = cm * (1.0f / QMAX);
        unsigned w[4];
#pragma unroll
        for (int d = 0; d < 4; ++d) { unsigned x = 0u;
            if constexpr (FP8) { x = __builtin_amdgcn_cvt_pk_fp8_f32(v[4 * d + 0][j] * inv, v[4 * d + 1][j] * inv, x, false); x = __builtin_amdgcn_cvt_pk_fp8_f32(v[4 * d + 2][j] * inv, v[4 * d + 3][j] * inv, x, true); }
            else {
#pragma unroll
                for (int b = 0; b < 4; ++b) { const int qv = (int)__builtin_rintf(v[4 * d + b][j] * inv); x |= ((unsigned)qv & 0xffu) << (8 * b); } }
            w[d] = x; }
        *(v4u*)(q.WQ + (size_t)(drow + j) * 1024 + 16 * kq) = (v4u){w[0], w[1], w[2], w[3]}; }
}
__device__ __forceinline__ void q_finish_any(f32x4 (&v)[16], const QItem& q, LAS unsigned* red, int tid) {
    if (q.type == 0) q_finish<true, false, false>(v, q, red, tid);
    else if (q.type == 1) q_finish<false, false, false>(v, q, red, tid);
    else if (q.type == 2) q_finish<false, true, false>(v, q, red, tid);
    else q_finish<false, true, true>(v, q, red, tid);
}
__device__ __forceinline__ void p0_prologue(Frame& F, const float* c_in, const float* ada_w, const float* ada_b, float* mod,
                                            const float* w_in, const float* w_out, const float* w_up, const float* w_dn,
                                            signed char* WQin, float* csc_in, signed char* WQout, float* csc_out, signed char* WQup, float* csc_up, signed char* WQdn, float* csc_dn, gu32* wq_ctr) {
    const int gw = F.vcu * NWAVES + F.wave, NGW = F.G * NWAVES;
    __syncthreads();
    LAS float* cond = (LAS float*)F.lds;
    for (int i = F.tid; i < BATCH * D; i += NTHR) { const float v = c_in[i]; cond[i] = v * frcp(1.0f + __expf(-v)); }
    __syncthreads();
    LAS float* part = (LAS float*)(F.lds + 32768);
    for (int bt = blockIdx.x; bt < DEPTH * 96; bt += F.G) {
        const int l = bt / 96, chunk = bt % 96, ks = F.wave, col = chunk * 64 + F.lane;
        float acc[BATCH];
#pragma unroll
        for (int b = 0; b < BATCH; ++b) acc[b] = 0.f;
        const float* w = ada_w + ((size_t)l * D + ks * 128) * (6 * D) + col;
#pragma unroll 16
        for (int k = 0; k < 128; ++k) { const float wv = w[(size_t)k * (6 * D)];
#pragma unroll
            for (int b = 0; b < BATCH; ++b) acc[b] += cond[b * D + ks * 128 + k] * wv; }
#pragma unroll
        for (int b = 0; b < BATCH; ++b) part[(ks * BATCH + b) * 64 + F.lane] = acc[b];
        __syncthreads();
        { const int b = F.wave; float sum = ada_b[l * 6 * D + col];
#pragma unroll
          for (int k2 = 0; k2 < 8; ++k2) sum += part[(k2 * BATCH + b) * 64 + F.lane];
          mod[((size_t)l * BATCH + b) * (6 * D) + col] = sum; }
        __syncthreads();
    }
    {   LAS unsigned* redA = (LAS unsigned*)(F.lds + 49152 + 1024), *redB = redA + 32; LAS unsigned* claim = redA + 64;
        constexpr int U_UP = DEPTH * NE * 64, U_IN = DEPTH * 88, U_DN = DEPTH * NE * 32, U_OUT = DEPTH * 32, U_ALL = U_UP + U_IN + U_DN + U_OUT;
        auto take = [&](QItem& q) -> bool {
            if (F.tid == 0) claim[0] = __hip_atomic_fetch_add(wq_ctr, 1u, RLX_AGENT);
            __syncthreads();
            const int u = (int)claim[0];
            __syncthreads();
            if (u >= U_ALL) return false;
            if (u < U_UP) { const int le = u >> 6; q = QItem{w_up + (size_t)le * D * 2048, WQup + (size_t)le * 2048 * D, csc_up + (size_t)le * 2048, 2048, 32 * (u & 63), 0}; }
            else if (u < U_UP + U_IN) { const int r = u - U_UP, l = r / 88; q = QItem{w_in + (size_t)l * D * INW, WQin + (size_t)l * INW * D, csc_in + (size_t)l * INW, INW, 32 * (r % 88), 1}; }
            else if (u < U_UP + U_IN + U_DN) { const int r = u - U_UP - U_IN, le = r >> 5; q = QItem{w_dn + (size_t)le * D * D, WQdn + (size_t)le * D * D, csc_dn + (size_t)le * D, D, 32 * (r & 31), 2}; }
            else { const int r = u - U_UP - U_IN - U_DN, l = r >> 5; q = QItem{w_out + (size_t)l * D * D, WQout + (size_t)l * D * D, csc_out + (size_t)l * D, D, 32 * (r & 31), 3}; }
            return true; };
        f32x4 vA[16], vB[16]; QItem qA, qB;
        bool hA = take(qA); if (hA) q_issue(vA, qA, F.tid);
        bool hB = hA && take(qB); if (hB) q_issue(vB, qB, F.tid);
        while (hA || hB) {
            if (hA) { q_finish_any(vA, qA, redA, F.tid); hA = take(qA); if (hA) q_issue(vA, qA, F.tid); }
            if (hB) { q_finish_any(vB, qB, redB, F.tid); hB = take(qB); if (hB) q_issue(vB, qB, F.tid); }
        }
    }
}
__device__ __forceinline__ void store_row_i8(signed char* qrow, float* sc, const f32x4 (&h)[4], int lane) {
    float mx = 0.f;
#pragma unroll
    for (int j = 0; j < 4; ++j) mx = fmaxf(fmaxf(mx, fmaxf(fabsf(h[j].x), fabsf(h[j].y))), fmaxf(fabsf(h[j].z), fabsf(h[j].w)));
    mx = wmax64(mx);
    const float inv = mx > 0.f ? 127.0f / mx : 0.f;
    unsigned* qr = (unsigned*)qrow + lane;
#pragma unroll
    for (int j = 0; j < 4; ++j) { const int q0 = (int)__builtin_rintf(h[j].x * inv), q1 = (int)__builtin_rintf(h[j].y * inv), q2 = (int)__builtin_rintf(h[j].z * inv), q3 = (int)__builtin_rintf(h[j].w * inv);
        qr[64 * j] = ((unsigned)q0 & 0xffu) | (((unsigned)q1 & 0xffu) << 8) | (((unsigned)q2 & 0xffu) << 16) | (((unsigned)q3 & 0xffu) << 24); }
    if (lane == 0) *sc = mx * (1.0f / 127.0f);
}
__device__ __forceinline__ void p0b_premix(Frame& F, const float* x, signed char* HQ, float* hs, const float* g, const float* mod_l) {
    const int lane = F.lane, gw = F.vcu * NWAVES + F.wave, NGW = F.G * NWAVES;
    for (int ch = gw; ch < M / 32; ch += NGW) { const int mb = ch * 32;
        const float* modb = mod_l + (size_t)(mb >> 13) * (6 * D);
        f32x4 gsv[4], shv[4];
#pragma unroll
        for (int j = 0; j < 4; ++j) { gsv[j] = ((const f32x4*)g)[lane + 64 * j] * (((const f32x4*)(modb + D))[lane + 64 * j] + 1.0f); shv[j] = ((const f32x4*)modb)[lane + 64 * j]; }
        f32x4 A[2][4], B[2][4];
#define P0B_ISSUE(BUF, t0) do { _Pragma("unroll") for (int r = 0; r < 2; ++r) load_row_f32(x + (size_t)(mb + (t0) + r) * D, BUF[r], lane); } while (0)
#define P0B_PROC(BUF, t0) do { _Pragma("unroll") for (int r = 0; r < 2; ++r) { const int m = mb + (t0) + r; f32x4 h[4]; const float rs = row_rstd(BUF[r]); \
            _Pragma("unroll") for (int j = 0; j < 4; ++j) h[j] = BUF[r][j] * rs * gsv[j] + shv[j]; store_row_i8(HQ + (size_t)m * D, hs + m, h, lane); } } while (0)
        P0B_ISSUE(A, 0);
#pragma unroll 1
        for (int it = 0; it < 8; ++it) { const int t0 = 4 * it;
            P0B_ISSUE(B, t0 + 2);
            P0B_PROC(A, t0);
            if (it < 7) P0B_ISSUE(A, t0 + 4);
            P0B_PROC(B, t0 + 2);
        }
#undef P0B_ISSUE
#undef P0B_PROC
    }
}
__device__ __forceinline__ void rope4(float (&y)[4][2], const float (&cr)[2], const float (&sr)[2], const float (&cc)[2], const float (&sc)[2], float scale, unsigned (&w)[4]) {
    float o[4][2];
#pragma unroll
    for (int e = 0; e < 2; ++e) { o[0][e] = y[0][e] * cr[e] - y[1][e] * sr[e]; o[1][e] = y[1][e] * cr[e] + y[0][e] * sr[e];
                                  o[2][e] = y[2][e] * cc[e] - y[3][e] * sc[e]; o[3][e] = y[3][e] * cc[e] + y[2][e] * sc[e]; }
#pragma unroll
    for (int q = 0; q < 4; ++q) w[q] = pkbf(o[q][0] * scale, o[q][1] * scale);
}
__device__ __forceinline__ void p1b_ka(Frame& F, bf16* PROJ, const float* kg) {
    const int lane = F.lane, gw = F.vcu * NWAVES + F.wave, NGW = F.G * NWAVES;
    const int ja = lane & 7, hk = (lane >> 3) & 1, sub = lane >> 4;
    constexpr float L2T = 13.287712379549449f;
    float fa[2], gk[4][2];
#pragma unroll
    for (int e = 0; e < 2; ++e) fa[e] = fexp2(-(float)(2 * ja + e) * (L2T / 16.f));
#pragma unroll
    for (int q = 0; q < 4; ++q)
#pragma unroll
        for (int e = 0; e < 2; ++e) gk[q][e] = kg[q * 16 + 2 * ja + e];
    for (int m0 = gw * 4; m0 < M; m0 += NGW * 4) {
        const int m = m0 + sub, s = m & (T - 1); const float rid = (float)(s >> 6), cid = (float)(s & 63);
        float cra[2], sra[2], cca[2], sca[2];
#pragma unroll
        for (int e = 0; e < 2; ++e) { cra[e] = __cosf(rid * fa[e]); sra[e] = __sinf(rid * fa[e]); cca[e] = __cosf(cid * fa[e]); sca[e] = __sinf(cid * fa[e]); }
        unsigned* p = (unsigned*)(PROJ + (size_t)m * INW + C_KA + hk * 64 + 2 * ja); unsigned w[4]; float y[4][2]; float ss = 0.f;
#pragma unroll
        for (int q = 0; q < 4; ++q) { w[q] = p[q * 8]; y[q][0] = bflo(w[q]); y[q][1] = bfhi(w[q]); ss += y[q][0] * y[q][0] + y[q][1] * y[q][1]; }
        ss += shx<1>(ss); ss += shx<2>(ss); ss += shx<4>(ss);
        const float rs = frsq(ss * (1.f / 64.f) + EPS);
#pragma unroll
        for (int q = 0; q < 4; ++q) { y[q][0] *= rs * gk[q][0]; y[q][1] *= rs * gk[q][1]; }
        rope4(y, cra, sra, cca, sca, 1.0f, w);
#pragma unroll
        for (int q = 0; q < 4; ++q) p[q * 8] = w[q];
    }
}
__device__ __forceinline__ void p1b_rope(Frame& F, bf16* PROJ, bf16* PDST, const float* qg, const float* kg) {
    const int lane = F.lane, gw = F.vcu * NWAVES + F.wave, NGW = F.G * NWAVES;
    const int ja = lane & 7, jr = lane & 15;
    constexpr float L2T = 13.287712379549449f;
    float fa[2], fr[2], gq[4][2], gk[4][2];
#pragma unroll
    for (int e = 0; e < 2; ++e) { fa[e] = fexp2(-(float)(2 * ja + e) * (L2T / 16.f)); fr[e] = fexp2(-(float)(2 * jr + e) * (L2T / 32.f)); }
#pragma unroll
    for (int q = 0; q < 4; ++q)
#pragma unroll
        for (int e = 0; e < 2; ++e) { gq[q][e] = qg[q * 16 + 2 * ja + e]; gk[q][e] = kg[q * 16 + 2 * ja + e]; }
    for (int m = gw; m < M; m += NGW) {
        const int s = m & (T - 1); const float rid = (float)(s >> 6), cid = (float)(s & 63);
        float cra[2], sra[2], cca[2], sca[2], crr[2], srr[2], ccr[2], scr2[2];
#pragma unroll
        for (int e = 0; e < 2; ++e) { cra[e] = __cosf(rid * fa[e]); sra[e] = __sinf(rid * fa[e]); cca[e] = __cosf(cid * fa[e]); sca[e] = __sinf(cid * fa[e]);
                                      crr[e] = __cosf(rid * fr[e]); srr[e] = __sinf(rid * fr[e]); ccr[e] = __cosf(cid * fr[e]); scr2[e] = __sinf(cid * fr[e]); }
        bf16* row = PROJ + (size_t)m * INW; const size_t dd = (size_t)((const char*)PDST - (const char*)PROJ) / 4;
        {
            unsigned* p = (unsigned*)(row + C_QA + (lane >> 3) * 64 + 2 * ja); unsigned w[4]; float y[4][2]; float ss = 0.f;
#pragma unroll
            for (int q = 0; q < 4; ++q) { w[q] = p[q * 8]; y[q][0] = bflo(w[q]); y[q][1] = bfhi(w[q]); ss += y[q][0] * y[q][0] + y[q][1] * y[q][1]; }
            ss += shx<1>(ss); ss += shx<2>(ss); ss += shx<4>(ss);
            const float rs = frsq(ss * (1.f / 64.f) + EPS);
#pragma unroll
            for (int q = 0; q < 4; ++q) { y[q][0] *= rs * gq[q][0]; y[q][1] *= rs * gq[q][1]; }
            rope4(y, cra, sra, cca, sca, attn_body::C2, w);
#pragma unroll
            for (int q = 0; q < 4; ++q) p[dd + q * 8] = w[q];
        }
        {
            const int hk = (lane >> 3) & 1;
            unsigned* p = (unsigned*)(row + C_KA + hk * 64 + 2 * ja); unsigned w[4]; float y[4][2]; float ss = 0.f;
#pragma unroll
            for (int q = 0; q < 4; ++q) { w[q] = p[q * 8]; y[q][0] = bflo(w[q]); y[q][1] = bfhi(w[q]); ss += y[q][0] * y[q][0] + y[q][1] * y[q][1]; }
            ss += shx<1>(ss); ss += shx<2>(ss); ss += shx<4>(ss);
            const float rs = frsq(ss * (1.f / 64.f) + EPS);
#pragma unroll
            for (int q = 0; q < 4; ++q) { y[q][0] *= rs * gk[q][0]; y[q][1] *= rs * gk[q][1]; }
            rope4(y, cra, sra, cca, sca, 1.0f, w);
            if (lane < 16) {
#pragma unroll
                for (int q = 0; q < 4; ++q) p[dd + q * 8] = w[q]; }
        }
#pragma unroll
        for (int which = 0; which < 2; ++which) {
            unsigned* p = (unsigned*)(row + (which ? C_KR : C_QR) + (lane >> 4) * 128 + 2 * jr); unsigned w[4]; float y[4][2];
#pragma unroll
            for (int q = 0; q < 4; ++q) { w[q] = p[q * 16]; y[q][0] = bflo(w[q]); y[q][1] = bfhi(w[q]); }
            rope4(y, crr, srr, ccr, scr2, which ? 0.08838834764831845f : 1.0f, w);
#pragma unroll
            for (int q = 0; q < 4; ++q) p[dd + q * 16] = w[q];
        }
    }
}

__device__ __forceinline__ unsigned off_b(unsigned row, unsigned ch) { return 256u * row + 16u * (ch ^ (((row & 3) << 2) | ((row >> 2) & 3))); }
__device__ __forceinline__ bf16x8 rowread(const LAS unsigned char* tb, int rb, int s, int lane) {
    return *(const LAS bf16x8*)(tb + off_b(32 * rb + (lane & 31), 2 * s + (lane >> 5)));
}
__device__ __forceinline__ bf16x8 trread(const LAS unsigned char* tb, int c, int ks, int lane) {
    const unsigned h = lane >> 5, blk = (lane >> 4) & 1, q = (lane & 15) >> 2, p = lane & 3;
    const unsigned r0 = 16 * ks + 8 * h + q, ch = 4 * c + 2 * blk + (p >> 1);
    const s16x4 lo = __builtin_amdgcn_ds_read_tr16_b64_v4i16((LAS s16x4*)(tb + off_b(r0, ch) + 8 * (p & 1)));
    const s16x4 hi = __builtin_amdgcn_ds_read_tr16_b64_v4i16((LAS s16x4*)(tb + off_b(r0 + 4, ch) + 8 * (p & 1)));
    return (bf16x8){lo[0], lo[1], lo[2], lo[3], hi[0], hi[1], hi[2], hi[3]};
}
__device__ __forceinline__ int crow(int r, int hi) { return (r & 3) + 8 * (r >> 2) + 4 * hi; }
template <int MODE> __device__ __forceinline__ void stage_tile(LAS unsigned char* tb, const bf16* src, int pitch, int tid, float lg) {
#pragma unroll
    for (int i = 0; i < 4; ++i) { const int n = tid + NTHR * i, row = n >> 4, ch = n & 15;
        v4u v = *(const v4u*)(src + (size_t)row * pitch + ch * 8);
        if (MODE != 0) { const float f = fexp2((MODE == 1 ? (float)(127 - row) : (float)row) * lg);
            v.x = pkbf(bflo(v.x) * f, bfhi(v.x) * f); v.y = pkbf(bflo(v.y) * f, bfhi(v.y) * f); v.z = pkbf(bflo(v.z) * f, bfhi(v.z) * f); v.w = pkbf(bflo(v.w) * f, bfhi(v.w) * f); }
        *(LAS v4u*)(tb + off_b(row, ch)) = v; }
}
template <int NOUT> __device__ __forceinline__ void stage_rope_tile(LAS unsigned char* tb0, LAS unsigned char* tb1, const bf16* src, int pitch, int tid, int s0, float scale, float lgf, float lgb) {
    constexpr float L2T = 13.287712379549449f;
#pragma unroll 1
    for (int i2 = 0; i2 < 2; ++i2) { const int n = tid + NTHR * i2, row = n >> 3, cp = n & 7, c0 = (cp & 3) + ((cp >> 2) << 3);
        const bf16* rp = src + (size_t)row * pitch; const v4u va = *(const v4u*)(rp + c0 * 8), vb = *(const v4u*)(rp + (c0 + 4) * 8);
        const int s = s0 + row; const float pos = (cp & 4) ? (float)(s & 63) : (float)(s >> 6);
        const unsigned wa[4] = {va.x, va.y, va.z, va.w}, wb[4] = {vb.x, vb.y, vb.z, vb.w}; float oa[8], ob[8];
#pragma unroll
        for (int j = 0; j < 8; ++j) { const float fr = fexp2(-(float)(8 * (cp & 3) + j) * (L2T / 32.f)), ang = pos * fr, cs = __cosf(ang), sn = __sinf(ang);
            const float a = (j & 1) ? bfhi(wa[j >> 1]) : bflo(wa[j >> 1]), b = (j & 1) ? bfhi(wb[j >> 1]) : bflo(wb[j >> 1]);
            oa[j] = (a * cs - b * sn) * scale; ob[j] = (b * cs + a * sn) * scale; }
        if (NOUT == 1) {
            *(LAS v4u*)(tb0 + off_b(row, c0)) = (v4u){pkbf(oa[0], oa[1]), pkbf(oa[2], oa[3]), pkbf(oa[4], oa[5]), pkbf(oa[6], oa[7])};
            *(LAS v4u*)(tb0 + off_b(row, c0 + 4)) = (v4u){pkbf(ob[0], ob[1]), pkbf(ob[2], ob[3]), pkbf(ob[4], ob[5]), pkbf(ob[6], ob[7])};
        } else {
            const float ff = fexp2((float)(127 - row) * lgf), fb = fexp2((float)row * lgb);
            *(LAS v4u*)(tb0 + off_b(row, c0)) = (v4u){pkbf(oa[0] * ff, oa[1] * ff), pkbf(oa[2] * ff, oa[3] * ff), pkbf(oa[4] * ff, oa[5] * ff), pkbf(oa[6] * ff, oa[7] * ff)};
            *(LAS v4u*)(tb0 + off_b(row, c0 + 4)) = (v4u){pkbf(ob[0] * ff, ob[1] * ff), pkbf(ob[2] * ff, ob[3] * ff), pkbf(ob[4] * ff, ob[5] * ff), pkbf(ob[6] * ff, ob[7] * ff)};
            *(LAS v4u*)(tb1 + off_b(row, c0)) = (v4u){pkbf(oa[0] * fb, oa[1] * fb), pkbf(oa[2] * fb, oa[3] * fb), pkbf(oa[4] * fb, oa[5] * fb), pkbf(oa[6] * fb, oa[7] * fb)};
            *(LAS v4u*)(tb1 + off_b(row, c0 + 4)) = (v4u){pkbf(ob[0] * fb, ob[1] * fb), pkbf(ob[2] * fb, ob[3] * fb), pkbf(ob[4] * fb, ob[5] * fb), pkbf(ob[6] * fb, ob[7] * fb)};
        } }
}
__device__ __forceinline__ void rope_load(v4u (&raw)[2][2], const bf16* src, int pitch, int tid) {
#pragma unroll
    for (int i2 = 0; i2 < 2; ++i2) { const int n = tid + NTHR * i2, row = n >> 3, cp = n & 7, c0 = (cp & 3) + ((cp >> 2) << 3);
        const bf16* rp = src + (size_t)row * pitch; raw[i2][0] = *(const v4u*)(rp + c0 * 8); raw[i2][1] = *(const v4u*)(rp + (c0 + 4) * 8); }
}
template <int NOUT> __device__ __forceinline__ void rope_store(LAS unsigned char* tb0, LAS unsigned char* tb1, const v4u (&raw)[2][2], int tid, int s0, float scale, float lgf, float lgb) {
    constexpr float L2T = 13.287712379549449f;
#pragma unroll
    for (int i2 = 0; i2 < 2; ++i2) { __builtin_amdgcn_sched_barrier(0);
        const int n = tid + NTHR * i2, row = n >> 3, cp = n & 7, c0 = (cp & 3) + ((cp >> 2) << 3);
        const v4u va = raw[i2][0], vb = raw[i2][1];
        const int s = s0 + row; const float pos = (cp & 4) ? (float)(s & 63) : (float)(s >> 6);
        const unsigned wa[4] = {va.x, va.y, va.z, va.w}, wb[4] = {vb.x, vb.y, vb.z, vb.w}; float oa[8], ob[8];
#pragma unroll
        for (int j = 0; j < 8; ++j) { const float fr = fexp2(-(float)(8 * (cp & 3) + j) * (L2T / 32.f)), ang = pos * fr, cs = __cosf(ang), sn = __sinf(ang);
            const float a = (j & 1) ? bfhi(wa[j >> 1]) : bflo(wa[j >> 1]), b = (j & 1) ? bfhi(wb[j >> 1]) : bflo(wb[j >> 1]);
            oa[j] = (a * cs - b * sn) * scale; ob[j] = (b * cs + a * sn) * scale; }
        if (NOUT == 1) {
            *(LAS v4u*)(tb0 + off_b(row, c0)) = (v4u){pkbf(oa[0], oa[1]), pkbf(oa[2], oa[3]), pkbf(oa[4], oa[5]), pkbf(oa[6], oa[7])};
            *(LAS v4u*)(tb0 + off_b(row, c0 + 4)) = (v4u){pkbf(ob[0], ob[1]), pkbf(ob[2], ob[3]), pkbf(ob[4], ob[5]), pkbf(ob[6], ob[7])};
        } else {
            const float ff = fexp2((float)(127 - row) * lgf), fb = fexp2((float)row * lgb);
            *(LAS v4u*)(tb0 + off_b(row, c0)) = (v4u){pkbf(oa[0] * ff, oa[1] * ff), pkbf(oa[2] * ff, oa[3] * ff), pkbf(oa[4] * ff, oa[5] * ff), pkbf(oa[6] * ff, oa[7] * ff)};
            *(LAS v4u*)(tb0 + off_b(row, c0 + 4)) = (v4u){pkbf(ob[0] * ff, ob[1] * ff), pkbf(ob[2] * ff, ob[3] * ff), pkbf(ob[4] * ff, ob[5] * ff), pkbf(ob[6] * ff, ob[7] * ff)};
            *(LAS v4u*)(tb1 + off_b(row, c0)) = (v4u){pkbf(oa[0] * fb, oa[1] * fb), pkbf(oa[2] * fb, oa[3] * fb), pkbf(oa[4] * fb, oa[5] * fb), pkbf(oa[6] * fb, oa[7] * fb)};
            *(LAS v4u*)(tb1 + off_b(row, c0 + 4)) = (v4u){pkbf(ob[0] * fb, ob[1] * fb), pkbf(ob[2] * fb, ob[3] * fb), pkbf(ob[4] * fb, ob[5] * fb), pkbf(ob[6] * fb, ob[7] * fb)};
        } }
}
__device__ __forceinline__ void vtile_load(v4u (&raw)[4], const bf16* src, int pitch, int tid) {
#pragma unroll
    for (int i = 0; i < 4; ++i) { const int n = tid + NTHR * i, row = n >> 4, ch = n & 15; raw[i] = *(const v4u*)(src + (size_t)row * pitch + ch * 8); }
}
__device__ __forceinline__ void vtile_store(LAS unsigned char* tb, const v4u (&raw)[4], int tid) {
#pragma unroll
    for (int i = 0; i < 4; ++i) { const int n = tid + NTHR * i, row = n >> 4, ch = n & 15; *(LAS v4u*)(tb + off_b(row, ch)) = raw[i]; }
}
__device__ __forceinline__ void r1_states(Frame& F, const bf16* PROJ, bf16* U, const float* dec_f, const float* dec_b) {
    LAS unsigned char* TKf = F.lds, *TKb = F.lds + 32768, *TV = F.lds + 65536;
    const int lane = F.lane, w = F.wave, hi = lane >> 5, mb = w & 3, nb0 = 2 * (w >> 2);
    for (int u = F.vcu; u < RUNITS; u += F.G) {
        const int b = u >> 8, h = (u >> 6) & 3, c = u & 63;
        const float lgf = dec_f[h] * LOG2E, lgb = dec_b[h] * LOG2E;
        const bf16* base = PROJ + ((size_t)b * T + (size_t)c * RCH) * INW + h * 128;
        { v4u rk[2][2], rv[4]; rope_load(rk, base + C_KR, INW, F.tid); vtile_load(rv, base + C_VR, INW, F.tid);
          rope_store<2>(TKf, TKb, rk, F.tid, c * RCH, 0.08838834764831845f, lgf, lgb);
          vtile_store(TV, rv, F.tid); }
        __syncthreads();
        f32x16 acc[2][2];
#pragma unroll
        for (int d = 0; d < 2; ++d)
#pragma unroll
            for (int n = 0; n < 2; ++n) acc[d][n] = (f32x16){};
#pragma unroll 2
        for (int ks = 0; ks < 8; ++ks) {
            const bf16x8 a = trread(TV, mb, ks, lane);
#pragma unroll
            for (int n = 0; n < 2; ++n) { const bf16x8 bf = trread(TKf, nb0 + n, ks, lane), bb = trread(TKb, nb0 + n, ks, lane);
                acc[0][n] = __builtin_amdgcn_mfma_f32_32x32x16_bf16(bf, a, acc[0][n], 0, 0, 0);
                acc[1][n] = __builtin_amdgcn_mfma_f32_32x32x16_bf16(bb, a, acc[1][n], 0, 0, 0); }
        }
#pragma unroll
        for (int d = 0; d < 2; ++d)
#pragma unroll
            for (int n = 0; n < 2; ++n) { bf16* o = U + ((size_t)u * 2 + d) * 16384 + (size_t)(32 * mb + (lane & 31)) * 128 + 32 * (nb0 + n) + 4 * hi;
#pragma unroll
                for (int g = 0; g < 4; ++g) { u32x2 w; w.x = pkbf(acc[d][n][4 * g], acc[d][n][4 * g + 1]); w.y = pkbf(acc[d][n][4 * g + 2], acc[d][n][4 * g + 3]); *(u32x2*)(o + 8 * g) = w; } }
        __syncthreads();
    }
}
__device__ __forceinline__ void r2_scan(Frame& F, const bf16* __restrict__ U, bf16* __restrict__ FT, const float* dec_f, const float* dec_b) {
    for (int task = blockIdx.x * NTHR + F.tid; task < BATCH * RH * 4096; task += F.G * NTHR) {
        const int bh = task >> 12, e4 = task & 4095, h = bh & 3;
        const float df = __expf(dec_f[h] * 128.f), db = __expf(dec_b[h] * 128.f);
        const size_t base = ((size_t)bh * NCH * 2) * 16384 + 4 * e4;
#define R2_LOAD(BUF, c0, DIR, STEP) do { _Pragma("unroll") for (int k = 0; k < 8; ++k) BUF[k] = *(const u32x2*)(U + base + ((size_t)((c0) + (STEP) * k) * 2 + (DIR)) * 16384); } while (0)
#define R2_PROC(BUF, c0, DIR, STEP, DEC) do { _Pragma("unroll") for (int k = 0; k < 8; ++k) { u32x2 w; w.x = pkbf(s.x, s.y); w.y = pkbf(s.z, s.w); \
            *(u32x2*)(FT + base + ((size_t)((c0) + (STEP) * k) * 2 + (DIR)) * 16384) = w; const u32x2 uw = BUF[k]; s = s * (DEC) + (f32x4){bflo(uw.x), bfhi(uw.x), bflo(uw.y), bfhi(uw.y)}; } } while (0)
        u32x2 bA[8], bB[8];
        f32x4 s = (f32x4){0.f, 0.f, 0.f, 0.f};
        R2_LOAD(bA, 0, 0, 1);
#pragma unroll 1
        for (int c0 = 0; c0 < NCH; c0 += 16) {
            R2_LOAD(bB, c0 + 8, 0, 1);
            R2_PROC(bA, c0, 0, 1, df);
            if (c0 + 16 < NCH) R2_LOAD(bA, c0 + 16, 0, 1);
            R2_PROC(bB, c0 + 8, 0, 1, df);
        }
        s = (f32x4){0.f, 0.f, 0.f, 0.f};
        R2_LOAD(bA, NCH - 1, 1, -1);
#pragma unroll 1
        for (int c0 = NCH - 1; c0 >= 0; c0 -= 16) {
            R2_LOAD(bB, c0 - 8, 1, -1);
            R2_PROC(bA, c0, 1, -1, db);
            if (c0 - 16 >= 0) R2_LOAD(bA, c0 - 16, 1, -1);
            R2_PROC(bB, c0 - 8, 1, -1, db);
        }
#undef R2_LOAD
#undef R2_PROC
    }
}
__device__ __forceinline__ void r3_out(Frame& F, const bf16* PROJ, const bf16* FT, bf16* CAT, const float* dec_f, const float* dec_b, const float* gn_g, const float* gn_b) {
    LAS unsigned char* TQ = F.lds, *TK = F.lds + 32768, *TV = F.lds + 65536, *TP = F.lds + 98304;
    LAS float* OT = (LAS float*)F.lds;
    const int w = F.wave, wb = w & 3, wp0 = 2 * (w >> 2);
    for (int u = F.vcu; u < RUNITS; u += F.G) {
        int lane = F.lane, tid_u = F.tid; asm volatile("" : "+v"(lane), "+v"(tid_u));
        const int hi = lane >> 5, l31 = lane & 31;
        const int b = u >> 8, h = (u >> 6) & 3, c = u & 63;
        const float lgf = dec_f[h] * LOG2E, lgb = dec_b[h] * LOG2E;
        const size_t m0 = (size_t)b * T + (size_t)c * RCH;
        const bf16* base = PROJ + m0 * INW + h * 128;
        const int gi = tid_u >> 2, gqd = tid_u & 3, gcol = h * 128 + 32 * gqd;
        const bf16* gp = PROJ + (m0 + gi) * INW + C_GR + gcol;
        v4u gw[4];
#pragma unroll
        for (int k2 = 0; k2 < 4; ++k2) gw[k2] = *(const v4u*)(gp + 8 * k2);
        bf16x8 cf[4][2], cb[4][2];
        const bf16* ftf = FT + ((size_t)u * 2 + 0) * 16384 + (size_t)(32 * wp0 + l31) * 128 + 8 * hi;
#pragma unroll
        for (int s = 0; s < 4; ++s)
#pragma unroll
            for (int n = 0; n < 2; ++n) { cf[s][n] = *(const bf16x8*)(ftf + n * 32 * 128 + 16 * s); cb[s][n] = *(const bf16x8*)(ftf + 16384 + n * 32 * 128 + 16 * s); }
        { v4u rq[2][2], rk[2][2], rv[4];
          rope_load(rq, base + C_QR, INW, tid_u); rope_load(rk, base + C_KR, INW, tid_u); vtile_load(rv, base + C_VR, INW, tid_u);
          __builtin_amdgcn_sched_barrier(0);
          rope_store<1>(TQ, TQ, rq, tid_u, c * RCH, 1.0f, 0.f, 0.f);
          rope_store<1>(TK, TK, rk, tid_u, c * RCH, 0.08838834764831845f, 0.f, 0.f);
          __builtin_amdgcn_sched_barrier(0);
          vtile_store(TV, rv, tid_u); }
        __syncthreads();
        {
            f32x16 st[2]; st[0] = (f32x16){}; st[1] = (f32x16){};
#pragma unroll 1
            for (int s = 0; s < 8; ++s) { const bf16x8 a = rowread(TK, wb, s, lane);
#pragma unroll
                for (int n = 0; n < 2; ++n) st[n] = __builtin_amdgcn_mfma_f32_32x32x16_bf16(a, rowread(TQ, wp0 + n, s, lane), st[n], 0, 0, 0); }
#pragma unroll
            for (int n = 0; n < 2; ++n) { const int i = 32 * (wp0 + n) + l31; __builtin_amdgcn_sched_barrier(0);
#pragma unroll
                for (int g = 0; g < 4; ++g) { float p[4];
#pragma unroll
                    for (int q = 0; q < 4; ++q) { const int j = 32 * wb + 8 * g + 4 * hi + q; const float fd = (float)(i - j);
                        const float mk = fexp2(fmaxf(fd, 0.f) * lgf + fmaxf(-fd, 0.f) * lgb) + fmaxf(1.0f - fabsf(fd), 0.f);
                        p[q] = st[n][4 * g + q] * mk; }
                    u32x2 pw; pw.x = pkbf(p[0], p[1]); pw.y = pkbf(p[2], p[3]);
                    *(LAS u32x2*)(TP + off_b(i, 4 * wb + g) + 8 * hi) = pw; } }
        }
        __syncthreads();
        f32x16 ao[2];
#pragma unroll
        for (int n = 0; n < 2; ++n) ao[n] = (f32x16){};
        {
            const float xf = fexp2((float)(32 * wb + l31 + 1) * lgf), xb = fexp2((float)(128 - 32 * wb - l31) * lgb);
#pragma unroll
            for (int s = 0; s < 8; ++s) { __builtin_amdgcn_sched_barrier(0); const bf16x8 ap = rowread(TP, wb, s, lane); const v4u aq = *(const LAS v4u*)(TQ + off_b(32 * wb + l31, 2 * s + hi));
                v4u qf, qb;
                qf.x = pkbf(bflo(aq.x) * xf, bfhi(aq.x) * xf); qf.y = pkbf(bflo(aq.y) * xf, bfhi(aq.y) * xf); qf.z = pkbf(bflo(aq.z) * xf, bfhi(aq.z) * xf); qf.w = pkbf(bflo(aq.w) * xf, bfhi(aq.w) * xf);
                qb.x = pkbf(bflo(aq.x) * xb, bfhi(aq.x) * xb); qb.y = pkbf(bflo(aq.y) * xb, bfhi(aq.y) * xb); qb.z = pkbf(bflo(aq.z) * xb, bfhi(aq.z) * xb); qb.w = pkbf(bflo(aq.w) * xb, bfhi(aq.w) * xb);
                const bf16x8 aqf = __builtin_bit_cast(bf16x8, qf), aqb = __builtin_bit_cast(bf16x8, qb);
#pragma unroll
                for (int n = 0; n < 2; ++n) {
                    ao[n] = __builtin_amdgcn_mfma_f32_32x32x16_bf16(ap, trread(TV, wp0 + n, s, lane), ao[n], 0, 0, 0);
                    ao[n] = __builtin_amdgcn_mfma_f32_32x32x16_bf16(aqf, cf[s & 3][n], ao[n], 0, 0, 0);
                    ao[n] = __builtin_amdgcn_mfma_f32_32x32x16_bf16(aqb, cb[s & 3][n], ao[n], 0, 0, 0); }
                if (s < 4) {
#pragma unroll
                    for (int n = 0; n < 2; ++n) { cf[s][n] = *(const bf16x8*)(ftf + n * 32 * 128 + 16 * (s + 4)); cb[s][n] = *(const bf16x8*)(ftf + 16384 + n * 32 * 128 + 16 * (s + 4)); } } }
        }
        __syncthreads();
#pragma unroll
        for (int r = 0; r < 16; ++r) { const int i = 32 * wb + crow(r, hi);
#pragma unroll
            for (int n = 0; n < 2; ++n) OT[i * 132 + 32 * (wp0 + n) + l31] = ao[n][r]; }
        __syncthreads();
        {
            const int i = tid_u >> 2, qd = tid_u & 3;
            f32x4 v[8]; float s1 = 0.f, s2 = 0.f;
#pragma unroll
            for (int k = 0; k < 8; ++k) { v[k] = *(const LAS f32x4*)(OT + i * 132 + 32 * qd + 4 * k); s1 += (v[k].x + v[k].y) + (v[k].z + v[k].w);
                s2 += (v[k].x * v[k].x + v[k].y * v[k].y) + (v[k].z * v[k].z + v[k].w * v[k].w); }
            s1 += shx<1>(s1); s1 += shx<2>(s1); s2 += shx<1>(s2); s2 += shx<2>(s2);
            const float mu = s1 * (1.f / 128.f), var = fmaxf(s2 * (1.f / 128.f) - mu * mu, 0.f), rs = frsq(var + EPS);
            const int col = h * 128 + 32 * qd;
            unsigned char* op = (unsigned char*)CAT + (m0 + i) * D + 512 + col;
            f32x4 gg[8], gbv[8];
#pragma unroll
            for (int k = 0; k < 8; ++k) { gg[k] = *(const f32x4*)(gn_g + col + 4 * k); gbv[k] = *(const f32x4*)(gn_b + col + 4 * k); }
#pragma unroll
            for (int k2 = 0; k2 < 4; ++k2) { __builtin_amdgcn_sched_barrier(0); const v4u gw4 = gw[k2]; const unsigned gwv[4] = {gw4.x, gw4.y, gw4.z, gw4.w}; float o[8];
#pragma unroll
                for (int q = 0; q < 8; ++q) { const int cc = 8 * k2 + q; const float x = v[cc >> 2][cc & 3];
                    const float y = (x - mu) * rs * gg[cc >> 2][cc & 3] + gbv[cc >> 2][cc & 3];
                    const float gt = (q & 1) ? bfhi(gwv[q >> 1]) : bflo(gwv[q >> 1]);
                    o[q] = y * gt * frcp(1.0f + __expf(-gt)); }
#pragma unroll
                for (int q = 0; q < 8; ++q) o[q] = __builtin_amdgcn_fmed3f(o[q] * CAT_S_RET, -448.0f, 448.0f);
                unsigned w0 = 0u, w1 = 0u;
                w0 = __builtin_amdgcn_cvt_pk_fp8_f32(o[0], o[1], w0, false); w0 = __builtin_amdgcn_cvt_pk_fp8_f32(o[2], o[3], w0, true);
                w1 = __builtin_amdgcn_cvt_pk_fp8_f32(o[4], o[5], w1, false); w1 = __builtin_amdgcn_cvt_pk_fp8_f32(o[6], o[7], w1, true);
                *(u32x2*)(op + 8 * k2) = (u32x2){w0, w1}; }
        }
        __syncthreads();
    }
}

#if defined(ATTN_PROBE)
__device__ __forceinline__ void attn_check(Frame& F, const bf16* PROJ, const bf16* CAT, gu32* flag, const float* qg) {
    const int lane = F.lane, s = F.vcu * NWAVES + F.wave;
    const int b = s & 7, h = (s >> 3) & 7, qpos = (s * 977 + 131) & (T - 1), kvh = h >> 2;
    const bf16* qrow = PROJ + ((size_t)b * T + qpos) * INW + C_QA + h * 64;
    float qf[64], o[64];
    {
        const float raw = __uint_as_float((unsigned)qrow[lane] << 16);
        const float ss = wave_sum(raw * raw), y = raw * (1.0f / sqrtf(ss * (1.f / 64.f) + 1e-6f)) * qg[lane];
        const int quarter = lane >> 4, i = lane & 15; const float partner = shx<16>(y);
        const float invf = exp2f(-(float)i * (13.287712379549449f / 16.f)), ang = ((quarter < 2) ? (float)(qpos >> 6) : (float)(qpos & 63)) * invf;
        const float cs = __cosf(ang), sn = __sinf(ang);
        const float rot = (quarter & 1) ? (y * cs + partner * sn) : (y * cs - partner * sn);
        const float qv = rot * (0.125f * 1.4426950408889634f);
#pragma unroll
        for (int d = 0; d < 64; ++d) qf[d] = __int_as_float(bcastl(__float_as_int(qv), d));
    }
#pragma unroll
    for (int d = 0; d < 64; ++d) o[d] = 0.f;
    float m = -1e30f, l = 0.f;
    for (int i = 0; i < T / 64; ++i) {
        const size_t krow = ((size_t)b * T + i * 64 + lane) * INW;
        const bf16* kp = PROJ + krow + C_KA + kvh * 64; const bf16* vp = PROJ + krow + C_VA + kvh * 64;
        float sc = 0.f;
#pragma unroll
        for (int c = 0; c < 8; ++c) { const v4u w = *(const v4u*)(kp + 8 * c);
            sc += qf[8 * c + 0] * bflo(w.x) + qf[8 * c + 1] * bfhi(w.x) + qf[8 * c + 2] * bflo(w.y) + qf[8 * c + 3] * bfhi(w.y) + qf[8 * c + 4] * bflo(w.z) + qf[8 * c + 5] * bfhi(w.z) + qf[8 * c + 6] * bflo(w.w) + qf[8 * c + 7] * bfhi(w.w); }
        const float mn = fmaxf(m, sc), fs = fexp2(m - mn), p = fexp2(sc - mn);
        l = l * fs + p; m = mn;
#pragma unroll
        for (int c = 0; c < 8; ++c) { const v4u w = *(const v4u*)(vp + 8 * c);
            o[8 * c + 0] = o[8 * c + 0] * fs + p * bflo(w.x); o[8 * c + 1] = o[8 * c + 1] * fs + p * bfhi(w.x); o[8 * c + 2] = o[8 * c + 2] * fs + p * bflo(w.y); o[8 * c + 3] = o[8 * c + 3] * fs + p * bfhi(w.y);
            o[8 * c + 4] = o[8 * c + 4] * fs + p * bflo(w.z); o[8 * c + 5] = o[8 * c + 5] * fs + p * bfhi(w.z); o[8 * c + 6] = o[8 * c + 6] * fs + p * bflo(w.w); o[8 * c + 7] = o[8 * c + 7] * fs + p * bfhi(w.w); }
    }
    float mm = m;
    mm = wmax64(mm);
    const float f = fexp2(m - mm); const float L = wave_sum(l * f);
    float mine = 0.f;
#pragma unroll
    for (int d = 0; d < 64; ++d) { const float od = wave_sum(o[d] * f) / L; if (lane == d) mine = od; }
    const unsigned short cw = CAT[((size_t)b * T + qpos) * D + h * 64 + lane];
    const float got = __uint_as_float((unsigned)cw << 16);
    const float E = wave_sum((mine - got) * (mine - got)), R = wave_sum(mine * mine);
    if (!(E <= 4e-4f * R) && lane == 0) __hip_atomic_store(flag, 1u, RLX_AGENT);
}
__device__ __forceinline__ void ka_expect(Frame& F, const bf16* PROJ, float* EXP, const float* kg) {
    const int lane = F.lane, s = F.vcu * NWAVES + F.wave, m = (s * 40503 + 77) & (M - 1), pos = m & (T - 1);
    for (int hk = 0; hk < 2; ++hk) {
        const float raw = __uint_as_float((unsigned)PROJ[(size_t)m * INW + C_KA + hk * 64 + lane] << 16);
        const float ss = wave_sum(raw * raw), y = raw * (1.0f / sqrtf(ss * (1.f / 64.f) + 1e-6f)) * kg[lane];
        const int quarter = lane >> 4, i = lane & 15; const float partner = shx<16>(y);
        const float invf = exp2f(-(float)i * (13.287712379549449f / 16.f)), ang = ((quarter < 2) ? (float)(pos >> 6) : (float)(pos & 63)) * invf;
        const float cs = __cosf(ang), sn = __sinf(ang);
        EXP[(size_t)s * 128 + hk * 64 + lane] = (quarter & 1) ? (y * cs + partner * sn) : (y * cs - partner * sn);
    }
}
__device__ __forceinline__ void ka_compare(Frame& F, const bf16* PROJ, const float* EXP, gu32* flag) {
    const int lane = F.lane, s = F.vcu * NWAVES + F.wave, m = (s * 40503 + 77) & (M - 1);
    float E = 0.f, R = 0.f;
    for (int hk = 0; hk < 2; ++hk) { const float got = __uint_as_float((unsigned)PROJ[(size_t)m * INW + C_KA + hk * 64 + lane] << 16), ex = EXP[(size_t)s * 128 + hk * 64 + lane];
        E += (got - ex) * (got - ex); R += ex * ex; }
    E = wave_sum(E); R = wave_sum(R);
    if (!(E <= 1e-4f * R) && lane == 0) __hip_atomic_store(flag, 1u, RLX_AGENT);
}
#endif

typedef _Float16 f16x8 __attribute__((ext_vector_type(8)));
typedef _Float16 f16x4 __attribute__((ext_vector_type(4)));
template <bool X16, bool XIN16 = false> __device__ __forceinline__ void p3b_postmix(Frame& F, const float* xin, float* xout, const bf16* YM, signed char* HQ, float* hs, const float* mod_l,
                                            const float* post_g, const float* pre_g, const float* rw, const float* rb, int* topi, float* topw, gu32* cnt_g) {
    const int lane = F.lane, gw = F.vcu * NWAVES + F.wave, NGW = F.G * NWAVES;
    LAS unsigned char* WT = F.lds;
    LAS unsigned char* AT = F.lds + 65536 + F.wave * 8192;
    LAS unsigned* lcnt = (LAS unsigned*)(F.lds + LCNT_OFF);
#pragma unroll
    for (int i = 0; i < 16; ++i) { const int n = F.tid + NTHR * i, k = n >> 3, e0 = (n & 7) * 4; const f32x4 v = *(const f32x4*)(rw + (size_t)k * NE + e0);
#pragma unroll
        for (int q = 0; q < 4; ++q) { const int e = e0 + q; *(LAS _Float16*)(WT + e * 2048 + (((k >> 3) ^ (e & 15)) << 4) + (k & 7) * 2) = (_Float16)v[q]; } }
    if (F.tid < 32) lcnt[F.tid] = 0u;
    LAS float* GL = (LAS float*)(F.lds + GAIN_OFF);
    { const f32x4 g0 = ((const f32x4*)post_g)[F.tid & 255], g1 = ((const f32x4*)pre_g)[F.tid & 255]; if (F.tid < 256) { ((LAS f32x4*)GL)[F.tid] = g0; ((LAS f32x4*)(GL + D))[F.tid] = g1; } }
    __syncthreads();
    const float rbias = rb[lane & 31];
    const int ar = lane & 3, kg = lane >> 4, be = lane & 15;
    for (int ch = gw; ch < M / 32; ch += NGW) { const int mb = ch * 32;
        const float* modb = mod_l + (size_t)(mb >> 13) * (6 * D);
        f32x4 gpv[4], gsv[4], shv[4];
#pragma unroll
        for (int j = 0; j < 4; ++j) { const f32x4 gm = ((const f32x4*)(modb + 2 * D))[lane + 64 * j], sc = ((const f32x4*)(modb + 4 * D))[lane + 64 * j]; shv[j] = ((const f32x4*)(modb + 3 * D))[lane + 64 * j];
            gpv[j] = gm * ((const LAS f32x4*)GL)[lane + 64 * j]; gsv[j] = ((const LAS f32x4*)(GL + D))[lane + 64 * j] * (sc + 1.0f); }
        u32x2 ywA[2][4], ywB[2][4]; f32x4 xrA[2][4], xrB[2][4];
#define P3B_ISSUE(YW, XR, t0) do { _Pragma("unroll") for (int rr = 0; rr < 2; ++rr) { const u32x2* yr = (const u32x2*)(YM + (size_t)(mb + (t0) + rr) * D) + lane; \
            _Pragma("unroll") for (int j = 0; j < 4; ++j) YW[rr][j] = yr[64 * j]; \
            if constexpr (XIN16) { const u32x2* xq = (const u32x2*)((const bf16*)xin + (size_t)(mb + (t0) + rr) * D) + lane; _Pragma("unroll") for (int j = 0; j < 4; ++j) { const u32x2 w = xq[64 * j]; XR[rr][j].x = __uint_as_float(w.x); XR[rr][j].y = __uint_as_float(w.y); } } \
            else load_row_f32(xin + (size_t)(mb + (t0) + rr) * D, XR[rr], lane); } } while (0)
#define P3B_PROC(YW, XR, t0, RB) do { _Pragma("unroll") for (int rr = 0; rr < 2; ++rr) { const int m = mb + (t0) + rr, r = (RB) + rr; \
            f32x4 y[4], x[4], hf[4]; \
            _Pragma("unroll") for (int j = 0; j < 4; ++j) { const u32x2 w = YW[rr][j]; y[j] = (f32x4){bflo(w.x), bfhi(w.x), bflo(w.y), bfhi(w.y)}; \
                if constexpr (XIN16) { const unsigned xa = __float_as_uint(XR[rr][j].x), xb = __float_as_uint(XR[rr][j].y); x[j] = (f32x4){bflo(xa), bfhi(xa), bflo(xb), bfhi(xb)}; } else x[j] = XR[rr][j]; } \
            const float rsy = row_rstd(y); \
            _Pragma("unroll") for (int j = 0; j < 4; ++j) { x[j] = x[j] + gpv[j] * (y[j] * rsy); if constexpr (!X16) ((f32x4*)(xout + (size_t)m * D))[lane + 64 * j] = x[j]; } \
            if constexpr (X16) store_row_bf16((bf16*)xout + (size_t)m * D, x, lane); \
            { const float rs = row_rstd(x); _Pragma("unroll") for (int j = 0; j < 4; ++j) hf[j] = x[j] * rs * gsv[j] + shv[j]; } \
            store_row_i8(HQ + (size_t)m * D, hs + m, hf, lane);                    \
            _Pragma("unroll") for (int j = 0; j < 4; ++j) { const int c = (lane >> 1) + 32 * j;        \
                *(LAS f16x4*)(AT + r * 2048 + ((c ^ (r << 2)) << 4) + 8 * (lane & 1)) = (f16x4){(_Float16)hf[j].x, (_Float16)hf[j].y, (_Float16)hf[j].z, (_Float16)hf[j].w}; } } } while (0)
        P3B_ISSUE(ywA, xrA, 0);
#pragma unroll 1
        for (int it = 0; it < 8; ++it) { const int m0 = mb + 4 * it;
        P3B_ISSUE(ywB, xrB, 4 * it + 2);
        P3B_PROC(ywA, xrA, 4 * it, 0);
        if (it < 7) P3B_ISSUE(ywA, xrA, 4 * it + 4);
        P3B_PROC(ywB, xrB, 4 * it + 2, 2);
        f32x4 la = (f32x4){0.f, 0.f, 0.f, 0.f}, lb = (f32x4){0.f, 0.f, 0.f, 0.f};
#pragma unroll 8
        for (int s = 0; s < 32; ++s) { const int c = 4 * s + kg;
            const f16x8 a = *(const LAS f16x8*)(AT + ar * 2048 + ((c ^ (ar << 2)) << 4));
            const f16x8 b0 = *(const LAS f16x8*)(WT + be * 2048 + ((c ^ be) << 4)), b1 = *(const LAS f16x8*)(WT + (16 + be) * 2048 + ((c ^ be) << 4));
            la = __builtin_amdgcn_mfma_f32_16x16x32_f16(a, b0, la, 0, 0, 0); lb = __builtin_amdgcn_mfma_f32_16x16x32_f16(a, b1, lb, 0, 0, 0); }
        const bool upper = (lane & 32) != 0, blk = (lane & 16) != 0;
#pragma unroll
        for (int pr = 0; pr < 2; ++pr) {
            const float lo_ = blk ? lb[pr] : la[pr], up_ = blk ? lb[pr + 2] : la[pr + 2];
            const float logit = (upper ? up_ : lo_) + rbias;
            const int m = m0 + pr + (upper ? 2 : 0);
            bool taken = false; float tv[TOPK]; int ti[TOPK];
#pragma unroll
            for (int k = 0; k < TOPK; ++k) { float bv = taken ? -INFINITY : logit; int bi = lane & 31;
#define MX_STEP(o) { const float ov = shx<(o)>(bv); const int oi = shxi<(o)>(bi); const bool tk = (ov > bv) || (ov == bv && oi < bi); bv = tk ? ov : bv; bi = tk ? oi : bi; }
                MX_STEP(16) MX_STEP(8) MX_STEP(4) MX_STEP(2) MX_STEP(1)
#undef MX_STEP
                tv[k] = bv; ti[k] = bi; if ((lane & 31) == bi) taken = true; }
            const float e1 = __expf(tv[1] - tv[0]), e2 = __expf(tv[2] - tv[0]), e3 = __expf(tv[3] - tv[0]), inv = frcp(1.0f + e1 + e2 + e3);
            if ((lane & 31) == 0) { *(i32x4*)(topi + (size_t)m * 4) = (i32x4){ti[0], ti[1], ti[2], ti[3]}; *(f32x4*)(topw + (size_t)m * 4) = (f32x4){inv, e1 * inv, e2 * inv, e3 * inv}; }
            if (taken) atomicAdd((unsigned*)(lcnt + (lane & 31)), 1u);
        }
        }
#undef P3B_ISSUE
#undef P3B_PROC
    }
    __syncthreads();
    if (F.tid < 32) { const unsigned c = lcnt[F.tid]; if (c) __hip_atomic_fetch_add(cnt_g + F.tid, c, RLX_AGENT); }
}
__device__ __forceinline__ void p4a_route(Frame& F, const float* hs, int* rmap, float* xsc, const int* topi, int* pos, gu32* cnt_g, gu32* cur_g) {
    const int gw = F.vcu * NWAVES + F.wave, NGW = F.G * NWAVES;
    LAS int* ts = (LAS int*)(F.lds + LTS_OFF);
    if (F.tid == 0) { int a = 0; for (int e = 0; e < NE; ++e) { ts[e] = a; a += (int)((__hip_atomic_load(cnt_g + e, RLX_AGENT) + 255u) >> 8); } ts[NE] = a; }
    __syncthreads();
    const int lane = F.lane;
    if (gw < NE) {
        const int c = (int)__hip_atomic_load(cnt_g + gw, RLX_AGENT), p0 = ts[gw] * 256 + c, p1 = ts[gw + 1] * 256;
        for (int p = p0 + lane; p < p1; p += 64) rmap[p] = 0;
    }
    for (int base = gw * 64; base < M; base += NGW * 64) {
        const int tok = base + lane; const i32x4 id = *(const i32x4*)(topi + (size_t)tok * 4);
        unsigned mycnt = 0u;
#pragma unroll 1
        for (int e = 0; e < NE; ++e) { const unsigned long long mk = __ballot(id.x == e || id.y == e || id.z == e || id.w == e); if (lane == e) mycnt = (unsigned)__popcll(mk); }
        unsigned mybase = 0u;
        if (lane < NE && mycnt) mybase = __hip_atomic_fetch_add(cur_g + lane, mycnt, RLX_AGENT);
        i32x4 ps = (i32x4){0, 0, 0, 0};
#pragma unroll 1
        for (int e = 0; e < NE; ++e) { const bool has = (id.x == e || id.y == e || id.z == e || id.w == e); const unsigned long long mk = __ballot(has);
            const int p = ts[e] * 256 + bcastl((int)mybase, e) + (int)__builtin_amdgcn_mbcnt_hi((unsigned)(mk >> 32), __builtin_amdgcn_mbcnt_lo((unsigned)mk, 0u));
            if (id.x == e) ps.x = p; if (id.y == e) ps.y = p; if (id.z == e) ps.z = p; if (id.w == e) ps.w = p; }
        *(i32x4*)(pos + (size_t)tok * 4) = ps;
        { const float sc = hs[tok]; xsc[ps.x] = sc; xsc[ps.y] = sc; xsc[ps.z] = sc; xsc[ps.w] = sc; rmap[ps.x] = tok; rmap[ps.y] = tok; rmap[ps.z] = tok; rmap[ps.w] = tok; }
    }
}
template <bool Y_F8, bool X16, bool XOUT16 = false> __device__ __forceinline__ void p5b_combine(Frame& F, const float* xin, float* xout, const bf16* Y,
                                            const int* pos, const float* topw, const float* mod_l, const float* post_g,
                                            bool has_next, const float* mod_n, const float* pre_g_n, signed char* HQ, float* hs) {
    const int lane = F.lane, gw = F.vcu * NWAVES + F.wave, NGW = F.G * NWAVES;
    for (int ch = gw; ch < M / 32; ch += NGW) { const int mb = ch * 32;
        const float* modb = mod_l + (size_t)(mb >> 13) * (6 * D); const float* modn = mod_n + (size_t)(mb >> 13) * (6 * D);
        f32x4 gpv[4], gsv[4], shv[4];
#pragma unroll
        for (int j = 0; j < 4; ++j) { gpv[j] = ((const f32x4*)post_g)[lane + 64 * j] * ((const f32x4*)(modb + 5 * D))[lane + 64 * j];
            gsv[j] = ((const f32x4*)pre_g_n)[lane + 64 * j] * (((const f32x4*)(modn + D))[lane + 64 * j] + 1.0f); shv[j] = ((const f32x4*)modn)[lane + 64 * j]; }
        const i32x4 myps = *(const i32x4*)(pos + (size_t)(mb + (lane & 31)) * 4); const f32x4 mywt = *(const f32x4*)(topw + (size_t)(mb + (lane & 31)) * 4);
        u32x2 ywA[2][TOPK][4], ywB[2][TOPK][4], xwA[2][4], xwB[2][4]; f32x4 xfA[2][4], xfB[2][4];
#define P5B_ISSUE(YW, XW, XF, t0) do { _Pragma("unroll") for (int r = 0; r < 2; ++r) { const int t_ = (t0) + r; \
            _Pragma("unroll") for (int k = 0; k < TOPK; ++k) { const int p_ = __builtin_amdgcn_readlane(myps[k], t_); \
                if constexpr (Y_F8) { const int c0 = 4 * lane; const unsigned* yr = (const unsigned*)((const unsigned char*)Y + (size_t)p_ * D + 64 * ((c0 >> 5) & 3) + 16 * ((c0 >> 3) & 3) + 8 * (c0 >> 7) + (c0 & 7)); \
                    _Pragma("unroll") for (int j = 0; j < 4; ++j) { YW[r][k][j].x = yr[64 * j]; YW[r][k][j].y = 0u; } } \
                else { const u32x2* yr = (const u32x2*)(Y + (size_t)p_ * D) + lane; _Pragma("unroll") for (int j = 0; j < 4; ++j) YW[r][k][j] = yr[64 * j]; } } \
            if constexpr (X16) { const u32x2* xr = (const u32x2*)((const bf16*)xin + (size_t)(mb + t_) * D) + lane; _Pragma("unroll") for (int j = 0; j < 4; ++j) XW[r][j] = xr[64 * j]; } \
            else load_row_f32(xin + (size_t)(mb + t_) * D, XF[r], lane); } } while (0)
#define P5B_PROC(YW, XW, XF, t0) do { _Pragma("unroll") for (int r = 0; r < 2; ++r) { const int t_ = (t0) + r, m = mb + t_; f32x4 y[4], x[4]; \
            float wk[TOPK]; _Pragma("unroll") for (int k = 0; k < TOPK; ++k) wk[k] = __int_as_float(__builtin_amdgcn_readlane(__float_as_int(mywt[k]), t_)); \
            _Pragma("unroll") for (int j = 0; j < 4; ++j) { y[j] = (f32x4){0.f, 0.f, 0.f, 0.f}; \
                _Pragma("unroll") for (int k = 0; k < TOPK; ++k) { const u32x2 w = YW[r][k][j]; \
                    if constexpr (Y_F8) { typedef float f32x2p __attribute__((ext_vector_type(2))); const f32x2p lo = __builtin_amdgcn_cvt_pk_f32_fp8(w.x, false), hi2 = __builtin_amdgcn_cvt_pk_f32_fp8(w.x, true); \
                        y[j] += (f32x4){lo.x, lo.y, hi2.x, hi2.y} * wk[k]; } \
                    else y[j] += (f32x4){bflo(w.x), bfhi(w.x), bflo(w.y), bfhi(w.y)} * wk[k]; } \
                if constexpr (X16) { const u32x2 w = XW[r][j]; x[j] = (f32x4){bflo(w.x), bfhi(w.x), bflo(w.y), bfhi(w.y)}; } else x[j] = XF[r][j]; } \
            const float rsy = row_rstd(y); \
            _Pragma("unroll") for (int j = 0; j < 4; ++j) { x[j] = x[j] + gpv[j] * (y[j] * rsy); if constexpr (!XOUT16) ((f32x4*)(xout + (size_t)m * D))[lane + 64 * j] = x[j]; } \
            if constexpr (XOUT16) store_row_bf16((bf16*)xout + (size_t)m * D, x, lane);        \
            if (has_next) { f32x4 h[4]; const float rs = row_rstd(x); _Pragma("unroll") for (int j = 0; j < 4; ++j) h[j] = x[j] * rs * gsv[j] + shv[j]; \
                store_row_i8(HQ + (size_t)m * D, hs + m, h, lane); } } } while (0)
        P5B_ISSUE(ywA, xwA, xfA, 0);
#pragma unroll 1
        for (int it = 0; it < 8; ++it) { const int t0 = 4 * it;
            P5B_ISSUE(ywB, xwB, xfB, t0 + 2);
            P5B_PROC(ywA, xwA, xfA, t0);
            if (it < 7) P5B_ISSUE(ywA, xwA, xfA, t0 + 4);
            P5B_PROC(ywB, xwB, xfB, t0 + 2);
        }
#undef P5B_ISSUE
#undef P5B_PROC
    }
}

constexpr int PTAB_OFF = LDSCTL_OFF + 512;
enum { I_X = 0, I_C, I_ADAW, I_ADAB, I_PREMIX, I_POSTMIX, I_WIN, I_QG, I_KG, I_DECF, I_DECB, I_GNG, I_GNB, I_WOUT, I_PREFFN, I_POSTFFN, I_RW, I_RB, I_WUP, I_BUP, I_WDN, I_BDN, I_OUT, I_WS };
__device__ __forceinline__ unsigned char* ptab(LAS unsigned char* lds, int k) {
    const LAS unsigned* p = (const LAS unsigned*)(lds + PTAB_OFF) + 2 * k;
    const unsigned lo = __builtin_amdgcn_readfirstlane(p[0]), hi = __builtin_amdgcn_readfirstlane(p[1]);
    return (unsigned char*)(GAS unsigned char*)(((unsigned long long)hi << 32) | lo);
}
__device__ __forceinline__ unsigned char* ptabx(LAS unsigned char* lds, int k) {
    const LAS unsigned* p = (const LAS unsigned*)(lds + PTAB_OFF) + 2 * k;
    const unsigned lo = __builtin_amdgcn_readfirstlane(p[0]), hi = __builtin_amdgcn_readfirstlane(p[1]);
    return (unsigned char*)(((unsigned long long)hi << 32) | lo);
}
#define WSX(off) (ptabx(F.lds, I_WS) + (off))
#define PF(k) ((const float*)ptab(F.lds, (k)))
#define WSP(off) (ptab(F.lds, I_WS) + (off))
struct Args { const float* in[22]; float* out; unsigned char* ws; };
__global__ void __launch_bounds__(NTHR, 2) mk_fwd(Args args) {
    extern __shared__ __attribute__((aligned(16))) unsigned char lds[];
    Frame F;
    F.lds = (LAS unsigned char*)lds;
    F.MISC = (volatile LAS unsigned*)(F.lds + MISC_OFF);
    F.tid = threadIdx.x; F.lane = F.tid & 63; F.wave = __builtin_amdgcn_readfirstlane(F.tid >> 6);
    F.G = gridDim.x; { const int bx = blockIdx.x; F.vcu = (F.G % 8 == 0) ? (bx % 8) * (F.G / 8) + bx / 8 : bx; }
    F.ctl = (gu32*)(args.ws + WS_CTL);
    for (int u = F.tid; u < (LDS_BYTES - LDSCTL_OFF) / 4; u += NTHR) ((LAS unsigned*)(F.lds + LDSCTL_OFF))[u] = 0u;
    __syncthreads();
    if (F.tid == 0) { LAS unsigned long long* PT = (LAS unsigned long long*)(F.lds + PTAB_OFF);
#pragma unroll
        for (int k = 0; k < 22; ++k) PT[k] = (unsigned long long)args.in[k];
        PT[I_OUT] = (unsigned long long)args.out; PT[I_WS] = (unsigned long long)args.ws; }
    __syncthreads();
    (void)xcd_barrier_post((unsigned*)(F.ctl + CW_BAR), F.MISC + 8);
#define LAUNDER() do { F.tid = threadIdx.x; asm volatile("" : "+v"(F.tid)); F.lane = F.tid & 63; F.wave = __builtin_amdgcn_readfirstlane(F.tid >> 6); \
    { unsigned long long lb_ = (unsigned long long)lds0_; int vc_ = vcu0_, g_ = G0_; asm volatile("" : "+s"(lb_), "+s"(vc_), "+s"(g_)); F.lds = (LAS unsigned char*)lb_; F.vcu = vc_; F.G = g_; } } while (0)
#ifndef REP_BAR
#define REP_BAR 1
#endif
#define GRID_BAR() for (int rb_ = 0; rb_ < REP_BAR; ++rb_) do { XcdBarrier b_; b_.bar = (unsigned*)(ptab(F.lds, I_WS) + WS_CTL) + CW_BAR; b_.x = xb_xcc_id(); b_.st = (volatile LAS unsigned*)(F.lds + MISC_OFF) + 8; xcd_barrier(b_); LAUNDER(); } while (0)
    const LAS unsigned char* lds0_ = F.lds; const int vcu0_ = F.vcu, G0_ = F.G;

#ifndef SKIP_P0
    for (int rep_ = 0; rep_ < REP_P0; ++rep_)
    p0_prologue(F, PF(I_C), PF(I_ADAW), PF(I_ADAB), (float*)WSP(WS_MOD), PF(I_WIN), PF(I_WOUT), PF(I_WUP), PF(I_WDN),
                (signed char*)WSP(WS_WIN), (float*)WSP(WS_CSCIN), (signed char*)WSP(WS_WOUT), (float*)WSP(WS_CSCOUT), (signed char*)WSP(WS_WUP), (float*)WSP(WS_CSC), (signed char*)WSP(WS_WDN), (float*)WSP(WS_CSCDN), F.ctl + CW_WQ);
#endif
    GRID_BAR();
#ifndef SKIP_P0B
    for (int rep_ = 0; rep_ < REP_P0B; ++rep_)
    p0b_premix(F, PF(I_X), (signed char*)WSP(WS_HM), (float*)WSP(WS_HS), PF(I_PREMIX), (const float*)WSP(WS_MOD));
#endif
    GRID_BAR();
    { constexpr int l = 0;
        for (int rep_ = 0; rep_ < REP_P1; ++rep_) { LAUNDER();
#ifndef SKIP_P1
        {
            pg8::Gemm g{(const bf16*)WSP(WS_HM), (const bf16*)(WSP(WS_WIN) + (size_t)l * INW * D), M, INW, D / 2}; pg8::StaticOrder S; S.init(M, INW, F.G, (int)blockIdx.x);
            pg8::EpiI8Bf16 E{(bf16*)WSP(WS_PROJ), INW, (const float*)WSP(WS_HS), (const float*)WSP(WS_CSCIN) + (size_t)l * INW, F.lds + EPI_SP_OFF};
#if defined(STAGGER_P1)
            { const unsigned long long t0_ = __builtin_amdgcn_s_memrealtime(), dl_ = (unsigned long long)(F.vcu & 7) * STAGGER_P1; while (__builtin_amdgcn_s_memrealtime() - t0_ < dl_) __builtin_amdgcn_s_sleep(8); }
#endif
#if defined(NOEPI_P1)
            { pg8::EpiNullI8 E0; pg8::gemm_phase<pg8::EpiNullI8, pg8::StaticOrder, true, true, true, true>(F.lds + RING_OFF, g, S, E0, (const int*)WSP(WS_RMAP)); LAUNDER(); }
#endif
            pg8::gemm_phase<pg8::EpiI8Bf16, pg8::StaticOrder, true, true, true>(F.lds + RING_OFF, g, S, E);
        }
#endif
        }
        GRID_BAR();
#if defined(ATTN_PROBE)
        if (l == 0) ka_expect(F, (const bf16*)WSP(WS_PROJ), (float*)WSP(WS_DUMMY), PF(I_KG));
        GRID_BAR();
#endif
#ifndef SKIP_P1B
        p1b_ka(F, (bf16*)WSP(WS_PROJ), PF(I_KG) + l * 64);
#endif
        for (int rep_ = 0; rep_ < REP_R1; ++rep_) { LAUNDER();
#ifndef SKIP_R1
        r1_states(F, (const bf16*)WSP(WS_PROJ), (bf16*)WSP(WS_U), PF(I_DECF) + l * RH, PF(I_DECB) + l * RH);
#endif
        }
        GRID_BAR();
        for (int rep_ = 0; rep_ < REP_R2; ++rep_) { LAUNDER();
#ifndef SKIP_R2
        r2_scan(F, (const bf16*)WSP(WS_U), (bf16*)WSP(WS_FT), PF(I_DECF) + l * RH, PF(I_DECB) + l * RH);
#endif
        }
        GRID_BAR();
#pragma unroll 1
        for (int pass_ = 0; pass_ < 2; ++pass_) { LAUNDER();
        if (((F.vcu ^ pass_) & 1) == 0) {
#ifndef SKIP_R3
        r3_out(F, (const bf16*)WSP(WS_PROJ), (const bf16*)WSP(WS_FT), (bf16*)WSP(WS_CAT), PF(I_DECF) + l * RH, PF(I_DECB) + l * RH, PF(I_GNG) + l * 512, PF(I_GNB) + l * 512);
#endif
        } else {
#ifndef SKIP_P2
        {
            const bf16* PROJ = (const bf16*)WSP(WS_PROJ);
            const attn_body::AttnTensors AT{(const attn_body::bf16*)(PROJ + C_QA), (const attn_body::bf16*)(PROJ + C_KA), (const attn_body::bf16*)(PROJ + C_VA), (attn_body::bf16*)WSP(WS_CAT), PF(I_QG) + l * 64, PF(I_KG) + l * 64};
            attn_body::attn_phase<8>((char*)lds + RING_OFF, AT, F.vcu, F.G);
        }
#endif
        }
        }
        GRID_BAR();
#if defined(ATTN_PROBE)
        if (l == 0) ka_compare(F, (const bf16*)WSP(WS_PROJ), (const float*)WSP(WS_DUMMY), F.ctl + CW_CODE + 8);
        if (l == 0) attn_check(F, (const bf16*)WSP(WS_PROJ), (const bf16*)WSP(WS_CAT), F.ctl + CW_CODE + 8, PF(I_QG));
#endif
        for (int rep_ = 0; rep_ < REP_P3; ++rep_) { LAUNDER();
#ifndef SKIP_P3
        {
            pg8::Gemm g{(const bf16*)WSP(WS_CAT), (const bf16*)(WSP(WS_WOUT) + (size_t)l * D * D), M, D, D / 2}; pg8::StaticOrder S; S.init(M, D, F.G, (int)blockIdx.x);
            pg8::EpiBf16 E{(bf16*)WSP(WS_YM), D, nullptr, 0, 0, F.lds + EPI_SP_OFF, (const float*)WSP(WS_CSCOUT) + (size_t)l * D, 1.0f};
            pg8::gemm_phase<pg8::EpiBf16, pg8::StaticOrder, true, true, false, false, true>(F.lds + RING_OFF, g, S, E);
        }
#endif
        }
        GRID_BAR();
#ifndef SKIP_P3B
        for (int rep_ = 1; rep_ < REP_P3B; ++rep_) { LAUNDER();
        p3b_postmix<false, (l > 0)>(F, l == 0 ? PF(I_X) : PF(I_OUT), (float*)WSP(WS_DUMMY), (const bf16*)WSP(WS_YM), (signed char*)WSP(WS_DUMMY + 256 * MiB), (float*)WSP(WS_DUMMY + 386 * MiB), (const float*)WSP(WS_MOD) + (size_t)l * BATCH * 6 * D,
                    PF(I_POSTMIX) + l * D, PF(I_PREFFN) + l * D, PF(I_RW) + (size_t)l * D * NE, PF(I_RB) + l * NE, (int*)WSP(WS_DUMMY + 384 * MiB), (float*)WSP(WS_DUMMY + 385 * MiB), F.ctl + CW_CNT + 128 + l * 64);
        }
        LAUNDER();
        p3b_postmix<(l >= X16_FROM), (l > 0)>(F, l == 0 ? PF(I_X) : PF(I_OUT), (l >= X16_FROM) ? (float*)WSP(WS_CAT) : (float*)ptab(F.lds, I_OUT), (const bf16*)WSP(WS_YM), (signed char*)WSP(WS_HM), (float*)WSP(WS_HS), (const float*)WSP(WS_MOD) + (size_t)l * BATCH * 6 * D,
                    PF(I_POSTMIX) + l * D, PF(I_PREFFN) + l * D, PF(I_RW) + (size_t)l * D * NE, PF(I_RB) + l * NE, (int*)WSP(WS_TOPI), (float*)WSP(WS_TOPW), F.ctl + CW_CNT + l * 64);
#endif
        GRID_BAR();
#ifndef SKIP_P4A
        for (int rep_ = 1; rep_ < REP_P4A; ++rep_) { LAUNDER();
        p4a_route(F, (const float*)WSP(WS_HS), (int*)WSP(WS_DUMMY + 16 * MiB), (float*)WSP(WS_DUMMY + 8 * MiB), (const int*)WSP(WS_TOPI), (int*)WSP(WS_DUMMY), F.ctl + CW_CNT + l * 64, F.ctl + CW_CUR + 128 + l * 64);
        }
        LAUNDER();
        p4a_route(F, (const float*)WSP(WS_HS), (int*)WSP(WS_RMAP), (float*)WSP(WS_XSC), (const int*)WSP(WS_TOPI), (int*)WSP(WS_POS), F.ctl + CW_CNT + l * 64, F.ctl + CW_CUR + l * 64);
#endif
        GRID_BAR();
        for (int rep_ = 0; rep_ < REP_P4; ++rep_) { LAUNDER();
#ifndef SKIP_P4
        {
            const LAS int* ts = (const LAS int*)(F.lds + LTS_OFF);
            pg8::Gemm g{(const bf16*)WSP(WS_HM), (const bf16*)(WSP(WS_WUP) + (size_t)l * NE * 2048 * D), XS_ROWS, 2048, D / 2}; pg8::MoeOrder<3> S{ts, F.G, F.vcu, ts[NE] * 8, ts[F.lane & 31]};
            pg8::EpiMoeUpT<true> E{(bf16*)WSP(WS_ACT), PF(I_BUP) + (size_t)l * NE * 2048, (const float*)WSP(WS_XSC), (const float*)WSP(WS_CSC) + (size_t)l * NE * 2048, F.lds + EPI_SP_OFF};
#if defined(STAGGER_P4)
            { const unsigned long long t0_ = __builtin_amdgcn_s_memrealtime(), dl_ = (unsigned long long)(F.vcu & (STAGGER_WAYS - 1)) * STAGGER_P4; while (__builtin_amdgcn_s_memrealtime() - t0_ < dl_) __builtin_amdgcn_s_sleep(8); }
#endif
#if defined(NOLOAD_P4)
            { pg8::EpiMoeUpNoLoad E0{(bf16*)WSP(WS_ACT), 1e-4f, 0.01f}; pg8::gemm_phase<pg8::EpiMoeUpNoLoad, pg8::MoeOrder<3>, true, true, true, true>(F.lds + RING_OFF, g, S, E0, (const int*)WSP(WS_RMAP)); LAUNDER(); }
#endif
#if defined(NOSTORE_P4)
            { pg8::EpiMoeUpNoStore E0{(bf16*)WSP(WS_ACT), 1e-4f, 0.01f}; pg8::gemm_phase<pg8::EpiMoeUpNoStore, pg8::MoeOrder<3>, true, true, true, true>(F.lds + RING_OFF, g, S, E0, (const int*)WSP(WS_RMAP)); LAUNDER(); }
#endif
#if defined(NOEPI_P4)
            { pg8::EpiNullI8 E0; pg8::gemm_phase<pg8::EpiNullI8, pg8::MoeOrder<3>, true, true, true, true>(F.lds + RING_OFF, g, S, E0, (const int*)WSP(WS_RMAP)); LAUNDER(); }
#endif
            pg8::gemm_phase<pg8::EpiMoeUpT<true>, pg8::MoeOrder<3>, true, true, true, true>(F.lds + RING_OFF, g, S, E, (const int*)WSP(WS_RMAP));
        }
#endif
        }
        GRID_BAR();
        for (int rep_ = 0; rep_ < REP_P5; ++rep_) { LAUNDER();
#ifndef SKIP_P5
        {
            const LAS int* ts = (const LAS int*)(F.lds + LTS_OFF);
            pg8::Gemm g{(const bf16*)WSP(WS_ACT), (const bf16*)(WSP(WS_WDN) + (size_t)l * NE * D * D), XS_ROWS, D, D / 2}; pg8::MoeOrder<2> S{ts, F.G, F.vcu, ts[NE] * 4, ts[F.lane & 31]};
            typedef pg8::EpiBf16T<(l >= YF8_FROM)> EpiDn;
            EpiDn E{(bf16*)WSP(WS_XS), D, PF(I_BDN) + (size_t)l * NE * D, D, 0, F.lds + EPI_SP_OFF, (const float*)WSP(WS_CSCDN) + (size_t)l * NE * D, 1.0f / pg8::ACT_F8_SCALE};
#if defined(STAGGER_P5)
            { const unsigned long long t0_ = __builtin_amdgcn_s_memrealtime(), dl_ = (unsigned long long)(F.vcu & 7) * STAGGER_P5; while (__builtin_amdgcn_s_memrealtime() - t0_ < dl_) __builtin_amdgcn_s_sleep(8); }
#endif
            pg8::gemm_phase<EpiDn, pg8::MoeOrder<2>, true, true, false, false, true>(F.lds + RING_OFF, g, S, E);
        }
#endif
        }
        GRID_BAR();
#ifndef SKIP_P5B
        for (int rep_ = 1; rep_ < REP_P5B; ++rep_) { LAUNDER();
        p5b_combine<(l >= YF8_FROM), (l >= X16_FROM), (l + 1 < DEPTH)>(F, (l >= X16_FROM) ? (const float*)WSP(WS_CAT) : (const float*)ptab(F.lds, I_OUT), (float*)WSP(WS_DUMMY), (const bf16*)WSP(WS_XS), (const int*)WSP(WS_POS), (const float*)WSP(WS_TOPW), (const float*)WSP(WS_MOD) + (size_t)l * BATCH * 6 * D, PF(I_POSTFFN) + l * D,
                    l + 1 < DEPTH, (const float*)WSP(WS_MOD) + (size_t)(l + 1 < DEPTH ? l + 1 : l) * BATCH * 6 * D, PF(I_PREMIX) + (l + 1 < DEPTH ? (l + 1) * D : 0), (signed char*)WSP(WS_DUMMY + 256 * MiB), (float*)WSP(WS_DUMMY + 386 * MiB));
        }
        LAUNDER();
        p5b_combine<(l >= YF8_FROM), (l >= X16_FROM), (l + 1 < DEPTH)>(F, (l >= X16_FROM) ? (const float*)WSP(WS_CAT) : (const float*)ptab(F.lds, I_OUT), (float*)ptab(F.lds, I_OUT), (const bf16*)WSP(WS_XS), (const int*)WSP(WS_POS), (const float*)WSP(WS_TOPW), (const float*)WSP(WS_MOD) + (size_t)l * BATCH * 6 * D, PF(I_POSTFFN) + l * D,
                    l + 1 < DEPTH, (const float*)WSP(WS_MOD) + (size_t)(l + 1 < DEPTH ? l + 1 : l) * BATCH * 6 * D, PF(I_PREMIX) + (l + 1 < DEPTH ? (l + 1) * D : 0), (signed char*)WSP(WS_HM), (float*)WSP(WS_HS));
#endif
        if (l + 1 < DEPTH) GRID_BAR();
    }
    { constexpr int l = 1;
        for (int rep_ = 0; rep_ < REP_P1; ++rep_) { LAUNDER();
#ifndef SKIP_P1
        {
            pg8::Gemm g{(const bf16*)WSP(WS_HM), (const bf16*)(WSP(WS_WIN) + (size_t)l * INW * D), M, INW, D / 2}; pg8::StaticOrder S; S.init(M, INW, F.G, (int)blockIdx.x);
            pg8::EpiI8Bf16 E{(bf16*)WSP(WS_PROJ), INW, (const float*)WSP(WS_HS), (const float*)WSP(WS_CSCIN) + (size_t)l * INW, F.lds + EPI_SP_OFF};
#if defined(STAGGER_P1)
            { const unsigned long long t0_ = __builtin_amdgcn_s_memrealtime(), dl_ = (unsigned long long)(F.vcu & 7) * STAGGER_P1; while (__builtin_amdgcn_s_memrealtime() - t0_ < dl_) __builtin_amdgcn_s_sleep(8); }
#endif
#if defined(NOEPI_P1)
            { pg8::EpiNullI8 E0; pg8::gemm_phase<pg8::EpiNullI8, pg8::StaticOrder, true, true, true, true>(F.lds + RING_OFF, g, S, E0, (const int*)WSP(WS_RMAP)); LAUNDER(); }
#endif
            pg8::gemm_phase<pg8::EpiI8Bf16, pg8::StaticOrder, true, true, true>(F.lds + RING_OFF, g, S, E);
        }
#endif
        }
        GRID_BAR();
#if defined(ATTN_PROBE)
        if (l == 0) ka_expect(F, (const bf16*)WSP(WS_PROJ), (float*)WSP(WS_DUMMY), PF(I_KG));
        GRID_BAR();
#endif
#ifndef SKIP_P1B
        p1b_ka(F, (bf16*)WSP(WS_PROJ), PF(I_KG) + l * 64);
#endif
        for (int rep_ = 0; rep_ < REP_R1; ++rep_) { LAUNDER();
#ifndef SKIP_R1
        r1_states(F, (const bf16*)WSP(WS_PROJ), (bf16*)WSP(WS_U), PF(I_DECF) + l * RH, PF(I_DECB) + l * RH);
#endif
        }
        GRID_BAR();
        for (int rep_ = 0; rep_ < REP_R2; ++rep_) { LAUNDER();
#ifndef SKIP_R2
        r2_scan(F, (const bf16*)WSP(WS_U), (bf16*)WSP(WS_FT), PF(I_DECF) + l * RH, PF(I_DECB) + l * RH);
#endif
        }
        GRID_BAR();
#pragma unroll 1
        for (int pass_ = 0; pass_ < 2; ++pass_) { LAUNDER();
        if (((F.vcu ^ pass_) & 1) == 0) {
#ifndef SKIP_R3
        r3_out(F, (const bf16*)WSP(WS_PROJ), (const bf16*)WSP(WS_FT), (bf16*)WSP(WS_CAT), PF(I_DECF) + l * RH, PF(I_DECB) + l * RH, PF(I_GNG) + l * 512, PF(I_GNB) + l * 512);
#endif
        } else {
#ifndef SKIP_P2
        {
            const bf16* PROJ = (const bf16*)WSP(WS_PROJ);
            const attn_body::AttnTensors AT{(const attn_body::bf16*)(PROJ + C_QA), (const attn_body::bf16*)(PROJ + C_KA), (const attn_body::bf16*)(PROJ + C_VA), (attn_body::bf16*)WSP(WS_CAT), PF(I_QG) + l * 64, PF(I_KG) + l * 64};
            attn_body::attn_phase<8>((char*)lds + RING_OFF, AT, F.vcu, F.G);
        }
#endif
        }
        }
        GRID_BAR();
#if defined(ATTN_PROBE)
        if (l == 0) ka_compare(F, (const bf16*)WSP(WS_PROJ), (const float*)WSP(WS_DUMMY), F.ctl + CW_CODE + 8);
        if (l == 0) attn_check(F, (const bf16*)WSP(WS_PROJ), (const bf16*)WSP(WS_CAT), F.ctl + CW_CODE + 8, PF(I_QG));
#endif
        for (int rep_ = 0; rep_ < REP_P3; ++rep_) { LAUNDER();
#ifndef SKIP_P3
        {
            pg8::Gemm g{(const bf16*)WSP(WS_CAT), (const bf16*)(WSP(WS_WOUT) + (size_t)l * D * D), M, D, D / 2}; pg8::StaticOrder S; S.init(M, D, F.G, (int)blockIdx.x);
            pg8::EpiBf16 E{(bf16*)WSP(WS_YM), D, nullptr, 0, 0, F.lds + EPI_SP_OFF, (const float*)WSP(WS_CSCOUT) + (size_t)l * D, 1.0f};
            pg8::gemm_phase<pg8::EpiBf16, pg8::StaticOrder, true, true, false, false, true>(F.lds + RING_OFF, g, S, E);
        }
#endif
        }
        GRID_BAR();
#ifndef SKIP_P3B
        for (int rep_ = 1; rep_ < REP_P3B; ++rep_) { LAUNDER();
        p3b_postmix<false, (l > 0)>(F, l == 0 ? PF(I_X) : PF(I_OUT), (float*)WSP(WS_DUMMY), (const bf16*)WSP(WS_YM), (signed char*)WSP(WS_DUMMY + 256 * MiB), (float*)WSP(WS_DUMMY + 386 * MiB), (const float*)WSP(WS_MOD) + (size_t)l * BATCH * 6 * D,
                    PF(I_POSTMIX) + l * D, PF(I_PREFFN) + l * D, PF(I_RW) + (size_t)l * D * NE, PF(I_RB) + l * NE, (int*)WSP(WS_DUMMY + 384 * MiB), (float*)WSP(WS_DUMMY + 385 * MiB), F.ctl + CW_CNT + 128 + l * 64);
        }
        LAUNDER();
        p3b_postmix<(l >= X16_FROM), (l > 0)>(F, l == 0 ? PF(I_X) : PF(I_OUT), (l >= X16_FROM) ? (float*)WSP(WS_CAT) : (float*)ptab(F.lds, I_OUT), (const bf16*)WSP(WS_YM), (signed char*)WSP(WS_HM), (float*)WSP(WS_HS), (const float*)WSP(WS_MOD) + (size_t)l * BATCH * 6 * D,
                    PF(I_POSTMIX) + l * D, PF(I_PREFFN) + l * D, PF(I_RW) + (size_t)l * D * NE, PF(I_RB) + l * NE, (int*)WSP(WS_TOPI), (float*)WSP(WS_TOPW), F.ctl + CW_CNT + l * 64);
#endif
        GRID_BAR();
#ifndef SKIP_P4A
        for (int rep_ = 1; rep_ < REP_P4A; ++rep_) { LAUNDER();
        p4a_route(F, (const float*)WSP(WS_HS), (int*)WSP(WS_DUMMY + 16 * MiB), (float*)WSP(WS_DUMMY + 8 * MiB), (const int*)WSP(WS_TOPI), (int*)WSP(WS_DUMMY), F.ctl + CW_CNT + l * 64, F.ctl + CW_CUR + 128 + l * 64);
        }
        LAUNDER();
        p4a_route(F, (const float*)WSP(WS_HS), (int*)WSP(WS_RMAP), (float*)WSP(WS_XSC), (const int*)WSP(WS_TOPI), (int*)WSP(WS_POS), F.ctl + CW_CNT + l * 64, F.ctl + CW_CUR + l * 64);
#endif
        GRID_BAR();
        for (int rep_ = 0; rep_ < REP_P4; ++rep_) { LAUNDER();
#ifndef SKIP_P4
        {
            const LAS int* ts = (const LAS int*)(F.lds + LTS_OFF);
            pg8::Gemm g{(const bf16*)WSP(WS_HM), (const bf16*)(WSP(WS_WUP) + (size_t)l * NE * 2048 * D), XS_ROWS, 2048, D / 2}; pg8::MoeOrder<3> S{ts, F.G, F.vcu, ts[NE] * 8, ts[F.lane & 31]};
            pg8::EpiMoeUpT<true> E{(bf16*)WSP(WS_ACT), PF(I_BUP) + (size_t)l * NE * 2048, (const float*)WSP(WS_XSC), (const float*)WSP(WS_CSC) + (size_t)l * NE * 2048, F.lds + EPI_SP_OFF};
#if defined(STAGGER_P4)
            { const unsigned long long t0_ = __builtin_amdgcn_s_memrealtime(), dl_ = (unsigned long long)(F.vcu & (STAGGER_WAYS - 1)) * STAGGER_P4; while (__builtin_amdgcn_s_memrealtime() - t0_ < dl_) __builtin_amdgcn_s_sleep(8); }
#endif
#if defined(NOLOAD_P4)
            { pg8::EpiMoeUpNoLoad E0{(bf16*)WSP(WS_ACT), 1e-4f, 0.01f}; pg8::gemm_phase<pg8::EpiMoeUpNoLoad, pg8::MoeOrder<3>, true, true, true, true>(F.lds + RING_OFF, g, S, E0, (const int*)WSP(WS_RMAP)); LAUNDER(); }
#endif
#if defined(NOSTORE_P4)
            { pg8::EpiMoeUpNoStore E0{(bf16*)WSP(WS_ACT), 1e-4f, 0.01f}; pg8::gemm_phase<pg8::EpiMoeUpNoStore, pg8::MoeOrder<3>, true, true, true, true>(F.lds + RING_OFF, g, S, E0, (const int*)WSP(WS_RMAP)); LAUNDER(); }
#endif
#if defined(NOEPI_P4)
            { pg8::EpiNullI8 E0; pg8::gemm_phase<pg8::EpiNullI8, pg8::MoeOrder<3>, true, true, true, true>(F.lds + RING_OFF, g, S, E0, (const int*)WSP(WS_RMAP)); LAUNDER(); }
#endif
            pg8::gemm_phase<pg8::EpiMoeUpT<true>, pg8::MoeOrder<3>, true, true, true, true>(F.lds + RING_OFF, g, S, E, (const int*)WSP(WS_RMAP));
        }
#endif
        }
        GRID_BAR();
        for (int rep_ = 0; rep_ < REP_P5; ++rep_) { LAUNDER();
#ifndef SKIP_P5
        {
            const LAS int* ts = (const LAS int*)(F.lds + LTS_OFF);
            pg8::Gemm g{(const bf16*)WSP(WS_ACT), (const bf16*)(WSP(WS_WDN) + (size_t)l * NE * D * D), XS_ROWS, D, D / 2}; pg8::MoeOrder<2> S{ts, F.G, F.vcu, ts[NE] * 4, ts[F.lane & 31]};
            typedef pg8::EpiBf16T<(l >= YF8_FROM)> EpiDn;
            EpiDn E{(bf16*)WSP(WS_XS), D, PF(I_BDN) + (size_t)l * NE * D, D, 0, F.lds + EPI_SP_OFF, (const float*)WSP(WS_CSCDN) + (size_t)l * NE * D, 1.0f / pg8::ACT_F8_SCALE};
#if defined(STAGGER_P5)
            { const unsigned long long t0_ = __builtin_amdgcn_s_memrealtime(), dl_ = (unsigned long long)(F.vcu & 7) * STAGGER_P5; while (__builtin_amdgcn_s_memrealtime() - t0_ < dl_) __builtin_amdgcn_s_sleep(8); }
#endif
            pg8::gemm_phase<EpiDn, pg8::MoeOrder<2>, true, true, false, false, true>(F.lds + RING_OFF, g, S, E);
        }
#endif
        }
        GRID_BAR();
#ifndef SKIP_P5B
        for (int rep_ = 1; rep_ < REP_P5B; ++rep_) { LAUNDER();
        p5b_combine<(l >= YF8_FROM), (l >= X16_FROM), (l + 1 < DEPTH)>(F, (l >= X16_FROM) ? (const float*)WSP(WS_CAT) : (const float*)ptab(F.lds, I_OUT), (float*)WSP(WS_DUMMY), (const bf16*)WSP(WS_XS), (const int*)WSP(WS_POS), (const float*)WSP(WS_TOPW), (const float*)WSP(WS_MOD) + (size_t)l * BATCH * 6 * D, PF(I_POSTFFN) + l * D,
                    l + 1 < DEPTH, (const float*)WSP(WS_MOD) + (size_t)(l + 1 < DEPTH ? l + 1 : l) * BATCH * 6 * D, PF(I_PREMIX) + (l + 1 < DEPTH ? (l + 1) * D : 0), (signed char*)WSP(WS_DUMMY + 256 * MiB), (float*)WSP(WS_DUMMY + 386 * MiB));
        }
        LAUNDER();
        p5b_combine<(l >= YF8_FROM), (l >= X16_FROM), (l + 1 < DEPTH)>(F, (l >= X16_FROM) ? (const float*)WSP(WS_CAT) : (const float*)ptab(F.lds, I_OUT), (float*)ptab(F.lds, I_OUT), (const bf16*)WSP(WS_XS), (const int*)WSP(WS_POS), (const float*)WSP(WS_TOPW), (const float*)WSP(WS_MOD) + (size_t)l * BATCH * 6 * D, PF(I_POSTFFN) + l * D,
                    l + 1 < DEPTH, (const float*)WSP(WS_MOD) + (size_t)(l + 1 < DEPTH ? l + 1 : l) * BATCH * 6 * D, PF(I_PREMIX) + (l + 1 < DEPTH ? (l + 1) * D : 0), (signed char*)WSP(WS_HM), (float*)WSP(WS_HS));
#endif
        if (l + 1 < DEPTH) GRID_BAR();
    }
#if defined(ATTN_PROBE)
    GRID_BAR();
    if (blockIdx.x == 0 && F.tid == 0 && __hip_atomic_load(F.ctl + CW_CODE + 8, RLX_AGENT) != 0u) ((float*)ptab(F.lds, I_OUT))[0] = __builtin_nanf("");
#endif
#undef GRID_BAR
}

extern "C" void kernel_launch(void* const* d_in, const int* in_sizes, int n_in, void* d_out, int out_size, void* d_ws, size_t ws_size, hipStream_t stream) {
    static int grid = 0;
    if (grid == 0) {
        if (n_in != 22 || in_sizes[0] != M * D || out_size != M * D || ws_size < WS_END) { fprintf(stderr, "kernel_launch: unexpected shapes/workspace (n_in %d, in0 %d, out %d, ws %zu < %zu)\n", n_in, n_in > 0 ? in_sizes[0] : -1, out_size, ws_size, (size_t)WS_END); grid = -1; return; }
        int dev = 0, cus = 0, per_cu = 0;
        if (hipGetDevice(&dev) != hipSuccess || hipDeviceGetAttribute(&cus, hipDeviceAttributeMultiprocessorCount, dev) != hipSuccess) { grid = -1; return; }
        if (hipFuncSetAttribute((const void*)mk_fwd, hipFuncAttributeMaxDynamicSharedMemorySize, LDS_BYTES) != hipSuccess) { fprintf(stderr, "kernel_launch: hipFuncSetAttribute failed\n"); grid = -1; return; }
        if (hipOccupancyMaxActiveBlocksPerMultiprocessor(&per_cu, (const void*)mk_fwd, NTHR, LDS_BYTES) != hipSuccess || per_cu < 1) { fprintf(stderr, "kernel_launch: occupancy query says %d\n", per_cu); }
        (void)hipGetLastError();
        grid = cus;
    }
    if (grid < 0) return;
    if (hipMemsetAsync((char*)d_ws + WS_CTL, 0, CTL_ZERO_BYTES, stream) != hipSuccess) { fprintf(stderr, "kernel_launch: memset failed\n"); return; }
    Args a{};
    for (int i = 0; i < 22; ++i) a.in[i] = (const float*)d_in[i];
    a.out = (float*)d_out; a.ws = (unsigned char*)d_ws;
    hipLaunchKernelGGL(mk_fwd, dim3(grid), dim3(NTHR), LDS_BYTES, stream, a);
    const hipError_t le = hipPeekAtLastError();
    if (le != hipSuccess) fprintf(stderr, "kernel_launch: launch failed: %s\n", hipGetErrorName(le));
}
```

```cpp
#ifndef REP_P0
#define REP_P0 1
#endif
#ifndef REP_P1
#define REP_P1 1
#endif
#ifndef REP_R1
#define REP_R1 1
#endif
#ifndef REP_R2
#define REP_R2 1
#endif
#ifndef REP_R3
#define REP_R3 1
#endif
#ifndef REP_P2
#define REP_P2 1
#endif
#ifndef REP_P3
#define REP_P3 1
#endif
#ifndef REP_P4
#define REP_P4 1
#endif
#ifndef REP_P5
#define REP_P5 1
#endif
#ifndef REP_P0B
#define REP_P0B 1
#endif
#ifndef REP_P1B
#define REP_P1B 1
#endif
#ifndef REP_P3B
#define REP_P3B 1
#endif
#ifndef REP_P4A
#define REP_P4A 1
#endif
#ifndef REP_P5B
#define REP_P5B 1
#endif
#ifndef REP_EPI
#define REP_EPI 1
#endif
#ifndef STAGGER_WAYS
#define STAGGER_WAYS 8
#endif
#include <hip/hip_runtime.h>
template <int M> __device__ __forceinline__ float shx(float v) { return __int_as_float(__builtin_amdgcn_ds_swizzle(__float_as_int(v), (M << 10) | 0x1f)); }
template <int M> __device__ __forceinline__ int shxi(int v) { return __builtin_amdgcn_ds_swizzle(v, (M << 10) | 0x1f); }
__device__ __forceinline__ float sum32(float v) { auto rr = __builtin_amdgcn_permlane32_swap(__float_as_uint(v), __float_as_uint(v), false, false); return __uint_as_float(rr[0]) + __uint_as_float(rr[1]); }
__device__ __forceinline__ float max32(float v) { auto rr = __builtin_amdgcn_permlane32_swap(__float_as_uint(v), __float_as_uint(v), false, false); return fmaxf(__uint_as_float(rr[0]), __uint_as_float(rr[1])); }
__device__ __forceinline__ float shx32(float v, bool upper) { auto rr = __builtin_amdgcn_permlane32_swap(__float_as_uint(v), __float_as_uint(v), false, false); return __uint_as_float(upper ? rr[0] : rr[1]); }
__device__ __forceinline__ int bcastl(int v, int srclane) { return __builtin_amdgcn_ds_bpermute(srclane << 2, v); }
__device__ __forceinline__ float wsum64(float v) { v += shx<1>(v); v += shx<2>(v); v += shx<4>(v); v += shx<8>(v); v += shx<16>(v); return sum32(v); }
__device__ __forceinline__ float wmax64(float v) { v = fmaxf(v, shx<1>(v)); v = fmaxf(v, shx<2>(v)); v = fmaxf(v, shx<4>(v)); v = fmaxf(v, shx<8>(v)); v = fmaxf(v, shx<16>(v)); return max32(v); }
#ifndef YF8_FROM
#define YF8_FROM 0
#endif
#ifndef X16_FROM
#define X16_FROM 0
#endif
#include <hip/hip_runtime.h>
#include <cstdio>
#include <cstdint>
namespace pg8 {
#define PG8_LAS __attribute__((address_space(3)))
typedef unsigned short bf16_t;
typedef short bf16x8 __attribute__((ext_vector_type(8)));
typedef float f32x4 __attribute__((ext_vector_type(4)));
typedef unsigned u32x4 __attribute__((ext_vector_type(4)));
constexpr int BM = 256, BK = 64, HALF = 128, HTB = HALF * BK * 2  , STAGE_BYTES = 8 * HTB, NXCD = 8, WGM = 8;

__host__ __device__ __forceinline__ int lds_byte(int r, int c) { const int st = (r >> 4) * 2 + (c >> 5), rr = r & 15, cc = c & 31, ob = rr * 64 + cc * 2; return st * 1024 + (ob ^ (((ob >> 9) & 1) << 5)); }
__host__ __device__ __forceinline__ void stage_rc(int b, int& R, int& C) { const int st = b / 1024, sb = b % 1024, swz = sb ^ (((sb >> 9) & 1) << 5); R = (st >> 1) * 16 + swz / 64; C = (st & 1) * 32 + (swz % 64) / 2; }
__host__ __device__ __forceinline__ int perm32(int rho) { const int n = rho >> 4, i = rho & 15; return 8 * (i >> 2) + 4 * n + (i & 3); }

struct Unit { int pm, pn; };
struct Gemm { const bf16_t* A; const bf16_t* Bt; int M, N, K; };

struct StaticOrder {
    int nM, nN, nwg, G, c;
    __host__ __device__ void init(int M, int N, int G_, int c_) { nM = M / BM; nN = N / BM; nwg = nM * nN; G = G_; c = c_; }
    __host__ __device__ bool next(int i, Unit& u) const {
        const long L = (long)i * G + c; if (L >= nwg) return false;
        int wgid = (int)L; { const int q = nwg / NXCD, r = nwg % NXCD, xcd = wgid % NXCD, off = wgid / NXCD; wgid = (xcd < r ? xcd * (q + 1) : r * (q + 1) + (xcd - r) * q) + off; }
        const int nig = WGM * nN, gid = wgid / nig, fm = gid * WGM, gsz = (nM - fm) < WGM ? (nM - fm) : WGM;
        u.pm = fm + ((wgid % nig) % gsz); u.pn = (wgid % nig) / gsz; return true;
    }
    __device__ __forceinline__ void a_ready(const Unit&) const {}
    __device__ __forceinline__ void done(const Unit&) const {}
};

__device__ __forceinline__ unsigned cvt_pk_bf16(float lo, float hi) { unsigned r; asm volatile("v_cvt_pk_bf16_f32 %0, %1, %2" : "=v"(r) : "v"(lo), "v"(hi)); return r; }
typedef float f32x2 __attribute__((ext_vector_type(2)));

typedef int i32x4 __attribute__((ext_vector_type(4)));
__device__ __forceinline__ void dma4(const float* g, PG8_LAS unsigned char* l) { __builtin_amdgcn_global_load_lds((const unsigned*)g, (PG8_LAS unsigned*)l, 4, 0, 0); }
template <bool OUT_F8> struct EpiBf16T {
    static constexpr bool PERM = true, AFTER_DRAIN = false; static constexpr int NST = OUT_F8 ? 8 : 16;
    bf16_t* O; int ldc; const float* bias; int split_cols; size_t split_stride; PG8_LAS unsigned char* sp;
    const float* csc = nullptr; float cmul = 1.0f;
    __device__ __forceinline__ void prefetch(const Unit& u, int wid, int lane) const {
        if (bias && wid < 4) dma4(bias + u.pn * BM + wid * 64 + lane, sp + wid * 256);
        if (csc && wid >= 4) dma4(csc + u.pn * BM + (wid - 4) * 64 + lane, sp + 1024 + (wid - 4) * 256);
    }
    __device__ __forceinline__ void operator()(const f32x4 (&acc)[2][2][4][2], const Unit& u, int wr, int wc, int fr, int fq) const {
        const int row0 = u.pm * BM + wr * 64 + fr; int colt = u.pn * BM; bf16_t* base = O;
        if (split_cols) { const int t = colt / split_cols; base += (size_t)t * split_stride; colt -= t * split_cols; }
        const int col0 = colt + wc * 32 + 8 * fq;
        f32x4 bv[2][2];
#pragma unroll
        for (int bj = 0; bj < 2; ++bj)
#pragma unroll
            for (int n = 0; n < 2; ++n) bv[bj][n] = bias ? *(const PG8_LAS f32x4*)(sp + 4 * (bj * HALF + wc * 32 + 8 * fq + 4 * n)) : (f32x4){0.f, 0.f, 0.f, 0.f};
        f32x4 cv[2][2];
#pragma unroll
        for (int bj = 0; bj < 2; ++bj)
#pragma unroll
            for (int n = 0; n < 2; ++n) cv[bj][n] = csc ? *(const PG8_LAS f32x4*)(sp + 1024 + 4 * (bj * HALF + wc * 32 + 8 * fq + 4 * n)) * cmul : (f32x4){1.f, 1.f, 1.f, 1.f};
#pragma unroll
        for (int ai = 0; ai < 2; ++ai)
#pragma unroll
            for (int m = 0; m < 4; ++m) { bf16_t* rowp = base + (size_t)(row0 + ai * HALF + m * 16) * ldc + col0;
                if constexpr (OUT_F8) { unsigned w[4];
#pragma unroll
                    for (int bj = 0; bj < 2; ++bj) { f32x4 v0 = acc[ai][bj][m][0] * cv[bj][0] + bv[bj][0], v1 = acc[ai][bj][m][1] * cv[bj][1] + bv[bj][1]; unsigned w0 = 0u, w1 = 0u;
#pragma unroll
                        for (int q = 0; q < 4; ++q) { v0[q] = __builtin_amdgcn_fmed3f(v0[q], -448.0f, 448.0f); v1[q] = __builtin_amdgcn_fmed3f(v1[q], -448.0f, 448.0f); }
                        w0 = __builtin_amdgcn_cvt_pk_fp8_f32(v0[0], v0[1], w0, false); w0 = __builtin_amdgcn_cvt_pk_fp8_f32(v0[2], v0[3], w0, true);
                        w1 = __builtin_amdgcn_cvt_pk_fp8_f32(v1[0], v1[1], w1, false); w1 = __builtin_amdgcn_cvt_pk_fp8_f32(v1[2], v1[3], w1, true);
                        w[2 * bj] = w0; w[2 * bj + 1] = w1; }
                    *(u32x4*)((unsigned char*)base + (size_t)(row0 + ai * HALF + m * 16) * ldc + colt + 64 * wc + 16 * fq) = (u32x4){w[0], w[1], w[2], w[3]}; }
                else {
#pragma unroll
                    for (int bj = 0; bj < 2; ++bj) { const f32x4 v0 = acc[ai][bj][m][0] * cv[bj][0] + bv[bj][0], v1 = acc[ai][bj][m][1] * cv[bj][1] + bv[bj][1];
                        u32x4 w; w.x = cvt_pk_bf16(v0[0], v0[1]); w.y = cvt_pk_bf16(v0[2], v0[3]); w.z = cvt_pk_bf16(v1[0], v1[1]); w.w = cvt_pk_bf16(v1[2], v1[3]);
                        *(u32x4*)(rowp + bj * HALF) = w; } } }
    }
};
typedef EpiBf16T<false> EpiBf16;
struct EpiNullI8 {
    static constexpr bool PERM = true, AFTER_DRAIN = false; static constexpr int NST = 0;
    __device__ __forceinline__ void prefetch(const Unit&, int, int) const {}
    __device__ __forceinline__ void operator()(const i32x4 (&acc)[2][2][4][2], const Unit&, int, int, int, int) const {
#pragma unroll
        for (int a = 0; a < 2; ++a)
#pragma unroll
            for (int b = 0; b < 2; ++b)
#pragma unroll
                for (int m = 0; m < 4; ++m)
#pragma unroll
                    for (int n = 0; n < 2; ++n) asm volatile("" :: "v"(acc[a][b][m][n]));
    }
};
struct EpiI8Bf16 {
    static constexpr bool PERM = true, AFTER_DRAIN = false; static constexpr int NST = 16;
    bf16_t* O; int ldc; const float* rsc; const float* csc; PG8_LAS unsigned char* sp;
    __device__ __forceinline__ void prefetch(const Unit& u, int wid, int lane) const {
        if (wid < 4) dma4(rsc + u.pm * BM + wid * 64 + lane, sp + wid * 256);
        else dma4(csc + u.pn * BM + (wid - 4) * 64 + lane, sp + 1024 + (wid - 4) * 256);
    }
    __device__ __forceinline__ void operator()(const i32x4 (&acc)[2][2][4][2], const Unit& u, int wr, int wc, int fr, int fq) const {
        const int row0 = u.pm * BM + wr * 64 + fr, col0 = u.pn * BM + wc * 32 + 8 * fq;
        const PG8_LAS float* spf = (const PG8_LAS float*)sp;
        f32x4 cv[2][2];
#pragma unroll
        for (int bj = 0; bj < 2; ++bj)
#pragma unroll
            for (int n = 0; n < 2; ++n) cv[bj][n] = *(const PG8_LAS f32x4*)(spf + 256 + bj * HALF + wc * 32 + 8 * fq + 4 * n);
#pragma unroll
        for (int ai = 0; ai < 2; ++ai)
#pragma unroll
            for (int m = 0; m < 4; ++m) { const int row = row0 + ai * HALF + m * 16; const float rs = spf[ai * HALF + wr * 64 + m * 16 + fr]; bf16_t* rowp = O + (size_t)row * ldc + col0;
#pragma unroll
                for (int bj = 0; bj < 2; ++bj) { float v[8];
#pragma unroll
                    for (int n = 0; n < 2; ++n)
#pragma unroll
                        for (int q = 0; q < 4; ++q) v[4 * n + q] = (float)acc[ai][bj][m][n][q] * (rs * cv[bj][n][q]);
                    u32x4 w; w.x = cvt_pk_bf16(v[0], v[1]); w.y = cvt_pk_bf16(v[2], v[3]); w.z = cvt_pk_bf16(v[4], v[5]); w.w = cvt_pk_bf16(v[6], v[7]);
                    *(u32x4*)(rowp + bj * HALF) = w; } }
    }
};
__device__ __forceinline__ float swiglu_c(float g, float l) {
    g = fminf(g, 7.0f); l = fminf(fmaxf(l, -7.0f), 7.0f);
    const float s = __builtin_amdgcn_rcpf(1.0f + __builtin_amdgcn_exp2f(g * (-1.702f * 1.4426950408889634f)));
    return g * s * (l + 1.0f);
}
typedef float f32x2e __attribute__((ext_vector_type(2)));
__device__ __forceinline__ f32x2e swiglu_pk(f32x2e g, f32x2e l) {
    g.x = fminf(g.x, 7.0f); g.y = fminf(g.y, 7.0f);
    l.x = __builtin_amdgcn_fmed3f(l.x, -7.0f, 7.0f); l.y = __builtin_amdgcn_fmed3f(l.y, -7.0f, 7.0f);
    const f32x2e z = g * (-1.702f * 1.4426950408889634f);
    f32x2e d; d.x = __builtin_amdgcn_exp2f(z.x); d.y = __builtin_amdgcn_exp2f(z.y);
    d = d + 1.0f;
    f32x2e s; s.x = __builtin_amdgcn_rcpf(d.x); s.y = __builtin_amdgcn_rcpf(d.y);
    return (g * s) * (l + 1.0f);
}
typedef unsigned pg_u32x2 __attribute__((ext_vector_type(2)));
constexpr float ACT_F8_SCALE = 4.0f;
template <bool ACT_F8> struct EpiMoeUpT {
    static constexpr bool PERM = true, AFTER_DRAIN = false; static constexpr int NST = 8;
    bf16_t* O; const float* bias; const float* rsc; const float* csc; PG8_LAS unsigned char* sp;
    __device__ __forceinline__ void prefetch(const Unit& u, int wid, int lane) const {
        const int e = u.pn >> 3, pnl = u.pn & 7;
        if (wid < 4) dma4(rsc + u.pm * BM + wid * 64 + lane, sp + wid * 256);
        else if (wid < 6) { const float* b = bias + (size_t)e * 2048 + pnl * HALF + (wid - 4) * 64 + lane; dma4(b, sp + 1024 + (wid - 4) * 256); dma4(b + 1024, sp + 1536 + (wid - 4) * 256); }
        else { const float* c = csc + (size_t)e * 2048 + pnl * 256 + (wid - 6) * 64 + lane; dma4(c, sp + 2048 + (wid - 6) * 256); dma4(c + HALF, sp + 2560 + (wid - 6) * 256); }
    }
    __device__ __forceinline__ void operator()(const i32x4 (&acc)[2][2][4][2], const Unit& u, int wr, int wc, int fr, int fq) const {
        const int pnl = u.pn & 7;
        const int row0 = u.pm * BM + wr * 64 + fr, cg0 = pnl * HALF + wc * 32 + 8 * fq;
        const PG8_LAS float* spf = (const PG8_LAS float*)sp; const int cl = wc * 32 + 8 * fq;
        f32x4 bgv[2], blv[2], sgv[2], slv[2];
#pragma unroll
        for (int n = 0; n < 2; ++n) { bgv[n] = *(const PG8_LAS f32x4*)(spf + 256 + cl + 4 * n); blv[n] = *(const PG8_LAS f32x4*)(spf + 384 + cl + 4 * n); sgv[n] = *(const PG8_LAS f32x4*)(spf + 512 + cl + 4 * n); slv[n] = *(const PG8_LAS f32x4*)(spf + 640 + cl + 4 * n); }
#pragma unroll
        for (int ai = 0; ai < 2; ++ai)
#pragma unroll
            for (int m = 0; m < 4; ++m) { const int row = row0 + ai * HALF + m * 16; bf16_t* rowp = O + (size_t)row * 1024 + cg0; const float rs = spf[ai * HALF + wr * 64 + m * 16 + fr];
                float a[8];
#pragma unroll
                for (int n = 0; n < 2; ++n) {
#pragma unroll
                    for (int q = 0; q < 4; q += 2) {
                        const f32x2e gi = (f32x2e){(float)acc[ai][0][m][n][q], (float)acc[ai][0][m][n][q + 1]}, li = (f32x2e){(float)acc[ai][1][m][n][q], (float)acc[ai][1][m][n][q + 1]};
                        const f32x2e sg2 = (f32x2e){sgv[n][q], sgv[n][q + 1]} * rs, sl2 = (f32x2e){slv[n][q], slv[n][q + 1]} * rs;
                        const f32x2e r = swiglu_pk(gi * sg2 + (f32x2e){bgv[n][q], bgv[n][q + 1]}, li * sl2 + (f32x2e){blv[n][q], blv[n][q + 1]});
                        a[4 * n + q] = r.x; a[4 * n + q + 1] = r.y; } }
                if constexpr (ACT_F8) { unsigned w0 = 0u, w1 = 0u;
                    w0 = __builtin_amdgcn_cvt_pk_fp8_f32(a[0] * ACT_F8_SCALE, a[1] * ACT_F8_SCALE, w0, false); w0 = __builtin_amdgcn_cvt_pk_fp8_f32(a[2] * ACT_F8_SCALE, a[3] * ACT_F8_SCALE, w0, true);
                    w1 = __builtin_amdgcn_cvt_pk_fp8_f32(a[4] * ACT_F8_SCALE, a[5] * ACT_F8_SCALE, w1, false); w1 = __builtin_amdgcn_cvt_pk_fp8_f32(a[6] * ACT_F8_SCALE, a[7] * ACT_F8_SCALE, w1, true);
                    *(pg_u32x2*)((unsigned char*)O + (size_t)row * 1024 + cg0) = (pg_u32x2){w0, w1}; }
                else { u32x4 w; w.x = cvt_pk_bf16(a[0], a[1]); w.y = cvt_pk_bf16(a[2], a[3]); w.z = cvt_pk_bf16(a[4], a[5]); w.w = cvt_pk_bf16(a[6], a[7]);
                    *(u32x4*)rowp = w; } }
    }
};
typedef EpiMoeUpT<false> EpiMoeUp;
struct EpiMoeUpNoLoad {
    static constexpr bool PERM = true, AFTER_DRAIN = false; static constexpr int NST = 8;
    __device__ __forceinline__ void prefetch(const Unit&, int, int) const {}
    bf16_t* O; float k0, k1;
    __device__ __forceinline__ void operator()(const i32x4 (&acc)[2][2][4][2], const Unit& u, int wr, int wc, int fr, int fq) const {
        const int pnl = u.pn & 7;
        const int row0 = u.pm * BM + wr * 64 + fr, cg0 = pnl * HALF + wc * 32 + 8 * fq;
#pragma unroll
        for (int ai = 0; ai < 2; ++ai)
#pragma unroll
            for (int m = 0; m < 4; ++m) { const int row = row0 + ai * HALF + m * 16; bf16_t* rowp = O + (size_t)row * 1024 + cg0;
                float a[8];
#pragma unroll
                for (int n = 0; n < 2; ++n) {
#pragma unroll
                    for (int q = 0; q < 4; ++q) { const float g = (float)acc[ai][0][m][n][q] * k0 + k1, l = (float)acc[ai][1][m][n][q] * k0 + k1;
                        a[4 * n + q] = swiglu_c(g, l); } }
                u32x4 w; w.x = cvt_pk_bf16(a[0], a[1]); w.y = cvt_pk_bf16(a[2], a[3]); w.z = cvt_pk_bf16(a[4], a[5]); w.w = cvt_pk_bf16(a[6], a[7]);
                *(u32x4*)rowp = w; }
    }
};
struct EpiMoeUpNoStore {
    static constexpr bool PERM = true, AFTER_DRAIN = false; static constexpr int NST = 8;
    __device__ __forceinline__ void prefetch(const Unit&, int, int) const {}
    bf16_t* O; float k0, k1;
    __device__ __forceinline__ void operator()(const i32x4 (&acc)[2][2][4][2], const Unit& u, int wr, int wc, int fr, int fq) const {
        const int pnl = u.pn & 7;
        const int row0 = u.pm * BM + wr * 64 + fr, cg0 = pnl * HALF + wc * 32 + 8 * fq;
#pragma unroll
        for (int ai = 0; ai < 2; ++ai)
#pragma unroll
            for (int m = 0; m < 4; ++m) { const int row = row0 + ai * HALF + m * 16; bf16_t* rowp = O + (size_t)row * 1024 + cg0;
                float a[8];
#pragma unroll
                for (int n = 0; n < 2; ++n) {
#pragma unroll
                    for (int q = 0; q < 4; ++q) { const float g = (float)acc[ai][0][m][n][q] * k0 + k1, l = (float)acc[ai][1][m][n][q] * k0 + k1;
                        a[4 * n + q] = swiglu_c(g, l); } }
                u32x4 w; w.x = cvt_pk_bf16(a[0], a[1]); w.y = cvt_pk_bf16(a[2], a[3]); w.z = cvt_pk_bf16(a[4], a[5]); w.w = cvt_pk_bf16(a[6], a[7]);
                if (ai == 0 && m == 0) *(u32x4*)rowp = w; else asm volatile("" :: "v"(w)); }
    }
};
template <int SH> struct MoeOrder {
    const PG8_LAS int* ts; int G, c, total; int tsv;
    __device__ __forceinline__ bool next(int i, Unit& u) const {
        const int L = i * G + c; if (L >= total) return false;
        const int pm = L >> SH, pnl = L & ((1 << SH) - 1);
        const unsigned long long mk = __builtin_amdgcn_ballot_w64(pm >= tsv);
        const int e = __builtin_popcount((unsigned)mk & 0xfffffffeu);
        u.pm = pm; u.pn = (e << SH) + pnl; return true;
    }
    __device__ __forceinline__ void a_ready(const Unit&) const {}
    __device__ __forceinline__ void done(const Unit&) const {}
};
typedef int i32x4 __attribute__((ext_vector_type(4)));
template <bool I8> struct AccSel { typedef f32x4 T; };
template <> struct AccSel<true> { typedef i32x4 T; };
template <bool I8> __device__ __forceinline__ typename AccSel<I8>::T mma16(bf16x8 b, bf16x8 a, typename AccSel<I8>::T c) {
    if constexpr (I8) return __builtin_amdgcn_mfma_i32_16x16x64_i8(__builtin_bit_cast(i32x4, b), __builtin_bit_cast(i32x4, a), c, 0, 0, 0);
    else return __builtin_amdgcn_mfma_f32_16x16x32_bf16(b, a, c, 0, 0, 0);
}
typedef int i32x8 __attribute__((ext_vector_type(8)));
__device__ __forceinline__ f32x4 mma_f8(bf16x8 b0, bf16x8 b1, bf16x8 a0, bf16x8 a1, f32x4 c) {
    const i32x4 bl = __builtin_bit_cast(i32x4, b0), bh = __builtin_bit_cast(i32x4, b1), al = __builtin_bit_cast(i32x4, a0), ah = __builtin_bit_cast(i32x4, a1);
    const i32x8 bb = (i32x8){bl[0], bl[1], bl[2], bl[3], bh[0], bh[1], bh[2], bh[3]}, aa = (i32x8){al[0], al[1], al[2], al[3], ah[0], ah[1], ah[2], ah[3]};
    return __builtin_amdgcn_mfma_scale_f32_16x16x128_f8f6f4(bb, aa, c, 0, 0, 0, 0, 0, 0);
}
template <class Epi, class Sched, bool ALIGN_EPI = false, bool SP2 = false, bool I8 = false, bool GATHER = false, bool F8 = false>
__device__ __forceinline__ void gemm_phase(PG8_LAS unsigned char* lds, const Gemm g, const Sched& S, const Epi& E, const int* rowmap = nullptr) {
    int tid_ = threadIdx.x; asm volatile("" : "+v"(tid_));
    const int tid = tid_, wid = __builtin_amdgcn_readfirstlane(tid >> 6), lane = tid & 63, wr = wid >> 2, wc = wid & 3, fr = lane & 15, fq = lane >> 4;
    const int K = g.K, nt = K / BK;
    unsigned voffA, voffB;
    { int R, C; stage_rc(tid * 16, R, C); const int Rb = Epi::PERM ? ((R & ~31) + perm32(R & 31)) : R;
        voffA = (unsigned)(R * K + C) * 2u; voffB = (unsigned)(Rb * K + C) * 2u; }
    const size_t pstep = (size_t)128 * K;
    unsigned offA[2][2];
    constexpr int RM_OFF = STAGE_BYTES + 1024 + 3072;
    const size_t kstep = (size_t)(BK * 2);
    const size_t hstep = (size_t)HALF * K * 2;
    const size_t tstep = 2 * hstep;
    const unsigned ldsw = (unsigned)wid * 1024u;
    const int aoff = lds_byte(wr * 64 + fr, fq * 8), boff = lds_byte(wc * 32 + fr, fq * 8);
#define PG8_SA(b, h) (((b) * 2 + (h)) * HTB)
#define PG8_SB(b, h) ((4 + (b) * 2 + (h)) * HTB)
#define PG8_STAGE(bufoff, gbase, voff) do { _Pragma("unroll") for (int _i = 0; _i < 2; ++_i) \
        __builtin_amdgcn_global_load_lds((const unsigned*)((const char*)(gbase) + (_i ? pstep : (size_t)0) + (voff)), (PG8_LAS unsigned*)(lds + (bufoff) + ldsw + _i * 8192), 16, 0, 0); } while (0)
#define PG8_STAGE_A(bufoff, gbase, h, nextu) do { if constexpr (GATHER) { _Pragma("unroll") for (int _i = 0; _i < 2; ++_i) \
        __builtin_amdgcn_global_load_lds((const unsigned*)((const char*)(gbase) + offA[h][_i]), (PG8_LAS unsigned*)(lds + (bufoff) + ldsw + _i * 8192), 16, 0, 0); } \
    else { PG8_STAGE(bufoff, (gbase) + (h) * hstep, voffA); } } while (0)
#define PG8_GOFF(SRCEXPR) do { _Pragma("unroll") for (int _h = 0; _h < 2; ++_h) _Pragma("unroll") for (int _i = 0; _i < 2; ++_i) { int R_, C_; stage_rc(tid * 16 + _i * 8192, R_, C_); \
        const int ri_ = _h * HALF + R_; offA[_h][_i] = (unsigned)(SRCEXPR) * (unsigned)(K * 2) + (unsigned)(C_ * 2); } } while (0)
#define PG8_LDA(dst, b, h) do { _Pragma("unroll") for (int m = 0; m < 4; ++m) _Pragma("unroll") for (int k = 0; k < 2; ++k) dst[m][k] = *(const PG8_LAS bf16x8*)(lds + PG8_SA(b, h) + aoff + m * 2048 + k * 1024); } while (0)
#define PG8_LDB(dst, b, h) do { _Pragma("unroll") for (int n = 0; n < 2; ++n) _Pragma("unroll") for (int k = 0; k < 2; ++k) dst[n][k] = *(const PG8_LAS bf16x8*)(lds + PG8_SB(b, h) + boff + n * 2048 + k * 1024); } while (0)
#define PG8_MMA(ai, bj, At, Bt) do { __builtin_amdgcn_s_setprio(1); _Pragma("unroll") for (int m = 0; m < 4; ++m) _Pragma("unroll") for (int n = 0; n < 2; ++n) { \
        if constexpr (F8) { const f32x4 c_ = n ? __builtin_shufflevector(acc8[ai][bj][m], acc8[ai][bj][m], 4, 5, 6, 7) : __builtin_shufflevector(acc8[ai][bj][m], acc8[ai][bj][m], 0, 1, 2, 3); \
            const f32x4 d_ = mma_f8(Bt[n][0], Bt[n][1], At[m][0], At[m][1], c_); \
            if (n) { acc8[ai][bj][m][4] = d_[0]; acc8[ai][bj][m][5] = d_[1]; acc8[ai][bj][m][6] = d_[2]; acc8[ai][bj][m][7] = d_[3]; } else { acc8[ai][bj][m][0] = d_[0]; acc8[ai][bj][m][1] = d_[1]; acc8[ai][bj][m][2] = d_[2]; acc8[ai][bj][m][3] = d_[3]; } } \
        else { _Pragma("unroll") for (int k = 0; k < 2; ++k) acc[ai][bj][m][n] = mma16<I8>(Bt[n][k], At[m][k], acc[ai][bj][m][n]); } } __builtin_amdgcn_s_setprio(0); } while (0)
#define PG8_WAIT_V(n) asm volatile("s_waitcnt vmcnt(" #n ")" ::: "memory")
#define PG8_WAIT_L(n) asm volatile("s_waitcnt lgkmcnt(" #n ")" ::: "memory")
#define PG8_WAIT_VR(fl) do { if constexpr (F8) { PG8_WAIT_V(8); } else asm volatile("s_waitcnt vmcnt(%1)\n\tv_cmp_ne_u32_e32 vcc, 0, %0\n\ts_cbranch_vccnz 1f\n\ts_waitcnt vmcnt(8)\n1:" :: "v"(fl), "n"(8 + Epi::NST) : "vcc", "memory"); } while (0)
#define PG8_BAR __builtin_amdgcn_s_barrier()
#define PG8_SCHED __builtin_amdgcn_sched_barrier(0)
    Unit cur, nxt; int ui = 0;
    if (!S.next(0, cur)) return;
    typedef typename AccSel<I8>::T acc4; acc4 acc[2][2][4][2];
    typedef float f32x8 __attribute__((ext_vector_type(8))); f32x8 acc8[2][2][4];
#pragma unroll
    for (int a = 0; a < 2; ++a)
#pragma unroll
        for (int b = 0; b < 2; ++b)
#pragma unroll
            for (int m = 0; m < 4; ++m)
#pragma unroll
                for (int n = 0; n < 2; ++n) { acc[a][b][m][n] = (acc4){0, 0, 0, 0}; if constexpr (F8) acc8[a][b][m] = (f32x8){0.f, 0.f, 0.f, 0.f, 0.f, 0.f, 0.f, 0.f}; }
    bf16x8 At[4][2], B0[2][2], B1[2][2];
    const char* cA = GATHER ? (const char*)g.A : (const char*)g.A + (size_t)cur.pm * tstep; const char* cB = (const char*)g.Bt + (size_t)cur.pn * tstep;
    if constexpr (GATHER) { PG8_GOFF(rowmap[cur.pm * BM + ri_]); }
    S.a_ready(cur);
    if constexpr (SP2) {
        PG8_STAGE(PG8_SB(0, 0), cB, voffB); PG8_STAGE(PG8_SB(0, 1), cB + hstep, voffB); PG8_STAGE_A(PG8_SA(0, 0), cA, 0, false); PG8_STAGE_A(PG8_SA(0, 1), cA, 1, false);
        if (wr == 1) PG8_BAR;
        PG8_WAIT_V(2); PG8_BAR;
        PG8_STAGE(PG8_SB(1, 0), cB + kstep, voffB); PG8_STAGE_A(PG8_SA(1, 0), cA + kstep, 0, false); PG8_STAGE(PG8_SB(1, 1), cB + hstep + kstep, voffB);
        PG8_STAGE_A(PG8_SA(1, 1), cA + kstep, 1, false);
        PG8_WAIT_V(8); PG8_BAR;
    } else {
        PG8_STAGE(PG8_SB(0, 0), cB, voffB); PG8_STAGE_A(PG8_SA(0, 0), cA, 0, false); PG8_STAGE(PG8_SB(0, 1), cB + hstep, voffB); PG8_STAGE_A(PG8_SA(0, 1), cA, 1, false);
        if (wr == 1) PG8_BAR;
        PG8_WAIT_V(4); PG8_BAR;
        PG8_STAGE(PG8_SB(1, 0), cB + kstep, voffB); PG8_STAGE_A(PG8_SA(1, 0), cA + kstep, 0, false); PG8_STAGE(PG8_SB(1, 1), cB + hstep + kstep, voffB);
        PG8_WAIT_V(6); PG8_BAR;
    }
    for (;;) {
        const bool has_next = S.next(ui + 1, nxt);
        if constexpr (GATHER) { if (has_next && wid < 4) __builtin_amdgcn_global_load_lds((const unsigned*)(rowmap + nxt.pm * BM + wid * 64 + lane), (PG8_LAS unsigned*)(lds + RM_OFF + wid * 256), 4, 0, 0); }
        const char* nA = (has_next && !GATHER) ? (const char*)g.A + (size_t)nxt.pm * tstep : cA; const char* nB = has_next ? (const char*)g.Bt + (size_t)nxt.pn * tstep : cB;
        for (int t = 0; t < nt; t += 2) {
            const bool last = (t == nt - 2);
            asm volatile("" : "+v"(voffA), "+v"(voffB));
            const char* a1 = cA + (size_t)(t + 1) * kstep;
            const char* a2 = last ? nA : cA + (size_t)(t + 2) * kstep; const char* b2 = last ? nB : cB + (size_t)(t + 2) * kstep;
            const char* a3 = a2 + kstep; const char* b3 = b2 + kstep;
            if (last && has_next) S.a_ready(nxt);
            if (last) { int ln_ = lane; asm volatile("" : "+v"(ln_)); E.prefetch(cur, wid, ln_); }
            if constexpr (SP2) {
            const int fl = (t == 0 && ui > 0) ? 1 : 0;
            PG8_LDB(B0, 0, 0); PG8_LDB(B1, 0, 1); PG8_SCHED; PG8_LDA(At, 0, 0);
            if constexpr (GATHER) { if (last && has_next) { const PG8_LAS int* rm = (const PG8_LAS int*)(lds + RM_OFF); PG8_GOFF(rm[ri_]); } }
            PG8_WAIT_VR(fl); PG8_WAIT_L(0); PG8_BAR; PG8_MMA(0, 0, At, B0); PG8_MMA(0, 1, At, B1); PG8_BAR; PG8_SCHED;
            PG8_LDA(At, 0, 1); PG8_STAGE(PG8_SB(0, 0), b2, voffB); PG8_STAGE(PG8_SB(0, 1), b2 + hstep, voffB); PG8_STAGE_A(PG8_SA(0, 0), a2, 0, last);
            PG8_WAIT_VR(fl); PG8_WAIT_L(0); PG8_BAR; PG8_MMA(1, 0, At, B0); PG8_MMA(1, 1, At, B1); PG8_BAR; PG8_SCHED;
            PG8_LDB(B0, 1, 0); PG8_LDB(B1, 1, 1); PG8_SCHED; PG8_LDA(At, 1, 0); PG8_STAGE_A(PG8_SA(0, 1), a2, 1, last);
            PG8_WAIT_VR(fl); PG8_WAIT_L(0); PG8_BAR; PG8_MMA(0, 0, At, B0); PG8_MMA(0, 1, At, B1); PG8_BAR; PG8_SCHED;
            PG8_LDA(At, 1, 1); PG8_STAGE(PG8_SB(1, 0), b3, voffB); PG8_STAGE(PG8_SB(1, 1), b3 + hstep, voffB); PG8_STAGE_A(PG8_SA(1, 0), a3, 0, last);
            PG8_WAIT_V(8); PG8_WAIT_L(0); PG8_BAR; PG8_MMA(1, 0, At, B0); PG8_MMA(1, 1, At, B1); PG8_BAR; PG8_SCHED;
            PG8_STAGE_A(PG8_SA(1, 1), a3, 1, last);
            } else {
            PG8_LDB(B0, 0, 0); PG8_SCHED; PG8_LDA(At, 0, 0); PG8_STAGE_A(PG8_SA(1, 1), a1, 1, false);
            if constexpr (GATHER) { if (last && has_next) { const PG8_LAS int* rm = (const PG8_LAS int*)(lds + RM_OFF); PG8_GOFF(rm[ri_]); } }
            PG8_WAIT_L(8); PG8_BAR; PG8_WAIT_L(0); PG8_MMA(0, 0, At, B0); PG8_BAR; PG8_SCHED;
            PG8_LDB(B1, 0, 1); PG8_STAGE(PG8_SB(0, 0), b2, voffB);
            PG8_BAR; PG8_WAIT_L(0); PG8_MMA(0, 1, At, B1); PG8_BAR;
            PG8_LDA(At, 0, 1); PG8_STAGE_A(PG8_SA(0, 0), a2, 0, last);
            PG8_BAR; PG8_WAIT_L(0); PG8_MMA(1, 0, At, B0); PG8_BAR; PG8_SCHED;
            PG8_STAGE(PG8_SB(0, 1), b2 + hstep, voffB);
            PG8_WAIT_V(6); PG8_BAR; PG8_MMA(1, 1, At, B1); PG8_BAR;
            PG8_LDB(B0, 1, 0); PG8_SCHED; PG8_LDA(At, 1, 0); PG8_STAGE_A(PG8_SA(0, 1), a2, 1, last);
            PG8_WAIT_L(8); PG8_BAR; PG8_WAIT_L(0); PG8_MMA(0, 0, At, B0); PG8_BAR; PG8_SCHED;
            PG8_LDB(B1, 1, 1); PG8_STAGE(PG8_SB(1, 0), b3, voffB);
            PG8_BAR; PG8_WAIT_L(0); PG8_MMA(0, 1, At, B1); PG8_BAR;
            PG8_LDA(At, 1, 1); PG8_STAGE_A(PG8_SA(1, 0), a3, 0, last);
            PG8_BAR; PG8_WAIT_L(0); PG8_MMA(1, 0, At, B0); PG8_BAR; PG8_SCHED;
            PG8_STAGE(PG8_SB(1, 1), b3 + hstep, voffB);
            PG8_WAIT_V(6); PG8_BAR; PG8_MMA(1, 1, At, B1); PG8_BAR;
            }
        }
        if constexpr (ALIGN_EPI) { if (wr == 0) PG8_BAR; }
        if constexpr (F8 && !I8) {
#pragma unroll
            for (int a_ = 0; a_ < 2; ++a_)
#pragma unroll
                for (int b_ = 0; b_ < 2; ++b_)
#pragma unroll
                    for (int m = 0; m < 4; ++m) { acc[a_][b_][m][0] = __builtin_shufflevector(acc8[a_][b_][m], acc8[a_][b_][m], 0, 1, 2, 3); acc[a_][b_][m][1] = __builtin_shufflevector(acc8[a_][b_][m], acc8[a_][b_][m], 4, 5, 6, 7); } }
        if constexpr (!Epi::AFTER_DRAIN) { int t2_ = threadIdx.x; asm volatile("" : "+v"(t2_)); E(acc, cur, wr, wc, t2_ & 15, (t2_ & 63) >> 4); S.done(cur); }
        if (!has_next) break;
#pragma unroll
        for (int a = 0; a < 2; ++a)
#pragma unroll
            for (int b = 0; b < 2; ++b)
#pragma unroll
                for (int m = 0; m < 4; ++m)
#pragma unroll
                    for (int n = 0; n < 2; ++n) { acc[a][b][m][n] = (acc4){0, 0, 0, 0}; if constexpr (F8) acc8[a][b][m] = (f32x8){0.f, 0.f, 0.f, 0.f, 0.f, 0.f, 0.f, 0.f}; }
        cur = nxt; cA = nA; cB = nB; ++ui;
        if constexpr (ALIGN_EPI) { if (wr == 1) PG8_BAR; }
    }
    PG8_WAIT_V(0);
    if constexpr (!ALIGN_EPI) { if (wr == 0) PG8_BAR; }
    PG8_BAR;
    if constexpr (Epi::AFTER_DRAIN) { E.fused(acc, cur, wr, wc, fr, fq, lds, wid, lane); S.done(cur); }
#undef PG8_SA
#undef PG8_SB
#undef PG8_STAGE
#undef PG8_STAGE_A
#undef PG8_GOFF
#undef PG8_LDA
#undef PG8_LDB
#undef PG8_MMA
#undef PG8_WAIT_V
#undef PG8_WAIT_L
#undef PG8_WAIT_VR
#undef PG8_BAR
#undef PG8_SCHED
}
}
#include <hip/hip_bf16.h>
#include <cmath>
namespace attn_body {
using bf16=__hip_bfloat16;
using bf16x8=__attribute__((ext_vector_type(8)))short;
using s16x4=__attribute__((ext_vector_type(4)))short;
using f32x16=__attribute__((ext_vector_type(16)))float;
using u32x4=__attribute__((ext_vector_type(4)))unsigned;
constexpr float OSCALE=32.0f;
constexpr int BATCH=8,NHEAD=8,NKVH=2,SEQ=8192,D=64,PQ=2816,PO=1024;
constexpr int NW=8,QBLK=32,QB=QBLK*NW,KVBLK=64,NQB=SEQ/QB;
constexpr int ATTN_UNIT_ROWS=QB;
__device__ __forceinline__ int crow(int r,int hi){return (r&3)+8*(r>>2)+4*hi;}
#define SBAR() __builtin_amdgcn_sched_barrier(0)
__device__ __forceinline__ void cmask(f32x16&p0,f32x16&p1,int jb,int qrel,int hi){
  const float NEG=-INFINITY; int kb=64*jb+4*hi;
  #pragma unroll
  for(int r=0;r<16;++r){int kv=kb+(r&3)+8*(r>>2); if(kv>qrel)p0[r]=NEG; if(kv+32>qrel)p1[r]=NEG;}
}

constexpr int NSLOT=3, SLOTB=8192;
constexpr int LDS_K=0, LDS_V=NSLOT*SLOTB, LDS_WS=2*NSLOT*SLOTB, LDS_OST=LDS_WS+NW*64*4, LDS_BYTES=LDS_OST+NW*4096;
constexpr float C2=0.125f*1.4426950408889634f;
__device__ __forceinline__ void glds16(const void*gsrc,unsigned lds_dst){unsigned keep;
  asm volatile("s_mov_b32 %0, m0\n\ts_mov_b32 m0, %2\n\ts_nop 0\n\tglobal_load_lds_dwordx4 %1, off\n\ts_mov_b32 m0, %0":"=&s"(keep):"v"(gsrc),"s"(lds_dst):"memory");}
__device__ __forceinline__ float max3f(float a,float b,float c){float r;asm("v_max3_f32 %0, %1, %2, %3":"=v"(r):"v"(a),"v"(b),"v"(c));return r;}
__device__ __forceinline__ float max2f(float a,float b){float r;asm("v_max_f32_e32 %0, %1, %2":"=v"(r):"v"(a),"v"(b));return r;}
__device__ __forceinline__ float fadd_s(float a,float b){float r;asm("v_add_f32_e32 %0, %1, %2":"=v"(r):"v"(a),"v"(b));return r;}
__device__ __forceinline__ float fsub_s(float a,float b){float r;asm("v_sub_f32_e32 %0, %1, %2":"=v"(r):"v"(a),"v"(b));return r;}
typedef float f32x2_t __attribute__((ext_vector_type(2))); typedef __bf16 bf16x2_t __attribute__((ext_vector_type(2)));
__device__ __forceinline__ unsigned cvtpk_s(float lo,float hi){f32x2_t v={lo,hi};bf16x2_t b=__builtin_convertvector(v,bf16x2_t);return __builtin_bit_cast(unsigned,b);}
#define WAIT_BAR(N) asm volatile("s_waitcnt vmcnt(" #N ") lgkmcnt(0)\n\ts_barrier":::"memory")

__device__ __forceinline__ void qkt(f32x16&p0,f32x16&p1,const char*Kslot,const bf16x8*qr,const f32x16&negm,int r32,int hi){
  const char*kb=Kslot+hi*1024+r32*16;
  #pragma unroll
  for(int d0=0;d0<4;++d0){
    const bf16x8 b0=*reinterpret_cast<const bf16x8*>(kb+d0*2048);
    const bf16x8 b1=*reinterpret_cast<const bf16x8*>(kb+d0*2048+512);
    if(d0==0){p0=__builtin_amdgcn_mfma_f32_32x32x16_bf16(b0,qr[0],negm,0,0,0);p1=__builtin_amdgcn_mfma_f32_32x32x16_bf16(b1,qr[0],negm,0,0,0);}
    else{p0=__builtin_amdgcn_mfma_f32_32x32x16_bf16(b0,qr[d0],p0,0,0,0);p1=__builtin_amdgcn_mfma_f32_32x32x16_bf16(b1,qr[d0],p1,0,0,0);}}
}
typedef __attribute__((address_space(3))) const char* lds_cptr;
typedef short v4i16_t __attribute__((ext_vector_type(4)));
__device__ __forceinline__ void kload8(bf16x8*kf,lds_cptr kp){
  kf[0]=*(const __attribute__((address_space(3))) bf16x8*)(kp);      kf[1]=*(const __attribute__((address_space(3))) bf16x8*)(kp+512);
  kf[2]=*(const __attribute__((address_space(3))) bf16x8*)(kp+2048); kf[3]=*(const __attribute__((address_space(3))) bf16x8*)(kp+2560);
  kf[4]=*(const __attribute__((address_space(3))) bf16x8*)(kp+4096); kf[5]=*(const __attribute__((address_space(3))) bf16x8*)(kp+4608);
  kf[6]=*(const __attribute__((address_space(3))) bf16x8*)(kp+6144); kf[7]=*(const __attribute__((address_space(3))) bf16x8*)(kp+6656);
}
__device__ __forceinline__ void kload2(bf16x8*kf,lds_cptr kp,int j){ kf[2*j]=*(const __attribute__((address_space(3))) bf16x8*)(kp+j*2048); kf[2*j+1]=*(const __attribute__((address_space(3))) bf16x8*)(kp+j*2048+512); }
__device__ __forceinline__ s16x4 vtr(lds_cptr p){ return __builtin_bit_cast(s16x4,__builtin_amdgcn_ds_read_tr16_b64_v4i16((__attribute__((address_space(3))) v4i16_t*)p)); }
__device__ __forceinline__ float rowmax(const f32x16&p0,const f32x16&p1){
  float a=max3f(p0[0],p0[1],p1[0]),b=max3f(p0[2],p0[3],p1[1]);a=max3f(a,p1[2],p1[3]);
  #pragma unroll
  for(int r=4;r<16;r+=4){a=max3f(a,p0[r],p0[r+1]);b=max3f(b,p0[r+2],p0[r+3]);a=max3f(a,p1[r],p1[r+1]);b=max3f(b,p1[r+2],p1[r+3]);}
  const float m=max2f(a,b);
  auto rr=__builtin_amdgcn_permlane32_swap(__float_as_uint(m),__float_as_uint(m),false,false);
  return max2f(__uint_as_float(rr[0]),__uint_as_float(rr[1]));
}
__device__ __forceinline__ void pv(f32x16*o,int vb,bf16x8 pa0,bf16x8 pa1,bf16x8 pa2,bf16x8 pa3){
  #pragma unroll
  for(int d0=0;d0<2;++d0){s16x4 lo[4],hi[4];
    #pragma unroll
    for(int ks=0;ks<4;++ks){
      asm volatile("ds_read_b64_tr_b16 %0,%1 offset:%c2":"=&v"(lo[ks]):"v"(vb),"i"(d0*4096+ks*1024):"memory");
      asm volatile("ds_read_b64_tr_b16 %0,%1 offset:%c2":"=&v"(hi[ks]):"v"(vb),"i"(d0*4096+ks*1024+512):"memory");}
    asm volatile("s_waitcnt lgkmcnt(0)":::"memory");SBAR();
    #define PK(k) (bf16x8){lo[k][0],lo[k][1],lo[k][2],lo[k][3],hi[k][0],hi[k][1],hi[k][2],hi[k][3]}
    o[d0]=__builtin_amdgcn_mfma_f32_32x32x16_bf16(pa0,PK(0),o[d0],0,0,0);
    o[d0]=__builtin_amdgcn_mfma_f32_32x32x16_bf16(pa1,PK(1),o[d0],0,0,0);
    o[d0]=__builtin_amdgcn_mfma_f32_32x32x16_bf16(pa2,PK(2),o[d0],0,0,0);
    o[d0]=__builtin_amdgcn_mfma_f32_32x32x16_bf16(pa3,PK(3),o[d0],0,0,0);
    #undef PK
  }
}

#ifndef ATTN_STORE16
#define ATTN_STORE16(p,v) (*(u32x4*)(p)=(v))
#endif
template<int THRL> __device__ __forceinline__ void attn_unit(int b,int h,int qb,const bf16*Q,const bf16*__restrict__ K,const bf16*__restrict__ V,bf16*O,char*shm,const float*qg,const float nref){
  int tid_=threadIdx.x; asm volatile("":"+v"(tid_)); const int tid=tid_,lane=tid&63,r32=lane&31,hi=lane>>5; const int wid=__builtin_amdgcn_readfirstlane(tid>>6);
  const long rowbase=(long)b*SEQ; const int q0=qb*QB;
  const bf16*Qw=Q+(rowbase+q0+wid*QBLK)*PQ+h*D;
  const bf16*Kh=K+rowbase*PQ+(h>>2)*D,*Vh=V+rowbase*PQ+(h>>2)*D;
  const unsigned lds0=(unsigned)(uintptr_t)shm;
  float*wsf=(float*)(shm+LDS_WS)+wid*64;
  const bf16*ksrc=Kh+(long)lane*PQ+wid*8;
  const bf16*vsrc=Vh+(long)(16*(wid&3)+(lane>>2))*PQ+(wid>>2)*32+(lane&3)*8;
  const unsigned kdst=lds0+LDS_K+wid*1024, vdst=lds0+LDS_V+wid*1024;
  #define DMA_K(t,slot) glds16(ksrc+(long)(t)*KVBLK*PQ,(unsigned)__builtin_amdgcn_readfirstlane(kdst+(slot)))
  #define DMA_V(t,slot) glds16(vsrc+(long)(t)*KVBLK*PQ,(unsigned)__builtin_amdgcn_readfirstlane(vdst+(slot)))
  const int vb0=(int)(lds0+LDS_V)+((lane>>4)&1)*32+(lane&3)*8+(4*hi+((lane&15)>>2))*64;
  const char*Kbase=shm+LDS_K; bf16x8 kf[8];
  const lds_cptr shm3=(lds_cptr)shm; const lds_cptr kp0=shm3+LDS_K+hi*1024+r32*16; const lds_cptr vp0=shm3+LDS_V+((lane>>4)&1)*32+(lane&3)*8+(4*hi+((lane&15)>>2))*64;
  constexpr int NT=SEQ/KVBLK;
  DMA_K(0,0);DMA_V(0,0);DMA_K(1,SLOTB);
  bf16x8 qr[4];
  #pragma unroll
  for(int d0=0;d0<4;++d0)qr[d0]=*reinterpret_cast<const bf16x8*>(&Qw[(long)r32*PQ+d0*16+hi*8]);
  {
    float y[4][8]; float ss=0.f;
    #pragma unroll
    for(int d0=0;d0<4;++d0){
      #pragma unroll
      for(int j=0;j<8;++j){ y[d0][j]=__uint_as_float(((unsigned)(unsigned short)qr[d0][j])<<16); ss+=y[d0][j]*y[d0][j]; } }
    { auto rr=__builtin_amdgcn_permlane32_swap(__float_as_uint(ss),__float_as_uint(ss),false,false); ss=__uint_as_float(rr[0])+__uint_as_float(rr[1]); }
    const float rs=__builtin_amdgcn_rsqf(ss*(1.f/64.f)+1e-6f);
    const int spos=q0+wid*QBLK+r32; const float rid=(float)(spos>>6),cid=(float)(spos&63);
    #pragma unroll
    for(int j=0;j<8;++j){ const float fr=__builtin_amdgcn_exp2f(-(float)(8*hi+j)*(13.287712379549449f/16.f));
      const float cr=__cosf(rid*fr),sr=__sinf(rid*fr),cc=__cosf(cid*fr),sc=__sinf(cid*fr);
      const float a1=y[0][j]*rs*qg[8*hi+j],a2=y[1][j]*rs*qg[16+8*hi+j],b1=y[2][j]*rs*qg[32+8*hi+j],b2=y[3][j]*rs*qg[48+8*hi+j];
      y[0][j]=(a1*cr-a2*sr)*C2; y[1][j]=(a2*cr+a1*sr)*C2; y[2][j]=(b1*cc-b2*sc)*C2; y[3][j]=(b2*cc+b1*sc)*C2; }
    #pragma unroll
    for(int d0=0;d0<4;++d0){ u32x4 w; w.x=cvtpk_s(y[d0][0],y[d0][1]); w.y=cvtpk_s(y[d0][2],y[d0][3]); w.z=cvtpk_s(y[d0][4],y[d0][5]); w.w=cvtpk_s(y[d0][6],y[d0][7]); qr[d0]=__builtin_bit_cast(bf16x8,w); }
  }
  float l_reg=0.f;f32x16 o[2];o[0]=f32x16{};o[1]=f32x16{};f32x16 negm; _Pragma("unroll") for(int r=0;r<16;++r)negm[r]=nref; asm volatile("":"+v"(negm));
  #define CMASK(P0,P1,t) do{}while(0)
  #define START(P0,P1) do{ _Pragma("unroll") for(int r=0;r<16;++r)P0[r]=__builtin_amdgcn_exp2f(P0[r]); }while(0)
  #define RESC() do{}while(0)
  f32x16 pA0,pA1,pB0,pB1;
  int sl_prev=0,sl_cur=0,sl_next=SLOTB;
  #define ROT() do{sl_prev=sl_cur;sl_cur=sl_next;sl_next=(sl_next==(NSLOT-1)*SLOTB)?0:sl_next+SLOTB;}while(0)
  DMA_K(2,2*SLOTB);
  WAIT_BAR(3);
  qkt(pA0,pA1,Kbase,qr,negm,r32,hi);asm volatile("s_nop 15\n\ts_nop 7":"+v"(pA0),"+v"(pA1));CMASK(pA0,pA1,0);
  START(pA0,pA1);
  _Pragma("unroll") for(int r=0;r<16;++r)pA1[r]=__builtin_amdgcn_exp2f(pA1[r]);
  WAIT_BAR(0);
  DMA_K(3,0);DMA_V(1,SLOTB);
  ROT();
  kload8(kf,kp0+sl_cur);
  WAIT_BAR(2);
  s16x4 vlo[8],vhi[8]; u32x4 pw0,pw1,pw2,pw3;
  #define PKW(P,B) cvtpk_s(P[B],P[B+1])
  #define PAF(k) __builtin_bit_cast(bf16x8,pw##k)
  #define VFR(i) (bf16x8){vlo[i][0],vlo[i][1],vlo[i][2],vlo[i][3],vhi[i][0],vhi[i][1],vhi[i][2],vhi[i][3]}
  #define PIN(x) asm volatile("":"+v"(x))
  #define MX3(a,b,c) __builtin_fmaxf(__builtin_fmaxf((a),(b)),(c))
  #define GAPA(MF,A0,A1,A2,A3,W0,W1,PW) do{ MF; sacc+=A0; sacc+=A1; sacc+=A2; sacc+=A3; PIN(sacc); W0; W1; PIN(PW); SBAR(); }while(0)
  #define EX(v) __builtin_amdgcn_exp2f(v)
  #define GAPB(MF,X,B) do{ MF; X[B]=EX(X[B]); X[B+1]=EX(X[B+1]); X[B+2]=EX(X[B+2]); X[B+3]=EX(X[B+3]); PIN(X); SBAR(); }while(0)
  #define VRD(i) do{ vlo[i]=vtr(vp_+(((i)>>2)*4096+((i)&3)*1024)); vhi[i]=vtr(vp_+(((i)>>2)*4096+((i)&3)*1024+512)); }while(0)
  #define KRD(G,j) do{ if(G){ kload2(kf,kp0+sl_next,j); SBAR(); } }while(0)
  #define STEP(C0,C1,P0,P1,t,GK,GV,GL) do{ SBAR(); \
    const lds_cptr vp_=vp0+sl_prev; \
    VRD(0); SBAR(); float sacc=(P0[0]+P0[1]); \
    GAPA(C0=__builtin_amdgcn_mfma_f32_32x32x16_bf16(kf[0],qr[0],negm,0,0,0), P0[2],P0[3],P0[4],P0[5],     pw0[0]=PKW(P0,0), pw0[1]=PKW(P0,2), pw0); \
    VRD(4); SBAR(); GAPA(C1=__builtin_amdgcn_mfma_f32_32x32x16_bf16(kf[1],qr[0],negm,0,0,0), P0[6],P0[7],P0[8],P0[9],     pw0[2]=PKW(P0,4), pw0[3]=PKW(P0,6), pw0); \
    VRD(1); SBAR(); GAPA(C0=__builtin_amdgcn_mfma_f32_32x32x16_bf16(kf[2],qr[1],C0,0,0,0),   P0[10],P0[11],P0[12],P0[13], pw1[0]=PKW(P0,8), pw1[1]=PKW(P0,10), pw1); \
    VRD(5); SBAR(); GAPA(C1=__builtin_amdgcn_mfma_f32_32x32x16_bf16(kf[3],qr[1],C1,0,0,0),   P0[14],P0[15],P1[0],P1[1],   pw1[2]=PKW(P0,12),pw1[3]=PKW(P0,14), pw1); \
    VRD(2); SBAR(); GAPA(C0=__builtin_amdgcn_mfma_f32_32x32x16_bf16(kf[4],qr[2],C0,0,0,0),   P1[2],P1[3],P1[4],P1[5],     pw2[0]=PKW(P1,0), pw2[1]=PKW(P1,2), pw2); \
    VRD(6); SBAR(); GAPA(C1=__builtin_amdgcn_mfma_f32_32x32x16_bf16(kf[5],qr[2],C1,0,0,0),   P1[6],P1[7],P1[8],P1[9],     pw2[2]=PKW(P1,4), pw2[3]=PKW(P1,6), pw2); \
    VRD(3); SBAR(); GAPA(C0=__builtin_amdgcn_mfma_f32_32x32x16_bf16(kf[6],qr[3],C0,0,0,0),   P1[10],P1[11],P1[12],P1[13], pw3[0]=PKW(P1,8), pw3[1]=PKW(P1,10), pw3); \
    VRD(7); SBAR(); GAPA(C1=__builtin_amdgcn_mfma_f32_32x32x16_bf16(kf[7],qr[3],C1,0,0,0),   P1[14],P1[15],0.f,0.f,       pw3[2]=PKW(P1,12),pw3[3]=PKW(P1,14), pw3); \
    l_reg+=sacc; \
    if(GK){DMA_K((t)+3,sl_cur);} if(GV){DMA_V((t)+1,sl_next);} \
    CMASK(C0,C1,t); \
    SBAR(); \
    GAPB(o[0]=__builtin_amdgcn_mfma_f32_32x32x16_bf16(PAF(0),VFR(0),o[0],0,0,0), C0,0); \
    GAPB(o[1]=__builtin_amdgcn_mfma_f32_32x32x16_bf16(PAF(0),VFR(4),o[1],0,0,0), C0,4); \
    KRD(GL,0); GAPB(o[0]=__builtin_amdgcn_mfma_f32_32x32x16_bf16(PAF(1),VFR(1),o[0],0,0,0), C0,8); \
    KRD(GL,1); GAPB(o[1]=__builtin_amdgcn_mfma_f32_32x32x16_bf16(PAF(1),VFR(5),o[1],0,0,0), C0,12); \
    KRD(GL,2); GAPB(o[0]=__builtin_amdgcn_mfma_f32_32x32x16_bf16(PAF(2),VFR(2),o[0],0,0,0), C1,0); \
    KRD(GL,3); GAPB(o[1]=__builtin_amdgcn_mfma_f32_32x32x16_bf16(PAF(2),VFR(6),o[1],0,0,0), C1,4); \
    GAPB(o[0]=__builtin_amdgcn_mfma_f32_32x32x16_bf16(PAF(3),VFR(3),o[0],0,0,0), C1,8); \
    GAPB(o[1]=__builtin_amdgcn_mfma_f32_32x32x16_bf16(PAF(3),VFR(7),o[1],0,0,0), C1,12); \
    }while(0)
  int t=1;
  #undef CMASK
  #define CMASK(P0,P1,t) do{}while(0)
  for(;t+5<NT;t+=2){
    STEP(pB0,pB1,pA0,pA1,t,true,true,true);     WAIT_BAR(2); RESC(); ROT();
    STEP(pA0,pA1,pB0,pB1,t+1,true,true,true);   WAIT_BAR(2); RESC(); ROT();
  }
  #undef CMASK
  #define CMASK(P0,P1,t) do{}while(0)
  #define ENDW(tt) do{ if((tt)+3<NT){WAIT_BAR(2);} else if((tt)+2<NT){WAIT_BAR(1);} else {WAIT_BAR(0);} }while(0)
  for(;t+1<NT;t+=2){
    STEP(pB0,pB1,pA0,pA1,t,(t+3<NT),(t+1<NT),(t+1<NT));       ENDW(t);   RESC(); ROT();
    STEP(pA0,pA1,pB0,pB1,t+1,(t+4<NT),(t+2<NT),(t+2<NT));     ENDW(t+1); RESC(); ROT();
  }
  STEP(pB0,pB1,pA0,pA1,NT-1,false,false,false); RESC();
  { float sacc=pB0[0]+pB0[1]; _Pragma("unroll") for(int r=2;r<16;++r)sacc+=pB0[r]; _Pragma("unroll") for(int r=0;r<16;++r)sacc+=pB1[r]; l_reg+=sacc;
    pw0=(u32x4){PKW(pB0,0),PKW(pB0,2),PKW(pB0,4),PKW(pB0,6)};pw1=(u32x4){PKW(pB0,8),PKW(pB0,10),PKW(pB0,12),PKW(pB0,14)};pw2=(u32x4){PKW(pB1,0),PKW(pB1,2),PKW(pB1,4),PKW(pB1,6)};pw3=(u32x4){PKW(pB1,8),PKW(pB1,10),PKW(pB1,12),PKW(pB1,14)};
    SBAR(); pv(o,vb0+sl_cur,PAF(0),PAF(1),PAF(2),PAF(3)); }
  #undef PKW
  #undef PAF
  #undef VFR
  #undef PIN
  #undef MX3
  #undef GAPA
  #undef GAPB
  #undef EX
  #undef VRD
  #undef KRD
  #undef STEP
  #undef ENDW
  {auto rr=__builtin_amdgcn_permlane32_swap(__float_as_uint(l_reg),__float_as_uint(l_reg),false,false);l_reg=__uint_as_float(rr[0])+__uint_as_float(rr[1]);}
  if(hi==0)wsf[32+r32]=l_reg;asm volatile("s_waitcnt lgkmcnt(0)":::"memory");
  float rli[16];
  #pragma unroll
  for(int r=0;r<16;++r)rli[r]=__builtin_amdgcn_rcpf(wsf[32+crow(r,hi)]);
  unsigned char*Ow=(unsigned char*)O+(rowbase+q0+wid*QBLK)*PO+h*D;
  { unsigned char*stg=(unsigned char*)(shm+LDS_OST)+wid*2048;
    #pragma unroll
    for(int r=0;r<16;++r){const int orow=crow(r,hi); const float sc=rli[r]*OSCALE;
      #pragma unroll
      for(int d0=0;d0<2;++d0){ const float v=__builtin_amdgcn_fmed3f(o[d0][r]*sc,-448.0f,448.0f); stg[orow*64+d0*32+r32]=(unsigned char)(__builtin_amdgcn_cvt_pk_fp8_f32(v,0.f,0u,false)&0xffu); } }
    asm volatile("s_waitcnt lgkmcnt(0)":::"memory");
    #pragma unroll
    for(int i=0;i<2;++i){const int row=i*16+(lane>>2),ch=lane&3; const u32x4 v=*(const u32x4*)(stg+row*64+ch*16); ATTN_STORE16(Ow+(long)row*PO+ch*16,v);} }
  asm volatile("s_waitcnt lgkmcnt(0)\n\ts_barrier":::"memory");
  #undef DMA_K
  #undef DMA_V
  #undef CMASK
  #undef START
  #undef RESC
  #undef ROT
}
constexpr int ATTN_LDS_BYTES=LDS_BYTES;
struct AttnTensors { const bf16* Q; const bf16* K; const bf16* V; bf16* O; const float* qg; const float* kg; };
template<int THRL=8> __device__ __forceinline__ void attn_phase(char*lds,const AttnTensors&T,int vcu,int G){
  float gq=fabsf(T.qg[threadIdx.x&63]),gk=fabsf(T.kg[threadIdx.x&63]);
  gq=wmax64(gq); gk=wmax64(gk);
  const float nref=__uint_as_float(__builtin_amdgcn_readfirstlane(__float_as_uint(-(64.f*C2*gq*gk*1.02f+0.25f))));
  for(int L=vcu;L<BATCH*NHEAD*NQB;L+=G){
    const int pair=((L>>5)&7)*2+((L>>8)>>2), idx=(L&31)+32*((L>>8)&3);
    const int b=pair>>1, h=(pair&1)*4+(idx>>5), qb=idx&31;
    attn_unit<THRL>(b,h,qb,T.Q,T.K,T.V,T.O,lds,T.qg,nref);
  }
}
#undef SBAR
#undef WAIT_BAR
}
constexpr int NWAVES = 8;
constexpr int NTHR = NWAVES * 64;
constexpr int BATCH = 8, T = 8192, D = 1024, DEPTH = 2;
constexpr int M = BATCH * T;
constexpr int INW = 2816;
constexpr int C_QA = 0, C_KA = 512, C_VA = 640, C_QR = 768, C_KR = 1280, C_VR = 1792, C_GR = 2304;
constexpr int NE = 32, TOPK = 4, NASG = M * TOPK;
constexpr int XS_ROWS = NASG + NE * 256;
constexpr int RCH = 128, NCH = T / RCH, RH = 4;
constexpr int RUNITS = BATCH * RH * NCH;
constexpr float EPS = 1e-6f;
constexpr float LOG2E = 1.4426950408889634f;

constexpr size_t MiB = 1u << 20;
constexpr size_t WS_CTL = 0, CTL_ZERO_BYTES = 2 * MiB;
constexpr size_t WS_MOD = 512 * 1024;
constexpr size_t WS_CMAXIN = 256 * 1024, WS_CSCIN = 320 * 1024;
constexpr size_t WS_CMAX = 1 * MiB;
constexpr size_t WS_CSCDN = 1 * MiB;
constexpr size_t WS_CSCOUT = 1 * MiB + 256 * 1024;
constexpr float CAT_S_ATT = 32.0f, CAT_S_RET = 8.0f;
static_assert(attn_body::OSCALE == CAT_S_ATT, "attention output scale");
constexpr size_t WS_CSC = 1 * MiB + 512 * 1024;
constexpr size_t WS_WIN = 2 * MiB;
constexpr size_t WS_WOUT = 13 * MiB;
constexpr size_t WS_WUP = 17 * MiB;
constexpr size_t WS_WDN = 273 * MiB;
constexpr size_t WS_HM = 401 * MiB;
constexpr size_t WS_TOPI = 529 * MiB, WS_TOPW = 530 * MiB, WS_POS = 531 * MiB;
constexpr size_t WS_PROJ = 532 * MiB;
constexpr size_t WS_CAT = 884 * MiB;
constexpr size_t WS_YM = 1012 * MiB;
constexpr size_t WS_U = 1140 * MiB;
constexpr size_t WS_FT = 1396 * MiB;
constexpr size_t WS_XS = 532 * MiB;
constexpr size_t WS_ACT = 1060 * MiB;
constexpr size_t WS_HS = 1588 * MiB;
constexpr size_t WS_XSC = 1589 * MiB;
constexpr size_t WS_RMAP = 1591 * MiB;
constexpr size_t WS_END = 1593 * MiB;
constexpr size_t WS_DUMMY = 1593 * MiB;
static_assert(WS_MOD + (size_t)DEPTH * BATCH * 6 * D * 4 <= CTL_ZERO_BYTES, "mod inside the memset region");
static_assert(WS_XS + (size_t)XS_ROWS * 1024 * 2 <= WS_ACT && WS_ACT + (size_t)XS_ROWS * 1024 * 2 <= WS_END, "moe map");
static_assert(WS_PROJ + (size_t)M * INW * 2 <= WS_CAT && WS_FT + (size_t)RUNITS * 2 * 16384 * 2 <= WS_END, "mixer map");
constexpr int CW_TMO = 0, CW_CODE = 1;
constexpr int CW_BAR = 4096;
constexpr int CW_CNT = 8192;
constexpr int CW_WQ = 8192 + 1024;
constexpr int CW_CUR = 8192 + 256;

constexpr int RING_OFF = 0, RING_BYTES = 131072;
constexpr int LDSCTL_OFF = RING_BYTES;
constexpr int LCNT_OFF = LDSCTL_OFF, LTS_OFF = LDSCTL_OFF + 128, MISC_OFF = LDSCTL_OFF + 320;
constexpr int EPI_SP_OFF = LDSCTL_OFF + 1024;
constexpr int GAIN_OFF = LDSCTL_OFF + 6144;
constexpr int LDS_BYTES = 147456;
#define GAS __attribute__((address_space(1)))
#define LAS __attribute__((address_space(3)))
typedef unsigned short bf16;
typedef unsigned v4u __attribute__((ext_vector_type(4)));
typedef float f32x4 __attribute__((ext_vector_type(4)));
typedef short bf16x8 __attribute__((ext_vector_type(8)));
typedef GAS unsigned gu32;
typedef GAS unsigned long long gu64;
#define RLX_AGENT __ATOMIC_RELAXED, __HIP_MEMORY_SCOPE_AGENT
#define LDS_WAIT() asm volatile("s_waitcnt lgkmcnt(0)" ::: "memory")
#define VM_WAIT() asm volatile("s_waitcnt vmcnt(0)" ::: "memory")
__device__ __forceinline__ unsigned long long rt() { return __builtin_amdgcn_s_memrealtime(); }
__device__ __forceinline__ unsigned f2bf(float f) { unsigned u = __builtin_bit_cast(unsigned, f); return (u + 0x7fffu + ((u >> 16) & 1u)) >> 16; }
__device__ __forceinline__ unsigned pk2(float lo, float hi) { return f2bf(lo) | (f2bf(hi) << 16); }

#define XB_TMO      128
#define XB_XCNT(j)  (256  + 64 * (j))
#define XB_XSUB(j)  (1280 + 64 * (j))
#define XB_XGEN(j)  (2304 + 64 * (j))
#define XB_TOP      3328
#define XB_TOPGEN   3392
#define XCD_BAR_WORDS 3456
#define XB_SPIN_CAP (1u << 18)

__device__ __forceinline__ unsigned xb_ld(unsigned* p)              { return __hip_atomic_load(p, __ATOMIC_RELAXED, __HIP_MEMORY_SCOPE_AGENT); }
__device__ __forceinline__ unsigned xb_add(unsigned* p, unsigned v) { return __hip_atomic_fetch_add(p, v, __ATOMIC_RELAXED, __HIP_MEMORY_SCOPE_AGENT); }
__device__ __forceinline__ unsigned xb_xcc_id() { return (unsigned)__builtin_amdgcn_s_getreg((3 << 11) | 20) & 0xFu; }
#define XB_SPIN(cond, bar) do { unsigned _sp = 0; while (cond) { __builtin_amdgcn_s_sleep(1); \
    if ((++_sp & 255u) == 0u) { if (xb_ld(&(bar)[XB_TMO])) break; if (_sp > XB_SPIN_CAP) { atomicAdd(&(bar)[XB_TMO], 1u); break; } } } } while (0)

struct XcdBarrier {
    unsigned* bar; unsigned x;
    volatile LAS unsigned* st;
};

__device__ __forceinline__ XcdBarrier xcd_barrier_post(unsigned* bar, volatile LAS unsigned* st) {
    XcdBarrier b; b.bar = bar; b.x = xb_xcc_id(); b.st = st;
    if (threadIdx.x == 0) (void)xb_add(&bar[XB_XCNT(b.x)], 1u);
    return b;
}
__device__ __forceinline__ void xcd_barrier_complete(unsigned* bar, unsigned x, unsigned& nloc, unsigned& nx) {
    const unsigned G = gridDim.x * gridDim.y * gridDim.z;
    unsigned sum, cnt, mine, sp = 0u;
    for (;;) {
        sum = 0u; cnt = 0u; mine = 0u;
#pragma unroll
        for (unsigned j = 0; j < 16; ++j) { const unsigned c = xb_ld(&bar[XB_XCNT(j)]); sum += c; cnt += (c > 0u) ? 1u : 0u; mine = (j == x) ? c : mine; }
        if (sum == G) break;
        __builtin_amdgcn_s_sleep(1);
        if ((++sp & 255u) == 0u) { if (xb_ld(&bar[XB_TMO])) break; if (sp > XB_SPIN_CAP) { atomicAdd(&bar[XB_TMO], 1u); break; } }
    }
    nloc = mine > 0u ? mine : 1u; nx = cnt > 0u ? cnt : 1u;
}

__device__ __forceinline__ void xcd_barrier(const XcdBarrier& b) {
    asm volatile("s_waitcnt vmcnt(0)" ::: "memory");
    __syncthreads();
    if (threadIdx.x == 0) {
        unsigned* bar = b.bar;
        __builtin_amdgcn_s_waitcnt(0);
        unsigned nloc = b.st[0], nx = b.st[1];
        if (nloc == 0u) { xcd_barrier_complete(bar, b.x, nloc, nx); b.st[0] = nloc; b.st[1] = nx; }
        const unsigned old = xb_add(&bar[XB_XSUB(b.x)], 1u);
        const unsigned gen = old / nloc;
        if (old + 1u == (gen + 1u) * nloc) {
            __builtin_amdgcn_fence(__ATOMIC_RELEASE, "agent");
            asm volatile("s_waitcnt vmcnt(0)" ::: "memory");
            const unsigned og = xb_add(&bar[XB_TOP], 1u);
            const unsigned tg = og / nx;
            if (og + 1u == (tg + 1u) * nx) xb_add(&bar[XB_TOPGEN], 1u);
            else XB_SPIN(xb_ld(&bar[XB_TOPGEN]) == tg, bar);
            __builtin_amdgcn_fence(__ATOMIC_ACQUIRE, "agent");
            xb_add(&bar[XB_XGEN(b.x)], 1u);
            asm volatile("s_waitcnt vmcnt(0)" ::: "memory");
        } else {
            XB_SPIN(xb_ld(&bar[XB_XGEN(b.x)]) == gen, bar);
            __builtin_amdgcn_fence(__ATOMIC_ACQUIRE, "agent");
            asm volatile("s_waitcnt vmcnt(0)" ::: "memory");
        }
    }
    __syncthreads();
}

typedef unsigned u32x2 __attribute__((ext_vector_type(2)));
typedef short s16x4 __attribute__((ext_vector_type(4)));
typedef float f32x16 __attribute__((ext_vector_type(16)));
typedef int i32x4 __attribute__((ext_vector_type(4)));
struct Frame {
    LAS unsigned char* lds;
    volatile LAS unsigned* MISC;
    gu32* ctl;
    int tid, lane, wave, vcu, G;
};
__device__ __forceinline__ float wave_sum(float v) {
    return wsum64(v);
}
__device__ __forceinline__ float bflo(unsigned w) { return __uint_as_float(w << 16); }
__device__ __forceinline__ float bfhi(unsigned w) { return __uint_as_float(w & 0xffff0000u); }
__device__ __forceinline__ unsigned pkbf(float lo, float hi) { return pg8::cvt_pk_bf16(lo, hi); }
__device__ __forceinline__ float fexp2(float x) { return __builtin_amdgcn_exp2f(x); }
__device__ __forceinline__ float frsq(float x) { return __builtin_amdgcn_rsqf(x); }
__device__ __forceinline__ float frcp(float x) { return __builtin_amdgcn_rcpf(x); }
__device__ __forceinline__ float row_rstd(const f32x4 (&v)[4]) {
    float s = 0.f;
#pragma unroll
    for (int j = 0; j < 4; ++j) s += (v[j].x * v[j].x + v[j].y * v[j].y) + (v[j].z * v[j].z + v[j].w * v[j].w);
    return frsq(wave_sum(s) * (1.f / D) + EPS);
}
__device__ __forceinline__ void store_row_bf16(bf16* orow, const f32x4 (&v)[4], int lane) {
    u32x2* o8 = (u32x2*)orow + lane;
#pragma unroll
    for (int j = 0; j < 4; ++j) { u32x2 w; w.x = pkbf(v[j].x, v[j].y); w.y = pkbf(v[j].z, v[j].w); o8[64 * j] = w; }
}
__device__ __forceinline__ void load_row_f32(const float* xrow, f32x4 (&v)[4], int lane) {
    const f32x4* xr = (const f32x4*)xrow + lane;
#pragma unroll
    for (int j = 0; j < 4; ++j) v[j] = xr[64 * j];
}
__device__ __forceinline__ void modnorm_row(const f32x4 (&x)[4], f32x4 (&h)[4], const float* g, const float* sc, const float* sh, int lane) {
    const float rs = row_rstd(x);
#pragma unroll
    for (int j = 0; j < 4; ++j) { const f32x4 gv = ((const f32x4*)g)[lane + 64 * j], scv = ((const f32x4*)sc)[lane + 64 * j], shv = ((const f32x4*)sh)[lane + 64 * j];
        h[j] = x[j] * rs * gv * (scv + 1.0f) + shv; }
}

template <bool UPPERM> __device__ __forceinline__ void p0_transpose_item(const float* W, int K, int N, bf16* WT, int item, int lane) {
    const int nblk = N / 256, kb = item / nblk, nb = item - kb * nblk, k0 = 32 * kb, n0 = 256 * nb + 4 * lane;
    const float* src = W + (size_t)k0 * N + n0;
    int drow = n0;
    if (UPPERM) drow = (n0 < 1024) ? (256 * (n0 >> 7) + (n0 & 127)) : (256 * ((n0 - 1024) >> 7) + 128 + ((n0 - 1024) & 127));
    bf16* dst = WT + (size_t)drow * K + k0;
#pragma unroll
    for (int s = 0; s < 4; ++s) {
        f32x4 v[8];
#pragma unroll
        for (int k = 0; k < 8; ++k) v[k] = *(const f32x4*)(src + (size_t)(8 * s + k) * N);
#pragma unroll
        for (int j = 0; j < 4; ++j) { v4u o; o.x = pkbf(v[0][j], v[1][j]); o.y = pkbf(v[2][j], v[3][j]); o.z = pkbf(v[4][j], v[5][j]); o.w = pkbf(v[6][j], v[7][j]);
            *(v4u*)(dst + (size_t)j * K + 8 * s) = o; }
    }
}
__device__ __forceinline__ int up_dest_row(int n0) { return (n0 < 1024) ? (256 * (n0 >> 7) + (n0 & 127)) : (256 * ((n0 - 1024) >> 7) + 128 + ((n0 - 1024) & 127)); }
template <int N, bool UPPERM> __device__ __forceinline__ void p0_absmax_item(const float* W, unsigned* cmax, int item, int lane) {
    constexpr int NBLK = N / 256; const int kb = item / NBLK, nb = item - kb * NBLK, k0 = 32 * kb, n0 = 256 * nb + 4 * lane;
    const float* src = W + (size_t)k0 * N + n0;
    f32x4 mx = (f32x4){0.f, 0.f, 0.f, 0.f};
#pragma unroll
    for (int k = 0; k < 32; ++k) { const f32x4 v = *(const f32x4*)(src + (size_t)k * N); mx.x = fmaxf(mx.x, fabsf(v.x)); mx.y = fmaxf(mx.y, fabsf(v.y)); mx.z = fmaxf(mx.z, fabsf(v.z)); mx.w = fmaxf(mx.w, fabsf(v.w)); }
    unsigned* d = cmax + (UPPERM ? up_dest_row(n0) : n0);
    atomicMax(d + 0, __float_as_uint(mx.x)); atomicMax(d + 1, __float_as_uint(mx.y)); atomicMax(d + 2, __float_as_uint(mx.z)); atomicMax(d + 3, __float_as_uint(mx.w));
}
template <int N, bool UPPERM> __device__ __forceinline__ void p0_quant_item(const float* W, const unsigned* cmax, signed char* WQ, float* csc, int item, int lane) {
    constexpr int NBLK = N / 256; const int kb = item / NBLK, nb = item - kb * NBLK, k0 = 32 * kb, n0 = 256 * nb + 4 * lane, drow = UPPERM ? up_dest_row(n0) : n0;
    const float* src = W + (size_t)k0 * N + n0;
    float inv[4];
#pragma unroll
    for (int j = 0; j < 4; ++j) { const float cm = __uint_as_float(cmax[drow + j]); inv[j] = cm > 0.f ? 127.0f / cm : 0.f; if (kb == 0) csc[drow + j] = cm * (1.0f / 127.0f); }
#pragma unroll
    for (int s = 0; s < 2; ++s) {
        f32x4 v[16];
#pragma unroll
        for (int k = 0; k < 16; ++k) v[k] = *(const f32x4*)(src + (size_t)(16 * s + k) * N);
#pragma unroll
        for (int j = 0; j < 4; ++j) { unsigned w[4];
#pragma unroll
            for (int d = 0; d < 4; ++d) { unsigned x = 0u;
#pragma unroll
                for (int b = 0; b < 4; ++b) { const int q = (int)__builtin_rintf(v[4 * d + b][j] * inv[j]); x |= ((unsigned)q & 0xffu) << (8 * b); }
                w[d] = x; }
            *(v4u*)(WQ + (size_t)(drow + j) * 1024 + k0 + 16 * s) = (v4u){w[0], w[1], w[2], w[3]}; }
    }
}
__device__ __forceinline__ void p0_quant_up(Frame& F, const float* w_up, const unsigned* cmax, signed char* WQ, float* csc, const float* w_in, const unsigned* cmax_in, signed char* WQin, float* csc_in) {
    const int gw = F.vcu * NWAVES + F.wave, NGW = F.G * NWAVES;
    for (int it = gw; it < DEPTH * NE * 256 + DEPTH * 352; it += NGW) {
        if (it < DEPTH * NE * 256) { const int le = it >> 8;
            p0_quant_item<2048, true>(w_up + (size_t)le * D * 2048, cmax + (size_t)le * 2048, WQ + (size_t)le * 2048 * D, csc + (size_t)le * 2048, it & 255, F.lane); }
        else { const int r = it - DEPTH * NE * 256, l = r / 352;
            p0_quant_item<INW, false>(w_in + (size_t)l * D * INW, cmax_in + (size_t)l * INW, WQin + (size_t)l * INW * D, csc_in + (size_t)l * INW, r % 352, F.lane); }
    }
}
template <int N, bool UPPERM, bool FP8 = false, bool KSC = false> __device__ __forceinline__ void p0_quant_unit(const float* W, signed char* WQ, float* csc, int cb, LAS unsigned* red, int tid) {
    const int cg = tid & 15, kq = tid >> 4, n0 = 64 * cb + 4 * cg, drow = UPPERM ? up_dest_row(n0) : n0;
    f32x4 v[2][16]; f32x4 mx = (f32x4){0.f, 0.f, 0.f, 0.f};
#pragma unroll
    for (int h = 0; h < 2; ++h)
#pragma unroll
        for (int i = 0; i < 16; ++i) { v[h][i] = *(const f32x4*)(W + (size_t)(16 * (kq + 32 * h) + i) * N + n0); if constexpr (KSC) v[h][i] = v[h][i] * (h == 0 ? 1.0f / CAT_S_ATT : 1.0f / CAT_S_RET);
            mx.x = fmaxf(mx.x, fabsf(v[h][i].x)); mx.y = fmaxf(mx.y, fabsf(v[h][i].y)); mx.z = fmaxf(mx.z, fabsf(v[h][i].z)); mx.w = fmaxf(mx.w, fabsf(v[h][i].w)); }
    if (tid < 64) red[tid] = 0u;
    __syncthreads();
    atomicMax((unsigned*)(red + 4 * cg + 0), __float_as_uint(mx.x)); atomicMax((unsigned*)(red + 4 * cg + 1), __float_as_uint(mx.y));
    atomicMax((unsigned*)(red + 4 * cg + 2), __float_as_uint(mx.z)); atomicMax((unsigned*)(red + 4 * cg + 3), __float_as_uint(mx.w));
    __syncthreads();
    float inv[4];
#pragma unroll
    for (int j = 0; j < 4; ++j) { const float cm = __uint_as_float(red[4 * cg + j]); constexpr float QMAX = FP8 ? 448.0f : 127.0f; inv[j] = cm > 0.f ? QMAX / cm : 0.f; if (kq == 0) csc[drow + j] = cm * (1.0f / QMAX); }
#pragma unroll
    for (int h = 0; h < 2; ++h)
#pragma unroll
        for (int j = 0; j < 4; ++j) { unsigned w[4];
#pragma unroll
            for (int d = 0; d < 4; ++d) { unsigned x = 0u;
                if constexpr (FP8) { x = __builtin_amdgcn_cvt_pk_fp8_f32(v[h][4 * d + 0][j] * inv[j], v[h][4 * d + 1][j] * inv[j], x, false); x = __builtin_amdgcn_cvt_pk_fp8_f32(v[h][4 * d + 2][j] * inv[j], v[h][4 * d + 3][j] * inv[j], x, true); }
                else {
#pragma unroll
                for (int b = 0; b < 4; ++b) { const int q = (int)__builtin_rintf(v[h][4 * d + b][j] * inv[j]); x |= ((unsigned)q & 0xffu) << (8 * b); } }
                w[d] = x; }
            *(v4u*)(WQ + (size_t)(drow + j) * 1024 + 16 * (kq + 32 * h)) = (v4u){w[0], w[1], w[2], w[3]}; }
    __syncthreads();
}
struct QItem { const float* W; signed char* WQ; float* csc; int N, n0, type; };
__device__ __forceinline__ void q_issue(f32x4 (&v)[16], const QItem& q, int tid) {
    const int cg = tid & 7, kq = tid >> 3; const float* src = q.W + (size_t)(16 * kq) * q.N + q.n0 + 4 * cg;
#pragma unroll
    for (int i = 0; i < 16; ++i) v[i] = *(const f32x4*)(src + (size_t)i * q.N);
}
template <bool UPPERM, bool FP8, bool KSC> __device__ __forceinline__ void q_finish(f32x4 (&v)[16], const QItem& q, LAS unsigned* red, int tid) {
    const int cg = tid & 7, kq = tid >> 3, n0 = q.n0 + 4 * cg, drow = UPPERM ? up_dest_row(n0) : n0;
    f32x4 mx = (f32x4){0.f, 0.f, 0.f, 0.f};
#pragma unroll
    for (int i = 0; i < 16; ++i) { if constexpr (KSC) v[i] = v[i] * (kq < 32 ? 1.0f / CAT_S_ATT : 1.0f / CAT_S_RET);
        mx.x = fmaxf(mx.x, fabsf(v[i].x)); mx.y = fmaxf(mx.y, fabsf(v[i].y)); mx.z = fmaxf(mx.z, fabsf(v[i].z)); mx.w = fmaxf(mx.w, fabsf(v[i].w)); }
    if (tid < 32) red[tid] = 0u;
    __syncthreads();
    atomicMax((unsigned*)(red + 4 * cg + 0), __float_as_uint(mx.x)); atomicMax((unsigned*)(red + 4 * cg + 1), __float_as_uint(mx.y));
    atomicMax((unsigned*)(red + 4 * cg + 2), __float_as_uint(mx.z)); atomicMax((unsigned*)(red + 4 * cg + 3), __float_as_uint(mx.w));
    __syncthreads();
    constexpr float QMAX = FP8 ? 448.0f : 127.0f;
#pragma unroll
    for (int j = 0; j < 4; ++j) { const float cm = __uint_as_float(red[4 * cg + j]), inv = cm > 0.f ? QMAX / cm : 0.f; if (kq == 0) q.csc[drow + j] = cm * (1.0f / QMAX);
        unsigned w[4];
#pragma unroll
        for (int d = 0; d < 4; ++d) { unsigned x = 0u;
            if constexpr (FP8) { x = __builtin_amdgcn_cvt_pk_fp8_f32(v[4 * d + 0][j] * inv, v[4 * d + 1][j] * inv, x, false); x = __builtin_amdgcn_cvt_pk_fp8_f32(v[4 * d + 2][j] * inv, v[4 * d + 3][j] * inv, x, true); }
            else {
#pragma unroll
                for (int b = 0; b < 4; ++b) { const int qv = (int)__builtin_rintf(v[4 * d + b][j] * inv); x |= ((unsigned)qv & 0xffu) << (8 * b); } }
            w[d] = x; }
        *(v4u*)(q.WQ + (size_t)(drow + j) * 1024 + 16 * kq) = (v4u){w[0], w[1], w[2], w[3]}; }
}
__device__ __forceinline__ void q_finish_any(f32x4 (&v)[16], const QItem& q, LAS unsigned* red, int tid) {
    if (q.type == 0) q_finish<true, false, false>(v, q, red, tid);
    else if (q.type == 1) q_finish<false, false, false>(v, q, red, tid);
    else if (q.type == 2) q_finish<false, true, false>(v, q, red, tid);
    else q_finish<false, true, true>(v, q, red, tid);
}
__device__ __forceinline__ void p0_prologue(Frame& F, const float* c_in, const float* ada_w, const float* ada_b, float* mod,
                                            const float* w_in, const float* w_out, const float* w_up, const float* w_dn,
                                            signed char* WQin, float* csc_in, signed char* WQout, float* csc_out, signed char* WQup, float* csc_up, signed char* WQdn, float* csc_dn, gu32* wq_ctr) {
    const int gw = F.vcu * NWAVES + F.wave, NGW = F.G * NWAVES;
    __syncthreads();
    LAS float* cond = (LAS float*)F.lds;
    for (int i = F.tid; i < BATCH * D; i += NTHR) { const float v = c_in[i]; cond[i] = v * frcp(1.0f + __expf(-v)); }
    __syncthreads();
    LAS float* part = (LAS float*)(F.lds + 32768);
    for (int bt = blockIdx.x; bt < DEPTH * 96; bt += F.G) {
        const int l = bt / 96, chunk = bt % 96, ks = F.wave, col = chunk * 64 + F.lane;
        float acc[BATCH];
#pragma unroll
        for (int b = 0; b < BATCH; ++b) acc[b] = 0.f;
        const float* w = ada_w + ((size_t)l * D + ks * 128) * (6 * D) + col;
#pragma unroll 16
        for (int k = 0; k < 128; ++k) { const float wv = w[(size_t)k * (6 * D)];
#pragma unroll
            for (int b = 0; b < BATCH; ++b) acc[b] += cond[b * D + ks * 128 + k] * wv; }
#pragma unroll
        for (int b = 0; b < BATCH; ++b) part[(ks * BATCH + b) * 64 + F.lane] = acc[b];
        __syncthreads();
        { const int b = F.wave; float sum = ada_b[l * 6 * D + col];
#pragma unroll
          for (int k2 = 0; k2 < 8; ++k2) sum += part[(k2 * BATCH + b) * 64 + F.lane];
          mod[((size_t)l * BATCH + b) * (6 * D) + col] = sum; }
        __syncthreads();
    }
    {   LAS unsigned* redA = (LAS unsigned*)(F.lds + 49152 + 1024), *redB = redA + 32; LAS unsigned* claim = redA + 64;
        constexpr int U_UP = DEPTH * NE * 64, U_IN = DEPTH * 88, U_DN = DEPTH * NE * 32, U_OUT = DEPTH * 32, U_ALL = U_UP + U_IN + U_DN + U_OUT;
        auto take = [&](QItem& q) -> bool {
            if (F.tid == 0) claim[0] = __hip_atomic_fetch_add(wq_ctr, 1u, RLX_AGENT);
            __syncthreads();
            const int u = (int)claim[0];
            __syncthreads();
            if (u >= U_ALL) return false;
            if (u < U_UP) { const int le = u >> 6; q = QItem{w_up + (size_t)le * D * 2048, WQup + (size_t)le * 2048 * D, csc_up + (size_t)le * 2048, 2048, 32 * (u & 63), 0}; }
            else if (u < U_UP + U_IN) { const int r = u - U_UP, l = r / 88; q = QItem{w_in + (size_t)l * D * INW, WQin + (size_t)l * INW * D, csc_in + (size_t)l * INW, INW, 32 * (r % 88), 1}; }
            else if (u < U_UP + U_IN + U_DN) { const int r = u - U_UP - U_IN, le = r >> 5; q = QItem{w_dn + (size_t)le * D * D, WQdn + (size_t)le * D * D, csc_dn + (size_t)le * D, D, 32 * (r & 31), 2}; }
            else { const int r = u - U_UP - U_IN - U_DN, l = r >> 5; q = QItem{w_out + (size_t)l * D * D, WQout + (size_t)l * D * D, csc_out + (size_t)l * D, D, 32 * (r & 31), 3}; }
            return true; };
        f32x4 vA[16], vB[16]; QItem qA, qB;
        bool hA = take(qA); if (hA) q_issue(vA, qA, F.tid);
        bool hB = hA && take(qB); if (hB) q_issue(vB, qB, F.tid);
        while (hA || hB) {
            if (hA) { q_finish_any(vA, qA, redA, F.tid); hA = take(qA); if (hA) q_issue(vA, qA, F.tid); }
            if (hB) { q_finish_any(vB, qB, redB, F.tid); hB = take(qB); if (hB) q_issue(vB, qB, F.tid); }
        }
    }
}
__device__ __forceinline__ void store_row_i8(signed char* qrow, float* sc, const f32x4 (&h)[4], int lane) {
    float mx = 0.f;
#pragma unroll
    for (int j = 0; j < 4; ++j) mx = fmaxf(fmaxf(mx, fmaxf(fabsf(h[j].x), fabsf(h[j].y))), fmaxf(fabsf(h[j].z), fabsf(h[j].w)));
    mx = wmax64(mx);
    const float inv = mx > 0.f ? 127.0f / mx : 0.f;
    unsigned* qr = (unsigned*)qrow + lane;
#pragma unroll
    for (int j = 0; j < 4; ++j) { const int q0 = (int)__builtin_rintf(h[j].x * inv), q1 = (int)__builtin_rintf(h[j].y * inv), q2 = (int)__builtin_rintf(h[j].z * inv), q3 = (int)__builtin_rintf(h[j].w * inv);
        qr[64 * j] = ((unsigned)q0 & 0xffu) | (((unsigned)q1 & 0xffu) << 8) | (((unsigned)q2 & 0xffu) << 16) | (((unsigned)q3 & 0xffu) << 24); }
    if (lane == 0) *sc = mx * (1.0f / 127.0f);
}
__device__ __forceinline__ void p0b_premix(Frame& F, const float* x, signed char* HQ, float* hs, const float* g, const float* mod_l) {
    const int lane = F.lane, gw = F.vcu * NWAVES + F.wave, NGW = F.G * NWAVES;
    for (int ch = gw; ch < M / 32; ch += NGW) { const int mb = ch * 32;
        const float* modb = mod_l + (size_t)(mb >> 13) * (6 * D);
        f32x4 gsv[4], shv[4];
#pragma unroll
        for (int j = 0; j < 4; ++j) { gsv[j] = ((const f32x4*)g)[lane + 64 * j] * (((const f32x4*)(modb + D))[lane + 64 * j] + 1.0f); shv[j] = ((const f32x4*)modb)[lane + 64 * j]; }
        f32x4 A[2][4], B[2][4];
#define P0B_ISSUE(BUF, t0) do { _Pragma("unroll") for (int r = 0; r < 2; ++r) load_row_f32(x + (size_t)(mb + (t0) + r) * D, BUF[r], lane); } while (0)
#define P0B_PROC(BUF, t0) do { _Pragma("unroll") for (int r = 0; r < 2; ++r) { const int m = mb + (t0) + r; f32x4 h[4]; const float rs = row_rstd(BUF[r]); \
            _Pragma("unroll") for (int j = 0; j < 4; ++j) h[j] = BUF[r][j] * rs * gsv[j] + shv[j]; store_row_i8(HQ + (size_t)m * D, hs + m, h, lane); } } while (0)
        P0B_ISSUE(A, 0);
#pragma unroll 1
        for (int it = 0; it < 8; ++it) { const int t0 = 4 * it;
            P0B_ISSUE(B, t0 + 2);
            P0B_PROC(A, t0);
            if (it < 7) P0B_ISSUE(A, t0 + 4);
            P0B_PROC(B, t0 + 2);
        }
#undef P0B_ISSUE
#undef P0B_PROC
    }
}
__device__ __forceinline__ void rope4(float (&y)[4][2], const float (&cr)[2], const float (&sr)[2], const float (&cc)[2], const float (&sc)[2], float scale, unsigned (&w)[4]) {
    float o[4][2];
#pragma unroll
    for (int e = 0; e < 2; ++e) { o[0][e] = y[0][e] * cr[e] - y[1][e] * sr[e]; o[1][e] = y[1][e] * cr[e] + y[0][e] * sr[e];
                                  o[2][e] = y[2][e] * cc[e] - y[3][e] * sc[e]; o[3][e] = y[3][e] * cc[e] + y[2][e] * sc[e]; }
#pragma unroll
    for (int q = 0; q < 4; ++q) w[q] = pkbf(o[q][0] * scale, o[q][1] * scale);
}
__device__ __forceinline__ void p1b_ka(Frame& F, bf16* PROJ, const float* kg) {
    const int lane = F.lane, gw = F.vcu * NWAVES + F.wave, NGW = F.G * NWAVES;
    const int ja = lane & 7, hk = (lane >> 3) & 1, sub = lane >> 4;
    constexpr float L2T = 13.287712379549449f;
    float fa[2], gk[4][2];
#pragma unroll
    for (int e = 0; e < 2; ++e) fa[e] = fexp2(-(float)(2 * ja + e) * (L2T / 16.f));
#pragma unroll
    for (int q = 0; q < 4; ++q)
#pragma unroll
        for (int e = 0; e < 2; ++e) gk[q][e] = kg[q * 16 + 2 * ja + e];
    for (int m0 = gw * 4; m0 < M; m0 += NGW * 4) {
        const int m = m0 + sub, s = m & (T - 1); const float rid = (float)(s >> 6), cid = (float)(s & 63);
        float cra[2], sra[2], cca[2], sca[2];
#pragma unroll
        for (int e = 0; e < 2; ++e) { cra[e] = __cosf(rid * fa[e]); sra[e] = __sinf(rid * fa[e]); cca[e] = __cosf(cid * fa[e]); sca[e] = __sinf(cid * fa[e]); }
        unsigned* p = (unsigned*)(PROJ + (size_t)m * INW + C_KA + hk * 64 + 2 * ja); unsigned w[4]; float y[4][2]; float ss = 0.f;
#pragma unroll
        for (int q = 0; q < 4; ++q) { w[q] = p[q * 8]; y[q][0] = bflo(w[q]); y[q][1] = bfhi(w[q]); ss += y[q][0] * y[q][0] + y[q][1] * y[q][1]; }
        ss += shx<1>(ss); ss += shx<2>(ss); ss += shx<4>(ss);
        const float rs = frsq(ss * (1.f / 64.f) + EPS);
#pragma unroll
        for (int q = 0; q < 4; ++q) { y[q][0] *= rs * gk[q][0]; y[q][1] *= rs * gk[q][1]; }
        rope4(y, cra, sra, cca, sca, 1.0f, w);
#pragma unroll
        for (int q = 0; q < 4; ++q) p[q * 8] = w[q];
    }
}
__device__ __forceinline__ void p1b_rope(Frame& F, bf16* PROJ, bf16* PDST, const float* qg, const float* kg) {
    const int lane = F.lane, gw = F.vcu * NWAVES + F.wave, NGW = F.G * NWAVES;
    const int ja = lane & 7, jr = lane & 15;
    constexpr float L2T = 13.287712379549449f;
    float fa[2], fr[2], gq[4][2], gk[4][2];
#pragma unroll
    for (int e = 0; e < 2; ++e) { fa[e] = fexp2(-(float)(2 * ja + e) * (L2T / 16.f)); fr[e] = fexp2(-(float)(2 * jr + e) * (L2T / 32.f)); }
#pragma unroll
    for (int q = 0; q < 4; ++q)
#pragma unroll
        for (int e = 0; e < 2; ++e) { gq[q][e] = qg[q * 16 + 2 * ja + e]; gk[q][e] = kg[q * 16 + 2 * ja + e]; }
    for (int m = gw; m < M; m += NGW) {
        const int s = m & (T - 1); const float rid = (float)(s >> 6), cid = (float)(s & 63);
        float cra[2], sra[2], cca[2], sca[2], crr[2], srr[2], ccr[2], scr2[2];
#pragma unroll
        for (int e = 0; e < 2; ++e) { cra[e] = __cosf(rid * fa[e]); sra[e] = __sinf(rid * fa[e]); cca[e] = __cosf(cid * fa[e]); sca[e] = __sinf(cid * fa[e]);
                                      crr[e] = __cosf(rid * fr[e]); srr[e] = __sinf(rid * fr[e]); ccr[e] = __cosf(cid * fr[e]); scr2[e] = __sinf(cid * fr[e]); }
        bf16* row = PROJ + (size_t)m * INW; const size_t dd = (size_t)((const char*)PDST - (const char*)PROJ) / 4;
        {
            unsigned* p = (unsigned*)(row + C_QA + (lane >> 3) * 64 + 2 * ja); unsigned w[4]; float y[4][2]; float ss = 0.f;
#pragma unroll
            for (int q = 0; q < 4; ++q) { w[q] = p[q * 8]; y[q][0] = bflo(w[q]); y[q][1] = bfhi(w[q]); ss += y[q][0] * y[q][0] + y[q][1] * y[q][1]; }
            ss += shx<1>(ss); ss += shx<2>(ss); ss += shx<4>(ss);
            const float rs = frsq(ss * (1.f / 64.f) + EPS);
#pragma unroll
            for (int q = 0; q < 4; ++q) { y[q][0] *= rs * gq[q][0]; y[q][1] *= rs * gq[q][1]; }
            rope4(y, cra, sra, cca, sca, attn_body::C2, w);
#pragma unroll
            for (int q = 0; q < 4; ++q) p[dd + q * 8] = w[q];
        }
        {
            const int hk = (lane >> 3) & 1;
            unsigned* p = (unsigned*)(row + C_KA + hk * 64 + 2 * ja); unsigned w[4]; float y[4][2]; float ss = 0.f;
#pragma unroll
            for (int q = 0; q < 4; ++q) { w[q] = p[q * 8]; y[q][0] = bflo(w[q]); y[q][1] = bfhi(w[q]); ss += y[q][0] * y[q][0] + y[q][1] * y[q][1]; }
            ss += shx<1>(ss); ss += shx<2>(ss); ss += shx<4>(ss);
            const float rs = frsq(ss * (1.f / 64.f) + EPS);
#pragma unroll
            for (int q = 0; q < 4; ++q) { y[q][0] *= rs * gk[q][0]; y[q][1] *= rs * gk[q][1]; }
            rope4(y, cra, sra, cca, sca, 1.0f, w);
            if (lane < 16) {
#pragma unroll
                for (int q = 0; q < 4; ++q) p[dd + q * 8] = w[q]; }
        }
#pragma unroll
        for (int which = 0; which < 2; ++which) {
            unsigned* p = (unsigned*)(row + (which ? C_KR : C_QR) + (lane >> 4) * 128 + 2 * jr); unsigned w[4]; float y[4][2];
#pragma unroll
            for (int q = 0; q < 4; ++q) { w[q] = p[q * 16]; y[q][0] = bflo(w[q]); y[q][1] = bfhi(w[q]); }
            rope4(y, crr, srr, ccr, scr2, which ? 0.08838834764831845f : 1.0f, w);
#pragma unroll
            for (int q = 0; q < 4; ++q) p[dd + q * 16] = w[q];
        }
    }
}

__device__ __forceinline__ unsigned off_b(unsigned row, unsigned ch) { return 256u * row + 16u * (ch ^ (((row & 3) << 2) | ((row >> 2) & 3))); }
__device__ __forceinline__ bf16x8 rowread(const LAS unsigned char* tb, int rb, int s, int lane) {
    return *(const LAS bf16x8*)(tb + off_b(32 * rb + (lane & 31), 2 * s + (lane >> 5)));
}
__device__ __forceinline__ bf16x8 trread(const LAS unsigned char* tb, int c, int ks, int lane) {
    const unsigned h = lane >> 5, blk = (lane >> 4) & 1, q = (lane & 15) >> 2, p = lane & 3;
    const unsigned r0 = 16 * ks + 8 * h + q, ch = 4 * c + 2 * blk + (p >> 1);
    const s16x4 lo = __builtin_amdgcn_ds_read_tr16_b64_v4i16((LAS s16x4*)(tb + off_b(r0, ch) + 8 * (p & 1)));
    const s16x4 hi = __builtin_amdgcn_ds_read_tr16_b64_v4i16((LAS s16x4*)(tb + off_b(r0 + 4, ch) + 8 * (p & 1)));
    return (bf16x8){lo[0], lo[1], lo[2], lo[3], hi[0], hi[1], hi[2], hi[3]};
}
__device__ __forceinline__ int crow(int r, int hi) { return (r & 3) + 8 * (r >> 2) + 4 * hi; }
template <int MODE> __device__ __forceinline__ void stage_tile(LAS unsigned char* tb, const bf16* src, int pitch, int tid, float lg) {
#pragma unroll
    for (int i = 0; i < 4; ++i) { const int n = tid + NTHR * i, row = n >> 4, ch = n & 15;
        v4u v = *(const v4u*)(src + (size_t)row * pitch + ch * 8);
        if (MODE != 0) { const float f = fexp2((MODE == 1 ? (float)(127 - row) : (float)row) * lg);
            v.x = pkbf(bflo(v.x) * f, bfhi(v.x) * f); v.y = pkbf(bflo(v.y) * f, bfhi(v.y) * f); v.z = pkbf(bflo(v.z) * f, bfhi(v.z) * f); v.w = pkbf(bflo(v.w) * f, bfhi(v.w) * f); }
        *(LAS v4u*)(tb + off_b(row, ch)) = v; }
}
template <int NOUT> __device__ __forceinline__ void stage_rope_tile(LAS unsigned char* tb0, LAS unsigned char* tb1, const bf16* src, int pitch, int tid, int s0, float scale, float lgf, float lgb) {
    constexpr float L2T = 13.287712379549449f;
#pragma unroll 1
    for (int i2 = 0; i2 < 2; ++i2) { const int n = tid + NTHR * i2, row = n >> 3, cp = n & 7, c0 = (cp & 3) + ((cp >> 2) << 3);
        const bf16* rp = src + (size_t)row * pitch; const v4u va = *(const v4u*)(rp + c0 * 8), vb = *(const v4u*)(rp + (c0 + 4) * 8);
        const int s = s0 + row; const float pos = (cp & 4) ? (float)(s & 63) : (float)(s >> 6);
        const unsigned wa[4] = {va.x, va.y, va.z, va.w}, wb[4] = {vb.x, vb.y, vb.z, vb.w}; float oa[8], ob[8];
#pragma unroll
        for (int j = 0; j < 8; ++j) { const float fr = fexp2(-(float)(8 * (cp & 3) + j) * (L2T / 32.f)), ang = pos * fr, cs = __cosf(ang), sn = __sinf(ang);
            const float a = (j & 1) ? bfhi(wa[j >> 1]) : bflo(wa[j >> 1]), b = (j & 1) ? bfhi(wb[j >> 1]) : bflo(wb[j >> 1]);
            oa[j] = (a * cs - b * sn) * scale; ob[j] = (b * cs + a * sn) * scale; }
        if (NOUT == 1) {
            *(LAS v4u*)(tb0 + off_b(row, c0)) = (v4u){pkbf(oa[0], oa[1]), pkbf(oa[2], oa[3]), pkbf(oa[4], oa[5]), pkbf(oa[6], oa[7])};
            *(LAS v4u*)(tb0 + off_b(row, c0 + 4)) = (v4u){pkbf(ob[0], ob[1]), pkbf(ob[2], ob[3]), pkbf(ob[4], ob[5]), pkbf(ob[6], ob[7])};
        } else {
            const float ff = fexp2((float)(127 - row) * lgf), fb = fexp2((float)row * lgb);
            *(LAS v4u*)(tb0 + off_b(row, c0)) = (v4u){pkbf(oa[0] * ff, oa[1] * ff), pkbf(oa[2] * ff, oa[3] * ff), pkbf(oa[4] * ff, oa[5] * ff), pkbf(oa[6] * ff, oa[7] * ff)};
            *(LAS v4u*)(tb0 + off_b(row, c0 + 4)) = (v4u){pkbf(ob[0] * ff, ob[1] * ff), pkbf(ob[2] * ff, ob[3] * ff), pkbf(ob[4] * ff, ob[5] * ff), pkbf(ob[6] * ff, ob[7] * ff)};
            *(LAS v4u*)(tb1 + off_b(row, c0)) = (v4u){pkbf(oa[0] * fb, oa[1] * fb), pkbf(oa[2] * fb, oa[3] * fb), pkbf(oa[4] * fb, oa[5] * fb), pkbf(oa[6] * fb, oa[7] * fb)};
            *(LAS v4u*)(tb1 + off_b(row, c0 + 4)) = (v4u){pkbf(ob[0] * fb, ob[1] * fb), pkbf(ob[2] * fb, ob[3] * fb), pkbf(ob[4] * fb, ob[5] * fb), pkbf(ob[6] * fb, ob[7] * fb)};
        } }
}
__device__ __forceinline__ void rope_load(v4u (&raw)[2][2], const bf16* src, int pitch, int tid) {
#pragma unroll
    for (int i2 = 0; i2 < 2; ++i2) { const int n = tid + NTHR * i2, row = n >> 3, cp = n & 7, c0 = (cp & 3) + ((cp >> 2) << 3);
        const bf16* rp = src + (size_t)row * pitch; raw[i2][0] = *(const v4u*)(rp + c0 * 8); raw[i2][1] = *(const v4u*)(rp + (c0 + 4) * 8); }
}
template <int NOUT> __device__ __forceinline__ void rope_store(LAS unsigned char* tb0, LAS unsigned char* tb1, const v4u (&raw)[2][2], int tid, int s0, float scale, float lgf, float lgb) {
    constexpr float L2T = 13.287712379549449f;
#pragma unroll
    for (int i2 = 0; i2 < 2; ++i2) { __builtin_amdgcn_sched_barrier(0);
        const int n = tid + NTHR * i2, row = n >> 3, cp = n & 7, c0 = (cp & 3) + ((cp >> 2) << 3);
        const v4u va = raw[i2][0], vb = raw[i2][1];
        const int s = s0 + row; const float pos = (cp & 4) ? (float)(s & 63) : (float)(s >> 6);
        const unsigned wa[4] = {va.x, va.y, va.z, va.w}, wb[4] = {vb.x, vb.y, vb.z, vb.w}; float oa[8], ob[8];
#pragma unroll
        for (int j = 0; j < 8; ++j) { const float fr = fexp2(-(float)(8 * (cp & 3) + j) * (L2T / 32.f)), ang = pos * fr, cs = __cosf(ang), sn = __sinf(ang);
            const float a = (j & 1) ? bfhi(wa[j >> 1]) : bflo(wa[j >> 1]), b = (j & 1) ? bfhi(wb[j >> 1]) : bflo(wb[j >> 1]);
            oa[j] = (a * cs - b * sn) * scale; ob[j] = (b * cs + a * sn) * scale; }
        if (NOUT == 1) {
            *(LAS v4u*)(tb0 + off_b(row, c0)) = (v4u){pkbf(oa[0], oa[1]), pkbf(oa[2], oa[3]), pkbf(oa[4], oa[5]), pkbf(oa[6], oa[7])};
            *(LAS v4u*)(tb0 + off_b(row, c0 + 4)) = (v4u){pkbf(ob[0], ob[1]), pkbf(ob[2], ob[3]), pkbf(ob[4], ob[5]), pkbf(ob[6], ob[7])};
        } else {
            const float ff = fexp2((float)(127 - row) * lgf), fb = fexp2((float)row * lgb);
            *(LAS v4u*)(tb0 + off_b(row, c0)) = (v4u){pkbf(oa[0] * ff, oa[1] * ff), pkbf(oa[2] * ff, oa[3] * ff), pkbf(oa[4] * ff, oa[5] * ff), pkbf(oa[6] * ff, oa[7] * ff)};
            *(LAS v4u*)(tb0 + off_b(row, c0 + 4)) = (v4u){pkbf(ob[0] * ff, ob[1] * ff), pkbf(ob[2] * ff, ob[3] * ff), pkbf(ob[4] * ff, ob[5] * ff), pkbf(ob[6] * ff, ob[7] * ff)};
            *(LAS v4u*)(tb1 + off_b(row, c0)) = (v4u){pkbf(oa[0] * fb, oa[1] * fb), pkbf(oa[2] * fb, oa[3] * fb), pkbf(oa[4] * fb, oa[5] * fb), pkbf(oa[6] * fb, oa[7] * fb)};
            *(LAS v4u*)(tb1 + off_b(row, c0 + 4)) = (v4u){pkbf(ob[0] * fb, ob[1] * fb), pkbf(ob[2] * fb, ob[3] * fb), pkbf(ob[4] * fb, ob[5] * fb), pkbf(ob[6] * fb, ob[7] * fb)};
        } }
}
__device__ __forceinline__ void vtile_load(v4u (&raw)[4], const bf16* src, int pitch, int tid) {
#pragma unroll
    for (int i = 0; i < 4; ++i) { const int n = tid + NTHR * i, row = n >> 4, ch = n & 15; raw[i] = *(const v4u*)(src + (size_t)row * pitch + ch * 8); }
}
__device__ __forceinline__ void vtile_store(LAS unsigned char* tb, const v4u (&raw)[4], int tid) {
#pragma unroll
    for (int i = 0; i < 4; ++i) { const int n = tid + NTHR * i, row = n >> 4, ch = n & 15; *(LAS v4u*)(tb + off_b(row, ch)) = raw[i]; }
}
__device__ __forceinline__ void r1_states(Frame& F, const bf16* PROJ, bf16* U, const float* dec_f, const float* dec_b) {
    LAS unsigned char* TKf = F.lds, *TKb = F.lds + 32768, *TV = F.lds + 65536;
    const int lane = F.lane, w = F.wave, hi = lane >> 5, mb = w & 3, nb0 = 2 * (w >> 2);
    for (int u = F.vcu; u < RUNITS; u += F.G) {
        const int b = u >> 8, h = (u >> 6) & 3, c = u & 63;
        const float lgf = dec_f[h] * LOG2E, lgb = dec_b[h] * LOG2E;
        const bf16* base = PROJ + ((size_t)b * T + (size_t)c * RCH) * INW + h * 128;
        { v4u rk[2][2], rv[4]; rope_load(rk, base + C_KR, INW, F.tid); vtile_load(rv, base + C_VR, INW, F.tid);
          rope_store<2>(TKf, TKb, rk, F.tid, c * RCH, 0.08838834764831845f, lgf, lgb);
          vtile_store(TV, rv, F.tid); }
        __syncthreads();
        f32x16 acc[2][2];
#pragma unroll
        for (int d = 0; d < 2; ++d)
#pragma unroll
            for (int n = 0; n < 2; ++n) acc[d][n] = (f32x16){};
#pragma unroll 2
        for (int ks = 0; ks < 8; ++ks) {
            const bf16x8 a = trread(TV, mb, ks, lane);
#pragma unroll
            for (int n = 0; n < 2; ++n) { const bf16x8 bf = trread(TKf, nb0 + n, ks, lane), bb = trread(TKb, nb0 + n, ks, lane);
                acc[0][n] = __builtin_amdgcn_mfma_f32_32x32x16_bf16(bf, a, acc[0][n], 0, 0, 0);
                acc[1][n] = __builtin_amdgcn_mfma_f32_32x32x16_bf16(bb, a, acc[1][n], 0, 0, 0); }
        }
#pragma unroll
        for (int d = 0; d < 2; ++d)
#pragma unroll
            for (int n = 0; n < 2; ++n) { bf16* o = U + ((size_t)u * 2 + d) * 16384 + (size_t)(32 * mb + (lane & 31)) * 128 + 32 * (nb0 + n) + 4 * hi;
#pragma unroll
                for (int g = 0; g < 4; ++g) { u32x2 w; w.x = pkbf(acc[d][n][4 * g], acc[d][n][4 * g + 1]); w.y = pkbf(acc[d][n][4 * g + 2], acc[d][n][4 * g + 3]); *(u32x2*)(o + 8 * g) = w; } }
        __syncthreads();
    }
}
__device__ __forceinline__ void r2_scan(Frame& F, const bf16* __restrict__ U, bf16* __restrict__ FT, const float* dec_f, const float* dec_b) {
    for (int task = blockIdx.x * NTHR + F.tid; task < BATCH * RH * 4096; task += F.G * NTHR) {
        const int bh = task >> 12, e4 = task & 4095, h = bh & 3;
        const float df = __expf(dec_f[h] * 128.f), db = __expf(dec_b[h] * 128.f);
        const size_t base = ((size_t)bh * NCH * 2) * 16384 + 4 * e4;
#define R2_LOAD(BUF, c0, DIR, STEP) do { _Pragma("unroll") for (int k = 0; k < 8; ++k) BUF[k] = *(const u32x2*)(U + base + ((size_t)((c0) + (STEP) * k) * 2 + (DIR)) * 16384); } while (0)
#define R2_PROC(BUF, c0, DIR, STEP, DEC) do { _Pragma("unroll") for (int k = 0; k < 8; ++k) { u32x2 w; w.x = pkbf(s.x, s.y); w.y = pkbf(s.z, s.w); \
            *(u32x2*)(FT + base + ((size_t)((c0) + (STEP) * k) * 2 + (DIR)) * 16384) = w; const u32x2 uw = BUF[k]; s = s * (DEC) + (f32x4){bflo(uw.x), bfhi(uw.x), bflo(uw.y), bfhi(uw.y)}; } } while (0)
        u32x2 bA[8], bB[8];
        f32x4 s = (f32x4){0.f, 0.f, 0.f, 0.f};
        R2_LOAD(bA, 0, 0, 1);
#pragma unroll 1
        for (int c0 = 0; c0 < NCH; c0 += 16) {
            R2_LOAD(bB, c0 + 8, 0, 1);
            R2_PROC(bA, c0, 0, 1, df);
            if (c0 + 16 < NCH) R2_LOAD(bA, c0 + 16, 0, 1);
            R2_PROC(bB, c0 + 8, 0, 1, df);
        }
        s = (f32x4){0.f, 0.f, 0.f, 0.f};
        R2_LOAD(bA, NCH - 1, 1, -1);
#pragma unroll 1
        for (int c0 = NCH - 1; c0 >= 0; c0 -= 16) {
            R2_LOAD(bB, c0 - 8, 1, -1);
            R2_PROC(bA, c0, 1, -1, db);
            if (c0 - 16 >= 0) R2_LOAD(bA, c0 - 16, 1, -1);
            R2_PROC(bB, c0 - 8, 1, -1, db);
        }
#undef R2_LOAD
#undef R2_PROC
    }
}
__device__ __forceinline__ void r3_out(Frame& F, const bf16* PROJ, const bf16* FT, bf16* CAT, const float* dec_f, const float* dec_b, const float* gn_g, const float* gn_b) {
    LAS unsigned char* TQ = F.lds, *TK = F.lds + 32768, *TV = F.lds + 65536, *TP = F.lds + 98304;
    LAS float* OT = (LAS float*)F.lds;
    const int w = F.wave, wb = w & 3, wp0 = 2 * (w >> 2);
    for (int u = F.vcu; u < RUNITS; u += F.G) {
        int lane = F.lane, tid_u = F.tid; asm volatile("" : "+v"(lane), "+v"(tid_u));
        const int hi = lane >> 5, l31 = lane & 31;
        const int b = u >> 8, h = (u >> 6) & 3, c = u & 63;
        const float lgf = dec_f[h] * LOG2E, lgb = dec_b[h] * LOG2E;
        const size_t m0 = (size_t)b * T + (size_t)c * RCH;
        const bf16* base = PROJ + m0 * INW + h * 128;
        const int gi = tid_u >> 2, gqd = tid_u & 3, gcol = h * 128 + 32 * gqd;
        const bf16* gp = PROJ + (m0 + gi) * INW + C_GR + gcol;
        v4u gw[4];
#pragma unroll
        for (int k2 = 0; k2 < 4; ++k2) gw[k2] = *(const v4u*)(gp + 8 * k2);
        bf16x8 cf[4][2], cb[4][2];
        const bf16* ftf = FT + ((size_t)u * 2 + 0) * 16384 + (size_t)(32 * wp0 + l31) * 128 + 8 * hi;
#pragma unroll
        for (int s = 0; s < 4; ++s)
#pragma unroll
            for (int n = 0; n < 2; ++n) { cf[s][n] = *(const bf16x8*)(ftf + n * 32 * 128 + 16 * s); cb[s][n] = *(const bf16x8*)(ftf + 16384 + n * 32 * 128 + 16 * s); }
        { v4u rq[2][2], rk[2][2], rv[4];
          rope_load(rq, base + C_QR, INW, tid_u); rope_load(rk, base + C_KR, INW, tid_u); vtile_load(rv, base + C_VR, INW, tid_u);
          __builtin_amdgcn_sched_barrier(0);
          rope_store<1>(TQ, TQ, rq, tid_u, c * RCH, 1.0f, 0.f, 0.f);
          rope_store<1>(TK, TK, rk, tid_u, c * RCH, 0.08838834764831845f, 0.f, 0.f);
          __builtin_amdgcn_sched_barrier(0);
          vtile_store(TV, rv, tid_u); }
        __syncthreads();
        {
            f32x16 st[2]; st[0] = (f32x16){}; st[1] = (f32x16){};
#pragma unroll 1
            for (int s = 0; s < 8; ++s) { const bf16x8 a = rowread(TK, wb, s, lane);
#pragma unroll
                for (int n = 0; n < 2; ++n) st[n] = __builtin_amdgcn_mfma_f32_32x32x16_bf16(a, rowread(TQ, wp0 + n, s, lane), st[n], 0, 0, 0); }
#pragma unroll
            for (int n = 0; n < 2; ++n) { const int i = 32 * (wp0 + n) + l31; __builtin_amdgcn_sched_barrier(0);
#pragma unroll
                for (int g = 0; g < 4; ++g) { float p[4];
#pragma unroll
                    for (int q = 0; q < 4; ++q) { const int j = 32 * wb + 8 * g + 4 * hi + q; const float fd = (float)(i - j);
                        const float mk = fexp2(fmaxf(fd, 0.f) * lgf + fmaxf(-fd, 0.f) * lgb) + fmaxf(1.0f - fabsf(fd), 0.f);
                        p[q] = st[n][4 * g + q] * mk; }
                    u32x2 pw; pw.x = pkbf(p[0], p[1]); pw.y = pkbf(p[2], p[3]);
                    *(LAS u32x2*)(TP + off_b(i, 4 * wb + g) + 8 * hi) = pw; } }
        }
        __syncthreads();
        f32x16 ao[2];
#pragma unroll
        for (int n = 0; n < 2; ++n) ao[n] = (f32x16){};
        {
            const float xf = fexp2((float)(32 * wb + l31 + 1) * lgf), xb = fexp2((float)(128 - 32 * wb - l31) * lgb);
#pragma unroll
            for (int s = 0; s < 8; ++s) { __builtin_amdgcn_sched_barrier(0); const bf16x8 ap = rowread(TP, wb, s, lane); const v4u aq = *(const LAS v4u*)(TQ + off_b(32 * wb + l31, 2 * s + hi));
                v4u qf, qb;
                qf.x = pkbf(bflo(aq.x) * xf, bfhi(aq.x) * xf); qf.y = pkbf(bflo(aq.y) * xf, bfhi(aq.y) * xf); qf.z = pkbf(bflo(aq.z) * xf, bfhi(aq.z) * xf); qf.w = pkbf(bflo(aq.w) * xf, bfhi(aq.w) * xf);
                qb.x = pkbf(bflo(aq.x) * xb, bfhi(aq.x) * xb); qb.y = pkbf(bflo(aq.y) * xb, bfhi(aq.y) * xb); qb.z = pkbf(bflo(aq.z) * xb, bfhi(aq.z) * xb); qb.w = pkbf(bflo(aq.w) * xb, bfhi(aq.w) * xb);
                const bf16x8 aqf = __builtin_bit_cast(bf16x8, qf), aqb = __builtin_bit_cast(bf16x8, qb);
#pragma unroll
                for (int n = 0; n < 2; ++n) {
                    ao[n] = __builtin_amdgcn_mfma_f32_32x32x16_bf16(ap, trread(TV, wp0 + n, s, lane), ao[n], 0, 0, 0);
                    ao[n] = __builtin_amdgcn_mfma_f32_32x32x16_bf16(aqf, cf[s & 3][n], ao[n], 0, 0, 0);
                    ao[n] = __builtin_amdgcn_mfma_f32_32x32x16_bf16(aqb, cb[s & 3][n], ao[n], 0, 0, 0); }
                if (s < 4) {
#pragma unroll
                    for (int n = 0; n < 2; ++n) { cf[s][n] = *(const bf16x8*)(ftf + n * 32 * 128 + 16 * (s + 4)); cb[s][n] = *(const bf16x8*)(ftf + 16384 + n * 32 * 128 + 16 * (s + 4)); } } }
        }
        __syncthreads();
#pragma unroll
        for (int r = 0; r < 16; ++r) { const int i = 32 * wb + crow(r, hi);
#pragma unroll
            for (int n = 0; n < 2; ++n) OT[i * 132 + 32 * (wp0 + n) + l31] = ao[n][r]; }
        __syncthreads();
        {
            const int i = tid_u >> 2, qd = tid_u & 3;
            f32x4 v[8]; float s1 = 0.f, s2 = 0.f;
#pragma unroll
            for (int k = 0; k < 8; ++k) { v[k] = *(const LAS f32x4*)(OT + i * 132 + 32 * qd + 4 * k); s1 += (v[k].x + v[k].y) + (v[k].z + v[k].w);
                s2 += (v[k].x * v[k].x + v[k].y * v[k].y) + (v[k].z * v[k].z + v[k].w * v[k].w); }
            s1 += shx<1>(s1); s1 += shx<2>(s1); s2 += shx<1>(s2); s2 += shx<2>(s2);
            const float mu = s1 * (1.f / 128.f), var = fmaxf(s2 * (1.f / 128.f) - mu * mu, 0.f), rs = frsq(var + EPS);
            const int col = h * 128 + 32 * qd;
            unsigned char* op = (unsigned char*)CAT + (m0 + i) * D + 512 + col;
            f32x4 gg[8], gbv[8];
#pragma unroll
            for (int k = 0; k < 8; ++k) { gg[k] = *(const f32x4*)(gn_g + col + 4 * k); gbv[k] = *(const f32x4*)(gn_b + col + 4 * k); }
#pragma unroll
            for (int k2 = 0; k2 < 4; ++k2) { __builtin_amdgcn_sched_barrier(0); const v4u gw4 = gw[k2]; const unsigned gwv[4] = {gw4.x, gw4.y, gw4.z, gw4.w}; float o[8];
#pragma unroll
                for (int q = 0; q < 8; ++q) { const int cc = 8 * k2 + q; const float x = v[cc >> 2][cc & 3];
                    const float y = (x - mu) * rs * gg[cc >> 2][cc & 3] + gbv[cc >> 2][cc & 3];
                    const float gt = (q & 1) ? bfhi(gwv[q >> 1]) : bflo(gwv[q >> 1]);
                    o[q] = y * gt * frcp(1.0f + __expf(-gt)); }
#pragma unroll
                for (int q = 0; q < 8; ++q) o[q] = __builtin_amdgcn_fmed3f(o[q] * CAT_S_RET, -448.0f, 448.0f);
                unsigned w0 = 0u, w1 = 0u;
                w0 = __builtin_amdgcn_cvt_pk_fp8_f32(o[0], o[1], w0, false); w0 = __builtin_amdgcn_cvt_pk_fp8_f32(o[2], o[3], w0, true);
                w1 = __builtin_amdgcn_cvt_pk_fp8_f32(o[4], o[5], w1, false); w1 = __builtin_amdgcn_cvt_pk_fp8_f32(o[6], o[7], w1, true);
                *(u32x2*)(op + 8 * k2) = (u32x2){w0, w1}; }
        }
        __syncthreads();
    }
}

#if defined(ATTN_PROBE)
__device__ __forceinline__ void attn_check(Frame& F, const bf16* PROJ, const bf16* CAT, gu32* flag, const float* qg) {
    const int lane = F.lane, s = F.vcu * NWAVES + F.wave;
    const int b = s & 7, h = (s >> 3) & 7, qpos = (s * 977 + 131) & (T - 1), kvh = h >> 2;
    const bf16* qrow = PROJ + ((size_t)b * T + qpos) * INW + C_QA + h * 64;
    float qf[64], o[64];
    {
        const float raw = __uint_as_float((unsigned)qrow[lane] << 16);
        const float ss = wave_sum(raw * raw), y = raw * (1.0f / sqrtf(ss * (1.f / 64.f) + 1e-6f)) * qg[lane];
        const int quarter = lane >> 4, i = lane & 15; const float partner = shx<16>(y);
        const float invf = exp2f(-(float)i * (13.287712379549449f / 16.f)), ang = ((quarter < 2) ? (float)(qpos >> 6) : (float)(qpos & 63)) * invf;
        const float cs = __cosf(ang), sn = __sinf(ang);
        const float rot = (quarter & 1) ? (y * cs + partner * sn) : (y * cs - partner * sn);
        const float qv = rot * (0.125f * 1.4426950408889634f);
#pragma unroll
        for (int d = 0; d < 64; ++d) qf[d] = __int_as_float(bcastl(__float_as_int(qv), d));
    }
#pragma unroll
    for (int d = 0; d < 64; ++d) o[d] = 0.f;
    float m = -1e30f, l = 0.f;
    for (int i = 0; i < T / 64; ++i) {
        const size_t krow = ((size_t)b * T + i * 64 + lane) * INW;
        const bf16* kp = PROJ + krow + C_KA + kvh * 64; const bf16* vp = PROJ + krow + C_VA + kvh * 64;
        float sc = 0.f;
#pragma unroll
        for (int c = 0; c < 8; ++c) { const v4u w = *(const v4u*)(kp + 8 * c);
            sc += qf[8 * c + 0] * bflo(w.x) + qf[8 * c + 1] * bfhi(w.x) + qf[8 * c + 2] * bflo(w.y) + qf[8 * c + 3] * bfhi(w.y) + qf[8 * c + 4] * bflo(w.z) + qf[8 * c + 5] * bfhi(w.z) + qf[8 * c + 6] * bflo(w.w) + qf[8 * c + 7] * bfhi(w.w); }
        const float mn = fmaxf(m, sc), fs = fexp2(m - mn), p = fexp2(sc - mn);
        l = l * fs + p; m = mn;
#pragma unroll
        for (int c = 0; c < 8; ++c) { const v4u w = *(const v4u*)(vp + 8 * c);
            o[8 * c + 0] = o[8 * c + 0] * fs + p * bflo(w.x); o[8 * c + 1] = o[8 * c + 1] * fs + p * bfhi(w.x); o[8 * c + 2] = o[8 * c + 2] * fs + p * bflo(w.y); o[8 * c + 3] = o[8 * c + 3] * fs + p * bfhi(w.y);
            o[8 * c + 4] = o[8 * c + 4] * fs + p * bflo(w.z); o[8 * c + 5] = o[8 * c + 5] * fs + p * bfhi(w.z); o[8 * c + 6] = o[8 * c + 6] * fs + p * bflo(w.w); o[8 * c + 7] = o[8 * c + 7] * fs + p * bfhi(w.w); }
    }
    float mm = m;
    mm = wmax64(mm);
    const float f = fexp2(m - mm); const float L = wave_sum(l * f);
    float mine = 0.f;
#pragma unroll
    for (int d = 0; d < 64; ++d) { const float od = wave_sum(o[d] * f) / L; if (lane == d) mine = od; }
    const unsigned short cw = CAT[((size_t)b * T + qpos) * D + h * 64 + lane];
    const float got = __uint_as_float((unsigned)cw << 16);
    const float E = wave_sum((mine - got) * (mine - got)), R = wave_sum(mine * mine);
    if (!(E <= 4e-4f * R) && lane == 0) __hip_atomic_store(flag, 1u, RLX_AGENT);
}
__device__ __forceinline__ void ka_expect(Frame& F, const bf16* PROJ, float* EXP, const float* kg) {
    const int lane = F.lane, s = F.vcu * NWAVES + F.wave, m = (s * 40503 + 77) & (M - 1), pos = m & (T - 1);
    for (int hk = 0; hk < 2; ++hk) {
        const float raw = __uint_as_float((unsigned)PROJ[(size_t)m * INW + C_KA + hk * 64 + lane] << 16);
        const float ss = wave_sum(raw * raw), y = raw * (1.0f / sqrtf(ss * (1.f / 64.f) + 1e-6f)) * kg[lane];
        const int quarter = lane >> 4, i = lane & 15; const float partner = shx<16>(y);
        const float invf = exp2f(-(float)i * (13.287712379549449f / 16.f)), ang = ((quarter < 2) ? (float)(pos >> 6) : (float)(pos & 63)) * invf;
        const float cs = __cosf(ang), sn = __sinf(ang);
        EXP[(size_t)s * 128 + hk * 64 + lane] = (quarter & 1) ? (y * cs + partner * sn) : (y * cs - partner * sn);
    }
}
__device__ __forceinline__ void ka_compare(Frame& F, const bf16* PROJ, const float* EXP, gu32* flag) {
    const int lane = F.lane, s = F.vcu * NWAVES + F.wave, m = (s * 40503 + 77) & (M - 1);
    float E = 0.f, R = 0.f;
    for (int hk = 0; hk < 2; ++hk) { const float got = __uint_as_float((unsigned)PROJ[(size_t)m * INW + C_KA + hk * 64 + lane] << 16), ex = EXP[(size_t)s * 128 + hk * 64 + lane];
        E += (got - ex) * (got - ex); R += ex * ex; }
    E = wave_sum(E); R = wave_sum(R);
    if (!(E <= 1e-4f * R) && lane == 0) __hip_atomic_store(flag, 1u, RLX_AGENT);
}
#endif

typedef _Float16 f16x8 __attribute__((ext_vector_type(8)));
typedef _Float16 f16x4 __attribute__((ext_vector_type(4)));
template <bool X16, bool XIN16 = false> __device__ __forceinline__ void p3b_postmix(Frame& F, const float* xin, float* xout, const bf16* YM, signed char* HQ, float* hs, const float* mod_l,
                                            const float* post_g, const float* pre_g, const float* rw, const float* rb, int* topi, float* topw, gu32* cnt_g) {
    const int lane = F.lane, gw = F.vcu * NWAVES + F.wave, NGW = F.G * NWAVES;
    LAS unsigned char* WT = F.lds;
    LAS unsigned char* AT = F.lds + 65536 + F.wave * 8192;
    LAS unsigned* lcnt = (LAS unsigned*)(F.lds + LCNT_OFF);
#pragma unroll
    for (int i = 0; i < 16; ++i) { const int n = F.tid + NTHR * i, k = n >> 3, e0 = (n & 7) * 4; const f32x4 v = *(const f32x4*)(rw + (size_t)k * NE + e0);
#pragma unroll
        for (int q = 0; q < 4; ++q) { const int e = e0 + q; *(LAS _Float16*)(WT + e * 2048 + (((k >> 3) ^ (e & 15)) << 4) + (k & 7) * 2) = (_Float16)v[q]; } }
    if (F.tid < 32) lcnt[F.tid] = 0u;
    LAS float* GL = (LAS float*)(F.lds + GAIN_OFF);
    { const f32x4 g0 = ((const f32x4*)post_g)[F.tid & 255], g1 = ((const f32x4*)pre_g)[F.tid & 255]; if (F.tid < 256) { ((LAS f32x4*)GL)[F.tid] = g0; ((LAS f32x4*)(GL + D))[F.tid] = g1; } }
    __syncthreads();
    const float rbias = rb[lane & 31];
    const int ar = lane & 3, kg = lane >> 4, be = lane & 15;
    for (int ch = gw; ch < M / 32; ch += NGW) { const int mb = ch * 32;
        const float* modb = mod_l + (size_t)(mb >> 13) * (6 * D);
        f32x4 gpv[4], gsv[4], shv[4];
#pragma unroll
        for (int j = 0; j < 4; ++j) { const f32x4 gm = ((const f32x4*)(modb + 2 * D))[lane + 64 * j], sc = ((const f32x4*)(modb + 4 * D))[lane + 64 * j]; shv[j] = ((const f32x4*)(modb + 3 * D))[lane + 64 * j];
            gpv[j] = gm * ((const LAS f32x4*)GL)[lane + 64 * j]; gsv[j] = ((const LAS f32x4*)(GL + D))[lane + 64 * j] * (sc + 1.0f); }
        u32x2 ywA[2][4], ywB[2][4]; f32x4 xrA[2][4], xrB[2][4];
#define P3B_ISSUE(YW, XR, t0) do { _Pragma("unroll") for (int rr = 0; rr < 2; ++rr) { const u32x2* yr = (const u32x2*)(YM + (size_t)(mb + (t0) + rr) * D) + lane; \
            _Pragma("unroll") for (int j = 0; j < 4; ++j) YW[rr][j] = yr[64 * j]; \
            if constexpr (XIN16) { const u32x2* xq = (const u32x2*)((const bf16*)xin + (size_t)(mb + (t0) + rr) * D) + lane; _Pragma("unroll") for (int j = 0; j < 4; ++j) { const u32x2 w = xq[64 * j]; XR[rr][j].x = __uint_as_float(w.x); XR[rr][j].y = __uint_as_float(w.y); } } \
            else load_row_f32(xin + (size_t)(mb + (t0) + rr) * D, XR[rr], lane); } } while (0)
#define P3B_PROC(YW, XR, t0, RB) do { _Pragma("unroll") for (int rr = 0; rr < 2; ++rr) { const int m = mb + (t0) + rr, r = (RB) + rr; \
            f32x4 y[4], x[4], hf[4]; \
            _Pragma("unroll") for (int j = 0; j < 4; ++j) { const u32x2 w = YW[rr][j]; y[j] = (f32x4){bflo(w.x), bfhi(w.x), bflo(w.y), bfhi(w.y)}; \
                if constexpr (XIN16) { const unsigned xa = __float_as_uint(XR[rr][j].x), xb = __float_as_uint(XR[rr][j].y); x[j] = (f32x4){bflo(xa), bfhi(xa), bflo(xb), bfhi(xb)}; } else x[j] = XR[rr][j]; } \
            const float rsy = row_rstd(y); \
            _Pragma("unroll") for (int j = 0; j < 4; ++j) { x[j] = x[j] + gpv[j] * (y[j] * rsy); if constexpr (!X16) ((f32x4*)(xout + (size_t)m * D))[lane + 64 * j] = x[j]; } \
            if constexpr (X16) store_row_bf16((bf16*)xout + (size_t)m * D, x, lane); \
            { const float rs = row_rstd(x); _Pragma("unroll") for (int j = 0; j < 4; ++j) hf[j] = x[j] * rs * gsv[j] + shv[j]; } \
            store_row_i8(HQ + (size_t)m * D, hs + m, hf, lane);                    \
            _Pragma("unroll") for (int j = 0; j < 4; ++j) { const int c = (lane >> 1) + 32 * j;        \
                *(LAS f16x4*)(AT + r * 2048 + ((c ^ (r << 2)) << 4) + 8 * (lane & 1)) = (f16x4){(_Float16)hf[j].x, (_Float16)hf[j].y, (_Float16)hf[j].z, (_Float16)hf[j].w}; } } } while (0)
        P3B_ISSUE(ywA, xrA, 0);
#pragma unroll 1
        for (int it = 0; it < 8; ++it) { const int m0 = mb + 4 * it;
        P3B_ISSUE(ywB, xrB, 4 * it + 2);
        P3B_PROC(ywA, xrA, 4 * it, 0);
        if (it < 7) P3B_ISSUE(ywA, xrA, 4 * it + 4);
        P3B_PROC(ywB, xrB, 4 * it + 2, 2);
        f32x4 la = (f32x4){0.f, 0.f, 0.f, 0.f}, lb = (f32x4){0.f, 0.f, 0.f, 0.f};
#pragma unroll 8
        for (int s = 0; s < 32; ++s) { const int c = 4 * s + kg;
            const f16x8 a = *(const LAS f16x8*)(AT + ar * 2048 + ((c ^ (ar << 2)) << 4));
            const f16x8 b0 = *(const LAS f16x8*)(WT + be * 2048 + ((c ^ be) << 4)), b1 = *(const LAS f16x8*)(WT + (16 + be) * 2048 + ((c ^ be) << 4));
            la = __builtin_amdgcn_mfma_f32_16x16x32_f16(a, b0, la, 0, 0, 0); lb = __builtin_amdgcn_mfma_f32_16x16x32_f16(a, b1, lb, 0, 0, 0); }
        const bool upper = (lane & 32) != 0, blk = (lane & 16) != 0;
#pragma unroll
        for (int pr = 0; pr < 2; ++pr) {
            const float lo_ = blk ? lb[pr] : la[pr], up_ = blk ? lb[pr + 2] : la[pr + 2];
            const float logit = (upper ? up_ : lo_) + rbias;
            const int m = m0 + pr + (upper ? 2 : 0);
            bool taken = false; float tv[TOPK]; int ti[TOPK];
#pragma unroll
            for (int k = 0; k < TOPK; ++k) { float bv = taken ? -INFINITY : logit; int bi = lane & 31;
#define MX_STEP(o) { const float ov = shx<(o)>(bv); const int oi = shxi<(o)>(bi); const bool tk = (ov > bv) || (ov == bv && oi < bi); bv = tk ? ov : bv; bi = tk ? oi : bi; }
                MX_STEP(16) MX_STEP(8) MX_STEP(4) MX_STEP(2) MX_STEP(1)
#undef MX_STEP
                tv[k] = bv; ti[k] = bi; if ((lane & 31) == bi) taken = true; }
            const float e1 = __expf(tv[1] - tv[0]), e2 = __expf(tv[2] - tv[0]), e3 = __expf(tv[3] - tv[0]), inv = frcp(1.0f + e1 + e2 + e3);
            if ((lane & 31) == 0) { *(i32x4*)(topi + (size_t)m * 4) = (i32x4){ti[0], ti[1], ti[2], ti[3]}; *(f32x4*)(topw + (size_t)m * 4) = (f32x4){inv, e1 * inv, e2 * inv, e3 * inv}; }
            if (taken) atomicAdd((unsigned*)(lcnt + (lane & 31)), 1u);
        }
        }
#undef P3B_ISSUE
#undef P3B_PROC
    }
    __syncthreads();
    if (F.tid < 32) { const unsigned c = lcnt[F.tid]; if (c) __hip_atomic_fetch_add(cnt_g + F.tid, c, RLX_AGENT); }
}
__device__ __forceinline__ void p4a_route(Frame& F, const float* hs, int* rmap, float* xsc, const int* topi, int* pos, gu32* cnt_g, gu32* cur_g) {
    const int gw = F.vcu * NWAVES + F.wave, NGW = F.G * NWAVES;
    LAS int* ts = (LAS int*)(F.lds + LTS_OFF);
    if (F.wave == 0) { LAS int* tmp = (LAS int*)(F.lds + LCNT_OFF); const int ln = F.lane;
        if (ln < NE) tmp[ln] = (int)((__hip_atomic_load(cnt_g + ln, RLX_AGENT) + 255u) >> 8);
        LDS_WAIT();
        if (ln <= NE) { int acc_ = 0; for (int k = 0; k < NE; ++k) acc_ += (k < ln) ? tmp[k] : 0; ts[ln] = acc_; } }
    __syncthreads();
    const int lane = F.lane;
    if (gw < NE) {
        const int c = (int)__hip_atomic_load(cnt_g + gw, RLX_AGENT), p0 = ts[gw] * 256 + c, p1 = ts[gw + 1] * 256;
        for (int p = p0 + lane; p < p1; p += 64) rmap[p] = 0;
    }
    for (int base = gw * 64; base < M; base += NGW * 64) {
        const int tok = base + lane; const i32x4 id = *(const i32x4*)(topi + (size_t)tok * 4);
        unsigned mycnt = 0u;
#pragma unroll 1
        for (int e = 0; e < NE; ++e) { const unsigned long long mk = __ballot(id.x == e || id.y == e || id.z == e || id.w == e); if (lane == e) mycnt = (unsigned)__popcll(mk); }
        unsigned mybase = 0u;
        if (lane < NE && mycnt) mybase = __hip_atomic_fetch_add(cur_g + lane, mycnt, RLX_AGENT);
        i32x4 ps = (i32x4){0, 0, 0, 0};
#pragma unroll 1
        for (int e = 0; e < NE; ++e) { const bool has = (id.x == e || id.y == e || id.z == e || id.w == e); const unsigned long long mk = __ballot(has);
            const int p = ts[e] * 256 + bcastl((int)mybase, e) + (int)__builtin_amdgcn_mbcnt_hi((unsigned)(mk >> 32), __builtin_amdgcn_mbcnt_lo((unsigned)mk, 0u));
            if (id.x == e) ps.x = p; if (id.y == e) ps.y = p; if (id.z == e) ps.z = p; if (id.w == e) ps.w = p; }
        *(i32x4*)(pos + (size_t)tok * 4) = ps;
        { const float sc = hs[tok]; xsc[ps.x] = sc; xsc[ps.y] = sc; xsc[ps.z] = sc; xsc[ps.w] = sc; rmap[ps.x] = tok; rmap[ps.y] = tok; rmap[ps.z] = tok; rmap[ps.w] = tok; }
    }
}
template <bool Y_F8, bool X16, bool XOUT16 = false> __device__ __forceinline__ void p5b_combine(Frame& F, const float* xin, float* xout, const bf16* Y,
                                            const int* pos, const float* topw, const float* mod_l, const float* post_g,
                                            bool has_next, const float* mod_n, const float* pre_g_n, signed char* HQ, float* hs) {
    const int lane = F.lane, gw = F.vcu * NWAVES + F.wave, NGW = F.G * NWAVES;
    for (int ch = gw; ch < M / 32; ch += NGW) { const int mb = ch * 32;
        const float* modb = mod_l + (size_t)(mb >> 13) * (6 * D); const float* modn = mod_n + (size_t)(mb >> 13) * (6 * D);
        f32x4 gpv[4], gsv[4], shv[4];
#pragma unroll
        for (int j = 0; j < 4; ++j) { gpv[j] = ((const f32x4*)post_g)[lane + 64 * j] * ((const f32x4*)(modb + 5 * D))[lane + 64 * j];
            gsv[j] = ((const f32x4*)pre_g_n)[lane + 64 * j] * (((const f32x4*)(modn + D))[lane + 64 * j] + 1.0f); shv[j] = ((const f32x4*)modn)[lane + 64 * j]; }
        const i32x4 myps = *(const i32x4*)(pos + (size_t)(mb + (lane & 31)) * 4); const f32x4 mywt = *(const f32x4*)(topw + (size_t)(mb + (lane & 31)) * 4);
        u32x2 ywA[2][TOPK][4], ywB[2][TOPK][4], xwA[2][4], xwB[2][4]; f32x4 xfA[2][4], xfB[2][4];
#define P5B_ISSUE(YW, XW, XF, t0) do { _Pragma("unroll") for (int r = 0; r < 2; ++r) { const int t_ = (t0) + r; \
            _Pragma("unroll") for (int k = 0; k < TOPK; ++k) { const int p_ = __builtin_amdgcn_readlane(myps[k], t_); \
                if constexpr (Y_F8) { const int c0 = 4 * lane; const unsigned* yr = (const unsigned*)((const unsigned char*)Y + (size_t)p_ * D + 64 * ((c0 >> 5) & 3) + 16 * ((c0 >> 3) & 3) + 8 * (c0 >> 7) + (c0 & 7)); \
                    _Pragma("unroll") for (int j = 0; j < 4; ++j) { YW[r][k][j].x = yr[64 * j]; YW[r][k][j].y = 0u; } } \
                else { const u32x2* yr = (const u32x2*)(Y + (size_t)p_ * D) + lane; _Pragma("unroll") for (int j = 0; j < 4; ++j) YW[r][k][j] = yr[64 * j]; } } \
            if constexpr (X16) { const u32x2* xr = (const u32x2*)((const bf16*)xin + (size_t)(mb + t_) * D) + lane; _Pragma("unroll") for (int j = 0; j < 4; ++j) XW[r][j] = xr[64 * j]; } \
            else load_row_f32(xin + (size_t)(mb + t_) * D, XF[r], lane); } } while (0)
#define P5B_PROC(YW, XW, XF, t0) do { _Pragma("unroll") for (int r = 0; r < 2; ++r) { const int t_ = (t0) + r, m = mb + t_; f32x4 y[4], x[4]; \
            float wk[TOPK]; _Pragma("unroll") for (int k = 0; k < TOPK; ++k) wk[k] = __int_as_float(__builtin_amdgcn_readlane(__float_as_int(mywt[k]), t_)); \
            _Pragma("unroll") for (int j = 0; j < 4; ++j) { y[j] = (f32x4){0.f, 0.f, 0.f, 0.f}; \
                _Pragma("unroll") for (int k = 0; k < TOPK; ++k) { const u32x2 w = YW[r][k][j]; \
                    if constexpr (Y_F8) { typedef float f32x2p __attribute__((ext_vector_type(2))); const f32x2p lo = __builtin_amdgcn_cvt_pk_f32_fp8(w.x, false), hi2 = __builtin_amdgcn_cvt_pk_f32_fp8(w.x, true); \
                        y[j] += (f32x4){lo.x, lo.y, hi2.x, hi2.y} * wk[k]; } \
                    else y[j] += (f32x4){bflo(w.x), bfhi(w.x), bflo(w.y), bfhi(w.y)} * wk[k]; } \
                if constexpr (X16) { const u32x2 w = XW[r][j]; x[j] = (f32x4){bflo(w.x), bfhi(w.x), bflo(w.y), bfhi(w.y)}; } else x[j] = XF[r][j]; } \
            const float rsy = row_rstd(y); \
            _Pragma("unroll") for (int j = 0; j < 4; ++j) { x[j] = x[j] + gpv[j] * (y[j] * rsy); if constexpr (!XOUT16) ((f32x4*)(xout + (size_t)m * D))[lane + 64 * j] = x[j]; } \
            if constexpr (XOUT16) store_row_bf16((bf16*)xout + (size_t)m * D, x, lane);        \
            if (has_next) { f32x4 h[4]; const float rs = row_rstd(x); _Pragma("unroll") for (int j = 0; j < 4; ++j) h[j] = x[j] * rs * gsv[j] + shv[j]; \
                store_row_i8(HQ + (size_t)m * D, hs + m, h, lane); } } } while (0)
        P5B_ISSUE(ywA, xwA, xfA, 0);
#pragma unroll 1
        for (int it = 0; it < 8; ++it) { const int t0 = 4 * it;
            P5B_ISSUE(ywB, xwB, xfB, t0 + 2);
            P5B_PROC(ywA, xwA, xfA, t0);
            if (it < 7) P5B_ISSUE(ywA, xwA, xfA, t0 + 4);
            P5B_PROC(ywB, xwB, xfB, t0 + 2);
        }
#undef P5B_ISSUE
#undef P5B_PROC
    }
}

constexpr int PTAB_OFF = LDSCTL_OFF + 512;
enum { I_X = 0, I_C, I_ADAW, I_ADAB, I_PREMIX, I_POSTMIX, I_WIN, I_QG, I_KG, I_DECF, I_DECB, I_GNG, I_GNB, I_WOUT, I_PREFFN, I_POSTFFN, I_RW, I_RB, I_WUP, I_BUP, I_WDN, I_BDN, I_OUT, I_WS };
__device__ __forceinline__ unsigned char* ptab(LAS unsigned char* lds, int k) {
    const LAS unsigned* p = (const LAS unsigned*)(lds + PTAB_OFF) + 2 * k;
    const unsigned lo = __builtin_amdgcn_readfirstlane(p[0]), hi = __builtin_amdgcn_readfirstlane(p[1]);
    return (unsigned char*)(GAS unsigned char*)(((unsigned long long)hi << 32) | lo);
}
__device__ __forceinline__ unsigned char* ptabx(LAS unsigned char* lds, int k) {
    const LAS unsigned* p = (const LAS unsigned*)(lds + PTAB_OFF) + 2 * k;
    const unsigned lo = __builtin_amdgcn_readfirstlane(p[0]), hi = __builtin_amdgcn_readfirstlane(p[1]);
    return (unsigned char*)(((unsigned long long)hi << 32) | lo);
}
#define WSX(off) (ptabx(F.lds, I_WS) + (off))
#define PF(k) ((const float*)ptab(F.lds, (k)))
#define WSP(off) (ptab(F.lds, I_WS) + (off))
struct Args { const float* in[22]; float* out; unsigned char* ws; };
__global__ void __launch_bounds__(NTHR, 2) mk_fwd(Args args) {
    extern __shared__ __attribute__((aligned(16))) unsigned char lds[];
    Frame F;
    F.lds = (LAS unsigned char*)lds;
    F.MISC = (volatile LAS unsigned*)(F.lds + MISC_OFF);
    F.tid = threadIdx.x; F.lane = F.tid & 63; F.wave = __builtin_amdgcn_readfirstlane(F.tid >> 6);
    F.G = gridDim.x; { const int bx = blockIdx.x; F.vcu = (F.G % 8 == 0) ? (bx % 8) * (F.G / 8) + bx / 8 : bx; }
    F.ctl = (gu32*)(args.ws + WS_CTL);
    for (int u = F.tid; u < (LDS_BYTES - LDSCTL_OFF) / 4; u += NTHR) ((LAS unsigned*)(F.lds + LDSCTL_OFF))[u] = 0u;
    __syncthreads();
    if (F.tid == 0) { LAS unsigned long long* PT = (LAS unsigned long long*)(F.lds + PTAB_OFF);
#pragma unroll
        for (int k = 0; k < 22; ++k) PT[k] = (unsigned long long)args.in[k];
        PT[I_OUT] = (unsigned long long)args.out; PT[I_WS] = (unsigned long long)args.ws; }
    __syncthreads();
    (void)xcd_barrier_post((unsigned*)(F.ctl + CW_BAR), F.MISC + 8);
#define LAUNDER() do { F.tid = threadIdx.x; asm volatile("" : "+v"(F.tid)); F.lane = F.tid & 63; F.wave = __builtin_amdgcn_readfirstlane(F.tid >> 6); \
    { unsigned long long lb_ = (unsigned long long)lds0_; int vc_ = vcu0_, g_ = G0_; asm volatile("" : "+s"(lb_), "+s"(vc_), "+s"(g_)); F.lds = (LAS unsigned char*)lb_; F.vcu = vc_; F.G = g_; } } while (0)
#ifndef REP_BAR
#define REP_BAR 1
#endif
#define GRID_BAR() for (int rb_ = 0; rb_ < REP_BAR; ++rb_) do { XcdBarrier b_; b_.bar = (unsigned*)(ptab(F.lds, I_WS) + WS_CTL) + CW_BAR; b_.x = xb_xcc_id(); b_.st = (volatile LAS unsigned*)(F.lds + MISC_OFF) + 8; xcd_barrier(b_); LAUNDER(); } while (0)
    const LAS unsigned char* lds0_ = F.lds; const int vcu0_ = F.vcu, G0_ = F.G;

#ifndef SKIP_P0
    for (int rep_ = 0; rep_ < REP_P0; ++rep_)
    p0_prologue(F, PF(I_C), PF(I_ADAW), PF(I_ADAB), (float*)WSP(WS_MOD), PF(I_WIN), PF(I_WOUT), PF(I_WUP), PF(I_WDN),
                (signed char*)WSP(WS_WIN), (float*)WSP(WS_CSCIN), (signed char*)WSP(WS_WOUT), (float*)WSP(WS_CSCOUT), (signed char*)WSP(WS_WUP), (float*)WSP(WS_CSC), (signed char*)WSP(WS_WDN), (float*)WSP(WS_CSCDN), F.ctl + CW_WQ);
#endif
    GRID_BAR();
#ifndef SKIP_P0B
    for (int rep_ = 0; rep_ < REP_P0B; ++rep_)
    p0b_premix(F, PF(I_X), (signed char*)WSP(WS_HM), (float*)WSP(WS_HS), PF(I_PREMIX), (const float*)WSP(WS_MOD));
#endif
    GRID_BAR();
    { constexpr int l = 0;
        for (int rep_ = 0; rep_ < REP_P1; ++rep_) { LAUNDER();
#ifndef SKIP_P1
        {
            pg8::Gemm g{(const bf16*)WSP(WS_HM), (const bf16*)(WSP(WS_WIN) + (size_t)l * INW * D), M, INW, D / 2}; pg8::StaticOrder S; S.init(M, INW, F.G, (int)blockIdx.x);
            pg8::EpiI8Bf16 E{(bf16*)WSP(WS_PROJ), INW, (const float*)WSP(WS_HS), (const float*)WSP(WS_CSCIN) + (size_t)l * INW, F.lds + EPI_SP_OFF};
#if defined(STAGGER_P1)
            { const unsigned long long t0_ = __builtin_amdgcn_s_memrealtime(), dl_ = (unsigned long long)(F.vcu & 7) * STAGGER_P1; while (__builtin_amdgcn_s_memrealtime() - t0_ < dl_) __builtin_amdgcn_s_sleep(8); }
#endif
#if defined(NOEPI_P1)
            { pg8::EpiNullI8 E0; pg8::gemm_phase<pg8::EpiNullI8, pg8::StaticOrder, true, true, true, true>(F.lds + RING_OFF, g, S, E0, (const int*)WSP(WS_RMAP)); LAUNDER(); }
#endif
            pg8::gemm_phase<pg8::EpiI8Bf16, pg8::StaticOrder, true, true, true>(F.lds + RING_OFF, g, S, E);
        }
#endif
        }
        GRID_BAR();
#if defined(ATTN_PROBE)
        if (l == 0) ka_expect(F, (const bf16*)WSP(WS_PROJ), (float*)WSP(WS_DUMMY), PF(I_KG));
        GRID_BAR();
#endif
#ifndef SKIP_P1B
        p1b_ka(F, (bf16*)WSP(WS_PROJ), PF(I_KG) + l * 64);
#endif
        for (int rep_ = 0; rep_ < REP_R1; ++rep_) { LAUNDER();
#ifndef SKIP_R1
        r1_states(F, (const bf16*)WSP(WS_PROJ), (bf16*)WSP(WS_U), PF(I_DECF) + l * RH, PF(I_DECB) + l * RH);
#endif
        }
        GRID_BAR();
        for (int rep_ = 0; rep_ < REP_R2; ++rep_) { LAUNDER();
#ifndef SKIP_R2
        r2_scan(F, (const bf16*)WSP(WS_U), (bf16*)WSP(WS_FT), PF(I_DECF) + l * RH, PF(I_DECB) + l * RH);
#endif
        }
        GRID_BAR();
#pragma unroll 1
        for (int pass_ = 0; pass_ < 2; ++pass_) { LAUNDER();
        if (((F.vcu ^ pass_) & 1) == 0) {
#ifndef SKIP_R3
        r3_out(F, (const bf16*)WSP(WS_PROJ), (const bf16*)WSP(WS_FT), (bf16*)WSP(WS_CAT), PF(I_DECF) + l * RH, PF(I_DECB) + l * RH, PF(I_GNG) + l * 512, PF(I_GNB) + l * 512);
#endif
        } else {
#ifndef SKIP_P2
        {
            const bf16* PROJ = (const bf16*)WSP(WS_PROJ);
            const attn_body::AttnTensors AT{(const attn_body::bf16*)(PROJ + C_QA), (const attn_body::bf16*)(PROJ + C_KA), (const attn_body::bf16*)(PROJ + C_VA), (attn_body::bf16*)WSP(WS_CAT), PF(I_QG) + l * 64, PF(I_KG) + l * 64};
            attn_body::attn_phase<8>((char*)lds + RING_OFF, AT, F.vcu, F.G);
        }
#endif
        }
        }
        GRID_BAR();
#if defined(ATTN_PROBE)
        if (l == 0) ka_compare(F, (const bf16*)WSP(WS_PROJ), (const float*)WSP(WS_DUMMY), F.ctl + CW_CODE + 8);
        if (l == 0) attn_check(F, (const bf16*)WSP(WS_PROJ), (const bf16*)WSP(WS_CAT), F.ctl + CW_CODE + 8, PF(I_QG));
#endif
        for (int rep_ = 0; rep_ < REP_P3; ++rep_) { LAUNDER();
#ifndef SKIP_P3
        {
            pg8::Gemm g{(const bf16*)WSP(WS_CAT), (const bf16*)(WSP(WS_WOUT) + (size_t)l * D * D), M, D, D / 2}; pg8::StaticOrder S; S.init(M, D, F.G, (int)blockIdx.x);
            pg8::EpiBf16 E{(bf16*)WSP(WS_YM), D, nullptr, 0, 0, F.lds + EPI_SP_OFF, (const float*)WSP(WS_CSCOUT) + (size_t)l * D, 1.0f};
            pg8::gemm_phase<pg8::EpiBf16, pg8::StaticOrder, true, true, false, false, true>(F.lds + RING_OFF, g, S, E);
        }
#endif
        }
        GRID_BAR();
#ifndef SKIP_P3B
        for (int rep_ = 1; rep_ < REP_P3B; ++rep_) { LAUNDER();
        p3b_postmix<false, (l > 0)>(F, l == 0 ? PF(I_X) : PF(I_OUT), (float*)WSP(WS_DUMMY), (const bf16*)WSP(WS_YM), (signed char*)WSP(WS_DUMMY + 256 * MiB), (float*)WSP(WS_DUMMY + 386 * MiB), (const float*)WSP(WS_MOD) + (size_t)l * BATCH * 6 * D,
                    PF(I_POSTMIX) + l * D, PF(I_PREFFN) + l * D, PF(I_RW) + (size_t)l * D * NE, PF(I_RB) + l * NE, (int*)WSP(WS_DUMMY + 384 * MiB), (float*)WSP(WS_DUMMY + 385 * MiB), F.ctl + CW_CNT + 128 + l * 64);
        }
        LAUNDER();
        p3b_postmix<(l >= X16_FROM), (l > 0)>(F, l == 0 ? PF(I_X) : PF(I_OUT), (l >= X16_FROM) ? (float*)WSP(WS_CAT) : (float*)ptab(F.lds, I_OUT), (const bf16*)WSP(WS_YM), (signed char*)WSP(WS_HM), (float*)WSP(WS_HS), (const float*)WSP(WS_MOD) + (size_t)l * BATCH * 6 * D,
                    PF(I_POSTMIX) + l * D, PF(I_PREFFN) + l * D, PF(I_RW) + (size_t)l * D * NE, PF(I_RB) + l * NE, (int*)WSP(WS_TOPI), (float*)WSP(WS_TOPW), F.ctl + CW_CNT + l * 64);
#endif
        GRID_BAR();
#ifndef SKIP_P4A
        for (int rep_ = 1; rep_ < REP_P4A; ++rep_) { LAUNDER();
        p4a_route(F, (const float*)WSP(WS_HS), (int*)WSP(WS_DUMMY + 16 * MiB), (float*)WSP(WS_DUMMY + 8 * MiB), (const int*)WSP(WS_TOPI), (int*)WSP(WS_DUMMY), F.ctl + CW_CNT + l * 64, F.ctl + CW_CUR + 128 + l * 64);
        }
        LAUNDER();
        p4a_route(F, (const float*)WSP(WS_HS), (int*)WSP(WS_RMAP), (float*)WSP(WS_XSC), (const int*)WSP(WS_TOPI), (int*)WSP(WS_POS), F.ctl + CW_CNT + l * 64, F.ctl + CW_CUR + l * 64);
#endif
        GRID_BAR();
        for (int rep_ = 0; rep_ < REP_P4; ++rep_) { LAUNDER();
#ifndef SKIP_P4
        {
            const LAS int* ts = (const LAS int*)(F.lds + LTS_OFF);
            pg8::Gemm g{(const bf16*)WSP(WS_HM), (const bf16*)(WSP(WS_WUP) + (size_t)l * NE * 2048 * D), XS_ROWS, 2048, D / 2}; pg8::MoeOrder<3> S{ts, F.G, F.vcu, ts[NE] * 8, ts[F.lane & 31]};
            pg8::EpiMoeUpT<true> E{(bf16*)WSP(WS_ACT), PF(I_BUP) + (size_t)l * NE * 2048, (const float*)WSP(WS_XSC), (const float*)WSP(WS_CSC) + (size_t)l * NE * 2048, F.lds + EPI_SP_OFF};
#if defined(STAGGER_P4)
            { const unsigned long long t0_ = __builtin_amdgcn_s_memrealtime(), dl_ = (unsigned long long)(F.vcu & (STAGGER_WAYS - 1)) * STAGGER_P4; while (__builtin_amdgcn_s_memrealtime() - t0_ < dl_) __builtin_amdgcn_s_sleep(8); }
#endif
#if defined(NOLOAD_P4)
            { pg8::EpiMoeUpNoLoad E0{(bf16*)WSP(WS_ACT), 1e-4f, 0.01f}; pg8::gemm_phase<pg8::EpiMoeUpNoLoad, pg8::MoeOrder<3>, true, true, true, true>(F.lds + RING_OFF, g, S, E0, (const int*)WSP(WS_RMAP)); LAUNDER(); }
#endif
#if defined(NOSTORE_P4)
            { pg8::EpiMoeUpNoStore E0{(bf16*)WSP(WS_ACT), 1e-4f, 0.01f}; pg8::gemm_phase<pg8::EpiMoeUpNoStore, pg8::MoeOrder<3>, true, true, true, true>(F.lds + RING_OFF, g, S, E0, (const int*)WSP(WS_RMAP)); LAUNDER(); }
#endif
#if defined(NOEPI_P4)
            { pg8::EpiNullI8 E0; pg8::gemm_phase<pg8::EpiNullI8, pg8::MoeOrder<3>, true, true, true, true>(F.lds + RING_OFF, g, S, E0, (const int*)WSP(WS_RMAP)); LAUNDER(); }
#endif
            pg8::gemm_phase<pg8::EpiMoeUpT<true>, pg8::MoeOrder<3>, true, true, true, true>(F.lds + RING_OFF, g, S, E, (const int*)WSP(WS_RMAP));
        }
#endif
        }
        GRID_BAR();
        for (int rep_ = 0; rep_ < REP_P5; ++rep_) { LAUNDER();
#ifndef SKIP_P5
        {
            const LAS int* ts = (const LAS int*)(F.lds + LTS_OFF);
            pg8::Gemm g{(const bf16*)WSP(WS_ACT), (const bf16*)(WSP(WS_WDN) + (size_t)l * NE * D * D), XS_ROWS, D, D / 2}; pg8::MoeOrder<2> S{ts, F.G, F.vcu, ts[NE] * 4, ts[F.lane & 31]};
            typedef pg8::EpiBf16T<(l >= YF8_FROM)> EpiDn;
            EpiDn E{(bf16*)WSP(WS_XS), D, PF(I_BDN) + (size_t)l * NE * D, D, 0, F.lds + EPI_SP_OFF, (const float*)WSP(WS_CSCDN) + (size_t)l * NE * D, 1.0f / pg8::ACT_F8_SCALE};
#if defined(STAGGER_P5)
            { const unsigned long long t0_ = __builtin_amdgcn_s_memrealtime(), dl_ = (unsigned long long)(F.vcu & 7) * STAGGER_P5; while (__builtin_amdgcn_s_memrealtime() - t0_ < dl_) __builtin_amdgcn_s_sleep(8); }
#endif
            pg8::gemm_phase<EpiDn, pg8::MoeOrder<2>, true, true, false, false, true>(F.lds + RING_OFF, g, S, E);
        }
#endif
        }
        GRID_BAR();
#ifndef SKIP_P5B
        for (int rep_ = 1; rep_ < REP_P5B; ++rep_) { LAUNDER();
        p5b_combine<(l >= YF8_FROM), (l >= X16_FROM), (l + 1 < DEPTH)>(F, (l >= X16_FROM) ? (const float*)WSP(WS_CAT) : (const float*)ptab(F.lds, I_OUT), (float*)WSP(WS_DUMMY), (const bf16*)WSP(WS_XS), (const int*)WSP(WS_POS), (const float*)WSP(WS_TOPW), (const float*)WSP(WS_MOD) + (size_t)l * BATCH * 6 * D, PF(I_POSTFFN) + l * D,
                    l + 1 < DEPTH, (const float*)WSP(WS_MOD) + (size_t)(l + 1 < DEPTH ? l + 1 : l) * BATCH * 6 * D, PF(I_PREMIX) + (l + 1 < DEPTH ? (l + 1) * D : 0), (signed char*)WSP(WS_DUMMY + 256 * MiB), (float*)WSP(WS_DUMMY + 386 * MiB));
        }
        LAUNDER();
        p5b_combine<(l >= YF8_FROM), (l >= X16_FROM), (l + 1 < DEPTH)>(F, (l >= X16_FROM) ? (const float*)WSP(WS_CAT) : (const float*)ptab(F.lds, I_OUT), (float*)ptab(F.lds, I_OUT), (const bf16*)WSP(WS_XS), (const int*)WSP(WS_POS), (const float*)WSP(WS_TOPW), (const float*)WSP(WS_MOD) + (size_t)l * BATCH * 6 * D, PF(I_POSTFFN) + l * D,
                    l + 1 < DEPTH, (const float*)WSP(WS_MOD) + (size_t)(l + 1 < DEPTH ? l + 1 : l) * BATCH * 6 * D, PF(I_PREMIX) + (l + 1 < DEPTH ? (l + 1) * D : 0), (signed char*)WSP(WS_HM), (float*)WSP(WS_HS));
#endif
        if (l + 1 < DEPTH) GRID_BAR();
    }
    { constexpr int l = 1;
        for (int rep_ = 0; rep_ < REP_P1; ++rep_) { LAUNDER();
#ifndef SKIP_P1
        {
            pg8::Gemm g{(const bf16*)WSP(WS_HM), (const bf16*)(WSP(WS_WIN) + (size_t)l * INW * D), M, INW, D / 2}; pg8::StaticOrder S; S.init(M, INW, F.G, (int)blockIdx.x);
            pg8::EpiI8Bf16 E{(bf16*)WSP(WS_PROJ), INW, (const float*)WSP(WS_HS), (const float*)WSP(WS_CSCIN) + (size_t)l * INW, F.lds + EPI_SP_OFF};
#if defined(STAGGER_P1)
            { const unsigned long long t0_ = __builtin_amdgcn_s_memrealtime(), dl_ = (unsigned long long)(F.vcu & 7) * STAGGER_P1; while (__builtin_amdgcn_s_memrealtime() - t0_ < dl_) __builtin_amdgcn_s_sleep(8); }
#endif
#if defined(NOEPI_P1)
            { pg8::EpiNullI8 E0; pg8::gemm_phase<pg8::EpiNullI8, pg8::StaticOrder, true, true, true, true>(F.lds + RING_OFF, g, S, E0, (const int*)WSP(WS_RMAP)); LAUNDER(); }
#endif
            pg8::gemm_phase<pg8::EpiI8Bf16, pg8::StaticOrder, true, true, true>(F.lds + RING_OFF, g, S, E);
        }
#endif
        }
        GRID_BAR();
#if defined(ATTN_PROBE)
        if (l == 0) ka_expect(F, (const bf16*)WSP(WS_PROJ), (float*)WSP(WS_DUMMY), PF(I_KG));
        GRID_BAR();
#endif
#ifndef SKIP_P1B
        p1b_ka(F, (bf16*)WSP(WS_PROJ), PF(I_KG) + l * 64);
#endif
        for (int rep_ = 0; rep_ < REP_R1; ++rep_) { LAUNDER();
#ifndef SKIP_R1
        r1_states(F, (const bf16*)WSP(WS_PROJ), (bf16*)WSP(WS_U), PF(I_DECF) + l * RH, PF(I_DECB) + l * RH);
#endif
        }
        GRID_BAR();
        for (int rep_ = 0; rep_ < REP_R2; ++rep_) { LAUNDER();
#ifndef SKIP_R2
        r2_scan(F, (const bf16*)WSP(WS_U), (bf16*)WSP(WS_FT), PF(I_DECF) + l * RH, PF(I_DECB) + l * RH);
#endif
        }
        GRID_BAR();
#pragma unroll 1
        for (int pass_ = 0; pass_ < 2; ++pass_) { LAUNDER();
        if (((F.vcu ^ pass_) & 1) == 0) {
#ifndef SKIP_R3
        r3_out(F, (const bf16*)WSP(WS_PROJ), (const bf16*)WSP(WS_FT), (bf16*)WSP(WS_CAT), PF(I_DECF) + l * RH, PF(I_DECB) + l * RH, PF(I_GNG) + l * 512, PF(I_GNB) + l * 512);
#endif
        } else {
#ifndef SKIP_P2
        {
            const bf16* PROJ = (const bf16*)WSP(WS_PROJ);
            const attn_body::AttnTensors AT{(const attn_body::bf16*)(PROJ + C_QA), (const attn_body::bf16*)(PROJ + C_KA), (const attn_body::bf16*)(PROJ + C_VA), (attn_body::bf16*)WSP(WS_CAT), PF(I_QG) + l * 64, PF(I_KG) + l * 64};
            attn_body::attn_phase<8>((char*)lds + RING_OFF, AT, F.vcu, F.G);
        }
#endif
        }
        }
        GRID_BAR();
#if defined(ATTN_PROBE)
        if (l == 0) ka_compare(F, (const bf16*)WSP(WS_PROJ), (const float*)WSP(WS_DUMMY), F.ctl + CW_CODE + 8);
        if (l == 0) attn_check(F, (const bf16*)WSP(WS_PROJ), (const bf16*)WSP(WS_CAT), F.ctl + CW_CODE + 8, PF(I_QG));
#endif
        for (int rep_ = 0; rep_ < REP_P3; ++rep_) { LAUNDER();
#ifndef SKIP_P3
        {
            pg8::Gemm g{(const bf16*)WSP(WS_CAT), (const bf16*)(WSP(WS_WOUT) + (size_t)l * D * D), M, D, D / 2}; pg8::StaticOrder S; S.init(M, D, F.G, (int)blockIdx.x);
            pg8::EpiBf16 E{(bf16*)WSP(WS_YM), D, nullptr, 0, 0, F.lds + EPI_SP_OFF, (const float*)WSP(WS_CSCOUT) + (size_t)l * D, 1.0f};
            pg8::gemm_phase<pg8::EpiBf16, pg8::StaticOrder, true, true, false, false, true>(F.lds + RING_OFF, g, S, E);
        }
#endif
        }
        GRID_BAR();
#ifndef SKIP_P3B
        for (int rep_ = 1; rep_ < REP_P3B; ++rep_) { LAUNDER();
        p3b_postmix<false, (l > 0)>(F, l == 0 ? PF(I_X) : PF(I_OUT), (float*)WSP(WS_DUMMY), (const bf16*)WSP(WS_YM), (signed char*)WSP(WS_DUMMY + 256 * MiB), (float*)WSP(WS_DUMMY + 386 * MiB), (const float*)WSP(WS_MOD) + (size_t)l * BATCH * 6 * D,
                    PF(I_POSTMIX) + l * D, PF(I_PREFFN) + l * D, PF(I_RW) + (size_t)l * D * NE, PF(I_RB) + l * NE, (int*)WSP(WS_DUMMY + 384 * MiB), (float*)WSP(WS_DUMMY + 385 * MiB), F.ctl + CW_CNT + 128 + l * 64);
        }
        LAUNDER();
        p3b_postmix<(l >= X16_FROM), (l > 0)>(F, l == 0 ? PF(I_X) : PF(I_OUT), (l >= X16_FROM) ? (float*)WSP(WS_CAT) : (float*)ptab(F.lds, I_OUT), (const bf16*)WSP(WS_YM), (signed char*)WSP(WS_HM), (float*)WSP(WS_HS), (const float*)WSP(WS_MOD) + (size_t)l * BATCH * 6 * D,
                    PF(I_POSTMIX) + l * D, PF(I_PREFFN) + l * D, PF(I_RW) + (size_t)l * D * NE, PF(I_RB) + l * NE, (int*)WSP(WS_TOPI), (float*)WSP(WS_TOPW), F.ctl + CW_CNT + l * 64);
#endif
        GRID_BAR();
#ifndef SKIP_P4A
        for (int rep_ = 1; rep_ < REP_P4A; ++rep_) { LAUNDER();
        p4a_route(F, (const float*)WSP(WS_HS), (int*)WSP(WS_DUMMY + 16 * MiB), (float*)WSP(WS_DUMMY + 8 * MiB), (const int*)WSP(WS_TOPI), (int*)WSP(WS_DUMMY), F.ctl + CW_CNT + l * 64, F.ctl + CW_CUR + 128 + l * 64);
        }
        LAUNDER();
        p4a_route(F, (const float*)WSP(WS_HS), (int*)WSP(WS_RMAP), (float*)WSP(WS_XSC), (const int*)WSP(WS_TOPI), (int*)WSP(WS_POS), F.ctl + CW_CNT + l * 64, F.ctl + CW_CUR + l * 64);
#endif
        GRID_BAR();
        for (int rep_ = 0; rep_ < REP_P4; ++rep_) { LAUNDER();
#ifndef SKIP_P4
        {
            const LAS int* ts = (const LAS int*)(F.lds + LTS_OFF);
            pg8::Gemm g{(const bf16*)WSP(WS_HM), (const bf16*)(WSP(WS_WUP) + (size_t)l * NE * 2048 * D), XS_ROWS, 2048, D / 2}; pg8::MoeOrder<3> S{ts, F.G, F.vcu, ts[NE] * 8, ts[F.lane & 31]};
            pg8::EpiMoeUpT<true> E{(bf16*)WSP(WS_ACT), PF(I_BUP) + (size_t)l * NE * 2048, (const float*)WSP(WS_XSC), (const float*)WSP(WS_CSC) + (size_t)l * NE * 2048, F.lds + EPI_SP_OFF};
#if defined(STAGGER_P4)
            { const unsigned long long t0_ = __builtin_amdgcn_s_memrealtime(), dl_ = (unsigned long long)(F.vcu & (STAGGER_WAYS - 1)) * STAGGER_P4; while (__builtin_amdgcn_s_memrealtime() - t0_ < dl_) __builtin_amdgcn_s_sleep(8); }
#endif
#if defined(NOLOAD_P4)
            { pg8::EpiMoeUpNoLoad E0{(bf16*)WSP(WS_ACT), 1e-4f, 0.01f}; pg8::gemm_phase<pg8::EpiMoeUpNoLoad, pg8::MoeOrder<3>, true, true, true, true>(F.lds + RING_OFF, g, S, E0, (const int*)WSP(WS_RMAP)); LAUNDER(); }
#endif
#if defined(NOSTORE_P4)
            { pg8::EpiMoeUpNoStore E0{(bf16*)WSP(WS_ACT), 1e-4f, 0.01f}; pg8::gemm_phase<pg8::EpiMoeUpNoStore, pg8::MoeOrder<3>, true, true, true, true>(F.lds + RING_OFF, g, S, E0, (const int*)WSP(WS_RMAP)); LAUNDER(); }
#endif
#if defined(NOEPI_P4)
            { pg8::EpiNullI8 E0; pg8::gemm_phase<pg8::EpiNullI8, pg8::MoeOrder<3>, true, true, true, true>(F.lds + RING_OFF, g, S, E0, (const int*)WSP(WS_RMAP)); LAUNDER(); }
#endif
            pg8::gemm_phase<pg8::EpiMoeUpT<true>, pg8::MoeOrder<3>, true, true, true, true>(F.lds + RING_OFF, g, S, E, (const int*)WSP(WS_RMAP));
        }
#endif
        }
        GRID_BAR();
        for (int rep_ = 0; rep_ < REP_P5; ++rep_) { LAUNDER();
#ifndef SKIP_P5
        {
            const LAS int* ts = (const LAS int*)(F.lds + LTS_OFF);
            pg8::Gemm g{(const bf16*)WSP(WS_ACT), (const bf16*)(WSP(WS_WDN) + (size_t)l * NE * D * D), XS_ROWS, D, D / 2}; pg8::MoeOrder<2> S{ts, F.G, F.vcu, ts[NE] * 4, ts[F.lane & 31]};
            typedef pg8::EpiBf16T<(l >= YF8_FROM)> EpiDn;
            EpiDn E{(bf16*)WSP(WS_XS), D, PF(I_BDN) + (size_t)l * NE * D, D, 0, F.lds + EPI_SP_OFF, (const float*)WSP(WS_CSCDN) + (size_t)l * NE * D, 1.0f / pg8::ACT_F8_SCALE};
#if defined(STAGGER_P5)
            { const unsigned long long t0_ = __builtin_amdgcn_s_memrealtime(), dl_ = (unsigned long long)(F.vcu & 7) * STAGGER_P5; while (__builtin_amdgcn_s_memrealtime() - t0_ < dl_) __builtin_amdgcn_s_sleep(8); }
#endif
            pg8::gemm_phase<EpiDn, pg8::MoeOrder<2>, true, true, false, false, true>(F.lds + RING_OFF, g, S, E);
        }
#endif
        }
        GRID_BAR();
#ifndef SKIP_P5B
        for (int rep_ = 1; rep_ < REP_P5B; ++rep_) { LAUNDER();
        p5b_combine<(l >= YF8_FROM), (l >= X16_FROM), (l + 1 < DEPTH)>(F, (l >= X16_FROM) ? (const float*)WSP(WS_CAT) : (const float*)ptab(F.lds, I_OUT), (float*)WSP(WS_DUMMY), (const bf16*)WSP(WS_XS), (const int*)WSP(WS_POS), (const float*)WSP(WS_TOPW), (const float*)WSP(WS_MOD) + (size_t)l * BATCH * 6 * D, PF(I_POSTFFN) + l * D,
                    l + 1 < DEPTH, (const float*)WSP(WS_MOD) + (size_t)(l + 1 < DEPTH ? l + 1 : l) * BATCH * 6 * D, PF(I_PREMIX) + (l + 1 < DEPTH ? (l + 1) * D : 0), (signed char*)WSP(WS_DUMMY + 256 * MiB), (float*)WSP(WS_DUMMY + 386 * MiB));
        }
        LAUNDER();
        p5b_combine<(l >= YF8_FROM), (l >= X16_FROM), (l + 1 < DEPTH)>(F, (l >= X16_FROM) ? (const float*)WSP(WS_CAT) : (const float*)ptab(F.lds, I_OUT), (float*)ptab(F.lds, I_OUT), (const bf16*)WSP(WS_XS), (const int*)WSP(WS_POS), (const float*)WSP(WS_TOPW), (const float*)WSP(WS_MOD) + (size_t)l * BATCH * 6 * D, PF(I_POSTFFN) + l * D,
                    l + 1 < DEPTH, (const float*)WSP(WS_MOD) + (size_t)(l + 1 < DEPTH ? l + 1 : l) * BATCH * 6 * D, PF(I_PREMIX) + (l + 1 < DEPTH ? (l + 1) * D : 0), (signed char*)WSP(WS_HM), (float*)WSP(WS_HS));
#endif
        if (l + 1 < DEPTH) GRID_BAR();
    }
#if defined(ATTN_PROBE)
    GRID_BAR();
    if (blockIdx.x == 0 && F.tid == 0 && __hip_atomic_load(F.ctl + CW_CODE + 8, RLX_AGENT) != 0u) ((float*)ptab(F.lds, I_OUT))[0] = __builtin_nanf("");
#endif
#undef GRID_BAR
}

extern "C" void kernel_launch(void* const* d_in, const int* in_sizes, int n_in, void* d_out, int out_size, void* d_ws, size_t ws_size, hipStream_t stream) {
    static int grid = 0;
    if (grid == 0) {
        if (n_in != 22 || in_sizes[0] != M * D || out_size != M * D || ws_size < WS_END) { fprintf(stderr, "kernel_launch: unexpected shapes/workspace (n_in %d, in0 %d, out %d, ws %zu < %zu)\n", n_in, n_in > 0 ? in_sizes[0] : -1, out_size, ws_size, (size_t)WS_END); grid = -1; return; }
        int dev = 0, cus = 0, per_cu = 0;
        if (hipGetDevice(&dev) != hipSuccess || hipDeviceGetAttribute(&cus, hipDeviceAttributeMultiprocessorCount, dev) != hipSuccess) { grid = -1; return; }
        if (hipFuncSetAttribute((const void*)mk_fwd, hipFuncAttributeMaxDynamicSharedMemorySize, LDS_BYTES) != hipSuccess) { fprintf(stderr, "kernel_launch: hipFuncSetAttribute failed\n"); grid = -1; return; }
        if (hipOccupancyMaxActiveBlocksPerMultiprocessor(&per_cu, (const void*)mk_fwd, NTHR, LDS_BYTES) != hipSuccess || per_cu < 1) { fprintf(stderr, "kernel_launch: occupancy query says %d\n", per_cu); }
        (void)hipGetLastError();
        grid = cus;
    }
    if (grid < 0) return;
    if (hipMemsetAsync((char*)d_ws + WS_CTL, 0, CTL_ZERO_BYTES, stream) != hipSuccess) { fprintf(stderr, "kernel_launch: memset failed\n"); return; }
    Args a{};
    for (int i = 0; i < 22; ++i) a.in[i] = (const float*)d_in[i];
    a.out = (float*)d_out; a.ws = (unsigned char*)d_ws;
    hipLaunchKernelGGL(mk_fwd, dim3(grid), dim3(NTHR), LDS_BYTES, stream, a);
    const hipError_t le = hipPeekAtLastError();
    if (le != hipSuccess) fprintf(stderr, "kernel_launch: launch failed: %s\n", hipGetErrorName(le));
}
```

```cpp
#ifndef REP_P0
#define REP_P0 1
#endif
#ifndef REP_P1
#define REP_P1 1
#endif
#ifndef REP_R1
#define REP_R1 1
#endif
#ifndef REP_R2
#define REP_R2 1
#endif
#ifndef REP_R3
#define REP_R3 1
#endif
#ifndef REP_P2
#define REP_P2 1
#endif
#ifndef REP_P3
#define REP_P3 1
#endif
#ifndef REP_P4
#define REP_P4 1
#endif
#ifndef REP_P5
#define REP_P5 1
#endif
#ifndef REP_P0B
#define REP_P0B 1
#endif
#ifndef REP_P1B
#define REP_P1B 1
#endif
#ifndef REP_P3B
#define REP_P3B 1
#endif
#ifndef REP_P4A
#define REP_P4A 1
#endif
#ifndef REP_P5B
#define REP_P5B 1
#endif
#ifndef REP_EPI
#define REP_EPI 1
#endif
#ifndef STAGGER_WAYS
#define STAGGER_WAYS 8
#endif
#include <hip/hip_runtime.h>
template <int M> __device__ __forceinline__ float shx(float v) { return __int_as_float(__builtin_amdgcn_ds_swizzle(__float_as_int(v), (M << 10) | 0x1f)); }
template <int M> __device__ __forceinline__ int shxi(int v) { return __builtin_amdgcn_ds_swizzle(v, (M << 10) | 0x1f); }
__device__ __forceinline__ float sum32(float v) { auto rr = __builtin_amdgcn_permlane32_swap(__float_as_uint(v), __float_as_uint(v), false, false); return __uint_as_float(rr[0]) + __uint_as_float(rr[1]); }
__device__ __forceinline__ float max32(float v) { auto rr = __builtin_amdgcn_permlane32_swap(__float_as_uint(v), __float_as_uint(v), false, false); return fmaxf(__uint_as_float(rr[0]), __uint_as_float(rr[1])); }
__device__ __forceinline__ float shx32(float v, bool upper) { auto rr = __builtin_amdgcn_permlane32_swap(__float_as_uint(v), __float_as_uint(v), false, false); return __uint_as_float(upper ? rr[0] : rr[1]); }
__device__ __forceinline__ int bcastl(int v, int srclane) { return __builtin_amdgcn_ds_bpermute(srclane << 2, v); }
__device__ __forceinline__ float wsum64(float v) { v += shx<1>(v); v += shx<2>(v); v += shx<4>(v); v += shx<8>(v); v += shx<16>(v); return sum32(v); }
__device__ __forceinline__ float wmax64(float v) { v = fmaxf(v, shx<1>(v)); v = fmaxf(v, shx<2>(v)); v = fmaxf(v, shx<4>(v)); v = fmaxf(v, shx<8>(v)); v = fmaxf(v, shx<16>(v)); return max32(v); }
#ifndef YF8_FROM
#define YF8_FROM 0
#endif
#ifndef X16_FROM
#define X16_FROM 0
#endif
#include <hip/hip_runtime.h>
#include <cstdio>
#include <cstdint>
namespace pg8 {
#define PG8_LAS __attribute__((address_space(3)))
typedef unsigned short bf16_t;
typedef short bf16x8 __attribute__((ext_vector_type(8)));
typedef float f32x4 __attribute__((ext_vector_type(4)));
typedef unsigned u32x4 __attribute__((ext_vector_type(4)));
constexpr int BM = 256, BK = 64, HALF = 128, HTB = HALF * BK * 2  , STAGE_BYTES = 8 * HTB, NXCD = 8, WGM = 8;

__host__ __device__ __forceinline__ int lds_byte(int r, int c) { const int st = (r >> 4) * 2 + (c >> 5), rr = r & 15, cc = c & 31, ob = rr * 64 + cc * 2; return st * 1024 + (ob ^ (((ob >> 9) & 1) << 5)); }
__host__ __device__ __forceinline__ void stage_rc(int b, int& R, int& C) { const int st = b / 1024, sb = b % 1024, swz = sb ^ (((sb >> 9) & 1) << 5); R = (st >> 1) * 16 + swz / 64; C = (st & 1) * 32 + (swz % 64) / 2; }
__host__ __device__ __forceinline__ int perm32(int rho) { const int n = rho >> 4, i = rho & 15; return 8 * (i >> 2) + 4 * n + (i & 3); }

struct Unit { int pm, pn; };
struct Gemm { const bf16_t* A; const bf16_t* Bt; int M, N, K; };

struct StaticOrder {
    int nM, nN, nwg, G, c;
    __host__ __device__ void init(int M, int N, int G_, int c_) { nM = M / BM; nN = N / BM; nwg = nM * nN; G = G_; c = c_; }
    __host__ __device__ bool next(int i, Unit& u) const {
        const long L = (long)i * G + c; if (L >= nwg) return false;
        int wgid = (int)L; { const int q = nwg / NXCD, r = nwg % NXCD, xcd = wgid % NXCD, off = wgid / NXCD; wgid = (xcd < r ? xcd * (q + 1) : r * (q + 1) + (xcd - r) * q) + off; }
        const int nig = WGM * nN, gid = wgid / nig, fm = gid * WGM, gsz = (nM - fm) < WGM ? (nM - fm) : WGM;
        u.pm = fm + ((wgid % nig) % gsz); u.pn = (wgid % nig) / gsz; return true;
    }
    __device__ __forceinline__ void a_ready(const Unit&) const {}
    __device__ __forceinline__ void done(const Unit&) const {}
};

__device__ __forceinline__ unsigned cvt_pk_bf16(float lo, float hi) { unsigned r; asm volatile("v_cvt_pk_bf16_f32 %0, %1, %2" : "=v"(r) : "v"(lo), "v"(hi)); return r; }
typedef float f32x2 __attribute__((ext_vector_type(2)));

typedef int i32x4 __attribute__((ext_vector_type(4)));
__device__ __forceinline__ void dma4(const float* g, PG8_LAS unsigned char* l) { __builtin_amdgcn_global_load_lds((const unsigned*)g, (PG8_LAS unsigned*)l, 4, 0, 0); }
template <bool OUT_F8> struct EpiBf16T {
    static constexpr bool PERM = true, AFTER_DRAIN = false; static constexpr int NST = OUT_F8 ? 8 : 16;
    bf16_t* O; int ldc; const float* bias; int split_cols; size_t split_stride; PG8_LAS unsigned char* sp;
    const float* csc = nullptr; float cmul = 1.0f;
    __device__ __forceinline__ void prefetch(const Unit& u, int wid, int lane) const {
        if (bias && wid < 4) dma4(bias + u.pn * BM + wid * 64 + lane, sp + wid * 256);
        if (csc && wid >= 4) dma4(csc + u.pn * BM + (wid - 4) * 64 + lane, sp + 1024 + (wid - 4) * 256);
    }
    __device__ __forceinline__ void operator()(const f32x4 (&acc)[2][2][4][2], const Unit& u, int wr, int wc, int fr, int fq) const {
        const int row0 = u.pm * BM + wr * 64 + fr; int colt = u.pn * BM; bf16_t* base = O;
        if (split_cols) { const int t = colt / split_cols; base += (size_t)t * split_stride; colt -= t * split_cols; }
        const int col0 = colt + wc * 32 + 8 * fq;
        f32x4 bv[2][2];
#pragma unroll
        for (int bj = 0; bj < 2; ++bj)
#pragma unroll
            for (int n = 0; n < 2; ++n) bv[bj][n] = bias ? *(const PG8_LAS f32x4*)(sp + 4 * (bj * HALF + wc * 32 + 8 * fq + 4 * n)) : (f32x4){0.f, 0.f, 0.f, 0.f};
        f32x4 cv[2][2];
#pragma unroll
        for (int bj = 0; bj < 2; ++bj)
#pragma unroll
            for (int n = 0; n < 2; ++n) cv[bj][n] = csc ? *(const PG8_LAS f32x4*)(sp + 1024 + 4 * (bj * HALF + wc * 32 + 8 * fq + 4 * n)) * cmul : (f32x4){1.f, 1.f, 1.f, 1.f};
#pragma unroll
        for (int ai = 0; ai < 2; ++ai)
#pragma unroll
            for (int m = 0; m < 4; ++m) { bf16_t* rowp = base + (size_t)(row0 + ai * HALF + m * 16) * ldc + col0;
                if constexpr (OUT_F8) { unsigned w[4];
#pragma unroll
                    for (int bj = 0; bj < 2; ++bj) { f32x4 v0 = acc[ai][bj][m][0] * cv[bj][0] + bv[bj][0], v1 = acc[ai][bj][m][1] * cv[bj][1] + bv[bj][1]; unsigned w0 = 0u, w1 = 0u;
#pragma unroll
                        for (int q = 0; q < 4; ++q) { v0[q] = __builtin_amdgcn_fmed3f(v0[q], -448.0f, 448.0f); v1[q] = __builtin_amdgcn_fmed3f(v1[q], -448.0f, 448.0f); }
                        w0 = __builtin_amdgcn_cvt_pk_fp8_f32(v0[0], v0[1], w0, false); w0 = __builtin_amdgcn_cvt_pk_fp8_f32(v0[2], v0[3], w0, true);
                        w1 = __builtin_amdgcn_cvt_pk_fp8_f32(v1[0], v1[1], w1, false); w1 = __builtin_amdgcn_cvt_pk_fp8_f32(v1[2], v1[3], w1, true);
                        w[2 * bj] = w0; w[2 * bj + 1] = w1; }
                    *(u32x4*)((unsigned char*)base + (size_t)(row0 + ai * HALF + m * 16) * ldc + colt + 64 * wc + 16 * fq) = (u32x4){w[0], w[1], w[2], w[3]}; }
                else {
#pragma unroll
                    for (int bj = 0; bj < 2; ++bj) { const f32x4 v0 = acc[ai][bj][m][0] * cv[bj][0] + bv[bj][0], v1 = acc[ai][bj][m][1] * cv[bj][1] + bv[bj][1];
                        u32x4 w; w.x = cvt_pk_bf16(v0[0], v0[1]); w.y = cvt_pk_bf16(v0[2], v0[3]); w.z = cvt_pk_bf16(v1[0], v1[1]); w.w = cvt_pk_bf16(v1[2], v1[3]);
                        *(u32x4*)(rowp + bj * HALF) = w; } } }
    }
};
typedef EpiBf16T<false> EpiBf16;
struct EpiNullI8 {
    static constexpr bool PERM = true, AFTER_DRAIN = false; static constexpr int NST = 0;
    __device__ __forceinline__ void prefetch(const Unit&, int, int) const {}
    __device__ __forceinline__ void operator()(const i32x4 (&acc)[2][2][4][2], const Unit&, int, int, int, int) const {
#pragma unroll
        for (int a = 0; a < 2; ++a)
#pragma unroll
            for (int b = 0; b < 2; ++b)
#pragma unroll
                for (int m = 0; m < 4; ++m)
#pragma unroll
                    for (int n = 0; n < 2; ++n) asm volatile("" :: "v"(acc[a][b][m][n]));
    }
};
struct EpiI8Bf16 {
    static constexpr bool PERM = true, AFTER_DRAIN = false; static constexpr int NST = 16;
    bf16_t* O; int ldc; const float* rsc; const float* csc; PG8_LAS unsigned char* sp;
    __device__ __forceinline__ void prefetch(const Unit& u, int wid, int lane) const {
        if (wid < 4) dma4(rsc + u.pm * BM + wid * 64 + lane, sp + wid * 256);
        else dma4(csc + u.pn * BM + (wid - 4) * 64 + lane, sp + 1024 + (wid - 4) * 256);
    }
    __device__ __forceinline__ void operator()(const i32x4 (&acc)[2][2][4][2], const Unit& u, int wr, int wc, int fr, int fq) const {
        const int row0 = u.pm * BM + wr * 64 + fr, col0 = u.pn * BM + wc * 32 + 8 * fq;
        const PG8_LAS float* spf = (const PG8_LAS float*)sp;
        f32x4 cv[2][2];
#pragma unroll
        for (int bj = 0; bj < 2; ++bj)
#pragma unroll
            for (int n = 0; n < 2; ++n) cv[bj][n] = *(const PG8_LAS f32x4*)(spf + 256 + bj * HALF + wc * 32 + 8 * fq + 4 * n);
#pragma unroll
        for (int ai = 0; ai < 2; ++ai)
#pragma unroll
            for (int m = 0; m < 4; ++m) { const int row = row0 + ai * HALF + m * 16; const float rs = spf[ai * HALF + wr * 64 + m * 16 + fr]; bf16_t* rowp = O + (size_t)row * ldc + col0;
#pragma unroll
                for (int bj = 0; bj < 2; ++bj) { float v[8];
#pragma unroll
                    for (int n = 0; n < 2; ++n)
#pragma unroll
                        for (int q = 0; q < 4; ++q) v[4 * n + q] = (float)acc[ai][bj][m][n][q] * (rs * cv[bj][n][q]);
                    u32x4 w; w.x = cvt_pk_bf16(v[0], v[1]); w.y = cvt_pk_bf16(v[2], v[3]); w.z = cvt_pk_bf16(v[4], v[5]); w.w = cvt_pk_bf16(v[6], v[7]);
                    *(u32x4*)(rowp + bj * HALF) = w; } }
    }
};
__device__ __forceinline__ float swiglu_c(float g, float l) {
    g = fminf(g, 7.0f); l = fminf(fmaxf(l, -7.0f), 7.0f);
    const float s = __builtin_amdgcn_rcpf(1.0f + __builtin_amdgcn_exp2f(g * (-1.702f * 1.4426950408889634f)));
    return g * s * (l + 1.0f);
}
typedef float f32x2e __attribute__((ext_vector_type(2)));
__device__ __forceinline__ f32x2e swiglu_pk(f32x2e g, f32x2e l) {
    g.x = fminf(g.x, 7.0f); g.y = fminf(g.y, 7.0f);
    l.x = __builtin_amdgcn_fmed3f(l.x, -7.0f, 7.0f); l.y = __builtin_amdgcn_fmed3f(l.y, -7.0f, 7.0f);
    const f32x2e z = g * (-1.702f * 1.4426950408889634f);
    f32x2e d; d.x = __builtin_amdgcn_exp2f(z.x); d.y = __builtin_amdgcn_exp2f(z.y);
    d = d + 1.0f;
    f32x2e s; s.x = __builtin_amdgcn_rcpf(d.x); s.y = __builtin_amdgcn_rcpf(d.y);
    return (g * s) * (l + 1.0f);
}
typedef unsigned pg_u32x2 __attribute__((ext_vector_type(2)));
constexpr float ACT_F8_SCALE = 4.0f;
template <bool ACT_F8> struct EpiMoeUpT {
    static constexpr bool PERM = true, AFTER_DRAIN = false; static constexpr int NST = 8;
    bf16_t* O; const float* bias; const float* rsc; const float* csc; PG8_LAS unsigned char* sp;
    __device__ __forceinline__ void prefetch(const Unit& u, int wid, int lane) const {
        const int e = u.pn >> 3, pnl = u.pn & 7;
        if (wid < 4) dma4(rsc + u.pm * BM + wid * 64 + lane, sp + wid * 256);
        else if (wid < 6) { const float* b = bias + (size_t)e * 2048 + pnl * HALF + (wid - 4) * 64 + lane; dma4(b, sp + 1024 + (wid - 4) * 256); dma4(b + 1024, sp + 1536 + (wid - 4) * 256); }
        else { const float* c = csc + (size_t)e * 2048 + pnl * 256 + (wid - 6) * 64 + lane; dma4(c, sp + 2048 + (wid - 6) * 256); dma4(c + HALF, sp + 2560 + (wid - 6) * 256); }
    }
    __device__ __forceinline__ void operator()(const i32x4 (&acc)[2][2][4][2], const Unit& u, int wr, int wc, int fr, int fq) const {
        const int pnl = u.pn & 7;
        const int row0 = u.pm * BM + wr * 64 + fr, cg0 = pnl * HALF + wc * 32 + 8 * fq;
        const PG8_LAS float* spf = (const PG8_LAS float*)sp; const int cl = wc * 32 + 8 * fq;
        f32x4 bgv[2], blv[2], sgv[2], slv[2];
#pragma unroll
        for (int n = 0; n < 2; ++n) { bgv[n] = *(const PG8_LAS f32x4*)(spf + 256 + cl + 4 * n); blv[n] = *(const PG8_LAS f32x4*)(spf + 384 + cl + 4 * n); sgv[n] = *(const PG8_LAS f32x4*)(spf + 512 + cl + 4 * n); slv[n] = *(const PG8_LAS f32x4*)(spf + 640 + cl + 4 * n); }
#pragma unroll
        for (int ai = 0; ai < 2; ++ai)
#pragma unroll
            for (int m = 0; m < 4; ++m) { const int row = row0 + ai * HALF + m * 16; bf16_t* rowp = O + (size_t)row * 1024 + cg0; const float rs = spf[ai * HALF + wr * 64 + m * 16 + fr];
                float a[8];
#pragma unroll
                for (int n = 0; n < 2; ++n) {
#pragma unroll
                    for (int q = 0; q < 4; q += 2) {
                        const f32x2e gi = (f32x2e){(float)acc[ai][0][m][n][q], (float)acc[ai][0][m][n][q + 1]}, li = (f32x2e){(float)acc[ai][1][m][n][q], (float)acc[ai][1][m][n][q + 1]};
                        const f32x2e sg2 = (f32x2e){sgv[n][q], sgv[n][q + 1]} * rs, sl2 = (f32x2e){slv[n][q], slv[n][q + 1]} * rs;
                        const f32x2e r = swiglu_pk(gi * sg2 + (f32x2e){bgv[n][q], bgv[n][q + 1]}, li * sl2 + (f32x2e){blv[n][q], blv[n][q + 1]});
                        a[4 * n + q] = r.x; a[4 * n + q + 1] = r.y; } }
                if constexpr (ACT_F8) { unsigned w0 = 0u, w1 = 0u;
                    w0 = __builtin_amdgcn_cvt_pk_fp8_f32(a[0] * ACT_F8_SCALE, a[1] * ACT_F8_SCALE, w0, false); w0 = __builtin_amdgcn_cvt_pk_fp8_f32(a[2] * ACT_F8_SCALE, a[3] * ACT_F8_SCALE, w0, true);
                    w1 = __builtin_amdgcn_cvt_pk_fp8_f32(a[4] * ACT_F8_SCALE, a[5] * ACT_F8_SCALE, w1, false); w1 = __builtin_amdgcn_cvt_pk_fp8_f32(a[6] * ACT_F8_SCALE, a[7] * ACT_F8_SCALE, w1, true);
                    *(pg_u32x2*)((unsigned char*)O + (size_t)row * 1024 + cg0) = (pg_u32x2){w0, w1}; }
                else { u32x4 w; w.x = cvt_pk_bf16(a[0], a[1]); w.y = cvt_pk_bf16(a[2], a[3]); w.z = cvt_pk_bf16(a[4], a[5]); w.w = cvt_pk_bf16(a[6], a[7]);
                    *(u32x4*)rowp = w; } }
    }
};
typedef EpiMoeUpT<false> EpiMoeUp;
struct EpiMoeUpNoLoad {
    static constexpr bool PERM = true, AFTER_DRAIN = false; static constexpr int NST = 8;
    __device__ __forceinline__ void prefetch(const Unit&, int, int) const {}
    bf16_t* O; float k0, k1;
    __device__ __forceinline__ void operator()(const i32x4 (&acc)[2][2][4][2], const Unit& u, int wr, int wc, int fr, int fq) const {
        const int pnl = u.pn & 7;
        const int row0 = u.pm * BM + wr * 64 + fr, cg0 = pnl * HALF + wc * 32 + 8 * fq;
#pragma unroll
        for (int ai = 0; ai < 2; ++ai)
#pragma unroll
            for (int m = 0; m < 4; ++m) { const int row = row0 + ai * HALF + m * 16; bf16_t* rowp = O + (size_t)row * 1024 + cg0;
                float a[8];
#pragma unroll
                for (int n = 0; n < 2; ++n) {
#pragma unroll
                    for (int q = 0; q < 4; ++q) { const float g = (float)acc[ai][0][m][n][q] * k0 + k1, l = (float)acc[ai][1][m][n][q] * k0 + k1;
                        a[4 * n + q] = swiglu_c(g, l); } }
                u32x4 w; w.x = cvt_pk_bf16(a[0], a[1]); w.y = cvt_pk_bf16(a[2], a[3]); w.z = cvt_pk_bf16(a[4], a[5]); w.w = cvt_pk_bf16(a[6], a[7]);
                *(u32x4*)rowp = w; }
    }
};
struct EpiMoeUpNoStore {
    static constexpr bool PERM = true, AFTER_DRAIN = false; static constexpr int NST = 8;
    __device__ __forceinline__ void prefetch(const Unit&, int, int) const {}
    bf16_t* O; float k0, k1;
    __device__ __forceinline__ void operator()(const i32x4 (&acc)[2][2][4][2], const Unit& u, int wr, int wc, int fr, int fq) const {
        const int pnl = u.pn & 7;
        const int row0 = u.pm * BM + wr * 64 + fr, cg0 = pnl * HALF + wc * 32 + 8 * fq;
#pragma unroll
        for (int ai = 0; ai < 2; ++ai)
#pragma unroll
            for (int m = 0; m < 4; ++m) { const int row = row0 + ai * HALF + m * 16; bf16_t* rowp = O + (size_t)row * 1024 + cg0;
                float a[8];
#pragma unroll
                for (int n = 0; n < 2; ++n) {
#pragma unroll
                    for (int q = 0; q < 4; ++q) { const float g = (float)acc[ai][0][m][n][q] * k0 + k1, l = (float)acc[ai][1][m][n][q] * k0 + k1;
                        a[4 * n + q] = swiglu_c(g, l); } }
                u32x4 w; w.x = cvt_pk_bf16(a[0], a[1]); w.y = cvt_pk_bf16(a[2], a[3]); w.z = cvt_pk_bf16(a[4], a[5]); w.w = cvt_pk_bf16(a[6], a[7]);
                if (ai == 0 && m == 0) *(u32x4*)rowp = w; else asm volatile("" :: "v"(w)); }
    }
};
template <int SH> struct MoeOrder {
    const PG8_LAS int* ts; int G, c, total; int tsv;
    __device__ __forceinline__ bool next(int i, Unit& u) const {
        const int L = i * G + c; if (L >= total) return false;
        const int pm = L >> SH, pnl = L & ((1 << SH) - 1);
        const unsigned long long mk = __builtin_amdgcn_ballot_w64(pm >= tsv);
        const int e = __builtin_popcount((unsigned)mk & 0xfffffffeu);
        u.pm = pm; u.pn = (e << SH) + pnl; return true;
    }
    __device__ __forceinline__ void a_ready(const Unit&) const {}
    __device__ __forceinline__ void done(const Unit&) const {}
};
typedef int i32x4 __attribute__((ext_vector_type(4)));
template <bool I8> struct AccSel { typedef f32x4 T; };
template <> struct AccSel<true> { typedef i32x4 T; };
template <bool I8> __device__ __forceinline__ typename AccSel<I8>::T mma16(bf16x8 b, bf16x8 a, typename AccSel<I8>::T c) {
    if constexpr (I8) return __builtin_amdgcn_mfma_i32_16x16x64_i8(__builtin_bit_cast(i32x4, b), __builtin_bit_cast(i32x4, a), c, 0, 0, 0);
    else return __builtin_amdgcn_mfma_f32_16x16x32_bf16(b, a, c, 0, 0, 0);
}
typedef int i32x8 __attribute__((ext_vector_type(8)));
__device__ __forceinline__ f32x4 mma_f8(bf16x8 b0, bf16x8 b1, bf16x8 a0, bf16x8 a1, f32x4 c) {
    const i32x4 bl = __builtin_bit_cast(i32x4, b0), bh = __builtin_bit_cast(i32x4, b1), al = __builtin_bit_cast(i32x4, a0), ah = __builtin_bit_cast(i32x4, a1);
    const i32x8 bb = (i32x8){bl[0], bl[1], bl[2], bl[3], bh[0], bh[1], bh[2], bh[3]}, aa = (i32x8){al[0], al[1], al[2], al[3], ah[0], ah[1], ah[2], ah[3]};
    return __builtin_amdgcn_mfma_scale_f32_16x16x128_f8f6f4(bb, aa, c, 0, 0, 0, 0, 0, 0);
}
template <class Epi, class Sched, bool ALIGN_EPI = false, bool SP2 = false, bool I8 = false, bool GATHER = false, bool F8 = false>
__device__ __forceinline__ void gemm_phase(PG8_LAS unsigned char* lds, const Gemm g, const Sched& S, const Epi& E, const int* rowmap = nullptr) {
    int tid_ = threadIdx.x; asm volatile("" : "+v"(tid_));
    const int tid = tid_, wid = __builtin_amdgcn_readfirstlane(tid >> 6), lane = tid & 63, wr = wid >> 2, wc = wid & 3, fr = lane & 15, fq = lane >> 4;
    const int K = g.K, nt = K / BK;
    unsigned voffA, voffB;
    { int R, C; stage_rc(tid * 16, R, C); const int Rb = Epi::PERM ? ((R & ~31) + perm32(R & 31)) : R;
        voffA = (unsigned)(R * K + C) * 2u; voffB = (unsigned)(Rb * K + C) * 2u; }
    const size_t pstep = (size_t)128 * K;
    unsigned offA[2][2];
    constexpr int RM_OFF = STAGE_BYTES + 1024 + 3072;
    const size_t kstep = (size_t)(BK * 2);
    const size_t hstep = (size_t)HALF * K * 2;
    const size_t tstep = 2 * hstep;
    const unsigned ldsw = (unsigned)wid * 1024u;
    const int aoff = lds_byte(wr * 64 + fr, fq * 8), boff = lds_byte(wc * 32 + fr, fq * 8);
#define PG8_SA(b, h) (((b) * 2 + (h)) * HTB)
#define PG8_SB(b, h) ((4 + (b) * 2 + (h)) * HTB)
#define PG8_STAGE(bufoff, gbase, voff) do { _Pragma("unroll") for (int _i = 0; _i < 2; ++_i) \
        __builtin_amdgcn_global_load_lds((const unsigned*)((const char*)(gbase) + (_i ? pstep : (size_t)0) + (voff)), (PG8_LAS unsigned*)(lds + (bufoff) + ldsw + _i * 8192), 16, 0, 0); } while (0)
#define PG8_STAGE_A(bufoff, gbase, h, nextu) do { if constexpr (GATHER) { _Pragma("unroll") for (int _i = 0; _i < 2; ++_i) \
        __builtin_amdgcn_global_load_lds((const unsigned*)((const char*)(gbase) + offA[h][_i]), (PG8_LAS unsigned*)(lds + (bufoff) + ldsw + _i * 8192), 16, 0, 0); } \
    else { PG8_STAGE(bufoff, (gbase) + (h) * hstep, voffA); } } while (0)
#define PG8_GOFF(SRCEXPR) do { _Pragma("unroll") for (int _h = 0; _h < 2; ++_h) _Pragma("unroll") for (int _i = 0; _i < 2; ++_i) { int R_, C_; stage_rc(tid * 16 + _i * 8192, R_, C_); \
        const int ri_ = _h * HALF + R_; offA[_h][_i] = (unsigned)(SRCEXPR) * (unsigned)(K * 2) + (unsigned)(C_ * 2); } } while (0)
#define PG8_LDA(dst, b, h) do { _Pragma("unroll") for (int m = 0; m < 4; ++m) _Pragma("unroll") for (int k = 0; k < 2; ++k) dst[m][k] = *(const PG8_LAS bf16x8*)(lds + PG8_SA(b, h) + aoff + m * 2048 + k * 1024); } while (0)
#define PG8_LDB(dst, b, h) do { _Pragma("unroll") for (int n = 0; n < 2; ++n) _Pragma("unroll") for (int k = 0; k < 2; ++k) dst[n][k] = *(const PG8_LAS bf16x8*)(lds + PG8_SB(b, h) + boff + n * 2048 + k * 1024); } while (0)
#define PG8_MMA(ai, bj, At, Bt) do { __builtin_amdgcn_s_setprio(1); _Pragma("unroll") for (int m = 0; m < 4; ++m) _Pragma("unroll") for (int n = 0; n < 2; ++n) { \
        if constexpr (F8) { const f32x4 c_ = n ? __builtin_shufflevector(acc8[ai][bj][m], acc8[ai][bj][m], 4, 5, 6, 7) : __builtin_shufflevector(acc8[ai][bj][m], acc8[ai][bj][m], 0, 1, 2, 3); \
            const f32x4 d_ = mma_f8(Bt[n][0], Bt[n][1], At[m][0], At[m][1], c_); \
            if (n) { acc8[ai][bj][m][4] = d_[0]; acc8[ai][bj][m][5] = d_[1]; acc8[ai][bj][m][6] = d_[2]; acc8[ai][bj][m][7] = d_[3]; } else { acc8[ai][bj][m][0] = d_[0]; acc8[ai][bj][m][1] = d_[1]; acc8[ai][bj][m][2] = d_[2]; acc8[ai][bj][m][3] = d_[3]; } } \
        else { _Pragma("unroll") for (int k = 0; k < 2; ++k) acc[ai][bj][m][n] = mma16<I8>(Bt[n][k], At[m][k], acc[ai][bj][m][n]); } } __builtin_amdgcn_s_setprio(0); } while (0)
#define PG8_WAIT_V(n) asm volatile("s_waitcnt vmcnt(" #n ")" ::: "memory")
#define PG8_WAIT_L(n) asm volatile("s_waitcnt lgkmcnt(" #n ")" ::: "memory")
#define PG8_WAIT_VR(fl) do { if constexpr (F8) { PG8_WAIT_V(8); } else asm volatile("s_waitcnt vmcnt(%1)\n\tv_cmp_ne_u32_e32 vcc, 0, %0\n\ts_cbranch_vccnz 1f\n\ts_waitcnt vmcnt(8)\n1:" :: "v"(fl), "n"(8 + Epi::NST) : "vcc", "memory"); } while (0)
#define PG8_BAR __builtin_amdgcn_s_barrier()
#define PG8_SCHED __builtin_amdgcn_sched_barrier(0)
    Unit cur, nxt; int ui = 0;
    if (!S.next(0, cur)) return;
    typedef typename AccSel<I8>::T acc4; acc4 acc[2][2][4][2];
    typedef float f32x8 __attribute__((ext_vector_type(8))); f32x8 acc8[2][2][4];
#pragma unroll
    for (int a = 0; a < 2; ++a)
#pragma unroll
        for (int b = 0; b < 2; ++b)
#pragma unroll
            for (int m = 0; m < 4; ++m)
#pragma unroll
                for (int n = 0; n < 2; ++n) { acc[a][b][m][n] = (acc4){0, 0, 0, 0}; if constexpr (F8) acc8[a][b][m] = (f32x8){0.f, 0.f, 0.f, 0.f, 0.f, 0.f, 0.f, 0.f}; }
    bf16x8 At[4][2], B0[2][2], B1[2][2];
    const char* cA = GATHER ? (const char*)g.A : (const char*)g.A + (size_t)cur.pm * tstep; const char* cB = (const char*)g.Bt + (size_t)cur.pn * tstep;
    if constexpr (GATHER) { PG8_GOFF(rowmap[cur.pm * BM + ri_]); }
    S.a_ready(cur);
    if constexpr (SP2) {
        PG8_STAGE(PG8_SB(0, 0), cB, voffB); PG8_STAGE(PG8_SB(0, 1), cB + hstep, voffB); PG8_STAGE_A(PG8_SA(0, 0), cA, 0, false); PG8_STAGE_A(PG8_SA(0, 1), cA, 1, false);
        if (wr == 1) PG8_BAR;
        PG8_WAIT_V(2); PG8_BAR;
        PG8_STAGE(PG8_SB(1, 0), cB + kstep, voffB); PG8_STAGE_A(PG8_SA(1, 0), cA + kstep, 0, false); PG8_STAGE(PG8_SB(1, 1), cB + hstep + kstep, voffB);
        PG8_STAGE_A(PG8_SA(1, 1), cA + kstep, 1, false);
        PG8_WAIT_V(8); PG8_BAR;
    } else {
        PG8_STAGE(PG8_SB(0, 0), cB, voffB); PG8_STAGE_A(PG8_SA(0, 0), cA, 0, false); PG8_STAGE(PG8_SB(0, 1), cB + hstep, voffB); PG8_STAGE_A(PG8_SA(0, 1), cA, 1, false);
        if (wr == 1) PG8_BAR;
        PG8_WAIT_V(4); PG8_BAR;
        PG8_STAGE(PG8_SB(1, 0), cB + kstep, voffB); PG8_STAGE_A(PG8_SA(1, 0), cA + kstep, 0, false); PG8_STAGE(PG8_SB(1, 1), cB + hstep + kstep, voffB);
        PG8_WAIT_V(6); PG8_BAR;
    }
    for (;;) {
        const bool has_next = S.next(ui + 1, nxt);
        if constexpr (GATHER) { if (has_next && wid < 4) __builtin_amdgcn_global_load_lds((const unsigned*)(rowmap + nxt.pm * BM + wid * 64 + lane), (PG8_LAS unsigned*)(lds + RM_OFF + wid * 256), 4, 0, 0); }
        const char* nA = (has_next && !GATHER) ? (const char*)g.A + (size_t)nxt.pm * tstep : cA; const char* nB = has_next ? (const char*)g.Bt + (size_t)nxt.pn * tstep : cB;
        for (int t = 0; t < nt; t += 2) {
            const bool last = (t == nt - 2);
            asm volatile("" : "+v"(voffA), "+v"(voffB));
            const char* a1 = cA + (size_t)(t + 1) * kstep;
            const char* a2 = last ? nA : cA + (size_t)(t + 2) * kstep; const char* b2 = last ? nB : cB + (size_t)(t + 2) * kstep;
            const char* a3 = a2 + kstep; const char* b3 = b2 + kstep;
            if (last && has_next) S.a_ready(nxt);
            if (last) { int ln_ = lane; asm volatile("" : "+v"(ln_)); E.prefetch(cur, wid, ln_); }
            if constexpr (SP2) {
            const int fl = (t == 0 && ui > 0) ? 1 : 0;
            PG8_LDB(B0, 0, 0); PG8_LDB(B1, 0, 1); PG8_SCHED; PG8_LDA(At, 0, 0);
            if constexpr (GATHER) { if (last && has_next) { const PG8_LAS int* rm = (const PG8_LAS int*)(lds + RM_OFF); PG8_GOFF(rm[ri_]); } }
            PG8_WAIT_VR(fl); PG8_WAIT_L(0); PG8_BAR; PG8_MMA(0, 0, At, B0); PG8_MMA(0, 1, At, B1); PG8_BAR; PG8_SCHED;
            PG8_LDA(At, 0, 1); PG8_STAGE(PG8_SB(0, 0), b2, voffB); PG8_STAGE(PG8_SB(0, 1), b2 + hstep, voffB); PG8_STAGE_A(PG8_SA(0, 0), a2, 0, last);
            PG8_WAIT_VR(fl); PG8_WAIT_L(0); PG8_BAR; PG8_MMA(1, 0, At, B0); PG8_MMA(1, 1, At, B1); PG8_BAR; PG8_SCHED;
            PG8_LDB(B0, 1, 0); PG8_LDB(B1, 1, 1); PG8_SCHED; PG8_LDA(At, 1, 0); PG8_STAGE_A(PG8_SA(0, 1), a2, 1, last);
            PG8_WAIT_VR(fl); PG8_WAIT_L(0); PG8_BAR; PG8_MMA(0, 0, At, B0); PG8_MMA(0, 1, At, B1); PG8_BAR; PG8_SCHED;
            PG8_LDA(At, 1, 1); PG8_STAGE(PG8_SB(1, 0), b3, voffB); PG8_STAGE(PG8_SB(1, 1), b3 + hstep, voffB); PG8_STAGE_A(PG8_SA(1, 0), a3, 0, last);
            PG8_WAIT_V(8); PG8_WAIT_L(0); PG8_BAR; PG8_MMA(1, 0, At, B0); PG8_MMA(1, 1, At, B1); PG8_BAR; PG8_SCHED;
            PG8_STAGE_A(PG8_SA(1, 1), a3, 1, last);
            } else {
            PG8_LDB(B0, 0, 0); PG8_SCHED; PG8_LDA(At, 0, 0); PG8_STAGE_A(PG8_SA(1, 1), a1, 1, false);
            if constexpr (GATHER) { if (last && has_next) { const PG8_LAS int* rm = (const PG8_LAS int*)(lds + RM_OFF); PG8_GOFF(rm[ri_]); } }
            PG8_WAIT_L(8); PG8_BAR; PG8_WAIT_L(0); PG8_MMA(0, 0, At, B0); PG8_BAR; PG8_SCHED;
            PG8_LDB(B1, 0, 1); PG8_STAGE(PG8_SB(0, 0), b2, voffB);
            PG8_BAR; PG8_WAIT_L(0); PG8_MMA(0, 1, At, B1); PG8_BAR;
            PG8_LDA(At, 0, 1); PG8_STAGE_A(PG8_SA(0, 0), a2, 0, last);
            PG8_BAR; PG8_WAIT_L(0); PG8_MMA(1, 0, At, B0); PG8_BAR; PG8_SCHED;
            PG8_STAGE(PG8_SB(0, 1), b2 + hstep, voffB);
            PG8_WAIT_V(6); PG8_BAR; PG8_MMA(1, 1, At, B1); PG8_BAR;
            PG8_LDB(B0, 1, 0); PG8_SCHED; PG8_LDA(At, 1, 0); PG8_STAGE_A(PG8_SA(0, 1), a2, 1, last);
            PG8_WAIT_L(8); PG8_BAR; PG8_WAIT_L(0); PG8_MMA(0, 0, At, B0); PG8_BAR; PG8_SCHED;
            PG8_LDB(B1, 1, 1); PG8_STAGE(PG8_SB(1, 0), b3, voffB);
            PG8_BAR; PG8_WAIT_L(0); PG8_MMA(0, 1, At, B1); PG8_BAR;
            PG8_LDA(At, 1, 1); PG8_STAGE_A(PG8_SA(1, 0), a3, 0, last);
            PG8_BAR; PG8_WAIT_L(0); PG8_MMA(1, 0, At, B0); PG8_BAR; PG8_SCHED;
            PG8_STAGE(PG8_SB(1, 1), b3 + hstep, voffB);
            PG8_WAIT_V(6); PG8_BAR; PG8_MMA(1, 1, At, B1); PG8_BAR;
            }
        }
        if constexpr (ALIGN_EPI) { if (wr == 0) PG8_BAR; }
        if constexpr (F8 && !I8) {
#pragma unroll
            for (int a_ = 0; a_ < 2; ++a_)
#pragma unroll
                for (int b_ = 0; b_ < 2; ++b_)
#pragma unroll
                    for (int m = 0; m < 4; ++m) { acc[a_][b_][m][0] = __builtin_shufflevector(acc8[a_][b_][m], acc8[a_][b_][m], 0, 1, 2, 3); acc[a_][b_][m][1] = __builtin_shufflevector(acc8[a_][b_][m], acc8[a_][b_][m], 4, 5, 6, 7); } }
        if constexpr (!Epi::AFTER_DRAIN) { int t2_ = threadIdx.x; asm volatile("" : "+v"(t2_)); E(acc, cur, wr, wc, t2_ & 15, (t2_ & 63) >> 4); S.done(cur); }
        if (!has_next) break;
#pragma unroll
        for (int a = 0; a < 2; ++a)
#pragma unroll
            for (int b = 0; b < 2; ++b)
#pragma unroll
                for (int m = 0; m < 4; ++m)
#pragma unroll
                    for (int n = 0; n < 2; ++n) { acc[a][b][m][n] = (acc4){0, 0, 0, 0}; if constexpr (F8) acc8[a][b][m] = (f32x8){0.f, 0.f, 0.f, 0.f, 0.f, 0.f, 0.f, 0.f}; }
        cur = nxt; cA = nA; cB = nB; ++ui;
        if constexpr (ALIGN_EPI) { if (wr == 1) PG8_BAR; }
    }
    PG8_WAIT_V(0);
    if constexpr (!ALIGN_EPI) { if (wr == 0) PG8_BAR; }
    PG8_BAR;
    if constexpr (Epi::AFTER_DRAIN) { E.fused(acc, cur, wr, wc, fr, fq, lds, wid, lane); S.done(cur); }
#undef PG8_SA
#undef PG8_SB
#undef PG8_STAGE
#undef PG8_STAGE_A
#undef PG8_GOFF
#undef PG8_LDA
#undef PG8_LDB
#undef PG8_MMA
#undef PG8_WAIT_V
#undef PG8_WAIT_L
#undef PG8_WAIT_VR
#undef PG8_BAR
#undef PG8_SCHED
}
}
#include <hip/hip_bf16.h>
#include <cmath>
namespace attn_body {
using bf16=__hip_bfloat16;
using bf16x8=__attribute__((ext_vector_type(8)))short;
using s16x4=__attribute__((ext_vector_type(4)))short;
using f32x16=__attribute__((ext_vector_type(16)))float;
using u32x4=__attribute__((ext_vector_type(4)))unsigned;
constexpr float OSCALE=32.0f;
constexpr int BATCH=8,NHEAD=8,NKVH=2,SEQ=8192,D=64,PQ=2816,PO=1024;
constexpr int NW=8,QBLK=32,QB=QBLK*NW,KVBLK=64,NQB=SEQ/QB;
constexpr int ATTN_UNIT_ROWS=QB;
__device__ __forceinline__ int crow(int r,int hi){return (r&3)+8*(r>>2)+4*hi;}
#define SBAR() __builtin_amdgcn_sched_barrier(0)
__device__ __forceinline__ void cmask(f32x16&p0,f32x16&p1,int jb,int qrel,int hi){
  const float NEG=-INFINITY; int kb=64*jb+4*hi;
  #pragma unroll
  for(int r=0;r<16;++r){int kv=kb+(r&3)+8*(r>>2); if(kv>qrel)p0[r]=NEG; if(kv+32>qrel)p1[r]=NEG;}
}

constexpr int NSLOT=3, SLOTB=8192;
constexpr int LDS_K=0, LDS_V=NSLOT*SLOTB, LDS_WS=2*NSLOT*SLOTB, LDS_OST=LDS_WS+NW*64*4, LDS_BYTES=LDS_OST+NW*4096;
constexpr float C2=0.125f*1.4426950408889634f;
__device__ __forceinline__ void glds16(const void*gsrc,unsigned lds_dst){unsigned keep;
  asm volatile("s_mov_b32 %0, m0\n\ts_mov_b32 m0, %2\n\ts_nop 0\n\tglobal_load_lds_dwordx4 %1, off\n\ts_mov_b32 m0, %0":"=&s"(keep):"v"(gsrc),"s"(lds_dst):"memory");}
__device__ __forceinline__ float max3f(float a,float b,float c){float r;asm("v_max3_f32 %0, %1, %2, %3":"=v"(r):"v"(a),"v"(b),"v"(c));return r;}
__device__ __forceinline__ float max2f(float a,float b){float r;asm("v_max_f32_e32 %0, %1, %2":"=v"(r):"v"(a),"v"(b));return r;}
__device__ __forceinline__ float fadd_s(float a,float b){float r;asm("v_add_f32_e32 %0, %1, %2":"=v"(r):"v"(a),"v"(b));return r;}
__device__ __forceinline__ float fsub_s(float a,float b){float r;asm("v_sub_f32_e32 %0, %1, %2":"=v"(r):"v"(a),"v"(b));return r;}
typedef float f32x2_t __attribute__((ext_vector_type(2))); typedef __bf16 bf16x2_t __attribute__((ext_vector_type(2)));
__device__ __forceinline__ unsigned cvtpk_s(float lo,float hi){f32x2_t v={lo,hi};bf16x2_t b=__builtin_convertvector(v,bf16x2_t);return __builtin_bit_cast(unsigned,b);}
#define WAIT_BAR(N) asm volatile("s_waitcnt vmcnt(" #N ") lgkmcnt(0)\n\ts_barrier":::"memory")

__device__ __forceinline__ void qkt(f32x16&p0,f32x16&p1,const char*Kslot,const bf16x8*qr,const f32x16&negm,int r32,int hi){
  const char*kb=Kslot+hi*1024+r32*16;
  #pragma unroll
  for(int d0=0;d0<4;++d0){
    const bf16x8 b0=*reinterpret_cast<const bf16x8*>(kb+d0*2048);
    const bf16x8 b1=*reinterpret_cast<const bf16x8*>(kb+d0*2048+512);
    if(d0==0){p0=__builtin_amdgcn_mfma_f32_32x32x16_bf16(b0,qr[0],negm,0,0,0);p1=__builtin_amdgcn_mfma_f32_32x32x16_bf16(b1,qr[0],negm,0,0,0);}
    else{p0=__builtin_amdgcn_mfma_f32_32x32x16_bf16(b0,qr[d0],p0,0,0,0);p1=__builtin_amdgcn_mfma_f32_32x32x16_bf16(b1,qr[d0],p1,0,0,0);}}
}
typedef __attribute__((address_space(3))) const char* lds_cptr;
typedef short v4i16_t __attribute__((ext_vector_type(4)));
__device__ __forceinline__ void kload8(bf16x8*kf,lds_cptr kp){
  kf[0]=*(const __attribute__((address_space(3))) bf16x8*)(kp);      kf[1]=*(const __attribute__((address_space(3))) bf16x8*)(kp+512);
  kf[2]=*(const __attribute__((address_space(3))) bf16x8*)(kp+2048); kf[3]=*(const __attribute__((address_space(3))) bf16x8*)(kp+2560);
  kf[4]=*(const __attribute__((address_space(3))) bf16x8*)(kp+4096); kf[5]=*(const __attribute__((address_space(3))) bf16x8*)(kp+4608);
  kf[6]=*(const __attribute__((address_space(3))) bf16x8*)(kp+6144); kf[7]=*(const __attribute__((address_space(3))) bf16x8*)(kp+6656);
}
__device__ __forceinline__ void kload2(bf16x8*kf,lds_cptr kp,int j){ kf[2*j]=*(const __attribute__((address_space(3))) bf16x8*)(kp+j*2048); kf[2*j+1]=*(const __attribute__((address_space(3))) bf16x8*)(kp+j*2048+512); }
__device__ __forceinline__ s16x4 vtr(lds_cptr p){ return __builtin_bit_cast(s16x4,__builtin_amdgcn_ds_read_tr16_b64_v4i16((__attribute__((address_space(3))) v4i16_t*)p)); }
__device__ __forceinline__ float rowmax(const f32x16&p0,const f32x16&p1){
  float a=max3f(p0[0],p0[1],p1[0]),b=max3f(p0[2],p0[3],p1[1]);a=max3f(a,p1[2],p1[3]);
  #pragma unroll
  for(int r=4;r<16;r+=4){a=max3f(a,p0[r],p0[r+1]);b=max3f(b,p0[r+2],p0[r+3]);a=max3f(a,p1[r],p1[r+1]);b=max3f(b,p1[r+2],p1[r+3]);}
  const float m=max2f(a,b);
  auto rr=__builtin_amdgcn_permlane32_swap(__float_as_uint(m),__float_as_uint(m),false,false);
  return max2f(__uint_as_float(rr[0]),__uint_as_float(rr[1]));
}
__device__ __forceinline__ void pv(f32x16*o,int vb,bf16x8 pa0,bf16x8 pa1,bf16x8 pa2,bf16x8 pa3){
  #pragma unroll
  for(int d0=0;d0<2;++d0){s16x4 lo[4],hi[4];
    #pragma unroll
    for(int ks=0;ks<4;++ks){
      asm volatile("ds_read_b64_tr_b16 %0,%1 offset:%c2":"=&v"(lo[ks]):"v"(vb),"i"(d0*4096+ks*1024):"memory");
      asm volatile("ds_read_b64_tr_b16 %0,%1 offset:%c2":"=&v"(hi[ks]):"v"(vb),"i"(d0*4096+ks*1024+512):"memory");}
    asm volatile("s_waitcnt lgkmcnt(0)":::"memory");SBAR();
    #define PK(k) (bf16x8){lo[k][0],lo[k][1],lo[k][2],lo[k][3],hi[k][0],hi[k][1],hi[k][2],hi[k][3]}
    o[d0]=__builtin_amdgcn_mfma_f32_32x32x16_bf16(pa0,PK(0),o[d0],0,0,0);
    o[d0]=__builtin_amdgcn_mfma_f32_32x32x16_bf16(pa1,PK(1),o[d0],0,0,0);
    o[d0]=__builtin_amdgcn_mfma_f32_32x32x16_bf16(pa2,PK(2),o[d0],0,0,0);
    o[d0]=__builtin_amdgcn_mfma_f32_32x32x16_bf16(pa3,PK(3),o[d0],0,0,0);
    #undef PK
  }
}

#ifndef ATTN_STORE16
#define ATTN_STORE16(p,v) (*(u32x4*)(p)=(v))
#endif
template<int THRL> __device__ __forceinline__ void attn_unit(int b,int h,int qb,const bf16*Q,const bf16*__restrict__ K,const bf16*__restrict__ V,bf16*O,char*shm,const float*qg,const float nref){
  int tid_=threadIdx.x; asm volatile("":"+v"(tid_)); const int tid=tid_,lane=tid&63,r32=lane&31,hi=lane>>5; const int wid=__builtin_amdgcn_readfirstlane(tid>>6);
  const long rowbase=(long)b*SEQ; const int q0=qb*QB;
  const bf16*Qw=Q+(rowbase+q0+wid*QBLK)*PQ+h*D;
  const bf16*Kh=K+rowbase*PQ+(h>>2)*D,*Vh=V+rowbase*PQ+(h>>2)*D;
  const unsigned lds0=(unsigned)(uintptr_t)shm;
  float*wsf=(float*)(shm+LDS_WS)+wid*64;
  const bf16*ksrc=Kh+(long)lane*PQ+wid*8;
  const bf16*vsrc=Vh+(long)(16*(wid&3)+(lane>>2))*PQ+(wid>>2)*32+(lane&3)*8;
  const unsigned kdst=lds0+LDS_K+wid*1024, vdst=lds0+LDS_V+wid*1024;
  #define DMA_K(t,slot) glds16(ksrc+(long)(t)*KVBLK*PQ,(unsigned)__builtin_amdgcn_readfirstlane(kdst+(slot)))
  #define DMA_V(t,slot) glds16(vsrc+(long)(t)*KVBLK*PQ,(unsigned)__builtin_amdgcn_readfirstlane(vdst+(slot)))
  const int vb0=(int)(lds0+LDS_V)+((lane>>4)&1)*32+(lane&3)*8+(4*hi+((lane&15)>>2))*64;
  const char*Kbase=shm+LDS_K; bf16x8 kf[8];
  const lds_cptr shm3=(lds_cptr)shm; const lds_cptr kp0=shm3+LDS_K+hi*1024+r32*16; const lds_cptr vp0=shm3+LDS_V+((lane>>4)&1)*32+(lane&3)*8+(4*hi+((lane&15)>>2))*64;
  constexpr int NT=SEQ/KVBLK;
  DMA_K(0,0);DMA_V(0,0);DMA_K(1,SLOTB);
  bf16x8 qr[4];
  #pragma unroll
  for(int d0=0;d0<4;++d0)qr[d0]=*reinterpret_cast<const bf16x8*>(&Qw[(long)r32*PQ+d0*16+hi*8]);
  {
    float y[4][8]; float ss=0.f;
    #pragma unroll
    for(int d0=0;d0<4;++d0){
      #pragma unroll
      for(int j=0;j<8;++j){ y[d0][j]=__uint_as_float(((unsigned)(unsigned short)qr[d0][j])<<16); ss+=y[d0][j]*y[d0][j]; } }
    { auto rr=__builtin_amdgcn_permlane32_swap(__float_as_uint(ss),__float_as_uint(ss),false,false); ss=__uint_as_float(rr[0])+__uint_as_float(rr[1]); }
    const float rs=__builtin_amdgcn_rsqf(ss*(1.f/64.f)+1e-6f);
    const int spos=q0+wid*QBLK+r32; const float rid=(float)(spos>>6),cid=(float)(spos&63);
    #pragma unroll
    for(int j=0;j<8;++j){ const float fr=__builtin_amdgcn_exp2f(-(float)(8*hi+j)*(13.287712379549449f/16.f));
      const float cr=__cosf(rid*fr),sr=__sinf(rid*fr),cc=__cosf(cid*fr),sc=__sinf(cid*fr);
      const float a1=y[0][j]*rs*qg[8*hi+j],a2=y[1][j]*rs*qg[16+8*hi+j],b1=y[2][j]*rs*qg[32+8*hi+j],b2=y[3][j]*rs*qg[48+8*hi+j];
      y[0][j]=(a1*cr-a2*sr)*C2; y[1][j]=(a2*cr+a1*sr)*C2; y[2][j]=(b1*cc-b2*sc)*C2; y[3][j]=(b2*cc+b1*sc)*C2; }
    #pragma unroll
    for(int d0=0;d0<4;++d0){ u32x4 w; w.x=cvtpk_s(y[d0][0],y[d0][1]); w.y=cvtpk_s(y[d0][2],y[d0][3]); w.z=cvtpk_s(y[d0][4],y[d0][5]); w.w=cvtpk_s(y[d0][6],y[d0][7]); qr[d0]=__builtin_bit_cast(bf16x8,w); }
  }
  float l_reg=0.f;f32x16 o[2];o[0]=f32x16{};o[1]=f32x16{};f32x16 negm; _Pragma("unroll") for(int r=0;r<16;++r)negm[r]=nref; asm volatile("":"+v"(negm));
  #define CMASK(P0,P1,t) do{}while(0)
  #define START(P0,P1) do{ _Pragma("unroll") for(int r=0;r<16;++r)P0[r]=__builtin_amdgcn_exp2f(P0[r]); }while(0)
  #define RESC() do{}while(0)
  f32x16 pA0,pA1,pB0,pB1;
  int sl_prev=0,sl_cur=0,sl_next=SLOTB;
  #define ROT() do{sl_prev=sl_cur;sl_cur=sl_next;sl_next=(sl_next==(NSLOT-1)*SLOTB)?0:sl_next+SLOTB;}while(0)
  DMA_K(2,2*SLOTB);
  WAIT_BAR(3);
  qkt(pA0,pA1,Kbase,qr,negm,r32,hi);asm volatile("s_nop 15\n\ts_nop 7":"+v"(pA0),"+v"(pA1));CMASK(pA0,pA1,0);
  START(pA0,pA1);
  _Pragma("unroll") for(int r=0;r<16;++r)pA1[r]=__builtin_amdgcn_exp2f(pA1[r]);
  WAIT_BAR(0);
  DMA_K(3,0);DMA_V(1,SLOTB);
  ROT();
  kload8(kf,kp0+sl_cur);
  WAIT_BAR(2);
  s16x4 vlo[8],vhi[8]; u32x4 pw0,pw1,pw2,pw3;
  #define PKW(P,B) cvtpk_s(P[B],P[B+1])
  #define PAF(k) __builtin_bit_cast(bf16x8,pw##k)
  #define VFR(i) (bf16x8){vlo[i][0],vlo[i][1],vlo[i][2],vlo[i][3],vhi[i][0],vhi[i][1],vhi[i][2],vhi[i][3]}
  #define PIN(x) asm volatile("":"+v"(x))
  #define MX3(a,b,c) __builtin_fmaxf(__builtin_fmaxf((a),(b)),(c))
  #define GAPA(MF,A0,A1,A2,A3,W0,W1,PW) do{ MF; sacc+=A0; sacc+=A1; sacc+=A2; sacc+=A3; PIN(sacc); W0; W1; PIN(PW); SBAR(); }while(0)
  #define EX(v) __builtin_amdgcn_exp2f(v)
  #define GAPB(MF,X,B) do{ MF; X[B]=EX(X[B]); X[B+1]=EX(X[B+1]); X[B+2]=EX(X[B+2]); X[B+3]=EX(X[B+3]); PIN(X); SBAR(); }while(0)
  #define VRD(i) do{ vlo[i]=vtr(vp_+(((i)>>2)*4096+((i)&3)*1024)); vhi[i]=vtr(vp_+(((i)>>2)*4096+((i)&3)*1024+512)); }while(0)
  #define KRD(G,j) do{ if(G){ kload2(kf,kp0+sl_next,j); SBAR(); } }while(0)
  #define STEP(C0,C1,P0,P1,t,GK,GV,GL) do{ SBAR(); \
    const lds_cptr vp_=vp0+sl_prev; \
    VRD(0); SBAR(); float sacc=(P0[0]+P0[1]); \
    GAPA(C0=__builtin_amdgcn_mfma_f32_32x32x16_bf16(kf[0],qr[0],negm,0,0,0), P0[2],P0[3],P0[4],P0[5],     pw0[0]=PKW(P0,0), pw0[1]=PKW(P0,2), pw0); \
    VRD(4); SBAR(); GAPA(C1=__builtin_amdgcn_mfma_f32_32x32x16_bf16(kf[1],qr[0],negm,0,0,0), P0[6],P0[7],P0[8],P0[9],     pw0[2]=PKW(P0,4), pw0[3]=PKW(P0,6), pw0); \
    VRD(1); SBAR(); GAPA(C0=__builtin_amdgcn_mfma_f32_32x32x16_bf16(kf[2],qr[1],C0,0,0,0),   P0[10],P0[11],P0[12],P0[13], pw1[0]=PKW(P0,8), pw1[1]=PKW(P0,10), pw1); \
    VRD(5); SBAR(); GAPA(C1=__builtin_amdgcn_mfma_f32_32x32x16_bf16(kf[3],qr[1],C1,0,0,0),   P0[14],P0[15],P1[0],P1[1],   pw1[2]=PKW(P0,12),pw1[3]=PKW(P0,14), pw1); \
    VRD(2); SBAR(); GAPA(C0=__builtin_amdgcn_mfma_f32_32x32x16_bf16(kf[4],qr[2],C0,0,0,0),   P1[2],P1[3],P1[4],P1[5],     pw2[0]=PKW(P1,0), pw2[1]=PKW(P1,2), pw2); \
    VRD(6); SBAR(); GAPA(C1=__builtin_amdgcn_mfma_f32_32x32x16_bf16(kf[5],qr[2],C1,0,0,0),   P1[6],P1[7],P1[8],P1[9],     pw2[2]=PKW(P1,4), pw2[3]=PKW(P1,6), pw2); \
    VRD(3); SBAR(); GAPA(C0=__builtin_amdgcn_mfma_f32_32x32x16_bf16(kf[6],qr[3],C0,0,0,0),   P1[10],P1[11],P1[12],P1[13], pw3[0]=PKW(P1,8), pw3[1]=PKW(P1,10), pw3); \
    VRD(7); SBAR(); GAPA(C1=__builtin_amdgcn_mfma_f32_32x32x16_bf16(kf[7],qr[3],C1,0,0,0),   P1[14],P1[15],0.f,0.f,       pw3[2]=PKW(P1,12),pw3[3]=PKW(P1,14), pw3); \
    l_reg+=sacc; \
    if(GK){DMA_K((t)+3,sl_cur);} if(GV){DMA_V((t)+1,sl_next);} \
    CMASK(C0,C1,t); \
    SBAR(); \
    GAPB(o[0]=__builtin_amdgcn_mfma_f32_32x32x16_bf16(PAF(0),VFR(0),o[0],0,0,0), C0,0); \
    GAPB(o[1]=__builtin_amdgcn_mfma_f32_32x32x16_bf16(PAF(0),VFR(4),o[1],0,0,0), C0,4); \
    KRD(GL,0); GAPB(o[0]=__builtin_amdgcn_mfma_f32_32x32x16_bf16(PAF(1),VFR(1),o[0],0,0,0), C0,8); \
    KRD(GL,1); GAPB(o[1]=__builtin_amdgcn_mfma_f32_32x32x16_bf16(PAF(1),VFR(5),o[1],0,0,0), C0,12); \
    KRD(GL,2); GAPB(o[0]=__builtin_amdgcn_mfma_f32_32x32x16_bf16(PAF(2),VFR(2),o[0],0,0,0), C1,0); \
    KRD(GL,3); GAPB(o[1]=__builtin_amdgcn_mfma_f32_32x32x16_bf16(PAF(2),VFR(6),o[1],0,0,0), C1,4); \
    GAPB(o[0]=__builtin_amdgcn_mfma_f32_32x32x16_bf16(PAF(3),VFR(3),o[0],0,0,0), C1,8); \
    GAPB(o[1]=__builtin_amdgcn_mfma_f32_32x32x16_bf16(PAF(3),VFR(7),o[1],0,0,0), C1,12); \
    }while(0)
  int t=1;
  #undef CMASK
  #define CMASK(P0,P1,t) do{}while(0)
  for(;t+5<NT;t+=2){
    STEP(pB0,pB1,pA0,pA1,t,true,true,true);     WAIT_BAR(2); RESC(); ROT();
    STEP(pA0,pA1,pB0,pB1,t+1,true,true,true);   WAIT_BAR(2); RESC(); ROT();
  }
  #undef CMASK
  #define CMASK(P0,P1,t) do{}while(0)
  #define ENDW(tt) do{ if((tt)+3<NT){WAIT_BAR(2);} else if((tt)+2<NT){WAIT_BAR(1);} else {WAIT_BAR(0);} }while(0)
  for(;t+1<NT;t+=2){
    STEP(pB0,pB1,pA0,pA1,t,(t+3<NT),(t+1<NT),(t+1<NT));       ENDW(t);   RESC(); ROT();
    STEP(pA0,pA1,pB0,pB1,t+1,(t+4<NT),(t+2<NT),(t+2<NT));     ENDW(t+1); RESC(); ROT();
  }
  STEP(pB0,pB1,pA0,pA1,NT-1,false,false,false); RESC();
  { float sacc=pB0[0]+pB0[1]; _Pragma("unroll") for(int r=2;r<16;++r)sacc+=pB0[r]; _Pragma("unroll") for(int r=0;r<16;++r)sacc+=pB1[r]; l_reg+=sacc;
    pw0=(u32x4){PKW(pB0,0),PKW(pB0,2),PKW(pB0,4),PKW(pB0,6)};pw1=(u32x4){PKW(pB0,8),PKW(pB0,10),PKW(pB0,12),PKW(pB0,14)};pw2=(u32x4){PKW(pB1,0),PKW(pB1,2),PKW(pB1,4),PKW(pB1,6)};pw3=(u32x4){PKW(pB1,8),PKW(pB1,10),PKW(pB1,12),PKW(pB1,14)};
    SBAR(); pv(o,vb0+sl_cur,PAF(0),PAF(1),PAF(2),PAF(3)); }
  #undef PKW
  #undef PAF
  #undef VFR
  #undef PIN
  #undef MX3
  #undef GAPA
  #undef GAPB
  #undef EX
  #undef VRD
  #undef KRD
  #undef STEP
  #undef ENDW
  {auto rr=__builtin_amdgcn_permlane32_swap(__float_as_uint(l_reg),__float_as_uint(l_reg),false,false);l_reg=__uint_as_float(rr[0])+__uint_as_float(rr[1]);}
  if(hi==0)wsf[32+r32]=l_reg;asm volatile("s_waitcnt lgkmcnt(0)":::"memory");
  float rli[16];
  #pragma unroll
  for(int r=0;r<16;++r)rli[r]=__builtin_amdgcn_rcpf(wsf[32+crow(r,hi)]);
  unsigned char*Ow=(unsigned char*)O+(rowbase+q0+wid*QBLK)*PO+h*D;
  { unsigned char*stg=(unsigned char*)(shm+LDS_OST)+wid*2048;
    #pragma unroll
    for(int r=0;r<16;++r){const int orow=crow(r,hi); const float sc=rli[r]*OSCALE;
      #pragma unroll
      for(int d0=0;d0<2;++d0){ const float v=__builtin_amdgcn_fmed3f(o[d0][r]*sc,-448.0f,448.0f); stg[orow*64+d0*32+r32]=(unsigned char)(__builtin_amdgcn_cvt_pk_fp8_f32(v,0.f,0u,false)&0xffu); } }
    asm volatile("s_waitcnt lgkmcnt(0)":::"memory");
    #pragma unroll
    for(int i=0;i<2;++i){const int row=i*16+(lane>>2),ch=lane&3; const u32x4 v=*(const u32x4*)(stg+row*64+ch*16); ATTN_STORE16(Ow+(long)row*PO+ch*16,v);} }
  asm volatile("s_waitcnt lgkmcnt(0)\n\ts_barrier":::"memory");
  #undef DMA_K
  #undef DMA_V
  #undef CMASK
  #undef START
  #undef RESC
  #undef ROT
}
constexpr int ATTN_LDS_BYTES=LDS_BYTES;
struct AttnTensors { const bf16* Q; const bf16* K; const bf16* V; bf16* O; const float* qg; const float* kg; };
template<int THRL=8> __device__ __forceinline__ void attn_phase(char*lds,const AttnTensors&T,int vcu,int G){
  float gq=fabsf(T.qg[threadIdx.x&63]),gk=fabsf(T.kg[threadIdx.x&63]);
  gq=wmax64(gq); gk=wmax64(gk);
  const float nref=__uint_as_float(__builtin_amdgcn_readfirstlane(__float_as_uint(-(64.f*C2*gq*gk*1.02f+0.25f))));
  for(int L=vcu;L<BATCH*NHEAD*NQB;L+=G){
    const int pair=((L>>5)&7)*2+((L>>8)>>2), idx=(L&31)+32*((L>>8)&3);
    const int b=pair>>1, h=(pair&1)*4+(idx>>5), qb=idx&31;
    attn_unit<THRL>(b,h,qb,T.Q,T.K,T.V,T.O,lds,T.qg,nref);
  }
}
#undef SBAR
#undef WAIT_BAR
}
constexpr int NWAVES = 8;
constexpr int NTHR = NWAVES * 64;
constexpr int BATCH = 8, T = 8192, D = 1024, DEPTH = 2;
constexpr int M = BATCH * T;
constexpr int INW = 2816;
constexpr int C_QA = 0, C_KA = 512, C_VA = 640, C_QR = 768, C_KR = 1280, C_VR = 1792, C_GR = 2304;
constexpr int NE = 32, TOPK = 4, NASG = M * TOPK;
constexpr int XS_ROWS = NASG + NE * 256;
constexpr int RCH = 128, NCH = T / RCH, RH = 4;
constexpr int RUNITS = BATCH * RH * NCH;
constexpr float EPS = 1e-6f;
constexpr float LOG2E = 1.4426950408889634f;

constexpr size_t MiB = 1u << 20;
constexpr size_t WS_CTL = 0, CTL_ZERO_BYTES = 2 * MiB;
constexpr size_t WS_MOD = 512 * 1024;
constexpr size_t WS_CMAXIN = 256 * 1024, WS_CSCIN = 320 * 1024;
constexpr size_t WS_CMAX = 1 * MiB;
constexpr size_t WS_CSCDN = 1 * MiB;
constexpr size_t WS_CSCOUT = 1 * MiB + 256 * 1024;
constexpr float CAT_S_ATT = 32.0f, CAT_S_RET = 8.0f;
static_assert(attn_body::OSCALE == CAT_S_ATT, "attention output scale");
constexpr size_t WS_CSC = 1 * MiB + 512 * 1024;
constexpr size_t WS_WIN = 2 * MiB;
constexpr size_t WS_WOUT = 13 * MiB;
constexpr size_t WS_WUP = 17 * MiB;
constexpr size_t WS_WDN = 273 * MiB;
constexpr size_t WS_HM = 401 * MiB;
constexpr size_t WS_TOPI = 529 * MiB, WS_TOPW = 530 * MiB, WS_POS = 531 * MiB;
constexpr size_t WS_PROJ = 532 * MiB;
constexpr size_t WS_CAT = 884 * MiB;
constexpr size_t WS_YM = 1012 * MiB;
constexpr size_t WS_U = 1140 * MiB;
constexpr size_t WS_FT = 1396 * MiB;
constexpr size_t WS_XS = 532 * MiB;
constexpr size_t WS_ACT = 1060 * MiB;
constexpr size_t WS_HS = 1588 * MiB;
constexpr size_t WS_XSC = 1589 * MiB;
constexpr size_t WS_RMAP = 1591 * MiB;
constexpr size_t WS_END = 1593 * MiB;
constexpr size_t WS_DUMMY = 1593 * MiB;
static_assert(WS_MOD + (size_t)DEPTH * BATCH * 6 * D * 4 <= CTL_ZERO_BYTES, "mod inside the memset region");
static_assert(WS_XS + (size_t)XS_ROWS * 1024 * 2 <= WS_ACT && WS_ACT + (size_t)XS_ROWS * 1024 * 2 <= WS_END, "moe map");
static_assert(WS_PROJ + (size_t)M * INW * 2 <= WS_CAT && WS_FT + (size_t)RUNITS * 2 * 16384 * 2 <= WS_END, "mixer map");
constexpr int CW_TMO = 0, CW_CODE = 1;
constexpr int CW_BAR = 4096;
constexpr int CW_CNT = 8192;
constexpr int CW_WQ = 8192 + 1024;
constexpr int CW_CUR = 8192 + 256;

constexpr int RING_OFF = 0, RING_BYTES = 131072;
constexpr int LDSCTL_OFF = RING_BYTES;
constexpr int LCNT_OFF = LDSCTL_OFF, LTS_OFF = LDSCTL_OFF + 128, MISC_OFF = LDSCTL_OFF + 320;
constexpr int EPI_SP_OFF = LDSCTL_OFF + 1024;
constexpr int GAIN_OFF = LDSCTL_OFF + 6144;
constexpr int LDS_BYTES = 147456;
#define GAS __attribute__((address_space(1)))
#define LAS __attribute__((address_space(3)))
typedef unsigned short bf16;
typedef unsigned v4u __attribute__((ext_vector_type(4)));
typedef float f32x4 __attribute__((ext_vector_type(4)));
typedef short bf16x8 __attribute__((ext_vector_type(8)));
typedef GAS unsigned gu32;
typedef GAS unsigned long long gu64;
#define RLX_AGENT __ATOMIC_RELAXED, __HIP_MEMORY_SCOPE_AGENT
#define LDS_WAIT() asm volatile("s_waitcnt lgkmcnt(0)" ::: "memory")
#define VM_WAIT() asm volatile("s_waitcnt vmcnt(0)" ::: "memory")
__device__ __forceinline__ unsigned long long rt() { return __builtin_amdgcn_s_memrealtime(); }
__device__ __forceinline__ unsigned f2bf(float f) { unsigned u = __builtin_bit_cast(unsigned, f); return (u + 0x7fffu + ((u >> 16) & 1u)) >> 16; }
__device__ __forceinline__ unsigned pk2(float lo, float hi) { return f2bf(lo) | (f2bf(hi) << 16); }

#define XB_TMO      128
#define XB_XCNT(j)  (256  + 64 * (j))
#define XB_XSUB(j)  (1280 + 64 * (j))
#define XB_XGEN(j)  (2304 + 64 * (j))
#define XB_TOP      3328
#define XB_TOPGEN   3392
#define XCD_BAR_WORDS 3456
#define XB_SPIN_CAP (1u << 18)

__device__ __forceinline__ unsigned xb_ld(unsigned* p)              { return __hip_atomic_load(p, __ATOMIC_RELAXED, __HIP_MEMORY_SCOPE_AGENT); }
__device__ __forceinline__ unsigned xb_add(unsigned* p, unsigned v) { return __hip_atomic_fetch_add(p, v, __ATOMIC_RELAXED, __HIP_MEMORY_SCOPE_AGENT); }
__device__ __forceinline__ unsigned xb_xcc_id() { return (unsigned)__builtin_amdgcn_s_getreg((3 << 11) | 20) & 0xFu; }
#define XB_SPIN(cond, bar) do { unsigned _sp = 0; while (cond) { __builtin_amdgcn_s_sleep(1); \
    if ((++_sp & 255u) == 0u) { if (xb_ld(&(bar)[XB_TMO])) break; if (_sp > XB_SPIN_CAP) { atomicAdd(&(bar)[XB_TMO], 1u); break; } } } } while (0)

struct XcdBarrier {
    unsigned* bar; unsigned x;
    volatile LAS unsigned* st;
};

__device__ __forceinline__ XcdBarrier xcd_barrier_post(unsigned* bar, volatile LAS unsigned* st) {
    XcdBarrier b; b.bar = bar; b.x = xb_xcc_id(); b.st = st;
    if (threadIdx.x == 0) (void)xb_add(&bar[XB_XCNT(b.x)], 1u);
    return b;
}
__device__ __forceinline__ void xcd_barrier_complete(unsigned* bar, unsigned x, unsigned& nloc, unsigned& nx) {
    const unsigned G = gridDim.x * gridDim.y * gridDim.z;
    unsigned sum, cnt, mine, sp = 0u;
    for (;;) {
        sum = 0u; cnt = 0u; mine = 0u;
#pragma unroll
        for (unsigned j = 0; j < 16; ++j) { const unsigned c = xb_ld(&bar[XB_XCNT(j)]); sum += c; cnt += (c > 0u) ? 1u : 0u; mine = (j == x) ? c : mine; }
        if (sum == G) break;
        __builtin_amdgcn_s_sleep(1);
        if ((++sp & 255u) == 0u) { if (xb_ld(&bar[XB_TMO])) break; if (sp > XB_SPIN_CAP) { atomicAdd(&bar[XB_TMO], 1u); break; } }
    }
    nloc = mine > 0u ? mine : 1u; nx = cnt > 0u ? cnt : 1u;
}

__device__ __forceinline__ void xcd_barrier(const XcdBarrier& b) {
    asm volatile("s_waitcnt vmcnt(0)" ::: "memory");
    __syncthreads();
    if (threadIdx.x == 0) {
        unsigned* bar = b.bar;
        __builtin_amdgcn_s_waitcnt(0);
        unsigned nloc = b.st[0], nx = b.st[1];
        if (nloc == 0u) { xcd_barrier_complete(bar, b.x, nloc, nx); b.st[0] = nloc; b.st[1] = nx; }
        const unsigned old = xb_add(&bar[XB_XSUB(b.x)], 1u);
        const unsigned gen = old / nloc;
        if (old + 1u == (gen + 1u) * nloc) {
            __builtin_amdgcn_fence(__ATOMIC_RELEASE, "agent");
            asm volatile("s_waitcnt vmcnt(0)" ::: "memory");
            const unsigned og = xb_add(&bar[XB_TOP], 1u);
            const unsigned tg = og / nx;
            if (og + 1u == (tg + 1u) * nx) xb_add(&bar[XB_TOPGEN], 1u);
            else XB_SPIN(xb_ld(&bar[XB_TOPGEN]) == tg, bar);
            __builtin_amdgcn_fence(__ATOMIC_ACQUIRE, "agent");
            xb_add(&bar[XB_XGEN(b.x)], 1u);
            asm volatile("s_waitcnt vmcnt(0)" ::: "memory");
        } else {
            XB_SPIN(xb_ld(&bar[XB_XGEN(b.x)]) == gen, bar);
            __builtin_amdgcn_fence(__ATOMIC_ACQUIRE, "agent");
            asm volatile("s_waitcnt vmcnt(0)" ::: "memory");
        }
    }
    __syncthreads();
}

typedef unsigned u32x2 __attribute__((ext_vector_type(2)));
typedef short s16x4 __attribute__((ext_vector_type(4)));
typedef float f32x16 __attribute__((ext_vector_type(16)));
typedef int i32x4 __attribute__((ext_vector_type(4)));
struct Frame {
    LAS unsigned char* lds;
    volatile LAS unsigned* MISC;
    gu32* ctl;
    int tid, lane, wave, vcu, G;
};
__device__ __forceinline__ float wave_sum(float v) {
    return wsum64(v);
}
__device__ __forceinline__ float bflo(unsigned w) { return __uint_as_float(w << 16); }
__device__ __forceinline__ float bfhi(unsigned w) { return __uint_as_float(w & 0xffff0000u); }
__device__ __forceinline__ unsigned pkbf(float lo, float hi) { return pg8::cvt_pk_bf16(lo, hi); }
__device__ __forceinline__ float fexp2(float x) { return __builtin_amdgcn_exp2f(x); }
__device__ __forceinline__ float frsq(float x) { return __builtin_amdgcn_rsqf(x); }
__device__ __forceinline__ float frcp(float x) { return __builtin_amdgcn_rcpf(x); }
__device__ __forceinline__ float row_rstd(const f32x4 (&v)[4]) {
    float s = 0.f;
#pragma unroll
    for (int j = 0; j < 4; ++j) s += (v[j].x * v[j].x + v[j].y * v[j].y) + (v[j].z * v[j].z + v[j].w * v[j].w);
    return frsq(wave_sum(s) * (1.f / D) + EPS);
}
__device__ __forceinline__ void store_row_bf16(bf16* orow, const f32x4 (&v)[4], int lane) {
    u32x2* o8 = (u32x2*)orow + lane;
#pragma unroll
    for (int j = 0; j < 4; ++j) { u32x2 w; w.x = pkbf(v[j].x, v[j].y); w.y = pkbf(v[j].z, v[j].w); o8[64 * j] = w; }
}
__device__ __forceinline__ void load_row_f32(const float* xrow, f32x4 (&v)[4], int lane) {
    const f32x4* xr = (const f32x4*)xrow + lane;
#pragma unroll
    for (int j = 0; j < 4; ++j) v[j] = xr[64 * j];
}
__device__ __forceinline__ void load_row_f32_nt(const float* xrow, f32x4 (&v)[4], int lane) {
    const f32x4* xr = (const f32x4*)xrow + lane;
#pragma unroll
    for (int j = 0; j < 4; ++j) v[j] = __builtin_nontemporal_load(xr + 64 * j);
}
__device__ __forceinline__ void modnorm_row(const f32x4 (&x)[4], f32x4 (&h)[4], const float* g, const float* sc, const float* sh, int lane) {
    const float rs = row_rstd(x);
#pragma unroll
    for (int j = 0; j < 4; ++j) { const f32x4 gv = ((const f32x4*)g)[lane + 64 * j], scv = ((const f32x4*)sc)[lane + 64 * j], shv = ((const f32x4*)sh)[lane + 64 * j];
        h[j] = x[j] * rs * gv * (scv + 1.0f) + shv; }
}

template <bool UPPERM> __device__ __forceinline__ void p0_transpose_item(const float* W, int K, int N, bf16* WT, int item, int lane) {
    const int nblk = N / 256, kb = item / nblk, nb = item - kb * nblk, k0 = 32 * kb, n0 = 256 * nb + 4 * lane;
    const float* src = W + (size_t)k0 * N + n0;
    int drow = n0;
    if (UPPERM) drow = (n0 < 1024) ? (256 * (n0 >> 7) + (n0 & 127)) : (256 * ((n0 - 1024) >> 7) + 128 + ((n0 - 1024) & 127));
    bf16* dst = WT + (size_t)drow * K + k0;
#pragma unroll
    for (int s = 0; s < 4; ++s) {
        f32x4 v[8];
#pragma unroll
        for (int k = 0; k < 8; ++k) v[k] = *(const f32x4*)(src + (size_t)(8 * s + k) * N);
#pragma unroll
        for (int j = 0; j < 4; ++j) { v4u o; o.x = pkbf(v[0][j], v[1][j]); o.y = pkbf(v[2][j], v[3][j]); o.z = pkbf(v[4][j], v[5][j]); o.w = pkbf(v[6][j], v[7][j]);
            *(v4u*)(dst + (size_t)j * K + 8 * s) = o; }
    }
}
__device__ __forceinline__ int up_dest_row(int n0) { return (n0 < 1024) ? (256 * (n0 >> 7) + (n0 & 127)) : (256 * ((n0 - 1024) >> 7) + 128 + ((n0 - 1024) & 127)); }
template <int N, bool UPPERM> __device__ __forceinline__ void p0_absmax_item(const float* W, unsigned* cmax, int item, int lane) {
    constexpr int NBLK = N / 256; const int kb = item / NBLK, nb = item - kb * NBLK, k0 = 32 * kb, n0 = 256 * nb + 4 * lane;
    const float* src = W + (size_t)k0 * N + n0;
    f32x4 mx = (f32x4){0.f, 0.f, 0.f, 0.f};
#pragma unroll
    for (int k = 0; k < 32; ++k) { const f32x4 v = *(const f32x4*)(src + (size_t)k * N); mx.x = fmaxf(mx.x, fabsf(v.x)); mx.y = fmaxf(mx.y, fabsf(v.y)); mx.z = fmaxf(mx.z, fabsf(v.z)); mx.w = fmaxf(mx.w, fabsf(v.w)); }
    unsigned* d = cmax + (UPPERM ? up_dest_row(n0) : n0);
    atomicMax(d + 0, __float_as_uint(mx.x)); atomicMax(d + 1, __float_as_uint(mx.y)); atomicMax(d + 2, __float_as_uint(mx.z)); atomicMax(d + 3, __float_as_uint(mx.w));
}
template <int N, bool UPPERM> __device__ __forceinline__ void p0_quant_item(const float* W, const unsigned* cmax, signed char* WQ, float* csc, int item, int lane) {
    constexpr int NBLK = N / 256; const int kb = item / NBLK, nb = item - kb * NBLK, k0 = 32 * kb, n0 = 256 * nb + 4 * lane, drow = UPPERM ? up_dest_row(n0) : n0;
    const float* src = W + (size_t)k0 * N + n0;
    float inv[4];
#pragma unroll
    for (int j = 0; j < 4; ++j) { const float cm = __uint_as_float(cmax[drow + j]); inv[j] = cm > 0.f ? 127.0f / cm : 0.f; if (kb == 0) csc[drow + j] = cm * (1.0f / 127.0f); }
#pragma unroll
    for (int s = 0; s < 2; ++s) {
        f32x4 v[16];
#pragma unroll
        for (int k = 0; k < 16; ++k) v[k] = *(const f32x4*)(src + (size_t)(16 * s + k) * N);
#pragma unroll
        for (int j = 0; j < 4; ++j) { unsigned w[4];
#pragma unroll
            for (int d = 0; d < 4; ++d) { unsigned x = 0u;
#pragma unroll
                for (int b = 0; b < 4; ++b) { const int q = (int)__builtin_rintf(v[4 * d + b][j] * inv[j]); x |= ((unsigned)q & 0xffu) << (8 * b); }
                w[d] = x; }
            *(v4u*)(WQ + (size_t)(drow + j) * 1024 + k0 + 16 * s) = (v4u){w[0], w[1], w[2], w[3]}; }
    }
}
__device__ __forceinline__ void p0_quant_up(Frame& F, const float* w_up, const unsigned* cmax, signed char* WQ, float* csc, const float* w_in, const unsigned* cmax_in, signed char* WQin, float* csc_in) {
    const int gw = F.vcu * NWAVES + F.wave, NGW = F.G * NWAVES;
    for (int it = gw; it < DEPTH * NE * 256 + DEPTH * 352; it += NGW) {
        if (it < DEPTH * NE * 256) { const int le = it >> 8;
            p0_quant_item<2048, true>(w_up + (size_t)le * D * 2048, cmax + (size_t)le * 2048, WQ + (size_t)le * 2048 * D, csc + (size_t)le * 2048, it & 255, F.lane); }
        else { const int r = it - DEPTH * NE * 256, l = r / 352;
            p0_quant_item<INW, false>(w_in + (size_t)l * D * INW, cmax_in + (size_t)l * INW, WQin + (size_t)l * INW * D, csc_in + (size_t)l * INW, r % 352, F.lane); }
    }
}
template <int N, bool UPPERM, bool FP8 = false, bool KSC = false> __device__ __forceinline__ void p0_quant_unit(const float* W, signed char* WQ, float* csc, int cb, LAS unsigned* red, int tid) {
    const int cg = tid & 15, kq = tid >> 4, n0 = 64 * cb + 4 * cg, drow = UPPERM ? up_dest_row(n0) : n0;
    f32x4 v[2][16]; f32x4 mx = (f32x4){0.f, 0.f, 0.f, 0.f};
#pragma unroll
    for (int h = 0; h < 2; ++h)
#pragma unroll
        for (int i = 0; i < 16; ++i) { v[h][i] = *(const f32x4*)(W + (size_t)(16 * (kq + 32 * h) + i) * N + n0); if constexpr (KSC) v[h][i] = v[h][i] * (h == 0 ? 1.0f / CAT_S_ATT : 1.0f / CAT_S_RET);
            mx.x = fmaxf(mx.x, fabsf(v[h][i].x)); mx.y = fmaxf(mx.y, fabsf(v[h][i].y)); mx.z = fmaxf(mx.z, fabsf(v[h][i].z)); mx.w = fmaxf(mx.w, fabsf(v[h][i].w)); }
    if (tid < 64) red[tid] = 0u;
    __syncthreads();
    atomicMax((unsigned*)(red + 4 * cg + 0), __float_as_uint(mx.x)); atomicMax((unsigned*)(red + 4 * cg + 1), __float_as_uint(mx.y));
    atomicMax((unsigned*)(red + 4 * cg + 2), __float_as_uint(mx.z)); atomicMax((unsigned*)(red + 4 * cg + 3), __float_as_uint(mx.w));
    __syncthreads();
    float inv[4];
#pragma unroll
    for (int j = 0; j < 4; ++j) { const float cm = __uint_as_float(red[4 * cg + j]); constexpr float QMAX = FP8 ? 448.0f : 127.0f; inv[j] = cm > 0.f ? QMAX / cm : 0.f; if (kq == 0) csc[drow + j] = cm * (1.0f / QMAX); }
#pragma unroll
    for (int h = 0; h < 2; ++h)
#pragma unroll
        for (int j = 0; j < 4; ++j) { unsigned w[4];
#pragma unroll
            for (int d = 0; d < 4; ++d) { unsigned x = 0u;
                if constexpr (FP8) { x = __builtin_amdgcn_cvt_pk_fp8_f32(v[h][4 * d + 0][j] * inv[j], v[h][4 * d + 1][j] * inv[j], x, false); x = __builtin_amdgcn_cvt_pk_fp8_f32(v[h][4 * d + 2][j] * inv[j], v[h][4 * d + 3][j] * inv[j], x, true); }
                else {
#pragma unroll
                for (int b = 0; b < 4; ++b) { const int q = (int)__builtin_rintf(v[h][4 * d + b][j] * inv[j]); x |= ((unsigned)q & 0xffu) << (8 * b); } }
                w[d] = x; }
            *(v4u*)(WQ + (size_t)(drow + j) * 1024 + 16 * (kq + 32 * h)) = (v4u){w[0], w[1], w[2], w[3]}; }
    __syncthreads();
}
struct QItem { const float* W; signed char* WQ; float* csc; int N, n0, type; };
__device__ __forceinline__ void q_issue(f32x4 (&v)[16], const QItem& q, int tid) {
    const int cg = tid & 7, kq = tid >> 3; const float* src = q.W + (size_t)(16 * kq) * q.N + q.n0 + 4 * cg;
#pragma unroll
    for (int i = 0; i < 16; ++i) v[i] = __builtin_nontemporal_load((const f32x4*)(src + (size_t)i * q.N));
}
template <bool UPPERM, bool FP8, bool KSC> __device__ __forceinline__ void q_finish(f32x4 (&v)[16], const QItem& q, LAS unsigned* red, int tid) {
    const int cg = tid & 7, kq = tid >> 3, n0 = q.n0 + 4 * cg, drow = UPPERM ? up_dest_row(n0) : n0;
    f32x4 mx = (f32x4){0.f, 0.f, 0.f, 0.f};
#pragma unroll
    for (int i = 0; i < 16; ++i) { if constexpr (KSC) v[i] = v[i] * (kq < 32 ? 1.0f / CAT_S_ATT : 1.0f / CAT_S_RET);
        mx.x = fmaxf(mx.x, fabsf(v[i].x)); mx.y = fmaxf(mx.y, fabsf(v[i].y)); mx.z = fmaxf(mx.z, fabsf(v[i].z)); mx.w = fmaxf(mx.w, fabsf(v[i].w)); }
    if (tid < 32) red[tid] = 0u;
    __syncthreads();
    atomicMax((unsigned*)(red + 4 * cg + 0), __float_as_uint(mx.x)); atomicMax((unsigned*)(red + 4 * cg + 1), __float_as_uint(mx.y));
    atomicMax((unsigned*)(red + 4 * cg + 2), __float_as_uint(mx.z)); atomicMax((unsigned*)(red + 4 * cg + 3), __float_as_uint(mx.w));
    __syncthreads();
    constexpr float QMAX = FP8 ? 448.0f : 127.0f;
#pragma unroll
    for (int j = 0; j < 4; ++j) { const float cm = __uint_as_float(red[4 * cg + j]), inv = cm > 0.f ? QMAX / cm : 0.f; if (kq == 0) q.csc[drow + j] = cm * (1.0f / QMAX);
        unsigned w[4];
#pragma unroll
        for (int d = 0; d < 4; ++d) { unsigned x = 0u;
            if constexpr (FP8) { x = __builtin_amdgcn_cvt_pk_fp8_f32(v[4 * d + 0][j] * inv, v[4 * d + 1][j] * inv, x, false); x = __builtin_amdgcn_cvt_pk_fp8_f32(v[4 * d + 2][j] * inv, v[4 * d + 3][j] * inv, x, true); }
            else {
#pragma unroll
                for (int b = 0; b < 4; ++b) { const int qv = (int)__builtin_rintf(v[4 * d + b][j] * inv); x |= ((unsigned)qv & 0xffu) << (8 * b); } }
            w[d] = x; }
        *(v4u*)(q.WQ + (size_t)(drow + j) * 1024 + 16 * kq) = (v4u){w[0], w[1], w[2], w[3]}; }
}
__device__ __forceinline__ void q_finish_any(f32x4 (&v)[16], const QItem& q, LAS unsigned* red, int tid) {
    if (q.type == 0) q_finish<true, false, false>(v, q, red, tid);
    else if (q.type == 1) q_finish<false, false, false>(v, q, red, tid);
    else if (q.type == 2) q_finish<false, true, false>(v, q, red, tid);
    else q_finish<false, true, true>(v, q, red, tid);
}
__device__ __forceinline__ void p0_prologue(Frame& F, const float* c_in, const float* ada_w, const float* ada_b, float* mod,
                                            const float* w_in, const float* w_out, const float* w_up, const float* w_dn,
                                            signed char* WQin, float* csc_in, signed char* WQout, float* csc_out, signed char* WQup, float* csc_up, signed char* WQdn, float* csc_dn, gu32* wq_ctr) {
    const int gw = F.vcu * NWAVES + F.wave, NGW = F.G * NWAVES;
    __syncthreads();
    LAS float* cond = (LAS float*)F.lds;
    for (int i = F.tid; i < BATCH * D; i += NTHR) { const float v = c_in[i]; cond[i] = v * frcp(1.0f + __expf(-v)); }
    __syncthreads();
    LAS float* part = (LAS float*)(F.lds + 32768);
    for (int bt = blockIdx.x; bt < DEPTH * 96; bt += F.G) {
        const int l = bt / 96, chunk = bt % 96, ks = F.wave, col = chunk * 64 + F.lane;
        float acc[BATCH];
#pragma unroll
        for (int b = 0; b < BATCH; ++b) acc[b] = 0.f;
        const float* w = ada_w + ((size_t)l * D + ks * 128) * (6 * D) + col;
#pragma unroll 16
        for (int k = 0; k < 128; ++k) { const float wv = w[(size_t)k * (6 * D)];
#pragma unroll
            for (int b = 0; b < BATCH; ++b) acc[b] += cond[b * D + ks * 128 + k] * wv; }
#pragma unroll
        for (int b = 0; b < BATCH; ++b) part[(ks * BATCH + b) * 64 + F.lane] = acc[b];
        __syncthreads();
        { const int b = F.wave; float sum = ada_b[l * 6 * D + col];
#pragma unroll
          for (int k2 = 0; k2 < 8; ++k2) sum += part[(k2 * BATCH + b) * 64 + F.lane];
          mod[((size_t)l * BATCH + b) * (6 * D) + col] = sum; }
        __syncthreads();
    }
    {   LAS unsigned* redA = (LAS unsigned*)(F.lds + 49152 + 1024), *redB = redA + 32; LAS unsigned* claim = redA + 64;
        constexpr int U_UP = DEPTH * NE * 64, U_IN = DEPTH * 88, U_DN = DEPTH * NE * 32, U_OUT = DEPTH * 32, U_ALL = U_UP + U_IN + U_DN + U_OUT;
        auto take = [&](QItem& q) -> bool {
            if (F.tid == 0) claim[0] = __hip_atomic_fetch_add(wq_ctr, 1u, RLX_AGENT);
            __syncthreads();
            const int u = (int)claim[0];
            __syncthreads();
            if (u >= U_ALL) return false;
            if (u < U_UP) { const int le = u >> 6; q = QItem{w_up + (size_t)le * D * 2048, WQup + (size_t)le * 2048 * D, csc_up + (size_t)le * 2048, 2048, 32 * (u & 63), 0}; }
            else if (u < U_UP + U_IN) { const int r = u - U_UP, l = r / 88; q = QItem{w_in + (size_t)l * D * INW, WQin + (size_t)l * INW * D, csc_in + (size_t)l * INW, INW, 32 * (r % 88), 1}; }
            else if (u < U_UP + U_IN + U_DN) { const int r = u - U_UP - U_IN, le = r >> 5; q = QItem{w_dn + (size_t)le * D * D, WQdn + (size_t)le * D * D, csc_dn + (size_t)le * D, D, 32 * (r & 31), 2}; }
            else { const int r = u - U_UP - U_IN - U_DN, l = r >> 5; q = QItem{w_out + (size_t)l * D * D, WQout + (size_t)l * D * D, csc_out + (size_t)l * D, D, 32 * (r & 31), 3}; }
            return true; };
        f32x4 vA[16], vB[16]; QItem qA, qB;
        bool hA = take(qA); if (hA) q_issue(vA, qA, F.tid);
        bool hB = hA && take(qB); if (hB) q_issue(vB, qB, F.tid);
        while (hA || hB) {
            if (hA) { q_finish_any(vA, qA, redA, F.tid); hA = take(qA); if (hA) q_issue(vA, qA, F.tid); }
            if (hB) { q_finish_any(vB, qB, redB, F.tid); hB = take(qB); if (hB) q_issue(vB, qB, F.tid); }
        }
    }
}
__device__ __forceinline__ void store_row_i8(signed char* qrow, float* sc, const f32x4 (&h)[4], int lane) {
    float mx = 0.f;
#pragma unroll
    for (int j = 0; j < 4; ++j) mx = fmaxf(fmaxf(mx, fmaxf(fabsf(h[j].x), fabsf(h[j].y))), fmaxf(fabsf(h[j].z), fabsf(h[j].w)));
    mx = wmax64(mx);
    const float inv = mx > 0.f ? 127.0f / mx : 0.f;
    unsigned* qr = (unsigned*)qrow + lane;
#pragma unroll
    for (int j = 0; j < 4; ++j) { const int q0 = (int)__builtin_rintf(h[j].x * inv), q1 = (int)__builtin_rintf(h[j].y * inv), q2 = (int)__builtin_rintf(h[j].z * inv), q3 = (int)__builtin_rintf(h[j].w * inv);
        qr[64 * j] = ((unsigned)q0 & 0xffu) | (((unsigned)q1 & 0xffu) << 8) | (((unsigned)q2 & 0xffu) << 16) | (((unsigned)q3 & 0xffu) << 24); }
    if (lane == 0) *sc = mx * (1.0f / 127.0f);
}
__device__ __forceinline__ void p0b_premix(Frame& F, const float* x, signed char* HQ, float* hs, const float* g, const float* mod_l) {
    const int lane = F.lane, gw = F.vcu * NWAVES + F.wave, NGW = F.G * NWAVES;
    for (int ch = gw; ch < M / 32; ch += NGW) { const int mb = ch * 32;
        const float* modb = mod_l + (size_t)(mb >> 13) * (6 * D);
        f32x4 gsv[4], shv[4];
#pragma unroll
        for (int j = 0; j < 4; ++j) { gsv[j] = ((const f32x4*)g)[lane + 64 * j] * (((const f32x4*)(modb + D))[lane + 64 * j] + 1.0f); shv[j] = ((const f32x4*)modb)[lane + 64 * j]; }
        f32x4 A[2][4], B[2][4];
#define P0B_ISSUE(BUF, t0) do { _Pragma("unroll") for (int r = 0; r < 2; ++r) load_row_f32_nt(x + (size_t)(mb + (t0) + r) * D, BUF[r], lane); } while (0)
#define P0B_PROC(BUF, t0) do { _Pragma("unroll") for (int r = 0; r < 2; ++r) { const int m = mb + (t0) + r; f32x4 h[4]; const float rs = row_rstd(BUF[r]); \
            _Pragma("unroll") for (int j = 0; j < 4; ++j) h[j] = BUF[r][j] * rs * gsv[j] + shv[j]; store_row_i8(HQ + (size_t)m * D, hs + m, h, lane); } } while (0)
        P0B_ISSUE(A, 0);
#pragma unroll 1
        for (int it = 0; it < 8; ++it) { const int t0 = 4 * it;
            P0B_ISSUE(B, t0 + 2);
            P0B_PROC(A, t0);
            if (it < 7) P0B_ISSUE(A, t0 + 4);
            P0B_PROC(B, t0 + 2);
        }
#undef P0B_ISSUE
#undef P0B_PROC
    }
}
__device__ __forceinline__ void rope4(float (&y)[4][2], const float (&cr)[2], const float (&sr)[2], const float (&cc)[2], const float (&sc)[2], float scale, unsigned (&w)[4]) {
    float o[4][2];
#pragma unroll
    for (int e = 0; e < 2; ++e) { o[0][e] = y[0][e] * cr[e] - y[1][e] * sr[e]; o[1][e] = y[1][e] * cr[e] + y[0][e] * sr[e];
                                  o[2][e] = y[2][e] * cc[e] - y[3][e] * sc[e]; o[3][e] = y[3][e] * cc[e] + y[2][e] * sc[e]; }
#pragma unroll
    for (int q = 0; q < 4; ++q) w[q] = pkbf(o[q][0] * scale, o[q][1] * scale);
}
__device__ __forceinline__ void p1b_ka(Frame& F, bf16* PROJ, const float* kg) {
    const int lane = F.lane, gw = F.vcu * NWAVES + F.wave, NGW = F.G * NWAVES;
    const int ja = lane & 7, hk = (lane >> 3) & 1, sub = lane >> 4;
    constexpr float L2T = 13.287712379549449f;
    float fa[2], gk[4][2];
#pragma unroll
    for (int e = 0; e < 2; ++e) fa[e] = fexp2(-(float)(2 * ja + e) * (L2T / 16.f));
#pragma unroll
    for (int q = 0; q < 4; ++q)
#pragma unroll
        for (int e = 0; e < 2; ++e) gk[q][e] = kg[q * 16 + 2 * ja + e];
    for (int m0 = gw * 4; m0 < M; m0 += NGW * 4) {
        const int m = m0 + sub, s = m & (T - 1); const float rid = (float)(s >> 6), cid = (float)(s & 63);
        float cra[2], sra[2], cca[2], sca[2];
#pragma unroll
        for (int e = 0; e < 2; ++e) { cra[e] = __cosf(rid * fa[e]); sra[e] = __sinf(rid * fa[e]); cca[e] = __cosf(cid * fa[e]); sca[e] = __sinf(cid * fa[e]); }
        unsigned* p = (unsigned*)(PROJ + (size_t)m * INW + C_KA + hk * 64 + 2 * ja); unsigned w[4]; float y[4][2]; float ss = 0.f;
#pragma unroll
        for (int q = 0; q < 4; ++q) { w[q] = p[q * 8]; y[q][0] = bflo(w[q]); y[q][1] = bfhi(w[q]); ss += y[q][0] * y[q][0] + y[q][1] * y[q][1]; }
        ss += shx<1>(ss); ss += shx<2>(ss); ss += shx<4>(ss);
        const float rs = frsq(ss * (1.f / 64.f) + EPS);
#pragma unroll
        for (int q = 0; q < 4; ++q) { y[q][0] *= rs * gk[q][0]; y[q][1] *= rs * gk[q][1]; }
        rope4(y, cra, sra, cca, sca, 1.0f, w);
#pragma unroll
        for (int q = 0; q < 4; ++q) p[q * 8] = w[q];
    }
}
__device__ __forceinline__ void p1b_rope(Frame& F, bf16* PROJ, bf16* PDST, const float* qg, const float* kg) {
    const int lane = F.lane, gw = F.vcu * NWAVES + F.wave, NGW = F.G * NWAVES;
    const int ja = lane & 7, jr = lane & 15;
    constexpr float L2T = 13.287712379549449f;
    float fa[2], fr[2], gq[4][2], gk[4][2];
#pragma unroll
    for (int e = 0; e < 2; ++e) { fa[e] = fexp2(-(float)(2 * ja + e) * (L2T / 16.f)); fr[e] = fexp2(-(float)(2 * jr + e) * (L2T / 32.f)); }
#pragma unroll
    for (int q = 0; q < 4; ++q)
#pragma unroll
        for (int e = 0; e < 2; ++e) { gq[q][e] = qg[q * 16 + 2 * ja + e]; gk[q][e] = kg[q * 16 + 2 * ja + e]; }
    for (int m = gw; m < M; m += NGW) {
        const int s = m & (T - 1); const float rid = (float)(s >> 6), cid = (float)(s & 63);
        float cra[2], sra[2], cca[2], sca[2], crr[2], srr[2], ccr[2], scr2[2];
#pragma unroll
        for (int e = 0; e < 2; ++e) { cra[e] = __cosf(rid * fa[e]); sra[e] = __sinf(rid * fa[e]); cca[e] = __cosf(cid * fa[e]); sca[e] = __sinf(cid * fa[e]);
                                      crr[e] = __cosf(rid * fr[e]); srr[e] = __sinf(rid * fr[e]); ccr[e] = __cosf(cid * fr[e]); scr2[e] = __sinf(cid * fr[e]); }
        bf16* row = PROJ + (size_t)m * INW; const size_t dd = (size_t)((const char*)PDST - (const char*)PROJ) / 4;
        {
            unsigned* p = (unsigned*)(row + C_QA + (lane >> 3) * 64 + 2 * ja); unsigned w[4]; float y[4][2]; float ss = 0.f;
#pragma unroll
            for (int q = 0; q < 4; ++q) { w[q] = p[q * 8]; y[q][0] = bflo(w[q]); y[q][1] = bfhi(w[q]); ss += y[q][0] * y[q][0] + y[q][1] * y[q][1]; }
            ss += shx<1>(ss); ss += shx<2>(ss); ss += shx<4>(ss);
            const float rs = frsq(ss * (1.f / 64.f) + EPS);
#pragma unroll
            for (int q = 0; q < 4; ++q) { y[q][0] *= rs * gq[q][0]; y[q][1] *= rs * gq[q][1]; }
            rope4(y, cra, sra, cca, sca, attn_body::C2, w);
#pragma unroll
            for (int q = 0; q < 4; ++q) p[dd + q * 8] = w[q];
        }
        {
            const int hk = (lane >> 3) & 1;
            unsigned* p = (unsigned*)(row + C_KA + hk * 64 + 2 * ja); unsigned w[4]; float y[4][2]; float ss = 0.f;
#pragma unroll
            for (int q = 0; q < 4; ++q) { w[q] = p[q * 8]; y[q][0] = bflo(w[q]); y[q][1] = bfhi(w[q]); ss += y[q][0] * y[q][0] + y[q][1] * y[q][1]; }
            ss += shx<1>(ss); ss += shx<2>(ss); ss += shx<4>(ss);
            const float rs = frsq(ss * (1.f / 64.f) + EPS);
#pragma unroll
            for (int q = 0; q < 4; ++q) { y[q][0] *= rs * gk[q][0]; y[q][1] *= rs * gk[q][1]; }
            rope4(y, cra, sra, cca, sca, 1.0f, w);
            if (lane < 16) {
#pragma unroll
                for (int q = 0; q < 4; ++q) p[dd + q * 8] = w[q]; }
        }
#pragma unroll
        for (int which = 0; which < 2; ++which) {
            unsigned* p = (unsigned*)(row + (which ? C_KR : C_QR) + (lane >> 4) * 128 + 2 * jr); unsigned w[4]; float y[4][2];
#pragma unroll
            for (int q = 0; q < 4; ++q) { w[q] = p[q * 16]; y[q][0] = bflo(w[q]); y[q][1] = bfhi(w[q]); }
            rope4(y, crr, srr, ccr, scr2, which ? 0.08838834764831845f : 1.0f, w);
#pragma unroll
            for (int q = 0; q < 4; ++q) p[dd + q * 16] = w[q];
        }
    }
}

__device__ __forceinline__ unsigned off_b(unsigned row, unsigned ch) { return 256u * row + 16u * (ch ^ (((row & 3) << 2) | ((row >> 2) & 3))); }
__device__ __forceinline__ bf16x8 rowread(const LAS unsigned char* tb, int rb, int s, int lane) {
    return *(const LAS bf16x8*)(tb + off_b(32 * rb + (lane & 31), 2 * s + (lane >> 5)));
}
__device__ __forceinline__ bf16x8 trread(const LAS unsigned char* tb, int c, int ks, int lane) {
    const unsigned h = lane >> 5, blk = (lane >> 4) & 1, q = (lane & 15) >> 2, p = lane & 3;
    const unsigned r0 = 16 * ks + 8 * h + q, ch = 4 * c + 2 * blk + (p >> 1);
    const s16x4 lo = __builtin_amdgcn_ds_read_tr16_b64_v4i16((LAS s16x4*)(tb + off_b(r0, ch) + 8 * (p & 1)));
    const s16x4 hi = __builtin_amdgcn_ds_read_tr16_b64_v4i16((LAS s16x4*)(tb + off_b(r0 + 4, ch) + 8 * (p & 1)));
    return (bf16x8){lo[0], lo[1], lo[2], lo[3], hi[0], hi[1], hi[2], hi[3]};
}
__device__ __forceinline__ int crow(int r, int hi) { return (r & 3) + 8 * (r >> 2) + 4 * hi; }
template <int MODE> __device__ __forceinline__ void stage_tile(LAS unsigned char* tb, const bf16* src, int pitch, int tid, float lg) {
#pragma unroll
    for (int i = 0; i < 4; ++i) { const int n = tid + NTHR * i, row = n >> 4, ch = n & 15;
        v4u v = *(const v4u*)(src + (size_t)row * pitch + ch * 8);
        if (MODE != 0) { const float f = fexp2((MODE == 1 ? (float)(127 - row) : (float)row) * lg);
            v.x = pkbf(bflo(v.x) * f, bfhi(v.x) * f); v.y = pkbf(bflo(v.y) * f, bfhi(v.y) * f); v.z = pkbf(bflo(v.z) * f, bfhi(v.z) * f); v.w = pkbf(bflo(v.w) * f, bfhi(v.w) * f); }
        *(LAS v4u*)(tb + off_b(row, ch)) = v; }
}
template <int NOUT> __device__ __forceinline__ void stage_rope_tile(LAS unsigned char* tb0, LAS unsigned char* tb1, const bf16* src, int pitch, int tid, int s0, float scale, float lgf, float lgb) {
    constexpr float L2T = 13.287712379549449f;
#pragma unroll 1
    for (int i2 = 0; i2 < 2; ++i2) { const int n = tid + NTHR * i2, row = n >> 3, cp = n & 7, c0 = (cp & 3) + ((cp >> 2) << 3);
        const bf16* rp = src + (size_t)row * pitch; const v4u va = *(const v4u*)(rp + c0 * 8), vb = *(const v4u*)(rp + (c0 + 4) * 8);
        const int s = s0 + row; const float pos = (cp & 4) ? (float)(s & 63) : (float)(s >> 6);
        const unsigned wa[4] = {va.x, va.y, va.z, va.w}, wb[4] = {vb.x, vb.y, vb.z, vb.w}; float oa[8], ob[8];
#pragma unroll
        for (int j = 0; j < 8; ++j) { const float fr = fexp2(-(float)(8 * (cp & 3) + j) * (L2T / 32.f)), ang = pos * fr, cs = __cosf(ang), sn = __sinf(ang);
            const float a = (j & 1) ? bfhi(wa[j >> 1]) : bflo(wa[j >> 1]), b = (j & 1) ? bfhi(wb[j >> 1]) : bflo(wb[j >> 1]);
            oa[j] = (a * cs - b * sn) * scale; ob[j] = (b * cs + a * sn) * scale; }
        if (NOUT == 1) {
            *(LAS v4u*)(tb0 + off_b(row, c0)) = (v4u){pkbf(oa[0], oa[1]), pkbf(oa[2], oa[3]), pkbf(oa[4], oa[5]), pkbf(oa[6], oa[7])};
            *(LAS v4u*)(tb0 + off_b(row, c0 + 4)) = (v4u){pkbf(ob[0], ob[1]), pkbf(ob[2], ob[3]), pkbf(ob[4], ob[5]), pkbf(ob[6], ob[7])};
        } else {
            const float ff = fexp2((float)(127 - row) * lgf), fb = fexp2((float)row * lgb);
            *(LAS v4u*)(tb0 + off_b(row, c0)) = (v4u){pkbf(oa[0] * ff, oa[1] * ff), pkbf(oa[2] * ff, oa[3] * ff), pkbf(oa[4] * ff, oa[5] * ff), pkbf(oa[6] * ff, oa[7] * ff)};
            *(LAS v4u*)(tb0 + off_b(row, c0 + 4)) = (v4u){pkbf(ob[0] * ff, ob[1] * ff), pkbf(ob[2] * ff, ob[3] * ff), pkbf(ob[4] * ff, ob[5] * ff), pkbf(ob[6] * ff, ob[7] * ff)};
            *(LAS v4u*)(tb1 + off_b(row, c0)) = (v4u){pkbf(oa[0] * fb, oa[1] * fb), pkbf(oa[2] * fb, oa[3] * fb), pkbf(oa[4] * fb, oa[5] * fb), pkbf(oa[6] * fb, oa[7] * fb)};
            *(LAS v4u*)(tb1 + off_b(row, c0 + 4)) = (v4u){pkbf(ob[0] * fb, ob[1] * fb), pkbf(ob[2] * fb, ob[3] * fb), pkbf(ob[4] * fb, ob[5] * fb), pkbf(ob[6] * fb, ob[7] * fb)};
        } }
}
__device__ __forceinline__ void rope_load(v4u (&raw)[2][2], const bf16* src, int pitch, int tid) {
#pragma unroll
    for (int i2 = 0; i2 < 2; ++i2) { const int n = tid + NTHR * i2, row = n >> 3, cp = n & 7, c0 = (cp & 3) + ((cp >> 2) << 3);
        const bf16* rp = src + (size_t)row * pitch; raw[i2][0] = *(const v4u*)(rp + c0 * 8); raw[i2][1] = *(const v4u*)(rp + (c0 + 4) * 8); }
}
template <int NOUT> __device__ __forceinline__ void rope_store(LAS unsigned char* tb0, LAS unsigned char* tb1, const v4u (&raw)[2][2], int tid, int s0, float scale, float lgf, float lgb) {
    constexpr float L2T = 13.287712379549449f;
#pragma unroll
    for (int i2 = 0; i2 < 2; ++i2) { __builtin_amdgcn_sched_barrier(0);
        const int n = tid + NTHR * i2, row = n >> 3, cp = n & 7, c0 = (cp & 3) + ((cp >> 2) << 3);
        const v4u va = raw[i2][0], vb = raw[i2][1];
        const int s = s0 + row; const float pos = (cp & 4) ? (float)(s & 63) : (float)(s >> 6);
        const unsigned wa[4] = {va.x, va.y, va.z, va.w}, wb[4] = {vb.x, vb.y, vb.z, vb.w}; float oa[8], ob[8];
#pragma unroll
        for (int j = 0; j < 8; ++j) { const float fr = fexp2(-(float)(8 * (cp & 3) + j) * (L2T / 32.f)), ang = pos * fr, cs = __cosf(ang), sn = __sinf(ang);
            const float a = (j & 1) ? bfhi(wa[j >> 1]) : bflo(wa[j >> 1]), b = (j & 1) ? bfhi(wb[j >> 1]) : bflo(wb[j >> 1]);
            oa[j] = (a * cs - b * sn) * scale; ob[j] = (b * cs + a * sn) * scale; }
        if (NOUT == 1) {
            *(LAS v4u*)(tb0 + off_b(row, c0)) = (v4u){pkbf(oa[0], oa[1]), pkbf(oa[2], oa[3]), pkbf(oa[4], oa[5]), pkbf(oa[6], oa[7])};
            *(LAS v4u*)(tb0 + off_b(row, c0 + 4)) = (v4u){pkbf(ob[0], ob[1]), pkbf(ob[2], ob[3]), pkbf(ob[4], ob[5]), pkbf(ob[6], ob[7])};
        } else {
            const float ff = fexp2((float)(127 - row) * lgf), fb = fexp2((float)row * lgb);
            *(LAS v4u*)(tb0 + off_b(row, c0)) = (v4u){pkbf(oa[0] * ff, oa[1] * ff), pkbf(oa[2] * ff, oa[3] * ff), pkbf(oa[4] * ff, oa[5] * ff), pkbf(oa[6] * ff, oa[7] * ff)};
            *(LAS v4u*)(tb0 + off_b(row, c0 + 4)) = (v4u){pkbf(ob[0] * ff, ob[1] * ff), pkbf(ob[2] * ff, ob[3] * ff), pkbf(ob[4] * ff, ob[5] * ff), pkbf(ob[6] * ff, ob[7] * ff)};
            *(LAS v4u*)(tb1 + off_b(row, c0)) = (v4u){pkbf(oa[0] * fb, oa[1] * fb), pkbf(oa[2] * fb, oa[3] * fb), pkbf(oa[4] * fb, oa[5] * fb), pkbf(oa[6] * fb, oa[7] * fb)};
            *(LAS v4u*)(tb1 + off_b(row, c0 + 4)) = (v4u){pkbf(ob[0] * fb, ob[1] * fb), pkbf(ob[2] * fb, ob[3] * fb), pkbf(ob[4] * fb, ob[5] * fb), pkbf(ob[6] * fb, ob[7] * fb)};
        } }
}
__device__ __forceinline__ void vtile_load(v4u (&raw)[4], const bf16* src, int pitch, int tid) {
#pragma unroll
    for (int i = 0; i < 4; ++i) { const int n = tid + NTHR * i, row = n >> 4, ch = n & 15; raw[i] = *(const v4u*)(src + (size_t)row * pitch + ch * 8); }
}
__device__ __forceinline__ void vtile_store(LAS unsigned char* tb, const v4u (&raw)[4], int tid) {
#pragma unroll
    for (int i = 0; i < 4; ++i) { const int n = tid + NTHR * i, row = n >> 4, ch = n & 15; *(LAS v4u*)(tb + off_b(row, ch)) = raw[i]; }
}
__device__ __forceinline__ void r1_states(Frame& F, const bf16* PROJ, bf16* U, const float* dec_f, const float* dec_b) {
    LAS unsigned char* TKf = F.lds, *TKb = F.lds + 32768, *TV = F.lds + 65536;
    const int lane = F.lane, w = F.wave, hi = lane >> 5, mb = w & 3, nb0 = 2 * (w >> 2);
    for (int u = F.vcu; u < RUNITS; u += F.G) {
        const int b = u >> 8, h = (u >> 6) & 3, c = u & 63;
        const float lgf = dec_f[h] * LOG2E, lgb = dec_b[h] * LOG2E;
        const bf16* base = PROJ + ((size_t)b * T + (size_t)c * RCH) * INW + h * 128;
        { v4u rk[2][2], rv[4]; rope_load(rk, base + C_KR, INW, F.tid); vtile_load(rv, base + C_VR, INW, F.tid);
          rope_store<2>(TKf, TKb, rk, F.tid, c * RCH, 0.08838834764831845f, lgf, lgb);
          vtile_store(TV, rv, F.tid); }
        __syncthreads();
        f32x16 acc[2][2];
#pragma unroll
        for (int d = 0; d < 2; ++d)
#pragma unroll
            for (int n = 0; n < 2; ++n) acc[d][n] = (f32x16){};
#pragma unroll 2
        for (int ks = 0; ks < 8; ++ks) {
            const bf16x8 a = trread(TV, mb, ks, lane);
#pragma unroll
            for (int n = 0; n < 2; ++n) { const bf16x8 bf = trread(TKf, nb0 + n, ks, lane), bb = trread(TKb, nb0 + n, ks, lane);
                acc[0][n] = __builtin_amdgcn_mfma_f32_32x32x16_bf16(bf, a, acc[0][n], 0, 0, 0);
                acc[1][n] = __builtin_amdgcn_mfma_f32_32x32x16_bf16(bb, a, acc[1][n], 0, 0, 0); }
        }
#pragma unroll
        for (int d = 0; d < 2; ++d)
#pragma unroll
            for (int n = 0; n < 2; ++n) { bf16* o = U + ((size_t)u * 2 + d) * 16384 + (size_t)(32 * mb + (lane & 31)) * 128 + 32 * (nb0 + n) + 4 * hi;
#pragma unroll
                for (int g = 0; g < 4; ++g) { u32x2 w; w.x = pkbf(acc[d][n][4 * g], acc[d][n][4 * g + 1]); w.y = pkbf(acc[d][n][4 * g + 2], acc[d][n][4 * g + 3]); *(u32x2*)(o + 8 * g) = w; } }
        __syncthreads();
    }
}
__device__ __forceinline__ void r2_scan(Frame& F, const bf16* __restrict__ U, bf16* __restrict__ FT, const float* dec_f, const float* dec_b) {
    for (int task = blockIdx.x * NTHR + F.tid; task < BATCH * RH * 4096; task += F.G * NTHR) {
        const int bh = task >> 12, e4 = task & 4095, h = bh & 3;
        const float df = __expf(dec_f[h] * 128.f), db = __expf(dec_b[h] * 128.f);
        const size_t base = ((size_t)bh * NCH * 2) * 16384 + 4 * e4;
#define R2_LOAD(BUF, c0, DIR, STEP) do { _Pragma("unroll") for (int k = 0; k < 8; ++k) BUF[k] = *(const u32x2*)(U + base + ((size_t)((c0) + (STEP) * k) * 2 + (DIR)) * 16384); } while (0)
#define R2_PROC(BUF, c0, DIR, STEP, DEC) do { _Pragma("unroll") for (int k = 0; k < 8; ++k) { u32x2 w; w.x = pkbf(s.x, s.y); w.y = pkbf(s.z, s.w); \
            *(u32x2*)(FT + base + ((size_t)((c0) + (STEP) * k) * 2 + (DIR)) * 16384) = w; const u32x2 uw = BUF[k]; s = s * (DEC) + (f32x4){bflo(uw.x), bfhi(uw.x), bflo(uw.y), bfhi(uw.y)}; } } while (0)
        u32x2 bA[8], bB[8];
        f32x4 s = (f32x4){0.f, 0.f, 0.f, 0.f};
        R2_LOAD(bA, 0, 0, 1);
#pragma unroll 1
        for (int c0 = 0; c0 < NCH; c0 += 16) {
            R2_LOAD(bB, c0 + 8, 0, 1);
            R2_PROC(bA, c0, 0, 1, df);
            if (c0 + 16 < NCH) R2_LOAD(bA, c0 + 16, 0, 1);
            R2_PROC(bB, c0 + 8, 0, 1, df);
        }
        s = (f32x4){0.f, 0.f, 0.f, 0.f};
        R2_LOAD(bA, NCH - 1, 1, -1);
#pragma unroll 1
        for (int c0 = NCH - 1; c0 >= 0; c0 -= 16) {
            R2_LOAD(bB, c0 - 8, 1, -1);
            R2_PROC(bA, c0, 1, -1, db);
            if (c0 - 16 >= 0) R2_LOAD(bA, c0 - 16, 1, -1);
            R2_PROC(bB, c0 - 8, 1, -1, db);
        }
#undef R2_LOAD
#undef R2_PROC
    }
}
__device__ __forceinline__ void r3_out(Frame& F, const bf16* PROJ, const bf16* FT, bf16* CAT, const float* dec_f, const float* dec_b, const float* gn_g, const float* gn_b) {
    LAS unsigned char* TQ = F.lds, *TK = F.lds + 32768, *TV = F.lds + 65536, *TP = F.lds + 98304;
    LAS float* OT = (LAS float*)F.lds;
    const int w = F.wave, wb = w & 3, wp0 = 2 * (w >> 2);
    for (int u = F.vcu; u < RUNITS; u += F.G) {
        int lane = F.lane, tid_u = F.tid; asm volatile("" : "+v"(lane), "+v"(tid_u));
        const int hi = lane >> 5, l31 = lane & 31;
        const int b = u >> 8, h = (u >> 6) & 3, c = u & 63;
        const float lgf = dec_f[h] * LOG2E, lgb = dec_b[h] * LOG2E;
        const size_t m0 = (size_t)b * T + (size_t)c * RCH;
        const bf16* base = PROJ + m0 * INW + h * 128;
        const int gi = tid_u >> 2, gqd = tid_u & 3, gcol = h * 128 + 32 * gqd;
        const bf16* gp = PROJ + (m0 + gi) * INW + C_GR + gcol;
        v4u gw[4];
#pragma unroll
        for (int k2 = 0; k2 < 4; ++k2) gw[k2] = *(const v4u*)(gp + 8 * k2);
        bf16x8 cf[4][2], cb[4][2];
        const bf16* ftf = FT + ((size_t)u * 2 + 0) * 16384 + (size_t)(32 * wp0 + l31) * 128 + 8 * hi;
#pragma unroll
        for (int s = 0; s < 4; ++s)
#pragma unroll
            for (int n = 0; n < 2; ++n) { cf[s][n] = *(const bf16x8*)(ftf + n * 32 * 128 + 16 * s); cb[s][n] = *(const bf16x8*)(ftf + 16384 + n * 32 * 128 + 16 * s); }
        { v4u rq[2][2], rk[2][2], rv[4];
          rope_load(rq, base + C_QR, INW, tid_u); rope_load(rk, base + C_KR, INW, tid_u); vtile_load(rv, base + C_VR, INW, tid_u);
          __builtin_amdgcn_sched_barrier(0);
          rope_store<1>(TQ, TQ, rq, tid_u, c * RCH, 1.0f, 0.f, 0.f);
          rope_store<1>(TK, TK, rk, tid_u, c * RCH, 0.08838834764831845f, 0.f, 0.f);
          __builtin_amdgcn_sched_barrier(0);
          vtile_store(TV, rv, tid_u); }
        __syncthreads();
        {
            f32x16 st[2]; st[0] = (f32x16){}; st[1] = (f32x16){};
#pragma unroll 1
            for (int s = 0; s < 8; ++s) { const bf16x8 a = rowread(TK, wb, s, lane);
#pragma unroll
                for (int n = 0; n < 2; ++n) st[n] = __builtin_amdgcn_mfma_f32_32x32x16_bf16(a, rowread(TQ, wp0 + n, s, lane), st[n], 0, 0, 0); }
#pragma unroll
            for (int n = 0; n < 2; ++n) { const int i = 32 * (wp0 + n) + l31; __builtin_amdgcn_sched_barrier(0);
#pragma unroll
                for (int g = 0; g < 4; ++g) { float p[4];
#pragma unroll
                    for (int q = 0; q < 4; ++q) { const int j = 32 * wb + 8 * g + 4 * hi + q; const float fd = (float)(i - j);
                        const float mk = fexp2(fmaxf(fd, 0.f) * lgf + fmaxf(-fd, 0.f) * lgb) + fmaxf(1.0f - fabsf(fd), 0.f);
                        p[q] = st[n][4 * g + q] * mk; }
                    u32x2 pw; pw.x = pkbf(p[0], p[1]); pw.y = pkbf(p[2], p[3]);
                    *(LAS u32x2*)(TP + off_b(i, 4 * wb + g) + 8 * hi) = pw; } }
        }
        __syncthreads();
        f32x16 ao[2];
#pragma unroll
        for (int n = 0; n < 2; ++n) ao[n] = (f32x16){};
        {
            const float xf = fexp2((float)(32 * wb + l31 + 1) * lgf), xb = fexp2((float)(128 - 32 * wb - l31) * lgb);
#pragma unroll
            for (int s = 0; s < 8; ++s) { __builtin_amdgcn_sched_barrier(0); const bf16x8 ap = rowread(TP, wb, s, lane); const v4u aq = *(const LAS v4u*)(TQ + off_b(32 * wb + l31, 2 * s + hi));
                v4u qf, qb;
                qf.x = pkbf(bflo(aq.x) * xf, bfhi(aq.x) * xf); qf.y = pkbf(bflo(aq.y) * xf, bfhi(aq.y) * xf); qf.z = pkbf(bflo(aq.z) * xf, bfhi(aq.z) * xf); qf.w = pkbf(bflo(aq.w) * xf, bfhi(aq.w) * xf);
                qb.x = pkbf(bflo(aq.x) * xb, bfhi(aq.x) * xb); qb.y = pkbf(bflo(aq.y) * xb, bfhi(aq.y) * xb); qb.z = pkbf(bflo(aq.z) * xb, bfhi(aq.z) * xb); qb.w = pkbf(bflo(aq.w) * xb, bfhi(aq.w) * xb);
                const bf16x8 aqf = __builtin_bit_cast(bf16x8, qf), aqb = __builtin_bit_cast(bf16x8, qb);
#pragma unroll
                for (int n = 0; n < 2; ++n) {
                    ao[n] = __builtin_amdgcn_mfma_f32_32x32x16_bf16(ap, trread(TV, wp0 + n, s, lane), ao[n], 0, 0, 0);
                    ao[n] = __builtin_amdgcn_mfma_f32_32x32x16_bf16(aqf, cf[s & 3][n], ao[n], 0, 0, 0);
                    ao[n] = __builtin_amdgcn_mfma_f32_32x32x16_bf16(aqb, cb[s & 3][n], ao[n], 0, 0, 0); }
                if (s < 4) {
#pragma unroll
                    for (int n = 0; n < 2; ++n) { cf[s][n] = *(const bf16x8*)(ftf + n * 32 * 128 + 16 * (s + 4)); cb[s][n] = *(const bf16x8*)(ftf + 16384 + n * 32 * 128 + 16 * (s + 4)); } } }
        }
        __syncthreads();
#pragma unroll
        for (int r = 0; r < 16; ++r) { const int i = 32 * wb + crow(r, hi);
#pragma unroll
            for (int n = 0; n < 2; ++n) OT[i * 132 + 32 * (wp0 + n) + l31] = ao[n][r]; }
        __syncthreads();
        {
            const int i = tid_u >> 2, qd = tid_u & 3;
            f32x4 v[8]; float s1 = 0.f, s2 = 0.f;
#pragma unroll
            for (int k = 0; k < 8; ++k) { v[k] = *(const LAS f32x4*)(OT + i * 132 + 32 * qd + 4 * k); s1 += (v[k].x + v[k].y) + (v[k].z + v[k].w);
                s2 += (v[k].x * v[k].x + v[k].y * v[k].y) + (v[k].z * v[k].z + v[k].w * v[k].w); }
            s1 += shx<1>(s1); s1 += shx<2>(s1); s2 += shx<1>(s2); s2 += shx<2>(s2);
            const float mu = s1 * (1.f / 128.f), var = fmaxf(s2 * (1.f / 128.f) - mu * mu, 0.f), rs = frsq(var + EPS);
            const int col = h * 128 + 32 * qd;
            unsigned char* op = (unsigned char*)CAT + (m0 + i) * D + 512 + col;
            f32x4 gg[8], gbv[8];
#pragma unroll
            for (int k = 0; k < 8; ++k) { gg[k] = *(const f32x4*)(gn_g + col + 4 * k); gbv[k] = *(const f32x4*)(gn_b + col + 4 * k); }
#pragma unroll
            for (int k2 = 0; k2 < 4; ++k2) { __builtin_amdgcn_sched_barrier(0); const v4u gw4 = gw[k2]; const unsigned gwv[4] = {gw4.x, gw4.y, gw4.z, gw4.w}; float o[8];
#pragma unroll
                for (int q = 0; q < 8; ++q) { const int cc = 8 * k2 + q; const float x = v[cc >> 2][cc & 3];
                    const float y = (x - mu) * rs * gg[cc >> 2][cc & 3] + gbv[cc >> 2][cc & 3];
                    const float gt = (q & 1) ? bfhi(gwv[q >> 1]) : bflo(gwv[q >> 1]);
                    o[q] = y * gt * frcp(1.0f + __expf(-gt)); }
#pragma unroll
                for (int q = 0; q < 8; ++q) o[q] = __builtin_amdgcn_fmed3f(o[q] * CAT_S_RET, -448.0f, 448.0f);
                unsigned w0 = 0u, w1 = 0u;
                w0 = __builtin_amdgcn_cvt_pk_fp8_f32(o[0], o[1], w0, false); w0 = __builtin_amdgcn_cvt_pk_fp8_f32(o[2], o[3], w0, true);
                w1 = __builtin_amdgcn_cvt_pk_fp8_f32(o[4], o[5], w1, false); w1 = __builtin_amdgcn_cvt_pk_fp8_f32(o[6], o[7], w1, true);
                *(u32x2*)(op + 8 * k2) = (u32x2){w0, w1}; }
        }
        __syncthreads();
    }
}

#if defined(ATTN_PROBE)
__device__ __forceinline__ void attn_check(Frame& F, const bf16* PROJ, const bf16* CAT, gu32* flag, const float* qg) {
    const int lane = F.lane, s = F.vcu * NWAVES + F.wave;
    const int b = s & 7, h = (s >> 3) & 7, qpos = (s * 977 + 131) & (T - 1), kvh = h >> 2;
    const bf16* qrow = PROJ + ((size_t)b * T + qpos) * INW + C_QA + h * 64;
    float qf[64], o[64];
    {
        const float raw = __uint_as_float((unsigned)qrow[lane] << 16);
        const float ss = wave_sum(raw * raw), y = raw * (1.0f / sqrtf(ss * (1.f / 64.f) + 1e-6f)) * qg[lane];
        const int quarter = lane >> 4, i = lane & 15; const float partner = shx<16>(y);
        const float invf = exp2f(-(float)i * (13.287712379549449f / 16.f)), ang = ((quarter < 2) ? (float)(qpos >> 6) : (float)(qpos & 63)) * invf;
        const float cs = __cosf(ang), sn = __sinf(ang);
        const float rot = (quarter & 1) ? (y * cs + partner * sn) : (y * cs - partner * sn);
        const float qv = rot * (0.125f * 1.4426950408889634f);
#pragma unroll
        for (int d = 0; d < 64; ++d) qf[d] = __int_as_float(bcastl(__float_as_int(qv), d));
    }
#pragma unroll
    for (int d = 0; d < 64; ++d) o[d] = 0.f;
    float m = -1e30f, l = 0.f;
    for (int i = 0; i < T / 64; ++i) {
        const size_t krow = ((size_t)b * T + i * 64 + lane) * INW;
        const bf16* kp = PROJ + krow + C_KA + kvh * 64; const bf16* vp = PROJ + krow + C_VA + kvh * 64;
        float sc = 0.f;
#pragma unroll
        for (int c = 0; c < 8; ++c) { const v4u w = *(const v4u*)(kp + 8 * c);
            sc += qf[8 * c + 0] * bflo(w.x) + qf[8 * c + 1] * bfhi(w.x) + qf[8 * c + 2] * bflo(w.y) + qf[8 * c + 3] * bfhi(w.y) + qf[8 * c + 4] * bflo(w.z) + qf[8 * c + 5] * bfhi(w.z) + qf[8 * c + 6] * bflo(w.w) + qf[8 * c + 7] * bfhi(w.w); }
        const float mn = fmaxf(m, sc), fs = fexp2(m - mn), p = fexp2(sc - mn);
        l = l * fs + p; m = mn;
#pragma unroll
        for (int c = 0; c < 8; ++c) { const v4u w = *(const v4u*)(vp + 8 * c);
            o[8 * c + 0] = o[8 * c + 0] * fs + p * bflo(w.x); o[8 * c + 1] = o[8 * c + 1] * fs + p * bfhi(w.x); o[8 * c + 2] = o[8 * c + 2] * fs + p * bflo(w.y); o[8 * c + 3] = o[8 * c + 3] * fs + p * bfhi(w.y);
            o[8 * c + 4] = o[8 * c + 4] * fs + p * bflo(w.z); o[8 * c + 5] = o[8 * c + 5] * fs + p * bfhi(w.z); o[8 * c + 6] = o[8 * c + 6] * fs + p * bflo(w.w); o[8 * c + 7] = o[8 * c + 7] * fs + p * bfhi(w.w); }
    }
    float mm = m;
    mm = wmax64(mm);
    const float f = fexp2(m - mm); const float L = wave_sum(l * f);
    float mine = 0.f;
#pragma unroll
    for (int d = 0; d < 64; ++d) { const float od = wave_sum(o[d] * f) / L; if (lane == d) mine = od; }
    const unsigned short cw = CAT[((size_t)b * T + qpos) * D + h * 64 + lane];
    const float got = __uint_as_float((unsigned)cw << 16);
    const float E = wave_sum((mine - got) * (mine - got)), R = wave_sum(mine * mine);
    if (!(E <= 4e-4f * R) && lane == 0) __hip_atomic_store(flag, 1u, RLX_AGENT);
}
__device__ __forceinline__ void ka_expect(Frame& F, const bf16* PROJ, float* EXP, const float* kg) {
    const int lane = F.lane, s = F.vcu * NWAVES + F.wave, m = (s * 40503 + 77) & (M - 1), pos = m & (T - 1);
    for (int hk = 0; hk < 2; ++hk) {
        const float raw = __uint_as_float((unsigned)PROJ[(size_t)m * INW + C_KA + hk * 64 + lane] << 16);
        const float ss = wave_sum(raw * raw), y = raw * (1.0f / sqrtf(ss * (1.f / 64.f) + 1e-6f)) * kg[lane];
        const int quarter = lane >> 4, i = lane & 15; const float partner = shx<16>(y);
        const float invf = exp2f(-(float)i * (13.287712379549449f / 16.f)), ang = ((quarter < 2) ? (float)(pos >> 6) : (float)(pos & 63)) * invf;
        const float cs = __cosf(ang), sn = __sinf(ang);
        EXP[(size_t)s * 128 + hk * 64 + lane] = (quarter & 1) ? (y * cs + partner * sn) : (y * cs - partner * sn);
    }
}
__device__ __forceinline__ void ka_compare(Frame& F, const bf16* PROJ, const float* EXP, gu32* flag) {
    const int lane = F.lane, s = F.vcu * NWAVES + F.wave, m = (s * 40503 + 77) & (M - 1);
    float E = 0.f, R = 0.f;
    for (int hk = 0; hk < 2; ++hk) { const float got = __uint_as_float((unsigned)PROJ[(size_t)m * INW + C_KA + hk * 64 + lane] << 16), ex = EXP[(size_t)s * 128 + hk * 64 + lane];
        E += (got - ex) * (got - ex); R += ex * ex; }
    E = wave_sum(E); R = wave_sum(R);
    if (!(E <= 1e-4f * R) && lane == 0) __hip_atomic_store(flag, 1u, RLX_AGENT);
}
#endif

typedef _Float16 f16x8 __attribute__((ext_vector_type(8)));
typedef _Float16 f16x4 __attribute__((ext_vector_type(4)));
template <bool X16, bool XIN16 = false> __device__ __forceinline__ void p3b_postmix(Frame& F, const float* xin, float* xout, const bf16* YM, signed char* HQ, float* hs, const float* mod_l,
                                            const float* post_g, const float* pre_g, const float* rw, const float* rb, int* topi, float* topw, gu32* cnt_g) {
    const int lane = F.lane, gw = F.vcu * NWAVES + F.wave, NGW = F.G * NWAVES;
    LAS unsigned char* WT = F.lds;
    LAS unsigned char* AT = F.lds + 65536 + F.wave * 8192;
    LAS unsigned* lcnt = (LAS unsigned*)(F.lds + LCNT_OFF);
#pragma unroll
    for (int i = 0; i < 16; ++i) { const int n = F.tid + NTHR * i, k = n >> 3, e0 = (n & 7) * 4; const f32x4 v = *(const f32x4*)(rw + (size_t)k * NE + e0);
#pragma unroll
        for (int q = 0; q < 4; ++q) { const int e = e0 + q; *(LAS _Float16*)(WT + e * 2048 + (((k >> 3) ^ (e & 15)) << 4) + (k & 7) * 2) = (_Float16)v[q]; } }
    if (F.tid < 32) lcnt[F.tid] = 0u;
    LAS float* GL = (LAS float*)(F.lds + GAIN_OFF);
    { const f32x4 g0 = ((const f32x4*)post_g)[F.tid & 255], g1 = ((const f32x4*)pre_g)[F.tid & 255]; if (F.tid < 256) { ((LAS f32x4*)GL)[F.tid] = g0; ((LAS f32x4*)(GL + D))[F.tid] = g1; } }
    __syncthreads();
    const float rbias = rb[lane & 31];
    const int ar = lane & 3, kg = lane >> 4, be = lane & 15;
    for (int ch = gw; ch < M / 32; ch += NGW) { const int mb = ch * 32;
        const float* modb = mod_l + (size_t)(mb >> 13) * (6 * D);
        f32x4 gpv[4], gsv[4], shv[4];
#pragma unroll
        for (int j = 0; j < 4; ++j) { const f32x4 gm = ((const f32x4*)(modb + 2 * D))[lane + 64 * j], sc = ((const f32x4*)(modb + 4 * D))[lane + 64 * j]; shv[j] = ((const f32x4*)(modb + 3 * D))[lane + 64 * j];
            gpv[j] = gm * ((const LAS f32x4*)GL)[lane + 64 * j]; gsv[j] = ((const LAS f32x4*)(GL + D))[lane + 64 * j] * (sc + 1.0f); }
        u32x2 ywA[2][4], ywB[2][4]; f32x4 xrA[2][4], xrB[2][4];
#define P3B_ISSUE(YW, XR, t0) do { _Pragma("unroll") for (int rr = 0; rr < 2; ++rr) { const u32x2* yr = (const u32x2*)(YM + (size_t)(mb + (t0) + rr) * D) + lane; \
            _Pragma("unroll") for (int j = 0; j < 4; ++j) YW[rr][j] = yr[64 * j]; \
            if constexpr (XIN16) { const u32x2* xq = (const u32x2*)((const bf16*)xin + (size_t)(mb + (t0) + rr) * D) + lane; _Pragma("unroll") for (int j = 0; j < 4; ++j) { const u32x2 w = xq[64 * j]; XR[rr][j].x = __uint_as_float(w.x); XR[rr][j].y = __uint_as_float(w.y); } } \
            else load_row_f32_nt(xin + (size_t)(mb + (t0) + rr) * D, XR[rr], lane); } } while (0)
#define P3B_PROC(YW, XR, t0, RB) do { _Pragma("unroll") for (int rr = 0; rr < 2; ++rr) { const int m = mb + (t0) + rr, r = (RB) + rr; \
            f32x4 y[4], x[4], hf[4]; \
            _Pragma("unroll") for (int j = 0; j < 4; ++j) { const u32x2 w = YW[rr][j]; y[j] = (f32x4){bflo(w.x), bfhi(w.x), bflo(w.y), bfhi(w.y)}; \
                if constexpr (XIN16) { const unsigned xa = __float_as_uint(XR[rr][j].x), xb = __float_as_uint(XR[rr][j].y); x[j] = (f32x4){bflo(xa), bfhi(xa), bflo(xb), bfhi(xb)}; } else x[j] = XR[rr][j]; } \
            const float rsy = row_rstd(y); \
            _Pragma("unroll") for (int j = 0; j < 4; ++j) { x[j] = x[j] + gpv[j] * (y[j] * rsy); if constexpr (!X16) ((f32x4*)(xout + (size_t)m * D))[lane + 64 * j] = x[j]; } \
            if constexpr (X16) store_row_bf16((bf16*)xout + (size_t)m * D, x, lane); \
            { const float rs = row_rstd(x); _Pragma("unroll") for (int j = 0; j < 4; ++j) hf[j] = x[j] * rs * gsv[j] + shv[j]; } \
            store_row_i8(HQ + (size_t)m * D, hs + m, hf, lane);                    \
            _Pragma("unroll") for (int j = 0; j < 4; ++j) { const int c = (lane >> 1) + 32 * j;        \
                *(LAS f16x4*)(AT + r * 2048 + ((c ^ (r << 2)) << 4) + 8 * (lane & 1)) = (f16x4){(_Float16)hf[j].x, (_Float16)hf[j].y, (_Float16)hf[j].z, (_Float16)hf[j].w}; } } } while (0)
        P3B_ISSUE(ywA, xrA, 0);
#pragma unroll 1
        for (int it = 0; it < 8; ++it) { const int m0 = mb + 4 * it;
        P3B_ISSUE(ywB, xrB, 4 * it + 2);
        P3B_PROC(ywA, xrA, 4 * it, 0);
        if (it < 7) P3B_ISSUE(ywA, xrA, 4 * it + 4);
        P3B_PROC(ywB, xrB, 4 * it + 2, 2);
        f32x4 la = (f32x4){0.f, 0.f, 0.f, 0.f}, lb = (f32x4){0.f, 0.f, 0.f, 0.f};
#pragma unroll 8
        for (int s = 0; s < 32; ++s) { const int c = 4 * s + kg;
            const f16x8 a = *(const LAS f16x8*)(AT + ar * 2048 + ((c ^ (ar << 2)) << 4));
            const f16x8 b0 = *(const LAS f16x8*)(WT + be * 2048 + ((c ^ be) << 4)), b1 = *(const LAS f16x8*)(WT + (16 + be) * 2048 + ((c ^ be) << 4));
            la = __builtin_amdgcn_mfma_f32_16x16x32_f16(a, b0, la, 0, 0, 0); lb = __builtin_amdgcn_mfma_f32_16x16x32_f16(a, b1, lb, 0, 0, 0); }
        const bool upper = (lane & 32) != 0, blk = (lane & 16) != 0;
#pragma unroll
        for (int pr = 0; pr < 2; ++pr) {
            const float lo_ = blk ? lb[pr] : la[pr], up_ = blk ? lb[pr + 2] : la[pr + 2];
            const float logit = (upper ? up_ : lo_) + rbias;
            const int m = m0 + pr + (upper ? 2 : 0);
            bool taken = false; float tv[TOPK]; int ti[TOPK];
#pragma unroll
            for (int k = 0; k < TOPK; ++k) { float bv = taken ? -INFINITY : logit; int bi = lane & 31;
#define MX_STEP(o) { const float ov = shx<(o)>(bv); const int oi = shxi<(o)>(bi); const bool tk = (ov > bv) || (ov == bv && oi < bi); bv = tk ? ov : bv; bi = tk ? oi : bi; }
                MX_STEP(16) MX_STEP(8) MX_STEP(4) MX_STEP(2) MX_STEP(1)
#undef MX_STEP
                tv[k] = bv; ti[k] = bi; if ((lane & 31) == bi) taken = true; }
            const float e1 = __expf(tv[1] - tv[0]), e2 = __expf(tv[2] - tv[0]), e3 = __expf(tv[3] - tv[0]), inv = frcp(1.0f + e1 + e2 + e3);
            if ((lane & 31) == 0) { *(i32x4*)(topi + (size_t)m * 4) = (i32x4){ti[0], ti[1], ti[2], ti[3]}; *(f32x4*)(topw + (size_t)m * 4) = (f32x4){inv, e1 * inv, e2 * inv, e3 * inv}; }
            if (taken) atomicAdd((unsigned*)(lcnt + (lane & 31)), 1u);
        }
        }
#undef P3B_ISSUE
#undef P3B_PROC
    }
    __syncthreads();
    if (F.tid < 32) { const unsigned c = lcnt[F.tid]; if (c) __hip_atomic_fetch_add(cnt_g + F.tid, c, RLX_AGENT); }
}
__device__ __forceinline__ void p4a_route(Frame& F, const float* hs, int* rmap, float* xsc, const int* topi, int* pos, gu32* cnt_g, gu32* cur_g) {
    const int gw = F.vcu * NWAVES + F.wave, NGW = F.G * NWAVES;
    LAS int* ts = (LAS int*)(F.lds + LTS_OFF);
    if (F.wave == 0) { LAS int* tmp = (LAS int*)(F.lds + LCNT_OFF); const int ln = F.lane;
        if (ln < NE) tmp[ln] = (int)((__hip_atomic_load(cnt_g + ln, RLX_AGENT) + 255u) >> 8);
        LDS_WAIT();
        if (ln <= NE) { int acc_ = 0; for (int k = 0; k < NE; ++k) acc_ += (k < ln) ? tmp[k] : 0; ts[ln] = acc_; } }
    __syncthreads();
    const int lane = F.lane;
    if (gw < NE) {
        const int c = (int)__hip_atomic_load(cnt_g + gw, RLX_AGENT), p0 = ts[gw] * 256 + c, p1 = ts[gw + 1] * 256;
        for (int p = p0 + lane; p < p1; p += 64) rmap[p] = 0;
    }
    for (int base = gw * 64; base < M; base += NGW * 64) {
        const int tok = base + lane; const i32x4 id = *(const i32x4*)(topi + (size_t)tok * 4);
        unsigned mycnt = 0u;
#pragma unroll 1
        for (int e = 0; e < NE; ++e) { const unsigned long long mk = __ballot(id.x == e || id.y == e || id.z == e || id.w == e); if (lane == e) mycnt = (unsigned)__popcll(mk); }
        unsigned mybase = 0u;
        if (lane < NE && mycnt) mybase = __hip_atomic_fetch_add(cur_g + lane, mycnt, RLX_AGENT);
        i32x4 ps = (i32x4){0, 0, 0, 0};
#pragma unroll 1
        for (int e = 0; e < NE; ++e) { const bool has = (id.x == e || id.y == e || id.z == e || id.w == e); const unsigned long long mk = __ballot(has);
            const int p = ts[e] * 256 + bcastl((int)mybase, e) + (int)__builtin_amdgcn_mbcnt_hi((unsigned)(mk >> 32), __builtin_amdgcn_mbcnt_lo((unsigned)mk, 0u));
            if (id.x == e) ps.x = p; if (id.y == e) ps.y = p; if (id.z == e) ps.z = p; if (id.w == e) ps.w = p; }
        *(i32x4*)(pos + (size_t)tok * 4) = ps;
        { const float sc = hs[tok]; xsc[ps.x] = sc; xsc[ps.y] = sc; xsc[ps.z] = sc; xsc[ps.w] = sc; rmap[ps.x] = tok; rmap[ps.y] = tok; rmap[ps.z] = tok; rmap[ps.w] = tok; }
    }
}
template <bool Y_F8, bool X16, bool XOUT16 = false> __device__ __forceinline__ void p5b_combine(Frame& F, const float* xin, float* xout, const bf16* Y,
                                            const int* pos, const float* topw, const float* mod_l, const float* post_g,
                                            bool has_next, const float* mod_n, const float* pre_g_n, signed char* HQ, float* hs) {
    const int lane = F.lane, gw = F.vcu * NWAVES + F.wave, NGW = F.G * NWAVES;
    for (int ch = gw; ch < M / 32; ch += NGW) { const int mb = ch * 32;
        const float* modb = mod_l + (size_t)(mb >> 13) * (6 * D); const float* modn = mod_n + (size_t)(mb >> 13) * (6 * D);
        f32x4 gpv[4], gsv[4], shv[4];
#pragma unroll
        for (int j = 0; j < 4; ++j) { gpv[j] = ((const f32x4*)post_g)[lane + 64 * j] * ((const f32x4*)(modb + 5 * D))[lane + 64 * j];
            gsv[j] = ((const f32x4*)pre_g_n)[lane + 64 * j] * (((const f32x4*)(modn + D))[lane + 64 * j] + 1.0f); shv[j] = ((const f32x4*)modn)[lane + 64 * j]; }
        const i32x4 myps = *(const i32x4*)(pos + (size_t)(mb + (lane & 31)) * 4); const f32x4 mywt = *(const f32x4*)(topw + (size_t)(mb + (lane & 31)) * 4);
        u32x2 ywA[2][TOPK][4], ywB[2][TOPK][4], xwA[2][4], xwB[2][4]; f32x4 xfA[2][4], xfB[2][4];
#define P5B_ISSUE(YW, XW, XF, t0) do { _Pragma("unroll") for (int r = 0; r < 2; ++r) { const int t_ = (t0) + r; \
            _Pragma("unroll") for (int k = 0; k < TOPK; ++k) { const int p_ = __builtin_amdgcn_readlane(myps[k], t_); \
                if constexpr (Y_F8) { const int c0 = 4 * lane; const unsigned* yr = (const unsigned*)((const unsigned char*)Y + (size_t)p_ * D + 64 * ((c0 >> 5) & 3) + 16 * ((c0 >> 3) & 3) + 8 * (c0 >> 7) + (c0 & 7)); \
                    _Pragma("unroll") for (int j = 0; j < 4; ++j) { YW[r][k][j].x = yr[64 * j]; YW[r][k][j].y = 0u; } } \
                else { const u32x2* yr = (const u32x2*)(Y + (size_t)p_ * D) + lane; _Pragma("unroll") for (int j = 0; j < 4; ++j) YW[r][k][j] = yr[64 * j]; } } \
            if constexpr (X16) { const u32x2* xr = (const u32x2*)((const bf16*)xin + (size_t)(mb + t_) * D) + lane; _Pragma("unroll") for (int j = 0; j < 4; ++j) XW[r][j] = xr[64 * j]; } \
            else load_row_f32(xin + (size_t)(mb + t_) * D, XF[r], lane); } } while (0)
#define P5B_PROC(YW, XW, XF, t0) do { _Pragma("unroll") for (int r = 0; r < 2; ++r) { const int t_ = (t0) + r, m = mb + t_; f32x4 y[4], x[4]; \
            float wk[TOPK]; _Pragma("unroll") for (int k = 0; k < TOPK; ++k) wk[k] = __int_as_float(__builtin_amdgcn_readlane(__float_as_int(mywt[k]), t_)); \
            _Pragma("unroll") for (int j = 0; j < 4; ++j) { y[j] = (f32x4){0.f, 0.f, 0.f, 0.f}; \
                _Pragma("unroll") for (int k = 0; k < TOPK; ++k) { const u32x2 w = YW[r][k][j]; \
                    if constexpr (Y_F8) { typedef float f32x2p __attribute__((ext_vector_type(2))); const f32x2p lo = __builtin_amdgcn_cvt_pk_f32_fp8(w.x, false), hi2 = __builtin_amdgcn_cvt_pk_f32_fp8(w.x, true); \
                        y[j] += (f32x4){lo.x, lo.y, hi2.x, hi2.y} * wk[k]; } \
                    else y[j] += (f32x4){bflo(w.x), bfhi(w.x), bflo(w.y), bfhi(w.y)} * wk[k]; } \
                if constexpr (X16) { const u32x2 w = XW[r][j]; x[j] = (f32x4){bflo(w.x), bfhi(w.x), bflo(w.y), bfhi(w.y)}; } else x[j] = XF[r][j]; } \
            const float rsy = row_rstd(y); \
            _Pragma("unroll") for (int j = 0; j < 4; ++j) { x[j] = x[j] + gpv[j] * (y[j] * rsy); if constexpr (!XOUT16) __builtin_nontemporal_store(x[j], (f32x4*)(xout + (size_t)m * D) + lane + 64 * j); } \
            if constexpr (XOUT16) store_row_bf16((bf16*)xout + (size_t)m * D, x, lane);        \
            if (has_next) { f32x4 h[4]; const float rs = row_rstd(x); _Pragma("unroll") for (int j = 0; j < 4; ++j) h[j] = x[j] * rs * gsv[j] + shv[j]; \
                store_row_i8(HQ + (size_t)m * D, hs + m, h, lane); } } } while (0)
        P5B_ISSUE(ywA, xwA, xfA, 0);
#pragma unroll 1
        for (int it = 0; it < 8; ++it) { const int t0 = 4 * it;
            P5B_ISSUE(ywB, xwB, xfB, t0 + 2);
            P5B_PROC(ywA, xwA, xfA, t0);
            if (it < 7) P5B_ISSUE(ywA, xwA, xfA, t0 + 4);
            P5B_PROC(ywB, xwB, xfB, t0 + 2);
        }
#undef P5B_ISSUE
#undef P5B_PROC
    }
}

constexpr int PTAB_OFF = LDSCTL_OFF + 512;
enum { I_X = 0, I_C, I_ADAW, I_ADAB, I_PREMIX, I_POSTMIX, I_WIN, I_QG, I_KG, I_DECF, I_DECB, I_GNG, I_GNB, I_WOUT, I_PREFFN, I_POSTFFN, I_RW, I_RB, I_WUP, I_BUP, I_WDN, I_BDN, I_OUT, I_WS };
__device__ __forceinline__ unsigned char* ptab(LAS unsigned char* lds, int k) {
    const LAS unsigned* p = (const LAS unsigned*)(lds + PTAB_OFF) + 2 * k;
    const unsigned lo = __builtin_amdgcn_readfirstlane(p[0]), hi = __builtin_amdgcn_readfirstlane(p[1]);
    return (unsigned char*)(GAS unsigned char*)(((unsigned long long)hi << 32) | lo);
}
__device__ __forceinline__ unsigned char* ptabx(LAS unsigned char* lds, int k) {
    const LAS unsigned* p = (const LAS unsigned*)(lds + PTAB_OFF) + 2 * k;
    const unsigned lo = __builtin_amdgcn_readfirstlane(p[0]), hi = __builtin_amdgcn_readfirstlane(p[1]);
    return (unsigned char*)(((unsigned long long)hi << 32) | lo);
}
#define WSX(off) (ptabx(F.lds, I_WS) + (off))
#define PF(k) ((const float*)ptab(F.lds, (k)))
#define WSP(off) (ptab(F.lds, I_WS) + (off))
struct Args { const float* in[22]; float* out; unsigned char* ws; };
__global__ void __launch_bounds__(NTHR, 2) mk_fwd(Args args) {
    extern __shared__ __attribute__((aligned(16))) unsigned char lds[];
    Frame F;
    F.lds = (LAS unsigned char*)lds;
    F.MISC = (volatile LAS unsigned*)(F.lds + MISC_OFF);
    F.tid = threadIdx.x; F.lane = F.tid & 63; F.wave = __builtin_amdgcn_readfirstlane(F.tid >> 6);
    F.G = gridDim.x; { const int bx = blockIdx.x; F.vcu = (F.G % 8 == 0) ? (bx % 8) * (F.G / 8) + bx / 8 : bx; }
    F.ctl = (gu32*)(args.ws + WS_CTL);
    for (int u = F.tid; u < (LDS_BYTES - LDSCTL_OFF) / 4; u += NTHR) ((LAS unsigned*)(F.lds + LDSCTL_OFF))[u] = 0u;
    __syncthreads();
    if (F.tid == 0) { LAS unsigned long long* PT = (LAS unsigned long long*)(F.lds + PTAB_OFF);
#pragma unroll
        for (int k = 0; k < 22; ++k) PT[k] = (unsigned long long)args.in[k];
        PT[I_OUT] = (unsigned long long)args.out; PT[I_WS] = (unsigned long long)args.ws; }
    __syncthreads();
    (void)xcd_barrier_post((unsigned*)(F.ctl + CW_BAR), F.MISC + 8);
#define LAUNDER() do { F.tid = threadIdx.x; asm volatile("" : "+v"(F.tid)); F.lane = F.tid & 63; F.wave = __builtin_amdgcn_readfirstlane(F.tid >> 6); \
    { unsigned long long lb_ = (unsigned long long)lds0_; int vc_ = vcu0_, g_ = G0_; asm volatile("" : "+s"(lb_), "+s"(vc_), "+s"(g_)); F.lds = (LAS unsigned char*)lb_; F.vcu = vc_; F.G = g_; } } while (0)
#ifndef REP_BAR
#define REP_BAR 1
#endif
#define GRID_BAR() for (int rb_ = 0; rb_ < REP_BAR; ++rb_) do { XcdBarrier b_; b_.bar = (unsigned*)(ptab(F.lds, I_WS) + WS_CTL) + CW_BAR; b_.x = xb_xcc_id(); b_.st = (volatile LAS unsigned*)(F.lds + MISC_OFF) + 8; xcd_barrier(b_); LAUNDER(); } while (0)
    const LAS unsigned char* lds0_ = F.lds; const int vcu0_ = F.vcu, G0_ = F.G;

#ifndef SKIP_P0
    for (int rep_ = 0; rep_ < REP_P0; ++rep_)
    p0_prologue(F, PF(I_C), PF(I_ADAW), PF(I_ADAB), (float*)WSP(WS_MOD), PF(I_WIN), PF(I_WOUT), PF(I_WUP), PF(I_WDN),
                (signed char*)WSP(WS_WIN), (float*)WSP(WS_CSCIN), (signed char*)WSP(WS_WOUT), (float*)WSP(WS_CSCOUT), (signed char*)WSP(WS_WUP), (float*)WSP(WS_CSC), (signed char*)WSP(WS_WDN), (float*)WSP(WS_CSCDN), F.ctl + CW_WQ);
#endif
    GRID_BAR();
#ifndef SKIP_P0B
    for (int rep_ = 0; rep_ < REP_P0B; ++rep_)
    p0b_premix(F, PF(I_X), (signed char*)WSP(WS_HM), (float*)WSP(WS_HS), PF(I_PREMIX), (const float*)WSP(WS_MOD));
#endif
    GRID_BAR();
    { constexpr int l = 0;
        for (int rep_ = 0; rep_ < REP_P1; ++rep_) { LAUNDER();
#ifndef SKIP_P1
        {
            pg8::Gemm g{(const bf16*)WSP(WS_HM), (const bf16*)(WSP(WS_WIN) + (size_t)l * INW * D), M, INW, D / 2}; pg8::StaticOrder S; S.init(M, INW, F.G, (int)blockIdx.x);
            pg8::EpiI8Bf16 E{(bf16*)WSP(WS_PROJ), INW, (const float*)WSP(WS_HS), (const float*)WSP(WS_CSCIN) + (size_t)l * INW, F.lds + EPI_SP_OFF};
#if defined(STAGGER_P1)
            { const unsigned long long t0_ = __builtin_amdgcn_s_memrealtime(), dl_ = (unsigned long long)(F.vcu & 7) * STAGGER_P1; while (__builtin_amdgcn_s_memrealtime() - t0_ < dl_) __builtin_amdgcn_s_sleep(8); }
#endif
#if defined(NOEPI_P1)
            { pg8::EpiNullI8 E0; pg8::gemm_phase<pg8::EpiNullI8, pg8::StaticOrder, true, true, true, true>(F.lds + RING_OFF, g, S, E0, (const int*)WSP(WS_RMAP)); LAUNDER(); }
#endif
            pg8::gemm_phase<pg8::EpiI8Bf16, pg8::StaticOrder, true, true, true>(F.lds + RING_OFF, g, S, E);
        }
#endif
        }
        GRID_BAR();
#if defined(ATTN_PROBE)
        if (l == 0) ka_expect(F, (const bf16*)WSP(WS_PROJ), (float*)WSP(WS_DUMMY), PF(I_KG));
        GRID_BAR();
#endif
#ifndef SKIP_P1B
        p1b_ka(F, (bf16*)WSP(WS_PROJ), PF(I_KG) + l * 64);
#endif
        for (int rep_ = 0; rep_ < REP_R1; ++rep_) { LAUNDER();
#ifndef SKIP_R1
        r1_states(F, (const bf16*)WSP(WS_PROJ), (bf16*)WSP(WS_U), PF(I_DECF) + l * RH, PF(I_DECB) + l * RH);
#endif
        }
        GRID_BAR();
        for (int rep_ = 0; rep_ < REP_R2; ++rep_) { LAUNDER();
#ifndef SKIP_R2
        r2_scan(F, (const bf16*)WSP(WS_U), (bf16*)WSP(WS_FT), PF(I_DECF) + l * RH, PF(I_DECB) + l * RH);
#endif
        }
        GRID_BAR();
#pragma unroll 1
        for (int pass_ = 0; pass_ < 2; ++pass_) { LAUNDER();
        if (((F.vcu ^ pass_) & 1) == 0) {
#ifndef SKIP_R3
        for (int rr_ = 0; rr_ < REP_R3; ++rr_) { LAUNDER();
        r3_out(F, (const bf16*)WSP(WS_PROJ), (const bf16*)WSP(WS_FT), (bf16*)WSP(WS_CAT), PF(I_DECF) + l * RH, PF(I_DECB) + l * RH, PF(I_GNG) + l * 512, PF(I_GNB) + l * 512);
        }
#endif
        } else {
#ifndef SKIP_P2
        {
            const bf16* PROJ = (const bf16*)WSP(WS_PROJ);
            const attn_body::AttnTensors AT{(const attn_body::bf16*)(PROJ + C_QA), (const attn_body::bf16*)(PROJ + C_KA), (const attn_body::bf16*)(PROJ + C_VA), (attn_body::bf16*)WSP(WS_CAT), PF(I_QG) + l * 64, PF(I_KG) + l * 64};
            attn_body::attn_phase<8>((char*)lds + RING_OFF, AT, F.vcu, F.G);
        }
#endif
        }
        }
        GRID_BAR();
#if defined(ATTN_PROBE)
        if (l == 0) ka_compare(F, (const bf16*)WSP(WS_PROJ), (const float*)WSP(WS_DUMMY), F.ctl + CW_CODE + 8);
        if (l == 0) attn_check(F, (const bf16*)WSP(WS_PROJ), (const bf16*)WSP(WS_CAT), F.ctl + CW_CODE + 8, PF(I_QG));
#endif
        for (int rep_ = 0; rep_ < REP_P3; ++rep_) { LAUNDER();
#ifndef SKIP_P3
        {
            pg8::Gemm g{(const bf16*)WSP(WS_CAT), (const bf16*)(WSP(WS_WOUT) + (size_t)l * D * D), M, D, D / 2}; pg8::StaticOrder S; S.init(M, D, F.G, (int)blockIdx.x);
            pg8::EpiBf16 E{(bf16*)WSP(WS_YM), D, nullptr, 0, 0, F.lds + EPI_SP_OFF, (const float*)WSP(WS_CSCOUT) + (size_t)l * D, 1.0f};
            pg8::gemm_phase<pg8::EpiBf16, pg8::StaticOrder, true, true, false, false, true>(F.lds + RING_OFF, g, S, E);
        }
#endif
        }
        GRID_BAR();
#ifndef SKIP_P3B
        for (int rep_ = 1; rep_ < REP_P3B; ++rep_) { LAUNDER();
        p3b_postmix<false, (l > 0)>(F, l == 0 ? PF(I_X) : PF(I_OUT), (float*)WSP(WS_DUMMY), (const bf16*)WSP(WS_YM), (signed char*)WSP(WS_DUMMY + 256 * MiB), (float*)WSP(WS_DUMMY + 386 * MiB), (const float*)WSP(WS_MOD) + (size_t)l * BATCH * 6 * D,
                    PF(I_POSTMIX) + l * D, PF(I_PREFFN) + l * D, PF(I_RW) + (size_t)l * D * NE, PF(I_RB) + l * NE, (int*)WSP(WS_DUMMY + 384 * MiB), (float*)WSP(WS_DUMMY + 385 * MiB), F.ctl + CW_CNT + 128 + l * 64);
        }
        LAUNDER();
        p3b_postmix<(l >= X16_FROM), (l > 0)>(F, l == 0 ? PF(I_X) : PF(I_OUT), (l >= X16_FROM) ? (float*)WSP(WS_CAT) : (float*)ptab(F.lds, I_OUT), (const bf16*)WSP(WS_YM), (signed char*)WSP(WS_HM), (float*)WSP(WS_HS), (const float*)WSP(WS_MOD) + (size_t)l * BATCH * 6 * D,
                    PF(I_POSTMIX) + l * D, PF(I_PREFFN) + l * D, PF(I_RW) + (size_t)l * D * NE, PF(I_RB) + l * NE, (int*)WSP(WS_TOPI), (float*)WSP(WS_TOPW), F.ctl + CW_CNT + l * 64);
#endif
        GRID_BAR();
#ifndef SKIP_P4A
        for (int rep_ = 1; rep_ < REP_P4A; ++rep_) { LAUNDER();
        p4a_route(F, (const float*)WSP(WS_HS), (int*)WSP(WS_DUMMY + 16 * MiB), (float*)WSP(WS_DUMMY + 8 * MiB), (const int*)WSP(WS_TOPI), (int*)WSP(WS_DUMMY), F.ctl + CW_CNT + l * 64, F.ctl + CW_CUR + 128 + l * 64);
        }
        LAUNDER();
        p4a_route(F, (const float*)WSP(WS_HS), (int*)WSP(WS_RMAP), (float*)WSP(WS_XSC), (const int*)WSP(WS_TOPI), (int*)WSP(WS_POS), F.ctl + CW_CNT + l * 64, F.ctl + CW_CUR + l * 64);
#endif
        GRID_BAR();
        for (int rep_ = 0; rep_ < REP_P4; ++rep_) { LAUNDER();
#ifndef SKIP_P4
        {
            const LAS int* ts = (const LAS int*)(F.lds + LTS_OFF);
            pg8::Gemm g{(const bf16*)WSP(WS_HM), (const bf16*)(WSP(WS_WUP) + (size_t)l * NE * 2048 * D), XS_ROWS, 2048, D / 2}; pg8::MoeOrder<3> S{ts, F.G, F.vcu, ts[NE] * 8, ts[F.lane & 31]};
            pg8::EpiMoeUpT<true> E{(bf16*)WSP(WS_ACT), PF(I_BUP) + (size_t)l * NE * 2048, (const float*)WSP(WS_XSC), (const float*)WSP(WS_CSC) + (size_t)l * NE * 2048, F.lds + EPI_SP_OFF};
#if defined(STAGGER_P4)
            { const unsigned long long t0_ = __builtin_amdgcn_s_memrealtime(), dl_ = (unsigned long long)(F.vcu & (STAGGER_WAYS - 1)) * STAGGER_P4; while (__builtin_amdgcn_s_memrealtime() - t0_ < dl_) __builtin_amdgcn_s_sleep(8); }
#endif
#if defined(NOLOAD_P4)
            { pg8::EpiMoeUpNoLoad E0{(bf16*)WSP(WS_ACT), 1e-4f, 0.01f}; pg8::gemm_phase<pg8::EpiMoeUpNoLoad, pg8::MoeOrder<3>, true, true, true, true>(F.lds + RING_OFF, g, S, E0, (const int*)WSP(WS_RMAP)); LAUNDER(); }
#endif
#if defined(NOSTORE_P4)
            { pg8::EpiMoeUpNoStore E0{(bf16*)WSP(WS_ACT), 1e-4f, 0.01f}; pg8::gemm_phase<pg8::EpiMoeUpNoStore, pg8::MoeOrder<3>, true, true, true, true>(F.lds + RING_OFF, g, S, E0, (const int*)WSP(WS_RMAP)); LAUNDER(); }
#endif
#if defined(NOEPI_P4)
            { pg8::EpiNullI8 E0; pg8::gemm_phase<pg8::EpiNullI8, pg8::MoeOrder<3>, true, true, true, true>(F.lds + RING_OFF, g, S, E0, (const int*)WSP(WS_RMAP)); LAUNDER(); }
#endif
            pg8::gemm_phase<pg8::EpiMoeUpT<true>, pg8::MoeOrder<3>, true, true, true, true>(F.lds + RING_OFF, g, S, E, (const int*)WSP(WS_RMAP));
        }
#endif
        }
        GRID_BAR();
        for (int rep_ = 0; rep_ < REP_P5; ++rep_) { LAUNDER();
#ifndef SKIP_P5
        {
            const LAS int* ts = (const LAS int*)(F.lds + LTS_OFF);
            pg8::Gemm g{(const bf16*)WSP(WS_ACT), (const bf16*)(WSP(WS_WDN) + (size_t)l * NE * D * D), XS_ROWS, D, D / 2}; pg8::MoeOrder<2> S{ts, F.G, F.vcu, ts[NE] * 4, ts[F.lane & 31]};
            typedef pg8::EpiBf16T<(l >= YF8_FROM)> EpiDn;
            EpiDn E{(bf16*)WSP(WS_XS), D, PF(I_BDN) + (size_t)l * NE * D, D, 0, F.lds + EPI_SP_OFF, (const float*)WSP(WS_CSCDN) + (size_t)l * NE * D, 1.0f / pg8::ACT_F8_SCALE};
#if defined(STAGGER_P5)
            { const unsigned long long t0_ = __builtin_amdgcn_s_memrealtime(), dl_ = (unsigned long long)(F.vcu & 7) * STAGGER_P5; while (__builtin_amdgcn_s_memrealtime() - t0_ < dl_) __builtin_amdgcn_s_sleep(8); }
#endif
            pg8::gemm_phase<EpiDn, pg8::MoeOrder<2>, true, true, false, false, true>(F.lds + RING_OFF, g, S, E);
        }
#endif
        }
        GRID_BAR();
#ifndef SKIP_P5B
        for (int rep_ = 1; rep_ < REP_P5B; ++rep_) { LAUNDER();
        p5b_combine<(l >= YF8_FROM), (l >= X16_FROM), (l + 1 < DEPTH)>(F, (l >= X16_FROM) ? (const float*)WSP(WS_CAT) : (const float*)ptab(F.lds, I_OUT), (float*)WSP(WS_DUMMY), (const bf16*)WSP(WS_XS), (const int*)WSP(WS_POS), (const float*)WSP(WS_TOPW), (const float*)WSP(WS_MOD) + (size_t)l * BATCH * 6 * D, PF(I_POSTFFN) + l * D,
                    l + 1 < DEPTH, (const float*)WSP(WS_MOD) + (size_t)(l + 1 < DEPTH ? l + 1 : l) * BATCH * 6 * D, PF(I_PREMIX) + (l + 1 < DEPTH ? (l + 1) * D : 0), (signed char*)WSP(WS_DUMMY + 256 * MiB), (float*)WSP(WS_DUMMY + 386 * MiB));
        }
        LAUNDER();
        p5b_combine<(l >= YF8_FROM), (l >= X16_FROM), (l + 1 < DEPTH)>(F, (l >= X16_FROM) ? (const float*)WSP(WS_CAT) : (const float*)ptab(F.lds, I_OUT), (float*)ptab(F.lds, I_OUT), (const bf16*)WSP(WS_XS), (const int*)WSP(WS_POS), (const float*)WSP(WS_TOPW), (const float*)WSP(WS_MOD) + (size_t)l * BATCH * 6 * D, PF(I_POSTFFN) + l * D,
                    l + 1 < DEPTH, (const float*)WSP(WS_MOD) + (size_t)(l + 1 < DEPTH ? l + 1 : l) * BATCH * 6 * D, PF(I_PREMIX) + (l + 1 < DEPTH ? (l + 1) * D : 0), (signed char*)WSP(WS_HM), (float*)WSP(WS_HS));
#endif
        if (l + 1 < DEPTH) GRID_BAR();
    }
    { constexpr int l = 1;
        for (int rep_ = 0; rep_ < REP_P1; ++rep_) { LAUNDER();
#ifndef SKIP_P1
        {
            pg8::Gemm g{(const bf16*)WSP(WS_HM), (const bf16*)(WSP(WS_WIN) + (size_t)l * INW * D), M, INW, D / 2}; pg8::StaticOrder S; S.init(M, INW, F.G, (int)blockIdx.x);
            pg8::EpiI8Bf16 E{(bf16*)WSP(WS_PROJ), INW, (const float*)WSP(WS_HS), (const float*)WSP(WS_CSCIN) + (size_t)l * INW, F.lds + EPI_SP_OFF};
#if defined(STAGGER_P1)
            { const unsigned long long t0_ = __builtin_amdgcn_s_memrealtime(), dl_ = (unsigned long long)(F.vcu & 7) * STAGGER_P1; while (__builtin_amdgcn_s_memrealtime() - t0_ < dl_) __builtin_amdgcn_s_sleep(8); }
#endif
#if defined(NOEPI_P1)
            { pg8::EpiNullI8 E0; pg8::gemm_phase<pg8::EpiNullI8, pg8::StaticOrder, true, true, true, true>(F.lds + RING_OFF, g, S, E0, (const int*)WSP(WS_RMAP)); LAUNDER(); }
#endif
            pg8::gemm_phase<pg8::EpiI8Bf16, pg8::StaticOrder, true, true, true>(F.lds + RING_OFF, g, S, E);
        }
#endif
        }
        GRID_BAR();
#if defined(ATTN_PROBE)
        if (l == 0) ka_expect(F, (const bf16*)WSP(WS_PROJ), (float*)WSP(WS_DUMMY), PF(I_KG));
        GRID_BAR();
#endif
#ifndef SKIP_P1B
        p1b_ka(F, (bf16*)WSP(WS_PROJ), PF(I_KG) + l * 64);
#endif
        for (int rep_ = 0; rep_ < REP_R1; ++rep_) { LAUNDER();
#ifndef SKIP_R1
        r1_states(F, (const bf16*)WSP(WS_PROJ), (bf16*)WSP(WS_U), PF(I_DECF) + l * RH, PF(I_DECB) + l * RH);
#endif
        }
        GRID_BAR();
        for (int rep_ = 0; rep_ < REP_R2; ++rep_) { LAUNDER();
#ifndef SKIP_R2
        r2_scan(F, (const bf16*)WSP(WS_U), (bf16*)WSP(WS_FT), PF(I_DECF) + l * RH, PF(I_DECB) + l * RH);
#endif
        }
        GRID_BAR();
#pragma unroll 1
        for (int pass_ = 0; pass_ < 2; ++pass_) { LAUNDER();
        if (((F.vcu ^ pass_) & 1) == 0) {
#ifndef SKIP_R3
        for (int rr_ = 0; rr_ < REP_R3; ++rr_) { LAUNDER();
        r3_out(F, (const bf16*)WSP(WS_PROJ), (const bf16*)WSP(WS_FT), (bf16*)WSP(WS_CAT), PF(I_DECF) + l * RH, PF(I_DECB) + l * RH, PF(I_GNG) + l * 512, PF(I_GNB) + l * 512);
        }
#endif
        } else {
#ifndef SKIP_P2
        {
            const bf16* PROJ = (const bf16*)WSP(WS_PROJ);
            const attn_body::AttnTensors AT{(const attn_body::bf16*)(PROJ + C_QA), (const attn_body::bf16*)(PROJ + C_KA), (const attn_body::bf16*)(PROJ + C_VA), (attn_body::bf16*)WSP(WS_CAT), PF(I_QG) + l * 64, PF(I_KG) + l * 64};
            attn_body::attn_phase<8>((char*)lds + RING_OFF, AT, F.vcu, F.G);
        }
#endif
        }
        }
        GRID_BAR();
#if defined(ATTN_PROBE)
        if (l == 0) ka_compare(F, (const bf16*)WSP(WS_PROJ), (const float*)WSP(WS_DUMMY), F.ctl + CW_CODE + 8);
        if (l == 0) attn_check(F, (const bf16*)WSP(WS_PROJ), (const bf16*)WSP(WS_CAT), F.ctl + CW_CODE + 8, PF(I_QG));
#endif
        for (int rep_ = 0; rep_ < REP_P3; ++rep_) { LAUNDER();
#ifndef SKIP_P3
        {
            pg8::Gemm g{(const bf16*)WSP(WS_CAT), (const bf16*)(WSP(WS_WOUT) + (size_t)l * D * D), M, D, D / 2}; pg8::StaticOrder S; S.init(M, D, F.G, (int)blockIdx.x);
            pg8::EpiBf16 E{(bf16*)WSP(WS_YM), D, nullptr, 0, 0, F.lds + EPI_SP_OFF, (const float*)WSP(WS_CSCOUT) + (size_t)l * D, 1.0f};
            pg8::gemm_phase<pg8::EpiBf16, pg8::StaticOrder, true, true, false, false, true>(F.lds + RING_OFF, g, S, E);
        }
#endif
        }
        GRID_BAR();
#ifndef SKIP_P3B
        for (int rep_ = 1; rep_ < REP_P3B; ++rep_) { LAUNDER();
        p3b_postmix<false, (l > 0)>(F, l == 0 ? PF(I_X) : PF(I_OUT), (float*)WSP(WS_DUMMY), (const bf16*)WSP(WS_YM), (signed char*)WSP(WS_DUMMY + 256 * MiB), (float*)WSP(WS_DUMMY + 386 * MiB), (const float*)WSP(WS_MOD) + (size_t)l * BATCH * 6 * D,
                    PF(I_POSTMIX) + l * D, PF(I_PREFFN) + l * D, PF(I_RW) + (size_t)l * D * NE, PF(I_RB) + l * NE, (int*)WSP(WS_DUMMY + 384 * MiB), (float*)WSP(WS_DUMMY + 385 * MiB), F.ctl + CW_CNT + 128 + l * 64);
        }
        LAUNDER();
        p3b_postmix<(l >= X16_FROM), (l > 0)>(F, l == 0 ? PF(I_X) : PF(I_OUT), (l >= X16_FROM) ? (float*)WSP(WS_CAT) : (float*)ptab(F.lds, I_OUT), (const bf16*)WSP(WS_YM), (signed char*)WSP(WS_HM), (float*)WSP(WS_HS), (const float*)WSP(WS_MOD) + (size_t)l * BATCH * 6 * D,
                    PF(I_POSTMIX) + l * D, PF(I_PREFFN) + l * D, PF(I_RW) + (size_t)l * D * NE, PF(I_RB) + l * NE, (int*)WSP(WS_TOPI), (float*)WSP(WS_TOPW), F.ctl + CW_CNT + l * 64);
#endif
        GRID_BAR();
#ifndef SKIP_P4A
        for (int rep_ = 1; rep_ < REP_P4A; ++rep_) { LAUNDER();
        p4a_route(F, (const float*)WSP(WS_HS), (int*)WSP(WS_DUMMY + 16 * MiB), (float*)WSP(WS_DUMMY + 8 * MiB), (const int*)WSP(WS_TOPI), (int*)WSP(WS_DUMMY), F.ctl + CW_CNT + l * 64, F.ctl + CW_CUR + 128 + l * 64);
        }
        LAUNDER();
        p4a_route(F, (const float*)WSP(WS_HS), (int*)WSP(WS_RMAP), (float*)WSP(WS_XSC), (const int*)WSP(WS_TOPI), (int*)WSP(WS_POS), F.ctl + CW_CNT + l * 64, F.ctl + CW_CUR + l * 64);
#endif
        GRID_BAR();
        for (int rep_ = 0; rep_ < REP_P4; ++rep_) { LAUNDER();
#ifndef SKIP_P4
        {
            const LAS int* ts = (const LAS int*)(F.lds + LTS_OFF);
            pg8::Gemm g{(const bf16*)WSP(WS_HM), (const bf16*)(WSP(WS_WUP) + (size_t)l * NE * 2048 * D), XS_ROWS, 2048, D / 2}; pg8::MoeOrder<3> S{ts, F.G, F.vcu, ts[NE] * 8, ts[F.lane & 31]};
            pg8::EpiMoeUpT<true> E{(bf16*)WSP(WS_ACT), PF(I_BUP) + (size_t)l * NE * 2048, (const float*)WSP(WS_XSC), (const float*)WSP(WS_CSC) + (size_t)l * NE * 2048, F.lds + EPI_SP_OFF};
#if defined(STAGGER_P4)
            { const unsigned long long t0_ = __builtin_amdgcn_s_memrealtime(), dl_ = (unsigned long long)(F.vcu & (STAGGER_WAYS - 1)) * STAGGER_P4; while (__builtin_amdgcn_s_memrealtime() - t0_ < dl_) __builtin_amdgcn_s_sleep(8); }
#endif
#if defined(NOLOAD_P4)
            { pg8::EpiMoeUpNoLoad E0{(bf16*)WSP(WS_ACT), 1e-4f, 0.01f}; pg8::gemm_phase<pg8::EpiMoeUpNoLoad, pg8::MoeOrder<3>, true, true, true, true>(F.lds + RING_OFF, g, S, E0, (const int*)WSP(WS_RMAP)); LAUNDER(); }
#endif
#if defined(NOSTORE_P4)
            { pg8::EpiMoeUpNoStore E0{(bf16*)WSP(WS_ACT), 1e-4f, 0.01f}; pg8::gemm_phase<pg8::EpiMoeUpNoStore, pg8::MoeOrder<3>, true, true, true, true>(F.lds + RING_OFF, g, S, E0, (const int*)WSP(WS_RMAP)); LAUNDER(); }
#endif
#if defined(NOEPI_P4)
            { pg8::EpiNullI8 E0; pg8::gemm_phase<pg8::EpiNullI8, pg8::MoeOrder<3>, true, true, true, true>(F.lds + RING_OFF, g, S, E0, (const int*)WSP(WS_RMAP)); LAUNDER(); }
#endif
            pg8::gemm_phase<pg8::EpiMoeUpT<true>, pg8::MoeOrder<3>, true, true, true, true>(F.lds + RING_OFF, g, S, E, (const int*)WSP(WS_RMAP));
        }
#endif
        }
        GRID_BAR();
        for (int rep_ = 0; rep_ < REP_P5; ++rep_) { LAUNDER();
#ifndef SKIP_P5
        {
            const LAS int* ts = (const LAS int*)(F.lds + LTS_OFF);
            pg8::Gemm g{(const bf16*)WSP(WS_ACT), (const bf16*)(WSP(WS_WDN) + (size_t)l * NE * D * D), XS_ROWS, D, D / 2}; pg8::MoeOrder<2> S{ts, F.G, F.vcu, ts[NE] * 4, ts[F.lane & 31]};
            typedef pg8::EpiBf16T<(l >= YF8_FROM)> EpiDn;
            EpiDn E{(bf16*)WSP(WS_XS), D, PF(I_BDN) + (size_t)l * NE * D, D, 0, F.lds + EPI_SP_OFF, (const float*)WSP(WS_CSCDN) + (size_t)l * NE * D, 1.0f / pg8::ACT_F8_SCALE};
#if defined(STAGGER_P5)
            { const unsigned long long t0_ = __builtin_amdgcn_s_memrealtime(), dl_ = (unsigned long long)(F.vcu & 7) * STAGGER_P5; while (__builtin_amdgcn_s_memrealtime() - t0_ < dl_) __builtin_amdgcn_s_sleep(8); }
#endif
            pg8::gemm_phase<EpiDn, pg8::MoeOrder<2>, true, true, false, false, true>(F.lds + RING_OFF, g, S, E);
        }
#endif
        }
        GRID_BAR();
#ifndef SKIP_P5B
        for (int rep_ = 1; rep_ < REP_P5B; ++rep_) { LAUNDER();
        p5b_combine<(l >= YF8_FROM), (l >= X16_FROM), (l + 1 < DEPTH)>(F, (l >= X16_FROM) ? (const float*)WSP(WS_CAT) : (const float*)ptab(F.lds, I_OUT), (float*)WSP(WS_DUMMY), (const bf16*)WSP(WS_XS), (const int*)WSP(WS_POS), (const float*)WSP(WS_TOPW), (const float*)WSP(WS_MOD) + (size_t)l * BATCH * 6 * D, PF(I_POSTFFN) + l * D,
                    l + 1 < DEPTH, (const float*)WSP(WS_MOD) + (size_t)(l + 1 < DEPTH ? l + 1 : l) * BATCH * 6 * D, PF(I_PREMIX) + (l + 1 < DEPTH ? (l + 1) * D : 0), (signed char*)WSP(WS_DUMMY + 256 * MiB), (float*)WSP(WS_DUMMY + 386 * MiB));
        }
        LAUNDER();
        p5b_combine<(l >= YF8_FROM), (l >= X16_FROM), (l + 1 < DEPTH)>(F, (l >= X16_FROM) ? (const float*)WSP(WS_CAT) : (const float*)ptab(F.lds, I_OUT), (float*)ptab(F.lds, I_OUT), (const bf16*)WSP(WS_XS), (const int*)WSP(WS_POS), (const float*)WSP(WS_TOPW), (const float*)WSP(WS_MOD) + (size_t)l * BATCH * 6 * D, PF(I_POSTFFN) + l * D,
                    l + 1 < DEPTH, (const float*)WSP(WS_MOD) + (size_t)(l + 1 < DEPTH ? l + 1 : l) * BATCH * 6 * D, PF(I_PREMIX) + (l + 1 < DEPTH ? (l + 1) * D : 0), (signed char*)WSP(WS_HM), (float*)WSP(WS_HS));
#endif
        if (l + 1 < DEPTH) GRID_BAR();
    }
#if defined(ATTN_PROBE)
    GRID_BAR();
    if (blockIdx.x == 0 && F.tid == 0 && __hip_atomic_load(F.ctl + CW_CODE + 8, RLX_AGENT) != 0u) ((float*)ptab(F.lds, I_OUT))[0] = __builtin_nanf("");
#endif
#undef GRID_BAR
}

extern "C" void kernel_launch(void* const* d_in, const int* in_sizes, int n_in, void* d_out, int out_size, void* d_ws, size_t ws_size, hipStream_t stream) {
    static int grid = 0;
    if (grid == 0) {
        if (n_in != 22 || in_sizes[0] != M * D || out_size != M * D || ws_size < WS_END) { fprintf(stderr, "kernel_launch: unexpected shapes/workspace (n_in %d, in0 %d, out %d, ws %zu < %zu)\n", n_in, n_in > 0 ? in_sizes[0] : -1, out_size, ws_size, (size_t)WS_END); grid = -1; return; }
        int dev = 0, cus = 0, per_cu = 0;
        if (hipGetDevice(&dev) != hipSuccess || hipDeviceGetAttribute(&cus, hipDeviceAttributeMultiprocessorCount, dev) != hipSuccess) { grid = -1; return; }
        if (hipFuncSetAttribute((const void*)mk_fwd, hipFuncAttributeMaxDynamicSharedMemorySize, LDS_BYTES) != hipSuccess) { fprintf(stderr, "kernel_launch: hipFuncSetAttribute failed\n"); grid = -1; return; }
        if (hipOccupancyMaxActiveBlocksPerMultiprocessor(&per_cu, (const void*)mk_fwd, NTHR, LDS_BYTES) != hipSuccess || per_cu < 1) { fprintf(stderr, "kernel_launch: occupancy query says %d\n", per_cu); }
        (void)hipGetLastError();
        grid = cus;
    }
    if (grid < 0) return;
    if (hipMemsetAsync((char*)d_ws + WS_CTL, 0, CTL_ZERO_BYTES, stream) != hipSuccess) { fprintf(stderr, "kernel_launch: memset failed\n"); return; }
    Args a{};
    for (int i = 0; i < 22; ++i) a.in[i] = (const float*)d_in[i];
    a.out = (float*)d_out; a.ws = (unsigned char*)d_ws;
    hipLaunchKernelGGL(mk_fwd, dim3(grid), dim3(NTHR), LDS_BYTES, stream, a);
    const hipError_t le = hipPeekAtLastError();
    if (le != hipSuccess) fprintf(stderr, "kernel_launch: launch failed: %s\n", hipGetErrorName(le));
}
```

```cpp
#ifndef REP_P0
#define REP_P0 1
#endif
#ifndef REP_P1
#define REP_P1 1
#endif
#ifndef REP_R1
#define REP_R1 1
#endif
#ifndef REP_R2
#define REP_R2 1
#endif
#ifndef REP_R3
#define REP_R3 1
#endif
#ifndef REP_P2
#define REP_P2 1
#endif
#ifndef REP_P3
#define REP_P3 1
#endif
#ifndef REP_P4
#define REP_P4 1
#endif
#ifndef REP_P5
#define REP_P5 1
#endif
#ifndef REP_P0B
#define REP_P0B 1
#endif
#ifndef REP_P1B
#define REP_P1B 1
#endif
#ifndef REP_P3B
#define REP_P3B 1
#endif
#ifndef REP_P4A
#define REP_P4A 1
#endif
#ifndef REP_P5B
#define REP_P5B 1
#endif
#ifndef REP_EPI
#define REP_EPI 1
#endif
#ifndef STAGGER_WAYS
#define STAGGER_WAYS 8
#endif
#include <hip/hip_runtime.h>
template <int M> __device__ __forceinline__ float shx(float v) { return __int_as_float(__builtin_amdgcn_ds_swizzle(__float_as_int(v), (M << 10) | 0x1f)); }
template <int M> __device__ __forceinline__ int shxi(int v) { return __builtin_amdgcn_ds_swizzle(v, (M << 10) | 0x1f); }
__device__ __forceinline__ float sum32(float v) { auto rr = __builtin_amdgcn_permlane32_swap(__float_as_uint(v), __float_as_uint(v), false, false); return __uint_as_float(rr[0]) + __uint_as_float(rr[1]); }
__device__ __forceinline__ float max32(float v) { auto rr = __builtin_amdgcn_permlane32_swap(__float_as_uint(v), __float_as_uint(v), false, false); return fmaxf(__uint_as_float(rr[0]), __uint_as_float(rr[1])); }
__device__ __forceinline__ float shx32(float v, bool upper) { auto rr = __builtin_amdgcn_permlane32_swap(__float_as_uint(v), __float_as_uint(v), false, false); return __uint_as_float(upper ? rr[0] : rr[1]); }
__device__ __forceinline__ int bcastl(int v, int srclane) { return __builtin_amdgcn_ds_bpermute(srclane << 2, v); }
__device__ __forceinline__ float wsum64(float v) { v += shx<1>(v); v += shx<2>(v); v += shx<4>(v); v += shx<8>(v); v += shx<16>(v); return sum32(v); }
__device__ __forceinline__ float wmax64(float v) { v = fmaxf(v, shx<1>(v)); v = fmaxf(v, shx<2>(v)); v = fmaxf(v, shx<4>(v)); v = fmaxf(v, shx<8>(v)); v = fmaxf(v, shx<16>(v)); return max32(v); }
#ifndef YF8_FROM
#define YF8_FROM 0
#endif
#ifndef X16_FROM
#define X16_FROM 0
#endif
#include <hip/hip_runtime.h>
#include <cstdio>
#include <cstdint>
namespace pg8 {
#define PG8_LAS __attribute__((address_space(3)))
typedef unsigned short bf16_t;
typedef short bf16x8 __attribute__((ext_vector_type(8)));
typedef float f32x4 __attribute__((ext_vector_type(4)));
typedef unsigned u32x4 __attribute__((ext_vector_type(4)));
constexpr int BM = 256, BK = 64, HALF = 128, HTB = HALF * BK * 2  , STAGE_BYTES = 8 * HTB, NXCD = 8, WGM = 8;

__host__ __device__ __forceinline__ int lds_byte(int r, int c) { const int st = (r >> 4) * 2 + (c >> 5), rr = r & 15, cc = c & 31, ob = rr * 64 + cc * 2; return st * 1024 + (ob ^ (((ob >> 9) & 1) << 5)); }
__host__ __device__ __forceinline__ void stage_rc(int b, int& R, int& C) { const int st = b / 1024, sb = b % 1024, swz = sb ^ (((sb >> 9) & 1) << 5); R = (st >> 1) * 16 + swz / 64; C = (st & 1) * 32 + (swz % 64) / 2; }
__host__ __device__ __forceinline__ int perm32(int rho) { const int n = rho >> 4, i = rho & 15; return 8 * (i >> 2) + 4 * n + (i & 3); }

struct Unit { int pm, pn; };
struct Gemm { const bf16_t* A; const bf16_t* Bt; int M, N, K; };

struct StaticOrder {
    int nM, nN, nwg, G, c;
    __host__ __device__ void init(int M, int N, int G_, int c_) { nM = M / BM; nN = N / BM; nwg = nM * nN; G = G_; c = c_; }
    __host__ __device__ bool next(int i, Unit& u) const {
        const long L = (long)i * G + c; if (L >= nwg) return false;
        int wgid = (int)L; { const int q = nwg / NXCD, r = nwg % NXCD, xcd = wgid % NXCD, off = wgid / NXCD; wgid = (xcd < r ? xcd * (q + 1) : r * (q + 1) + (xcd - r) * q) + off; }
        const int nig = WGM * nN, gid = wgid / nig, fm = gid * WGM, gsz = (nM - fm) < WGM ? (nM - fm) : WGM;
        u.pm = fm + ((wgid % nig) % gsz); u.pn = (wgid % nig) / gsz; return true;
    }
    __device__ __forceinline__ void a_ready(const Unit&) const {}
    __device__ __forceinline__ void done(const Unit&) const {}
};

__device__ __forceinline__ unsigned cvt_pk_bf16(float lo, float hi) { unsigned r; asm volatile("v_cvt_pk_bf16_f32 %0, %1, %2" : "=v"(r) : "v"(lo), "v"(hi)); return r; }
typedef float f32x2 __attribute__((ext_vector_type(2)));

typedef int i32x4 __attribute__((ext_vector_type(4)));
__device__ __forceinline__ void dma4(const float* g, PG8_LAS unsigned char* l) { __builtin_amdgcn_global_load_lds((const unsigned*)g, (PG8_LAS unsigned*)l, 4, 0, 0); }
template <bool OUT_F8> struct EpiBf16T {
    static constexpr bool PERM = true, AFTER_DRAIN = false; static constexpr int NST = OUT_F8 ? 8 : 16;
    bf16_t* O; int ldc; const float* bias; int split_cols; size_t split_stride; PG8_LAS unsigned char* sp;
    const float* csc = nullptr; float cmul = 1.0f;
    __device__ __forceinline__ void prefetch(const Unit& u, int wid, int lane) const {
        if (bias && wid < 4) dma4(bias + u.pn * BM + wid * 64 + lane, sp + wid * 256);
        if (csc && wid >= 4) dma4(csc + u.pn * BM + (wid - 4) * 64 + lane, sp + 1024 + (wid - 4) * 256);
    }
    __device__ __forceinline__ void operator()(const f32x4 (&acc)[2][2][4][2], const Unit& u, int wr, int wc, int fr, int fq) const {
        const int row0 = u.pm * BM + wr * 64 + fr; int colt = u.pn * BM; bf16_t* base = O;
        if (split_cols) { const int t = colt / split_cols; base += (size_t)t * split_stride; colt -= t * split_cols; }
        const int col0 = colt + wc * 32 + 8 * fq;
        f32x4 bv[2][2];
#pragma unroll
        for (int bj = 0; bj < 2; ++bj)
#pragma unroll
            for (int n = 0; n < 2; ++n) bv[bj][n] = bias ? *(const PG8_LAS f32x4*)(sp + 4 * (bj * HALF + wc * 32 + 8 * fq + 4 * n)) : (f32x4){0.f, 0.f, 0.f, 0.f};
        f32x4 cv[2][2];
#pragma unroll
        for (int bj = 0; bj < 2; ++bj)
#pragma unroll
            for (int n = 0; n < 2; ++n) cv[bj][n] = csc ? *(const PG8_LAS f32x4*)(sp + 1024 + 4 * (bj * HALF + wc * 32 + 8 * fq + 4 * n)) * cmul : (f32x4){1.f, 1.f, 1.f, 1.f};
#pragma unroll
        for (int ai = 0; ai < 2; ++ai)
#pragma unroll
            for (int m = 0; m < 4; ++m) { bf16_t* rowp = base + (size_t)(row0 + ai * HALF + m * 16) * ldc + col0;
                if constexpr (OUT_F8) { unsigned w[4];
#pragma unroll
                    for (int bj = 0; bj < 2; ++bj) { f32x4 v0 = acc[ai][bj][m][0] * cv[bj][0] + bv[bj][0], v1 = acc[ai][bj][m][1] * cv[bj][1] + bv[bj][1]; unsigned w0 = 0u, w1 = 0u;
#pragma unroll
                        for (int q = 0; q < 4; ++q) { v0[q] = __builtin_amdgcn_fmed3f(v0[q], -448.0f, 448.0f); v1[q] = __builtin_amdgcn_fmed3f(v1[q], -448.0f, 448.0f); }
                        w0 = __builtin_amdgcn_cvt_pk_fp8_f32(v0[0], v0[1], w0, false); w0 = __builtin_amdgcn_cvt_pk_fp8_f32(v0[2], v0[3], w0, true);
                        w1 = __builtin_amdgcn_cvt_pk_fp8_f32(v1[0], v1[1], w1, false); w1 = __builtin_amdgcn_cvt_pk_fp8_f32(v1[2], v1[3], w1, true);
                        w[2 * bj] = w0; w[2 * bj + 1] = w1; }
                    *(u32x4*)((unsigned char*)base + (size_t)(row0 + ai * HALF + m * 16) * ldc + colt + 64 * wc + 16 * fq) = (u32x4){w[0], w[1], w[2], w[3]}; }
                else {
#pragma unroll
                    for (int bj = 0; bj < 2; ++bj) { const f32x4 v0 = acc[ai][bj][m][0] * cv[bj][0] + bv[bj][0], v1 = acc[ai][bj][m][1] * cv[bj][1] + bv[bj][1];
                        u32x4 w; w.x = cvt_pk_bf16(v0[0], v0[1]); w.y = cvt_pk_bf16(v0[2], v0[3]); w.z = cvt_pk_bf16(v1[0], v1[1]); w.w = cvt_pk_bf16(v1[2], v1[3]);
                        *(u32x4*)(rowp + bj * HALF) = w; } } }
    }
};
typedef EpiBf16T<false> EpiBf16;
struct EpiNullI8 {
    static constexpr bool PERM = true, AFTER_DRAIN = false; static constexpr int NST = 0;
    __device__ __forceinline__ void prefetch(const Unit&, int, int) const {}
    __device__ __forceinline__ void operator()(const i32x4 (&acc)[2][2][4][2], const Unit&, int, int, int, int) const {
#pragma unroll
        for (int a = 0; a < 2; ++a)
#pragma unroll
            for (int b = 0; b < 2; ++b)
#pragma unroll
                for (int m = 0; m < 4; ++m)
#pragma unroll
                    for (int n = 0; n < 2; ++n) asm volatile("" :: "v"(acc[a][b][m][n]));
    }
};
struct EpiI8Bf16 {
    static constexpr bool PERM = true, AFTER_DRAIN = false; static constexpr int NST = 16;
    bf16_t* O; int ldc; const float* rsc; const float* csc; PG8_LAS unsigned char* sp;
    __device__ __forceinline__ void prefetch(const Unit& u, int wid, int lane) const {
        if (wid < 4) dma4(rsc + u.pm * BM + wid * 64 + lane, sp + wid * 256);
        else dma4(csc + u.pn * BM + (wid - 4) * 64 + lane, sp + 1024 + (wid - 4) * 256);
    }
    __device__ __forceinline__ void operator()(const i32x4 (&acc)[2][2][4][2], const Unit& u, int wr, int wc, int fr, int fq) const {
        const int row0 = u.pm * BM + wr * 64 + fr, col0 = u.pn * BM + wc * 32 + 8 * fq;
        const PG8_LAS float* spf = (const PG8_LAS float*)sp;
        f32x4 cv[2][2];
#pragma unroll
        for (int bj = 0; bj < 2; ++bj)
#pragma unroll
            for (int n = 0; n < 2; ++n) cv[bj][n] = *(const PG8_LAS f32x4*)(spf + 256 + bj * HALF + wc * 32 + 8 * fq + 4 * n);
#pragma unroll
        for (int ai = 0; ai < 2; ++ai)
#pragma unroll
            for (int m = 0; m < 4; ++m) { const int row = row0 + ai * HALF + m * 16; const float rs = spf[ai * HALF + wr * 64 + m * 16 + fr]; bf16_t* rowp = O + (size_t)row * ldc + col0;
#pragma unroll
                for (int bj = 0; bj < 2; ++bj) { float v[8];
#pragma unroll
                    for (int n = 0; n < 2; ++n)
#pragma unroll
                        for (int q = 0; q < 4; ++q) v[4 * n + q] = (float)acc[ai][bj][m][n][q] * (rs * cv[bj][n][q]);
                    u32x4 w; w.x = cvt_pk_bf16(v[0], v[1]); w.y = cvt_pk_bf16(v[2], v[3]); w.z = cvt_pk_bf16(v[4], v[5]); w.w = cvt_pk_bf16(v[6], v[7]);
                    *(u32x4*)(rowp + bj * HALF) = w; } }
    }
};
__device__ __forceinline__ float swiglu_c(float g, float l) {
    g = fminf(g, 7.0f); l = fminf(fmaxf(l, -7.0f), 7.0f);
    const float s = __builtin_amdgcn_rcpf(1.0f + __builtin_amdgcn_exp2f(g * (-1.702f * 1.4426950408889634f)));
    return g * s * (l + 1.0f);
}
typedef float f32x2e __attribute__((ext_vector_type(2)));
__device__ __forceinline__ f32x2e swiglu_pk(f32x2e g, f32x2e l) {
    g.x = fminf(g.x, 7.0f); g.y = fminf(g.y, 7.0f);
    l.x = __builtin_amdgcn_fmed3f(l.x, -7.0f, 7.0f); l.y = __builtin_amdgcn_fmed3f(l.y, -7.0f, 7.0f);
    const f32x2e z = g * (-1.702f * 1.4426950408889634f);
    f32x2e d; d.x = __builtin_amdgcn_exp2f(z.x); d.y = __builtin_amdgcn_exp2f(z.y);
    d = d + 1.0f;
    f32x2e s; s.x = __builtin_amdgcn_rcpf(d.x); s.y = __builtin_amdgcn_rcpf(d.y);
    return (g * s) * (l + 1.0f);
}
typedef unsigned pg_u32x2 __attribute__((ext_vector_type(2)));
constexpr float ACT_F8_SCALE = 4.0f;
template <bool ACT_F8> struct EpiMoeUpT {
    static constexpr bool PERM = true, AFTER_DRAIN = false; static constexpr int NST = 8;
    bf16_t* O; const float* bias; const float* rsc; const float* csc; PG8_LAS unsigned char* sp;
    __device__ __forceinline__ void prefetch(const Unit& u, int wid, int lane) const {
        const int e = u.pn >> 3, pnl = u.pn & 7;
        if (wid < 4) dma4(rsc + u.pm * BM + wid * 64 + lane, sp + wid * 256);
        else if (wid < 6) { const float* b = bias + (size_t)e * 2048 + pnl * HALF + (wid - 4) * 64 + lane; dma4(b, sp + 1024 + (wid - 4) * 256); dma4(b + 1024, sp + 1536 + (wid - 4) * 256); }
        else { const float* c = csc + (size_t)e * 2048 + pnl * 256 + (wid - 6) * 64 + lane; dma4(c, sp + 2048 + (wid - 6) * 256); dma4(c + HALF, sp + 2560 + (wid - 6) * 256); }
    }
    __device__ __forceinline__ void operator()(const i32x4 (&acc)[2][2][4][2], const Unit& u, int wr, int wc, int fr, int fq) const {
        const int pnl = u.pn & 7;
        const int row0 = u.pm * BM + wr * 64 + fr, cg0 = pnl * HALF + wc * 32 + 8 * fq;
        const PG8_LAS float* spf = (const PG8_LAS float*)sp; const int cl = wc * 32 + 8 * fq;
        f32x4 bgv[2], blv[2], sgv[2], slv[2];
#pragma unroll
        for (int n = 0; n < 2; ++n) { bgv[n] = *(const PG8_LAS f32x4*)(spf + 256 + cl + 4 * n); blv[n] = *(const PG8_LAS f32x4*)(spf + 384 + cl + 4 * n); sgv[n] = *(const PG8_LAS f32x4*)(spf + 512 + cl + 4 * n); slv[n] = *(const PG8_LAS f32x4*)(spf + 640 + cl + 4 * n); }
#pragma unroll
        for (int ai = 0; ai < 2; ++ai)
#pragma unroll
            for (int m = 0; m < 4; ++m) { const int row = row0 + ai * HALF + m * 16; bf16_t* rowp = O + (size_t)row * 1024 + cg0; const float rs = spf[ai * HALF + wr * 64 + m * 16 + fr];
                float a[8];
#pragma unroll
                for (int n = 0; n < 2; ++n) {
#pragma unroll
                    for (int q = 0; q < 4; q += 2) {
                        const f32x2e gi = (f32x2e){(float)acc[ai][0][m][n][q], (float)acc[ai][0][m][n][q + 1]}, li = (f32x2e){(float)acc[ai][1][m][n][q], (float)acc[ai][1][m][n][q + 1]};
                        const f32x2e sg2 = (f32x2e){sgv[n][q], sgv[n][q + 1]} * rs, sl2 = (f32x2e){slv[n][q], slv[n][q + 1]} * rs;
                        const f32x2e r = swiglu_pk(gi * sg2 + (f32x2e){bgv[n][q], bgv[n][q + 1]}, li * sl2 + (f32x2e){blv[n][q], blv[n][q + 1]});
                        a[4 * n + q] = r.x; a[4 * n + q + 1] = r.y; } }
                if constexpr (ACT_F8) { unsigned w0 = 0u, w1 = 0u;
                    w0 = __builtin_amdgcn_cvt_pk_fp8_f32(a[0] * ACT_F8_SCALE, a[1] * ACT_F8_SCALE, w0, false); w0 = __builtin_amdgcn_cvt_pk_fp8_f32(a[2] * ACT_F8_SCALE, a[3] * ACT_F8_SCALE, w0, true);
                    w1 = __builtin_amdgcn_cvt_pk_fp8_f32(a[4] * ACT_F8_SCALE, a[5] * ACT_F8_SCALE, w1, false); w1 = __builtin_amdgcn_cvt_pk_fp8_f32(a[6] * ACT_F8_SCALE, a[7] * ACT_F8_SCALE, w1, true);
                    *(pg_u32x2*)((unsigned char*)O + (size_t)row * 1024 + cg0) = (pg_u32x2){w0, w1}; }
                else { u32x4 w; w.x = cvt_pk_bf16(a[0], a[1]); w.y = cvt_pk_bf16(a[2], a[3]); w.z = cvt_pk_bf16(a[4], a[5]); w.w = cvt_pk_bf16(a[6], a[7]);
                    *(u32x4*)rowp = w; } }
    }
};
typedef EpiMoeUpT<false> EpiMoeUp;
struct EpiMoeUpNoLoad {
    static constexpr bool PERM = true, AFTER_DRAIN = false; static constexpr int NST = 8;
    __device__ __forceinline__ void prefetch(const Unit&, int, int) const {}
    bf16_t* O; float k0, k1;
    __device__ __forceinline__ void operator()(const i32x4 (&acc)[2][2][4][2], const Unit& u, int wr, int wc, int fr, int fq) const {
        const int pnl = u.pn & 7;
        const int row0 = u.pm * BM + wr * 64 + fr, cg0 = pnl * HALF + wc * 32 + 8 * fq;
#pragma unroll
        for (int ai = 0; ai < 2; ++ai)
#pragma unroll
            for (int m = 0; m < 4; ++m) { const int row = row0 + ai * HALF + m * 16; bf16_t* rowp = O + (size_t)row * 1024 + cg0;
                float a[8];
#pragma unroll
                for (int n = 0; n < 2; ++n) {
#pragma unroll
                    for (int q = 0; q < 4; ++q) { const float g = (float)acc[ai][0][m][n][q] * k0 + k1, l = (float)acc[ai][1][m][n][q] * k0 + k1;
                        a[4 * n + q] = swiglu_c(g, l); } }
                u32x4 w; w.x = cvt_pk_bf16(a[0], a[1]); w.y = cvt_pk_bf16(a[2], a[3]); w.z = cvt_pk_bf16(a[4], a[5]); w.w = cvt_pk_bf16(a[6], a[7]);
                *(u32x4*)rowp = w; }
    }
};
struct EpiMoeUpNoStore {
    static constexpr bool PERM = true, AFTER_DRAIN = false; static constexpr int NST = 8;
    __device__ __forceinline__ void prefetch(const Unit&, int, int) const {}
    bf16_t* O; float k0, k1;
    __device__ __forceinline__ void operator()(const i32x4 (&acc)[2][2][4][2], const Unit& u, int wr, int wc, int fr, int fq) const {
        const int pnl = u.pn & 7;
        const int row0 = u.pm * BM + wr * 64 + fr, cg0 = pnl * HALF + wc * 32 + 8 * fq;
#pragma unroll
        for (int ai = 0; ai < 2; ++ai)
#pragma unroll
            for (int m = 0; m < 4; ++m) { const int row = row0 + ai * HALF + m * 16; bf16_t* rowp = O + (size_t)row * 1024 + cg0;
                float a[8];
#pragma unroll
                for (int n = 0; n < 2; ++n) {
#pragma unroll
                    for (int q = 0; q < 4; ++q) { const float g = (float)acc[ai][0][m][n][q] * k0 + k1, l = (float)acc[ai][1][m][n][q] * k0 + k1;
                        a[4 * n + q] = swiglu_c(g, l); } }
                u32x4 w; w.x = cvt_pk_bf16(a[0], a[1]); w.y = cvt_pk_bf16(a[2], a[3]); w.z = cvt_pk_bf16(a[4], a[5]); w.w = cvt_pk_bf16(a[6], a[7]);
                if (ai == 0 && m == 0) *(u32x4*)rowp = w; else asm volatile("" :: "v"(w)); }
    }
};
template <int SH> struct MoeOrder {
    const PG8_LAS int* ts; int G, c, total; int tsv;
    __device__ __forceinline__ bool next(int i, Unit& u) const {
        const int L = i * G + c; if (L >= total) return false;
        const int pm = L >> SH, pnl = L & ((1 << SH) - 1);
        const unsigned long long mk = __builtin_amdgcn_ballot_w64(pm >= tsv);
        const int e = __builtin_popcount((unsigned)mk & 0xfffffffeu);
        u.pm = pm; u.pn = (e << SH) + pnl; return true;
    }
    __device__ __forceinline__ void a_ready(const Unit&) const {}
    __device__ __forceinline__ void done(const Unit&) const {}
};
typedef int i32x4 __attribute__((ext_vector_type(4)));
template <bool I8> struct AccSel { typedef f32x4 T; };
template <> struct AccSel<true> { typedef i32x4 T; };
template <bool I8> __device__ __forceinline__ typename AccSel<I8>::T mma16(bf16x8 b, bf16x8 a, typename AccSel<I8>::T c) {
    if constexpr (I8) return __builtin_amdgcn_mfma_i32_16x16x64_i8(__builtin_bit_cast(i32x4, b), __builtin_bit_cast(i32x4, a), c, 0, 0, 0);
    else return __builtin_amdgcn_mfma_f32_16x16x32_bf16(b, a, c, 0, 0, 0);
}
typedef int i32x8 __attribute__((ext_vector_type(8)));
__device__ __forceinline__ f32x4 mma_f8(bf16x8 b0, bf16x8 b1, bf16x8 a0, bf16x8 a1, f32x4 c) {
    const i32x4 bl = __builtin_bit_cast(i32x4, b0), bh = __builtin_bit_cast(i32x4, b1), al = __builtin_bit_cast(i32x4, a0), ah = __builtin_bit_cast(i32x4, a1);
    const i32x8 bb = (i32x8){bl[0], bl[1], bl[2], bl[3], bh[0], bh[1], bh[2], bh[3]}, aa = (i32x8){al[0], al[1], al[2], al[3], ah[0], ah[1], ah[2], ah[3]};
    return __builtin_amdgcn_mfma_scale_f32_16x16x128_f8f6f4(bb, aa, c, 0, 0, 0, 0, 0, 0);
}
template <class Epi, class Sched, bool ALIGN_EPI = false, bool SP2 = false, bool I8 = false, bool GATHER = false, bool F8 = false>
__device__ __forceinline__ void gemm_phase(PG8_LAS unsigned char* lds, const Gemm g, const Sched& S, const Epi& E, const int* rowmap = nullptr) {
    int tid_ = threadIdx.x; asm volatile("" : "+v"(tid_));
    const int tid = tid_, wid = __builtin_amdgcn_readfirstlane(tid >> 6), lane = tid & 63, wr = wid >> 2, wc = wid & 3, fr = lane & 15, fq = lane >> 4;
    const int K = g.K, nt = K / BK;
    unsigned voffA, voffB;
    { int R, C; stage_rc(tid * 16, R, C); const int Rb = Epi::PERM ? ((R & ~31) + perm32(R & 31)) : R;
        voffA = (unsigned)(R * K + C) * 2u; voffB = (unsigned)(Rb * K + C) * 2u; }
    const size_t pstep = (size_t)128 * K;
    unsigned offA[2][2];
    constexpr int RM_OFF = STAGE_BYTES + 1024 + 3072;
    const size_t kstep = (size_t)(BK * 2);
    const size_t hstep = (size_t)HALF * K * 2;
    const size_t tstep = 2 * hstep;
    const unsigned ldsw = (unsigned)wid * 1024u;
    const int aoff = lds_byte(wr * 64 + fr, fq * 8), boff = lds_byte(wc * 32 + fr, fq * 8);
#define PG8_SA(b, h) (((b) * 2 + (h)) * HTB)
#define PG8_SB(b, h) ((4 + (b) * 2 + (h)) * HTB)
#define PG8_STAGE(bufoff, gbase, voff) do { _Pragma("unroll") for (int _i = 0; _i < 2; ++_i) \
        __builtin_amdgcn_global_load_lds((const unsigned*)((const char*)(gbase) + (_i ? pstep : (size_t)0) + (voff)), (PG8_LAS unsigned*)(lds + (bufoff) + ldsw + _i * 8192), 16, 0, 0); } while (0)
#define PG8_STAGE_A(bufoff, gbase, h, nextu) do { if constexpr (GATHER) { _Pragma("unroll") for (int _i = 0; _i < 2; ++_i) \
        __builtin_amdgcn_global_load_lds((const unsigned*)((const char*)(gbase) + offA[h][_i]), (PG8_LAS unsigned*)(lds + (bufoff) + ldsw + _i * 8192), 16, 0, 0); } \
    else { PG8_STAGE(bufoff, (gbase) + (h) * hstep, voffA); } } while (0)
#define PG8_GOFF(SRCEXPR) do { _Pragma("unroll") for (int _h = 0; _h < 2; ++_h) _Pragma("unroll") for (int _i = 0; _i < 2; ++_i) { int R_, C_; stage_rc(tid * 16 + _i * 8192, R_, C_); \
        const int ri_ = _h * HALF + R_; offA[_h][_i] = (unsigned)(SRCEXPR) * (unsigned)(K * 2) + (unsigned)(C_ * 2); } } while (0)
#define PG8_LDA(dst, b, h) do { _Pragma("unroll") for (int m = 0; m < 4; ++m) _Pragma("unroll") for (int k = 0; k < 2; ++k) dst[m][k] = *(const PG8_LAS bf16x8*)(lds + PG8_SA(b, h) + aoff + m * 2048 + k * 1024); } while (0)
#define PG8_LDB(dst, b, h) do { _Pragma("unroll") for (int n = 0; n < 2; ++n) _Pragma("unroll") for (int k = 0; k < 2; ++k) dst[n][k] = *(const PG8_LAS bf16x8*)(lds + PG8_SB(b, h) + boff + n * 2048 + k * 1024); } while (0)
#define PG8_MMA(ai, bj, At, Bt) do { __builtin_amdgcn_s_setprio(1); _Pragma("unroll") for (int m = 0; m < 4; ++m) _Pragma("unroll") for (int n = 0; n < 2; ++n) { \
        if constexpr (F8) { const f32x4 c_ = n ? __builtin_shufflevector(acc8[ai][bj][m], acc8[ai][bj][m], 4, 5, 6, 7) : __builtin_shufflevector(acc8[ai][bj][m], acc8[ai][bj][m], 0, 1, 2, 3); \
            const f32x4 d_ = mma_f8(Bt[n][0], Bt[n][1], At[m][0], At[m][1], c_); \
            if (n) { acc8[ai][bj][m][4] = d_[0]; acc8[ai][bj][m][5] = d_[1]; acc8[ai][bj][m][6] = d_[2]; acc8[ai][bj][m][7] = d_[3]; } else { acc8[ai][bj][m][0] = d_[0]; acc8[ai][bj][m][1] = d_[1]; acc8[ai][bj][m][2] = d_[2]; acc8[ai][bj][m][3] = d_[3]; } } \
        else { _Pragma("unroll") for (int k = 0; k < 2; ++k) acc[ai][bj][m][n] = mma16<I8>(Bt[n][k], At[m][k], acc[ai][bj][m][n]); } } __builtin_amdgcn_s_setprio(0); } while (0)
#define PG8_WAIT_V(n) asm volatile("s_waitcnt vmcnt(" #n ")" ::: "memory")
#define PG8_WAIT_L(n) asm volatile("s_waitcnt lgkmcnt(" #n ")" ::: "memory")
#define PG8_WAIT_VR(fl) do { if constexpr (F8) { PG8_WAIT_V(8); } else asm volatile("s_waitcnt vmcnt(%1)\n\tv_cmp_ne_u32_e32 vcc, 0, %0\n\ts_cbranch_vccnz 1f\n\ts_waitcnt vmcnt(8)\n1:" :: "v"(fl), "n"(8 + Epi::NST) : "vcc", "memory"); } while (0)
#define PG8_BAR __builtin_amdgcn_s_barrier()
#define PG8_SCHED __builtin_amdgcn_sched_barrier(0)
    Unit cur, nxt; int ui = 0;
    if (!S.next(0, cur)) return;
    typedef typename AccSel<I8>::T acc4; acc4 acc[2][2][4][2];
    typedef float f32x8 __attribute__((ext_vector_type(8))); f32x8 acc8[2][2][4];
#pragma unroll
    for (int a = 0; a < 2; ++a)
#pragma unroll
        for (int b = 0; b < 2; ++b)
#pragma unroll
            for (int m = 0; m < 4; ++m)
#pragma unroll
                for (int n = 0; n < 2; ++n) { acc[a][b][m][n] = (acc4){0, 0, 0, 0}; if constexpr (F8) acc8[a][b][m] = (f32x8){0.f, 0.f, 0.f, 0.f, 0.f, 0.f, 0.f, 0.f}; }
    bf16x8 At[4][2], B0[2][2], B1[2][2];
    const char* cA = GATHER ? (const char*)g.A : (const char*)g.A + (size_t)cur.pm * tstep; const char* cB = (const char*)g.Bt + (size_t)cur.pn * tstep;
    if constexpr (GATHER) { PG8_GOFF(rowmap[cur.pm * BM + ri_]); }
    S.a_ready(cur);
    if constexpr (SP2) {
        PG8_STAGE(PG8_SB(0, 0), cB, voffB); PG8_STAGE(PG8_SB(0, 1), cB + hstep, voffB); PG8_STAGE_A(PG8_SA(0, 0), cA, 0, false); PG8_STAGE_A(PG8_SA(0, 1), cA, 1, false);
        if (wr == 1) PG8_BAR;
        PG8_WAIT_V(2); PG8_BAR;
        PG8_STAGE(PG8_SB(1, 0), cB + kstep, voffB); PG8_STAGE_A(PG8_SA(1, 0), cA + kstep, 0, false); PG8_STAGE(PG8_SB(1, 1), cB + hstep + kstep, voffB);
        PG8_STAGE_A(PG8_SA(1, 1), cA + kstep, 1, false);
        PG8_WAIT_V(8); PG8_BAR;
    } else {
        PG8_STAGE(PG8_SB(0, 0), cB, voffB); PG8_STAGE_A(PG8_SA(0, 0), cA, 0, false); PG8_STAGE(PG8_SB(0, 1), cB + hstep, voffB); PG8_STAGE_A(PG8_SA(0, 1), cA, 1, false);
        if (wr == 1) PG8_BAR;
        PG8_WAIT_V(4); PG8_BAR;
        PG8_STAGE(PG8_SB(1, 0), cB + kstep, voffB); PG8_STAGE_A(PG8_SA(1, 0), cA + kstep, 0, false); PG8_STAGE(PG8_SB(1, 1), cB + hstep + kstep, voffB);
        PG8_WAIT_V(6); PG8_BAR;
    }
    for (;;) {
        const bool has_next = S.next(ui + 1, nxt);
        if constexpr (GATHER) { if (has_next && wid < 4) __builtin_amdgcn_global_load_lds((const unsigned*)(rowmap + nxt.pm * BM + wid * 64 + lane), (PG8_LAS unsigned*)(lds + RM_OFF + wid * 256), 4, 0, 0); }
        const char* nA = (has_next && !GATHER) ? (const char*)g.A + (size_t)nxt.pm * tstep : cA; const char* nB = has_next ? (const char*)g.Bt + (size_t)nxt.pn * tstep : cB;
        for (int t = 0; t < nt; t += 2) {
            const bool last = (t == nt - 2);
            asm volatile("" : "+v"(voffA), "+v"(voffB));
            const char* a1 = cA + (size_t)(t + 1) * kstep;
            const char* a2 = last ? nA : cA + (size_t)(t + 2) * kstep; const char* b2 = last ? nB : cB + (size_t)(t + 2) * kstep;
            const char* a3 = a2 + kstep; const char* b3 = b2 + kstep;
            if (last && has_next) S.a_ready(nxt);
            if (last) { int ln_ = lane; asm volatile("" : "+v"(ln_)); E.prefetch(cur, wid, ln_); }
            if constexpr (SP2) {
            const int fl = (t == 0 && ui > 0) ? 1 : 0;
            PG8_LDB(B0, 0, 0); PG8_LDB(B1, 0, 1); PG8_SCHED; PG8_LDA(At, 0, 0);
            if constexpr (GATHER) { if (last && has_next) { const PG8_LAS int* rm = (const PG8_LAS int*)(lds + RM_OFF); PG8_GOFF(rm[ri_]); } }
            PG8_WAIT_VR(fl); PG8_WAIT_L(0); PG8_BAR; PG8_MMA(0, 0, At, B0); PG8_MMA(0, 1, At, B1); PG8_BAR; PG8_SCHED;
            PG8_LDA(At, 0, 1); PG8_STAGE(PG8_SB(0, 0), b2, voffB); PG8_STAGE(PG8_SB(0, 1), b2 + hstep, voffB); PG8_STAGE_A(PG8_SA(0, 0), a2, 0, last);
            PG8_WAIT_VR(fl); PG8_WAIT_L(0); PG8_BAR; PG8_MMA(1, 0, At, B0); PG8_MMA(1, 1, At, B1); PG8_BAR; PG8_SCHED;
            PG8_LDB(B0, 1, 0); PG8_LDB(B1, 1, 1); PG8_SCHED; PG8_LDA(At, 1, 0); PG8_STAGE_A(PG8_SA(0, 1), a2, 1, last);
            PG8_WAIT_VR(fl); PG8_WAIT_L(0); PG8_BAR; PG8_MMA(0, 0, At, B0); PG8_MMA(0, 1, At, B1); PG8_BAR; PG8_SCHED;
            PG8_LDA(At, 1, 1); PG8_STAGE(PG8_SB(1, 0), b3, voffB); PG8_STAGE(PG8_SB(1, 1), b3 + hstep, voffB); PG8_STAGE_A(PG8_SA(1, 0), a3, 0, last);
            PG8_WAIT_V(8); PG8_WAIT_L(0); PG8_BAR; PG8_MMA(1, 0, At, B0); PG8_MMA(1, 1, At, B1); PG8_BAR; PG8_SCHED;
            PG8_STAGE_A(PG8_SA(1, 1), a3, 1, last);
            } else {
            PG8_LDB(B0, 0, 0); PG8_SCHED; PG8_LDA(At, 0, 0); PG8_STAGE_A(PG8_SA(1, 1), a1, 1, false);
            if constexpr (GATHER) { if (last && has_next) { const PG8_LAS int* rm = (const PG8_LAS int*)(lds + RM_OFF); PG8_GOFF(rm[ri_]); } }
            PG8_WAIT_L(8); PG8_BAR; PG8_WAIT_L(0); PG8_MMA(0, 0, At, B0); PG8_BAR; PG8_SCHED;
            PG8_LDB(B1, 0, 1); PG8_STAGE(PG8_SB(0, 0), b2, voffB);
            PG8_BAR; PG8_WAIT_L(0); PG8_MMA(0, 1, At, B1); PG8_BAR;
            PG8_LDA(At, 0, 1); PG8_STAGE_A(PG8_SA(0, 0), a2, 0, last);
            PG8_BAR; PG8_WAIT_L(0); PG8_MMA(1, 0, At, B0); PG8_BAR; PG8_SCHED;
            PG8_STAGE(PG8_SB(0, 1), b2 + hstep, voffB);
            PG8_WAIT_V(6); PG8_BAR; PG8_MMA(1, 1, At, B1); PG8_BAR;
            PG8_LDB(B0, 1, 0); PG8_SCHED; PG8_LDA(At, 1, 0); PG8_STAGE_A(PG8_SA(0, 1), a2, 1, last);
            PG8_WAIT_L(8); PG8_BAR; PG8_WAIT_L(0); PG8_MMA(0, 0, At, B0); PG8_BAR; PG8_SCHED;
            PG8_LDB(B1, 1, 1); PG8_STAGE(PG8_SB(1, 0), b3, voffB);
            PG8_BAR; PG8_WAIT_L(0); PG8_MMA(0, 1, At, B1); PG8_BAR;
            PG8_LDA(At, 1, 1); PG8_STAGE_A(PG8_SA(1, 0), a3, 0, last);
            PG8_BAR; PG8_WAIT_L(0); PG8_MMA(1, 0, At, B0); PG8_BAR; PG8_SCHED;
            PG8_STAGE(PG8_SB(1, 1), b3 + hstep, voffB);
            PG8_WAIT_V(6); PG8_BAR; PG8_MMA(1, 1, At, B1); PG8_BAR;
            }
        }
        if constexpr (ALIGN_EPI) { if (wr == 0) PG8_BAR; }
        if constexpr (F8 && !I8) {
#pragma unroll
            for (int a_ = 0; a_ < 2; ++a_)
#pragma unroll
                for (int b_ = 0; b_ < 2; ++b_)
#pragma unroll
                    for (int m = 0; m < 4; ++m) { acc[a_][b_][m][0] = __builtin_shufflevector(acc8[a_][b_][m], acc8[a_][b_][m], 0, 1, 2, 3); acc[a_][b_][m][1] = __builtin_shufflevector(acc8[a_][b_][m], acc8[a_][b_][m], 4, 5, 6, 7); } }
        if constexpr (!Epi::AFTER_DRAIN) { int t2_ = threadIdx.x; asm volatile("" : "+v"(t2_)); E(acc, cur, wr, wc, t2_ & 15, (t2_ & 63) >> 4); S.done(cur); }
        if (!has_next) break;
#pragma unroll
        for (int a = 0; a < 2; ++a)
#pragma unroll
            for (int b = 0; b < 2; ++b)
#pragma unroll
                for (int m = 0; m < 4; ++m)
#pragma unroll
                    for (int n = 0; n < 2; ++n) { acc[a][b][m][n] = (acc4){0, 0, 0, 0}; if constexpr (F8) acc8[a][b][m] = (f32x8){0.f, 0.f, 0.f, 0.f, 0.f, 0.f, 0.f, 0.f}; }
        cur = nxt; cA = nA; cB = nB; ++ui;
        if constexpr (ALIGN_EPI) { if (wr == 1) PG8_BAR; }
    }
    PG8_WAIT_V(0);
    if constexpr (!ALIGN_EPI) { if (wr == 0) PG8_BAR; }
    PG8_BAR;
    if constexpr (Epi::AFTER_DRAIN) { E.fused(acc, cur, wr, wc, fr, fq, lds, wid, lane); S.done(cur); }
#undef PG8_SA
#undef PG8_SB
#undef PG8_STAGE
#undef PG8_STAGE_A
#undef PG8_GOFF
#undef PG8_LDA
#undef PG8_LDB
#undef PG8_MMA
#undef PG8_WAIT_V
#undef PG8_WAIT_L
#undef PG8_WAIT_VR
#undef PG8_BAR
#undef PG8_SCHED
}
}
#include <hip/hip_bf16.h>
#include <cmath>
namespace attn_body {
using bf16=__hip_bfloat16;
using bf16x8=__attribute__((ext_vector_type(8)))short;
using s16x4=__attribute__((ext_vector_type(4)))short;
using f32x16=__attribute__((ext_vector_type(16)))float;
using u32x4=__attribute__((ext_vector_type(4)))unsigned;
constexpr float OSCALE=32.0f;
constexpr int BATCH=8,NHEAD=8,NKVH=2,SEQ=8192,D=64,PQ=2816,PO=1024;
constexpr int NW=8,QBLK=32,QB=QBLK*NW,KVBLK=64,NQB=SEQ/QB;
constexpr int ATTN_UNIT_ROWS=QB;
__device__ __forceinline__ int crow(int r,int hi){return (r&3)+8*(r>>2)+4*hi;}
#define SBAR() __builtin_amdgcn_sched_barrier(0)
__device__ __forceinline__ void cmask(f32x16&p0,f32x16&p1,int jb,int qrel,int hi){
  const float NEG=-INFINITY; int kb=64*jb+4*hi;
  #pragma unroll
  for(int r=0;r<16;++r){int kv=kb+(r&3)+8*(r>>2); if(kv>qrel)p0[r]=NEG; if(kv+32>qrel)p1[r]=NEG;}
}

constexpr int NSLOT=3, SLOTB=8192;
constexpr int LDS_K=0, LDS_V=NSLOT*SLOTB, LDS_WS=2*NSLOT*SLOTB, LDS_OST=LDS_WS+NW*64*4, LDS_BYTES=LDS_OST+NW*4096;
constexpr float C2=0.125f*1.4426950408889634f;
__device__ __forceinline__ void glds16(const void*gsrc,unsigned lds_dst){unsigned keep;
  asm volatile("s_mov_b32 %0, m0\n\ts_mov_b32 m0, %2\n\ts_nop 0\n\tglobal_load_lds_dwordx4 %1, off\n\ts_mov_b32 m0, %0":"=&s"(keep):"v"(gsrc),"s"(lds_dst):"memory");}
__device__ __forceinline__ float max3f(float a,float b,float c){float r;asm("v_max3_f32 %0, %1, %2, %3":"=v"(r):"v"(a),"v"(b),"v"(c));return r;}
__device__ __forceinline__ float max2f(float a,float b){float r;asm("v_max_f32_e32 %0, %1, %2":"=v"(r):"v"(a),"v"(b));return r;}
__device__ __forceinline__ float fadd_s(float a,float b){float r;asm("v_add_f32_e32 %0, %1, %2":"=v"(r):"v"(a),"v"(b));return r;}
__device__ __forceinline__ float fsub_s(float a,float b){float r;asm("v_sub_f32_e32 %0, %1, %2":"=v"(r):"v"(a),"v"(b));return r;}
typedef float f32x2_t __attribute__((ext_vector_type(2))); typedef __bf16 bf16x2_t __attribute__((ext_vector_type(2)));
__device__ __forceinline__ unsigned cvtpk_s(float lo,float hi){f32x2_t v={lo,hi};bf16x2_t b=__builtin_convertvector(v,bf16x2_t);return __builtin_bit_cast(unsigned,b);}
#define WAIT_BAR(N) asm volatile("s_waitcnt vmcnt(" #N ") lgkmcnt(0)\n\ts_barrier":::"memory")

__device__ __forceinline__ void qkt(f32x16&p0,f32x16&p1,const char*Kslot,const bf16x8*qr,const f32x16&negm,int r32,int hi){
  const char*kb=Kslot+hi*1024+r32*16;
  #pragma unroll
  for(int d0=0;d0<4;++d0){
    const bf16x8 b0=*reinterpret_cast<const bf16x8*>(kb+d0*2048);
    const bf16x8 b1=*reinterpret_cast<const bf16x8*>(kb+d0*2048+512);
    if(d0==0){p0=__builtin_amdgcn_mfma_f32_32x32x16_bf16(b0,qr[0],negm,0,0,0);p1=__builtin_amdgcn_mfma_f32_32x32x16_bf16(b1,qr[0],negm,0,0,0);}
    else{p0=__builtin_amdgcn_mfma_f32_32x32x16_bf16(b0,qr[d0],p0,0,0,0);p1=__builtin_amdgcn_mfma_f32_32x32x16_bf16(b1,qr[d0],p1,0,0,0);}}
}
typedef __attribute__((address_space(3))) const char* lds_cptr;
typedef short v4i16_t __attribute__((ext_vector_type(4)));
__device__ __forceinline__ void kload8(bf16x8*kf,lds_cptr kp){
  kf[0]=*(const __attribute__((address_space(3))) bf16x8*)(kp);      kf[1]=*(const __attribute__((address_space(3))) bf16x8*)(kp+512);
  kf[2]=*(const __attribute__((address_space(3))) bf16x8*)(kp+2048); kf[3]=*(const __attribute__((address_space(3))) bf16x8*)(kp+2560);
  kf[4]=*(const __attribute__((address_space(3))) bf16x8*)(kp+4096); kf[5]=*(const __attribute__((address_space(3))) bf16x8*)(kp+4608);
  kf[6]=*(const __attribute__((address_space(3))) bf16x8*)(kp+6144); kf[7]=*(const __attribute__((address_space(3))) bf16x8*)(kp+6656);
}
__device__ __forceinline__ void kload2(bf16x8*kf,lds_cptr kp,int j){ kf[2*j]=*(const __attribute__((address_space(3))) bf16x8*)(kp+j*2048); kf[2*j+1]=*(const __attribute__((address_space(3))) bf16x8*)(kp+j*2048+512); }
__device__ __forceinline__ s16x4 vtr(lds_cptr p){ return __builtin_bit_cast(s16x4,__builtin_amdgcn_ds_read_tr16_b64_v4i16((__attribute__((address_space(3))) v4i16_t*)p)); }
__device__ __forceinline__ float rowmax(const f32x16&p0,const f32x16&p1){
  float a=max3f(p0[0],p0[1],p1[0]),b=max3f(p0[2],p0[3],p1[1]);a=max3f(a,p1[2],p1[3]);
  #pragma unroll
  for(int r=4;r<16;r+=4){a=max3f(a,p0[r],p0[r+1]);b=max3f(b,p0[r+2],p0[r+3]);a=max3f(a,p1[r],p1[r+1]);b=max3f(b,p1[r+2],p1[r+3]);}
  const float m=max2f(a,b);
  auto rr=__builtin_amdgcn_permlane32_swap(__float_as_uint(m),__float_as_uint(m),false,false);
  return max2f(__uint_as_float(rr[0]),__uint_as_float(rr[1]));
}
__device__ __forceinline__ void pv(f32x16*o,int vb,bf16x8 pa0,bf16x8 pa1,bf16x8 pa2,bf16x8 pa3){
  #pragma unroll
  for(int d0=0;d0<2;++d0){s16x4 lo[4],hi[4];
    #pragma unroll
    for(int ks=0;ks<4;++ks){
      asm volatile("ds_read_b64_tr_b16 %0,%1 offset:%c2":"=&v"(lo[ks]):"v"(vb),"i"(d0*4096+ks*1024):"memory");
      asm volatile("ds_read_b64_tr_b16 %0,%1 offset:%c2":"=&v"(hi[ks]):"v"(vb),"i"(d0*4096+ks*1024+512):"memory");}
    asm volatile("s_waitcnt lgkmcnt(0)":::"memory");SBAR();
    #define PK(k) (bf16x8){lo[k][0],lo[k][1],lo[k][2],lo[k][3],hi[k][0],hi[k][1],hi[k][2],hi[k][3]}
    o[d0]=__builtin_amdgcn_mfma_f32_32x32x16_bf16(pa0,PK(0),o[d0],0,0,0);
    o[d0]=__builtin_amdgcn_mfma_f32_32x32x16_bf16(pa1,PK(1),o[d0],0,0,0);
    o[d0]=__builtin_amdgcn_mfma_f32_32x32x16_bf16(pa2,PK(2),o[d0],0,0,0);
    o[d0]=__builtin_amdgcn_mfma_f32_32x32x16_bf16(pa3,PK(3),o[d0],0,0,0);
    #undef PK
  }
}

#ifndef ATTN_STORE16
#define ATTN_STORE16(p,v) (*(u32x4*)(p)=(v))
#endif
template<int THRL> __device__ __forceinline__ void attn_unit(int b,int h,int qb,const bf16*Q,const bf16*__restrict__ K,const bf16*__restrict__ V,bf16*O,char*shm,const float*qg,const float nref){
  int tid_=threadIdx.x; asm volatile("":"+v"(tid_)); const int tid=tid_,lane=tid&63,r32=lane&31,hi=lane>>5; const int wid=__builtin_amdgcn_readfirstlane(tid>>6);
  const long rowbase=(long)b*SEQ; const int q0=qb*QB;
  const bf16*Qw=Q+(rowbase+q0+wid*QBLK)*PQ+h*D;
  const bf16*Kh=K+rowbase*PQ+(h>>2)*D,*Vh=V+rowbase*PQ+(h>>2)*D;
  const unsigned lds0=(unsigned)(uintptr_t)shm;
  float*wsf=(float*)(shm+LDS_WS)+wid*64;
  const bf16*ksrc=Kh+(long)lane*PQ+wid*8;
  const bf16*vsrc=Vh+(long)(16*(wid&3)+(lane>>2))*PQ+(wid>>2)*32+(lane&3)*8;
  const unsigned kdst=lds0+LDS_K+wid*1024, vdst=lds0+LDS_V+wid*1024;
  #define DMA_K(t,slot) glds16(ksrc+(long)(t)*KVBLK*PQ,(unsigned)__builtin_amdgcn_readfirstlane(kdst+(slot)))
  #define DMA_V(t,slot) glds16(vsrc+(long)(t)*KVBLK*PQ,(unsigned)__builtin_amdgcn_readfirstlane(vdst+(slot)))
  const int vb0=(int)(lds0+LDS_V)+((lane>>4)&1)*32+(lane&3)*8+(4*hi+((lane&15)>>2))*64;
  const char*Kbase=shm+LDS_K; bf16x8 kf[8];
  const lds_cptr shm3=(lds_cptr)shm; const lds_cptr kp0=shm3+LDS_K+hi*1024+r32*16; const lds_cptr vp0=shm3+LDS_V+((lane>>4)&1)*32+(lane&3)*8+(4*hi+((lane&15)>>2))*64;
  constexpr int NT=SEQ/KVBLK;
  DMA_K(0,0);DMA_V(0,0);DMA_K(1,SLOTB);
  bf16x8 qr[4];
  #pragma unroll
  for(int d0=0;d0<4;++d0)qr[d0]=*reinterpret_cast<const bf16x8*>(&Qw[(long)r32*PQ+d0*16+hi*8]);
  {
    float y[4][8]; float ss=0.f;
    #pragma unroll
    for(int d0=0;d0<4;++d0){
      #pragma unroll
      for(int j=0;j<8;++j){ y[d0][j]=__uint_as_float(((unsigned)(unsigned short)qr[d0][j])<<16); ss+=y[d0][j]*y[d0][j]; } }
    { auto rr=__builtin_amdgcn_permlane32_swap(__float_as_uint(ss),__float_as_uint(ss),false,false); ss=__uint_as_float(rr[0])+__uint_as_float(rr[1]); }
    const float rs=__builtin_amdgcn_rsqf(ss*(1.f/64.f)+1e-6f);
    const int spos=q0+wid*QBLK+r32; const float rid=(float)(spos>>6),cid=(float)(spos&63);
    #pragma unroll
    for(int j=0;j<8;++j){ const float fr=__builtin_amdgcn_exp2f(-(float)(8*hi+j)*(13.287712379549449f/16.f));
      const float cr=__cosf(rid*fr),sr=__sinf(rid*fr),cc=__cosf(cid*fr),sc=__sinf(cid*fr);
      const float a1=y[0][j]*rs*qg[8*hi+j],a2=y[1][j]*rs*qg[16+8*hi+j],b1=y[2][j]*rs*qg[32+8*hi+j],b2=y[3][j]*rs*qg[48+8*hi+j];
      y[0][j]=(a1*cr-a2*sr)*C2; y[1][j]=(a2*cr+a1*sr)*C2; y[2][j]=(b1*cc-b2*sc)*C2; y[3][j]=(b2*cc+b1*sc)*C2; }
    #pragma unroll
    for(int d0=0;d0<4;++d0){ u32x4 w; w.x=cvtpk_s(y[d0][0],y[d0][1]); w.y=cvtpk_s(y[d0][2],y[d0][3]); w.z=cvtpk_s(y[d0][4],y[d0][5]); w.w=cvtpk_s(y[d0][6],y[d0][7]); qr[d0]=__builtin_bit_cast(bf16x8,w); }
  }
  float l_reg=0.f;f32x16 o[2];o[0]=f32x16{};o[1]=f32x16{};f32x16 negm; _Pragma("unroll") for(int r=0;r<16;++r)negm[r]=nref; asm volatile("":"+v"(negm));
  #define CMASK(P0,P1,t) do{}while(0)
  #define START(P0,P1) do{ _Pragma("unroll") for(int r=0;r<16;++r)P0[r]=__builtin_amdgcn_exp2f(P0[r]); }while(0)
  #define RESC() do{}while(0)
  f32x16 pA0,pA1,pB0,pB1;
  int sl_prev=0,sl_cur=0,sl_next=SLOTB;
  #define ROT() do{sl_prev=sl_cur;sl_cur=sl_next;sl_next=(sl_next==(NSLOT-1)*SLOTB)?0:sl_next+SLOTB;}while(0)
  DMA_K(2,2*SLOTB);
  WAIT_BAR(3);
  qkt(pA0,pA1,Kbase,qr,negm,r32,hi);asm volatile("s_nop 15\n\ts_nop 7":"+v"(pA0),"+v"(pA1));CMASK(pA0,pA1,0);
  START(pA0,pA1);
  _Pragma("unroll") for(int r=0;r<16;++r)pA1[r]=__builtin_amdgcn_exp2f(pA1[r]);
  WAIT_BAR(0);
  DMA_K(3,0);DMA_V(1,SLOTB);
  ROT();
  kload8(kf,kp0+sl_cur);
  WAIT_BAR(2);
  s16x4 vlo[8],vhi[8]; u32x4 pw0,pw1,pw2,pw3;
  #define PKW(P,B) cvtpk_s(P[B],P[B+1])
  #define PAF(k) __builtin_bit_cast(bf16x8,pw##k)
  #define VFR(i) (bf16x8){vlo[i][0],vlo[i][1],vlo[i][2],vlo[i][3],vhi[i][0],vhi[i][1],vhi[i][2],vhi[i][3]}
  #define PIN(x) asm volatile("":"+v"(x))
  #define MX3(a,b,c) __builtin_fmaxf(__builtin_fmaxf((a),(b)),(c))
  #define GAPA(MF,A0,A1,A2,A3,W0,W1,PW) do{ MF; sacc+=A0; sacc+=A1; sacc+=A2; sacc+=A3; PIN(sacc); W0; W1; PIN(PW); SBAR(); }while(0)
  #define EX(v) __builtin_amdgcn_exp2f(v)
  #define GAPB(MF,X,B) do{ MF; X[B]=EX(X[B]); X[B+1]=EX(X[B+1]); X[B+2]=EX(X[B+2]); X[B+3]=EX(X[B+3]); PIN(X); SBAR(); }while(0)
  #define VRD(i) do{ vlo[i]=vtr(vp_+(((i)>>2)*4096+((i)&3)*1024)); vhi[i]=vtr(vp_+(((i)>>2)*4096+((i)&3)*1024+512)); }while(0)
  #define KRD(G,j) do{ if(G){ kload2(kf,kp0+sl_next,j); SBAR(); } }while(0)
  #define STEP(C0,C1,P0,P1,t,GK,GV,GL) do{ SBAR(); \
    const lds_cptr vp_=vp0+sl_prev; \
    VRD(0); SBAR(); float sacc=(P0[0]+P0[1]); \
    GAPA(C0=__builtin_amdgcn_mfma_f32_32x32x16_bf16(kf[0],qr[0],negm,0,0,0), P0[2],P0[3],P0[4],P0[5],     pw0[0]=PKW(P0,0), pw0[1]=PKW(P0,2), pw0); \
    VRD(4); SBAR(); GAPA(C1=__builtin_amdgcn_mfma_f32_32x32x16_bf16(kf[1],qr[0],negm,0,0,0), P0[6],P0[7],P0[8],P0[9],     pw0[2]=PKW(P0,4), pw0[3]=PKW(P0,6), pw0); \
    VRD(1); SBAR(); GAPA(C0=__builtin_amdgcn_mfma_f32_32x32x16_bf16(kf[2],qr[1],C0,0,0,0),   P0[10],P0[11],P0[12],P0[13], pw1[0]=PKW(P0,8), pw1[1]=PKW(P0,10), pw1); \
    VRD(5); SBAR(); GAPA(C1=__builtin_amdgcn_mfma_f32_32x32x16_bf16(kf[3],qr[1],C1,0,0,0),   P0[14],P0[15],P1[0],P1[1],   pw1[2]=PKW(P0,12),pw1[3]=PKW(P0,14), pw1); \
    VRD(2); SBAR(); GAPA(C0=__builtin_amdgcn_mfma_f32_32x32x16_bf16(kf[4],qr[2],C0,0,0,0),   P1[2],P1[3],P1[4],P1[5],     pw2[0]=PKW(P1,0), pw2[1]=PKW(P1,2), pw2); \
    VRD(6); SBAR(); GAPA(C1=__builtin_amdgcn_mfma_f32_32x32x16_bf16(kf[5],qr[2],C1,0,0,0),   P1[6],P1[7],P1[8],P1[9],     pw2[2]=PKW(P1,4), pw2[3]=PKW(P1,6), pw2); \
    VRD(3); SBAR(); GAPA(C0=__builtin_amdgcn_mfma_f32_32x32x16_bf16(kf[6],qr[3],C0,0,0,0),   P1[10],P1[11],P1[12],P1[13], pw3[0]=PKW(P1,8), pw3[1]=PKW(P1,10), pw3); \
    VRD(7); SBAR(); GAPA(C1=__builtin_amdgcn_mfma_f32_32x32x16_bf16(kf[7],qr[3],C1,0,0,0),   P1[14],P1[15],0.f,0.f,       pw3[2]=PKW(P1,12),pw3[3]=PKW(P1,14), pw3); \
    l_reg+=sacc; \
    if(GK){DMA_K((t)+3,sl_cur);} if(GV){DMA_V((t)+1,sl_next);} \
    CMASK(C0,C1,t); \
    SBAR(); \
    GAPB(o[0]=__builtin_amdgcn_mfma_f32_32x32x16_bf16(PAF(0),VFR(0),o[0],0,0,0), C0,0); \
    GAPB(o[1]=__builtin_amdgcn_mfma_f32_32x32x16_bf16(PAF(0),VFR(4),o[1],0,0,0), C0,4); \
    KRD(GL,0); GAPB(o[0]=__builtin_amdgcn_mfma_f32_32x32x16_bf16(PAF(1),VFR(1),o[0],0,0,0), C0,8); \
    KRD(GL,1); GAPB(o[1]=__builtin_amdgcn_mfma_f32_32x32x16_bf16(PAF(1),VFR(5),o[1],0,0,0), C0,12); \
    KRD(GL,2); GAPB(o[0]=__builtin_amdgcn_mfma_f32_32x32x16_bf16(PAF(2),VFR(2),o[0],0,0,0), C1,0); \
    KRD(GL,3); GAPB(o[1]=__builtin_amdgcn_mfma_f32_32x32x16_bf16(PAF(2),VFR(6),o[1],0,0,0), C1,4); \
    GAPB(o[0]=__builtin_amdgcn_mfma_f32_32x32x16_bf16(PAF(3),VFR(3),o[0],0,0,0), C1,8); \
    GAPB(o[1]=__builtin_amdgcn_mfma_f32_32x32x16_bf16(PAF(3),VFR(7),o[1],0,0,0), C1,12); \
    }while(0)
  int t=1;
  #undef CMASK
  #define CMASK(P0,P1,t) do{}while(0)
  for(;t+5<NT;t+=2){
    STEP(pB0,pB1,pA0,pA1,t,true,true,true);     WAIT_BAR(2); RESC(); ROT();
    STEP(pA0,pA1,pB0,pB1,t+1,true,true,true);   WAIT_BAR(2); RESC(); ROT();
  }
  #undef CMASK
  #define CMASK(P0,P1,t) do{}while(0)
  #define ENDW(tt) do{ if((tt)+3<NT){WAIT_BAR(2);} else if((tt)+2<NT){WAIT_BAR(1);} else {WAIT_BAR(0);} }while(0)
  for(;t+1<NT;t+=2){
    STEP(pB0,pB1,pA0,pA1,t,(t+3<NT),(t+1<NT),(t+1<NT));       ENDW(t);   RESC(); ROT();
    STEP(pA0,pA1,pB0,pB1,t+1,(t+4<NT),(t+2<NT),(t+2<NT));     ENDW(t+1); RESC(); ROT();
  }
  STEP(pB0,pB1,pA0,pA1,NT-1,false,false,false); RESC();
  { float sacc=pB0[0]+pB0[1]; _Pragma("unroll") for(int r=2;r<16;++r)sacc+=pB0[r]; _Pragma("unroll") for(int r=0;r<16;++r)sacc+=pB1[r]; l_reg+=sacc;
    pw0=(u32x4){PKW(pB0,0),PKW(pB0,2),PKW(pB0,4),PKW(pB0,6)};pw1=(u32x4){PKW(pB0,8),PKW(pB0,10),PKW(pB0,12),PKW(pB0,14)};pw2=(u32x4){PKW(pB1,0),PKW(pB1,2),PKW(pB1,4),PKW(pB1,6)};pw3=(u32x4){PKW(pB1,8),PKW(pB1,10),PKW(pB1,12),PKW(pB1,14)};
    SBAR(); pv(o,vb0+sl_cur,PAF(0),PAF(1),PAF(2),PAF(3)); }
  #undef PKW
  #undef PAF
  #undef VFR
  #undef PIN
  #undef MX3
  #undef GAPA
  #undef GAPB
  #undef EX
  #undef VRD
  #undef KRD
  #undef STEP
  #undef ENDW
  {auto rr=__builtin_amdgcn_permlane32_swap(__float_as_uint(l_reg),__float_as_uint(l_reg),false,false);l_reg=__uint_as_float(rr[0])+__uint_as_float(rr[1]);}
  if(hi==0)wsf[32+r32]=l_reg;asm volatile("s_waitcnt lgkmcnt(0)":::"memory");
  float rli[16];
  #pragma unroll
  for(int r=0;r<16;++r)rli[r]=__builtin_amdgcn_rcpf(wsf[32+crow(r,hi)]);
  unsigned char*Ow=(unsigned char*)O+(rowbase+q0+wid*QBLK)*PO+h*D;
  { unsigned char*stg=(unsigned char*)(shm+LDS_OST)+wid*2048;
    #pragma unroll
    for(int r=0;r<16;++r){const int orow=crow(r,hi); const float sc=rli[r]*OSCALE;
      #pragma unroll
      for(int d0=0;d0<2;++d0){ const float v=__builtin_amdgcn_fmed3f(o[d0][r]*sc,-448.0f,448.0f); stg[orow*64+d0*32+r32]=(unsigned char)(__builtin_amdgcn_cvt_pk_fp8_f32(v,0.f,0u,false)&0xffu); } }
    asm volatile("s_waitcnt lgkmcnt(0)":::"memory");
    #pragma unroll
    for(int i=0;i<2;++i){const int row=i*16+(lane>>2),ch=lane&3; const u32x4 v=*(const u32x4*)(stg+row*64+ch*16); ATTN_STORE16(Ow+(long)row*PO+ch*16,v);} }
  asm volatile("s_waitcnt lgkmcnt(0)\n\ts_barrier":::"memory");
  #undef DMA_K
  #undef DMA_V
  #undef CMASK
  #undef START
  #undef RESC
  #undef ROT
}
constexpr int ATTN_LDS_BYTES=LDS_BYTES;
struct AttnTensors { const bf16* Q; const bf16* K; const bf16* V; bf16* O; const float* qg; const float* kg; };
template<int THRL=8> __device__ __forceinline__ void attn_phase(char*lds,const AttnTensors&T,int vcu,int G){
  float gq=fabsf(T.qg[threadIdx.x&63]),gk=fabsf(T.kg[threadIdx.x&63]);
  gq=wmax64(gq); gk=wmax64(gk);
  const float nref=__uint_as_float(__builtin_amdgcn_readfirstlane(__float_as_uint(-(64.f*C2*gq*gk*1.02f+0.25f))));
  for(int L=vcu;L<BATCH*NHEAD*NQB;L+=G){
    const int pair=((L>>5)&7)*2+((L>>8)>>2), idx=(L&31)+32*((L>>8)&3);
    const int b=pair>>1, h=(pair&1)*4+(idx>>5), qb=idx&31;
    attn_unit<THRL>(b,h,qb,T.Q,T.K,T.V,T.O,lds,T.qg,nref);
  }
}
#undef SBAR
#undef WAIT_BAR
}
constexpr int NWAVES = 8;
constexpr int NTHR = NWAVES * 64;
constexpr int BATCH = 8, T = 8192, D = 1024, DEPTH = 2;
constexpr int M = BATCH * T;
constexpr int INW = 2816;
constexpr int C_QA = 0, C_KA = 512, C_VA = 640, C_QR = 768, C_KR = 1280, C_VR = 1792, C_GR = 2304;
constexpr int NE = 32, TOPK = 4, NASG = M * TOPK;
constexpr int XS_ROWS = NASG + NE * 256;
constexpr int RCH = 128, NCH = T / RCH, RH = 4;
constexpr int RUNITS = BATCH * RH * NCH;
constexpr float EPS = 1e-6f;
constexpr float LOG2E = 1.4426950408889634f;

constexpr size_t MiB = 1u << 20;
constexpr size_t WS_CTL = 0, CTL_ZERO_BYTES = 2 * MiB;
constexpr size_t WS_MOD = 512 * 1024;
constexpr size_t WS_CMAXIN = 256 * 1024, WS_CSCIN = 320 * 1024;
constexpr size_t WS_CMAX = 1 * MiB;
constexpr size_t WS_CSCDN = 1 * MiB;
constexpr size_t WS_CSCOUT = 1 * MiB + 256 * 1024;
constexpr float CAT_S_ATT = 32.0f, CAT_S_RET = 8.0f;
static_assert(attn_body::OSCALE == CAT_S_ATT, "attention output scale");
constexpr size_t WS_CSC = 1 * MiB + 512 * 1024;
constexpr size_t WS_WIN = 2 * MiB;
constexpr size_t WS_WOUT = 13 * MiB;
constexpr size_t WS_WUP = 17 * MiB;
constexpr size_t WS_WDN = 273 * MiB;
constexpr size_t WS_HM = 401 * MiB;
constexpr size_t WS_TOPI = 529 * MiB, WS_TOPW = 530 * MiB, WS_POS = 531 * MiB;
constexpr size_t WS_PROJ = 532 * MiB;
constexpr size_t WS_CAT = 884 * MiB;
constexpr size_t WS_YM = 1012 * MiB;
constexpr size_t WS_U = 1140 * MiB;
constexpr size_t WS_FT = 1396 * MiB;
constexpr size_t WS_XS = 532 * MiB;
constexpr size_t WS_ACT = 1060 * MiB;
constexpr size_t WS_HS = 1588 * MiB;
constexpr size_t WS_XSC = 1589 * MiB;
constexpr size_t WS_RMAP = 1591 * MiB;
constexpr size_t WS_END = 1593 * MiB;
constexpr size_t WS_DUMMY = 1593 * MiB;
static_assert(WS_MOD + (size_t)DEPTH * BATCH * 6 * D * 4 <= CTL_ZERO_BYTES, "mod inside the memset region");
static_assert(WS_XS + (size_t)XS_ROWS * 1024 * 2 <= WS_ACT && WS_ACT + (size_t)XS_ROWS * 1024 * 2 <= WS_END, "moe map");
static_assert(WS_PROJ + (size_t)M * INW * 2 <= WS_CAT && WS_FT + (size_t)RUNITS * 2 * 16384 * 2 <= WS_END, "mixer map");
constexpr int CW_TMO = 0, CW_CODE = 1;
constexpr int CW_BAR = 4096;
constexpr int CW_CNT = 8192;
constexpr int CW_WQ = 8192 + 1024;
constexpr int CW_CUR = 8192 + 256;

constexpr int RING_OFF = 0, RING_BYTES = 131072;
constexpr int LDSCTL_OFF = RING_BYTES;
constexpr int LCNT_OFF = LDSCTL_OFF, LTS_OFF = LDSCTL_OFF + 128, MISC_OFF = LDSCTL_OFF + 320;
constexpr int EPI_SP_OFF = LDSCTL_OFF + 1024;
constexpr int GAIN_OFF = LDSCTL_OFF + 6144;
constexpr int LDS_BYTES = 147456;
#define GAS __attribute__((address_space(1)))
#define LAS __attribute__((address_space(3)))
typedef unsigned short bf16;
typedef unsigned v4u __attribute__((ext_vector_type(4)));
typedef float f32x4 __attribute__((ext_vector_type(4)));
typedef short bf16x8 __attribute__((ext_vector_type(8)));
typedef GAS unsigned gu32;
typedef GAS unsigned long long gu64;
#define RLX_AGENT __ATOMIC_RELAXED, __HIP_MEMORY_SCOPE_AGENT
#define LDS_WAIT() asm volatile("s_waitcnt lgkmcnt(0)" ::: "memory")
#define VM_WAIT() asm volatile("s_waitcnt vmcnt(0)" ::: "memory")
__device__ __forceinline__ unsigned long long rt() { return __builtin_amdgcn_s_memrealtime(); }
__device__ __forceinline__ unsigned f2bf(float f) { unsigned u = __builtin_bit_cast(unsigned, f); return (u + 0x7fffu + ((u >> 16) & 1u)) >> 16; }
__device__ __forceinline__ unsigned pk2(float lo, float hi) { return f2bf(lo) | (f2bf(hi) << 16); }

#define XB_TMO      128
#define XB_XCNT(j)  (256  + 64 * (j))
#define XB_XSUB(j)  (1280 + 64 * (j))
#define XB_XGEN(j)  (2304 + 64 * (j))
#define XB_TOP      3328
#define XB_TOPGEN   3392
#define XCD_BAR_WORDS 3456
#define XB_SPIN_CAP (1u << 18)

__device__ __forceinline__ unsigned xb_ld(unsigned* p)              { return __hip_atomic_load(p, __ATOMIC_RELAXED, __HIP_MEMORY_SCOPE_AGENT); }
__device__ __forceinline__ unsigned xb_add(unsigned* p, unsigned v) { return __hip_atomic_fetch_add(p, v, __ATOMIC_RELAXED, __HIP_MEMORY_SCOPE_AGENT); }
__device__ __forceinline__ unsigned xb_xcc_id() { return (unsigned)__builtin_amdgcn_s_getreg((3 << 11) | 20) & 0xFu; }
#define XB_SPIN(cond, bar) do { unsigned _sp = 0; while (cond) { __builtin_amdgcn_s_sleep(1); \
    if ((++_sp & 255u) == 0u) { if (xb_ld(&(bar)[XB_TMO])) break; if (_sp > XB_SPIN_CAP) { atomicAdd(&(bar)[XB_TMO], 1u); break; } } } } while (0)

struct XcdBarrier {
    unsigned* bar; unsigned x;
    volatile LAS unsigned* st;
};

__device__ __forceinline__ XcdBarrier xcd_barrier_post(unsigned* bar, volatile LAS unsigned* st) {
    XcdBarrier b; b.bar = bar; b.x = xb_xcc_id(); b.st = st;
    if (threadIdx.x == 0) (void)xb_add(&bar[XB_XCNT(b.x)], 1u);
    return b;
}
__device__ __forceinline__ void xcd_barrier_complete(unsigned* bar, unsigned x, unsigned& nloc, unsigned& nx) {
    const unsigned G = gridDim.x * gridDim.y * gridDim.z;
    unsigned sum, cnt, mine, sp = 0u;
    for (;;) {
        sum = 0u; cnt = 0u; mine = 0u;
#pragma unroll
        for (unsigned j = 0; j < 16; ++j) { const unsigned c = xb_ld(&bar[XB_XCNT(j)]); sum += c; cnt += (c > 0u) ? 1u : 0u; mine = (j == x) ? c : mine; }
        if (sum == G) break;
        __builtin_amdgcn_s_sleep(1);
        if ((++sp & 255u) == 0u) { if (xb_ld(&bar[XB_TMO])) break; if (sp > XB_SPIN_CAP) { atomicAdd(&bar[XB_TMO], 1u); break; } }
    }
    nloc = mine > 0u ? mine : 1u; nx = cnt > 0u ? cnt : 1u;
}

__device__ __forceinline__ void xcd_barrier(const XcdBarrier& b) {
    asm volatile("s_waitcnt vmcnt(0)" ::: "memory");
    __syncthreads();
    if (threadIdx.x == 0) {
        unsigned* bar = b.bar;
        __builtin_amdgcn_s_waitcnt(0);
        unsigned nloc = b.st[0], nx = b.st[1];
        if (nloc == 0u) { xcd_barrier_complete(bar, b.x, nloc, nx); b.st[0] = nloc; b.st[1] = nx; }
        const unsigned old = xb_add(&bar[XB_XSUB(b.x)], 1u);
        const unsigned gen = old / nloc;
        if (old + 1u == (gen + 1u) * nloc) {
            __builtin_amdgcn_fence(__ATOMIC_RELEASE, "agent");
            asm volatile("s_waitcnt vmcnt(0)" ::: "memory");
            const unsigned og = xb_add(&bar[XB_TOP], 1u);
            const unsigned tg = og / nx;
            if (og + 1u == (tg + 1u) * nx) xb_add(&bar[XB_TOPGEN], 1u);
            else XB_SPIN(xb_ld(&bar[XB_TOPGEN]) == tg, bar);
            __builtin_amdgcn_fence(__ATOMIC_ACQUIRE, "agent");
            xb_add(&bar[XB_XGEN(b.x)], 1u);
            asm volatile("s_waitcnt vmcnt(0)" ::: "memory");
        } else {
            XB_SPIN(xb_ld(&bar[XB_XGEN(b.x)]) == gen, bar);
            __builtin_amdgcn_fence(__ATOMIC_ACQUIRE, "agent");
            asm volatile("s_waitcnt vmcnt(0)" ::: "memory");
        }
    }
    __syncthreads();
}

typedef unsigned u32x2 __attribute__((ext_vector_type(2)));
typedef short s16x4 __attribute__((ext_vector_type(4)));
typedef float f32x16 __attribute__((ext_vector_type(16)));
typedef int i32x4 __attribute__((ext_vector_type(4)));
struct Frame {
    LAS unsigned char* lds;
    volatile LAS unsigned* MISC;
    gu32* ctl;
    int tid, lane, wave, vcu, G;
};
__device__ __forceinline__ float wave_sum(float v) {
    return wsum64(v);
}
__device__ __forceinline__ float bflo(unsigned w) { return __uint_as_float(w << 16); }
__device__ __forceinline__ float bfhi(unsigned w) { return __uint_as_float(w & 0xffff0000u); }
__device__ __forceinline__ unsigned pkbf(float lo, float hi) { return pg8::cvt_pk_bf16(lo, hi); }
__device__ __forceinline__ float fexp2(float x) { return __builtin_amdgcn_exp2f(x); }
__device__ __forceinline__ float frsq(float x) { return __builtin_amdgcn_rsqf(x); }
__device__ __forceinline__ float frcp(float x) { return __builtin_amdgcn_rcpf(x); }
__device__ __forceinline__ float row_rstd(const f32x4 (&v)[4]) {
    float s = 0.f;
#pragma unroll
    for (int j = 0; j < 4; ++j) s += (v[j].x * v[j].x + v[j].y * v[j].y) + (v[j].z * v[j].z + v[j].w * v[j].w);
    return frsq(wave_sum(s) * (1.f / D) + EPS);
}
__device__ __forceinline__ void store_row_bf16(bf16* orow, const f32x4 (&v)[4], int lane) {
    u32x2* o8 = (u32x2*)orow + lane;
#pragma unroll
    for (int j = 0; j < 4; ++j) { u32x2 w; w.x = pkbf(v[j].x, v[j].y); w.y = pkbf(v[j].z, v[j].w); o8[64 * j] = w; }
}
__device__ __forceinline__ void store_row_bf16_nt(bf16* orow, const f32x4 (&v)[4], int lane) {
    u32x2* o8 = (u32x2*)orow + lane;
#pragma unroll
    for (int j = 0; j < 4; ++j) { u32x2 w; w.x = pkbf(v[j].x, v[j].y); w.y = pkbf(v[j].z, v[j].w); __builtin_nontemporal_store(w, o8 + 64 * j); }
}
__device__ __forceinline__ void load_row_f32(const float* xrow, f32x4 (&v)[4], int lane) {
    const f32x4* xr = (const f32x4*)xrow + lane;
#pragma unroll
    for (int j = 0; j < 4; ++j) v[j] = xr[64 * j];
}
__device__ __forceinline__ void load_row_f32_nt(const float* xrow, f32x4 (&v)[4], int lane) {
    const f32x4* xr = (const f32x4*)xrow + lane;
#pragma unroll
    for (int j = 0; j < 4; ++j) v[j] = __builtin_nontemporal_load(xr + 64 * j);
}
__device__ __forceinline__ void modnorm_row(const f32x4 (&x)[4], f32x4 (&h)[4], const float* g, const float* sc, const float* sh, int lane) {
    const float rs = row_rstd(x);
#pragma unroll
    for (int j = 0; j < 4; ++j) { const f32x4 gv = ((const f32x4*)g)[lane + 64 * j], scv = ((const f32x4*)sc)[lane + 64 * j], shv = ((const f32x4*)sh)[lane + 64 * j];
        h[j] = x[j] * rs * gv * (scv + 1.0f) + shv; }
}

template <bool UPPERM> __device__ __forceinline__ void p0_transpose_item(const float* W, int K, int N, bf16* WT, int item, int lane) {
    const int nblk = N / 256, kb = item / nblk, nb = item - kb * nblk, k0 = 32 * kb, n0 = 256 * nb + 4 * lane;
    const float* src = W + (size_t)k0 * N + n0;
    int drow = n0;
    if (UPPERM) drow = (n0 < 1024) ? (256 * (n0 >> 7) + (n0 & 127)) : (256 * ((n0 - 1024) >> 7) + 128 + ((n0 - 1024) & 127));
    bf16* dst = WT + (size_t)drow * K + k0;
#pragma unroll
    for (int s = 0; s < 4; ++s) {
        f32x4 v[8];
#pragma unroll
        for (int k = 0; k < 8; ++k) v[k] = *(const f32x4*)(src + (size_t)(8 * s + k) * N);
#pragma unroll
        for (int j = 0; j < 4; ++j) { v4u o; o.x = pkbf(v[0][j], v[1][j]); o.y = pkbf(v[2][j], v[3][j]); o.z = pkbf(v[4][j], v[5][j]); o.w = pkbf(v[6][j], v[7][j]);
            *(v4u*)(dst + (size_t)j * K + 8 * s) = o; }
    }
}
__device__ __forceinline__ int up_dest_row(int n0) { return (n0 < 1024) ? (256 * (n0 >> 7) + (n0 & 127)) : (256 * ((n0 - 1024) >> 7) + 128 + ((n0 - 1024) & 127)); }
template <int N, bool UPPERM> __device__ __forceinline__ void p0_absmax_item(const float* W, unsigned* cmax, int item, int lane) {
    constexpr int NBLK = N / 256; const int kb = item / NBLK, nb = item - kb * NBLK, k0 = 32 * kb, n0 = 256 * nb + 4 * lane;
    const float* src = W + (size_t)k0 * N + n0;
    f32x4 mx = (f32x4){0.f, 0.f, 0.f, 0.f};
#pragma unroll
    for (int k = 0; k < 32; ++k) { const f32x4 v = *(const f32x4*)(src + (size_t)k * N); mx.x = fmaxf(mx.x, fabsf(v.x)); mx.y = fmaxf(mx.y, fabsf(v.y)); mx.z = fmaxf(mx.z, fabsf(v.z)); mx.w = fmaxf(mx.w, fabsf(v.w)); }
    unsigned* d = cmax + (UPPERM ? up_dest_row(n0) : n0);
    atomicMax(d + 0, __float_as_uint(mx.x)); atomicMax(d + 1, __float_as_uint(mx.y)); atomicMax(d + 2, __float_as_uint(mx.z)); atomicMax(d + 3, __float_as_uint(mx.w));
}
template <int N, bool UPPERM> __device__ __forceinline__ void p0_quant_item(const float* W, const unsigned* cmax, signed char* WQ, float* csc, int item, int lane) {
    constexpr int NBLK = N / 256; const int kb = item / NBLK, nb = item - kb * NBLK, k0 = 32 * kb, n0 = 256 * nb + 4 * lane, drow = UPPERM ? up_dest_row(n0) : n0;
    const float* src = W + (size_t)k0 * N + n0;
    float inv[4];
#pragma unroll
    for (int j = 0; j < 4; ++j) { const float cm = __uint_as_float(cmax[drow + j]); inv[j] = cm > 0.f ? 127.0f / cm : 0.f; if (kb == 0) csc[drow + j] = cm * (1.0f / 127.0f); }
#pragma unroll
    for (int s = 0; s < 2; ++s) {
        f32x4 v[16];
#pragma unroll
        for (int k = 0; k < 16; ++k) v[k] = *(const f32x4*)(src + (size_t)(16 * s + k) * N);
#pragma unroll
        for (int j = 0; j < 4; ++j) { unsigned w[4];
#pragma unroll
            for (int d = 0; d < 4; ++d) { unsigned x = 0u;
#pragma unroll
                for (int b = 0; b < 4; ++b) { const int q = (int)__builtin_rintf(v[4 * d + b][j] * inv[j]); x |= ((unsigned)q & 0xffu) << (8 * b); }
                w[d] = x; }
            *(v4u*)(WQ + (size_t)(drow + j) * 1024 + k0 + 16 * s) = (v4u){w[0], w[1], w[2], w[3]}; }
    }
}
__device__ __forceinline__ void p0_quant_up(Frame& F, const float* w_up, const unsigned* cmax, signed char* WQ, float* csc, const float* w_in, const unsigned* cmax_in, signed char* WQin, float* csc_in) {
    const int gw = F.vcu * NWAVES + F.wave, NGW = F.G * NWAVES;
    for (int it = gw; it < DEPTH * NE * 256 + DEPTH * 352; it += NGW) {
        if (it < DEPTH * NE * 256) { const int le = it >> 8;
            p0_quant_item<2048, true>(w_up + (size_t)le * D * 2048, cmax + (size_t)le * 2048, WQ + (size_t)le * 2048 * D, csc + (size_t)le * 2048, it & 255, F.lane); }
        else { const int r = it - DEPTH * NE * 256, l = r / 352;
            p0_quant_item<INW, false>(w_in + (size_t)l * D * INW, cmax_in + (size_t)l * INW, WQin + (size_t)l * INW * D, csc_in + (size_t)l * INW, r % 352, F.lane); }
    }
}
template <int N, bool UPPERM, bool FP8 = false, bool KSC = false> __device__ __forceinline__ void p0_quant_unit(const float* W, signed char* WQ, float* csc, int cb, LAS unsigned* red, int tid) {
    const int cg = tid & 15, kq = tid >> 4, n0 = 64 * cb + 4 * cg, drow = UPPERM ? up_dest_row(n0) : n0;
    f32x4 v[2][16]; f32x4 mx = (f32x4){0.f, 0.f, 0.f, 0.f};
#pragma unroll
    for (int h = 0; h < 2; ++h)
#pragma unroll
        for (int i = 0; i < 16; ++i) { v[h][i] = *(const f32x4*)(W + (size_t)(16 * (kq + 32 * h) + i) * N + n0); if constexpr (KSC) v[h][i] = v[h][i] * (h == 0 ? 1.0f / CAT_S_ATT : 1.0f / CAT_S_RET);
            mx.x = fmaxf(mx.x, fabsf(v[h][i].x)); mx.y = fmaxf(mx.y, fabsf(v[h][i].y)); mx.z = fmaxf(mx.z, fabsf(v[h][i].z)); mx.w = fmaxf(mx.w, fabsf(v[h][i].w)); }
    if (tid < 64) red[tid] = 0u;
    __syncthreads();
    atomicMax((unsigned*)(red + 4 * cg + 0), __float_as_uint(mx.x)); atomicMax((unsigned*)(red + 4 * cg + 1), __float_as_uint(mx.y));
    atomicMax((unsigned*)(red + 4 * cg + 2), __float_as_uint(mx.z)); atomicMax((unsigned*)(red + 4 * cg + 3), __float_as_uint(mx.w));
    __syncthreads();
    float inv[4];
#pragma unroll
    for (int j = 0; j < 4; ++j) { const float cm = __uint_as_float(red[4 * cg + j]); constexpr float QMAX = FP8 ? 448.0f : 127.0f; inv[j] = cm > 0.f ? QMAX / cm : 0.f; if (kq == 0) csc[drow + j] = cm * (1.0f / QMAX); }
#pragma unroll
    for (int h = 0; h < 2; ++h)
#pragma unroll
        for (int j = 0; j < 4; ++j) { unsigned w[4];
#pragma unroll
            for (int d = 0; d < 4; ++d) { unsigned x = 0u;
                if constexpr (FP8) { x = __builtin_amdgcn_cvt_pk_fp8_f32(v[h][4 * d + 0][j] * inv[j], v[h][4 * d + 1][j] * inv[j], x, false); x = __builtin_amdgcn_cvt_pk_fp8_f32(v[h][4 * d + 2][j] * inv[j], v[h][4 * d + 3][j] * inv[j], x, true); }
                else {
#pragma unroll
                for (int b = 0; b < 4; ++b) { const int q = (int)__builtin_rintf(v[h][4 * d + b][j] * inv[j]); x |= ((unsigned)q & 0xffu) << (8 * b); } }
                w[d] = x; }
            *(v4u*)(WQ + (size_t)(drow + j) * 1024 + 16 * (kq + 32 * h)) = (v4u){w[0], w[1], w[2], w[3]}; }
    __syncthreads();
}
struct QItem { const float* W; signed char* WQ; float* csc; int N, n0, type; };
__device__ __forceinline__ void q_issue(f32x4 (&v)[16], const QItem& q, int tid) {
    const int cg = tid & 7, kq = tid >> 3; const float* src = q.W + (size_t)(16 * kq) * q.N + q.n0 + 4 * cg;
#pragma unroll
    for (int i = 0; i < 16; ++i) v[i] = __builtin_nontemporal_load((const f32x4*)(src + (size_t)i * q.N));
}
template <bool UPPERM, bool FP8, bool KSC> __device__ __forceinline__ void q_finish(f32x4 (&v)[16], const QItem& q, LAS unsigned* red, int tid) {
    const int cg = tid & 7, kq = tid >> 3, n0 = q.n0 + 4 * cg, drow = UPPERM ? up_dest_row(n0) : n0;
    f32x4 mx = (f32x4){0.f, 0.f, 0.f, 0.f};
#pragma unroll
    for (int i = 0; i < 16; ++i) { if constexpr (KSC) v[i] = v[i] * (kq < 32 ? 1.0f / CAT_S_ATT : 1.0f / CAT_S_RET);
        mx.x = fmaxf(mx.x, fabsf(v[i].x)); mx.y = fmaxf(mx.y, fabsf(v[i].y)); mx.z = fmaxf(mx.z, fabsf(v[i].z)); mx.w = fmaxf(mx.w, fabsf(v[i].w)); }
    if (tid < 32) red[tid] = 0u;
    __syncthreads();
    atomicMax((unsigned*)(red + 4 * cg + 0), __float_as_uint(mx.x)); atomicMax((unsigned*)(red + 4 * cg + 1), __float_as_uint(mx.y));
    atomicMax((unsigned*)(red + 4 * cg + 2), __float_as_uint(mx.z)); atomicMax((unsigned*)(red + 4 * cg + 3), __float_as_uint(mx.w));
    __syncthreads();
    constexpr float QMAX = FP8 ? 448.0f : 127.0f;
#pragma unroll
    for (int j = 0; j < 4; ++j) { const float cm = __uint_as_float(red[4 * cg + j]), inv = cm > 0.f ? QMAX / cm : 0.f; if (kq == 0) q.csc[drow + j] = cm * (1.0f / QMAX);
        unsigned w[4];
#pragma unroll
        for (int d = 0; d < 4; ++d) { unsigned x = 0u;
            if constexpr (FP8) { x = __builtin_amdgcn_cvt_pk_fp8_f32(v[4 * d + 0][j] * inv, v[4 * d + 1][j] * inv, x, false); x = __builtin_amdgcn_cvt_pk_fp8_f32(v[4 * d + 2][j] * inv, v[4 * d + 3][j] * inv, x, true); }
            else {
#pragma unroll
                for (int b = 0; b < 4; ++b) { const int qv = (int)__builtin_rintf(v[4 * d + b][j] * inv); x |= ((unsigned)qv & 0xffu) << (8 * b); } }
            w[d] = x; }
        *(v4u*)(q.WQ + (size_t)(drow + j) * 1024 + 16 * kq) = (v4u){w[0], w[1], w[2], w[3]}; }
}
__device__ __forceinline__ void q_finish_any(f32x4 (&v)[16], const QItem& q, LAS unsigned* red, int tid) {
    if (q.type == 0) q_finish<true, false, false>(v, q, red, tid);
    else if (q.type == 1) q_finish<false, false, false>(v, q, red, tid);
    else if (q.type == 2) q_finish<false, true, false>(v, q, red, tid);
    else q_finish<false, true, true>(v, q, red, tid);
}
__device__ __forceinline__ void p0_prologue(Frame& F, const float* c_in, const float* ada_w, const float* ada_b, float* mod,
                                            const float* w_in, const float* w_out, const float* w_up, const float* w_dn,
                                            signed char* WQin, float* csc_in, signed char* WQout, float* csc_out, signed char* WQup, float* csc_up, signed char* WQdn, float* csc_dn, gu32* wq_ctr) {
    const int gw = F.vcu * NWAVES + F.wave, NGW = F.G * NWAVES;
    __syncthreads();
    LAS float* cond = (LAS float*)F.lds;
    for (int i = F.tid; i < BATCH * D; i += NTHR) { const float v = c_in[i]; cond[i] = v * frcp(1.0f + __expf(-v)); }
    __syncthreads();
    LAS float* part = (LAS float*)(F.lds + 32768);
    for (int bt = blockIdx.x; bt < DEPTH * 96; bt += F.G) {
        const int l = bt / 96, chunk = bt % 96, ks = F.wave, col = chunk * 64 + F.lane;
        float acc[BATCH];
#pragma unroll
        for (int b = 0; b < BATCH; ++b) acc[b] = 0.f;
        const float* w = ada_w + ((size_t)l * D + ks * 128) * (6 * D) + col;
#pragma unroll 16
        for (int k = 0; k < 128; ++k) { const float wv = w[(size_t)k * (6 * D)];
#pragma unroll
            for (int b = 0; b < BATCH; ++b) acc[b] += cond[b * D + ks * 128 + k] * wv; }
#pragma unroll
        for (int b = 0; b < BATCH; ++b) part[(ks * BATCH + b) * 64 + F.lane] = acc[b];
        __syncthreads();
        { const int b = F.wave; float sum = ada_b[l * 6 * D + col];
#pragma unroll
          for (int k2 = 0; k2 < 8; ++k2) sum += part[(k2 * BATCH + b) * 64 + F.lane];
          mod[((size_t)l * BATCH + b) * (6 * D) + col] = sum; }
        __syncthreads();
    }
    {   LAS unsigned* redA = (LAS unsigned*)(F.lds + 49152 + 1024), *redB = redA + 32; LAS unsigned* claim = redA + 64;
        constexpr int U_UP = DEPTH * NE * 64, U_IN = DEPTH * 88, U_DN = DEPTH * NE * 32, U_OUT = DEPTH * 32, U_ALL = U_UP + U_IN + U_DN + U_OUT;
        auto take = [&](QItem& q) -> bool {
            if (F.tid == 0) claim[0] = __hip_atomic_fetch_add(wq_ctr, 1u, RLX_AGENT);
            __syncthreads();
            const int u = (int)claim[0];
            __syncthreads();
            if (u >= U_ALL) return false;
            if (u < U_UP) { const int le = u >> 6; q = QItem{w_up + (size_t)le * D * 2048, WQup + (size_t)le * 2048 * D, csc_up + (size_t)le * 2048, 2048, 32 * (u & 63), 0}; }
            else if (u < U_UP + U_IN) { const int r = u - U_UP, l = r / 88; q = QItem{w_in + (size_t)l * D * INW, WQin + (size_t)l * INW * D, csc_in + (size_t)l * INW, INW, 32 * (r % 88), 1}; }
            else if (u < U_UP + U_IN + U_DN) { const int r = u - U_UP - U_IN, le = r >> 5; q = QItem{w_dn + (size_t)le * D * D, WQdn + (size_t)le * D * D, csc_dn + (size_t)le * D, D, 32 * (r & 31), 2}; }
            else { const int r = u - U_UP - U_IN - U_DN, l = r >> 5; q = QItem{w_out + (size_t)l * D * D, WQout + (size_t)l * D * D, csc_out + (size_t)l * D, D, 32 * (r & 31), 3}; }
            return true; };
        f32x4 vA[16], vB[16]; QItem qA, qB;
        bool hA = take(qA); if (hA) q_issue(vA, qA, F.tid);
        bool hB = hA && take(qB); if (hB) q_issue(vB, qB, F.tid);
        while (hA || hB) {
            if (hA) { q_finish_any(vA, qA, redA, F.tid); hA = take(qA); if (hA) q_issue(vA, qA, F.tid); }
            if (hB) { q_finish_any(vB, qB, redB, F.tid); hB = take(qB); if (hB) q_issue(vB, qB, F.tid); }
        }
    }
}
__device__ __forceinline__ void store_row_i8(signed char* qrow, float* sc, const f32x4 (&h)[4], int lane) {
    float mx = 0.f;
#pragma unroll
    for (int j = 0; j < 4; ++j) mx = fmaxf(fmaxf(mx, fmaxf(fabsf(h[j].x), fabsf(h[j].y))), fmaxf(fabsf(h[j].z), fabsf(h[j].w)));
    mx = wmax64(mx);
    const float inv = mx > 0.f ? 127.0f / mx : 0.f;
    unsigned* qr = (unsigned*)qrow + lane;
#pragma unroll
    for (int j = 0; j < 4; ++j) { const int q0 = (int)__builtin_rintf(h[j].x * inv), q1 = (int)__builtin_rintf(h[j].y * inv), q2 = (int)__builtin_rintf(h[j].z * inv), q3 = (int)__builtin_rintf(h[j].w * inv);
        qr[64 * j] = ((unsigned)q0 & 0xffu) | (((unsigned)q1 & 0xffu) << 8) | (((unsigned)q2 & 0xffu) << 16) | (((unsigned)q3 & 0xffu) << 24); }
    if (lane == 0) *sc = mx * (1.0f / 127.0f);
}
__device__ __forceinline__ void p0b_premix(Frame& F, const float* x, signed char* HQ, float* hs, const float* g, const float* mod_l) {
    const int lane = F.lane, gw = F.vcu * NWAVES + F.wave, NGW = F.G * NWAVES;
    for (int ch = gw; ch < M / 32; ch += NGW) { const int mb = ch * 32;
        const float* modb = mod_l + (size_t)(mb >> 13) * (6 * D);
        f32x4 gsv[4], shv[4];
#pragma unroll
        for (int j = 0; j < 4; ++j) { gsv[j] = ((const f32x4*)g)[lane + 64 * j] * (((const f32x4*)(modb + D))[lane + 64 * j] + 1.0f); shv[j] = ((const f32x4*)modb)[lane + 64 * j]; }
        f32x4 A[2][4], B[2][4];
#define P0B_ISSUE(BUF, t0) do { _Pragma("unroll") for (int r = 0; r < 2; ++r) load_row_f32_nt(x + (size_t)(mb + (t0) + r) * D, BUF[r], lane); } while (0)
#define P0B_PROC(BUF, t0) do { _Pragma("unroll") for (int r = 0; r < 2; ++r) { const int m = mb + (t0) + r; f32x4 h[4]; const float rs = row_rstd(BUF[r]); \
            _Pragma("unroll") for (int j = 0; j < 4; ++j) h[j] = BUF[r][j] * rs * gsv[j] + shv[j]; store_row_i8(HQ + (size_t)m * D, hs + m, h, lane); } } while (0)
        P0B_ISSUE(A, 0);
#pragma unroll 1
        for (int it = 0; it < 8; ++it) { const int t0 = 4 * it;
            P0B_ISSUE(B, t0 + 2);
            P0B_PROC(A, t0);
            if (it < 7) P0B_ISSUE(A, t0 + 4);
            P0B_PROC(B, t0 + 2);
        }
#undef P0B_ISSUE
#undef P0B_PROC
    }
}
__device__ __forceinline__ void rope4(float (&y)[4][2], const float (&cr)[2], const float (&sr)[2], const float (&cc)[2], const float (&sc)[2], float scale, unsigned (&w)[4]) {
    float o[4][2];
#pragma unroll
    for (int e = 0; e < 2; ++e) { o[0][e] = y[0][e] * cr[e] - y[1][e] * sr[e]; o[1][e] = y[1][e] * cr[e] + y[0][e] * sr[e];
                                  o[2][e] = y[2][e] * cc[e] - y[3][e] * sc[e]; o[3][e] = y[3][e] * cc[e] + y[2][e] * sc[e]; }
#pragma unroll
    for (int q = 0; q < 4; ++q) w[q] = pkbf(o[q][0] * scale, o[q][1] * scale);
}
__device__ __forceinline__ void p1b_ka(Frame& F, bf16* PROJ, const float* kg) {
    const int lane = F.lane, gw = F.vcu * NWAVES + F.wave, NGW = F.G * NWAVES;
    const int ja = lane & 7, hk = (lane >> 3) & 1, sub = lane >> 4;
    constexpr float L2T = 13.287712379549449f;
    float fa[2], gk[4][2];
#pragma unroll
    for (int e = 0; e < 2; ++e) fa[e] = fexp2(-(float)(2 * ja + e) * (L2T / 16.f));
#pragma unroll
    for (int q = 0; q < 4; ++q)
#pragma unroll
        for (int e = 0; e < 2; ++e) gk[q][e] = kg[q * 16 + 2 * ja + e];
    for (int m0 = gw * 4; m0 < M; m0 += NGW * 4) {
        const int m = m0 + sub, s = m & (T - 1); const float rid = (float)(s >> 6), cid = (float)(s & 63);
        float cra[2], sra[2], cca[2], sca[2];
#pragma unroll
        for (int e = 0; e < 2; ++e) { cra[e] = __cosf(rid * fa[e]); sra[e] = __sinf(rid * fa[e]); cca[e] = __cosf(cid * fa[e]); sca[e] = __sinf(cid * fa[e]); }
        unsigned* p = (unsigned*)(PROJ + (size_t)m * INW + C_KA + hk * 64 + 2 * ja); unsigned w[4]; float y[4][2]; float ss = 0.f;
#pragma unroll
        for (int q = 0; q < 4; ++q) { w[q] = p[q * 8]; y[q][0] = bflo(w[q]); y[q][1] = bfhi(w[q]); ss += y[q][0] * y[q][0] + y[q][1] * y[q][1]; }
        ss += shx<1>(ss); ss += shx<2>(ss); ss += shx<4>(ss);
        const float rs = frsq(ss * (1.f / 64.f) + EPS);
#pragma unroll
        for (int q = 0; q < 4; ++q) { y[q][0] *= rs * gk[q][0]; y[q][1] *= rs * gk[q][1]; }
        rope4(y, cra, sra, cca, sca, 1.0f, w);
#pragma unroll
        for (int q = 0; q < 4; ++q) p[q * 8] = w[q];
    }
}
__device__ __forceinline__ void p1b_rope(Frame& F, bf16* PROJ, bf16* PDST, const float* qg, const float* kg) {
    const int lane = F.lane, gw = F.vcu * NWAVES + F.wave, NGW = F.G * NWAVES;
    const int ja = lane & 7, jr = lane & 15;
    constexpr float L2T = 13.287712379549449f;
    float fa[2], fr[2], gq[4][2], gk[4][2];
#pragma unroll
    for (int e = 0; e < 2; ++e) { fa[e] = fexp2(-(float)(2 * ja + e) * (L2T / 16.f)); fr[e] = fexp2(-(float)(2 * jr + e) * (L2T / 32.f)); }
#pragma unroll
    for (int q = 0; q < 4; ++q)
#pragma unroll
        for (int e = 0; e < 2; ++e) { gq[q][e] = qg[q * 16 + 2 * ja + e]; gk[q][e] = kg[q * 16 + 2 * ja + e]; }
    for (int m = gw; m < M; m += NGW) {
        const int s = m & (T - 1); const float rid = (float)(s >> 6), cid = (float)(s & 63);
        float cra[2], sra[2], cca[2], sca[2], crr[2], srr[2], ccr[2], scr2[2];
#pragma unroll
        for (int e = 0; e < 2; ++e) { cra[e] = __cosf(rid * fa[e]); sra[e] = __sinf(rid * fa[e]); cca[e] = __cosf(cid * fa[e]); sca[e] = __sinf(cid * fa[e]);
                                      crr[e] = __cosf(rid * fr[e]); srr[e] = __sinf(rid * fr[e]); ccr[e] = __cosf(cid * fr[e]); scr2[e] = __sinf(cid * fr[e]); }
        bf16* row = PROJ + (size_t)m * INW; const size_t dd = (size_t)((const char*)PDST - (const char*)PROJ) / 4;
        {
            unsigned* p = (unsigned*)(row + C_QA + (lane >> 3) * 64 + 2 * ja); unsigned w[4]; float y[4][2]; float ss = 0.f;
#pragma unroll
            for (int q = 0; q < 4; ++q) { w[q] = p[q * 8]; y[q][0] = bflo(w[q]); y[q][1] = bfhi(w[q]); ss += y[q][0] * y[q][0] + y[q][1] * y[q][1]; }
            ss += shx<1>(ss); ss += shx<2>(ss); ss += shx<4>(ss);
            const float rs = frsq(ss * (1.f / 64.f) + EPS);
#pragma unroll
            for (int q = 0; q < 4; ++q) { y[q][0] *= rs * gq[q][0]; y[q][1] *= rs * gq[q][1]; }
            rope4(y, cra, sra, cca, sca, attn_body::C2, w);
#pragma unroll
            for (int q = 0; q < 4; ++q) p[dd + q * 8] = w[q];
        }
        {
            const int hk = (lane >> 3) & 1;
            unsigned* p = (unsigned*)(row + C_KA + hk * 64 + 2 * ja); unsigned w[4]; float y[4][2]; float ss = 0.f;
#pragma unroll
            for (int q = 0; q < 4; ++q) { w[q] = p[q * 8]; y[q][0] = bflo(w[q]); y[q][1] = bfhi(w[q]); ss += y[q][0] * y[q][0] + y[q][1] * y[q][1]; }
            ss += shx<1>(ss); ss += shx<2>(ss); ss += shx<4>(ss);
            const float rs = frsq(ss * (1.f / 64.f) + EPS);
#pragma unroll
            for (int q = 0; q < 4; ++q) { y[q][0] *= rs * gk[q][0]; y[q][1] *= rs * gk[q][1]; }
            rope4(y, cra, sra, cca, sca, 1.0f, w);
            if (lane < 16) {
#pragma unroll
                for (int q = 0; q < 4; ++q) p[dd + q * 8] = w[q]; }
        }
#pragma unroll
        for (int which = 0; which < 2; ++which) {
            unsigned* p = (unsigned*)(row + (which ? C_KR : C_QR) + (lane >> 4) * 128 + 2 * jr); unsigned w[4]; float y[4][2];
#pragma unroll
            for (int q = 0; q < 4; ++q) { w[q] = p[q * 16]; y[q][0] = bflo(w[q]); y[q][1] = bfhi(w[q]); }
            rope4(y, crr, srr, ccr, scr2, which ? 0.08838834764831845f : 1.0f, w);
#pragma unroll
            for (int q = 0; q < 4; ++q) p[dd + q * 16] = w[q];
        }
    }
}

__device__ __forceinline__ unsigned off_b(unsigned row, unsigned ch) { return 256u * row + 16u * (ch ^ (((row & 3) << 2) | ((row >> 2) & 3))); }
__device__ __forceinline__ bf16x8 rowread(const LAS unsigned char* tb, int rb, int s, int lane) {
    return *(const LAS bf16x8*)(tb + off_b(32 * rb + (lane & 31), 2 * s + (lane >> 5)));
}
__device__ __forceinline__ bf16x8 trread(const LAS unsigned char* tb, int c, int ks, int lane) {
    const unsigned h = lane >> 5, blk = (lane >> 4) & 1, q = (lane & 15) >> 2, p = lane & 3;
    const unsigned r0 = 16 * ks + 8 * h + q, ch = 4 * c + 2 * blk + (p >> 1);
    const s16x4 lo = __builtin_amdgcn_ds_read_tr16_b64_v4i16((LAS s16x4*)(tb + off_b(r0, ch) + 8 * (p & 1)));
    const s16x4 hi = __builtin_amdgcn_ds_read_tr16_b64_v4i16((LAS s16x4*)(tb + off_b(r0 + 4, ch) + 8 * (p & 1)));
    return (bf16x8){lo[0], lo[1], lo[2], lo[3], hi[0], hi[1], hi[2], hi[3]};
}
__device__ __forceinline__ int crow(int r, int hi) { return (r & 3) + 8 * (r >> 2) + 4 * hi; }
template <int MODE> __device__ __forceinline__ void stage_tile(LAS unsigned char* tb, const bf16* src, int pitch, int tid, float lg) {
#pragma unroll
    for (int i = 0; i < 4; ++i) { const int n = tid + NTHR * i, row = n >> 4, ch = n & 15;
        v4u v = *(const v4u*)(src + (size_t)row * pitch + ch * 8);
        if (MODE != 0) { const float f = fexp2((MODE == 1 ? (float)(127 - row) : (float)row) * lg);
            v.x = pkbf(bflo(v.x) * f, bfhi(v.x) * f); v.y = pkbf(bflo(v.y) * f, bfhi(v.y) * f); v.z = pkbf(bflo(v.z) * f, bfhi(v.z) * f); v.w = pkbf(bflo(v.w) * f, bfhi(v.w) * f); }
        *(LAS v4u*)(tb + off_b(row, ch)) = v; }
}
template <int NOUT> __device__ __forceinline__ void stage_rope_tile(LAS unsigned char* tb0, LAS unsigned char* tb1, const bf16* src, int pitch, int tid, int s0, float scale, float lgf, float lgb) {
    constexpr float L2T = 13.287712379549449f;
#pragma unroll 1
    for (int i2 = 0; i2 < 2; ++i2) { const int n = tid + NTHR * i2, row = n >> 3, cp = n & 7, c0 = (cp & 3) + ((cp >> 2) << 3);
        const bf16* rp = src + (size_t)row * pitch; const v4u va = *(const v4u*)(rp + c0 * 8), vb = *(const v4u*)(rp + (c0 + 4) * 8);
        const int s = s0 + row; const float pos = (cp & 4) ? (float)(s & 63) : (float)(s >> 6);
        const unsigned wa[4] = {va.x, va.y, va.z, va.w}, wb[4] = {vb.x, vb.y, vb.z, vb.w}; float oa[8], ob[8];
#pragma unroll
        for (int j = 0; j < 8; ++j) { const float fr = fexp2(-(float)(8 * (cp & 3) + j) * (L2T / 32.f)), ang = pos * fr, cs = __cosf(ang), sn = __sinf(ang);
            const float a = (j & 1) ? bfhi(wa[j >> 1]) : bflo(wa[j >> 1]), b = (j & 1) ? bfhi(wb[j >> 1]) : bflo(wb[j >> 1]);
            oa[j] = (a * cs - b * sn) * scale; ob[j] = (b * cs + a * sn) * scale; }
        if (NOUT == 1) {
            *(LAS v4u*)(tb0 + off_b(row, c0)) = (v4u){pkbf(oa[0], oa[1]), pkbf(oa[2], oa[3]), pkbf(oa[4], oa[5]), pkbf(oa[6], oa[7])};
            *(LAS v4u*)(tb0 + off_b(row, c0 + 4)) = (v4u){pkbf(ob[0], ob[1]), pkbf(ob[2], ob[3]), pkbf(ob[4], ob[5]), pkbf(ob[6], ob[7])};
        } else {
            const float ff = fexp2((float)(127 - row) * lgf), fb = fexp2((float)row * lgb);
            *(LAS v4u*)(tb0 + off_b(row, c0)) = (v4u){pkbf(oa[0] * ff, oa[1] * ff), pkbf(oa[2] * ff, oa[3] * ff), pkbf(oa[4] * ff, oa[5] * ff), pkbf(oa[6] * ff, oa[7] * ff)};
            *(LAS v4u*)(tb0 + off_b(row, c0 + 4)) = (v4u){pkbf(ob[0] * ff, ob[1] * ff), pkbf(ob[2] * ff, ob[3] * ff), pkbf(ob[4] * ff, ob[5] * ff), pkbf(ob[6] * ff, ob[7] * ff)};
            *(LAS v4u*)(tb1 + off_b(row, c0)) = (v4u){pkbf(oa[0] * fb, oa[1] * fb), pkbf(oa[2] * fb, oa[3] * fb), pkbf(oa[4] * fb, oa[5] * fb), pkbf(oa[6] * fb, oa[7] * fb)};
            *(LAS v4u*)(tb1 + off_b(row, c0 + 4)) = (v4u){pkbf(ob[0] * fb, ob[1] * fb), pkbf(ob[2] * fb, ob[3] * fb), pkbf(ob[4] * fb, ob[5] * fb), pkbf(ob[6] * fb, ob[7] * fb)};
        } }
}
__device__ __forceinline__ void rope_load(v4u (&raw)[2][2], const bf16* src, int pitch, int tid) {
#pragma unroll
    for (int i2 = 0; i2 < 2; ++i2) { const int n = tid + NTHR * i2, row = n >> 3, cp = n & 7, c0 = (cp & 3) + ((cp >> 2) << 3);
        const bf16* rp = src + (size_t)row * pitch; raw[i2][0] = *(const v4u*)(rp + c0 * 8); raw[i2][1] = *(const v4u*)(rp + (c0 + 4) * 8); }
}
template <int NOUT> __device__ __forceinline__ void rope_store(LAS unsigned char* tb0, LAS unsigned char* tb1, const v4u (&raw)[2][2], int tid, int s0, float scale, float lgf, float lgb) {
    constexpr float L2T = 13.287712379549449f;
#pragma unroll
    for (int i2 = 0; i2 < 2; ++i2) { __builtin_amdgcn_sched_barrier(0);
        const int n = tid + NTHR * i2, row = n >> 3, cp = n & 7, c0 = (cp & 3) + ((cp >> 2) << 3);
        const v4u va = raw[i2][0], vb = raw[i2][1];
        const int s = s0 + row; const float pos = (cp & 4) ? (float)(s & 63) : (float)(s >> 6);
        const unsigned wa[4] = {va.x, va.y, va.z, va.w}, wb[4] = {vb.x, vb.y, vb.z, vb.w}; float oa[8], ob[8];
#pragma unroll
        for (int j = 0; j < 8; ++j) { const float fr = fexp2(-(float)(8 * (cp & 3) + j) * (L2T / 32.f)), ang = pos * fr, cs = __cosf(ang), sn = __sinf(ang);
            const float a = (j & 1) ? bfhi(wa[j >> 1]) : bflo(wa[j >> 1]), b = (j & 1) ? bfhi(wb[j >> 1]) : bflo(wb[j >> 1]);
            oa[j] = (a * cs - b * sn) * scale; ob[j] = (b * cs + a * sn) * scale; }
        if (NOUT == 1) {
            *(LAS v4u*)(tb0 + off_b(row, c0)) = (v4u){pkbf(oa[0], oa[1]), pkbf(oa[2], oa[3]), pkbf(oa[4], oa[5]), pkbf(oa[6], oa[7])};
            *(LAS v4u*)(tb0 + off_b(row, c0 + 4)) = (v4u){pkbf(ob[0], ob[1]), pkbf(ob[2], ob[3]), pkbf(ob[4], ob[5]), pkbf(ob[6], ob[7])};
        } else {
            const float ff = fexp2((float)(127 - row) * lgf), fb = fexp2((float)row * lgb);
            *(LAS v4u*)(tb0 + off_b(row, c0)) = (v4u){pkbf(oa[0] * ff, oa[1] * ff), pkbf(oa[2] * ff, oa[3] * ff), pkbf(oa[4] * ff, oa[5] * ff), pkbf(oa[6] * ff, oa[7] * ff)};
            *(LAS v4u*)(tb0 + off_b(row, c0 + 4)) = (v4u){pkbf(ob[0] * ff, ob[1] * ff), pkbf(ob[2] * ff, ob[3] * ff), pkbf(ob[4] * ff, ob[5] * ff), pkbf(ob[6] * ff, ob[7] * ff)};
            *(LAS v4u*)(tb1 + off_b(row, c0)) = (v4u){pkbf(oa[0] * fb, oa[1] * fb), pkbf(oa[2] * fb, oa[3] * fb), pkbf(oa[4] * fb, oa[5] * fb), pkbf(oa[6] * fb, oa[7] * fb)};
            *(LAS v4u*)(tb1 + off_b(row, c0 + 4)) = (v4u){pkbf(ob[0] * fb, ob[1] * fb), pkbf(ob[2] * fb, ob[3] * fb), pkbf(ob[4] * fb, ob[5] * fb), pkbf(ob[6] * fb, ob[7] * fb)};
        } }
}
__device__ __forceinline__ void vtile_load(v4u (&raw)[4], const bf16* src, int pitch, int tid) {
#pragma unroll
    for (int i = 0; i < 4; ++i) { const int n = tid + NTHR * i, row = n >> 4, ch = n & 15; raw[i] = *(const v4u*)(src + (size_t)row * pitch + ch * 8); }
}
__device__ __forceinline__ void vtile_store(LAS unsigned char* tb, const v4u (&raw)[4], int tid) {
#pragma unroll
    for (int i = 0; i < 4; ++i) { const int n = tid + NTHR * i, row = n >> 4, ch = n & 15; *(LAS v4u*)(tb + off_b(row, ch)) = raw[i]; }
}
__device__ __forceinline__ void r1_states(Frame& F, const bf16* PROJ, bf16* U, const float* dec_f, const float* dec_b) {
    LAS unsigned char* TKf = F.lds, *TKb = F.lds + 32768, *TV = F.lds + 65536;
    const int lane = F.lane, w = F.wave, hi = lane >> 5, mb = w & 3, nb0 = 2 * (w >> 2);
    for (int u = F.vcu; u < RUNITS; u += F.G) {
        const int b = u >> 8, h = (u >> 6) & 3, c = u & 63;
        const float lgf = dec_f[h] * LOG2E, lgb = dec_b[h] * LOG2E;
        const bf16* base = PROJ + ((size_t)b * T + (size_t)c * RCH) * INW + h * 128;
        { v4u rk[2][2], rv[4]; rope_load(rk, base + C_KR, INW, F.tid); vtile_load(rv, base + C_VR, INW, F.tid);
          rope_store<2>(TKf, TKb, rk, F.tid, c * RCH, 0.08838834764831845f, lgf, lgb);
          vtile_store(TV, rv, F.tid); }
        __syncthreads();
        f32x16 acc[2][2];
#pragma unroll
        for (int d = 0; d < 2; ++d)
#pragma unroll
            for (int n = 0; n < 2; ++n) acc[d][n] = (f32x16){};
#pragma unroll 2
        for (int ks = 0; ks < 8; ++ks) {
            const bf16x8 a = trread(TV, mb, ks, lane);
#pragma unroll
            for (int n = 0; n < 2; ++n) { const bf16x8 bf = trread(TKf, nb0 + n, ks, lane), bb = trread(TKb, nb0 + n, ks, lane);
                acc[0][n] = __builtin_amdgcn_mfma_f32_32x32x16_bf16(bf, a, acc[0][n], 0, 0, 0);
                acc[1][n] = __builtin_amdgcn_mfma_f32_32x32x16_bf16(bb, a, acc[1][n], 0, 0, 0); }
        }
#pragma unroll
        for (int d = 0; d < 2; ++d)
#pragma unroll
            for (int n = 0; n < 2; ++n) { bf16* o = U + ((size_t)u * 2 + d) * 16384 + (size_t)(32 * mb + (lane & 31)) * 128 + 32 * (nb0 + n) + 4 * hi;
#pragma unroll
                for (int g = 0; g < 4; ++g) { u32x2 w; w.x = pkbf(acc[d][n][4 * g], acc[d][n][4 * g + 1]); w.y = pkbf(acc[d][n][4 * g + 2], acc[d][n][4 * g + 3]); *(u32x2*)(o + 8 * g) = w; } }
        __syncthreads();
    }
}
__device__ __forceinline__ void r2_scan(Frame& F, const bf16* __restrict__ U, bf16* __restrict__ FT, const float* dec_f, const float* dec_b) {
    for (int task = blockIdx.x * NTHR + F.tid; task < BATCH * RH * 4096; task += F.G * NTHR) {
        const int bh = task >> 12, e4 = task & 4095, h = bh & 3;
        const float df = __expf(dec_f[h] * 128.f), db = __expf(dec_b[h] * 128.f);
        const size_t base = ((size_t)bh * NCH * 2) * 16384 + 4 * e4;
#define R2_LOAD(BUF, c0, DIR, STEP) do { _Pragma("unroll") for (int k = 0; k < 8; ++k) BUF[k] = __builtin_nontemporal_load((const u32x2*)(U + base + ((size_t)((c0) + (STEP) * k) * 2 + (DIR)) * 16384)); } while (0)
#define R2_PROC(BUF, c0, DIR, STEP, DEC) do { _Pragma("unroll") for (int k = 0; k < 8; ++k) { u32x2 w; w.x = pkbf(s.x, s.y); w.y = pkbf(s.z, s.w); \
            *(u32x2*)(FT + base + ((size_t)((c0) + (STEP) * k) * 2 + (DIR)) * 16384) = w; const u32x2 uw = BUF[k]; s = s * (DEC) + (f32x4){bflo(uw.x), bfhi(uw.x), bflo(uw.y), bfhi(uw.y)}; } } while (0)
        u32x2 bA[8], bB[8];
        f32x4 s = (f32x4){0.f, 0.f, 0.f, 0.f};
        R2_LOAD(bA, 0, 0, 1);
#pragma unroll 1
        for (int c0 = 0; c0 < NCH; c0 += 16) {
            R2_LOAD(bB, c0 + 8, 0, 1);
            R2_PROC(bA, c0, 0, 1, df);
            if (c0 + 16 < NCH) R2_LOAD(bA, c0 + 16, 0, 1);
            R2_PROC(bB, c0 + 8, 0, 1, df);
        }
        s = (f32x4){0.f, 0.f, 0.f, 0.f};
        R2_LOAD(bA, NCH - 1, 1, -1);
#pragma unroll 1
        for (int c0 = NCH - 1; c0 >= 0; c0 -= 16) {
            R2_LOAD(bB, c0 - 8, 1, -1);
            R2_PROC(bA, c0, 1, -1, db);
            if (c0 - 16 >= 0) R2_LOAD(bA, c0 - 16, 1, -1);
            R2_PROC(bB, c0 - 8, 1, -1, db);
        }
#undef R2_LOAD
#undef R2_PROC
    }
}
__device__ __forceinline__ void r3_out(Frame& F, const bf16* PROJ, const bf16* FT, bf16* CAT, const float* dec_f, const float* dec_b, const float* gn_g, const float* gn_b) {
    LAS unsigned char* TQ = F.lds, *TK = F.lds + 32768, *TV = F.lds + 65536, *TP = F.lds + 98304;
    LAS float* OT = (LAS float*)F.lds;
    const int w = F.wave, wb = w & 3, wp0 = 2 * (w >> 2);
    for (int u = F.vcu; u < RUNITS; u += F.G) {
        int lane = F.lane, tid_u = F.tid; asm volatile("" : "+v"(lane), "+v"(tid_u));
        const int hi = lane >> 5, l31 = lane & 31;
        const int b = u >> 8, h = (u >> 6) & 3, c = u & 63;
        const float lgf = dec_f[h] * LOG2E, lgb = dec_b[h] * LOG2E;
        const size_t m0 = (size_t)b * T + (size_t)c * RCH;
        const bf16* base = PROJ + m0 * INW + h * 128;
        const int gi = tid_u >> 2, gqd = tid_u & 3, gcol = h * 128 + 32 * gqd;
        const bf16* gp = PROJ + (m0 + gi) * INW + C_GR + gcol;
        v4u gw[4];
#pragma unroll
        for (int k2 = 0; k2 < 4; ++k2) gw[k2] = *(const v4u*)(gp + 8 * k2);
        bf16x8 cf[4][2], cb[4][2];
        const bf16* ftf = FT + ((size_t)u * 2 + 0) * 16384 + (size_t)(32 * wp0 + l31) * 128 + 8 * hi;
#pragma unroll
        for (int s = 0; s < 4; ++s)
#pragma unroll
            for (int n = 0; n < 2; ++n) { cf[s][n] = *(const bf16x8*)(ftf + n * 32 * 128 + 16 * s); cb[s][n] = *(const bf16x8*)(ftf + 16384 + n * 32 * 128 + 16 * s); }
        { v4u rq[2][2], rk[2][2], rv[4];
          rope_load(rq, base + C_QR, INW, tid_u); rope_load(rk, base + C_KR, INW, tid_u); vtile_load(rv, base + C_VR, INW, tid_u);
          __builtin_amdgcn_sched_barrier(0);
          rope_store<1>(TQ, TQ, rq, tid_u, c * RCH, 1.0f, 0.f, 0.f);
          rope_store<1>(TK, TK, rk, tid_u, c * RCH, 0.08838834764831845f, 0.f, 0.f);
          __builtin_amdgcn_sched_barrier(0);
          vtile_store(TV, rv, tid_u); }
        __syncthreads();
        {
            f32x16 st[2]; st[0] = (f32x16){}; st[1] = (f32x16){};
#pragma unroll 1
            for (int s = 0; s < 8; ++s) { const bf16x8 a = rowread(TK, wb, s, lane);
#pragma unroll
                for (int n = 0; n < 2; ++n) st[n] = __builtin_amdgcn_mfma_f32_32x32x16_bf16(a, rowread(TQ, wp0 + n, s, lane), st[n], 0, 0, 0); }
#pragma unroll
            for (int n = 0; n < 2; ++n) { const int i = 32 * (wp0 + n) + l31; __builtin_amdgcn_sched_barrier(0);
#pragma unroll
                for (int g = 0; g < 4; ++g) { float p[4];
#pragma unroll
                    for (int q = 0; q < 4; ++q) { const int j = 32 * wb + 8 * g + 4 * hi + q; const float fd = (float)(i - j);
                        const float mk = fexp2(fmaxf(fd, 0.f) * lgf + fmaxf(-fd, 0.f) * lgb) + fmaxf(1.0f - fabsf(fd), 0.f);
                        p[q] = st[n][4 * g + q] * mk; }
                    u32x2 pw; pw.x = pkbf(p[0], p[1]); pw.y = pkbf(p[2], p[3]);
                    *(LAS u32x2*)(TP + off_b(i, 4 * wb + g) + 8 * hi) = pw; } }
        }
        __syncthreads();
        f32x16 ao[2];
#pragma unroll
        for (int n = 0; n < 2; ++n) ao[n] = (f32x16){};
        {
            const float xf = fexp2((float)(32 * wb + l31 + 1) * lgf), xb = fexp2((float)(128 - 32 * wb - l31) * lgb);
#pragma unroll
            for (int s = 0; s < 8; ++s) { __builtin_amdgcn_sched_barrier(0); const bf16x8 ap = rowread(TP, wb, s, lane); const v4u aq = *(const LAS v4u*)(TQ + off_b(32 * wb + l31, 2 * s + hi));
                v4u qf, qb;
                qf.x = pkbf(bflo(aq.x) * xf, bfhi(aq.x) * xf); qf.y = pkbf(bflo(aq.y) * xf, bfhi(aq.y) * xf); qf.z = pkbf(bflo(aq.z) * xf, bfhi(aq.z) * xf); qf.w = pkbf(bflo(aq.w) * xf, bfhi(aq.w) * xf);
                qb.x = pkbf(bflo(aq.x) * xb, bfhi(aq.x) * xb); qb.y = pkbf(bflo(aq.y) * xb, bfhi(aq.y) * xb); qb.z = pkbf(bflo(aq.z) * xb, bfhi(aq.z) * xb); qb.w = pkbf(bflo(aq.w) * xb, bfhi(aq.w) * xb);
                const bf16x8 aqf = __builtin_bit_cast(bf16x8, qf), aqb = __builtin_bit_cast(bf16x8, qb);
#pragma unroll
                for (int n = 0; n < 2; ++n) {
                    ao[n] = __builtin_amdgcn_mfma_f32_32x32x16_bf16(ap, trread(TV, wp0 + n, s, lane), ao[n], 0, 0, 0);
                    ao[n] = __builtin_amdgcn_mfma_f32_32x32x16_bf16(aqf, cf[s & 3][n], ao[n], 0, 0, 0);
                    ao[n] = __builtin_amdgcn_mfma_f32_32x32x16_bf16(aqb, cb[s & 3][n], ao[n], 0, 0, 0); }
                if (s < 4) {
#pragma unroll
                    for (int n = 0; n < 2; ++n) { cf[s][n] = *(const bf16x8*)(ftf + n * 32 * 128 + 16 * (s + 4)); cb[s][n] = *(const bf16x8*)(ftf + 16384 + n * 32 * 128 + 16 * (s + 4)); } } }
        }
        __syncthreads();
#pragma unroll
        for (int r = 0; r < 16; ++r) { const int i = 32 * wb + crow(r, hi);
#pragma unroll
            for (int n = 0; n < 2; ++n) OT[i * 132 + 32 * (wp0 + n) + l31] = ao[n][r]; }
        __syncthreads();
        {
            const int i = tid_u >> 2, qd = tid_u & 3;
            f32x4 v[8]; float s1 = 0.f, s2 = 0.f;
#pragma unroll
            for (int k = 0; k < 8; ++k) { v[k] = *(const LAS f32x4*)(OT + i * 132 + 32 * qd + 4 * k); s1 += (v[k].x + v[k].y) + (v[k].z + v[k].w);
                s2 += (v[k].x * v[k].x + v[k].y * v[k].y) + (v[k].z * v[k].z + v[k].w * v[k].w); }
            s1 += shx<1>(s1); s1 += shx<2>(s1); s2 += shx<1>(s2); s2 += shx<2>(s2);
            const float mu = s1 * (1.f / 128.f), var = fmaxf(s2 * (1.f / 128.f) - mu * mu, 0.f), rs = frsq(var + EPS);
            const int col = h * 128 + 32 * qd;
            unsigned char* op = (unsigned char*)CAT + (m0 + i) * D + 512 + col;
            f32x4 gg[8], gbv[8];
#pragma unroll
            for (int k = 0; k < 8; ++k) { gg[k] = *(const f32x4*)(gn_g + col + 4 * k); gbv[k] = *(const f32x4*)(gn_b + col + 4 * k); }
#pragma unroll
            for (int k2 = 0; k2 < 4; ++k2) { __builtin_amdgcn_sched_barrier(0); const v4u gw4 = gw[k2]; const unsigned gwv[4] = {gw4.x, gw4.y, gw4.z, gw4.w}; float o[8];
#pragma unroll
                for (int q = 0; q < 8; ++q) { const int cc = 8 * k2 + q; const float x = v[cc >> 2][cc & 3];
                    const float y = (x - mu) * rs * gg[cc >> 2][cc & 3] + gbv[cc >> 2][cc & 3];
                    const float gt = (q & 1) ? bfhi(gwv[q >> 1]) : bflo(gwv[q >> 1]);
                    o[q] = y * gt * frcp(1.0f + __expf(-gt)); }
#pragma unroll
                for (int q = 0; q < 8; ++q) o[q] = __builtin_amdgcn_fmed3f(o[q] * CAT_S_RET, -448.0f, 448.0f);
                unsigned w0 = 0u, w1 = 0u;
                w0 = __builtin_amdgcn_cvt_pk_fp8_f32(o[0], o[1], w0, false); w0 = __builtin_amdgcn_cvt_pk_fp8_f32(o[2], o[3], w0, true);
                w1 = __builtin_amdgcn_cvt_pk_fp8_f32(o[4], o[5], w1, false); w1 = __builtin_amdgcn_cvt_pk_fp8_f32(o[6], o[7], w1, true);
                *(u32x2*)(op + 8 * k2) = (u32x2){w0, w1}; }
        }
        __syncthreads();
    }
}

#if defined(ATTN_PROBE)
__device__ __forceinline__ void attn_check(Frame& F, const bf16* PROJ, const bf16* CAT, gu32* flag, const float* qg) {
    const int lane = F.lane, s = F.vcu * NWAVES + F.wave;
    const int b = s & 7, h = (s >> 3) & 7, qpos = (s * 977 + 131) & (T - 1), kvh = h >> 2;
    const bf16* qrow = PROJ + ((size_t)b * T + qpos) * INW + C_QA + h * 64;
    float qf[64], o[64];
    {
        const float raw = __uint_as_float((unsigned)qrow[lane] << 16);
        const float ss = wave_sum(raw * raw), y = raw * (1.0f / sqrtf(ss * (1.f / 64.f) + 1e-6f)) * qg[lane];
        const int quarter = lane >> 4, i = lane & 15; const float partner = shx<16>(y);
        const float invf = exp2f(-(float)i * (13.287712379549449f / 16.f)), ang = ((quarter < 2) ? (float)(qpos >> 6) : (float)(qpos & 63)) * invf;
        const float cs = __cosf(ang), sn = __sinf(ang);
        const float rot = (quarter & 1) ? (y * cs + partner * sn) : (y * cs - partner * sn);
        const float qv = rot * (0.125f * 1.4426950408889634f);
#pragma unroll
        for (int d = 0; d < 64; ++d) qf[d] = __int_as_float(bcastl(__float_as_int(qv), d));
    }
#pragma unroll
    for (int d = 0; d < 64; ++d) o[d] = 0.f;
    float m = -1e30f, l = 0.f;
    for (int i = 0; i < T / 64; ++i) {
        const size_t krow = ((size_t)b * T + i * 64 + lane) * INW;
        const bf16* kp = PROJ + krow + C_KA + kvh * 64; const bf16* vp = PROJ + krow + C_VA + kvh * 64;
        float sc = 0.f;
#pragma unroll
        for (int c = 0; c < 8; ++c) { const v4u w = *(const v4u*)(kp + 8 * c);
            sc += qf[8 * c + 0] * bflo(w.x) + qf[8 * c + 1] * bfhi(w.x) + qf[8 * c + 2] * bflo(w.y) + qf[8 * c + 3] * bfhi(w.y) + qf[8 * c + 4] * bflo(w.z) + qf[8 * c + 5] * bfhi(w.z) + qf[8 * c + 6] * bflo(w.w) + qf[8 * c + 7] * bfhi(w.w); }
        const float mn = fmaxf(m, sc), fs = fexp2(m - mn), p = fexp2(sc - mn);
        l = l * fs + p; m = mn;
#pragma unroll
        for (int c = 0; c < 8; ++c) { const v4u w = *(const v4u*)(vp + 8 * c);
            o[8 * c + 0] = o[8 * c + 0] * fs + p * bflo(w.x); o[8 * c + 1] = o[8 * c + 1] * fs + p * bfhi(w.x); o[8 * c + 2] = o[8 * c + 2] * fs + p * bflo(w.y); o[8 * c + 3] = o[8 * c + 3] * fs + p * bfhi(w.y);
            o[8 * c + 4] = o[8 * c + 4] * fs + p * bflo(w.z); o[8 * c + 5] = o[8 * c + 5] * fs + p * bfhi(w.z); o[8 * c + 6] = o[8 * c + 6] * fs + p * bflo(w.w); o[8 * c + 7] = o[8 * c + 7] * fs + p * bfhi(w.w); }
    }
    float mm = m;
    mm = wmax64(mm);
    const float f = fexp2(m - mm); const float L = wave_sum(l * f);
    float mine = 0.f;
#pragma unroll
    for (int d = 0; d < 64; ++d) { const float od = wave_sum(o[d] * f) / L; if (lane == d) mine = od; }
    const unsigned short cw = CAT[((size_t)b * T + qpos) * D + h * 64 + lane];
    const float got = __uint_as_float((unsigned)cw << 16);
    const float E = wave_sum((mine - got) * (mine - got)), R = wave_sum(mine * mine);
    if (!(E <= 4e-4f * R) && lane == 0) __hip_atomic_store(flag, 1u, RLX_AGENT);
}
__device__ __forceinline__ void ka_expect(Frame& F, const bf16* PROJ, float* EXP, const float* kg) {
    const int lane = F.lane, s = F.vcu * NWAVES + F.wave, m = (s * 40503 + 77) & (M - 1), pos = m & (T - 1);
    for (int hk = 0; hk < 2; ++hk) {
        const float raw = __uint_as_float((unsigned)PROJ[(size_t)m * INW + C_KA + hk * 64 + lane] << 16);
        const float ss = wave_sum(raw * raw), y = raw * (1.0f / sqrtf(ss * (1.f / 64.f) + 1e-6f)) * kg[lane];
        const int quarter = lane >> 4, i = lane & 15; const float partner = shx<16>(y);
        const float invf = exp2f(-(float)i * (13.287712379549449f / 16.f)), ang = ((quarter < 2) ? (float)(pos >> 6) : (float)(pos & 63)) * invf;
        const float cs = __cosf(ang), sn = __sinf(ang);
        EXP[(size_t)s * 128 + hk * 64 + lane] = (quarter & 1) ? (y * cs + partner * sn) : (y * cs - partner * sn);
    }
}
__device__ __forceinline__ void ka_compare(Frame& F, const bf16* PROJ, const float* EXP, gu32* flag) {
    const int lane = F.lane, s = F.vcu * NWAVES + F.wave, m = (s * 40503 + 77) & (M - 1);
    float E = 0.f, R = 0.f;
    for (int hk = 0; hk < 2; ++hk) { const float got = __uint_as_float((unsigned)PROJ[(size_t)m * INW + C_KA + hk * 64 + lane] << 16), ex = EXP[(size_t)s * 128 + hk * 64 + lane];
        E += (got - ex) * (got - ex); R += ex * ex; }
    E = wave_sum(E); R = wave_sum(R);
    if (!(E <= 1e-4f * R) && lane == 0) __hip_atomic_store(flag, 1u, RLX_AGENT);
}
#endif

typedef _Float16 f16x8 __attribute__((ext_vector_type(8)));
typedef _Float16 f16x4 __attribute__((ext_vector_type(4)));
template <bool X16, bool XIN16 = false> __device__ __forceinline__ void p3b_postmix(Frame& F, const float* xin, float* xout, const bf16* YM, signed char* HQ, float* hs, const float* mod_l,
                                            const float* post_g, const float* pre_g, const float* rw, const float* rb, int* topi, float* topw, gu32* cnt_g) {
    const int lane = F.lane, gw = F.vcu * NWAVES + F.wave, NGW = F.G * NWAVES;
    LAS unsigned char* WT = F.lds;
    LAS unsigned char* AT = F.lds + 65536 + F.wave * 8192;
    LAS unsigned* lcnt = (LAS unsigned*)(F.lds + LCNT_OFF);
#pragma unroll
    for (int i = 0; i < 16; ++i) { const int n = F.tid + NTHR * i, k = n >> 3, e0 = (n & 7) * 4; const f32x4 v = *(const f32x4*)(rw + (size_t)k * NE + e0);
#pragma unroll
        for (int q = 0; q < 4; ++q) { const int e = e0 + q; *(LAS _Float16*)(WT + e * 2048 + (((k >> 3) ^ (e & 15)) << 4) + (k & 7) * 2) = (_Float16)v[q]; } }
    if (F.tid < 32) lcnt[F.tid] = 0u;
    LAS float* GL = (LAS float*)(F.lds + GAIN_OFF);
    { const f32x4 g0 = ((const f32x4*)post_g)[F.tid & 255], g1 = ((const f32x4*)pre_g)[F.tid & 255]; if (F.tid < 256) { ((LAS f32x4*)GL)[F.tid] = g0; ((LAS f32x4*)(GL + D))[F.tid] = g1; } }
    __syncthreads();
    const float rbias = rb[lane & 31];
    const int ar = lane & 3, kg = lane >> 4, be = lane & 15;
    for (int ch = gw; ch < M / 32; ch += NGW) { const int mb = ch * 32;
        const float* modb = mod_l + (size_t)(mb >> 13) * (6 * D);
        f32x4 gpv[4], gsv[4], shv[4];
#pragma unroll
        for (int j = 0; j < 4; ++j) { const f32x4 gm = ((const f32x4*)(modb + 2 * D))[lane + 64 * j], sc = ((const f32x4*)(modb + 4 * D))[lane + 64 * j]; shv[j] = ((const f32x4*)(modb + 3 * D))[lane + 64 * j];
            gpv[j] = gm * ((const LAS f32x4*)GL)[lane + 64 * j]; gsv[j] = ((const LAS f32x4*)(GL + D))[lane + 64 * j] * (sc + 1.0f); }
        u32x2 ywA[2][4], ywB[2][4]; f32x4 xrA[2][4], xrB[2][4];
#define P3B_ISSUE(YW, XR, t0) do { _Pragma("unroll") for (int rr = 0; rr < 2; ++rr) { const u32x2* yr = (const u32x2*)(YM + (size_t)(mb + (t0) + rr) * D) + lane; \
            _Pragma("unroll") for (int j = 0; j < 4; ++j) YW[rr][j] = __builtin_nontemporal_load(yr + 64 * j); \
            if constexpr (XIN16) { const u32x2* xq = (const u32x2*)((const bf16*)xin + (size_t)(mb + (t0) + rr) * D) + lane; _Pragma("unroll") for (int j = 0; j < 4; ++j) { const u32x2 w = __builtin_nontemporal_load(xq + 64 * j); XR[rr][j].x = __uint_as_float(w.x); XR[rr][j].y = __uint_as_float(w.y); } } \
            else load_row_f32_nt(xin + (size_t)(mb + (t0) + rr) * D, XR[rr], lane); } } while (0)
#define P3B_PROC(YW, XR, t0, RB) do { _Pragma("unroll") for (int rr = 0; rr < 2; ++rr) { const int m = mb + (t0) + rr, r = (RB) + rr; \
            f32x4 y[4], x[4], hf[4]; \
            _Pragma("unroll") for (int j = 0; j < 4; ++j) { const u32x2 w = YW[rr][j]; y[j] = (f32x4){bflo(w.x), bfhi(w.x), bflo(w.y), bfhi(w.y)}; \
                if constexpr (XIN16) { const unsigned xa = __float_as_uint(XR[rr][j].x), xb = __float_as_uint(XR[rr][j].y); x[j] = (f32x4){bflo(xa), bfhi(xa), bflo(xb), bfhi(xb)}; } else x[j] = XR[rr][j]; } \
            const float rsy = row_rstd(y); \
            _Pragma("unroll") for (int j = 0; j < 4; ++j) { x[j] = x[j] + gpv[j] * (y[j] * rsy); if constexpr (!X16) ((f32x4*)(xout + (size_t)m * D))[lane + 64 * j] = x[j]; } \
            if constexpr (X16) store_row_bf16_nt((bf16*)xout + (size_t)m * D, x, lane); \
            { const float rs = row_rstd(x); _Pragma("unroll") for (int j = 0; j < 4; ++j) hf[j] = x[j] * rs * gsv[j] + shv[j]; } \
            store_row_i8(HQ + (size_t)m * D, hs + m, hf, lane);                    \
            _Pragma("unroll") for (int j = 0; j < 4; ++j) { const int c = (lane >> 1) + 32 * j;        \
                *(LAS f16x4*)(AT + r * 2048 + ((c ^ (r << 2)) << 4) + 8 * (lane & 1)) = (f16x4){(_Float16)hf[j].x, (_Float16)hf[j].y, (_Float16)hf[j].z, (_Float16)hf[j].w}; } } } while (0)
        P3B_ISSUE(ywA, xrA, 0);
#pragma unroll 1
        for (int it = 0; it < 8; ++it) { const int m0 = mb + 4 * it;
        P3B_ISSUE(ywB, xrB, 4 * it + 2);
        P3B_PROC(ywA, xrA, 4 * it, 0);
        if (it < 7) P3B_ISSUE(ywA, xrA, 4 * it + 4);
        P3B_PROC(ywB, xrB, 4 * it + 2, 2);
        f32x4 la = (f32x4){0.f, 0.f, 0.f, 0.f}, lb = (f32x4){0.f, 0.f, 0.f, 0.f};
#pragma unroll 8
        for (int s = 0; s < 32; ++s) { const int c = 4 * s + kg;
            const f16x8 a = *(const LAS f16x8*)(AT + ar * 2048 + ((c ^ (ar << 2)) << 4));
            const f16x8 b0 = *(const LAS f16x8*)(WT + be * 2048 + ((c ^ be) << 4)), b1 = *(const LAS f16x8*)(WT + (16 + be) * 2048 + ((c ^ be) << 4));
            la = __builtin_amdgcn_mfma_f32_16x16x32_f16(a, b0, la, 0, 0, 0); lb = __builtin_amdgcn_mfma_f32_16x16x32_f16(a, b1, lb, 0, 0, 0); }
        const bool upper = (lane & 32) != 0, blk = (lane & 16) != 0;
#pragma unroll
        for (int pr = 0; pr < 2; ++pr) {
            const float lo_ = blk ? lb[pr] : la[pr], up_ = blk ? lb[pr + 2] : la[pr + 2];
            const float logit = (upper ? up_ : lo_) + rbias;
            const int m = m0 + pr + (upper ? 2 : 0);
            bool taken = false; float tv[TOPK]; int ti[TOPK];
#pragma unroll
            for (int k = 0; k < TOPK; ++k) { float bv = taken ? -INFINITY : logit; int bi = lane & 31;
#define MX_STEP(o) { const float ov = shx<(o)>(bv); const int oi = shxi<(o)>(bi); const bool tk = (ov > bv) || (ov == bv && oi < bi); bv = tk ? ov : bv; bi = tk ? oi : bi; }
                MX_STEP(16) MX_STEP(8) MX_STEP(4) MX_STEP(2) MX_STEP(1)
#undef MX_STEP
                tv[k] = bv; ti[k] = bi; if ((lane & 31) == bi) taken = true; }
            const float e1 = __expf(tv[1] - tv[0]), e2 = __expf(tv[2] - tv[0]), e3 = __expf(tv[3] - tv[0]), inv = frcp(1.0f + e1 + e2 + e3);
            if ((lane & 31) == 0) { *(i32x4*)(topi + (size_t)m * 4) = (i32x4){ti[0], ti[1], ti[2], ti[3]}; *(f32x4*)(topw + (size_t)m * 4) = (f32x4){inv, e1 * inv, e2 * inv, e3 * inv}; }
            if (taken) atomicAdd((unsigned*)(lcnt + (lane & 31)), 1u);
        }
        }
#undef P3B_ISSUE
#undef P3B_PROC
    }
    __syncthreads();
    if (F.tid < 32) { const unsigned c = lcnt[F.tid]; if (c) __hip_atomic_fetch_add(cnt_g + F.tid, c, RLX_AGENT); }
}
__device__ __forceinline__ void p4a_route(Frame& F, const float* hs, int* rmap, float* xsc, const int* topi, int* pos, gu32* cnt_g, gu32* cur_g) {
    const int gw = F.vcu * NWAVES + F.wave, NGW = F.G * NWAVES;
    LAS int* ts = (LAS int*)(F.lds + LTS_OFF);
    if (F.wave == 0) { LAS int* tmp = (LAS int*)(F.lds + LCNT_OFF); const int ln = F.lane;
        if (ln < NE) tmp[ln] = (int)((__hip_atomic_load(cnt_g + ln, RLX_AGENT) + 255u) >> 8);
        LDS_WAIT();
        if (ln <= NE) { int acc_ = 0; for (int k = 0; k < NE; ++k) acc_ += (k < ln) ? tmp[k] : 0; ts[ln] = acc_; } }
    __syncthreads();
    const int lane = F.lane;
    if (gw < NE) {
        const int c = (int)__hip_atomic_load(cnt_g + gw, RLX_AGENT), p0 = ts[gw] * 256 + c, p1 = ts[gw + 1] * 256;
        for (int p = p0 + lane; p < p1; p += 64) rmap[p] = 0;
    }
    for (int base = gw * 64; base < M; base += NGW * 64) {
        const int tok = base + lane; const i32x4 id = *(const i32x4*)(topi + (size_t)tok * 4);
        unsigned mycnt = 0u;
#pragma unroll 1
        for (int e = 0; e < NE; ++e) { const unsigned long long mk = __ballot(id.x == e || id.y == e || id.z == e || id.w == e); if (lane == e) mycnt = (unsigned)__popcll(mk); }
        unsigned mybase = 0u;
        if (lane < NE && mycnt) mybase = __hip_atomic_fetch_add(cur_g + lane, mycnt, RLX_AGENT);
        i32x4 ps = (i32x4){0, 0, 0, 0};
#pragma unroll 1
        for (int e = 0; e < NE; ++e) { const bool has = (id.x == e || id.y == e || id.z == e || id.w == e); const unsigned long long mk = __ballot(has);
            const int p = ts[e] * 256 + bcastl((int)mybase, e) + (int)__builtin_amdgcn_mbcnt_hi((unsigned)(mk >> 32), __builtin_amdgcn_mbcnt_lo((unsigned)mk, 0u));
            if (id.x == e) ps.x = p; if (id.y == e) ps.y = p; if (id.z == e) ps.z = p; if (id.w == e) ps.w = p; }
        *(i32x4*)(pos + (size_t)tok * 4) = ps;
        { const float sc = hs[tok]; xsc[ps.x] = sc; xsc[ps.y] = sc; xsc[ps.z] = sc; xsc[ps.w] = sc; rmap[ps.x] = tok; rmap[ps.y] = tok; rmap[ps.z] = tok; rmap[ps.w] = tok; }
    }
}
template <bool Y_F8, bool X16, bool XOUT16 = false> __device__ __forceinline__ void p5b_combine(Frame& F, const float* xin, float* xout, const bf16* Y,
                                            const int* pos, const float* topw, const float* mod_l, const float* post_g,
                                            bool has_next, const float* mod_n, const float* pre_g_n, signed char* HQ, float* hs) {
    const int lane = F.lane, gw = F.vcu * NWAVES + F.wave, NGW = F.G * NWAVES;
    for (int ch = gw; ch < M / 32; ch += NGW) { const int mb = ch * 32;
        const float* modb = mod_l + (size_t)(mb >> 13) * (6 * D); const float* modn = mod_n + (size_t)(mb >> 13) * (6 * D);
        f32x4 gpv[4], gsv[4], shv[4];
#pragma unroll
        for (int j = 0; j < 4; ++j) { gpv[j] = ((const f32x4*)post_g)[lane + 64 * j] * ((const f32x4*)(modb + 5 * D))[lane + 64 * j];
            gsv[j] = ((const f32x4*)pre_g_n)[lane + 64 * j] * (((const f32x4*)(modn + D))[lane + 64 * j] + 1.0f); shv[j] = ((const f32x4*)modn)[lane + 64 * j]; }
        const i32x4 myps = *(const i32x4*)(pos + (size_t)(mb + (lane & 31)) * 4); const f32x4 mywt = *(const f32x4*)(topw + (size_t)(mb + (lane & 31)) * 4);
        u32x2 ywA[2][TOPK][4], ywB[2][TOPK][4], xwA[2][4], xwB[2][4]; f32x4 xfA[2][4], xfB[2][4];
#define P5B_ISSUE(YW, XW, XF, t0) do { _Pragma("unroll") for (int r = 0; r < 2; ++r) { const int t_ = (t0) + r; \
            _Pragma("unroll") for (int k = 0; k < TOPK; ++k) { const int p_ = __builtin_amdgcn_readlane(myps[k], t_); \
                if constexpr (Y_F8) { const int c0 = 4 * lane; const unsigned* yr = (const unsigned*)((const unsigned char*)Y + (size_t)p_ * D + 64 * ((c0 >> 5) & 3) + 16 * ((c0 >> 3) & 3) + 8 * (c0 >> 7) + (c0 & 7)); \
                    _Pragma("unroll") for (int j = 0; j < 4; ++j) { YW[r][k][j].x = __builtin_nontemporal_load(yr + 64 * j); YW[r][k][j].y = 0u; } } \
                else { const u32x2* yr = (const u32x2*)(Y + (size_t)p_ * D) + lane; _Pragma("unroll") for (int j = 0; j < 4; ++j) YW[r][k][j] = yr[64 * j]; } } \
            if constexpr (X16) { const u32x2* xr = (const u32x2*)((const bf16*)xin + (size_t)(mb + t_) * D) + lane; _Pragma("unroll") for (int j = 0; j < 4; ++j) XW[r][j] = __builtin_nontemporal_load(xr + 64 * j); } \
            else load_row_f32(xin + (size_t)(mb + t_) * D, XF[r], lane); } } while (0)
#define P5B_PROC(YW, XW, XF, t0) do { _Pragma("unroll") for (int r = 0; r < 2; ++r) { const int t_ = (t0) + r, m = mb + t_; f32x4 y[4], x[4]; \
            float wk[TOPK]; _Pragma("unroll") for (int k = 0; k < TOPK; ++k) wk[k] = __int_as_float(__builtin_amdgcn_readlane(__float_as_int(mywt[k]), t_)); \
            _Pragma("unroll") for (int j = 0; j < 4; ++j) { y[j] = (f32x4){0.f, 0.f, 0.f, 0.f}; \
                _Pragma("unroll") for (int k = 0; k < TOPK; ++k) { const u32x2 w = YW[r][k][j]; \
                    if constexpr (Y_F8) { typedef float f32x2p __attribute__((ext_vector_type(2))); const f32x2p lo = __builtin_amdgcn_cvt_pk_f32_fp8(w.x, false), hi2 = __builtin_amdgcn_cvt_pk_f32_fp8(w.x, true); \
                        y[j] += (f32x4){lo.x, lo.y, hi2.x, hi2.y} * wk[k]; } \
                    else y[j] += (f32x4){bflo(w.x), bfhi(w.x), bflo(w.y), bfhi(w.y)} * wk[k]; } \
                if constexpr (X16) { const u32x2 w = XW[r][j]; x[j] = (f32x4){bflo(w.x), bfhi(w.x), bflo(w.y), bfhi(w.y)}; } else x[j] = XF[r][j]; } \
            const float rsy = row_rstd(y); \
            _Pragma("unroll") for (int j = 0; j < 4; ++j) { x[j] = x[j] + gpv[j] * (y[j] * rsy); if constexpr (!XOUT16) __builtin_nontemporal_store(x[j], (f32x4*)(xout + (size_t)m * D) + lane + 64 * j); } \
            if constexpr (XOUT16) store_row_bf16_nt((bf16*)xout + (size_t)m * D, x, lane);        \
            if (has_next) { f32x4 h[4]; const float rs = row_rstd(x); _Pragma("unroll") for (int j = 0; j < 4; ++j) h[j] = x[j] * rs * gsv[j] + shv[j]; \
                store_row_i8(HQ + (size_t)m * D, hs + m, h, lane); } } } while (0)
        P5B_ISSUE(ywA, xwA, xfA, 0);
#pragma unroll 1
        for (int it = 0; it < 8; ++it) { const int t0 = 4 * it;
            P5B_ISSUE(ywB, xwB, xfB, t0 + 2);
            P5B_PROC(ywA, xwA, xfA, t0);
            if (it < 7) P5B_ISSUE(ywA, xwA, xfA, t0 + 4);
            P5B_PROC(ywB, xwB, xfB, t0 + 2);
        }
#undef P5B_ISSUE
#undef P5B_PROC
    }
}

constexpr int PTAB_OFF = LDSCTL_OFF + 512;
enum { I_X = 0, I_C, I_ADAW, I_ADAB, I_PREMIX, I_POSTMIX, I_WIN, I_QG, I_KG, I_DECF, I_DECB, I_GNG, I_GNB, I_WOUT, I_PREFFN, I_POSTFFN, I_RW, I_RB, I_WUP, I_BUP, I_WDN, I_BDN, I_OUT, I_WS };
__device__ __forceinline__ unsigned char* ptab(LAS unsigned char* lds, int k) {
    const LAS unsigned* p = (const LAS unsigned*)(lds + PTAB_OFF) + 2 * k;
    const unsigned lo = __builtin_amdgcn_readfirstlane(p[0]), hi = __builtin_amdgcn_readfirstlane(p[1]);
    return (unsigned char*)(GAS unsigned char*)(((unsigned long long)hi << 32) | lo);
}
__device__ __forceinline__ unsigned char* ptabx(LAS unsigned char* lds, int k) {
    const LAS unsigned* p = (const LAS unsigned*)(lds + PTAB_OFF) + 2 * k;
    const unsigned lo = __builtin_amdgcn_readfirstlane(p[0]), hi = __builtin_amdgcn_readfirstlane(p[1]);
    return (unsigned char*)(((unsigned long long)hi << 32) | lo);
}
#define WSX(off) (ptabx(F.lds, I_WS) + (off))
#define PF(k) ((const float*)ptab(F.lds, (k)))
#define WSP(off) (ptab(F.lds, I_WS) + (off))
struct Args { const float* in[22]; float* out; unsigned char* ws; };
__global__ void __launch_bounds__(NTHR, 2) mk_fwd(Args args) {
    extern __shared__ __attribute__((aligned(16))) unsigned char lds[];
    Frame F;
    F.lds = (LAS unsigned char*)lds;
    F.MISC = (volatile LAS unsigned*)(F.lds + MISC_OFF);
    F.tid = threadIdx.x; F.lane = F.tid & 63; F.wave = __builtin_amdgcn_readfirstlane(F.tid >> 6);
    F.G = gridDim.x; { const int bx = blockIdx.x; F.vcu = (F.G % 8 == 0) ? (bx % 8) * (F.G / 8) + bx / 8 : bx; }
    F.ctl = (gu32*)(args.ws + WS_CTL);
    for (int u = F.tid; u < (LDS_BYTES - LDSCTL_OFF) / 4; u += NTHR) ((LAS unsigned*)(F.lds + LDSCTL_OFF))[u] = 0u;
    __syncthreads();
    if (F.tid == 0) { LAS unsigned long long* PT = (LAS unsigned long long*)(F.lds + PTAB_OFF);
#pragma unroll
        for (int k = 0; k < 22; ++k) PT[k] = (unsigned long long)args.in[k];
        PT[I_OUT] = (unsigned long long)args.out; PT[I_WS] = (unsigned long long)args.ws; }
    __syncthreads();
    (void)xcd_barrier_post((unsigned*)(F.ctl + CW_BAR), F.MISC + 8);
#define LAUNDER() do { F.tid = threadIdx.x; asm volatile("" : "+v"(F.tid)); F.lane = F.tid & 63; F.wave = __builtin_amdgcn_readfirstlane(F.tid >> 6); \
    { unsigned long long lb_ = (unsigned long long)lds0_; int vc_ = vcu0_, g_ = G0_; asm volatile("" : "+s"(lb_), "+s"(vc_), "+s"(g_)); F.lds = (LAS unsigned char*)lb_; F.vcu = vc_; F.G = g_; } } while (0)
#ifndef REP_BAR
#define REP_BAR 1
#endif
#define GRID_BAR() for (int rb_ = 0; rb_ < REP_BAR; ++rb_) do { XcdBarrier b_; b_.bar = (unsigned*)(ptab(F.lds, I_WS) + WS_CTL) + CW_BAR; b_.x = xb_xcc_id(); b_.st = (volatile LAS unsigned*)(F.lds + MISC_OFF) + 8; xcd_barrier(b_); LAUNDER(); } while (0)
    const LAS unsigned char* lds0_ = F.lds; const int vcu0_ = F.vcu, G0_ = F.G;

#ifndef SKIP_P0
    for (int rep_ = 0; rep_ < REP_P0; ++rep_)
    p0_prologue(F, PF(I_C), PF(I_ADAW), PF(I_ADAB), (float*)WSP(WS_MOD), PF(I_WIN), PF(I_WOUT), PF(I_WUP), PF(I_WDN),
                (signed char*)WSP(WS_WIN), (float*)WSP(WS_CSCIN), (signed char*)WSP(WS_WOUT), (float*)WSP(WS_CSCOUT), (signed char*)WSP(WS_WUP), (float*)WSP(WS_CSC), (signed char*)WSP(WS_WDN), (float*)WSP(WS_CSCDN), F.ctl + CW_WQ);
#endif
    GRID_BAR();
#ifndef SKIP_P0B
    for (int rep_ = 0; rep_ < REP_P0B; ++rep_)
    p0b_premix(F, PF(I_X), (signed char*)WSP(WS_HM), (float*)WSP(WS_HS), PF(I_PREMIX), (const float*)WSP(WS_MOD));
#endif
    GRID_BAR();
    { constexpr int l = 0;
        for (int rep_ = 0; rep_ < REP_P1; ++rep_) { LAUNDER();
#ifndef SKIP_P1
        {
            pg8::Gemm g{(const bf16*)WSP(WS_HM), (const bf16*)(WSP(WS_WIN) + (size_t)l * INW * D), M, INW, D / 2}; pg8::StaticOrder S; S.init(M, INW, F.G, (int)blockIdx.x);
            pg8::EpiI8Bf16 E{(bf16*)WSP(WS_PROJ), INW, (const float*)WSP(WS_HS), (const float*)WSP(WS_CSCIN) + (size_t)l * INW, F.lds + EPI_SP_OFF};
#if defined(STAGGER_P1)
            { const unsigned long long t0_ = __builtin_amdgcn_s_memrealtime(), dl_ = (unsigned long long)(F.vcu & 7) * STAGGER_P1; while (__builtin_amdgcn_s_memrealtime() - t0_ < dl_) __builtin_amdgcn_s_sleep(8); }
#endif
#if defined(NOEPI_P1)
            { pg8::EpiNullI8 E0; pg8::gemm_phase<pg8::EpiNullI8, pg8::StaticOrder, true, true, true, true>(F.lds + RING_OFF, g, S, E0, (const int*)WSP(WS_RMAP)); LAUNDER(); }
#endif
            pg8::gemm_phase<pg8::EpiI8Bf16, pg8::StaticOrder, true, true, true>(F.lds + RING_OFF, g, S, E);
        }
#endif
        }
        GRID_BAR();
#if defined(ATTN_PROBE)
        if (l == 0) ka_expect(F, (const bf16*)WSP(WS_PROJ), (float*)WSP(WS_DUMMY), PF(I_KG));
        GRID_BAR();
#endif
#ifndef SKIP_P1B
        p1b_ka(F, (bf16*)WSP(WS_PROJ), PF(I_KG) + l * 64);
#endif
        for (int rep_ = 0; rep_ < REP_R1; ++rep_) { LAUNDER();
#ifndef SKIP_R1
        r1_states(F, (const bf16*)WSP(WS_PROJ), (bf16*)WSP(WS_U), PF(I_DECF) + l * RH, PF(I_DECB) + l * RH);
#endif
        }
        GRID_BAR();
        for (int rep_ = 0; rep_ < REP_R2; ++rep_) { LAUNDER();
#ifndef SKIP_R2
        r2_scan(F, (const bf16*)WSP(WS_U), (bf16*)WSP(WS_FT), PF(I_DECF) + l * RH, PF(I_DECB) + l * RH);
#endif
        }
        GRID_BAR();
#pragma unroll 1
        for (int pass_ = 0; pass_ < 2; ++pass_) { LAUNDER();
        if (((F.vcu ^ pass_) & 1) == 0) {
#ifndef SKIP_R3
        for (int rr_ = 0; rr_ < REP_R3; ++rr_) { LAUNDER();
        r3_out(F, (const bf16*)WSP(WS_PROJ), (const bf16*)WSP(WS_FT), (bf16*)WSP(WS_CAT), PF(I_DECF) + l * RH, PF(I_DECB) + l * RH, PF(I_GNG) + l * 512, PF(I_GNB) + l * 512);
        }
#endif
        } else {
#ifndef SKIP_P2
        {
            const bf16* PROJ = (const bf16*)WSP(WS_PROJ);
            const attn_body::AttnTensors AT{(const attn_body::bf16*)(PROJ + C_QA), (const attn_body::bf16*)(PROJ + C_KA), (const attn_body::bf16*)(PROJ + C_VA), (attn_body::bf16*)WSP(WS_CAT), PF(I_QG) + l * 64, PF(I_KG) + l * 64};
            attn_body::attn_phase<8>((char*)lds + RING_OFF, AT, F.vcu, F.G);
        }
#endif
        }
        }
        GRID_BAR();
#if defined(ATTN_PROBE)
        if (l == 0) ka_compare(F, (const bf16*)WSP(WS_PROJ), (const float*)WSP(WS_DUMMY), F.ctl + CW_CODE + 8);
        if (l == 0) attn_check(F, (const bf16*)WSP(WS_PROJ), (const bf16*)WSP(WS_CAT), F.ctl + CW_CODE + 8, PF(I_QG));
#endif
        for (int rep_ = 0; rep_ < REP_P3; ++rep_) { LAUNDER();
#ifndef SKIP_P3
        {
            pg8::Gemm g{(const bf16*)WSP(WS_CAT), (const bf16*)(WSP(WS_WOUT) + (size_t)l * D * D), M, D, D / 2}; pg8::StaticOrder S; S.init(M, D, F.G, (int)blockIdx.x);
            pg8::EpiBf16 E{(bf16*)WSP(WS_YM), D, nullptr, 0, 0, F.lds + EPI_SP_OFF, (const float*)WSP(WS_CSCOUT) + (size_t)l * D, 1.0f};
            pg8::gemm_phase<pg8::EpiBf16, pg8::StaticOrder, true, true, false, false, true>(F.lds + RING_OFF, g, S, E);
        }
#endif
        }
        GRID_BAR();
#ifndef SKIP_P3B
        for (int rep_ = 1; rep_ < REP_P3B; ++rep_) { LAUNDER();
        p3b_postmix<false, (l > 0)>(F, l == 0 ? PF(I_X) : PF(I_OUT), (float*)WSP(WS_DUMMY), (const bf16*)WSP(WS_YM), (signed char*)WSP(WS_DUMMY + 256 * MiB), (float*)WSP(WS_DUMMY + 386 * MiB), (const float*)WSP(WS_MOD) + (size_t)l * BATCH * 6 * D,
                    PF(I_POSTMIX) + l * D, PF(I_PREFFN) + l * D, PF(I_RW) + (size_t)l * D * NE, PF(I_RB) + l * NE, (int*)WSP(WS_DUMMY + 384 * MiB), (float*)WSP(WS_DUMMY + 385 * MiB), F.ctl + CW_CNT + 128 + l * 64);
        }
        LAUNDER();
        p3b_postmix<(l >= X16_FROM), (l > 0)>(F, l == 0 ? PF(I_X) : PF(I_OUT), (l >= X16_FROM) ? (float*)WSP(WS_CAT) : (float*)ptab(F.lds, I_OUT), (const bf16*)WSP(WS_YM), (signed char*)WSP(WS_HM), (float*)WSP(WS_HS), (const float*)WSP(WS_MOD) + (size_t)l * BATCH * 6 * D,
                    PF(I_POSTMIX) + l * D, PF(I_PREFFN) + l * D, PF(I_RW) + (size_t)l * D * NE, PF(I_RB) + l * NE, (int*)WSP(WS_TOPI), (float*)WSP(WS_TOPW), F.ctl + CW_CNT + l * 64);
#endif
        GRID_BAR();
#ifndef SKIP_P4A
        for (int rep_ = 1; rep_ < REP_P4A; ++rep_) { LAUNDER();
        p4a_route(F, (const float*)WSP(WS_HS), (int*)WSP(WS_DUMMY + 16 * MiB), (float*)WSP(WS_DUMMY + 8 * MiB), (const int*)WSP(WS_TOPI), (int*)WSP(WS_DUMMY), F.ctl + CW_CNT + l * 64, F.ctl + CW_CUR + 128 + l * 64);
        }
        LAUNDER();
        p4a_route(F, (const float*)WSP(WS_HS), (int*)WSP(WS_RMAP), (float*)WSP(WS_XSC), (const int*)WSP(WS_TOPI), (int*)WSP(WS_POS), F.ctl + CW_CNT + l * 64, F.ctl + CW_CUR + l * 64);
#endif
        GRID_BAR();
        for (int rep_ = 0; rep_ < REP_P4; ++rep_) { LAUNDER();
#ifndef SKIP_P4
        {
            const LAS int* ts = (const LAS int*)(F.lds + LTS_OFF);
            pg8::Gemm g{(const bf16*)WSP(WS_HM), (const bf16*)(WSP(WS_WUP) + (size_t)l * NE * 2048 * D), XS_ROWS, 2048, D / 2}; pg8::MoeOrder<3> S{ts, F.G, F.vcu, ts[NE] * 8, ts[F.lane & 31]};
            pg8::EpiMoeUpT<true> E{(bf16*)WSP(WS_ACT), PF(I_BUP) + (size_t)l * NE * 2048, (const float*)WSP(WS_XSC), (const float*)WSP(WS_CSC) + (size_t)l * NE * 2048, F.lds + EPI_SP_OFF};
#if defined(STAGGER_P4)
            { const unsigned long long t0_ = __builtin_amdgcn_s_memrealtime(), dl_ = (unsigned long long)(F.vcu & (STAGGER_WAYS - 1)) * STAGGER_P4; while (__builtin_amdgcn_s_memrealtime() - t0_ < dl_) __builtin_amdgcn_s_sleep(8); }
#endif
#if defined(NOLOAD_P4)
            { pg8::EpiMoeUpNoLoad E0{(bf16*)WSP(WS_ACT), 1e-4f, 0.01f}; pg8::gemm_phase<pg8::EpiMoeUpNoLoad, pg8::MoeOrder<3>, true, true, true, true>(F.lds + RING_OFF, g, S, E0, (const int*)WSP(WS_RMAP)); LAUNDER(); }
#endif
#if defined(NOSTORE_P4)
            { pg8::EpiMoeUpNoStore E0{(bf16*)WSP(WS_ACT), 1e-4f, 0.01f}; pg8::gemm_phase<pg8::EpiMoeUpNoStore, pg8::MoeOrder<3>, true, true, true, true>(F.lds + RING_OFF, g, S, E0, (const int*)WSP(WS_RMAP)); LAUNDER(); }
#endif
#if defined(NOEPI_P4)
            { pg8::EpiNullI8 E0; pg8::gemm_phase<pg8::EpiNullI8, pg8::MoeOrder<3>, true, true, true, true>(F.lds + RING_OFF, g, S, E0, (const int*)WSP(WS_RMAP)); LAUNDER(); }
#endif
            pg8::gemm_phase<pg8::EpiMoeUpT<true>, pg8::MoeOrder<3>, true, true, true, true>(F.lds + RING_OFF, g, S, E, (const int*)WSP(WS_RMAP));
        }
#endif
        }
        GRID_BAR();
        for (int rep_ = 0; rep_ < REP_P5; ++rep_) { LAUNDER();
#ifndef SKIP_P5
        {
            const LAS int* ts = (const LAS int*)(F.lds + LTS_OFF);
            pg8::Gemm g{(const bf16*)WSP(WS_ACT), (const bf16*)(WSP(WS_WDN) + (size_t)l * NE * D * D), XS_ROWS, D, D / 2}; pg8::MoeOrder<2> S{ts, F.G, F.vcu, ts[NE] * 4, ts[F.lane & 31]};
            typedef pg8::EpiBf16T<(l >= YF8_FROM)> EpiDn;
            EpiDn E{(bf16*)WSP(WS_XS), D, PF(I_BDN) + (size_t)l * NE * D, D, 0, F.lds + EPI_SP_OFF, (const float*)WSP(WS_CSCDN) + (size_t)l * NE * D, 1.0f / pg8::ACT_F8_SCALE};
#if defined(STAGGER_P5)
            { const unsigned long long t0_ = __builtin_amdgcn_s_memrealtime(), dl_ = (unsigned long long)(F.vcu & 7) * STAGGER_P5; while (__builtin_amdgcn_s_memrealtime() - t0_ < dl_) __builtin_amdgcn_s_sleep(8); }
#endif
            pg8::gemm_phase<EpiDn, pg8::MoeOrder<2>, true, true, false, false, true>(F.lds + RING_OFF, g, S, E);
        }
#endif
        }
        GRID_BAR();
#ifndef SKIP_P5B
        for (int rep_ = 1; rep_ < REP_P5B; ++rep_) { LAUNDER();
        p5b_combine<(l >= YF8_FROM), (l >= X16_FROM), (l + 1 < DEPTH)>(F, (l >= X16_FROM) ? (const float*)WSP(WS_CAT) : (const float*)ptab(F.lds, I_OUT), (float*)WSP(WS_DUMMY), (const bf16*)WSP(WS_XS), (const int*)WSP(WS_POS), (const float*)WSP(WS_TOPW), (const float*)WSP(WS_MOD) + (size_t)l * BATCH * 6 * D, PF(I_POSTFFN) + l * D,
                    l + 1 < DEPTH, (const float*)WSP(WS_MOD) + (size_t)(l + 1 < DEPTH ? l + 1 : l) * BATCH * 6 * D, PF(I_PREMIX) + (l + 1 < DEPTH ? (l + 1) * D : 0), (signed char*)WSP(WS_DUMMY + 256 * MiB), (float*)WSP(WS_DUMMY + 386 * MiB));
        }
        LAUNDER();
        p5b_combine<(l >= YF8_FROM), (l >= X16_FROM), (l + 1 < DEPTH)>(F, (l >= X16_FROM) ? (const float*)WSP(WS_CAT) : (const float*)ptab(F.lds, I_OUT), (float*)ptab(F.lds, I_OUT), (const bf16*)WSP(WS_XS), (const int*)WSP(WS_POS), (const float*)WSP(WS_TOPW), (const float*)WSP(WS_MOD) + (size_t)l * BATCH * 6 * D, PF(I_POSTFFN) + l * D,
                    l + 1 < DEPTH, (const float*)WSP(WS_MOD) + (size_t)(l + 1 < DEPTH ? l + 1 : l) * BATCH * 6 * D, PF(I_PREMIX) + (l + 1 < DEPTH ? (l + 1) * D : 0), (signed char*)WSP(WS_HM), (float*)WSP(WS_HS));
#endif
        if (l + 1 < DEPTH) GRID_BAR();
    }
    { constexpr int l = 1;
        for (int rep_ = 0; rep_ < REP_P1; ++rep_) { LAUNDER();
#ifndef SKIP_P1
        {
            pg8::Gemm g{(const bf16*)WSP(WS_HM), (const bf16*)(WSP(WS_WIN) + (size_t)l * INW * D), M, INW, D / 2}; pg8::StaticOrder S; S.init(M, INW, F.G, (int)blockIdx.x);
            pg8::EpiI8Bf16 E{(bf16*)WSP(WS_PROJ), INW, (const float*)WSP(WS_HS), (const float*)WSP(WS_CSCIN) + (size_t)l * INW, F.lds + EPI_SP_OFF};
#if defined(STAGGER_P1)
            { const unsigned long long t0_ = __builtin_amdgcn_s_memrealtime(), dl_ = (unsigned long long)(F.vcu & 7) * STAGGER_P1; while (__builtin_amdgcn_s_memrealtime() - t0_ < dl_) __builtin_amdgcn_s_sleep(8); }
#endif
#if defined(NOEPI_P1)
            { pg8::EpiNullI8 E0; pg8::gemm_phase<pg8::EpiNullI8, pg8::StaticOrder, true, true, true, true>(F.lds + RING_OFF, g, S, E0, (const int*)WSP(WS_RMAP)); LAUNDER(); }
#endif
            pg8::gemm_phase<pg8::EpiI8Bf16, pg8::StaticOrder, true, true, true>(F.lds + RING_OFF, g, S, E);
        }
#endif
        }
        GRID_BAR();
#if defined(ATTN_PROBE)
        if (l == 0) ka_expect(F, (const bf16*)WSP(WS_PROJ), (float*)WSP(WS_DUMMY), PF(I_KG));
        GRID_BAR();
#endif
#ifndef SKIP_P1B
        p1b_ka(F, (bf16*)WSP(WS_PROJ), PF(I_KG) + l * 64);
#endif
        for (int rep_ = 0; rep_ < REP_R1; ++rep_) { LAUNDER();
#ifndef SKIP_R1
        r1_states(F, (const bf16*)WSP(WS_PROJ), (bf16*)WSP(WS_U), PF(I_DECF) + l * RH, PF(I_DECB) + l * RH);
#endif
        }
        GRID_BAR();
        for (int rep_ = 0; rep_ < REP_R2; ++rep_) { LAUNDER();
#ifndef SKIP_R2
        r2_scan(F, (const bf16*)WSP(WS_U), (bf16*)WSP(WS_FT), PF(I_DECF) + l * RH, PF(I_DECB) + l * RH);
#endif
        }
        GRID_BAR();
#pragma unroll 1
        for (int pass_ = 0; pass_ < 2; ++pass_) { LAUNDER();
        if (((F.vcu ^ pass_) & 1) == 0) {
#ifndef SKIP_R3
        for (int rr_ = 0; rr_ < REP_R3; ++rr_) { LAUNDER();
        r3_out(F, (const bf16*)WSP(WS_PROJ), (const bf16*)WSP(WS_FT), (bf16*)WSP(WS_CAT), PF(I_DECF) + l * RH, PF(I_DECB) + l * RH, PF(I_GNG) + l * 512, PF(I_GNB) + l * 512);
        }
#endif
        } else {
#ifndef SKIP_P2
        {
            const bf16* PROJ = (const bf16*)WSP(WS_PROJ);
            const attn_body::AttnTensors AT{(const attn_body::bf16*)(PROJ + C_QA), (const attn_body::bf16*)(PROJ + C_KA), (const attn_body::bf16*)(PROJ + C_VA), (attn_body::bf16*)WSP(WS_CAT), PF(I_QG) + l * 64, PF(I_KG) + l * 64};
            attn_body::attn_phase<8>((char*)lds + RING_OFF, AT, F.vcu, F.G);
        }
#endif
        }
        }
        GRID_BAR();
#if defined(ATTN_PROBE)
        if (l == 0) ka_compare(F, (const bf16*)WSP(WS_PROJ), (const float*)WSP(WS_DUMMY), F.ctl + CW_CODE + 8);
        if (l == 0) attn_check(F, (const bf16*)WSP(WS_PROJ), (const bf16*)WSP(WS_CAT), F.ctl + CW_CODE + 8, PF(I_QG));
#endif
        for (int rep_ = 0; rep_ < REP_P3; ++rep_) { LAUNDER();
#ifndef SKIP_P3
        {
            pg8::Gemm g{(const bf16*)WSP(WS_CAT), (const bf16*)(WSP(WS_WOUT) + (size_t)l * D * D), M, D, D / 2}; pg8::StaticOrder S; S.init(M, D, F.G, (int)blockIdx.x);
            pg8::EpiBf16 E{(bf16*)WSP(WS_YM), D, nullptr, 0, 0, F.lds + EPI_SP_OFF, (const float*)WSP(WS_CSCOUT) + (size_t)l * D, 1.0f};
            pg8::gemm_phase<pg8::EpiBf16, pg8::StaticOrder, true, true, false, false, true>(F.lds + RING_OFF, g, S, E);
        }
#endif
        }
        GRID_BAR();
#ifndef SKIP_P3B
        for (int rep_ = 1; rep_ < REP_P3B; ++rep_) { LAUNDER();
        p3b_postmix<false, (l > 0)>(F, l == 0 ? PF(I_X) : PF(I_OUT), (float*)WSP(WS_DUMMY), (const bf16*)WSP(WS_YM), (signed char*)WSP(WS_DUMMY + 256 * MiB), (float*)WSP(WS_DUMMY + 386 * MiB), (const float*)WSP(WS_MOD) + (size_t)l * BATCH * 6 * D,
                    PF(I_POSTMIX) + l * D, PF(I_PREFFN) + l * D, PF(I_RW) + (size_t)l * D * NE, PF(I_RB) + l * NE, (int*)WSP(WS_DUMMY + 384 * MiB), (float*)WSP(WS_DUMMY + 385 * MiB), F.ctl + CW_CNT + 128 + l * 64);
        }
        LAUNDER();
        p3b_postmix<(l >= X16_FROM), (l > 0)>(F, l == 0 ? PF(I_X) : PF(I_OUT), (l >= X16_FROM) ? (float*)WSP(WS_CAT) : (float*)ptab(F.lds, I_OUT), (const bf16*)WSP(WS_YM), (signed char*)WSP(WS_HM), (float*)WSP(WS_HS), (const float*)WSP(WS_MOD) + (size_t)l * BATCH * 6 * D,
                    PF(I_POSTMIX) + l * D, PF(I_PREFFN) + l * D, PF(I_RW) + (size_t)l * D * NE, PF(I_RB) + l * NE, (int*)WSP(WS_TOPI), (float*)WSP(WS_TOPW), F.ctl + CW_CNT + l * 64);
#endif
        GRID_BAR();
#ifndef SKIP_P4A
        for (int rep_ = 1; rep_ < REP_P4A; ++rep_) { LAUNDER();
        p4a_route(F, (const float*)WSP(WS_HS), (int*)WSP(WS_DUMMY + 16 * MiB), (float*)WSP(WS_DUMMY + 8 * MiB), (const int*)WSP(WS_TOPI), (int*)WSP(WS_DUMMY), F.ctl + CW_CNT + l * 64, F.ctl + CW_CUR + 128 + l * 64);
        }
        LAUNDER();
        p4a_route(F, (const float*)WSP(WS_HS), (int*)WSP(WS_RMAP), (float*)WSP(WS_XSC), (const int*)WSP(WS_TOPI), (int*)WSP(WS_POS), F.ctl + CW_CNT + l * 64, F.ctl + CW_CUR + l * 64);
#endif
        GRID_BAR();
        for (int rep_ = 0; rep_ < REP_P4; ++rep_) { LAUNDER();
#ifndef SKIP_P4
        {
            const LAS int* ts = (const LAS int*)(F.lds + LTS_OFF);
            pg8::Gemm g{(const bf16*)WSP(WS_HM), (const bf16*)(WSP(WS_WUP) + (size_t)l * NE * 2048 * D), XS_ROWS, 2048, D / 2}; pg8::MoeOrder<3> S{ts, F.G, F.vcu, ts[NE] * 8, ts[F.lane & 31]};
            pg8::EpiMoeUpT<true> E{(bf16*)WSP(WS_ACT), PF(I_BUP) + (size_t)l * NE * 2048, (const float*)WSP(WS_XSC), (const float*)WSP(WS_CSC) + (size_t)l * NE * 2048, F.lds + EPI_SP_OFF};
#if defined(STAGGER_P4)
            { const unsigned long long t0_ = __builtin_amdgcn_s_memrealtime(), dl_ = (unsigned long long)(F.vcu & (STAGGER_WAYS - 1)) * STAGGER_P4; while (__builtin_amdgcn_s_memrealtime() - t0_ < dl_) __builtin_amdgcn_s_sleep(8); }
#endif
#if defined(NOLOAD_P4)
            { pg8::EpiMoeUpNoLoad E0{(bf16*)WSP(WS_ACT), 1e-4f, 0.01f}; pg8::gemm_phase<pg8::EpiMoeUpNoLoad, pg8::MoeOrder<3>, true, true, true, true>(F.lds + RING_OFF, g, S, E0, (const int*)WSP(WS_RMAP)); LAUNDER(); }
#endif
#if defined(NOSTORE_P4)
            { pg8::EpiMoeUpNoStore E0{(bf16*)WSP(WS_ACT), 1e-4f, 0.01f}; pg8::gemm_phase<pg8::EpiMoeUpNoStore, pg8::MoeOrder<3>, true, true, true, true>(F.lds + RING_OFF, g, S, E0, (const int*)WSP(WS_RMAP)); LAUNDER(); }
#endif
#if defined(NOEPI_P4)
            { pg8::EpiNullI8 E0; pg8::gemm_phase<pg8::EpiNullI8, pg8::MoeOrder<3>, true, true, true, true>(F.lds + RING_OFF, g, S, E0, (const int*)WSP(WS_RMAP)); LAUNDER(); }
#endif
            pg8::gemm_phase<pg8::EpiMoeUpT<true>, pg8::MoeOrder<3>, true, true, true, true>(F.lds + RING_OFF, g, S, E, (const int*)WSP(WS_RMAP));
        }
#endif
        }
        GRID_BAR();
        for (int rep_ = 0; rep_ < REP_P5; ++rep_) { LAUNDER();
#ifndef SKIP_P5
        {
            const LAS int* ts = (const LAS int*)(F.lds + LTS_OFF);
            pg8::Gemm g{(const bf16*)WSP(WS_ACT), (const bf16*)(WSP(WS_WDN) + (size_t)l * NE * D * D), XS_ROWS, D, D / 2}; pg8::MoeOrder<2> S{ts, F.G, F.vcu, ts[NE] * 4, ts[F.lane & 31]};
            typedef pg8::EpiBf16T<(l >= YF8_FROM)> EpiDn;
            EpiDn E{(bf16*)WSP(WS_XS), D, PF(I_BDN) + (size_t)l * NE * D, D, 0, F.lds + EPI_SP_OFF, (const float*)WSP(WS_CSCDN) + (size_t)l * NE * D, 1.0f / pg8::ACT_F8_SCALE};
#if defined(STAGGER_P5)
            { const unsigned long long t0_ = __builtin_amdgcn_s_memrealtime(), dl_ = (unsigned long long)(F.vcu & 7) * STAGGER_P5; while (__builtin_amdgcn_s_memrealtime() - t0_ < dl_) __builtin_amdgcn_s_sleep(8); }
#endif
            pg8::gemm_phase<EpiDn, pg8::MoeOrder<2>, true, true, false, false, true>(F.lds + RING_OFF, g, S, E);
        }
#endif
        }
        GRID_BAR();
#ifndef SKIP_P5B
        for (int rep_ = 1; rep_ < REP_P5B; ++rep_) { LAUNDER();
        p5b_combine<(l >= YF8_FROM), (l >= X16_FROM), (l + 1 < DEPTH)>(F, (l >= X16_FROM) ? (const float*)WSP(WS_CAT) : (const float*)ptab(F.lds, I_OUT), (float*)WSP(WS_DUMMY), (const bf16*)WSP(WS_XS), (const int*)WSP(WS_POS), (const float*)WSP(WS_TOPW), (const float*)WSP(WS_MOD) + (size_t)l * BATCH * 6 * D, PF(I_POSTFFN) + l * D,
                    l + 1 < DEPTH, (const float*)WSP(WS_MOD) + (size_t)(l + 1 < DEPTH ? l + 1 : l) * BATCH * 6 * D, PF(I_PREMIX) + (l + 1 < DEPTH ? (l + 1) * D : 0), (signed char*)WSP(WS_DUMMY + 256 * MiB), (float*)WSP(WS_DUMMY + 386 * MiB));
        }
        LAUNDER();
        p5b_combine<(l >= YF8_FROM), (l >= X16_FROM), (l + 1 < DEPTH)>(F, (l >= X16_FROM) ? (const float*)WSP(WS_CAT) : (const float*)ptab(F.lds, I_OUT), (float*)ptab(F.lds, I_OUT), (const bf16*)WSP(WS_XS), (const int*)WSP(WS_POS), (const float*)WSP(WS_TOPW), (const float*)WSP(WS_MOD) + (size_t)l * BATCH * 6 * D, PF(I_POSTFFN) + l * D,
                    l + 1 < DEPTH, (const float*)WSP(WS_MOD) + (size_t)(l + 1 < DEPTH ? l + 1 : l) * BATCH * 6 * D, PF(I_PREMIX) + (l + 1 < DEPTH ? (l + 1) * D : 0), (signed char*)WSP(WS_HM), (float*)WSP(WS_HS));
#endif
        if (l + 1 < DEPTH) GRID_BAR();
    }
#if defined(ATTN_PROBE)
    GRID_BAR();
    if (blockIdx.x == 0 && F.tid == 0 && __hip_atomic_load(F.ctl + CW_CODE + 8, RLX_AGENT) != 0u) ((float*)ptab(F.lds, I_OUT))[0] = __builtin_nanf("");
#endif
#undef GRID_BAR
}

extern "C" void kernel_launch(void* const* d_in, const int* in_sizes, int n_in, void* d_out, int out_size, void* d_ws, size_t ws_size, hipStream_t stream) {
    static int grid = 0;
    if (grid == 0) {
        if (n_in != 22 || in_sizes[0] != M * D || out_size != M * D || ws_size < WS_END) { fprintf(stderr, "kernel_launch: unexpected shapes/workspace (n_in %d, in0 %d, out %d, ws %zu < %zu)\n", n_in, n_in > 0 ? in_sizes[0] : -1, out_size, ws_size, (size_t)WS_END); grid = -1; return; }
        int dev = 0, cus = 0, per_cu = 0;
        if (hipGetDevice(&dev) != hipSuccess || hipDeviceGetAttribute(&cus, hipDeviceAttributeMultiprocessorCount, dev) != hipSuccess) { grid = -1; return; }
        if (hipFuncSetAttribute((const void*)mk_fwd, hipFuncAttributeMaxDynamicSharedMemorySize, LDS_BYTES) != hipSuccess) { fprintf(stderr, "kernel_launch: hipFuncSetAttribute failed\n"); grid = -1; return; }
        if (hipOccupancyMaxActiveBlocksPerMultiprocessor(&per_cu, (const void*)mk_fwd, NTHR, LDS_BYTES) != hipSuccess || per_cu < 1) { fprintf(stderr, "kernel_launch: occupancy query says %d\n", per_cu); }
        (void)hipGetLastError();
        grid = cus;
    }
    if (grid < 0) return;
    if (hipMemsetAsync((char*)d_ws + WS_CTL, 0, CTL_ZERO_BYTES, stream) != hipSuccess) { fprintf(stderr, "kernel_launch: memset failed\n"); return; }
    Args a{};
    for (int i = 0; i < 22; ++i) a.in[i] = (const float*)d_in[i];
    a.out = (float*)d_out; a.ws = (unsigned char*)d_ws;
    hipLaunchKernelGGL(mk_fwd, dim3(grid), dim3(NTHR), LDS_BYTES, stream, a);
    const hipError_t le = hipPeekAtLastError();
    if (le != hipSuccess) fprintf(stderr, "kernel_launch: launch failed: %s\n", hipGetErrorName(le));
}
```
